# Optimizing an MI355X kernel written in HIP

```python
import math
import jax, jax.numpy as jnp
from jax import lax
import numpy as np

D_MODEL = 1024
BATCH = 16
SEQ = 4096
DEPTH = 1

PLE_DIM = 256
RMS_EPS = 1e-6
A_HEAD_DIM = 64
A_HEADS = D_MODEL // 128
A_WIDTH = A_HEADS * A_HEAD_DIM
MOBA_BLOCK = 256
MOBA_TOPK = 3
Q_CHUNK = 16
REL_BUCKETS = 32
REL_MAX_EXACT = REL_BUCKETS // 2
REL_MAX_DIST = 128
B_HEAD_DIM = 64
B_HEADS = D_MODEL // 128
B_WIDTH = B_HEADS * B_HEAD_DIM
DECAY_RANK = 64
ICLR_RANK = 64
GN_EPS = 64e-5
A_COLS = 4 * A_WIDTH
RW_COLS = 4 * B_WIDTH + DECAY_RANK + ICLR_RANK
IN_COLS = A_COLS + RW_COLS + 2 * D_MODEL

kernel_name = "hybrid_moba_rwkv7_gated_block"


def _rms_norm(x, g):
    xf = x.astype(jnp.float32)
    y = xf * lax.rsqrt(jnp.mean(xf * xf, axis=-1, keepdims=True) + RMS_EPS)
    return y * g.astype(jnp.float32)


def _t5_bucket(dist):
    n = jnp.maximum(dist, 0)
    nf = jnp.maximum(n, 1).astype(jnp.float32)
    large = REL_MAX_EXACT + (jnp.log(nf / REL_MAX_EXACT) / math.log(REL_MAX_DIST / REL_MAX_EXACT)
                             * (REL_BUCKETS - REL_MAX_EXACT)).astype(jnp.int32)
    large = jnp.minimum(large, REL_BUCKETS - 1)
    return jnp.where(n < REL_MAX_EXACT, n, large)


def _moba_attention(q, k, v, rel_bias):
    bsz, seq, nh, hd = q.shape
    n_blk = -(-seq // MOBA_BLOCK)
    pad = n_blk * MOBA_BLOCK - seq
    topk = min(MOBA_TOPK, n_blk)
    qh = jnp.swapaxes(q, 1, 2).astype(jnp.float32) * (hd ** -0.5)
    kh = jnp.pad(jnp.swapaxes(k, 1, 2).astype(jnp.float32), ((0, 0), (0, 0), (0, pad), (0, 0)))
    vh = jnp.pad(jnp.swapaxes(v, 1, 2).astype(jnp.float32), ((0, 0), (0, 0), (0, pad), (0, 0)))
    k_blk = kh.reshape(bsz, nh, n_blk, MOBA_BLOCK, hd)
    v_blk = vh.reshape(bsz, nh, n_blk, MOBA_BLOCK, hd)
    k_mean = jnp.mean(k_blk, axis=3)
    gate = jnp.einsum('bhsd,bhnd->bhsn', qh, k_mean)
    q_blk = jnp.arange(seq) // MOBA_BLOCK
    past = jnp.arange(n_blk)[None, :] < q_blk[:, None]
    gate = jnp.where(past[None, None], gate, -jnp.inf)
    _, sel = lax.top_k(gate, topk)
    bias_h = rel_bias.T.astype(jnp.float32)
    b_idx = jnp.arange(bsz)[:, None, None, None]
    h_idx = jnp.arange(nh)[None, :, None, None]
    offs = jnp.arange(MOBA_BLOCK)

    def chunk(c):
        t0 = c * Q_CHUNK
        pos = t0 + jnp.arange(Q_CHUNK)
        qb = t0 // MOBA_BLOCK
        qc = lax.dynamic_slice_in_dim(qh, t0, Q_CHUNK, axis=2)
        sc = lax.dynamic_slice_in_dim(sel, t0, Q_CHUNK, axis=2)
        ks = k_blk[b_idx, h_idx, sc]
        vs = v_blk[b_idx, h_idx, sc]
        key_pos = sc[..., None] * MOBA_BLOCK + offs
        dist = pos[None, None, :, None, None] - key_pos
        l_sel = jnp.einsum('bhqd,bhqkjd->bhqkj', qc, ks) + bias_h[h_idx[..., None], _t5_bucket(dist)]
        valid = (sc < qb)[..., None]
        l_sel = jnp.where(valid, l_sel, -jnp.inf).reshape(bsz, nh, Q_CHUNK, topk * MOBA_BLOCK)
        ko = lax.dynamic_index_in_dim(k_blk, qb, axis=2, keepdims=False)
        vo = lax.dynamic_index_in_dim(v_blk, qb, axis=2, keepdims=False)
        dist_o = pos[:, None] - (qb * MOBA_BLOCK + offs)[None, :]
        l_own = jnp.einsum('bhqd,bhjd->bhqj', qc, ko) + bias_h[:, _t5_bucket(dist_o)][None]
        l_own = jnp.where((dist_o >= 0)[None, None], l_own, -jnp.inf)
        probs = jax.nn.softmax(jnp.concatenate([l_sel, l_own], axis=-1), axis=-1)
        p_sel = probs[..., :topk * MOBA_BLOCK].reshape(bsz, nh, Q_CHUNK, topk, MOBA_BLOCK)
        p_own = probs[..., topk * MOBA_BLOCK:]
        return (jnp.einsum('bhqkj,bhqkjd->bhqd', p_sel, vs)
                + jnp.einsum('bhqj,bhjd->bhqd', p_own, vo))

    outs = lax.map(chunk, jnp.arange(seq // Q_CHUNK))
    return outs.transpose(1, 0, 3, 2, 4).reshape(bsz, seq, nh * hd)


def _rwkv7_time_mix(cols, mu, w0, w_up, a0, a_up, k_k, k_a, r_k, ln_w, ln_b):
    bsz, seq, _ = cols.shape
    cols = cols.astype(jnp.float32)
    prev = jnp.pad(cols, ((0, 0), (1, 0), (0, 0)))[:, :-1]
    cols = cols + (prev - cols) * mu.astype(jnp.float32)
    o = np.cumsum([0, B_WIDTH, B_WIDTH, B_WIDTH, B_WIDTH, DECAY_RANK])
    r, k, v, z = (cols[..., o[j]:o[j + 1]] for j in range(4))
    wd = cols[..., o[4]:o[5]]
    ad = cols[..., o[5]:]
    w_log = -jax.nn.softplus(-(w0 + jnp.tanh(wd) @ w_up)) - 0.5
    decay = jnp.exp(-jnp.exp(w_log))
    a = jax.nn.sigmoid(a0 + ad @ a_up)
    heads = lambda t: t.reshape(bsz, seq, B_HEADS, B_HEAD_DIM)
    kk = heads(k * k_k)
    kk = kk / jnp.maximum(jnp.linalg.norm(kk, axis=-1, keepdims=True), 1e-12)
    k = k * (1.0 + (a - 1.0) * k_a)
    rh, kh, vh, ah = heads(r), heads(k), heads(v), heads(a)
    xs = tuple(jnp.moveaxis(t, 1, 0) for t in (rh, heads(decay), kh, vh, -kk, kk * ah))

    def step(state, inp):
        r_t, w_t, k_t, v_t, a_t, b_t = inp
        sa = jnp.einsum('bhvk,bhk->bhv', state, a_t)
        state = (state * w_t[:, :, None, :] + sa[..., None] * b_t[:, :, None, :]
                 + v_t[..., None] * k_t[:, :, None, :])
        return state, jnp.einsum('bhvk,bhk->bhv', state, r_t)

    s0 = jnp.zeros((bsz, B_HEADS, B_HEAD_DIM, B_HEAD_DIM), jnp.float32)
    _, y = lax.scan(step, s0, xs)
    y = jnp.moveaxis(y, 0, 1)
    mean = jnp.mean(y, axis=-1, keepdims=True)
    var = jnp.mean(jnp.square(y - mean), axis=-1, keepdims=True)
    y = ((y - mean) * lax.rsqrt(var + GN_EPS)).reshape(bsz, seq, B_WIDTH) * ln_w + ln_b
    bonus = jnp.sum(rh * kh * r_k, axis=-1, keepdims=True) * vh
    y = y + bonus.reshape(bsz, seq, B_WIDTH)
    return y, z


def setup_inputs(seed: int = 0) -> dict:
    key = jax.random.key(seed)
    ks = jax.random.split(key, 22)
    n = lambda k, s, sc: jax.random.normal(k, s, jnp.float32) * sc
    L = DEPTH
    return {
        "x": n(ks[0], (BATCH, SEQ, D_MODEL), 1.0),
        "p": n(ks[1], (DEPTH, BATCH, SEQ, PLE_DIM), 1.0),
        "g_pre": 1.0 + n(ks[2], (L, D_MODEL), 0.05),
        "w_in": n(ks[3], (L, D_MODEL, IN_COLS), D_MODEL ** -0.5),
        "rel_bias": n(ks[4], (REL_BUCKETS, A_HEADS), 0.5),
        "mu_shift": jax.random.uniform(ks[5], (L, RW_COLS), jnp.float32, 0.0, 1.0),
        "w0": jax.random.uniform(ks[6], (L, B_WIDTH), jnp.float32, -4.0, 1.0),
        "w_up": n(ks[7], (L, DECAY_RANK, B_WIDTH), 0.5 * DECAY_RANK ** -0.5),
        "a0": n(ks[8], (L, B_WIDTH), 0.5),
        "a_up": n(ks[9], (L, ICLR_RANK, B_WIDTH), 0.5 * ICLR_RANK ** -0.5),
        "k_k": 0.85 + n(ks[10], (L, B_WIDTH), 0.05),
        "k_a": 1.0 + n(ks[11], (L, B_WIDTH), 0.05),
        "r_k": n(ks[12], (L, B_HEADS, B_HEAD_DIM), 0.1),
        "ln_x_w": 1.0 + n(ks[13], (L, B_WIDTH), 0.05),
        "ln_x_b": n(ks[14], (L, B_WIDTH), 0.02),
        "p_a": n(ks[15], (L, A_WIDTH, D_MODEL), A_WIDTH ** -0.5),
        "p_b": n(ks[16], (L, B_WIDTH, D_MODEL), B_WIDTH ** -0.5),
        "w_out": n(ks[17], (L, D_MODEL, D_MODEL), D_MODEL ** -0.5),
        "g_post": 1.0 + n(ks[18], (L, D_MODEL), 0.05),
        "w_ple_up": n(ks[19], (L, PLE_DIM, D_MODEL), PLE_DIM ** -0.5),
        "w_ple_gate": n(ks[20], (L, D_MODEL, D_MODEL), D_MODEL ** -0.5),
    }


def reference(x, p, g_pre, w_in, rel_bias, mu_shift, w0, w_up, a0, a_up, k_k, k_a, r_k,
              ln_x_w, ln_x_b, p_a, p_b, w_out, g_post, w_ple_up, w_ple_gate):
    bsz, seq, _ = x.shape
    h = x.astype(jnp.float32)
    for i in range(DEPTH):
        u = _rms_norm(h, g_pre[i]).astype(w_in.dtype)
        cols = u @ w_in[i]
        a_cols = cols[..., :A_COLS]
        b_cols = cols[..., A_COLS:A_COLS + RW_COLS]
        gate_a = cols[..., A_COLS + RW_COLS:A_COLS + RW_COLS + D_MODEL].astype(jnp.float32)
        gate_b = cols[..., A_COLS + RW_COLS + D_MODEL:].astype(jnp.float32)
        qa, ka, va, za = (a_cols[..., j * A_WIDTH:(j + 1) * A_WIDTH].reshape(bsz, seq, A_HEADS, A_HEAD_DIM)
                          for j in range(4))
        y_a = _moba_attention(qa, ka, va, rel_bias) * jax.nn.silu(za.reshape(bsz, seq, A_WIDTH).astype(jnp.float32))
        y_b, z_b = _rwkv7_time_mix(b_cols, mu_shift[i], w0[i], w_up[i], a0[i], a_up[i], k_k[i], k_a[i],
                                   r_k[i], ln_x_w[i], ln_x_b[i])
        y_b = y_b * jax.nn.silu(z_b)
        merged = (jax.nn.sigmoid(gate_a) * (y_a.astype(p_a.dtype) @ p_a[i])
                  + jax.nn.sigmoid(gate_b) * (y_b.astype(p_b.dtype) @ p_b[i]))
        y = merged.astype(w_out.dtype) @ w_out[i]
        h = h + _rms_norm(y, g_post[i])
        e = p[i] @ w_ple_up[i]
        h = h + jax.nn.sigmoid((h.astype(w_ple_gate.dtype) @ w_ple_gate[i]).astype(jnp.float32)) * e
    return h.astype(x.dtype)
```

```cpp
#include <hip/hip_runtime.h>
#include <hip/hip_cooperative_groups.h>
#include <cstdio>
#include <cstdint>
#include <cmath>
namespace cg = cooperative_groups;
namespace pg8 {
#define PG8_LAS __attribute__((address_space(3)))
typedef unsigned short bf16_t;
typedef short bf16x8 __attribute__((ext_vector_type(8)));
typedef float f32x4 __attribute__((ext_vector_type(4)));
typedef float f32x2 __attribute__((ext_vector_type(2)));
typedef unsigned u32x4 __attribute__((ext_vector_type(4)));
typedef unsigned u32x2 __attribute__((ext_vector_type(2)));
constexpr int BM = 256, BK = 64, HALF = 128, HTB = HALF * BK * 2  , STAGE_BYTES = 8 * HTB, NXCD = 8, WGM = 8;

__host__ __device__ __forceinline__ int lds_byte(int r, int c) { const int st = (r >> 4) * 2 + (c >> 5), rr = r & 15, cc = c & 31, ob = rr * 64 + cc * 2; return st * 1024 + (ob ^ (((ob >> 9) & 1) << 5)); }
__host__ __device__ __forceinline__ void stage_rc(int b, int& R, int& C) { const int st = b / 1024, sb = b % 1024, swz = sb ^ (((sb >> 9) & 1) << 5); R = (st >> 1) * 16 + swz / 64; C = (st & 1) * 32 + (swz % 64) / 2; }
__host__ __device__ __forceinline__ int perm32(int rho) { const int n = rho >> 4, i = rho & 15; return 8 * (i >> 2) + 4 * n + (i & 3); }

struct Unit { int pm, pn; };
struct Gemm { const bf16_t* A; const bf16_t* Bt; int M, N, K, lda, ldb, bdiv; size_t bstride; };

struct StaticOrder {
    int nM, nN, nwg, G, c;
    __host__ __device__ void init(int M, int N, int G_, int c_) { nM = M / BM; nN = N / BM; nwg = nM * nN; G = G_; c = c_; }
    __host__ __device__ bool next(int i, Unit& u) const {
        const long L = (long)i * G + c; if (L >= nwg) return false;
        int wgid = (int)L; { const int q = nwg / NXCD, r = nwg % NXCD, xcd = wgid % NXCD, off = wgid / NXCD; wgid = (xcd < r ? xcd * (q + 1) : r * (q + 1) + (xcd - r) * q) + off; }
        const int nig = WGM * nN, gid = wgid / nig, fm = gid * WGM, gsz = (nM - fm) < WGM ? (nM - fm) : WGM;
        u.pm = fm + ((wgid % nig) % gsz); u.pn = (wgid % nig) / gsz; return true;
    }
};

__device__ __forceinline__ unsigned cvt_pk_bf16(float lo, float hi) { unsigned r; asm volatile("v_cvt_pk_bf16_f32 %0, %1, %2" : "=v"(r) : "v"(lo), "v"(hi)); return r; }
__device__ __forceinline__ float bf_lo(unsigned w) { return __uint_as_float(w << 16); }
__device__ __forceinline__ float bf_hi(unsigned w) { return __uint_as_float(w & 0xffff0000u); }

template <class Epi, class Sched, bool ALIGN_EPI = false, bool SP2 = false>
__device__ __forceinline__ void gemm_phase(PG8_LAS unsigned char* lds, const Gemm g, const Sched& S, const Epi& E) {
    const int tid = threadIdx.x, wid = __builtin_amdgcn_readfirstlane(tid >> 6), lane = tid & 63, wr = wid >> 2, wc = wid & 3, fr = lane & 15, fq = lane >> 4;
    const int K = g.K, nt = K / BK;
    unsigned voffA[2], voffB[2];
#pragma unroll
    for (int i = 0; i < 2; ++i) { int R, C; stage_rc(tid * 16 + i * 8192, R, C); const int Rb = Epi::PERM ? ((R & ~31) + perm32(R & 31)) : R;
        voffA[i] = (unsigned)(R * g.lda + C) * 2u; voffB[i] = (unsigned)(Rb * g.ldb + C) * 2u; }
    const size_t kstep = (size_t)(BK * 2);
    const size_t hstepA = (size_t)HALF * g.lda * 2, hstepB = (size_t)HALF * g.ldb * 2;
    const size_t tstepA = 2 * hstepA, tstepB = 2 * hstepB;
    const unsigned ldsw = (unsigned)wid * 1024u;
    const int aoff = lds_byte(wr * 64 + fr, fq * 8), boff = lds_byte(wc * 32 + fr, fq * 8);
#define PG8_SA(b, h) (((b) * 2 + (h)) * HTB)
#define PG8_SB(b, h) ((4 + (b) * 2 + (h)) * HTB)
#define PG8_STAGE(bufoff, gbase, voff) do { _Pragma("unroll") for (int _i = 0; _i < 2; ++_i) \
        __builtin_amdgcn_global_load_lds((const unsigned*)((const char*)(gbase) + (voff)[_i]), (PG8_LAS unsigned*)(lds + (bufoff) + ldsw + _i * 8192), 16, 0, 0); } while (0)
#define PG8_LDA(dst, b, h) do { _Pragma("unroll") for (int m = 0; m < 4; ++m) _Pragma("unroll") for (int k = 0; k < 2; ++k) dst[m][k] = *(const PG8_LAS bf16x8*)(lds + PG8_SA(b, h) + aoff + m * 2048 + k * 1024); } while (0)
#define PG8_LDB(dst, b, h) do { _Pragma("unroll") for (int n = 0; n < 2; ++n) _Pragma("unroll") for (int k = 0; k < 2; ++k) dst[n][k] = *(const PG8_LAS bf16x8*)(lds + PG8_SB(b, h) + boff + n * 2048 + k * 1024); } while (0)
#define PG8_MMA(ai, bj, At, Bt) do { __builtin_amdgcn_s_setprio(1); _Pragma("unroll") for (int m = 0; m < 4; ++m) _Pragma("unroll") for (int n = 0; n < 2; ++n) _Pragma("unroll") for (int k = 0; k < 2; ++k) \
        acc[ai][bj][m][n] = __builtin_amdgcn_mfma_f32_16x16x32_bf16(Bt[n][k], At[m][k], acc[ai][bj][m][n], 0, 0, 0); __builtin_amdgcn_s_setprio(0); } while (0)
#define PG8_WAIT_V(n) asm volatile("s_waitcnt vmcnt(" #n ")" ::: "memory")
#define PG8_WAIT_L(n) asm volatile("s_waitcnt lgkmcnt(" #n ")" ::: "memory")
#define PG8_BAR __builtin_amdgcn_s_barrier()
#define PG8_SCHED __builtin_amdgcn_sched_barrier(0)
#define PG8_BBASE(u) ((const char*)g.Bt + (size_t)(u).pn * tstepB + (g.bdiv ? (size_t)((u).pm / g.bdiv) * g.bstride * 2 : (size_t)0))
    Unit cur, nxt; int ui = 0;
    if (!S.next(0, cur)) return;
    f32x4 acc[2][2][4][2];
#pragma unroll
    for (int a = 0; a < 2; ++a)
#pragma unroll
        for (int b = 0; b < 2; ++b)
#pragma unroll
            for (int m = 0; m < 4; ++m)
#pragma unroll
                for (int n = 0; n < 2; ++n) acc[a][b][m][n] = (f32x4){0.f, 0.f, 0.f, 0.f};
    bf16x8 At[4][2], B0[2][2], B1[2][2];
    const char* cA = (const char*)g.A + (size_t)cur.pm * tstepA; const char* cB = PG8_BBASE(cur);
    if constexpr (SP2) {
        PG8_STAGE(PG8_SB(0, 0), cB, voffB); PG8_STAGE(PG8_SB(0, 1), cB + hstepB, voffB); PG8_STAGE(PG8_SA(0, 0), cA, voffA); PG8_STAGE(PG8_SA(0, 1), cA + hstepA, voffA);
        if (wr == 1) PG8_BAR;
        PG8_WAIT_V(2); PG8_BAR;
        PG8_STAGE(PG8_SB(1, 0), cB + kstep, voffB); PG8_STAGE(PG8_SA(1, 0), cA + kstep, voffA); PG8_STAGE(PG8_SB(1, 1), cB + hstepB + kstep, voffB);
        PG8_WAIT_V(6); PG8_BAR;
    } else {
        PG8_STAGE(PG8_SB(0, 0), cB, voffB); PG8_STAGE(PG8_SA(0, 0), cA, voffA); PG8_STAGE(PG8_SB(0, 1), cB + hstepB, voffB); PG8_STAGE(PG8_SA(0, 1), cA + hstepA, voffA);
        if (wr == 1) PG8_BAR;
        PG8_WAIT_V(4); PG8_BAR;
        PG8_STAGE(PG8_SB(1, 0), cB + kstep, voffB); PG8_STAGE(PG8_SA(1, 0), cA + kstep, voffA); PG8_STAGE(PG8_SB(1, 1), cB + hstepB + kstep, voffB);
        PG8_WAIT_V(6); PG8_BAR;
    }
    for (;;) {
        const bool has_next = S.next(ui + 1, nxt);
        const char* nA = has_next ? (const char*)g.A + (size_t)nxt.pm * tstepA : cA; const char* nB = has_next ? PG8_BBASE(nxt) : cB;
        for (int t = 0; t < nt; t += 2) {
            const bool last = (t == nt - 2);
            const char* a1 = cA + (size_t)(t + 1) * kstep;
            const char* a2 = last ? nA : cA + (size_t)(t + 2) * kstep; const char* b2 = last ? nB : cB + (size_t)(t + 2) * kstep;
            const char* a3 = a2 + kstep; const char* b3 = b2 + kstep;
            if constexpr (SP2) {
            PG8_LDB(B0, 0, 0); PG8_LDB(B1, 0, 1); PG8_SCHED; PG8_LDA(At, 0, 0); PG8_STAGE(PG8_SA(1, 1), a1 + hstepA, voffA);
            PG8_WAIT_V(8); PG8_WAIT_L(0); PG8_BAR; PG8_MMA(0, 0, At, B0); PG8_MMA(0, 1, At, B1); PG8_BAR; PG8_SCHED;
            PG8_LDA(At, 0, 1); PG8_STAGE(PG8_SB(0, 0), b2, voffB); PG8_STAGE(PG8_SB(0, 1), b2 + hstepB, voffB); PG8_STAGE(PG8_SA(0, 0), a2, voffA);
            PG8_WAIT_V(8); PG8_WAIT_L(0); PG8_BAR; PG8_MMA(1, 0, At, B0); PG8_MMA(1, 1, At, B1); PG8_BAR; PG8_SCHED;
            PG8_LDB(B0, 1, 0); PG8_LDB(B1, 1, 1); PG8_SCHED; PG8_LDA(At, 1, 0); PG8_STAGE(PG8_SA(0, 1), a2 + hstepA, voffA);
            PG8_WAIT_V(8); PG8_WAIT_L(0); PG8_BAR; PG8_MMA(0, 0, At, B0); PG8_MMA(0, 1, At, B1); PG8_BAR; PG8_SCHED;
            PG8_LDA(At, 1, 1); PG8_STAGE(PG8_SB(1, 0), b3, voffB); PG8_STAGE(PG8_SB(1, 1), b3 + hstepB, voffB); PG8_STAGE(PG8_SA(1, 0), a3, voffA);
            PG8_WAIT_V(8); PG8_WAIT_L(0); PG8_BAR; PG8_MMA(1, 0, At, B0); PG8_MMA(1, 1, At, B1); PG8_BAR; PG8_SCHED;
            } else {
            PG8_LDB(B0, 0, 0); PG8_SCHED; PG8_LDA(At, 0, 0); PG8_STAGE(PG8_SA(1, 1), a1 + hstepA, voffA);
            PG8_WAIT_L(8); PG8_BAR; PG8_WAIT_L(0); PG8_MMA(0, 0, At, B0); PG8_BAR; PG8_SCHED;
            PG8_LDB(B1, 0, 1); PG8_STAGE(PG8_SB(0, 0), b2, voffB);
            PG8_BAR; PG8_WAIT_L(0); PG8_MMA(0, 1, At, B1); PG8_BAR;
            PG8_LDA(At, 0, 1); PG8_STAGE(PG8_SA(0, 0), a2, voffA);
            PG8_BAR; PG8_WAIT_L(0); PG8_MMA(1, 0, At, B0); PG8_BAR; PG8_SCHED;
            PG8_STAGE(PG8_SB(0, 1), b2 + hstepB, voffB);
            PG8_WAIT_V(6); PG8_BAR; PG8_MMA(1, 1, At, B1); PG8_BAR;
            PG8_LDB(B0, 1, 0); PG8_SCHED; PG8_LDA(At, 1, 0); PG8_STAGE(PG8_SA(0, 1), a2 + hstepA, voffA);
            PG8_WAIT_L(8); PG8_BAR; PG8_WAIT_L(0); PG8_MMA(0, 0, At, B0); PG8_BAR; PG8_SCHED;
            PG8_LDB(B1, 1, 1); PG8_STAGE(PG8_SB(1, 0), b3, voffB);
            PG8_BAR; PG8_WAIT_L(0); PG8_MMA(0, 1, At, B1); PG8_BAR;
            PG8_LDA(At, 1, 1); PG8_STAGE(PG8_SA(1, 0), a3, voffA);
            PG8_BAR; PG8_WAIT_L(0); PG8_MMA(1, 0, At, B0); PG8_BAR; PG8_SCHED;
            PG8_STAGE(PG8_SB(1, 1), b3 + hstepB, voffB);
            PG8_WAIT_V(6); PG8_BAR; PG8_MMA(1, 1, At, B1); PG8_BAR;
            }
        }
        if constexpr (ALIGN_EPI) { if (wr == 0) PG8_BAR; }
        E(acc, cur, wr, wc, fr, fq);
        if (!has_next) break;
#pragma unroll
        for (int a = 0; a < 2; ++a)
#pragma unroll
            for (int b = 0; b < 2; ++b)
#pragma unroll
                for (int m = 0; m < 4; ++m)
#pragma unroll
                    for (int n = 0; n < 2; ++n) acc[a][b][m][n] = (f32x4){0.f, 0.f, 0.f, 0.f};
        cur = nxt; cA = nA; cB = nB; ++ui;
        if constexpr (ALIGN_EPI) { if (wr == 1) PG8_BAR; }
    }
    PG8_WAIT_V(0);
    if constexpr (!ALIGN_EPI) { if (wr == 0) PG8_BAR; }
    PG8_BAR;
#undef PG8_SA
#undef PG8_SB
#undef PG8_STAGE
#undef PG8_LDA
#undef PG8_LDB
#undef PG8_MMA
#undef PG8_WAIT_V
#undef PG8_WAIT_L
#undef PG8_BAR
#undef PG8_SCHED
#undef PG8_BBASE
}
}
namespace pg8 {
__device__ __forceinline__ float sigmoidf_(float x) { return 1.0f / (1.0f + __expf(-x)); }

struct EpiCols {
    static constexpr bool PERM = true;
    bf16_t* qkvz; bf16_t* rw; bf16_t* gab; float qscale;
    __device__ __forceinline__ void operator()(const f32x4 (&acc)[2][2][4][2], const Unit& u, int wr, int wc, int fr, int fq) const {
        const int pn = u.pn; bf16_t* base; int pitch, coff, nbj = 2; float sc = 1.f;
        if (pn < 8) { base = qkvz; pitch = 2048; coff = pn * 256; if (pn < 2) sc = qscale; }
        else if (pn < 16) { base = rw; pitch = 2176; coff = (pn - 8) * 256; }
        else if (pn < 24) { base = gab; pitch = 2048; coff = (pn - 16) * 256; }
        else { base = rw; pitch = 2176; coff = 2048; nbj = 1; }
        const int row0 = u.pm * BM + wr * 64 + fr; const int col0 = coff + wc * 32 + 8 * fq;
#pragma unroll
        for (int ai = 0; ai < 2; ++ai)
#pragma unroll
            for (int m = 0; m < 4; ++m) { bf16_t* rowp = base + (size_t)(row0 + ai * HALF + m * 16) * pitch + col0;
#pragma unroll
                for (int bj = 0; bj < 2; ++bj) { if (bj < nbj) { f32x4 v0 = acc[ai][bj][m][0] * sc, v1 = acc[ai][bj][m][1] * sc;
                    u32x4 w; w.x = cvt_pk_bf16(v0[0], v0[1]); w.y = cvt_pk_bf16(v0[2], v0[3]); w.z = cvt_pk_bf16(v1[0], v1[1]); w.w = cvt_pk_bf16(v1[2], v1[3]);
                    *(u32x4*)(rowp + bj * HALF) = w; } } }
    }
};
struct EpiBf16 {
    static constexpr bool PERM = true;
    bf16_t* O; int ldc;
    __device__ __forceinline__ void operator()(const f32x4 (&acc)[2][2][4][2], const Unit& u, int wr, int wc, int fr, int fq) const {
        const int row0 = u.pm * BM + wr * 64 + fr; const int col0 = u.pn * BM + wc * 32 + 8 * fq;
#pragma unroll
        for (int ai = 0; ai < 2; ++ai)
#pragma unroll
            for (int m = 0; m < 4; ++m) { bf16_t* rowp = O + (size_t)(row0 + ai * HALF + m * 16) * ldc + col0;
#pragma unroll
                for (int bj = 0; bj < 2; ++bj) { const f32x4 v0 = acc[ai][bj][m][0], v1 = acc[ai][bj][m][1];
                    u32x4 w; w.x = cvt_pk_bf16(v0[0], v0[1]); w.y = cvt_pk_bf16(v0[2], v0[3]); w.z = cvt_pk_bf16(v1[0], v1[1]); w.w = cvt_pk_bf16(v1[2], v1[3]);
                    *(u32x4*)(rowp + bj * HALF) = w; } }
    }
};
struct EpiF32 {
    static constexpr bool PERM = false;
    float* O; int ldc;
    __device__ __forceinline__ void operator()(const f32x4 (&acc)[2][2][4][2], const Unit& u, int wr, int wc, int fr, int fq) const {
        const int row0 = u.pm * BM + wr * 64 + fr; const int col0 = u.pn * BM + wc * 32 + 4 * fq;
#pragma unroll
        for (int ai = 0; ai < 2; ++ai)
#pragma unroll
            for (int m = 0; m < 4; ++m) { float* rowp = O + (size_t)(row0 + ai * HALF + m * 16) * ldc + col0;
#pragma unroll
                for (int bj = 0; bj < 2; ++bj)
#pragma unroll
                    for (int n = 0; n < 2; ++n) *(f32x4*)(rowp + bj * HALF + n * 16) = acc[ai][bj][m][n]; }
    }
};
template <bool ADD> struct EpiMerge {
    static constexpr bool PERM = true;
    bf16_t* O; int ldc; const bf16_t* G; int ldg;
    __device__ __forceinline__ void operator()(const f32x4 (&acc)[2][2][4][2], const Unit& u, int wr, int wc, int fr, int fq) const {
        const int row0 = u.pm * BM + wr * 64 + fr; const int col0 = u.pn * BM + wc * 32 + 8 * fq;
#pragma unroll
        for (int ai = 0; ai < 2; ++ai)
#pragma unroll
            for (int m = 0; m < 4; ++m) { const size_t r = (size_t)(row0 + ai * HALF + m * 16);
#pragma unroll
                for (int bj = 0; bj < 2; ++bj) { const f32x4 v0 = acc[ai][bj][m][0], v1 = acc[ai][bj][m][1];
                    const u32x4 gw = *(const u32x4*)(G + r * ldg + col0 + bj * HALF);
                    float o[8];
                    o[0] = sigmoidf_(bf_lo(gw.x)) * v0[0]; o[1] = sigmoidf_(bf_hi(gw.x)) * v0[1]; o[2] = sigmoidf_(bf_lo(gw.y)) * v0[2]; o[3] = sigmoidf_(bf_hi(gw.y)) * v0[3];
                    o[4] = sigmoidf_(bf_lo(gw.z)) * v1[0]; o[5] = sigmoidf_(bf_hi(gw.z)) * v1[1]; o[6] = sigmoidf_(bf_lo(gw.w)) * v1[2]; o[7] = sigmoidf_(bf_hi(gw.w)) * v1[3];
                    bf16_t* op = O + r * ldc + col0 + bj * HALF;
                    if (ADD) { const u32x4 pw = *(const u32x4*)op;
                        o[0] += bf_lo(pw.x); o[1] += bf_hi(pw.x); o[2] += bf_lo(pw.y); o[3] += bf_hi(pw.y); o[4] += bf_lo(pw.z); o[5] += bf_hi(pw.z); o[6] += bf_lo(pw.w); o[7] += bf_hi(pw.w); }
                    u32x4 w; w.x = cvt_pk_bf16(o[0], o[1]); w.y = cvt_pk_bf16(o[2], o[3]); w.z = cvt_pk_bf16(o[4], o[5]); w.w = cvt_pk_bf16(o[6], o[7]);
                    *(u32x4*)op = w; } }
    }
};
struct EpiFinal {
    static constexpr bool PERM = false;
    float* out; const float* x; const float* y; const float* rsy; const float* gpost; const bf16_t* E; int ldc;
    __device__ __forceinline__ void operator()(const f32x4 (&acc)[2][2][4][2], const Unit& u, int wr, int wc, int fr, int fq) const {
        const int row0 = u.pm * BM + wr * 64 + fr; const int col0 = u.pn * BM + wc * 32 + 4 * fq;
#pragma unroll
        for (int ai = 0; ai < 2; ++ai)
#pragma unroll
            for (int m = 0; m < 4; ++m) { const size_t r = (size_t)(row0 + ai * HALF + m * 16); const float rs = rsy[r];
#pragma unroll
                for (int bj = 0; bj < 2; ++bj)
#pragma unroll
                    for (int n = 0; n < 2; ++n) { const int c = col0 + bj * HALF + n * 16; const size_t off = r * ldc + c;
                        const f32x4 xv = *(const f32x4*)(x + off), yv = *(const f32x4*)(y + off), gp = *(const f32x4*)(gpost + c); const u32x2 ew = *(const u32x2*)(E + off);
                        const f32x4 a = acc[ai][bj][m][n]; f32x4 o;
                        o[0] = xv[0] + yv[0] * rs * gp[0] + sigmoidf_(a[0]) * bf_lo(ew.x);
                        o[1] = xv[1] + yv[1] * rs * gp[1] + sigmoidf_(a[1]) * bf_hi(ew.x);
                        o[2] = xv[2] + yv[2] * rs * gp[2] + sigmoidf_(a[2]) * bf_lo(ew.y);
                        o[3] = xv[3] + yv[3] * rs * gp[3] + sigmoidf_(a[3]) * bf_hi(ew.y);
                        *(f32x4*)(out + off) = o; } }
    }
};
}
#define GAS __attribute__((address_space(1)))
#define LAS __attribute__((address_space(3)))
typedef unsigned short bf16;
typedef unsigned v4u __attribute__((ext_vector_type(4)));
typedef unsigned v2u __attribute__((ext_vector_type(2)));
typedef float f32x4 __attribute__((ext_vector_type(4)));

constexpr int NWAVES = 8, NTHR = 512;
constexpr int BATCH = 16, SEQ = 4096, DM = 1024, M = BATCH * SEQ;
constexpr int NH = 8, HD = 64, AW = 512, PLE = 256;
constexpr int RWC = 2176, INC = 6272, INCP = 6400;
constexpr int NBLK = 16, BLK = 256;
constexpr float RMS_EPS = 1e-6f, GN_EPS = 64e-5f;
constexpr float LOG2E = 1.4426950408889634f;
constexpr float QSCALE = 0.125f * LOG2E;

constexpr size_t MiB = 1u << 20;
constexpr size_t WS_WIN = 2 * MiB;
constexpr size_t WS_WG = 16 * MiB;
constexpr size_t WS_PAB = 32 * MiB;
constexpr size_t WS_WOUT = 34 * MiB;
constexpr size_t WS_WPG = 36 * MiB;
constexpr size_t WS_WPU = 38 * MiB;
constexpr size_t WS_RSY = 39 * MiB;
constexpr size_t WS_PB = 42 * MiB;
constexpr size_t WS_GATE = 74 * MiB;
constexpr size_t WS_QKVZ = 138 * MiB;
constexpr size_t WS_RW = 394 * MiB;
constexpr size_t WS_GAB = 666 * MiB;
constexpr size_t WS_END = 922 * MiB;

__device__ const unsigned char T5B[128] = {0, 1, 2, 3, 4, 5, 6, 7, 8, 9, 10, 11, 12, 13, 14, 15, 16, 16, 16, 17, 17, 18, 18, 18, 19, 19, 19, 20, 20, 20, 20, 21, 21, 21, 21, 22, 22, 22, 22, 22, 23, 23, 23, 23, 23, 23, 24, 24, 24, 24, 24, 24, 25, 25, 25, 25, 25, 25, 25, 26, 26, 26, 26, 26, 26, 26, 26, 27, 27, 27, 27, 27, 27, 27, 27, 27, 27, 28, 28, 28, 28, 28, 28, 28, 28, 28, 28, 29, 29, 29, 29, 29, 29, 29, 29, 29, 29, 29, 29, 30, 30, 30, 30, 30, 30, 30, 30, 30, 30, 30, 30, 30, 30, 31, 31, 31, 31, 31, 31, 31, 31, 31, 31, 31, 31, 31, 31, 31};

__device__ __forceinline__ unsigned f2bf(float f) { unsigned u = __builtin_bit_cast(unsigned, f); return (u + 0x7fffu + ((u >> 16) & 1u)) >> 16; }
__device__ __forceinline__ unsigned pk2(float lo, float hi) { return f2bf(lo) | (f2bf(hi) << 16); }
__device__ __forceinline__ float bf2f(unsigned short h) { return __uint_as_float((unsigned)h << 16); }
__device__ __forceinline__ float wave_sum(float v) {
#pragma unroll
    for (int o = 1; o < 64; o <<= 1) v += __shfl_xor(v, o);
    return v;
}
__device__ __forceinline__ float sigm(float x) { return 1.0f / (1.0f + __expf(-x)); }

struct Args {
    const float* in[21]; float* out; unsigned char* ws; int ph_lo, ph_hi;
};
struct Frame {
    LAS unsigned char* lds; int tid, lane, wave, vcu, G;
    const float *x, *p, *g_pre, *w_in, *rel_bias, *mu, *w0, *w_up, *a0, *a_up, *k_k, *k_a, *r_k, *ln_w, *ln_b, *p_a, *p_b, *w_out, *g_post, *w_pu, *w_pg;
    float* out; unsigned char* ws;
};

__device__ __forceinline__ void transpose_item(const float* W, int N, int k0, int n0, bf16* WT, int ldw, int drow0, int koff, LAS float* scr, int lane) {
#pragma unroll 8
    for (int i = 0; i < 32; ++i) { const int kk = 2 * i + (lane >> 5); scr[kk * 33 + (lane & 31)] = W[(size_t)(k0 + kk) * N + n0 + (lane & 31)]; }
    asm volatile("s_waitcnt lgkmcnt(0)" ::: "memory");
    const int c = lane & 7;
#pragma unroll
    for (int j = 0; j < 4; ++j) { const int n = (lane >> 3) + 8 * j; const LAS float* s = scr + (8 * c) * 33 + n;
        v4u o; o.x = pk2(s[0 * 33], s[1 * 33]); o.y = pk2(s[2 * 33], s[3 * 33]); o.z = pk2(s[4 * 33], s[5 * 33]); o.w = pk2(s[6 * 33], s[7 * 33]);
        *(v4u*)(WT + (size_t)(drow0 + n) * ldw + koff + k0 + 8 * c) = o; }
    asm volatile("s_waitcnt lgkmcnt(0)" ::: "memory");
}

__device__ __forceinline__ void p0_prologue(Frame& F) {
    LAS float* scr = (LAS float*)(F.lds + F.wave * 16384);
    const int gw = F.vcu * NWAVES + F.wave, NGW = F.G * NWAVES;
    bf16* WinT = (bf16*)(F.ws + WS_WIN); bf16* PabT = (bf16*)(F.ws + WS_PAB); bf16* WoutT = (bf16*)(F.ws + WS_WOUT); bf16* WpgT = (bf16*)(F.ws + WS_WPG); bf16* WpuT = (bf16*)(F.ws + WS_WPU);
    constexpr int I_IN = 16 * (INC / 32), I_PA = 8 * 32, I_PB = 8 * 32, I_WO = 16 * 32, I_PG = 16 * 32, I_PU = 4 * 32;
    constexpr int NIT = I_IN + I_PA + I_PB + I_WO + I_PG + I_PU;
    for (int it = gw; it < NIT; it += NGW) {
        int r = it;
        if (r < I_IN) { const int nb = r % (INC / 32), kb = r / (INC / 32), n0 = nb * 32;
            const int d0 = n0 < 4096 ? n0 : (n0 < 4224 ? n0 + 2048 : n0 - 128);
            transpose_item(F.w_in, INC, kb * 64, n0, WinT, DM, d0, 0, scr, F.lane); continue; } r -= I_IN;
        if (r < I_PA) { transpose_item(F.p_a, DM, (r / 32) * 64, (r % 32) * 32, PabT, 1024, (r % 32) * 32, 0, scr, F.lane); continue; } r -= I_PA;
        if (r < I_PB) { transpose_item(F.p_b, DM, (r / 32) * 64, (r % 32) * 32, PabT, 1024, (r % 32) * 32, 512, scr, F.lane); continue; } r -= I_PB;
        if (r < I_WO) { transpose_item(F.w_out, DM, (r / 32) * 64, (r % 32) * 32, WoutT, 1024, (r % 32) * 32, 0, scr, F.lane); continue; } r -= I_WO;
        if (r < I_PG) { transpose_item(F.w_pg, DM, (r / 32) * 64, (r % 32) * 32, WpgT, 1024, (r % 32) * 32, 0, scr, F.lane); continue; } r -= I_PG;
        transpose_item(F.w_pu, DM, (r / 32) * 64, (r % 32) * 32, WpuT, 256, (r % 32) * 32, 0, scr, F.lane);
    }
    for (int i = gw * 64 + F.lane; i < 128 * 1024 / 8; i += NGW * 64) *(v4u*)(WinT + (size_t)INC * DM + (size_t)i * 8) = (v4u){0u, 0u, 0u, 0u};
    { bf16* PB = (bf16*)(F.ws + WS_PB); const size_t n8 = (size_t)M * PLE / 8;
      for (size_t i = (size_t)F.vcu * NTHR + F.tid; i < n8; i += (size_t)F.G * NTHR) { const f32x4 a = *(const f32x4*)(F.p + i * 8), b = *(const f32x4*)(F.p + i * 8 + 4);
          v4u o; o.x = pk2(a[0], a[1]); o.y = pk2(a[2], a[3]); o.z = pk2(b[0], b[1]); o.w = pk2(b[2], b[3]); *(v4u*)(PB + i * 8) = o; } }
    __syncthreads();
    LAS float* red = (LAS float*)F.lds;
    LAS float* ubar = (LAS float*)(F.lds + 32768);
    LAS float* kmean = (LAS float*)(F.lds + 36864);
    bf16* U2 = (bf16*)F.out; bf16* WgT = (bf16*)(F.ws + WS_WG);
    for (int blk = F.vcu; blk < M / BLK; blk += F.G) {
        float cs[16];
#pragma unroll
        for (int i = 0; i < 16; ++i) cs[i] = 0.f;
        f32x4 gv[4];
#pragma unroll
        for (int j = 0; j < 4; ++j) gv[j] = *((const f32x4*)F.g_pre + F.lane + 64 * j);
        for (int i = 0; i < 32; ++i) {
            const size_t row = (size_t)blk * BLK + F.wave + 8 * i;
            const f32x4* xr = (const f32x4*)(F.x + row * DM) + F.lane;
            f32x4 v[4]; float s = 0.f;
#pragma unroll
            for (int j = 0; j < 4; ++j) { v[j] = xr[64 * j]; s += (v[j][0] * v[j][0] + v[j][1] * v[j][1]) + (v[j][2] * v[j][2] + v[j][3] * v[j][3]); }
            const float rs = 1.0f / sqrtf(wave_sum(s) * (1.f / DM) + RMS_EPS);
#pragma unroll
            for (int j = 0; j < 4; ++j) {
                float u[4]; unsigned h[4], l[4];
#pragma unroll
                for (int e = 0; e < 4; ++e) { u[e] = v[j][e] * rs * gv[j][e]; cs[j * 4 + e] += u[e]; h[e] = f2bf(u[e]); l[e] = f2bf(u[e] - __uint_as_float(h[e] << 16)); }
                const int col = 4 * F.lane + 256 * j;
                *(v2u*)(U2 + row * 2048 + col) = (v2u){h[0] | (h[1] << 16), h[2] | (h[3] << 16)};
                *(v2u*)(U2 + row * 2048 + 1024 + col) = (v2u){l[0] | (l[1] << 16), l[2] | (l[3] << 16)};
            }
        }
#pragma unroll
        for (int j = 0; j < 4; ++j)
#pragma unroll
            for (int e = 0; e < 4; ++e) red[F.wave * 1024 + 4 * F.lane + 256 * j + e] = cs[j * 4 + e];
        __syncthreads();
        for (int k = F.tid; k < 1024; k += NTHR) { float s = 0.f;
#pragma unroll
            for (int w = 0; w < 8; ++w) s += red[w * 1024 + k];
            ubar[k] = s * (1.f / BLK); }
        __syncthreads();
        { float s = 0.f; const float* wk = F.w_in + 512 + F.tid;
          for (int k = 0; k < 1024; ++k) s += ubar[k] * wk[(size_t)k * INC];
          kmean[F.tid] = s; }
        __syncthreads();
        { const int b = blk / NBLK, n = blk % NBLK;
          for (int k = F.tid; k < 1024; k += NTHR) { const float* wq = F.w_in + (size_t)k * INC;
              for (int h = 0; h < NH; ++h) { float s = 0.f;
                  for (int d = 0; d < HD; d += 4) { const f32x4 w4 = *(const f32x4*)(wq + h * HD + d); s += w4[0] * kmean[h * HD + d] + w4[1] * kmean[h * HD + d + 1] + w4[2] * kmean[h * HD + d + 2] + w4[3] * kmean[h * HD + d + 3]; }
                  const unsigned hi = f2bf(s), lo = f2bf(s - __uint_as_float(hi << 16));
                  bf16* r0 = WgT + ((size_t)b * 256 + h * 16 + n) * 2048; bf16* r1 = WgT + ((size_t)b * 256 + 128 + h * 16 + n) * 2048;
                  r0[k] = (bf16)hi; r0[1024 + k] = (bf16)hi; r1[k] = (bf16)lo; r1[1024 + k] = (bf16)lo; } } }
        __syncthreads();
    }
}

__device__ __forceinline__ void attn_simple(Frame& F) {
    bf16* QKVZ = (bf16*)(F.ws + WS_QKVZ); const float* GATE = (const float*)(F.ws + WS_GATE);
    LAS float* btab = (LAS float*)F.lds;
    for (int i = F.tid; i < NH * 128; i += NTHR) { const int h = i >> 7, d = i & 127; btab[i] = F.rel_bias[T5B[d] * NH + h] * LOG2E; }
    __syncthreads();
    for (int u = F.vcu; u < BATCH * NH * 8; u += F.G) {
        const int b = u >> 6, h = (u >> 3) & 7, sg = u & 7;
        const int s = sg * 512 + F.tid, qb = s >> 8; const size_t row = (size_t)b * SEQ + s;
        float g0 = -INFINITY, g1 = -INFINITY, g2 = -INFINITY; int i0 = -1, i1 = -1, i2 = -1;
        for (int n = 0; n < qb; ++n) { const float g = GATE[row * 256 + h * 16 + n] + GATE[row * 256 + 128 + h * 16 + n];
            if (g > g0) { g2 = g1; i2 = i1; g1 = g0; i1 = i0; g0 = g; i0 = n; } else if (g > g1) { g2 = g1; i2 = i1; g1 = g; i1 = n; } else if (g > g2) { g2 = g; i2 = n; } }
        float q[64], o[64];
        { const v4u* qp = (const v4u*)(QKVZ + row * 2048 + h * HD);
#pragma unroll
          for (int c = 0; c < 8; ++c) { const v4u w = qp[c];
              q[c * 8 + 0] = __uint_as_float(w.x << 16); q[c * 8 + 1] = __uint_as_float(w.x & 0xffff0000u); q[c * 8 + 2] = __uint_as_float(w.y << 16); q[c * 8 + 3] = __uint_as_float(w.y & 0xffff0000u);
              q[c * 8 + 4] = __uint_as_float(w.z << 16); q[c * 8 + 5] = __uint_as_float(w.z & 0xffff0000u); q[c * 8 + 6] = __uint_as_float(w.w << 16); q[c * 8 + 7] = __uint_as_float(w.w & 0xffff0000u); } }
#pragma unroll
        for (int d = 0; d < 64; ++d) o[d] = 0.f;
        float mx = -INFINITY, l = 0.f;
        for (int pick = 0; pick < 4; ++pick) {
            const int blk = pick == 0 ? qb : (pick == 1 ? i0 : (pick == 2 ? i1 : i2));
            if (blk < 0) continue;
            const int jmax = pick == 0 ? (s & 255) : 255;
            for (int j = 0; j <= jmax; ++j) {
                const int kp = blk * BLK + j; const size_t krow = (size_t)b * SEQ + kp;
                const v4u* kptr = (const v4u*)(QKVZ + krow * 2048 + 512 + h * HD); const v4u* vptr = (const v4u*)(QKVZ + krow * 2048 + 1024 + h * HD);
                float dot = 0.f;
#pragma unroll
                for (int c = 0; c < 8; ++c) { const v4u w = kptr[c];
                    dot += q[c * 8 + 0] * __uint_as_float(w.x << 16) + q[c * 8 + 1] * __uint_as_float(w.x & 0xffff0000u) + q[c * 8 + 2] * __uint_as_float(w.y << 16) + q[c * 8 + 3] * __uint_as_float(w.y & 0xffff0000u)
                         + q[c * 8 + 4] * __uint_as_float(w.z << 16) + q[c * 8 + 5] * __uint_as_float(w.z & 0xffff0000u) + q[c * 8 + 6] * __uint_as_float(w.w << 16) + q[c * 8 + 7] * __uint_as_float(w.w & 0xffff0000u); }
                const int dist = s - kp; const float sc = dot + btab[h * 128 + (dist < 127 ? dist : 127)];
                const float mn = fmaxf(mx, sc), f = exp2f(mx - mn), pw = exp2f(sc - mn);
                l = l * f + pw; mx = mn;
#pragma unroll
                for (int c = 0; c < 8; ++c) { const v4u w = vptr[c];
                    o[c * 8 + 0] = o[c * 8 + 0] * f + pw * __uint_as_float(w.x << 16); o[c * 8 + 1] = o[c * 8 + 1] * f + pw * __uint_as_float(w.x & 0xffff0000u);
                    o[c * 8 + 2] = o[c * 8 + 2] * f + pw * __uint_as_float(w.y << 16); o[c * 8 + 3] = o[c * 8 + 3] * f + pw * __uint_as_float(w.y & 0xffff0000u);
                    o[c * 8 + 4] = o[c * 8 + 4] * f + pw * __uint_as_float(w.z << 16); o[c * 8 + 5] = o[c * 8 + 5] * f + pw * __uint_as_float(w.z & 0xffff0000u);
                    o[c * 8 + 6] = o[c * 8 + 6] * f + pw * __uint_as_float(w.w << 16); o[c * 8 + 7] = o[c * 8 + 7] * f + pw * __uint_as_float(w.w & 0xffff0000u); }
            }
        }
        const float il = 1.0f / l;
        const v4u* zp = (const v4u*)(QKVZ + row * 2048 + 1536 + h * HD); v4u* op = (v4u*)(QKVZ + row * 2048 + h * HD);
#pragma unroll
        for (int c = 0; c < 8; ++c) { const v4u w = zp[c]; float z[8] = {__uint_as_float(w.x << 16), __uint_as_float(w.x & 0xffff0000u), __uint_as_float(w.y << 16), __uint_as_float(w.y & 0xffff0000u),
                                                                     __uint_as_float(w.z << 16), __uint_as_float(w.z & 0xffff0000u), __uint_as_float(w.w << 16), __uint_as_float(w.w & 0xffff0000u)};
            float r[8];
#pragma unroll
            for (int e = 0; e < 8; ++e) r[e] = o[c * 8 + e] * il * z[e] * sigm(z[e]);
            v4u ow; ow.x = pk2(r[0], r[1]); ow.y = pk2(r[2], r[3]); ow.z = pk2(r[4], r[5]); ow.w = pk2(r[6], r[7]); op[c] = ow; }
    }
}

__device__ __forceinline__ void rwkv_simple(Frame& F) {
    const bf16* RW = (const bf16*)(F.ws + WS_RW); bf16* QKVZ = (bf16*)(F.ws + WS_QKVZ);
    LAS float* Wd = (LAS float*)F.lds;
    LAS float* Aa = Wd + 4096;
    LAS float* Bb = Aa + 4096;
    LAS float* Kk = Bb + 4096;
    LAS float* Rr = Kk + 4096;
    LAS float* Vv = Rr + 4096;
    LAS float* TW = Vv + 4096;
    LAS float* TA = TW + 4096;
    LAS float* Bon = TA + 4096;
    LAS float* PR = Bon + 64;
    for (int ch = F.vcu; ch < BATCH * NH; ch += F.G) {
        const int b = ch / NH, h = ch % NH;
        __syncthreads();
        for (int i = F.tid; i < 13 * 64; i += NTHR) { const int a = i >> 6, k = i & 63, col = h * HD + k; float v;
            switch (a) { case 0: v = F.mu[col]; break; case 1: v = F.mu[512 + col]; break; case 2: v = F.mu[1024 + col]; break; case 3: v = F.mu[1536 + col]; break;
                         case 4: v = F.mu[2048 + k]; break; case 5: v = F.mu[2112 + k]; break; case 6: v = F.w0[col]; break; case 7: v = F.a0[col]; break; case 8: v = F.k_k[col]; break;
                         case 9: v = F.k_a[col]; break; case 10: v = F.r_k[col]; break; case 11: v = F.ln_w[col]; break; default: v = F.ln_b[col]; break; }
            PR[i] = v; }
        __syncthreads();
        float S[64];
#pragma unroll
        for (int k = 0; k < 64; ++k) S[k] = 0.f;
        for (int c = 0; c < SEQ / 64; ++c) {
            const int t = F.tid >> 3, kg = F.tid & 7; const int s = c * 64 + t; const size_t row = (size_t)b * SEQ + s;
            const bf16* cur = RW + row * RWC; const bool hasp = s > 0; const bf16* prv = hasp ? cur - RWC : cur; const float pm = hasp ? 1.f : 0.f;
#pragma unroll
            for (int e = 0; e < 8; ++e) { const int j = kg * 8 + e;
                const float cw = bf2f(cur[2048 + j]), pw = pm * bf2f(prv[2048 + j]); TW[t * 64 + j] = tanhf(cw + (pw - cw) * PR[4 * 64 + j]);
                const float ca = bf2f(cur[2112 + j]), pa = pm * bf2f(prv[2112 + j]); TA[t * 64 + j] = ca + (pa - ca) * PR[5 * 64 + j]; }
            __syncthreads();
            float kkv[8]; float nrm = 0.f, bon = 0.f;
            float wpa[8], apa[8];
#pragma unroll
            for (int e = 0; e < 8; ++e) { wpa[e] = PR[6 * 64 + kg * 8 + e]; apa[e] = PR[7 * 64 + kg * 8 + e]; }
#pragma unroll 1
            for (int j = 0; j < 64; ++j) { const float tw = TW[t * 64 + j], ta = TA[t * 64 + j]; const float* wu = F.w_up + j * AW + h * HD + kg * 8; const float* au = F.a_up + j * AW + h * HD + kg * 8;
#pragma unroll
                for (int e = 0; e < 8; ++e) { wpa[e] += tw * wu[e]; apa[e] += ta * au[e]; } }
            const bf16* cb = cur + h * HD + kg * 8; const bf16* pb = prv + h * HD + kg * 8;
#pragma unroll
            for (int e = 0; e < 8; ++e) { const int k = kg * 8 + e;
                const float wp = wpa[e], ap = apa[e];
                const float sp = (-wp > 20.f) ? -wp : log1pf(__expf(-wp));
                const float wlog = -sp - 0.5f; const float dec = __expf(-__expf(wlog));
                const float a = sigm(ap);
                const float cr = bf2f(cb[e]), pr = pm * bf2f(pb[e]); const float r = cr + (pr - cr) * PR[0 * 64 + k];
                const float ck = bf2f(cb[512 + e]), pk = pm * bf2f(pb[512 + e]); const float kx = ck + (pk - ck) * PR[1 * 64 + k];
                const float cv = bf2f(cb[1024 + e]), pv = pm * bf2f(pb[1024 + e]); const float vx = cv + (pv - cv) * PR[2 * 64 + k];
                const float kkx = kx * PR[8 * 64 + k]; nrm += kkx * kkx; kkv[e] = kkx;
                const float kmod = kx * (1.0f + (a - 1.0f) * PR[9 * 64 + k]);
                bon += r * kmod * PR[10 * 64 + k];
                Wd[t * 64 + k] = dec; Rr[t * 64 + k] = r; Vv[t * 64 + k] = vx; Kk[t * 64 + k] = kmod; Bb[t * 64 + k] = a; }
            nrm += __shfl_xor(nrm, 1); nrm += __shfl_xor(nrm, 2); nrm += __shfl_xor(nrm, 4);
            bon += __shfl_xor(bon, 1); bon += __shfl_xor(bon, 2); bon += __shfl_xor(bon, 4);
            const float inv = 1.0f / fmaxf(sqrtf(nrm), 1e-12f);
#pragma unroll
            for (int e = 0; e < 8; ++e) { const int k = kg * 8 + e; const float kn = kkv[e] * inv; Aa[t * 64 + k] = -kn; Bb[t * 64 + k] = kn * Bb[t * 64 + k]; }
            if (kg == 0) Bon[t] = bon;
            __syncthreads();
            if (F.wave == 0) {
                const int v = F.lane; const int col = h * HD + v;
                const float lnw = PR[11 * 64 + v], lnb = PR[12 * 64 + v], muz = PR[3 * 64 + v];
#pragma unroll 1
                for (int tt = 0; tt < 64; ++tt) {
                    const LAS float* aA = Aa + tt * 64; const LAS float* aW = Wd + tt * 64; const LAS float* aB = Bb + tt * 64; const LAS float* aK = Kk + tt * 64; const LAS float* aR = Rr + tt * 64;
                    float sa0 = 0.f, sa1 = 0.f;
#pragma unroll
                    for (int kc = 0; kc < 64; kc += 8) {
#pragma unroll
                        for (int k = kc; k < kc + 8; k += 2) { sa0 += S[k] * aA[k]; sa1 += S[k + 1] * aA[k + 1]; }
                        asm volatile("" ::: "memory"); }
                    const float sa = sa0 + sa1, vv = Vv[tt * 64 + v];
                    float y0 = 0.f, y1 = 0.f;
#pragma unroll
                    for (int kc = 0; kc < 64; kc += 8) {
#pragma unroll
                        for (int k = kc; k < kc + 8; k += 2) {
                            S[k] = S[k] * aW[k] + sa * aB[k] + vv * aK[k]; y0 += S[k] * aR[k];
                            S[k + 1] = S[k + 1] * aW[k + 1] + sa * aB[k + 1] + vv * aK[k + 1]; y1 += S[k + 1] * aR[k + 1]; }
                        asm volatile("" ::: "memory"); }
                    const float y = y0 + y1;
                    const float mean = wave_sum(y) * (1.f / 64.f); const float dy = y - mean; const float var = wave_sum(dy * dy) * (1.f / 64.f);
                    float o = dy * (1.0f / sqrtf(var + GN_EPS)) * lnw + lnb + Bon[tt] * vv;
                    const int ss = c * 64 + tt; const size_t rw = (size_t)b * SEQ + ss;
                    const float cz = bf2f(RW[rw * RWC + 1536 + col]), pz = ss > 0 ? bf2f(RW[(rw - 1) * RWC + 1536 + col]) : 0.f; const float z = cz + (pz - cz) * muz;
                    o *= z * sigm(z);
                    QKVZ[rw * 2048 + 512 + col] = (bf16)f2bf(o);
                }
            }
            __syncthreads();
        }
    }
}

__device__ __forceinline__ void post_norm(Frame& F) {
    const float* Y = (const float*)(F.ws + WS_RW); float* RSY = (float*)(F.ws + WS_RSY); bf16* H1 = (bf16*)(F.ws + WS_QKVZ);
    const int gw = F.vcu * NWAVES + F.wave, NGW = F.G * NWAVES;
    f32x4 gv[4];
#pragma unroll
    for (int j = 0; j < 4; ++j) gv[j] = *((const f32x4*)F.g_post + F.lane + 64 * j);
    for (int row = gw; row < M; row += NGW) {
        const f32x4* yr = (const f32x4*)(Y + (size_t)row * DM) + F.lane; const f32x4* xr = (const f32x4*)(F.x + (size_t)row * DM) + F.lane;
        f32x4 v[4]; float s = 0.f;
#pragma unroll
        for (int j = 0; j < 4; ++j) { v[j] = yr[64 * j]; s += (v[j][0] * v[j][0] + v[j][1] * v[j][1]) + (v[j][2] * v[j][2] + v[j][3] * v[j][3]); }
        const float rs = 1.0f / sqrtf(wave_sum(s) * (1.f / DM) + RMS_EPS);
        if (F.lane == 0) RSY[row] = rs;
#pragma unroll
        for (int j = 0; j < 4; ++j) { const f32x4 xv = xr[64 * j]; float h[4];
#pragma unroll
            for (int e = 0; e < 4; ++e) h[e] = xv[e] + v[j][e] * rs * gv[j][e];
            *(v2u*)(H1 + (size_t)row * DM + 4 * F.lane + 256 * j) = (v2u){pk2(h[0], h[1]), pk2(h[2], h[3])}; }
    }
}
constexpr int LDS_BYTES = 147456;
constexpr int NPHASE = 9;

template <int PLO, int PHI> __global__ void __launch_bounds__(NTHR, 2) fwd(Args args) {
    extern __shared__ __attribute__((aligned(16))) unsigned char lds[];
    Frame F;
    F.lds = (LAS unsigned char*)lds;
    F.tid = threadIdx.x; F.lane = F.tid & 63; F.wave = __builtin_amdgcn_readfirstlane(F.tid >> 6);
    F.G = gridDim.x; { const int bx = blockIdx.x; F.vcu = (F.G % 8 == 0) ? (bx % 8) * (F.G / 8) + bx / 8 : bx; }
    F.x = args.in[0]; F.p = args.in[1]; F.g_pre = args.in[2]; F.w_in = args.in[3]; F.rel_bias = args.in[4]; F.mu = args.in[5]; F.w0 = args.in[6]; F.w_up = args.in[7];
    F.a0 = args.in[8]; F.a_up = args.in[9]; F.k_k = args.in[10]; F.k_a = args.in[11]; F.r_k = args.in[12]; F.ln_w = args.in[13]; F.ln_b = args.in[14];
    F.p_a = args.in[15]; F.p_b = args.in[16]; F.w_out = args.in[17]; F.g_post = args.in[18]; F.w_pu = args.in[19]; F.w_pg = args.in[20];
    F.out = args.out; F.ws = args.ws;
    constexpr int lo = PLO, hi = PHI;
    cg::grid_group grid = cg::this_grid();
#define IN(k) (lo <= (k) && (k) < hi)
#define SEAM(k) do { if constexpr (IN(k) && IN((k) + 1)) grid.sync(); } while (0)
    unsigned char* ws = F.ws;
    pg8::bf16_t* U2 = (pg8::bf16_t*)F.out; pg8::bf16_t* MERGED = (pg8::bf16_t*)F.out;
    pg8::bf16_t* QKVZ = (pg8::bf16_t*)(ws + WS_QKVZ); pg8::bf16_t* RWb = (pg8::bf16_t*)(ws + WS_RW); pg8::bf16_t* GAB = (pg8::bf16_t*)(ws + WS_GAB);

    if constexpr (IN(0)) { p0_prologue(F); } SEAM(0);
    if constexpr (IN(1)) {
        { pg8::Gemm g{U2, (const pg8::bf16_t*)(ws + WS_WIN), M, INCP, DM, 2048, DM, 0, 0}; pg8::StaticOrder S; S.init(M, INCP, F.G, (int)blockIdx.x);
          pg8::EpiCols E{QKVZ, RWb, GAB, QSCALE};
          pg8::gemm_phase<pg8::EpiCols, pg8::StaticOrder, true, true>(F.lds, g, S, E); }
        { pg8::Gemm g{U2, (const pg8::bf16_t*)(ws + WS_WG), M, 256, 2048, 2048, 2048, 16, (size_t)256 * 2048}; pg8::StaticOrder S; S.init(M, 256, F.G, (int)blockIdx.x);
          pg8::EpiF32 E{(float*)(ws + WS_GATE), 256};
          pg8::gemm_phase<pg8::EpiF32, pg8::StaticOrder, true, true>(F.lds, g, S, E); }
    } SEAM(1);
    if constexpr (IN(2)) { attn_simple(F); } SEAM(2);
    if constexpr (IN(3)) { rwkv_simple(F); } SEAM(3);
    if constexpr (IN(4)) {
        pg8::Gemm g{QKVZ, (const pg8::bf16_t*)(ws + WS_PAB), M, DM, 512, 2048, 1024, 0, 0}; pg8::StaticOrder S; S.init(M, DM, F.G, (int)blockIdx.x);
        pg8::EpiMerge<false> E{MERGED, DM, GAB, 2048};
        pg8::gemm_phase<pg8::EpiMerge<false>, pg8::StaticOrder, true, true>(F.lds, g, S, E);
    } SEAM(4);
    if constexpr (IN(5)) {
        pg8::Gemm g{QKVZ + 512, (const pg8::bf16_t*)(ws + WS_PAB) + 512, M, DM, 512, 2048, 1024, 0, 0}; pg8::StaticOrder S; S.init(M, DM, F.G, (int)blockIdx.x);
        pg8::EpiMerge<true> E{MERGED, DM, GAB + 1024, 2048};
        pg8::gemm_phase<pg8::EpiMerge<true>, pg8::StaticOrder, true, true>(F.lds, g, S, E);
    } SEAM(5);
    if constexpr (IN(6)) {
        { pg8::Gemm g{MERGED, (const pg8::bf16_t*)(ws + WS_WOUT), M, DM, DM, DM, DM, 0, 0}; pg8::StaticOrder S; S.init(M, DM, F.G, (int)blockIdx.x);
          pg8::EpiF32 E{(float*)(ws + WS_RW), DM};
          pg8::gemm_phase<pg8::EpiF32, pg8::StaticOrder, true, true>(F.lds, g, S, E); }
        { pg8::Gemm g{(const pg8::bf16_t*)(ws + WS_PB), (const pg8::bf16_t*)(ws + WS_WPU), M, DM, PLE, PLE, PLE, 0, 0}; pg8::StaticOrder S; S.init(M, DM, F.G, (int)blockIdx.x);
          pg8::EpiBf16 E{GAB, DM};
          pg8::gemm_phase<pg8::EpiBf16, pg8::StaticOrder, true, true>(F.lds, g, S, E); }
    } SEAM(6);
    if constexpr (IN(7)) { post_norm(F); } SEAM(7);
    if constexpr (IN(8)) {
        pg8::Gemm g{QKVZ, (const pg8::bf16_t*)(ws + WS_WPG), M, DM, DM, DM, DM, 0, 0}; pg8::StaticOrder S; S.init(M, DM, F.G, (int)blockIdx.x);
        pg8::EpiFinal E{F.out, F.x, (const float*)(ws + WS_RW), (const float*)(ws + WS_RSY), F.g_post, GAB, DM};
        pg8::gemm_phase<pg8::EpiFinal, pg8::StaticOrder, true, true>(F.lds, g, S, E);
    }
#undef IN
#undef SEAM
}

#ifndef MK_ONE_LAUNCH
#define MK_ONE_LAUNCH 0
#endif
extern "C" void kernel_launch(void* const* d_in, const int* in_sizes, int n_in, void* d_out, int out_size, void* d_ws, size_t ws_size, hipStream_t stream) {
    static int grid = 0;
    if (grid == 0) {
        if (n_in != 21 || out_size != M * DM || ws_size < WS_END) { fprintf(stderr, "kernel_launch: unexpected shapes n_in %d out %d ws %zu\n", n_in, out_size, ws_size); grid = -1; return; }
        int dev = 0, cus = 0, per_cu = 0;
        (void)hipGetDevice(&dev); (void)hipDeviceGetAttribute(&cus, hipDeviceAttributeMultiprocessorCount, dev);
        (void)per_cu;
        grid = cus;
    }
    if (grid < 0) return;
    Args a{};
    for (int i = 0; i < 21; ++i) a.in[i] = (const float*)d_in[i];
    a.out = (float*)d_out; a.ws = (unsigned char*)d_ws;
#if MK_ONE_LAUNCH
    a.ph_lo = 0; a.ph_hi = NPHASE;
    void* kargs[] = {&a};
    (void)hipFuncSetAttribute((const void*)fwd<0, NPHASE>, hipFuncAttributeMaxDynamicSharedMemorySize, LDS_BYTES);
    hipError_t e = hipLaunchCooperativeKernel((const void*)fwd<0, NPHASE>, dim3(grid), dim3(NTHR), kargs, LDS_BYTES, stream);
    if (e != hipSuccess) fprintf(stderr, "cooperative launch failed: %s\n", hipGetErrorString(e));
#else
#define LAUNCH_PH(k) do { (void)hipFuncSetAttribute((const void*)fwd<k, k + 1>, hipFuncAttributeMaxDynamicSharedMemorySize, LDS_BYTES); a.ph_lo = k; a.ph_hi = k + 1; hipLaunchKernelGGL((fwd<k, k + 1>), dim3(grid), dim3(NTHR), LDS_BYTES, stream, a); } while (0)
    LAUNCH_PH(0); LAUNCH_PH(1); LAUNCH_PH(2); LAUNCH_PH(3); LAUNCH_PH(4); LAUNCH_PH(5); LAUNCH_PH(6); LAUNCH_PH(7); LAUNCH_PH(8);
#endif
}
```

```cpp
#include <hip/hip_runtime.h>
#include <hip/hip_cooperative_groups.h>
#include <cstdio>
#include <cstdint>
#include <cmath>
namespace cg = cooperative_groups;
namespace pg8 {
#define PG8_LAS __attribute__((address_space(3)))
typedef unsigned short bf16_t;
typedef short bf16x8 __attribute__((ext_vector_type(8)));
typedef float f32x4 __attribute__((ext_vector_type(4)));
typedef float f32x2 __attribute__((ext_vector_type(2)));
typedef unsigned u32x4 __attribute__((ext_vector_type(4)));
typedef unsigned u32x2 __attribute__((ext_vector_type(2)));
constexpr int BM = 256, BK = 64, HALF = 128, HTB = HALF * BK * 2  , STAGE_BYTES = 8 * HTB, NXCD = 8, WGM = 8;

__host__ __device__ __forceinline__ int lds_byte(int r, int c) { const int st = (r >> 4) * 2 + (c >> 5), rr = r & 15, cc = c & 31, ob = rr * 64 + cc * 2; return st * 1024 + (ob ^ (((ob >> 9) & 1) << 5)); }
__host__ __device__ __forceinline__ void stage_rc(int b, int& R, int& C) { const int st = b / 1024, sb = b % 1024, swz = sb ^ (((sb >> 9) & 1) << 5); R = (st >> 1) * 16 + swz / 64; C = (st & 1) * 32 + (swz % 64) / 2; }
__host__ __device__ __forceinline__ int perm32(int rho) { const int n = rho >> 4, i = rho & 15; return 8 * (i >> 2) + 4 * n + (i & 3); }

struct Unit { int pm, pn; };
struct Gemm { const bf16_t* A; const bf16_t* Bt; int M, N, K, lda, ldb, bdiv; size_t bstride; };

struct StaticOrder {
    int nM, nN, nwg, G, c;
    __host__ __device__ void init(int M, int N, int G_, int c_) { nM = M / BM; nN = N / BM; nwg = nM * nN; G = G_; c = c_; }
    __host__ __device__ bool next(int i, Unit& u) const {
        const long L = (long)i * G + c; if (L >= nwg) return false;
        int wgid = (int)L; { const int q = nwg / NXCD, r = nwg % NXCD, xcd = wgid % NXCD, off = wgid / NXCD; wgid = (xcd < r ? xcd * (q + 1) : r * (q + 1) + (xcd - r) * q) + off; }
        const int nig = WGM * nN, gid = wgid / nig, fm = gid * WGM, gsz = (nM - fm) < WGM ? (nM - fm) : WGM;
        u.pm = fm + ((wgid % nig) % gsz); u.pn = (wgid % nig) / gsz; return true;
    }
};

__device__ __forceinline__ unsigned cvt_pk_bf16(float lo, float hi) { unsigned r; asm volatile("v_cvt_pk_bf16_f32 %0, %1, %2" : "=v"(r) : "v"(lo), "v"(hi)); return r; }
__device__ __forceinline__ float bf_lo(unsigned w) { return __uint_as_float(w << 16); }
__device__ __forceinline__ float bf_hi(unsigned w) { return __uint_as_float(w & 0xffff0000u); }

template <class Epi, class Sched, bool ALIGN_EPI = false, bool SP2 = false>
__device__ __forceinline__ void gemm_phase(PG8_LAS unsigned char* lds, const Gemm g, const Sched& S, const Epi& E) {
    int tid_ = threadIdx.x; asm volatile("" : "+v"(tid_));
    const int tid = tid_, wid = __builtin_amdgcn_readfirstlane(tid >> 6), lane = tid & 63, wr = wid >> 2, wc = wid & 3, fr = lane & 15, fq = lane >> 4;
    const int K = g.K, nt = K / BK;
    unsigned voffA[2], voffB[2];
#pragma unroll
    for (int i = 0; i < 2; ++i) { int R, C; stage_rc(tid * 16 + i * 8192, R, C); const int Rb = Epi::PERM ? ((R & ~31) + perm32(R & 31)) : R;
        voffA[i] = (unsigned)(R * g.lda + C) * 2u; voffB[i] = (unsigned)(Rb * g.ldb + C) * 2u; }
    const size_t kstep = (size_t)(BK * 2);
    const size_t hstepA = (size_t)HALF * g.lda * 2, hstepB = (size_t)HALF * g.ldb * 2;
    const size_t tstepA = 2 * hstepA, tstepB = 2 * hstepB;
    const unsigned ldsw = (unsigned)wid * 1024u;
    const int aoff = lds_byte(wr * 64 + fr, fq * 8), boff = lds_byte(wc * 32 + fr, fq * 8);
#define PG8_SA(b, h) (((b) * 2 + (h)) * HTB)
#define PG8_SB(b, h) ((4 + (b) * 2 + (h)) * HTB)
#define PG8_STAGE(bufoff, gbase, voff) do { _Pragma("unroll") for (int _i = 0; _i < 2; ++_i) \
        __builtin_amdgcn_global_load_lds((const unsigned*)((const char*)(gbase) + (voff)[_i]), (PG8_LAS unsigned*)(lds + (bufoff) + ldsw + _i * 8192), 16, 0, 0); } while (0)
#define PG8_LDA(dst, b, h) do { _Pragma("unroll") for (int m = 0; m < 4; ++m) _Pragma("unroll") for (int k = 0; k < 2; ++k) dst[m][k] = *(const PG8_LAS bf16x8*)(lds + PG8_SA(b, h) + aoff + m * 2048 + k * 1024); } while (0)
#define PG8_LDB(dst, b, h) do { _Pragma("unroll") for (int n = 0; n < 2; ++n) _Pragma("unroll") for (int k = 0; k < 2; ++k) dst[n][k] = *(const PG8_LAS bf16x8*)(lds + PG8_SB(b, h) + boff + n * 2048 + k * 1024); } while (0)
#define PG8_MMA(ai, bj, At, Bt) do { __builtin_amdgcn_s_setprio(1); _Pragma("unroll") for (int m = 0; m < 4; ++m) _Pragma("unroll") for (int n = 0; n < 2; ++n) _Pragma("unroll") for (int k = 0; k < 2; ++k) \
        acc[ai][bj][m][n] = __builtin_amdgcn_mfma_f32_16x16x32_bf16(Bt[n][k], At[m][k], acc[ai][bj][m][n], 0, 0, 0); __builtin_amdgcn_s_setprio(0); } while (0)
#define PG8_WAIT_V(n) asm volatile("s_waitcnt vmcnt(" #n ")" ::: "memory")
#define PG8_WAIT_L(n) asm volatile("s_waitcnt lgkmcnt(" #n ")" ::: "memory")
#define PG8_BAR __builtin_amdgcn_s_barrier()
#define PG8_SCHED __builtin_amdgcn_sched_barrier(0)
#define PG8_BBASE(u) ((const char*)g.Bt + (size_t)(u).pn * tstepB + (g.bdiv ? (size_t)((u).pm / g.bdiv) * g.bstride * 2 : (size_t)0))
    Unit cur, nxt; int ui = 0;
    if (!S.next(0, cur)) return;
    f32x4 acc[2][2][4][2];
#pragma unroll
    for (int a = 0; a < 2; ++a)
#pragma unroll
        for (int b = 0; b < 2; ++b)
#pragma unroll
            for (int m = 0; m < 4; ++m)
#pragma unroll
                for (int n = 0; n < 2; ++n) acc[a][b][m][n] = (f32x4){0.f, 0.f, 0.f, 0.f};
    bf16x8 At[4][2], B0[2][2], B1[2][2];
    const char* cA = (const char*)g.A + (size_t)cur.pm * tstepA; const char* cB = PG8_BBASE(cur);
    if constexpr (SP2) {
        PG8_STAGE(PG8_SB(0, 0), cB, voffB); PG8_STAGE(PG8_SB(0, 1), cB + hstepB, voffB); PG8_STAGE(PG8_SA(0, 0), cA, voffA); PG8_STAGE(PG8_SA(0, 1), cA + hstepA, voffA);
        if (wr == 1) PG8_BAR;
        PG8_WAIT_V(2); PG8_BAR;
        PG8_STAGE(PG8_SB(1, 0), cB + kstep, voffB); PG8_STAGE(PG8_SA(1, 0), cA + kstep, voffA); PG8_STAGE(PG8_SB(1, 1), cB + hstepB + kstep, voffB);
        PG8_WAIT_V(6); PG8_BAR;
    } else {
        PG8_STAGE(PG8_SB(0, 0), cB, voffB); PG8_STAGE(PG8_SA(0, 0), cA, voffA); PG8_STAGE(PG8_SB(0, 1), cB + hstepB, voffB); PG8_STAGE(PG8_SA(0, 1), cA + hstepA, voffA);
        if (wr == 1) PG8_BAR;
        PG8_WAIT_V(4); PG8_BAR;
        PG8_STAGE(PG8_SB(1, 0), cB + kstep, voffB); PG8_STAGE(PG8_SA(1, 0), cA + kstep, voffA); PG8_STAGE(PG8_SB(1, 1), cB + hstepB + kstep, voffB);
        PG8_WAIT_V(6); PG8_BAR;
    }
    for (;;) {
        const bool has_next = S.next(ui + 1, nxt);
        const char* nA = has_next ? (const char*)g.A + (size_t)nxt.pm * tstepA : cA; const char* nB = has_next ? PG8_BBASE(nxt) : cB;
        for (int t = 0; t < nt; t += 2) {
            const bool last = (t == nt - 2);
            const char* a1 = cA + (size_t)(t + 1) * kstep;
            const char* a2 = last ? nA : cA + (size_t)(t + 2) * kstep; const char* b2 = last ? nB : cB + (size_t)(t + 2) * kstep;
            const char* a3 = a2 + kstep; const char* b3 = b2 + kstep;
            if constexpr (SP2) {
            PG8_LDB(B0, 0, 0); PG8_LDB(B1, 0, 1); PG8_SCHED; PG8_LDA(At, 0, 0); PG8_STAGE(PG8_SA(1, 1), a1 + hstepA, voffA);
            PG8_WAIT_V(8); PG8_WAIT_L(0); PG8_BAR; PG8_MMA(0, 0, At, B0); PG8_MMA(0, 1, At, B1); PG8_BAR; PG8_SCHED;
            PG8_LDA(At, 0, 1); PG8_STAGE(PG8_SB(0, 0), b2, voffB); PG8_STAGE(PG8_SB(0, 1), b2 + hstepB, voffB); PG8_STAGE(PG8_SA(0, 0), a2, voffA);
            PG8_WAIT_V(8); PG8_WAIT_L(0); PG8_BAR; PG8_MMA(1, 0, At, B0); PG8_MMA(1, 1, At, B1); PG8_BAR; PG8_SCHED;
            PG8_LDB(B0, 1, 0); PG8_LDB(B1, 1, 1); PG8_SCHED; PG8_LDA(At, 1, 0); PG8_STAGE(PG8_SA(0, 1), a2 + hstepA, voffA);
            PG8_WAIT_V(8); PG8_WAIT_L(0); PG8_BAR; PG8_MMA(0, 0, At, B0); PG8_MMA(0, 1, At, B1); PG8_BAR; PG8_SCHED;
            PG8_LDA(At, 1, 1); PG8_STAGE(PG8_SB(1, 0), b3, voffB); PG8_STAGE(PG8_SB(1, 1), b3 + hstepB, voffB); PG8_STAGE(PG8_SA(1, 0), a3, voffA);
            PG8_WAIT_V(8); PG8_WAIT_L(0); PG8_BAR; PG8_MMA(1, 0, At, B0); PG8_MMA(1, 1, At, B1); PG8_BAR; PG8_SCHED;
            } else {
            PG8_LDB(B0, 0, 0); PG8_SCHED; PG8_LDA(At, 0, 0); PG8_STAGE(PG8_SA(1, 1), a1 + hstepA, voffA);
            PG8_WAIT_L(8); PG8_BAR; PG8_WAIT_L(0); PG8_MMA(0, 0, At, B0); PG8_BAR; PG8_SCHED;
            PG8_LDB(B1, 0, 1); PG8_STAGE(PG8_SB(0, 0), b2, voffB);
            PG8_BAR; PG8_WAIT_L(0); PG8_MMA(0, 1, At, B1); PG8_BAR;
            PG8_LDA(At, 0, 1); PG8_STAGE(PG8_SA(0, 0), a2, voffA);
            PG8_BAR; PG8_WAIT_L(0); PG8_MMA(1, 0, At, B0); PG8_BAR; PG8_SCHED;
            PG8_STAGE(PG8_SB(0, 1), b2 + hstepB, voffB);
            PG8_WAIT_V(6); PG8_BAR; PG8_MMA(1, 1, At, B1); PG8_BAR;
            PG8_LDB(B0, 1, 0); PG8_SCHED; PG8_LDA(At, 1, 0); PG8_STAGE(PG8_SA(0, 1), a2 + hstepA, voffA);
            PG8_WAIT_L(8); PG8_BAR; PG8_WAIT_L(0); PG8_MMA(0, 0, At, B0); PG8_BAR; PG8_SCHED;
            PG8_LDB(B1, 1, 1); PG8_STAGE(PG8_SB(1, 0), b3, voffB);
            PG8_BAR; PG8_WAIT_L(0); PG8_MMA(0, 1, At, B1); PG8_BAR;
            PG8_LDA(At, 1, 1); PG8_STAGE(PG8_SA(1, 0), a3, voffA);
            PG8_BAR; PG8_WAIT_L(0); PG8_MMA(1, 0, At, B0); PG8_BAR; PG8_SCHED;
            PG8_STAGE(PG8_SB(1, 1), b3 + hstepB, voffB);
            PG8_WAIT_V(6); PG8_BAR; PG8_MMA(1, 1, At, B1); PG8_BAR;
            }
        }
        if constexpr (ALIGN_EPI) { if (wr == 0) PG8_BAR; }
        E(acc, cur, wr, wc, fr, fq);
        if (!has_next) break;
#pragma unroll
        for (int a = 0; a < 2; ++a)
#pragma unroll
            for (int b = 0; b < 2; ++b)
#pragma unroll
                for (int m = 0; m < 4; ++m)
#pragma unroll
                    for (int n = 0; n < 2; ++n) acc[a][b][m][n] = (f32x4){0.f, 0.f, 0.f, 0.f};
        cur = nxt; cA = nA; cB = nB; ++ui;
        if constexpr (ALIGN_EPI) { if (wr == 1) PG8_BAR; }
    }
    PG8_WAIT_V(0);
    if constexpr (!ALIGN_EPI) { if (wr == 0) PG8_BAR; }
    PG8_BAR;
#undef PG8_SA
#undef PG8_SB
#undef PG8_STAGE
#undef PG8_LDA
#undef PG8_LDB
#undef PG8_MMA
#undef PG8_WAIT_V
#undef PG8_WAIT_L
#undef PG8_BAR
#undef PG8_SCHED
#undef PG8_BBASE
}
}
namespace pg8 {
__device__ __forceinline__ float sigmoidf_(float x) { return 1.0f / (1.0f + __expf(-x)); }

struct EpiCols {
    static constexpr bool PERM = true;
    bf16_t* qkvz; bf16_t* rw; bf16_t* gab; float qscale;
    __device__ __forceinline__ void operator()(const f32x4 (&acc)[2][2][4][2], const Unit& u, int wr, int wc, int fr, int fq) const {
        const int pn = u.pn; bf16_t* base; int pitch, coff, nbj = 2; float sc = 1.f;
        if (pn < 8) { base = qkvz; pitch = 2048; coff = pn * 256; if (pn < 2) sc = qscale; }
        else if (pn < 16) { base = rw; pitch = 2176; coff = (pn - 8) * 256; }
        else if (pn < 24) { base = gab; pitch = 2048; coff = (pn - 16) * 256; }
        else { base = rw; pitch = 2176; coff = 2048; nbj = 1; }
        const int row0 = u.pm * BM + wr * 64 + fr; const int col0 = coff + wc * 32 + 8 * fq;
#pragma unroll
        for (int ai = 0; ai < 2; ++ai)
#pragma unroll
            for (int m = 0; m < 4; ++m) { bf16_t* rowp = base + (size_t)(row0 + ai * HALF + m * 16) * pitch + col0;
#pragma unroll
                for (int bj = 0; bj < 2; ++bj) { if (bj < nbj) { f32x4 v0 = acc[ai][bj][m][0] * sc, v1 = acc[ai][bj][m][1] * sc;
                    u32x4 w; w.x = cvt_pk_bf16(v0[0], v0[1]); w.y = cvt_pk_bf16(v0[2], v0[3]); w.z = cvt_pk_bf16(v1[0], v1[1]); w.w = cvt_pk_bf16(v1[2], v1[3]);
                    *(u32x4*)(rowp + bj * HALF) = w; } } }
    }
};
struct EpiBf16 {
    static constexpr bool PERM = true;
    bf16_t* O; int ldc;
    __device__ __forceinline__ void operator()(const f32x4 (&acc)[2][2][4][2], const Unit& u, int wr, int wc, int fr, int fq) const {
        const int row0 = u.pm * BM + wr * 64 + fr; const int col0 = u.pn * BM + wc * 32 + 8 * fq;
#pragma unroll
        for (int ai = 0; ai < 2; ++ai)
#pragma unroll
            for (int m = 0; m < 4; ++m) { bf16_t* rowp = O + (size_t)(row0 + ai * HALF + m * 16) * ldc + col0;
#pragma unroll
                for (int bj = 0; bj < 2; ++bj) { const f32x4 v0 = acc[ai][bj][m][0], v1 = acc[ai][bj][m][1];
                    u32x4 w; w.x = cvt_pk_bf16(v0[0], v0[1]); w.y = cvt_pk_bf16(v0[2], v0[3]); w.z = cvt_pk_bf16(v1[0], v1[1]); w.w = cvt_pk_bf16(v1[2], v1[3]);
                    *(u32x4*)(rowp + bj * HALF) = w; } }
    }
};
struct EpiF32 {
    static constexpr bool PERM = false;
    float* O; int ldc;
    __device__ __forceinline__ void operator()(const f32x4 (&acc)[2][2][4][2], const Unit& u, int wr, int wc, int fr, int fq) const {
        const int row0 = u.pm * BM + wr * 64 + fr; const int col0 = u.pn * BM + wc * 32 + 4 * fq;
#pragma unroll
        for (int ai = 0; ai < 2; ++ai)
#pragma unroll
            for (int m = 0; m < 4; ++m) { float* rowp = O + (size_t)(row0 + ai * HALF + m * 16) * ldc + col0;
#pragma unroll
                for (int bj = 0; bj < 2; ++bj)
#pragma unroll
                    for (int n = 0; n < 2; ++n) *(f32x4*)(rowp + bj * HALF + n * 16) = acc[ai][bj][m][n]; }
    }
};
template <bool ADD> struct EpiMerge {
    static constexpr bool PERM = true;
    bf16_t* O; int ldc; const bf16_t* G; int ldg;
    __device__ __forceinline__ void operator()(const f32x4 (&acc)[2][2][4][2], const Unit& u, int wr, int wc, int fr, int fq) const {
        const int row0 = u.pm * BM + wr * 64 + fr; const int col0 = u.pn * BM + wc * 32 + 8 * fq;
#pragma unroll
        for (int ai = 0; ai < 2; ++ai)
#pragma unroll
            for (int m = 0; m < 4; ++m) { const size_t r = (size_t)(row0 + ai * HALF + m * 16);
#pragma unroll
                for (int bj = 0; bj < 2; ++bj) { const f32x4 v0 = acc[ai][bj][m][0], v1 = acc[ai][bj][m][1];
                    const u32x4 gw = *(const u32x4*)(G + r * ldg + col0 + bj * HALF);
                    float o[8];
                    o[0] = sigmoidf_(bf_lo(gw.x)) * v0[0]; o[1] = sigmoidf_(bf_hi(gw.x)) * v0[1]; o[2] = sigmoidf_(bf_lo(gw.y)) * v0[2]; o[3] = sigmoidf_(bf_hi(gw.y)) * v0[3];
                    o[4] = sigmoidf_(bf_lo(gw.z)) * v1[0]; o[5] = sigmoidf_(bf_hi(gw.z)) * v1[1]; o[6] = sigmoidf_(bf_lo(gw.w)) * v1[2]; o[7] = sigmoidf_(bf_hi(gw.w)) * v1[3];
                    bf16_t* op = O + r * ldc + col0 + bj * HALF;
                    if (ADD) { const u32x4 pw = *(const u32x4*)op;
                        o[0] += bf_lo(pw.x); o[1] += bf_hi(pw.x); o[2] += bf_lo(pw.y); o[3] += bf_hi(pw.y); o[4] += bf_lo(pw.z); o[5] += bf_hi(pw.z); o[6] += bf_lo(pw.w); o[7] += bf_hi(pw.w); }
                    u32x4 w; w.x = cvt_pk_bf16(o[0], o[1]); w.y = cvt_pk_bf16(o[2], o[3]); w.z = cvt_pk_bf16(o[4], o[5]); w.w = cvt_pk_bf16(o[6], o[7]);
                    *(u32x4*)op = w; } }
    }
};
struct EpiFinal {
    static constexpr bool PERM = false;
    float* out; const float* x; const float* y; const float* rsy; const float* gpost; const bf16_t* E; int ldc;
    __device__ __forceinline__ void operator()(const f32x4 (&acc)[2][2][4][2], const Unit& u, int wr, int wc, int fr, int fq) const {
        const int row0 = u.pm * BM + wr * 64 + fr; const int col0 = u.pn * BM + wc * 32 + 4 * fq;
#pragma unroll
        for (int ai = 0; ai < 2; ++ai)
#pragma unroll
            for (int m = 0; m < 4; ++m) { const size_t r = (size_t)(row0 + ai * HALF + m * 16); const float rs = rsy[r];
#pragma unroll
                for (int bj = 0; bj < 2; ++bj)
#pragma unroll
                    for (int n = 0; n < 2; ++n) { const int c = col0 + bj * HALF + n * 16; const size_t off = r * ldc + c;
                        const f32x4 xv = *(const f32x4*)(x + off), yv = *(const f32x4*)(y + off), gp = *(const f32x4*)(gpost + c); const u32x2 ew = *(const u32x2*)(E + off);
                        const f32x4 a = acc[ai][bj][m][n]; f32x4 o;
                        o[0] = xv[0] + yv[0] * rs * gp[0] + sigmoidf_(a[0]) * bf_lo(ew.x);
                        o[1] = xv[1] + yv[1] * rs * gp[1] + sigmoidf_(a[1]) * bf_hi(ew.x);
                        o[2] = xv[2] + yv[2] * rs * gp[2] + sigmoidf_(a[2]) * bf_lo(ew.y);
                        o[3] = xv[3] + yv[3] * rs * gp[3] + sigmoidf_(a[3]) * bf_hi(ew.y);
                        *(f32x4*)(out + off) = o; } }
    }
};
}
#define GAS __attribute__((address_space(1)))
#define LAS __attribute__((address_space(3)))
typedef unsigned short bf16;
typedef unsigned v4u __attribute__((ext_vector_type(4)));
typedef unsigned v2u __attribute__((ext_vector_type(2)));
typedef float f32x4 __attribute__((ext_vector_type(4)));

constexpr int NWAVES = 8, NTHR = 512;
constexpr int BATCH = 16, SEQ = 4096, DM = 1024, M = BATCH * SEQ;
constexpr int NH = 8, HD = 64, AW = 512, PLE = 256;
constexpr int RWC = 2176, INC = 6272, INCP = 6400;
constexpr int NBLK = 16, BLK = 256;
constexpr float RMS_EPS = 1e-6f, GN_EPS = 64e-5f;
constexpr float LOG2E = 1.4426950408889634f;
constexpr float QSCALE = 0.125f * LOG2E;

constexpr size_t MiB = 1u << 20;
constexpr size_t WS_WIN = 2 * MiB;
constexpr size_t WS_WG = 16 * MiB;
constexpr size_t WS_PAB = 32 * MiB;
constexpr size_t WS_WOUT = 34 * MiB;
constexpr size_t WS_WPG = 36 * MiB;
constexpr size_t WS_WPU = 38 * MiB;
constexpr size_t WS_RSY = 39 * MiB;
constexpr size_t WS_PB = 42 * MiB;
constexpr size_t WS_GATE = 74 * MiB;
constexpr size_t WS_QKVZ = 138 * MiB;
constexpr size_t WS_RW = 394 * MiB;
constexpr size_t WS_GAB = 666 * MiB;
constexpr size_t WS_END = 922 * MiB;

__device__ const unsigned char T5B[128] = {0, 1, 2, 3, 4, 5, 6, 7, 8, 9, 10, 11, 12, 13, 14, 15, 16, 16, 16, 17, 17, 18, 18, 18, 19, 19, 19, 20, 20, 20, 20, 21, 21, 21, 21, 22, 22, 22, 22, 22, 23, 23, 23, 23, 23, 23, 24, 24, 24, 24, 24, 24, 25, 25, 25, 25, 25, 25, 25, 26, 26, 26, 26, 26, 26, 26, 26, 27, 27, 27, 27, 27, 27, 27, 27, 27, 27, 28, 28, 28, 28, 28, 28, 28, 28, 28, 28, 29, 29, 29, 29, 29, 29, 29, 29, 29, 29, 29, 29, 30, 30, 30, 30, 30, 30, 30, 30, 30, 30, 30, 30, 30, 30, 31, 31, 31, 31, 31, 31, 31, 31, 31, 31, 31, 31, 31, 31, 31};

__device__ __forceinline__ unsigned f2bf(float f) { unsigned u = __builtin_bit_cast(unsigned, f); return (u + 0x7fffu + ((u >> 16) & 1u)) >> 16; }
__device__ __forceinline__ unsigned pk2(float lo, float hi) { return f2bf(lo) | (f2bf(hi) << 16); }
__device__ __forceinline__ float bf2f(unsigned short h) { return __uint_as_float((unsigned)h << 16); }
__device__ __forceinline__ float wave_sum(float v) {
#pragma unroll
    for (int o = 1; o < 64; o <<= 1) v += __shfl_xor(v, o);
    return v;
}
__device__ __forceinline__ float sigm(float x) { return 1.0f / (1.0f + __expf(-x)); }

struct Args {
    const float* in[21]; float* out; unsigned char* ws; int ph_lo, ph_hi;
};
struct Frame {
    LAS unsigned char* lds; int tid, lane, wave, vcu, G;
    const float *x, *p, *g_pre, *w_in, *rel_bias, *mu, *w0, *w_up, *a0, *a_up, *k_k, *k_a, *r_k, *ln_w, *ln_b, *p_a, *p_b, *w_out, *g_post, *w_pu, *w_pg;
    float* out; unsigned char* ws;
};

__device__ __forceinline__ void transpose_item(const float* W, int N, int k0, int n0, bf16* WT, int ldw, int drow0, int koff, LAS float* scr, int lane) {
#pragma unroll 8
    for (int i = 0; i < 32; ++i) { const int kk = 2 * i + (lane >> 5); scr[kk * 33 + (lane & 31)] = W[(size_t)(k0 + kk) * N + n0 + (lane & 31)]; }
    asm volatile("s_waitcnt lgkmcnt(0)" ::: "memory");
    const int c = lane & 7;
#pragma unroll
    for (int j = 0; j < 4; ++j) { const int n = (lane >> 3) + 8 * j; const LAS float* s = scr + (8 * c) * 33 + n;
        v4u o; o.x = pk2(s[0 * 33], s[1 * 33]); o.y = pk2(s[2 * 33], s[3 * 33]); o.z = pk2(s[4 * 33], s[5 * 33]); o.w = pk2(s[6 * 33], s[7 * 33]);
        *(v4u*)(WT + (size_t)(drow0 + n) * ldw + koff + k0 + 8 * c) = o; }
    asm volatile("s_waitcnt lgkmcnt(0)" ::: "memory");
}

__device__ __forceinline__ void p0_prologue(Frame& F) {
    LAS float* scr = (LAS float*)(F.lds + F.wave * 16384);
    const int gw = F.vcu * NWAVES + F.wave, NGW = F.G * NWAVES;
    bf16* WinT = (bf16*)(F.ws + WS_WIN); bf16* PabT = (bf16*)(F.ws + WS_PAB); bf16* WoutT = (bf16*)(F.ws + WS_WOUT); bf16* WpgT = (bf16*)(F.ws + WS_WPG); bf16* WpuT = (bf16*)(F.ws + WS_WPU);
    constexpr int I_IN = 16 * (INC / 32), I_PA = 8 * 32, I_PB = 8 * 32, I_WO = 16 * 32, I_PG = 16 * 32, I_PU = 4 * 32;
    constexpr int NIT = I_IN + I_PA + I_PB + I_WO + I_PG + I_PU;
    for (int it = gw; it < NIT; it += NGW) {
        int r = it;
        if (r < I_IN) { const int nb = r % (INC / 32), kb = r / (INC / 32), n0 = nb * 32;
            const int d0 = n0 < 4096 ? n0 : (n0 < 4224 ? n0 + 2048 : n0 - 128);
            transpose_item(F.w_in, INC, kb * 64, n0, WinT, DM, d0, 0, scr, F.lane); continue; } r -= I_IN;
        if (r < I_PA) { transpose_item(F.p_a, DM, (r / 32) * 64, (r % 32) * 32, PabT, 1024, (r % 32) * 32, 0, scr, F.lane); continue; } r -= I_PA;
        if (r < I_PB) { transpose_item(F.p_b, DM, (r / 32) * 64, (r % 32) * 32, PabT, 1024, (r % 32) * 32, 512, scr, F.lane); continue; } r -= I_PB;
        if (r < I_WO) { transpose_item(F.w_out, DM, (r / 32) * 64, (r % 32) * 32, WoutT, 1024, (r % 32) * 32, 0, scr, F.lane); continue; } r -= I_WO;
        if (r < I_PG) { transpose_item(F.w_pg, DM, (r / 32) * 64, (r % 32) * 32, WpgT, 1024, (r % 32) * 32, 0, scr, F.lane); continue; } r -= I_PG;
        transpose_item(F.w_pu, DM, (r / 32) * 64, (r % 32) * 32, WpuT, 256, (r % 32) * 32, 0, scr, F.lane);
    }
    for (int i = gw * 64 + F.lane; i < 128 * 1024 / 8; i += NGW * 64) *(v4u*)(WinT + (size_t)INC * DM + (size_t)i * 8) = (v4u){0u, 0u, 0u, 0u};
    { bf16* PB = (bf16*)(F.ws + WS_PB); const size_t n8 = (size_t)M * PLE / 8;
      for (size_t i = (size_t)F.vcu * NTHR + F.tid; i < n8; i += (size_t)F.G * NTHR) { const f32x4 a = *(const f32x4*)(F.p + i * 8), b = *(const f32x4*)(F.p + i * 8 + 4);
          v4u o; o.x = pk2(a[0], a[1]); o.y = pk2(a[2], a[3]); o.z = pk2(b[0], b[1]); o.w = pk2(b[2], b[3]); *(v4u*)(PB + i * 8) = o; } }
    __syncthreads();
    LAS float* red = (LAS float*)F.lds;
    LAS float* ubar = (LAS float*)(F.lds + 32768);
    LAS float* kmean = (LAS float*)(F.lds + 36864);
    bf16* U2 = (bf16*)F.out; bf16* WgT = (bf16*)(F.ws + WS_WG);
    for (int blk = F.vcu; blk < M / BLK; blk += F.G) {
        float cs[16];
#pragma unroll
        for (int i = 0; i < 16; ++i) cs[i] = 0.f;
        f32x4 gv[4];
#pragma unroll
        for (int j = 0; j < 4; ++j) gv[j] = *((const f32x4*)F.g_pre + F.lane + 64 * j);
        for (int i = 0; i < 32; ++i) {
            const size_t row = (size_t)blk * BLK + F.wave + 8 * i;
            const f32x4* xr = (const f32x4*)(F.x + row * DM) + F.lane;
            f32x4 v[4]; float s = 0.f;
#pragma unroll
            for (int j = 0; j < 4; ++j) { v[j] = xr[64 * j]; s += (v[j][0] * v[j][0] + v[j][1] * v[j][1]) + (v[j][2] * v[j][2] + v[j][3] * v[j][3]); }
            const float rs = 1.0f / sqrtf(wave_sum(s) * (1.f / DM) + RMS_EPS);
#pragma unroll
            for (int j = 0; j < 4; ++j) {
                float u[4]; unsigned h[4], l[4];
#pragma unroll
                for (int e = 0; e < 4; ++e) { u[e] = v[j][e] * rs * gv[j][e]; cs[j * 4 + e] += u[e]; h[e] = f2bf(u[e]); l[e] = f2bf(u[e] - __uint_as_float(h[e] << 16)); }
                const int col = 4 * F.lane + 256 * j;
                *(v2u*)(U2 + row * 2048 + col) = (v2u){h[0] | (h[1] << 16), h[2] | (h[3] << 16)};
                *(v2u*)(U2 + row * 2048 + 1024 + col) = (v2u){l[0] | (l[1] << 16), l[2] | (l[3] << 16)};
            }
        }
#pragma unroll
        for (int j = 0; j < 4; ++j)
#pragma unroll
            for (int e = 0; e < 4; ++e) red[F.wave * 1024 + 4 * F.lane + 256 * j + e] = cs[j * 4 + e];
        __syncthreads();
        for (int k = F.tid; k < 1024; k += NTHR) { float s = 0.f;
#pragma unroll
            for (int w = 0; w < 8; ++w) s += red[w * 1024 + k];
            ubar[k] = s * (1.f / BLK); }
        __syncthreads();
        { float s = 0.f; const float* wk = F.w_in + 512 + F.tid;
          for (int k = 0; k < 1024; ++k) s += ubar[k] * wk[(size_t)k * INC];
          kmean[F.tid] = s; }
        __syncthreads();
        { const int b = blk / NBLK, n = blk % NBLK;
          for (int k = F.tid; k < 1024; k += NTHR) { const float* wq = F.w_in + (size_t)k * INC;
              for (int h = 0; h < NH; ++h) { float s = 0.f;
                  for (int d = 0; d < HD; d += 4) { const f32x4 w4 = *(const f32x4*)(wq + h * HD + d); s += w4[0] * kmean[h * HD + d] + w4[1] * kmean[h * HD + d + 1] + w4[2] * kmean[h * HD + d + 2] + w4[3] * kmean[h * HD + d + 3]; }
                  const unsigned hi = f2bf(s), lo = f2bf(s - __uint_as_float(hi << 16));
                  bf16* r0 = WgT + ((size_t)b * 256 + h * 16 + n) * 2048; bf16* r1 = WgT + ((size_t)b * 256 + 128 + h * 16 + n) * 2048;
                  r0[k] = (bf16)hi; r0[1024 + k] = (bf16)hi; r1[k] = (bf16)lo; r1[1024 + k] = (bf16)lo; } } }
        __syncthreads();
    }
}

__device__ __forceinline__ void attn_simple(Frame& F) {
    bf16* QKVZ = (bf16*)(F.ws + WS_QKVZ); const float* GATE = (const float*)(F.ws + WS_GATE);
    LAS float* btab = (LAS float*)F.lds;
    for (int i = F.tid; i < NH * 128; i += NTHR) { const int h = i >> 7, d = i & 127; btab[i] = F.rel_bias[T5B[d] * NH + h] * LOG2E; }
    __syncthreads();
    for (int u = F.vcu; u < BATCH * NH * 8; u += F.G) {
        const int b = u >> 6, h = (u >> 3) & 7, sg = u & 7;
        const int s = sg * 512 + F.tid, qb = s >> 8; const size_t row = (size_t)b * SEQ + s;
        float g0 = -INFINITY, g1 = -INFINITY, g2 = -INFINITY; int i0 = -1, i1 = -1, i2 = -1;
        for (int n = 0; n < qb; ++n) { const float g = GATE[row * 256 + h * 16 + n] + GATE[row * 256 + 128 + h * 16 + n];
            if (g > g0) { g2 = g1; i2 = i1; g1 = g0; i1 = i0; g0 = g; i0 = n; } else if (g > g1) { g2 = g1; i2 = i1; g1 = g; i1 = n; } else if (g > g2) { g2 = g; i2 = n; } }
        float q[64], o[64];
        { const v4u* qp = (const v4u*)(QKVZ + row * 2048 + h * HD);
#pragma unroll
          for (int c = 0; c < 8; ++c) { const v4u w = qp[c];
              q[c * 8 + 0] = __uint_as_float(w.x << 16); q[c * 8 + 1] = __uint_as_float(w.x & 0xffff0000u); q[c * 8 + 2] = __uint_as_float(w.y << 16); q[c * 8 + 3] = __uint_as_float(w.y & 0xffff0000u);
              q[c * 8 + 4] = __uint_as_float(w.z << 16); q[c * 8 + 5] = __uint_as_float(w.z & 0xffff0000u); q[c * 8 + 6] = __uint_as_float(w.w << 16); q[c * 8 + 7] = __uint_as_float(w.w & 0xffff0000u); } }
#pragma unroll
        for (int d = 0; d < 64; ++d) o[d] = 0.f;
        float mx = -INFINITY, l = 0.f;
        for (int pick = 0; pick < 4; ++pick) {
            const int blk = pick == 0 ? qb : (pick == 1 ? i0 : (pick == 2 ? i1 : i2));
            if (blk < 0) continue;
            const int jmax = pick == 0 ? (s & 255) : 255;
            for (int j = 0; j <= jmax; ++j) {
                const int kp = blk * BLK + j; const size_t krow = (size_t)b * SEQ + kp;
                const v4u* kptr = (const v4u*)(QKVZ + krow * 2048 + 512 + h * HD); const v4u* vptr = (const v4u*)(QKVZ + krow * 2048 + 1024 + h * HD);
                float dot = 0.f;
#pragma unroll
                for (int c = 0; c < 8; ++c) { const v4u w = kptr[c];
                    dot += q[c * 8 + 0] * __uint_as_float(w.x << 16) + q[c * 8 + 1] * __uint_as_float(w.x & 0xffff0000u) + q[c * 8 + 2] * __uint_as_float(w.y << 16) + q[c * 8 + 3] * __uint_as_float(w.y & 0xffff0000u)
                         + q[c * 8 + 4] * __uint_as_float(w.z << 16) + q[c * 8 + 5] * __uint_as_float(w.z & 0xffff0000u) + q[c * 8 + 6] * __uint_as_float(w.w << 16) + q[c * 8 + 7] * __uint_as_float(w.w & 0xffff0000u); }
                const int dist = s - kp; const float sc = dot + btab[h * 128 + (dist < 127 ? dist : 127)];
                const float mn = fmaxf(mx, sc), f = exp2f(mx - mn), pw = exp2f(sc - mn);
                l = l * f + pw; mx = mn;
#pragma unroll
                for (int c = 0; c < 8; ++c) { const v4u w = vptr[c];
                    o[c * 8 + 0] = o[c * 8 + 0] * f + pw * __uint_as_float(w.x << 16); o[c * 8 + 1] = o[c * 8 + 1] * f + pw * __uint_as_float(w.x & 0xffff0000u);
                    o[c * 8 + 2] = o[c * 8 + 2] * f + pw * __uint_as_float(w.y << 16); o[c * 8 + 3] = o[c * 8 + 3] * f + pw * __uint_as_float(w.y & 0xffff0000u);
                    o[c * 8 + 4] = o[c * 8 + 4] * f + pw * __uint_as_float(w.z << 16); o[c * 8 + 5] = o[c * 8 + 5] * f + pw * __uint_as_float(w.z & 0xffff0000u);
                    o[c * 8 + 6] = o[c * 8 + 6] * f + pw * __uint_as_float(w.w << 16); o[c * 8 + 7] = o[c * 8 + 7] * f + pw * __uint_as_float(w.w & 0xffff0000u); }
            }
        }
        const float il = 1.0f / l;
        const v4u* zp = (const v4u*)(QKVZ + row * 2048 + 1536 + h * HD); v4u* op = (v4u*)(QKVZ + row * 2048 + h * HD);
#pragma unroll
        for (int c = 0; c < 8; ++c) { const v4u w = zp[c]; float z[8] = {__uint_as_float(w.x << 16), __uint_as_float(w.x & 0xffff0000u), __uint_as_float(w.y << 16), __uint_as_float(w.y & 0xffff0000u),
                                                                     __uint_as_float(w.z << 16), __uint_as_float(w.z & 0xffff0000u), __uint_as_float(w.w << 16), __uint_as_float(w.w & 0xffff0000u)};
            float r[8];
#pragma unroll
            for (int e = 0; e < 8; ++e) r[e] = o[c * 8 + e] * il * z[e] * sigm(z[e]);
            v4u ow; ow.x = pk2(r[0], r[1]); ow.y = pk2(r[2], r[3]); ow.z = pk2(r[4], r[5]); ow.w = pk2(r[6], r[7]); op[c] = ow; }
    }
}

__device__ __forceinline__ void rwkv_simple(Frame& F) {
    const bf16* RW = (const bf16*)(F.ws + WS_RW); bf16* QKVZ = (bf16*)(F.ws + WS_QKVZ);
    LAS float* Wd = (LAS float*)F.lds;
    LAS float* Aa = Wd + 4096;
    LAS float* Bb = Aa + 4096;
    LAS float* Kk = Bb + 4096;
    LAS float* Rr = Kk + 4096;
    LAS float* Vv = Rr + 4096;
    LAS float* TW = Vv + 4096;
    LAS float* TA = TW + 4096;
    LAS float* Bon = TA + 4096;
    LAS float* PR = Bon + 64;
    for (int ch = F.vcu; ch < BATCH * NH; ch += F.G) {
        const int b = ch / NH, h = ch % NH;
        __syncthreads();
        for (int i = F.tid; i < 13 * 64; i += NTHR) { const int a = i >> 6, k = i & 63, col = h * HD + k; float v;
            switch (a) { case 0: v = F.mu[col]; break; case 1: v = F.mu[512 + col]; break; case 2: v = F.mu[1024 + col]; break; case 3: v = F.mu[1536 + col]; break;
                         case 4: v = F.mu[2048 + k]; break; case 5: v = F.mu[2112 + k]; break; case 6: v = F.w0[col]; break; case 7: v = F.a0[col]; break; case 8: v = F.k_k[col]; break;
                         case 9: v = F.k_a[col]; break; case 10: v = F.r_k[col]; break; case 11: v = F.ln_w[col]; break; default: v = F.ln_b[col]; break; }
            PR[i] = v; }
        __syncthreads();
        float S[64];
#pragma unroll
        for (int k = 0; k < 64; ++k) S[k] = 0.f;
        for (int c = 0; c < SEQ / 64; ++c) {
            const int t = F.tid >> 3, kg = F.tid & 7; const int s = c * 64 + t; const size_t row = (size_t)b * SEQ + s;
            const bf16* cur = RW + row * RWC; const bool hasp = s > 0; const bf16* prv = hasp ? cur - RWC : cur; const float pm = hasp ? 1.f : 0.f;
#pragma unroll
            for (int e = 0; e < 8; ++e) { const int j = kg * 8 + e;
                const float cw = bf2f(cur[2048 + j]), pw = pm * bf2f(prv[2048 + j]); TW[t * 64 + j] = tanhf(cw + (pw - cw) * PR[4 * 64 + j]);
                const float ca = bf2f(cur[2112 + j]), pa = pm * bf2f(prv[2112 + j]); TA[t * 64 + j] = ca + (pa - ca) * PR[5 * 64 + j]; }
            __syncthreads();
            float kkv[8]; float nrm = 0.f, bon = 0.f;
            float wpa[8], apa[8];
#pragma unroll
            for (int e = 0; e < 8; ++e) { wpa[e] = PR[6 * 64 + kg * 8 + e]; apa[e] = PR[7 * 64 + kg * 8 + e]; }
#pragma unroll 1
            for (int j = 0; j < 64; ++j) { const float tw = TW[t * 64 + j], ta = TA[t * 64 + j]; const float* wu = F.w_up + j * AW + h * HD + kg * 8; const float* au = F.a_up + j * AW + h * HD + kg * 8;
#pragma unroll
                for (int e = 0; e < 8; ++e) { wpa[e] += tw * wu[e]; apa[e] += ta * au[e]; } }
            const bf16* cb = cur + h * HD + kg * 8; const bf16* pb = prv + h * HD + kg * 8;
#pragma unroll
            for (int e = 0; e < 8; ++e) { const int k = kg * 8 + e;
                const float wp = wpa[e], ap = apa[e];
                const float sp = (-wp > 20.f) ? -wp : log1pf(__expf(-wp));
                const float wlog = -sp - 0.5f; const float dec = __expf(-__expf(wlog));
                const float a = sigm(ap);
                const float cr = bf2f(cb[e]), pr = pm * bf2f(pb[e]); const float r = cr + (pr - cr) * PR[0 * 64 + k];
                const float ck = bf2f(cb[512 + e]), pk = pm * bf2f(pb[512 + e]); const float kx = ck + (pk - ck) * PR[1 * 64 + k];
                const float cv = bf2f(cb[1024 + e]), pv = pm * bf2f(pb[1024 + e]); const float vx = cv + (pv - cv) * PR[2 * 64 + k];
                const float kkx = kx * PR[8 * 64 + k]; nrm += kkx * kkx; kkv[e] = kkx;
                const float kmod = kx * (1.0f + (a - 1.0f) * PR[9 * 64 + k]);
                bon += r * kmod * PR[10 * 64 + k];
                Wd[t * 64 + k] = dec; Rr[t * 64 + k] = r; Vv[t * 64 + k] = vx; Kk[t * 64 + k] = kmod; Bb[t * 64 + k] = a; }
            nrm += __shfl_xor(nrm, 1); nrm += __shfl_xor(nrm, 2); nrm += __shfl_xor(nrm, 4);
            bon += __shfl_xor(bon, 1); bon += __shfl_xor(bon, 2); bon += __shfl_xor(bon, 4);
            const float inv = 1.0f / fmaxf(sqrtf(nrm), 1e-12f);
#pragma unroll
            for (int e = 0; e < 8; ++e) { const int k = kg * 8 + e; const float kn = kkv[e] * inv; Aa[t * 64 + k] = -kn; Bb[t * 64 + k] = kn * Bb[t * 64 + k]; }
            if (kg == 0) Bon[t] = bon;
            __syncthreads();
            if (F.wave == 0) {
                const int v = F.lane; const int col = h * HD + v;
                const float lnw = PR[11 * 64 + v], lnb = PR[12 * 64 + v], muz = PR[3 * 64 + v];
#pragma unroll 1
                for (int tt = 0; tt < 64; ++tt) {
                    const LAS float* aA = Aa + tt * 64; const LAS float* aW = Wd + tt * 64; const LAS float* aB = Bb + tt * 64; const LAS float* aK = Kk + tt * 64; const LAS float* aR = Rr + tt * 64;
                    float sa0 = 0.f, sa1 = 0.f;
#pragma unroll
                    for (int kc = 0; kc < 64; kc += 8) {
#pragma unroll
                        for (int k = kc; k < kc + 8; k += 2) { sa0 += S[k] * aA[k]; sa1 += S[k + 1] * aA[k + 1]; }
                        asm volatile("" ::: "memory"); }
                    const float sa = sa0 + sa1, vv = Vv[tt * 64 + v];
                    float y0 = 0.f, y1 = 0.f;
#pragma unroll
                    for (int kc = 0; kc < 64; kc += 8) {
#pragma unroll
                        for (int k = kc; k < kc + 8; k += 2) {
                            S[k] = S[k] * aW[k] + sa * aB[k] + vv * aK[k]; y0 += S[k] * aR[k];
                            S[k + 1] = S[k + 1] * aW[k + 1] + sa * aB[k + 1] + vv * aK[k + 1]; y1 += S[k + 1] * aR[k + 1]; }
                        asm volatile("" ::: "memory"); }
                    const float y = y0 + y1;
                    const float mean = wave_sum(y) * (1.f / 64.f); const float dy = y - mean; const float var = wave_sum(dy * dy) * (1.f / 64.f);
                    float o = dy * (1.0f / sqrtf(var + GN_EPS)) * lnw + lnb + Bon[tt] * vv;
                    const int ss = c * 64 + tt; const size_t rw = (size_t)b * SEQ + ss;
                    const float cz = bf2f(RW[rw * RWC + 1536 + col]), pz = ss > 0 ? bf2f(RW[(rw - 1) * RWC + 1536 + col]) : 0.f; const float z = cz + (pz - cz) * muz;
                    o *= z * sigm(z);
                    QKVZ[rw * 2048 + 512 + col] = (bf16)f2bf(o);
                }
            }
            __syncthreads();
        }
    }
}

__device__ __forceinline__ void post_norm(Frame& F) {
    const float* Y = (const float*)(F.ws + WS_RW); float* RSY = (float*)(F.ws + WS_RSY); bf16* H1 = (bf16*)(F.ws + WS_QKVZ);
    const int gw = F.vcu * NWAVES + F.wave, NGW = F.G * NWAVES;
    f32x4 gv[4];
#pragma unroll
    for (int j = 0; j < 4; ++j) gv[j] = *((const f32x4*)F.g_post + F.lane + 64 * j);
    for (int row = gw; row < M; row += NGW) {
        const f32x4* yr = (const f32x4*)(Y + (size_t)row * DM) + F.lane; const f32x4* xr = (const f32x4*)(F.x + (size_t)row * DM) + F.lane;
        f32x4 v[4]; float s = 0.f;
#pragma unroll
        for (int j = 0; j < 4; ++j) { v[j] = yr[64 * j]; s += (v[j][0] * v[j][0] + v[j][1] * v[j][1]) + (v[j][2] * v[j][2] + v[j][3] * v[j][3]); }
        const float rs = 1.0f / sqrtf(wave_sum(s) * (1.f / DM) + RMS_EPS);
        if (F.lane == 0) RSY[row] = rs;
#pragma unroll
        for (int j = 0; j < 4; ++j) { const f32x4 xv = xr[64 * j]; float h[4];
#pragma unroll
            for (int e = 0; e < 4; ++e) h[e] = xv[e] + v[j][e] * rs * gv[j][e];
            *(v2u*)(H1 + (size_t)row * DM + 4 * F.lane + 256 * j) = (v2u){pk2(h[0], h[1]), pk2(h[2], h[3])}; }
    }
}
constexpr int LDS_BYTES = 147456;
constexpr int NPHASE = 9;

template <int PLO, int PHI> __global__ void __launch_bounds__(NTHR, 2) fwd(Args args) {
    extern __shared__ __attribute__((aligned(16))) unsigned char lds[];
    Frame F;
    F.lds = (LAS unsigned char*)lds;
#define RETID() do { int t_ = threadIdx.x; asm volatile("" : "+v"(t_)); F.tid = t_; F.lane = t_ & 63; F.wave = __builtin_amdgcn_readfirstlane(t_ >> 6); } while (0)
    RETID();
    F.G = gridDim.x; { const int bx = blockIdx.x; F.vcu = (F.G % 8 == 0) ? (bx % 8) * (F.G / 8) + bx / 8 : bx; }
    F.x = args.in[0]; F.p = args.in[1]; F.g_pre = args.in[2]; F.w_in = args.in[3]; F.rel_bias = args.in[4]; F.mu = args.in[5]; F.w0 = args.in[6]; F.w_up = args.in[7];
    F.a0 = args.in[8]; F.a_up = args.in[9]; F.k_k = args.in[10]; F.k_a = args.in[11]; F.r_k = args.in[12]; F.ln_w = args.in[13]; F.ln_b = args.in[14];
    F.p_a = args.in[15]; F.p_b = args.in[16]; F.w_out = args.in[17]; F.g_post = args.in[18]; F.w_pu = args.in[19]; F.w_pg = args.in[20];
    F.out = args.out; F.ws = args.ws;
    constexpr int lo = PLO, hi = PHI;
    cg::grid_group grid = cg::this_grid();
#define IN(k) (lo <= (k) && (k) < hi)
#define SEAM(k) do { if constexpr (IN(k) && IN((k) + 1)) grid.sync(); } while (0)
    unsigned char* ws = F.ws;
    pg8::bf16_t* U2 = (pg8::bf16_t*)F.out; pg8::bf16_t* MERGED = (pg8::bf16_t*)F.out;
    pg8::bf16_t* QKVZ = (pg8::bf16_t*)(ws + WS_QKVZ); pg8::bf16_t* RWb = (pg8::bf16_t*)(ws + WS_RW); pg8::bf16_t* GAB = (pg8::bf16_t*)(ws + WS_GAB);

    if constexpr (IN(0)) { RETID(); p0_prologue(F); } SEAM(0);
    if constexpr (IN(1)) {
        { pg8::Gemm g{U2, (const pg8::bf16_t*)(ws + WS_WIN), M, INCP, DM, 2048, DM, 0, 0}; pg8::StaticOrder S; S.init(M, INCP, F.G, (int)blockIdx.x);
          pg8::EpiCols E{QKVZ, RWb, GAB, QSCALE};
          pg8::gemm_phase<pg8::EpiCols, pg8::StaticOrder, true, true>(F.lds, g, S, E); }
        { pg8::Gemm g{U2, (const pg8::bf16_t*)(ws + WS_WG), M, 256, 2048, 2048, 2048, 16, (size_t)256 * 2048}; pg8::StaticOrder S; S.init(M, 256, F.G, (int)blockIdx.x);
          pg8::EpiF32 E{(float*)(ws + WS_GATE), 256};
          pg8::gemm_phase<pg8::EpiF32, pg8::StaticOrder, true, true>(F.lds, g, S, E); }
    } SEAM(1);
    if constexpr (IN(2)) { RETID(); attn_simple(F); } SEAM(2);
    if constexpr (IN(3)) { RETID(); rwkv_simple(F); } SEAM(3);
    if constexpr (IN(4)) {
        pg8::Gemm g{QKVZ, (const pg8::bf16_t*)(ws + WS_PAB), M, DM, 512, 2048, 1024, 0, 0}; pg8::StaticOrder S; S.init(M, DM, F.G, (int)blockIdx.x);
        pg8::EpiMerge<false> E{MERGED, DM, GAB, 2048};
        pg8::gemm_phase<pg8::EpiMerge<false>, pg8::StaticOrder, true, true>(F.lds, g, S, E);
    } SEAM(4);
    if constexpr (IN(5)) {
        pg8::Gemm g{QKVZ + 512, (const pg8::bf16_t*)(ws + WS_PAB) + 512, M, DM, 512, 2048, 1024, 0, 0}; pg8::StaticOrder S; S.init(M, DM, F.G, (int)blockIdx.x);
        pg8::EpiMerge<true> E{MERGED, DM, GAB + 1024, 2048};
        pg8::gemm_phase<pg8::EpiMerge<true>, pg8::StaticOrder, true, true>(F.lds, g, S, E);
    } SEAM(5);
    if constexpr (IN(6)) {
        { pg8::Gemm g{MERGED, (const pg8::bf16_t*)(ws + WS_WOUT), M, DM, DM, DM, DM, 0, 0}; pg8::StaticOrder S; S.init(M, DM, F.G, (int)blockIdx.x);
          pg8::EpiF32 E{(float*)(ws + WS_RW), DM};
          pg8::gemm_phase<pg8::EpiF32, pg8::StaticOrder, true, true>(F.lds, g, S, E); }
        { pg8::Gemm g{(const pg8::bf16_t*)(ws + WS_PB), (const pg8::bf16_t*)(ws + WS_WPU), M, DM, PLE, PLE, PLE, 0, 0}; pg8::StaticOrder S; S.init(M, DM, F.G, (int)blockIdx.x);
          pg8::EpiBf16 E{GAB, DM};
          pg8::gemm_phase<pg8::EpiBf16, pg8::StaticOrder, true, true>(F.lds, g, S, E); }
    } SEAM(6);
    if constexpr (IN(7)) { RETID(); post_norm(F); } SEAM(7);
    if constexpr (IN(8)) {
        pg8::Gemm g{QKVZ, (const pg8::bf16_t*)(ws + WS_WPG), M, DM, DM, DM, DM, 0, 0}; pg8::StaticOrder S; S.init(M, DM, F.G, (int)blockIdx.x);
        pg8::EpiFinal E{F.out, F.x, (const float*)(ws + WS_RW), (const float*)(ws + WS_RSY), F.g_post, GAB, DM};
        pg8::gemm_phase<pg8::EpiFinal, pg8::StaticOrder, true, true>(F.lds, g, S, E);
    }
#undef IN
#undef SEAM
}

#ifndef MK_ONE_LAUNCH
#define MK_ONE_LAUNCH 1
#endif
extern "C" void kernel_launch(void* const* d_in, const int* in_sizes, int n_in, void* d_out, int out_size, void* d_ws, size_t ws_size, hipStream_t stream) {
    static int grid = 0;
    if (grid == 0) {
        if (n_in != 21 || out_size != M * DM || ws_size < WS_END) { fprintf(stderr, "kernel_launch: unexpected shapes n_in %d out %d ws %zu\n", n_in, out_size, ws_size); grid = -1; return; }
        int dev = 0, cus = 0, per_cu = 0;
        (void)hipGetDevice(&dev); (void)hipDeviceGetAttribute(&cus, hipDeviceAttributeMultiprocessorCount, dev);
        (void)per_cu;
        grid = cus;
    }
    if (grid < 0) return;
    Args a{};
    for (int i = 0; i < 21; ++i) a.in[i] = (const float*)d_in[i];
    a.out = (float*)d_out; a.ws = (unsigned char*)d_ws;
#if MK_ONE_LAUNCH
    a.ph_lo = 0; a.ph_hi = NPHASE;
    void* kargs[] = {&a};
    (void)hipFuncSetAttribute((const void*)fwd<0, NPHASE>, hipFuncAttributeMaxDynamicSharedMemorySize, LDS_BYTES);
    hipError_t e = hipLaunchCooperativeKernel((const void*)fwd<0, NPHASE>, dim3(grid), dim3(NTHR), kargs, LDS_BYTES, stream);
    if (e != hipSuccess) fprintf(stderr, "cooperative launch failed: %s\n", hipGetErrorString(e));
#else
#define LAUNCH_PH(k) do { (void)hipFuncSetAttribute((const void*)fwd<k, k + 1>, hipFuncAttributeMaxDynamicSharedMemorySize, LDS_BYTES); a.ph_lo = k; a.ph_hi = k + 1; hipLaunchKernelGGL((fwd<k, k + 1>), dim3(grid), dim3(NTHR), LDS_BYTES, stream, a); } while (0)
    LAUNCH_PH(0); LAUNCH_PH(1); LAUNCH_PH(2); LAUNCH_PH(3); LAUNCH_PH(4); LAUNCH_PH(5); LAUNCH_PH(6); LAUNCH_PH(7); LAUNCH_PH(8);
#endif
}
```

```cpp
#include <hip/hip_runtime.h>
#include <hip/hip_cooperative_groups.h>
#include <cstdio>
#include <cstdint>
#include <cmath>
namespace cg = cooperative_groups;
namespace pg8 {
#define PG8_LAS __attribute__((address_space(3)))
typedef unsigned short bf16_t;
typedef short bf16x8 __attribute__((ext_vector_type(8)));
typedef float f32x4 __attribute__((ext_vector_type(4)));
typedef float f32x2 __attribute__((ext_vector_type(2)));
typedef unsigned u32x4 __attribute__((ext_vector_type(4)));
typedef unsigned u32x2 __attribute__((ext_vector_type(2)));
constexpr int BM = 256, BK = 64, HALF = 128, HTB = HALF * BK * 2  , STAGE_BYTES = 8 * HTB, NXCD = 8, WGM = 8;

__host__ __device__ __forceinline__ int lds_byte(int r, int c) { const int st = (r >> 4) * 2 + (c >> 5), rr = r & 15, cc = c & 31, ob = rr * 64 + cc * 2; return st * 1024 + (ob ^ (((ob >> 9) & 1) << 5)); }
__host__ __device__ __forceinline__ void stage_rc(int b, int& R, int& C) { const int st = b / 1024, sb = b % 1024, swz = sb ^ (((sb >> 9) & 1) << 5); R = (st >> 1) * 16 + swz / 64; C = (st & 1) * 32 + (swz % 64) / 2; }
__host__ __device__ __forceinline__ int perm32(int rho) { const int n = rho >> 4, i = rho & 15; return 8 * (i >> 2) + 4 * n + (i & 3); }

struct Unit { int pm, pn; };
struct Gemm { const bf16_t* A; const bf16_t* Bt; int M, N, K, lda, ldb, bdiv; size_t bstride; };

struct StaticOrder {
    int nM, nN, nwg, G, c;
    __host__ __device__ void init(int M, int N, int G_, int c_) { nM = M / BM; nN = N / BM; nwg = nM * nN; G = G_; c = c_; }
    __host__ __device__ bool next(int i, Unit& u) const {
        const long L = (long)i * G + c; if (L >= nwg) return false;
        int wgid = (int)L; { const int q = nwg / NXCD, r = nwg % NXCD, xcd = wgid % NXCD, off = wgid / NXCD; wgid = (xcd < r ? xcd * (q + 1) : r * (q + 1) + (xcd - r) * q) + off; }
        const int nig = WGM * nN, gid = wgid / nig, fm = gid * WGM, gsz = (nM - fm) < WGM ? (nM - fm) : WGM;
        u.pm = fm + ((wgid % nig) % gsz); u.pn = (wgid % nig) / gsz; return true;
    }
};

__device__ __forceinline__ unsigned cvt_pk_bf16(float lo, float hi) { unsigned r; asm volatile("v_cvt_pk_bf16_f32 %0, %1, %2" : "=v"(r) : "v"(lo), "v"(hi)); return r; }
__device__ __forceinline__ float bf_lo(unsigned w) { return __uint_as_float(w << 16); }
__device__ __forceinline__ float bf_hi(unsigned w) { return __uint_as_float(w & 0xffff0000u); }

template <class Epi, class Sched, bool ALIGN_EPI = false, bool SP2 = false>
__device__ __forceinline__ void gemm_phase(PG8_LAS unsigned char* lds, const Gemm g, const Sched& S, const Epi& E) {
    int tid_ = threadIdx.x; asm volatile("" : "+v"(tid_));
    const int tid = tid_, wid = __builtin_amdgcn_readfirstlane(tid >> 6), lane = tid & 63, wr = wid >> 2, wc = wid & 3, fr = lane & 15, fq = lane >> 4;
    const int K = g.K, nt = K / BK;
    unsigned voffA[2], voffB[2];
#pragma unroll
    for (int i = 0; i < 2; ++i) { int R, C; stage_rc(tid * 16 + i * 8192, R, C); const int Rb = Epi::PERM ? ((R & ~31) + perm32(R & 31)) : R;
        voffA[i] = (unsigned)(R * g.lda + C) * 2u; voffB[i] = (unsigned)(Rb * g.ldb + C) * 2u; }
    const size_t kstep = (size_t)(BK * 2);
    const size_t hstepA = (size_t)HALF * g.lda * 2, hstepB = (size_t)HALF * g.ldb * 2;
    const size_t tstepA = 2 * hstepA, tstepB = 2 * hstepB;
    const unsigned ldsw = (unsigned)wid * 1024u;
    const int aoff = lds_byte(wr * 64 + fr, fq * 8), boff = lds_byte(wc * 32 + fr, fq * 8);
#define PG8_SA(b, h) (((b) * 2 + (h)) * HTB)
#define PG8_SB(b, h) ((4 + (b) * 2 + (h)) * HTB)
#define PG8_STAGE(bufoff, gbase, voff) do { _Pragma("unroll") for (int _i = 0; _i < 2; ++_i) \
        __builtin_amdgcn_global_load_lds((const unsigned*)((const char*)(gbase) + (voff)[_i]), (PG8_LAS unsigned*)(lds + (bufoff) + ldsw + _i * 8192), 16, 0, 0); } while (0)
#define PG8_LDA(dst, b, h) do { _Pragma("unroll") for (int m = 0; m < 4; ++m) _Pragma("unroll") for (int k = 0; k < 2; ++k) dst[m][k] = *(const PG8_LAS bf16x8*)(lds + PG8_SA(b, h) + aoff + m * 2048 + k * 1024); } while (0)
#define PG8_LDB(dst, b, h) do { _Pragma("unroll") for (int n = 0; n < 2; ++n) _Pragma("unroll") for (int k = 0; k < 2; ++k) dst[n][k] = *(const PG8_LAS bf16x8*)(lds + PG8_SB(b, h) + boff + n * 2048 + k * 1024); } while (0)
#define PG8_MMA(ai, bj, At, Bt) do { __builtin_amdgcn_s_setprio(1); _Pragma("unroll") for (int m = 0; m < 4; ++m) _Pragma("unroll") for (int n = 0; n < 2; ++n) _Pragma("unroll") for (int k = 0; k < 2; ++k) \
        acc[ai][bj][m][n] = __builtin_amdgcn_mfma_f32_16x16x32_bf16(Bt[n][k], At[m][k], acc[ai][bj][m][n], 0, 0, 0); __builtin_amdgcn_s_setprio(0); } while (0)
#define PG8_WAIT_V(n) asm volatile("s_waitcnt vmcnt(" #n ")" ::: "memory")
#define PG8_WAIT_L(n) asm volatile("s_waitcnt lgkmcnt(" #n ")" ::: "memory")
#define PG8_BAR __builtin_amdgcn_s_barrier()
#define PG8_SCHED __builtin_amdgcn_sched_barrier(0)
#define PG8_BBASE(u) ((const char*)g.Bt + (size_t)(u).pn * tstepB + (g.bdiv ? (size_t)((u).pm / g.bdiv) * g.bstride * 2 : (size_t)0))
    Unit cur, nxt; int ui = 0;
    if (!S.next(0, cur)) return;
    f32x4 acc[2][2][4][2];
#pragma unroll
    for (int a = 0; a < 2; ++a)
#pragma unroll
        for (int b = 0; b < 2; ++b)
#pragma unroll
            for (int m = 0; m < 4; ++m)
#pragma unroll
                for (int n = 0; n < 2; ++n) acc[a][b][m][n] = (f32x4){0.f, 0.f, 0.f, 0.f};
    bf16x8 At[4][2], B0[2][2], B1[2][2];
    const char* cA = (const char*)g.A + (size_t)cur.pm * tstepA; const char* cB = PG8_BBASE(cur);
    if constexpr (SP2) {
        PG8_STAGE(PG8_SB(0, 0), cB, voffB); PG8_STAGE(PG8_SB(0, 1), cB + hstepB, voffB); PG8_STAGE(PG8_SA(0, 0), cA, voffA); PG8_STAGE(PG8_SA(0, 1), cA + hstepA, voffA);
        if (wr == 1) PG8_BAR;
        PG8_WAIT_V(2); PG8_BAR;
        PG8_STAGE(PG8_SB(1, 0), cB + kstep, voffB); PG8_STAGE(PG8_SA(1, 0), cA + kstep, voffA); PG8_STAGE(PG8_SB(1, 1), cB + hstepB + kstep, voffB);
        PG8_WAIT_V(6); PG8_BAR;
    } else {
        PG8_STAGE(PG8_SB(0, 0), cB, voffB); PG8_STAGE(PG8_SA(0, 0), cA, voffA); PG8_STAGE(PG8_SB(0, 1), cB + hstepB, voffB); PG8_STAGE(PG8_SA(0, 1), cA + hstepA, voffA);
        if (wr == 1) PG8_BAR;
        PG8_WAIT_V(4); PG8_BAR;
        PG8_STAGE(PG8_SB(1, 0), cB + kstep, voffB); PG8_STAGE(PG8_SA(1, 0), cA + kstep, voffA); PG8_STAGE(PG8_SB(1, 1), cB + hstepB + kstep, voffB);
        PG8_WAIT_V(6); PG8_BAR;
    }
    for (;;) {
        const bool has_next = S.next(ui + 1, nxt);
        const char* nA = has_next ? (const char*)g.A + (size_t)nxt.pm * tstepA : cA; const char* nB = has_next ? PG8_BBASE(nxt) : cB;
        for (int t = 0; t < nt; t += 2) {
            const bool last = (t == nt - 2);
            const char* a1 = cA + (size_t)(t + 1) * kstep;
            const char* a2 = last ? nA : cA + (size_t)(t + 2) * kstep; const char* b2 = last ? nB : cB + (size_t)(t + 2) * kstep;
            const char* a3 = a2 + kstep; const char* b3 = b2 + kstep;
            if constexpr (SP2) {
            PG8_LDB(B0, 0, 0); PG8_LDB(B1, 0, 1); PG8_SCHED; PG8_LDA(At, 0, 0); PG8_STAGE(PG8_SA(1, 1), a1 + hstepA, voffA);
            PG8_WAIT_V(8); PG8_WAIT_L(0); PG8_BAR; PG8_MMA(0, 0, At, B0); PG8_MMA(0, 1, At, B1); PG8_BAR; PG8_SCHED;
            PG8_LDA(At, 0, 1); PG8_STAGE(PG8_SB(0, 0), b2, voffB); PG8_STAGE(PG8_SB(0, 1), b2 + hstepB, voffB); PG8_STAGE(PG8_SA(0, 0), a2, voffA);
            PG8_WAIT_V(8); PG8_WAIT_L(0); PG8_BAR; PG8_MMA(1, 0, At, B0); PG8_MMA(1, 1, At, B1); PG8_BAR; PG8_SCHED;
            PG8_LDB(B0, 1, 0); PG8_LDB(B1, 1, 1); PG8_SCHED; PG8_LDA(At, 1, 0); PG8_STAGE(PG8_SA(0, 1), a2 + hstepA, voffA);
            PG8_WAIT_V(8); PG8_WAIT_L(0); PG8_BAR; PG8_MMA(0, 0, At, B0); PG8_MMA(0, 1, At, B1); PG8_BAR; PG8_SCHED;
            PG8_LDA(At, 1, 1); PG8_STAGE(PG8_SB(1, 0), b3, voffB); PG8_STAGE(PG8_SB(1, 1), b3 + hstepB, voffB); PG8_STAGE(PG8_SA(1, 0), a3, voffA);
            PG8_WAIT_V(8); PG8_WAIT_L(0); PG8_BAR; PG8_MMA(1, 0, At, B0); PG8_MMA(1, 1, At, B1); PG8_BAR; PG8_SCHED;
            } else {
            PG8_LDB(B0, 0, 0); PG8_SCHED; PG8_LDA(At, 0, 0); PG8_STAGE(PG8_SA(1, 1), a1 + hstepA, voffA);
            PG8_WAIT_L(8); PG8_BAR; PG8_WAIT_L(0); PG8_MMA(0, 0, At, B0); PG8_BAR; PG8_SCHED;
            PG8_LDB(B1, 0, 1); PG8_STAGE(PG8_SB(0, 0), b2, voffB);
            PG8_BAR; PG8_WAIT_L(0); PG8_MMA(0, 1, At, B1); PG8_BAR;
            PG8_LDA(At, 0, 1); PG8_STAGE(PG8_SA(0, 0), a2, voffA);
            PG8_BAR; PG8_WAIT_L(0); PG8_MMA(1, 0, At, B0); PG8_BAR; PG8_SCHED;
            PG8_STAGE(PG8_SB(0, 1), b2 + hstepB, voffB);
            PG8_WAIT_V(6); PG8_BAR; PG8_MMA(1, 1, At, B1); PG8_BAR;
            PG8_LDB(B0, 1, 0); PG8_SCHED; PG8_LDA(At, 1, 0); PG8_STAGE(PG8_SA(0, 1), a2 + hstepA, voffA);
            PG8_WAIT_L(8); PG8_BAR; PG8_WAIT_L(0); PG8_MMA(0, 0, At, B0); PG8_BAR; PG8_SCHED;
            PG8_LDB(B1, 1, 1); PG8_STAGE(PG8_SB(1, 0), b3, voffB);
            PG8_BAR; PG8_WAIT_L(0); PG8_MMA(0, 1, At, B1); PG8_BAR;
            PG8_LDA(At, 1, 1); PG8_STAGE(PG8_SA(1, 0), a3, voffA);
            PG8_BAR; PG8_WAIT_L(0); PG8_MMA(1, 0, At, B0); PG8_BAR; PG8_SCHED;
            PG8_STAGE(PG8_SB(1, 1), b3 + hstepB, voffB);
            PG8_WAIT_V(6); PG8_BAR; PG8_MMA(1, 1, At, B1); PG8_BAR;
            }
        }
        if constexpr (ALIGN_EPI) { if (wr == 0) PG8_BAR; }
        E(acc, cur, wr, wc, fr, fq);
        if (!has_next) break;
#pragma unroll
        for (int a = 0; a < 2; ++a)
#pragma unroll
            for (int b = 0; b < 2; ++b)
#pragma unroll
                for (int m = 0; m < 4; ++m)
#pragma unroll
                    for (int n = 0; n < 2; ++n) acc[a][b][m][n] = (f32x4){0.f, 0.f, 0.f, 0.f};
        cur = nxt; cA = nA; cB = nB; ++ui;
        if constexpr (ALIGN_EPI) { if (wr == 1) PG8_BAR; }
    }
    PG8_WAIT_V(0);
    if constexpr (!ALIGN_EPI) { if (wr == 0) PG8_BAR; }
    PG8_BAR;
#undef PG8_SA
#undef PG8_SB
#undef PG8_STAGE
#undef PG8_LDA
#undef PG8_LDB
#undef PG8_MMA
#undef PG8_WAIT_V
#undef PG8_WAIT_L
#undef PG8_BAR
#undef PG8_SCHED
#undef PG8_BBASE
}
}
namespace pg8 {
__device__ __forceinline__ float sigmoidf_(float x) { return 1.0f / (1.0f + __expf(-x)); }

struct EpiCols {
    static constexpr bool PERM = true;
    bf16_t* qkvz; bf16_t* rw; bf16_t* gab; float qscale;
    __device__ __forceinline__ void operator()(const f32x4 (&acc)[2][2][4][2], const Unit& u, int wr, int wc, int fr, int fq) const {
        const int pn = u.pn; bf16_t* base; int pitch, coff, nbj = 2; float sc = 1.f;
        if (pn < 8) { base = qkvz; pitch = 2048; coff = pn * 256; if (pn < 2) sc = qscale; }
        else if (pn < 16) { base = rw; pitch = 2176; coff = (pn - 8) * 256; }
        else if (pn < 24) { base = gab; pitch = 2048; coff = (pn - 16) * 256; }
        else { base = rw; pitch = 2176; coff = 2048; nbj = 1; }
        const int row0 = u.pm * BM + wr * 64 + fr; const int col0 = coff + wc * 32 + 8 * fq;
#pragma unroll
        for (int ai = 0; ai < 2; ++ai)
#pragma unroll
            for (int m = 0; m < 4; ++m) { bf16_t* rowp = base + (size_t)(row0 + ai * HALF + m * 16) * pitch + col0;
#pragma unroll
                for (int bj = 0; bj < 2; ++bj) { if (bj < nbj) { f32x4 v0 = acc[ai][bj][m][0] * sc, v1 = acc[ai][bj][m][1] * sc;
                    u32x4 w; w.x = cvt_pk_bf16(v0[0], v0[1]); w.y = cvt_pk_bf16(v0[2], v0[3]); w.z = cvt_pk_bf16(v1[0], v1[1]); w.w = cvt_pk_bf16(v1[2], v1[3]);
                    *(u32x4*)(rowp + bj * HALF) = w; } } }
    }
};
struct EpiBf16 {
    static constexpr bool PERM = true;
    bf16_t* O; int ldc;
    __device__ __forceinline__ void operator()(const f32x4 (&acc)[2][2][4][2], const Unit& u, int wr, int wc, int fr, int fq) const {
        const int row0 = u.pm * BM + wr * 64 + fr; const int col0 = u.pn * BM + wc * 32 + 8 * fq;
#pragma unroll
        for (int ai = 0; ai < 2; ++ai)
#pragma unroll
            for (int m = 0; m < 4; ++m) { bf16_t* rowp = O + (size_t)(row0 + ai * HALF + m * 16) * ldc + col0;
#pragma unroll
                for (int bj = 0; bj < 2; ++bj) { const f32x4 v0 = acc[ai][bj][m][0], v1 = acc[ai][bj][m][1];
                    u32x4 w; w.x = cvt_pk_bf16(v0[0], v0[1]); w.y = cvt_pk_bf16(v0[2], v0[3]); w.z = cvt_pk_bf16(v1[0], v1[1]); w.w = cvt_pk_bf16(v1[2], v1[3]);
                    *(u32x4*)(rowp + bj * HALF) = w; } }
    }
};
struct EpiF32 {
    static constexpr bool PERM = false;
    float* O; int ldc;
    __device__ __forceinline__ void operator()(const f32x4 (&acc)[2][2][4][2], const Unit& u, int wr, int wc, int fr, int fq) const {
        const int row0 = u.pm * BM + wr * 64 + fr; const int col0 = u.pn * BM + wc * 32 + 4 * fq;
#pragma unroll
        for (int ai = 0; ai < 2; ++ai)
#pragma unroll
            for (int m = 0; m < 4; ++m) { float* rowp = O + (size_t)(row0 + ai * HALF + m * 16) * ldc + col0;
#pragma unroll
                for (int bj = 0; bj < 2; ++bj)
#pragma unroll
                    for (int n = 0; n < 2; ++n) *(f32x4*)(rowp + bj * HALF + n * 16) = acc[ai][bj][m][n]; }
    }
};
template <bool ADD> struct EpiMerge {
    static constexpr bool PERM = true;
    bf16_t* O; int ldc; const bf16_t* G; int ldg;
    __device__ __forceinline__ void operator()(const f32x4 (&acc)[2][2][4][2], const Unit& u, int wr, int wc, int fr, int fq) const {
        const int row0 = u.pm * BM + wr * 64 + fr; const int col0 = u.pn * BM + wc * 32 + 8 * fq;
#pragma unroll
        for (int ai = 0; ai < 2; ++ai)
#pragma unroll
            for (int m = 0; m < 4; ++m) { const size_t r = (size_t)(row0 + ai * HALF + m * 16);
#pragma unroll
                for (int bj = 0; bj < 2; ++bj) { const f32x4 v0 = acc[ai][bj][m][0], v1 = acc[ai][bj][m][1];
                    const u32x4 gw = *(const u32x4*)(G + r * ldg + col0 + bj * HALF);
                    float o[8];
                    o[0] = sigmoidf_(bf_lo(gw.x)) * v0[0]; o[1] = sigmoidf_(bf_hi(gw.x)) * v0[1]; o[2] = sigmoidf_(bf_lo(gw.y)) * v0[2]; o[3] = sigmoidf_(bf_hi(gw.y)) * v0[3];
                    o[4] = sigmoidf_(bf_lo(gw.z)) * v1[0]; o[5] = sigmoidf_(bf_hi(gw.z)) * v1[1]; o[6] = sigmoidf_(bf_lo(gw.w)) * v1[2]; o[7] = sigmoidf_(bf_hi(gw.w)) * v1[3];
                    bf16_t* op = O + r * ldc + col0 + bj * HALF;
                    if (ADD) { const u32x4 pw = *(const u32x4*)op;
                        o[0] += bf_lo(pw.x); o[1] += bf_hi(pw.x); o[2] += bf_lo(pw.y); o[3] += bf_hi(pw.y); o[4] += bf_lo(pw.z); o[5] += bf_hi(pw.z); o[6] += bf_lo(pw.w); o[7] += bf_hi(pw.w); }
                    u32x4 w; w.x = cvt_pk_bf16(o[0], o[1]); w.y = cvt_pk_bf16(o[2], o[3]); w.z = cvt_pk_bf16(o[4], o[5]); w.w = cvt_pk_bf16(o[6], o[7]);
                    *(u32x4*)op = w; } }
    }
};
struct EpiFinal {
    static constexpr bool PERM = false;
    float* out; const float* x; const float* y; const float* rsy; const float* gpost; const bf16_t* E; int ldc;
    __device__ __forceinline__ void operator()(const f32x4 (&acc)[2][2][4][2], const Unit& u, int wr, int wc, int fr, int fq) const {
        const int row0 = u.pm * BM + wr * 64 + fr; const int col0 = u.pn * BM + wc * 32 + 4 * fq;
#pragma unroll
        for (int ai = 0; ai < 2; ++ai)
#pragma unroll
            for (int m = 0; m < 4; ++m) { const size_t r = (size_t)(row0 + ai * HALF + m * 16); const float rs = rsy[r];
#pragma unroll
                for (int bj = 0; bj < 2; ++bj)
#pragma unroll
                    for (int n = 0; n < 2; ++n) { const int c = col0 + bj * HALF + n * 16; const size_t off = r * ldc + c;
                        const f32x4 xv = *(const f32x4*)(x + off), yv = *(const f32x4*)(y + off), gp = *(const f32x4*)(gpost + c); const u32x2 ew = *(const u32x2*)(E + off);
                        const f32x4 a = acc[ai][bj][m][n]; f32x4 o;
                        o[0] = xv[0] + yv[0] * rs * gp[0] + sigmoidf_(a[0]) * bf_lo(ew.x);
                        o[1] = xv[1] + yv[1] * rs * gp[1] + sigmoidf_(a[1]) * bf_hi(ew.x);
                        o[2] = xv[2] + yv[2] * rs * gp[2] + sigmoidf_(a[2]) * bf_lo(ew.y);
                        o[3] = xv[3] + yv[3] * rs * gp[3] + sigmoidf_(a[3]) * bf_hi(ew.y);
                        *(f32x4*)(out + off) = o; } }
    }
};
}
#define GAS __attribute__((address_space(1)))
#define LAS __attribute__((address_space(3)))
typedef unsigned short bf16;
typedef unsigned v4u __attribute__((ext_vector_type(4)));
typedef unsigned v2u __attribute__((ext_vector_type(2)));
typedef float f32x4 __attribute__((ext_vector_type(4)));

constexpr int NWAVES = 8, NTHR = 512;
constexpr int BATCH = 16, SEQ = 4096, DM = 1024, M = BATCH * SEQ;
constexpr int NH = 8, HD = 64, AW = 512, PLE = 256;
constexpr int RWC = 2176, INC = 6272, INCP = 6400;
constexpr int NBLK = 16, BLK = 256;
constexpr float RMS_EPS = 1e-6f, GN_EPS = 64e-5f;
constexpr float LOG2E = 1.4426950408889634f;
constexpr float QSCALE = 0.125f * LOG2E;

constexpr size_t MiB = 1u << 20;
constexpr size_t WS_WIN = 2 * MiB;
constexpr size_t WS_WG = 16 * MiB;
constexpr size_t WS_PAB = 32 * MiB;
constexpr size_t WS_WOUT = 34 * MiB;
constexpr size_t WS_WPG = 36 * MiB;
constexpr size_t WS_WPU = 38 * MiB;
constexpr size_t WS_RSY = 39 * MiB;
constexpr size_t WS_PB = 42 * MiB;
constexpr size_t WS_GATE = 74 * MiB;
constexpr size_t WS_QKVZ = 138 * MiB;
constexpr size_t WS_RW = 394 * MiB;
constexpr size_t WS_GAB = 666 * MiB;
constexpr size_t WS_END = 922 * MiB;
constexpr size_t WS_CNT = 0;
constexpr size_t WS_QCTR = 16384;
constexpr size_t DO_PARTO = 0, DO_PARTML = 192 * MiB, DO_LISTS = 208 * MiB;

__device__ const unsigned char T5B[128] = {0, 1, 2, 3, 4, 5, 6, 7, 8, 9, 10, 11, 12, 13, 14, 15, 16, 16, 16, 17, 17, 18, 18, 18, 19, 19, 19, 20, 20, 20, 20, 21, 21, 21, 21, 22, 22, 22, 22, 22, 23, 23, 23, 23, 23, 23, 24, 24, 24, 24, 24, 24, 25, 25, 25, 25, 25, 25, 25, 26, 26, 26, 26, 26, 26, 26, 26, 27, 27, 27, 27, 27, 27, 27, 27, 27, 27, 28, 28, 28, 28, 28, 28, 28, 28, 28, 28, 29, 29, 29, 29, 29, 29, 29, 29, 29, 29, 29, 29, 30, 30, 30, 30, 30, 30, 30, 30, 30, 30, 30, 30, 30, 30, 31, 31, 31, 31, 31, 31, 31, 31, 31, 31, 31, 31, 31, 31, 31};

__device__ __forceinline__ unsigned f2bf(float f) { unsigned u = __builtin_bit_cast(unsigned, f); return (u + 0x7fffu + ((u >> 16) & 1u)) >> 16; }
__device__ __forceinline__ unsigned pk2(float lo, float hi) { return f2bf(lo) | (f2bf(hi) << 16); }
__device__ __forceinline__ float bf2f(unsigned short h) { return __uint_as_float((unsigned)h << 16); }
__device__ __forceinline__ float wave_sum(float v) {
#pragma unroll
    for (int o = 1; o < 64; o <<= 1) v += __shfl_xor(v, o);
    return v;
}
__device__ __forceinline__ float sigm(float x) { return 1.0f / (1.0f + __expf(-x)); }

struct Args {
    const float* in[21]; float* out; unsigned char* ws; int ph_lo, ph_hi;
};
struct Frame {
    LAS unsigned char* lds; int tid, lane, wave, vcu, G;
    const float *x, *p, *g_pre, *w_in, *rel_bias, *mu, *w0, *w_up, *a0, *a_up, *k_k, *k_a, *r_k, *ln_w, *ln_b, *p_a, *p_b, *w_out, *g_post, *w_pu, *w_pg;
    float* out; unsigned char* ws;
};

__device__ __forceinline__ void transpose_item(const float* W, int N, int k0, int n0, bf16* WT, int ldw, int drow0, int koff, LAS float* scr, int lane) {
#pragma unroll 8
    for (int i = 0; i < 32; ++i) { const int kk = 2 * i + (lane >> 5); scr[kk * 33 + (lane & 31)] = W[(size_t)(k0 + kk) * N + n0 + (lane & 31)]; }
    asm volatile("s_waitcnt lgkmcnt(0)" ::: "memory");
    const int c = lane & 7;
#pragma unroll
    for (int j = 0; j < 4; ++j) { const int n = (lane >> 3) + 8 * j; const LAS float* s = scr + (8 * c) * 33 + n;
        v4u o; o.x = pk2(s[0 * 33], s[1 * 33]); o.y = pk2(s[2 * 33], s[3 * 33]); o.z = pk2(s[4 * 33], s[5 * 33]); o.w = pk2(s[6 * 33], s[7 * 33]);
        *(v4u*)(WT + (size_t)(drow0 + n) * ldw + koff + k0 + 8 * c) = o; }
    asm volatile("s_waitcnt lgkmcnt(0)" ::: "memory");
}

__device__ __forceinline__ void p0_prologue(Frame& F) {
    if (blockIdx.x == 0) { for (int i = F.tid; i < 2048; i += NTHR) ((unsigned*)(F.ws + WS_CNT))[i] = 0u; if (F.tid == 0) *(unsigned*)(F.ws + WS_QCTR) = 0u; }
    LAS float* scr = (LAS float*)(F.lds + F.wave * 16384);
    const int gw = F.vcu * NWAVES + F.wave, NGW = F.G * NWAVES;
    bf16* WinT = (bf16*)(F.ws + WS_WIN); bf16* PabT = (bf16*)(F.ws + WS_PAB); bf16* WoutT = (bf16*)(F.ws + WS_WOUT); bf16* WpgT = (bf16*)(F.ws + WS_WPG); bf16* WpuT = (bf16*)(F.ws + WS_WPU);
    constexpr int I_IN = 16 * (INC / 32), I_PA = 8 * 32, I_PB = 8 * 32, I_WO = 16 * 32, I_PG = 16 * 32, I_PU = 4 * 32;
    constexpr int NIT = I_IN + I_PA + I_PB + I_WO + I_PG + I_PU;
    for (int it = gw; it < NIT; it += NGW) {
        int r = it;
        if (r < I_IN) { const int nb = r % (INC / 32), kb = r / (INC / 32), n0 = nb * 32;
            const int d0 = n0 < 4096 ? n0 : (n0 < 4224 ? n0 + 2048 : n0 - 128);
            transpose_item(F.w_in, INC, kb * 64, n0, WinT, DM, d0, 0, scr, F.lane); continue; } r -= I_IN;
        if (r < I_PA) { transpose_item(F.p_a, DM, (r / 32) * 64, (r % 32) * 32, PabT, 1024, (r % 32) * 32, 0, scr, F.lane); continue; } r -= I_PA;
        if (r < I_PB) { transpose_item(F.p_b, DM, (r / 32) * 64, (r % 32) * 32, PabT, 1024, (r % 32) * 32, 512, scr, F.lane); continue; } r -= I_PB;
        if (r < I_WO) { transpose_item(F.w_out, DM, (r / 32) * 64, (r % 32) * 32, WoutT, 1024, (r % 32) * 32, 0, scr, F.lane); continue; } r -= I_WO;
        if (r < I_PG) { transpose_item(F.w_pg, DM, (r / 32) * 64, (r % 32) * 32, WpgT, 1024, (r % 32) * 32, 0, scr, F.lane); continue; } r -= I_PG;
        transpose_item(F.w_pu, DM, (r / 32) * 64, (r % 32) * 32, WpuT, 256, (r % 32) * 32, 0, scr, F.lane);
    }
    for (int i = gw * 64 + F.lane; i < 128 * 1024 / 8; i += NGW * 64) *(v4u*)(WinT + (size_t)INC * DM + (size_t)i * 8) = (v4u){0u, 0u, 0u, 0u};
    { bf16* PB = (bf16*)(F.ws + WS_PB); const size_t n8 = (size_t)M * PLE / 8;
      for (size_t i = (size_t)F.vcu * NTHR + F.tid; i < n8; i += (size_t)F.G * NTHR) { const f32x4 a = *(const f32x4*)(F.p + i * 8), b = *(const f32x4*)(F.p + i * 8 + 4);
          v4u o; o.x = pk2(a[0], a[1]); o.y = pk2(a[2], a[3]); o.z = pk2(b[0], b[1]); o.w = pk2(b[2], b[3]); *(v4u*)(PB + i * 8) = o; } }
    __syncthreads();
    LAS float* red = (LAS float*)F.lds;
    LAS float* ubar = (LAS float*)(F.lds + 32768);
    LAS float* kmean = (LAS float*)(F.lds + 36864);
    bf16* U2 = (bf16*)F.out; bf16* WgT = (bf16*)(F.ws + WS_WG);
    for (int blk = F.vcu; blk < M / BLK; blk += F.G) {
        float cs[16];
#pragma unroll
        for (int i = 0; i < 16; ++i) cs[i] = 0.f;
        f32x4 gv[4];
#pragma unroll
        for (int j = 0; j < 4; ++j) gv[j] = *((const f32x4*)F.g_pre + F.lane + 64 * j);
        for (int i = 0; i < 32; ++i) {
            const size_t row = (size_t)blk * BLK + F.wave + 8 * i;
            const f32x4* xr = (const f32x4*)(F.x + row * DM) + F.lane;
            f32x4 v[4]; float s = 0.f;
#pragma unroll
            for (int j = 0; j < 4; ++j) { v[j] = xr[64 * j]; s += (v[j][0] * v[j][0] + v[j][1] * v[j][1]) + (v[j][2] * v[j][2] + v[j][3] * v[j][3]); }
            const float rs = 1.0f / sqrtf(wave_sum(s) * (1.f / DM) + RMS_EPS);
#pragma unroll
            for (int j = 0; j < 4; ++j) {
                float u[4]; unsigned h[4], l[4];
#pragma unroll
                for (int e = 0; e < 4; ++e) { u[e] = v[j][e] * rs * gv[j][e]; cs[j * 4 + e] += u[e]; h[e] = f2bf(u[e]); l[e] = f2bf(u[e] - __uint_as_float(h[e] << 16)); }
                const int col = 4 * F.lane + 256 * j;
                *(v2u*)(U2 + row * 2048 + col) = (v2u){h[0] | (h[1] << 16), h[2] | (h[3] << 16)};
                *(v2u*)(U2 + row * 2048 + 1024 + col) = (v2u){l[0] | (l[1] << 16), l[2] | (l[3] << 16)};
            }
        }
#pragma unroll
        for (int j = 0; j < 4; ++j)
#pragma unroll
            for (int e = 0; e < 4; ++e) red[F.wave * 1024 + 4 * F.lane + 256 * j + e] = cs[j * 4 + e];
        __syncthreads();
        for (int k = F.tid; k < 1024; k += NTHR) { float s = 0.f;
#pragma unroll
            for (int w = 0; w < 8; ++w) s += red[w * 1024 + k];
            ubar[k] = s * (1.f / BLK); }
        __syncthreads();
        { float s = 0.f; const float* wk = F.w_in + 512 + F.tid;
          for (int k = 0; k < 1024; ++k) s += ubar[k] * wk[(size_t)k * INC];
          kmean[F.tid] = s; }
        __syncthreads();
        { const int b = blk / NBLK, n = blk % NBLK;
          for (int k = F.tid; k < 1024; k += NTHR) { const float* wq = F.w_in + (size_t)k * INC;
              for (int h = 0; h < NH; ++h) { float s = 0.f;
                  for (int d = 0; d < HD; d += 4) { const f32x4 w4 = *(const f32x4*)(wq + h * HD + d); s += w4[0] * kmean[h * HD + d] + w4[1] * kmean[h * HD + d + 1] + w4[2] * kmean[h * HD + d + 2] + w4[3] * kmean[h * HD + d + 3]; }
                  const unsigned hi = f2bf(s), lo = f2bf(s - __uint_as_float(hi << 16));
                  bf16* r0 = WgT + ((size_t)b * 256 + h * 16 + n) * 2048; bf16* r1 = WgT + ((size_t)b * 256 + 128 + h * 16 + n) * 2048;
                  r0[k] = (bf16)hi; r0[1024 + k] = (bf16)hi; r1[k] = (bf16)lo; r1[1024 + k] = (bf16)lo; } } }
        __syncthreads();
    }
}

__device__ __forceinline__ void rwkv_simple(Frame& F) {
    const bf16* RW = (const bf16*)(F.ws + WS_RW); bf16* QKVZ = (bf16*)(F.ws + WS_QKVZ);
    LAS float* Wd = (LAS float*)F.lds;
    LAS float* Aa = Wd + 4096;
    LAS float* Bb = Aa + 4096;
    LAS float* Kk = Bb + 4096;
    LAS float* Rr = Kk + 4096;
    LAS float* Vv = Rr + 4096;
    LAS float* TW = Vv + 4096;
    LAS float* TA = TW + 4096;
    LAS float* Bon = TA + 4096;
    LAS float* PR = Bon + 64;
    for (int ch = F.vcu; ch < BATCH * NH; ch += F.G) {
        const int b = ch / NH, h = ch % NH;
        __syncthreads();
        for (int i = F.tid; i < 13 * 64; i += NTHR) { const int a = i >> 6, k = i & 63, col = h * HD + k; float v;
            switch (a) { case 0: v = F.mu[col]; break; case 1: v = F.mu[512 + col]; break; case 2: v = F.mu[1024 + col]; break; case 3: v = F.mu[1536 + col]; break;
                         case 4: v = F.mu[2048 + k]; break; case 5: v = F.mu[2112 + k]; break; case 6: v = F.w0[col]; break; case 7: v = F.a0[col]; break; case 8: v = F.k_k[col]; break;
                         case 9: v = F.k_a[col]; break; case 10: v = F.r_k[col]; break; case 11: v = F.ln_w[col]; break; default: v = F.ln_b[col]; break; }
            PR[i] = v; }
        __syncthreads();
        float S[64];
#pragma unroll
        for (int k = 0; k < 64; ++k) S[k] = 0.f;
        for (int c = 0; c < SEQ / 64; ++c) {
            const int t = F.tid >> 3, kg = F.tid & 7; const int s = c * 64 + t; const size_t row = (size_t)b * SEQ + s;
            const bf16* cur = RW + row * RWC; const bool hasp = s > 0; const bf16* prv = hasp ? cur - RWC : cur; const float pm = hasp ? 1.f : 0.f;
#pragma unroll
            for (int e = 0; e < 8; ++e) { const int j = kg * 8 + e;
                const float cw = bf2f(cur[2048 + j]), pw = pm * bf2f(prv[2048 + j]); TW[t * 64 + j] = tanhf(cw + (pw - cw) * PR[4 * 64 + j]);
                const float ca = bf2f(cur[2112 + j]), pa = pm * bf2f(prv[2112 + j]); TA[t * 64 + j] = ca + (pa - ca) * PR[5 * 64 + j]; }
            __syncthreads();
            float kkv[8]; float nrm = 0.f, bon = 0.f;
            float wpa[8], apa[8];
#pragma unroll
            for (int e = 0; e < 8; ++e) { wpa[e] = PR[6 * 64 + kg * 8 + e]; apa[e] = PR[7 * 64 + kg * 8 + e]; }
#pragma unroll 1
            for (int j = 0; j < 64; ++j) { const float tw = TW[t * 64 + j], ta = TA[t * 64 + j]; const float* wu = F.w_up + j * AW + h * HD + kg * 8; const float* au = F.a_up + j * AW + h * HD + kg * 8;
#pragma unroll
                for (int e = 0; e < 8; ++e) { wpa[e] += tw * wu[e]; apa[e] += ta * au[e]; } }
            const bf16* cb = cur + h * HD + kg * 8; const bf16* pb = prv + h * HD + kg * 8;
#pragma unroll
            for (int e = 0; e < 8; ++e) { const int k = kg * 8 + e;
                const float wp = wpa[e], ap = apa[e];
                const float sp = (-wp > 20.f) ? -wp : log1pf(__expf(-wp));
                const float wlog = -sp - 0.5f; const float dec = __expf(-__expf(wlog));
                const float a = sigm(ap);
                const float cr = bf2f(cb[e]), pr = pm * bf2f(pb[e]); const float r = cr + (pr - cr) * PR[0 * 64 + k];
                const float ck = bf2f(cb[512 + e]), pk = pm * bf2f(pb[512 + e]); const float kx = ck + (pk - ck) * PR[1 * 64 + k];
                const float cv = bf2f(cb[1024 + e]), pv = pm * bf2f(pb[1024 + e]); const float vx = cv + (pv - cv) * PR[2 * 64 + k];
                const float kkx = kx * PR[8 * 64 + k]; nrm += kkx * kkx; kkv[e] = kkx;
                const float kmod = kx * (1.0f + (a - 1.0f) * PR[9 * 64 + k]);
                bon += r * kmod * PR[10 * 64 + k];
                Wd[t * 64 + k] = dec; Rr[t * 64 + k] = r; Vv[t * 64 + k] = vx; Kk[t * 64 + k] = kmod; Bb[t * 64 + k] = a; }
            nrm += __shfl_xor(nrm, 1); nrm += __shfl_xor(nrm, 2); nrm += __shfl_xor(nrm, 4);
            bon += __shfl_xor(bon, 1); bon += __shfl_xor(bon, 2); bon += __shfl_xor(bon, 4);
            const float inv = 1.0f / fmaxf(sqrtf(nrm), 1e-12f);
#pragma unroll
            for (int e = 0; e < 8; ++e) { const int k = kg * 8 + e; const float kn = kkv[e] * inv; Aa[t * 64 + k] = -kn; Bb[t * 64 + k] = kn * Bb[t * 64 + k]; }
            if (kg == 0) Bon[t] = bon;
            __syncthreads();
            if (F.wave == 0) {
                const int v = F.lane; const int col = h * HD + v;
                const float lnw = PR[11 * 64 + v], lnb = PR[12 * 64 + v], muz = PR[3 * 64 + v];
#pragma unroll 1
                for (int tt = 0; tt < 64; ++tt) {
                    const LAS float* aA = Aa + tt * 64; const LAS float* aW = Wd + tt * 64; const LAS float* aB = Bb + tt * 64; const LAS float* aK = Kk + tt * 64; const LAS float* aR = Rr + tt * 64;
                    float sa0 = 0.f, sa1 = 0.f;
#pragma unroll
                    for (int kc = 0; kc < 64; kc += 8) {
#pragma unroll
                        for (int k = kc; k < kc + 8; k += 2) { sa0 += S[k] * aA[k]; sa1 += S[k + 1] * aA[k + 1]; }
                        asm volatile("" ::: "memory"); }
                    const float sa = sa0 + sa1, vv = Vv[tt * 64 + v];
                    float y0 = 0.f, y1 = 0.f;
#pragma unroll
                    for (int kc = 0; kc < 64; kc += 8) {
#pragma unroll
                        for (int k = kc; k < kc + 8; k += 2) {
                            S[k] = S[k] * aW[k] + sa * aB[k] + vv * aK[k]; y0 += S[k] * aR[k];
                            S[k + 1] = S[k + 1] * aW[k + 1] + sa * aB[k + 1] + vv * aK[k + 1]; y1 += S[k + 1] * aR[k + 1]; }
                        asm volatile("" ::: "memory"); }
                    const float y = y0 + y1;
                    const float mean = wave_sum(y) * (1.f / 64.f); const float dy = y - mean; const float var = wave_sum(dy * dy) * (1.f / 64.f);
                    float o = dy * (1.0f / sqrtf(var + GN_EPS)) * lnw + lnb + Bon[tt] * vv;
                    const int ss = c * 64 + tt; const size_t rw = (size_t)b * SEQ + ss;
                    const float cz = bf2f(RW[rw * RWC + 1536 + col]), pz = ss > 0 ? bf2f(RW[(rw - 1) * RWC + 1536 + col]) : 0.f; const float z = cz + (pz - cz) * muz;
                    o *= z * sigm(z);
                    QKVZ[rw * 2048 + 512 + col] = (bf16)f2bf(o);
                }
            }
            __syncthreads();
        }
    }
}

__device__ __forceinline__ void post_norm(Frame& F) {
    const float* Y = (const float*)(F.ws + WS_RW); float* RSY = (float*)(F.ws + WS_RSY); bf16* H1 = (bf16*)(F.ws + WS_QKVZ);
    const int gw = F.vcu * NWAVES + F.wave, NGW = F.G * NWAVES;
    f32x4 gv[4];
#pragma unroll
    for (int j = 0; j < 4; ++j) gv[j] = *((const f32x4*)F.g_post + F.lane + 64 * j);
    for (int row = gw; row < M; row += NGW) {
        const f32x4* yr = (const f32x4*)(Y + (size_t)row * DM) + F.lane; const f32x4* xr = (const f32x4*)(F.x + (size_t)row * DM) + F.lane;
        f32x4 v[4]; float s = 0.f;
#pragma unroll
        for (int j = 0; j < 4; ++j) { v[j] = yr[64 * j]; s += (v[j][0] * v[j][0] + v[j][1] * v[j][1]) + (v[j][2] * v[j][2] + v[j][3] * v[j][3]); }
        const float rs = 1.0f / sqrtf(wave_sum(s) * (1.f / DM) + RMS_EPS);
        if (F.lane == 0) RSY[row] = rs;
#pragma unroll
        for (int j = 0; j < 4; ++j) { const f32x4 xv = xr[64 * j]; float h[4];
#pragma unroll
            for (int e = 0; e < 4; ++e) h[e] = xv[e] + v[j][e] * rs * gv[j][e];
            *(v2u*)(H1 + (size_t)row * DM + 4 * F.lane + 256 * j) = (v2u){pk2(h[0], h[1]), pk2(h[2], h[3])}; }
    }
}
namespace moba {
using bf16x8 = __attribute__((ext_vector_type(8))) short;
using s16x4 = __attribute__((ext_vector_type(4))) short;
using f32x16 = __attribute__((ext_vector_type(16))) float;
using u32x4 = __attribute__((ext_vector_type(4))) unsigned;
typedef short v4i16_t __attribute__((ext_vector_type(4)));
typedef float f32x2_t __attribute__((ext_vector_type(2))); typedef __bf16 bf16x2_t __attribute__((ext_vector_type(2)));
__device__ __forceinline__ int crow(int r, int hi) { return (r & 3) + 8 * (r >> 2) + 4 * hi; }
__device__ __forceinline__ unsigned cvtpk(float lo, float hi) { f32x2_t v = {lo, hi}; bf16x2_t b = __builtin_convertvector(v, bf16x2_t); return __builtin_bit_cast(unsigned, b); }
__device__ __forceinline__ float max3f(float a, float b, float c) { return fmaxf(fmaxf(a, b), c); }

constexpr int SLOTB = 8192;
__device__ __forceinline__ void qkt(f32x16& p0, f32x16& p1, const LAS unsigned char* Kslot, const bf16x8* qr, int r32, int hi) {
    const LAS unsigned char* kb = Kslot + hi * 1024 + r32 * 16;
    const f32x16 z = {};
#pragma unroll
    for (int d0 = 0; d0 < 4; ++d0) {
        const bf16x8 b0 = *(const LAS bf16x8*)(kb + d0 * 2048);
        const bf16x8 b1 = *(const LAS bf16x8*)(kb + d0 * 2048 + 512);
        if (d0 == 0) { p0 = __builtin_amdgcn_mfma_f32_32x32x16_bf16(b0, qr[0], z, 0, 0, 0); p1 = __builtin_amdgcn_mfma_f32_32x32x16_bf16(b1, qr[0], z, 0, 0, 0); }
        else { p0 = __builtin_amdgcn_mfma_f32_32x32x16_bf16(b0, qr[d0], p0, 0, 0, 0); p1 = __builtin_amdgcn_mfma_f32_32x32x16_bf16(b1, qr[d0], p1, 0, 0, 0); } }
}
__device__ __forceinline__ void pv(f32x16* o, int vb, bf16x8 pa0, bf16x8 pa1, bf16x8 pa2, bf16x8 pa3) {
#pragma unroll
    for (int d0 = 0; d0 < 2; ++d0) { s16x4 lo[4], hi[4];
#pragma unroll
        for (int ks = 0; ks < 4; ++ks) {
            asm volatile("ds_read_b64_tr_b16 %0,%1 offset:%c2" : "=&v"(lo[ks]) : "v"(vb), "i"(d0 * 4096 + ks * 1024) : "memory");
            asm volatile("ds_read_b64_tr_b16 %0,%1 offset:%c2" : "=&v"(hi[ks]) : "v"(vb), "i"(d0 * 4096 + ks * 1024 + 512) : "memory"); }
        asm volatile("s_waitcnt lgkmcnt(0)" ::: "memory"); __builtin_amdgcn_sched_barrier(0);
#define PK(k) (bf16x8){lo[k][0], lo[k][1], lo[k][2], lo[k][3], hi[k][0], hi[k][1], hi[k][2], hi[k][3]}
        o[d0] = __builtin_amdgcn_mfma_f32_32x32x16_bf16(pa0, PK(0), o[d0], 0, 0, 0);
        o[d0] = __builtin_amdgcn_mfma_f32_32x32x16_bf16(pa1, PK(1), o[d0], 0, 0, 0);
        o[d0] = __builtin_amdgcn_mfma_f32_32x32x16_bf16(pa2, PK(2), o[d0], 0, 0, 0);
        o[d0] = __builtin_amdgcn_mfma_f32_32x32x16_bf16(pa3, PK(3), o[d0], 0, 0, 0);
#undef PK
    }
}
__device__ __forceinline__ float rowmax2(const f32x16& p0, const f32x16& p1, float a) {
#pragma unroll
    for (int r = 0; r < 16; r += 2) { a = max3f(a, p0[r], p0[r + 1]); a = max3f(a, p1[r], p1[r + 1]); }
    return a;
}
__device__ __forceinline__ float swapmax(float m) { auto rr = __builtin_amdgcn_permlane32_swap(__float_as_uint(m), __float_as_uint(m), false, false); return fmaxf(__uint_as_float(rr[0]), __uint_as_float(rr[1])); }
__device__ __forceinline__ float swapsum(float m) { auto rr = __builtin_amdgcn_permlane32_swap(__float_as_uint(m), __float_as_uint(m), false, false); return __uint_as_float(rr[0]) + __uint_as_float(rr[1]); }

__device__ __forceinline__ void load_kv_block(LAS unsigned char* lds, int KOFF, int VOFF, const bf16* QKVZ, size_t krow0, int h, int wid, int lane) {
    const bf16* ksrc = QKVZ + (krow0 + lane) * 2048 + 512 + h * HD + wid * 8;
    const bf16* vsrc = QKVZ + (krow0 + 16 * (wid & 3) + (lane >> 2)) * 2048 + 1024 + h * HD + (wid >> 2) * 32 + (lane & 3) * 8;
#pragma unroll
    for (int t = 0; t < 4; ++t) {
        __builtin_amdgcn_global_load_lds((const unsigned*)(ksrc + (size_t)t * 64 * 2048), (LAS unsigned*)(lds + KOFF + t * SLOTB + wid * 1024), 16, 0, 0);
        __builtin_amdgcn_global_load_lds((const unsigned*)(vsrc + (size_t)t * 64 * 2048), (LAS unsigned*)(lds + VOFF + t * SLOTB + wid * 1024), 16, 0, 0); }
}
}

constexpr int LIST_CAP = 3840;

__device__ __forceinline__ void attn_select(Frame& F, const float* GATE, unsigned* CNT, unsigned short* LISTS) {
    const int gw = F.vcu * NWAVES + F.wave, NGW = F.G * NWAVES;
    for (int it = gw; it < BATCH * NH * (SEQ / 64); it += NGW) {
        const int sg = it % (SEQ / 64), h = (it / (SEQ / 64)) % NH, b = it / (SEQ / 64 * NH);
        const int s = sg * 64 + F.lane, qb = s >> 8; const size_t row = (size_t)b * SEQ + s;
        if (qb == 0) continue;
        float g0 = -INFINITY, g1 = -INFINITY, g2 = -INFINITY; int i0 = -1, i1 = -1, i2 = -1;
        const f32x4* gp = (const f32x4*)(GATE + row * 256 + h * 16); const f32x4* gl = (const f32x4*)(GATE + row * 256 + 128 + h * 16);
#pragma unroll
        for (int c = 0; c < 4; ++c) { const f32x4 a = gp[c], l = gl[c];
#pragma unroll
            for (int e = 0; e < 4; ++e) { const int n = c * 4 + e; const float g = (n < qb) ? a[e] + l[e] : -INFINITY;
                if (g > g0) { g2 = g1; i2 = i1; g1 = g0; i1 = i0; g0 = g; i0 = n; } else if (g > g1) { g2 = g1; i2 = i1; g1 = g; i1 = n; } else if (g > g2) { g2 = g; i2 = n; } } }
        unsigned* cnt = CNT + (b * NH + h) * 16; unsigned short* lst = LISTS + (size_t)(b * NH + h) * 16 * LIST_CAP;
        for (int n = 0; n < qb; ++n) {
            const int slot = (i0 == n) ? 0 : ((i1 == n) ? 1 : ((i2 == n) ? 2 : -1));
            const unsigned long long mask = __ballot(slot >= 0);
            if (mask == 0ull) continue;
            const int before = __builtin_amdgcn_mbcnt_hi((unsigned)(mask >> 32), __builtin_amdgcn_mbcnt_lo((unsigned)mask, 0u));
            unsigned base = 0u;
            if (F.lane == 0) base = atomicAdd(cnt + n, (unsigned)__popcll(mask));
            base = __builtin_amdgcn_readfirstlane(base);
            if (slot >= 0) lst[(size_t)n * LIST_CAP + base + before] = (unsigned short)(s | (slot << 12));
        }
    }
}

__device__ __forceinline__ void attn_partial(Frame& F, const bf16* QKVZ, const unsigned* CNT, const unsigned short* LISTS, bf16* PART_O, float* PART_ML, unsigned* QCTR) {
    using namespace moba;
    LAS unsigned char* lds = F.lds; const int wid = F.wave, lane = F.lane, r32 = lane & 31, hi = lane >> 5;
    LAS float* btab = (LAS float*)(lds + 102400); LAS unsigned* uword = (LAS unsigned*)(lds + 106496);
    LAS float* wsf = (LAS float*)(lds + 98304) + wid * 128; LAS bf16* stg = (LAS bf16*)(lds + 65536) + wid * 2048;
    for (int i = F.tid; i < NH * 128; i += NTHR) { const int h = i >> 7, d = i & 127; btab[i] = (F.rel_bias[T5B[d] * NH + h] - F.rel_bias[31 * NH + h]) * LOG2E; }
    const int vb0 = (int)(uintptr_t)(lds + 32768) + ((lane >> 4) & 1) * 32 + (lane & 3) * 8 + (4 * hi + ((lane & 15) >> 2)) * 64;
    const int NUNIT = BATCH * NH * 15;
    for (;;) {
        __syncthreads();
        if (F.tid == 0) uword[0] = atomicAdd(QCTR, 1u);
        __syncthreads();
        const int u = (int)uword[0];
        if (u >= NUNIT) break;
        const int n = u / (BATCH * NH), bh = u % (BATCH * NH), b = bh / NH, h = bh % NH;
        load_kv_block(lds, 0, 32768, QKVZ, (size_t)b * SEQ + n * BLK, h, wid, lane);
        const int cnt = (int)CNT[bh * 16 + n]; const unsigned short* lst = LISTS + ((size_t)bh * 16 + n) * LIST_CAP;
        const float b31 = F.rel_bias[31 * NH + h] * LOG2E;
        __syncthreads();
        const int ntile = (cnt + 31) >> 5;
        for (int tile = wid; tile < ntile; tile += NWAVES) {
            const int idx = tile * 32 + r32; const bool valid = idx < cnt;
            const unsigned e = lst[valid ? idx : 0]; const int s = e & 4095, slot = e >> 12; const size_t row = (size_t)b * SEQ + s;
            bf16x8 qr[4];
#pragma unroll
            for (int d0 = 0; d0 < 4; ++d0) qr[d0] = *(const bf16x8*)(QKVZ + row * 2048 + h * HD + d0 * 16 + hi * 8);
            f32x16 p[4][2];
#pragma unroll
            for (int t = 0; t < 4; ++t) qkt(p[t][0], p[t][1], lds + t * SLOTB, qr, r32, hi);
            const bool near = ((s >> 8) == n + 1);
            if (__any(near)) {
                const int dbase = near ? (s - (n * BLK + 128)) : 100000;
#pragma unroll
                for (int t = 2; t < 4; ++t)
#pragma unroll
                    for (int r = 0; r < 16; ++r) { const int kv = (t - 2) * 64 + crow(r, hi); int d0 = dbase - kv, d1 = d0 - 32; d0 = d0 > 127 ? 127 : d0; d1 = d1 > 127 ? 127 : d1;
                        p[t][0][r] += btab[h * 128 + d0]; p[t][1][r] += btab[h * 128 + d1]; }
            }
            float mx = -INFINITY;
#pragma unroll
            for (int t = 0; t < 4; ++t) mx = rowmax2(p[t][0], p[t][1], mx);
            mx = swapmax(mx);
            float l = 0.f;
#pragma unroll
            for (int t = 0; t < 4; ++t)
#pragma unroll
                for (int r = 0; r < 16; ++r) { p[t][0][r] = exp2f(p[t][0][r] - mx); p[t][1][r] = exp2f(p[t][1][r] - mx); l += p[t][0][r] + p[t][1][r]; }
            l = swapsum(l);
            f32x16 o[2]; o[0] = f32x16{}; o[1] = f32x16{};
#pragma unroll
            for (int t = 0; t < 4; ++t) {
                u32x4 w0, w1, w2, w3;
                w0 = (u32x4){cvtpk(p[t][0][0], p[t][0][1]), cvtpk(p[t][0][2], p[t][0][3]), cvtpk(p[t][0][4], p[t][0][5]), cvtpk(p[t][0][6], p[t][0][7])};
                w1 = (u32x4){cvtpk(p[t][0][8], p[t][0][9]), cvtpk(p[t][0][10], p[t][0][11]), cvtpk(p[t][0][12], p[t][0][13]), cvtpk(p[t][0][14], p[t][0][15])};
                w2 = (u32x4){cvtpk(p[t][1][0], p[t][1][1]), cvtpk(p[t][1][2], p[t][1][3]), cvtpk(p[t][1][4], p[t][1][5]), cvtpk(p[t][1][6], p[t][1][7])};
                w3 = (u32x4){cvtpk(p[t][1][8], p[t][1][9]), cvtpk(p[t][1][10], p[t][1][11]), cvtpk(p[t][1][12], p[t][1][13]), cvtpk(p[t][1][14], p[t][1][15])};
                pv(o, vb0 + t * SLOTB, __builtin_bit_cast(bf16x8, w0), __builtin_bit_cast(bf16x8, w1), __builtin_bit_cast(bf16x8, w2), __builtin_bit_cast(bf16x8, w3));
            }
            if (hi == 0) { wsf[r32] = 1.0f / l; ((LAS int*)wsf)[32 + r32] = valid ? (int)(((row * NH + h) * 3 + slot)) : -1;
                           if (valid) { float2 ml; ml.x = mx + b31; ml.y = l; *(float2*)(PART_ML + ((row * NH + h) * 3 + slot) * 2) = ml; } }
            asm volatile("s_waitcnt lgkmcnt(0)" ::: "memory");
#pragma unroll
            for (int r = 0; r < 16; ++r) { const int orow = crow(r, hi); const float il = wsf[orow];
#pragma unroll
                for (int d0 = 0; d0 < 2; ++d0) stg[orow * 64 + d0 * 32 + r32] = (bf16)f2bf(o[d0][r] * il); }
            asm volatile("s_waitcnt lgkmcnt(0)" ::: "memory");
#pragma unroll
            for (int i = 0; i < 4; ++i) { const int rr = i * 8 + (lane >> 3), ch = lane & 7; const int dst = ((LAS int*)wsf)[32 + rr];
                const u32x4 v = *(const LAS u32x4*)(stg + rr * 64 + ch * 8);
                if (dst >= 0) *(u32x4*)(PART_O + (size_t)dst * 64 + ch * 8) = v; }
            asm volatile("s_waitcnt lgkmcnt(0)" ::: "memory");
        }
    }
}

__device__ __forceinline__ void attn_own_combine(Frame& F, bf16* QKVZ, const bf16* PART_O, const float* PART_ML) {
    using namespace moba;
    LAS unsigned char* lds = F.lds; const int wid = F.wave, lane = F.lane, r32 = lane & 31, hi = lane >> 5;
    LAS float* btab = (LAS float*)(lds + 139264);
    LAS float* wsf = (LAS float*)(lds + 135168) + wid * 128; LAS float* ost = (LAS float*)(lds + 65536 + wid * 8704);
    __syncthreads();
    for (int i = F.tid; i < NH * 256; i += NTHR) { const int h = i >> 8, d = i & 255; btab[i] = F.rel_bias[T5B[d < 127 ? d : 127] * NH + h] * LOG2E; }
    const int vb0 = (int)(uintptr_t)(lds + 32768) + ((lane >> 4) & 1) * 32 + (lane & 3) * 8 + (4 * hi + ((lane & 15) >> 2)) * 64;
    for (int u = F.vcu; u < BATCH * NH * NBLK; u += F.G) {
        const int qb = u % NBLK, bh = u / NBLK, b = bh / NH, h = bh % NH;
        __syncthreads();
        load_kv_block(lds, 0, 32768, QKVZ, (size_t)b * SEQ + qb * BLK, h, wid, lane);
        const int sq = qb * BLK + wid * 32 + r32; const size_t row = (size_t)b * SEQ + sq;
        bf16x8 qr[4];
#pragma unroll
        for (int d0 = 0; d0 < 4; ++d0) qr[d0] = *(const bf16x8*)(QKVZ + row * 2048 + h * HD + d0 * 16 + hi * 8);
        __syncthreads();
        const int nt = (wid >> 1) + 1;
        int ql = wid * 32 + r32;
        asm volatile("" : "+v"(ql));
        f32x16 p[4][2];
        float mx = -INFINITY;
#pragma unroll
        for (int t = 0; t < 4; ++t) if (t < nt) {
            qkt(p[t][0], p[t][1], lds + t * SLOTB, qr, r32, hi);
            const LAS float* bt = btab + h * 256;
            if (t < nt - 1) {
#pragma unroll
                for (int r = 0; r < 16; ++r) { const int kv = t * 64 + crow(r, hi); const int d0 = ql - kv, d1 = d0 - 32;
                    p[t][0][r] += bt[d0]; p[t][1][r] += bt[d1]; }
            } else {
#pragma unroll
                for (int r = 0; r < 16; ++r) { const int kv = t * 64 + crow(r, hi); const int d0 = ql - kv, d1 = d0 - 32;
                    const float b0 = bt[d0 < 0 ? 0 : d0], b1 = bt[d1 < 0 ? 0 : d1];
                    p[t][0][r] = d0 >= 0 ? p[t][0][r] + b0 : -INFINITY; p[t][1][r] = d1 >= 0 ? p[t][1][r] + b1 : -INFINITY; }
            }
            mx = rowmax2(p[t][0], p[t][1], mx);
        }
        mx = swapmax(mx);
        float l = 0.f;
        f32x16 o[2]; o[0] = f32x16{}; o[1] = f32x16{};
#pragma unroll
        for (int t = 0; t < 4; ++t) if (t < nt) {
#pragma unroll
            for (int r = 0; r < 16; ++r) { p[t][0][r] = exp2f(p[t][0][r] - mx); p[t][1][r] = exp2f(p[t][1][r] - mx); l += p[t][0][r] + p[t][1][r]; }
            u32x4 w0, w1, w2, w3;
            w0 = (u32x4){cvtpk(p[t][0][0], p[t][0][1]), cvtpk(p[t][0][2], p[t][0][3]), cvtpk(p[t][0][4], p[t][0][5]), cvtpk(p[t][0][6], p[t][0][7])};
            w1 = (u32x4){cvtpk(p[t][0][8], p[t][0][9]), cvtpk(p[t][0][10], p[t][0][11]), cvtpk(p[t][0][12], p[t][0][13]), cvtpk(p[t][0][14], p[t][0][15])};
            w2 = (u32x4){cvtpk(p[t][1][0], p[t][1][1]), cvtpk(p[t][1][2], p[t][1][3]), cvtpk(p[t][1][4], p[t][1][5]), cvtpk(p[t][1][6], p[t][1][7])};
            w3 = (u32x4){cvtpk(p[t][1][8], p[t][1][9]), cvtpk(p[t][1][10], p[t][1][11]), cvtpk(p[t][1][12], p[t][1][13]), cvtpk(p[t][1][14], p[t][1][15])};
            pv(o, vb0 + t * SLOTB, __builtin_bit_cast(bf16x8, w0), __builtin_bit_cast(bf16x8, w1), __builtin_bit_cast(bf16x8, w2), __builtin_bit_cast(bf16x8, w3));
        }
        l = swapsum(l);
        if (hi == 0) { wsf[r32] = mx; wsf[32 + r32] = l; }
#pragma unroll
        for (int r = 0; r < 16; ++r) { const int orow = crow(r, hi);
#pragma unroll
            for (int d0 = 0; d0 < 2; ++d0) ost[orow * 68 + d0 * 32 + r32] = o[d0][r]; }
        asm volatile("s_waitcnt lgkmcnt(0)" ::: "memory");
        { const int q = lane >> 1, c0 = (lane & 1) * 32; const int s2 = qb * BLK + wid * 32 + q; const size_t row2 = (size_t)b * SEQ + s2;
          const float m0 = wsf[q], l0 = wsf[32 + q]; const int np = qb < 3 ? qb : 3;
          float mj[3], lj[3]; float mt = m0;
#pragma unroll
          for (int j = 0; j < 3; ++j) { if (j < np) { const float2 ml = *(const float2*)(PART_ML + ((row2 * NH + h) * 3 + j) * 2); mj[j] = ml.x; lj[j] = ml.y; mt = fmaxf(mt, ml.x); } else { mj[j] = -INFINITY; lj[j] = 0.f; } }
          const float w0 = exp2f(m0 - mt); float wj[3]; float den = w0 * l0;
#pragma unroll
          for (int j = 0; j < 3; ++j) { wj[j] = (j < np) ? exp2f(mj[j] - mt) * lj[j] : 0.f; den += wj[j]; }
          const float iden = 1.0f / den;
          float acc[32];
#pragma unroll
          for (int c = 0; c < 32; c += 4) { const f32x4 v = *(const LAS f32x4*)(ost + q * 68 + c0 + c); acc[c] = v[0] * w0; acc[c + 1] = v[1] * w0; acc[c + 2] = v[2] * w0; acc[c + 3] = v[3] * w0; }
#pragma unroll
          for (int j = 0; j < 3; ++j) if (j < np) { const v4u* pp = (const v4u*)(PART_O + ((row2 * NH + h) * 3 + j) * 64 + c0);
#pragma unroll
              for (int c = 0; c < 4; ++c) { const v4u w = pp[c]; const float f = wj[j];
                  acc[c * 8 + 0] += f * __uint_as_float(w.x << 16); acc[c * 8 + 1] += f * __uint_as_float(w.x & 0xffff0000u); acc[c * 8 + 2] += f * __uint_as_float(w.y << 16); acc[c * 8 + 3] += f * __uint_as_float(w.y & 0xffff0000u);
                  acc[c * 8 + 4] += f * __uint_as_float(w.z << 16); acc[c * 8 + 5] += f * __uint_as_float(w.z & 0xffff0000u); acc[c * 8 + 6] += f * __uint_as_float(w.w << 16); acc[c * 8 + 7] += f * __uint_as_float(w.w & 0xffff0000u); } }
          const v4u* zp = (const v4u*)(QKVZ + row2 * 2048 + 1536 + h * HD + c0); v4u* op = (v4u*)(QKVZ + row2 * 2048 + h * HD + c0);
#pragma unroll
          for (int c = 0; c < 4; ++c) { const v4u w = zp[c]; const float z[8] = {__uint_as_float(w.x << 16), __uint_as_float(w.x & 0xffff0000u), __uint_as_float(w.y << 16), __uint_as_float(w.y & 0xffff0000u),
                                                                               __uint_as_float(w.z << 16), __uint_as_float(w.z & 0xffff0000u), __uint_as_float(w.w << 16), __uint_as_float(w.w & 0xffff0000u)};
              float rr[8];
#pragma unroll
              for (int e2 = 0; e2 < 8; ++e2) rr[e2] = acc[c * 8 + e2] * iden * z[e2] * sigm(z[e2]);
              v4u ow; ow.x = pk2(rr[0], rr[1]); ow.y = pk2(rr[2], rr[3]); ow.z = pk2(rr[4], rr[5]); ow.w = pk2(rr[6], rr[7]); op[c] = ow; } }
        asm volatile("s_waitcnt lgkmcnt(0)" ::: "memory");
    }
}
constexpr int LDS_BYTES = 147456;
constexpr int NPHASE = 11;

template <int PLO, int PHI> __global__ void __launch_bounds__(NTHR, 2) fwd(Args args) {
    extern __shared__ __attribute__((aligned(16))) unsigned char lds[];
    Frame F;
    F.lds = (LAS unsigned char*)lds;
#define RETID() do { int t_ = threadIdx.x; asm volatile("" : "+v"(t_)); F.tid = t_; F.lane = t_ & 63; F.wave = __builtin_amdgcn_readfirstlane(t_ >> 6); } while (0)
    RETID();
    F.G = gridDim.x; { const int bx = blockIdx.x; F.vcu = (F.G % 8 == 0) ? (bx % 8) * (F.G / 8) + bx / 8 : bx; }
    F.x = args.in[0]; F.p = args.in[1]; F.g_pre = args.in[2]; F.w_in = args.in[3]; F.rel_bias = args.in[4]; F.mu = args.in[5]; F.w0 = args.in[6]; F.w_up = args.in[7];
    F.a0 = args.in[8]; F.a_up = args.in[9]; F.k_k = args.in[10]; F.k_a = args.in[11]; F.r_k = args.in[12]; F.ln_w = args.in[13]; F.ln_b = args.in[14];
    F.p_a = args.in[15]; F.p_b = args.in[16]; F.w_out = args.in[17]; F.g_post = args.in[18]; F.w_pu = args.in[19]; F.w_pg = args.in[20];
    F.out = args.out; F.ws = args.ws;
    constexpr int lo = PLO, hi = PHI;
    cg::grid_group grid = cg::this_grid();
#define IN(k) (lo <= (k) && (k) < hi)
#define SEAM(k) do { if constexpr (IN(k) && IN((k) + 1)) grid.sync(); } while (0)
    unsigned char* ws = F.ws;
    pg8::bf16_t* U2 = (pg8::bf16_t*)F.out; pg8::bf16_t* MERGED = (pg8::bf16_t*)F.out;
    pg8::bf16_t* QKVZ = (pg8::bf16_t*)(ws + WS_QKVZ); pg8::bf16_t* RWb = (pg8::bf16_t*)(ws + WS_RW); pg8::bf16_t* GAB = (pg8::bf16_t*)(ws + WS_GAB);

    if constexpr (IN(0)) { RETID(); p0_prologue(F); } SEAM(0);
    if constexpr (IN(1)) {
        { pg8::Gemm g{U2, (const pg8::bf16_t*)(ws + WS_WIN), M, INCP, DM, 2048, DM, 0, 0}; pg8::StaticOrder S; S.init(M, INCP, F.G, (int)blockIdx.x);
          pg8::EpiCols E{QKVZ, RWb, GAB, QSCALE};
          pg8::gemm_phase<pg8::EpiCols, pg8::StaticOrder, true, true>(F.lds, g, S, E); }
        { pg8::Gemm g{U2, (const pg8::bf16_t*)(ws + WS_WG), M, 256, 2048, 2048, 2048, 16, (size_t)256 * 2048}; pg8::StaticOrder S; S.init(M, 256, F.G, (int)blockIdx.x);
          pg8::EpiF32 E{(float*)(ws + WS_GATE), 256};
          pg8::gemm_phase<pg8::EpiF32, pg8::StaticOrder, true, true>(F.lds, g, S, E); }
    } SEAM(1);
    if constexpr (IN(2)) { RETID(); attn_select(F, (const float*)(ws + WS_GATE), (unsigned*)(ws + WS_CNT), (unsigned short*)((unsigned char*)F.out + DO_LISTS)); } SEAM(2);
    if constexpr (IN(3)) { RETID(); attn_partial(F, (const bf16*)(ws + WS_QKVZ), (const unsigned*)(ws + WS_CNT), (const unsigned short*)((unsigned char*)F.out + DO_LISTS),
                                         (bf16*)((unsigned char*)F.out + DO_PARTO), (float*)((unsigned char*)F.out + DO_PARTML), (unsigned*)(ws + WS_QCTR)); } SEAM(3);
    if constexpr (IN(4)) { RETID(); attn_own_combine(F, (bf16*)(ws + WS_QKVZ), (const bf16*)((unsigned char*)F.out + DO_PARTO), (const float*)((unsigned char*)F.out + DO_PARTML)); } SEAM(4);
    if constexpr (IN(5)) { RETID(); rwkv_simple(F); } SEAM(5);
    if constexpr (IN(6)) {
        pg8::Gemm g{QKVZ, (const pg8::bf16_t*)(ws + WS_PAB), M, DM, 512, 2048, 1024, 0, 0}; pg8::StaticOrder S; S.init(M, DM, F.G, (int)blockIdx.x);
        pg8::EpiMerge<false> E{MERGED, DM, GAB, 2048};
        pg8::gemm_phase<pg8::EpiMerge<false>, pg8::StaticOrder, true, true>(F.lds, g, S, E);
    } SEAM(6);
    if constexpr (IN(7)) {
        pg8::Gemm g{QKVZ + 512, (const pg8::bf16_t*)(ws + WS_PAB) + 512, M, DM, 512, 2048, 1024, 0, 0}; pg8::StaticOrder S; S.init(M, DM, F.G, (int)blockIdx.x);
        pg8::EpiMerge<true> E{MERGED, DM, GAB + 1024, 2048};
        pg8::gemm_phase<pg8::EpiMerge<true>, pg8::StaticOrder, true, true>(F.lds, g, S, E);
    } SEAM(7);
    if constexpr (IN(8)) {
        { pg8::Gemm g{MERGED, (const pg8::bf16_t*)(ws + WS_WOUT), M, DM, DM, DM, DM, 0, 0}; pg8::StaticOrder S; S.init(M, DM, F.G, (int)blockIdx.x);
          pg8::EpiF32 E{(float*)(ws + WS_RW), DM};
          pg8::gemm_phase<pg8::EpiF32, pg8::StaticOrder, true, true>(F.lds, g, S, E); }
        { pg8::Gemm g{(const pg8::bf16_t*)(ws + WS_PB), (const pg8::bf16_t*)(ws + WS_WPU), M, DM, PLE, PLE, PLE, 0, 0}; pg8::StaticOrder S; S.init(M, DM, F.G, (int)blockIdx.x);
          pg8::EpiBf16 E{GAB, DM};
          pg8::gemm_phase<pg8::EpiBf16, pg8::StaticOrder, true, true>(F.lds, g, S, E); }
    } SEAM(8);
    if constexpr (IN(9)) { RETID(); post_norm(F); } SEAM(9);
    if constexpr (IN(10)) {
        pg8::Gemm g{QKVZ, (const pg8::bf16_t*)(ws + WS_WPG), M, DM, DM, DM, DM, 0, 0}; pg8::StaticOrder S; S.init(M, DM, F.G, (int)blockIdx.x);
        pg8::EpiFinal E{F.out, F.x, (const float*)(ws + WS_RW), (const float*)(ws + WS_RSY), F.g_post, GAB, DM};
        pg8::gemm_phase<pg8::EpiFinal, pg8::StaticOrder, true, true>(F.lds, g, S, E);
    }
#undef IN
#undef SEAM
}

#ifndef MK_ONE_LAUNCH
#define MK_ONE_LAUNCH 1
#endif
extern "C" void kernel_launch(void* const* d_in, const int* in_sizes, int n_in, void* d_out, int out_size, void* d_ws, size_t ws_size, hipStream_t stream) {
    static int grid = 0;
    if (grid == 0) {
        if (n_in != 21 || out_size != M * DM || ws_size < WS_END) { fprintf(stderr, "kernel_launch: unexpected shapes n_in %d out %d ws %zu\n", n_in, out_size, ws_size); grid = -1; return; }
        int dev = 0, cus = 0, per_cu = 0;
        (void)hipGetDevice(&dev); (void)hipDeviceGetAttribute(&cus, hipDeviceAttributeMultiprocessorCount, dev);
        (void)per_cu;
        grid = cus;
    }
    if (grid < 0) return;
    Args a{};
    for (int i = 0; i < 21; ++i) a.in[i] = (const float*)d_in[i];
    a.out = (float*)d_out; a.ws = (unsigned char*)d_ws;
#if MK_ONE_LAUNCH
    a.ph_lo = 0; a.ph_hi = NPHASE;
    void* kargs[] = {&a};
    (void)hipFuncSetAttribute((const void*)fwd<0, NPHASE>, hipFuncAttributeMaxDynamicSharedMemorySize, LDS_BYTES);
    hipError_t e = hipLaunchCooperativeKernel((const void*)fwd<0, NPHASE>, dim3(grid), dim3(NTHR), kargs, LDS_BYTES, stream);
    if (e != hipSuccess) fprintf(stderr, "cooperative launch failed: %s\n", hipGetErrorString(e));
#else
#define LAUNCH_PH(k) do { (void)hipFuncSetAttribute((const void*)fwd<k, k + 1>, hipFuncAttributeMaxDynamicSharedMemorySize, LDS_BYTES); a.ph_lo = k; a.ph_hi = k + 1; hipLaunchKernelGGL((fwd<k, k + 1>), dim3(grid), dim3(NTHR), LDS_BYTES, stream, a); } while (0)
    LAUNCH_PH(0); LAUNCH_PH(1); LAUNCH_PH(2); LAUNCH_PH(3); LAUNCH_PH(4); LAUNCH_PH(5); LAUNCH_PH(6); LAUNCH_PH(7); LAUNCH_PH(8); LAUNCH_PH(9); LAUNCH_PH(10);
#endif
}
```

```cpp
#include <hip/hip_runtime.h>
#include <hip/hip_cooperative_groups.h>
#include <cstdio>
#include <cstdint>
#include <cmath>
namespace cg = cooperative_groups;
namespace pg8 {
#define PG8_LAS __attribute__((address_space(3)))
typedef unsigned short bf16_t;
typedef short bf16x8 __attribute__((ext_vector_type(8)));
typedef float f32x4 __attribute__((ext_vector_type(4)));
typedef float f32x2 __attribute__((ext_vector_type(2)));
typedef unsigned u32x4 __attribute__((ext_vector_type(4)));
typedef unsigned u32x2 __attribute__((ext_vector_type(2)));
constexpr int BM = 256, BK = 64, HALF = 128, HTB = HALF * BK * 2  , STAGE_BYTES = 8 * HTB, NXCD = 8, WGM = 8;

__host__ __device__ __forceinline__ int lds_byte(int r, int c) { const int st = (r >> 4) * 2 + (c >> 5), rr = r & 15, cc = c & 31, ob = rr * 64 + cc * 2; return st * 1024 + (ob ^ (((ob >> 9) & 1) << 5)); }
__host__ __device__ __forceinline__ void stage_rc(int b, int& R, int& C) { const int st = b / 1024, sb = b % 1024, swz = sb ^ (((sb >> 9) & 1) << 5); R = (st >> 1) * 16 + swz / 64; C = (st & 1) * 32 + (swz % 64) / 2; }
__host__ __device__ __forceinline__ int perm32(int rho) { const int n = rho >> 4, i = rho & 15; return 8 * (i >> 2) + 4 * n + (i & 3); }

struct Unit { int pm, pn; };
struct Gemm { const bf16_t* A; const bf16_t* Bt; int M, N, K, lda, ldb, bdiv; size_t bstride; };

struct StaticOrder {
    int nM, nN, nwg, G, c;
    __host__ __device__ void init(int M, int N, int G_, int c_) { nM = M / BM; nN = N / BM; nwg = nM * nN; G = G_; c = c_; }
    __host__ __device__ bool next(int i, Unit& u) const {
        const long L = (long)i * G + c; if (L >= nwg) return false;
        int wgid = (int)L; { const int q = nwg / NXCD, r = nwg % NXCD, xcd = wgid % NXCD, off = wgid / NXCD; wgid = (xcd < r ? xcd * (q + 1) : r * (q + 1) + (xcd - r) * q) + off; }
        const int nig = WGM * nN, gid = wgid / nig, fm = gid * WGM, gsz = (nM - fm) < WGM ? (nM - fm) : WGM;
        u.pm = fm + ((wgid % nig) % gsz); u.pn = (wgid % nig) / gsz; return true;
    }
};

__device__ __forceinline__ unsigned cvt_pk_bf16(float lo, float hi) { unsigned r; asm volatile("v_cvt_pk_bf16_f32 %0, %1, %2" : "=v"(r) : "v"(lo), "v"(hi)); return r; }
__device__ __forceinline__ float bf_lo(unsigned w) { return __uint_as_float(w << 16); }
__device__ __forceinline__ float bf_hi(unsigned w) { return __uint_as_float(w & 0xffff0000u); }

template <class Epi, class Sched, bool ALIGN_EPI = false, bool SP2 = false>
__device__ __forceinline__ void gemm_phase(PG8_LAS unsigned char* lds, const Gemm g, const Sched& S, const Epi& E) {
    int tid_ = threadIdx.x; asm volatile("" : "+v"(tid_));
    const int tid = tid_, wid = __builtin_amdgcn_readfirstlane(tid >> 6), lane = tid & 63, wr = wid >> 2, wc = wid & 3, fr = lane & 15, fq = lane >> 4;
    const int K = g.K, nt = K / BK;
    unsigned voffA[2], voffB[2];
#pragma unroll
    for (int i = 0; i < 2; ++i) { int R, C; stage_rc(tid * 16 + i * 8192, R, C); const int Rb = Epi::PERM ? ((R & ~31) + perm32(R & 31)) : R;
        voffA[i] = (unsigned)(R * g.lda + C) * 2u; voffB[i] = (unsigned)(Rb * g.ldb + C) * 2u; }
    const size_t kstep = (size_t)(BK * 2);
    const size_t hstepA = (size_t)HALF * g.lda * 2, hstepB = (size_t)HALF * g.ldb * 2;
    const size_t tstepA = 2 * hstepA, tstepB = 2 * hstepB;
    const unsigned ldsw = (unsigned)wid * 1024u;
    const int aoff = lds_byte(wr * 64 + fr, fq * 8), boff = lds_byte(wc * 32 + fr, fq * 8);
#define PG8_SA(b, h) (((b) * 2 + (h)) * HTB)
#define PG8_SB(b, h) ((4 + (b) * 2 + (h)) * HTB)
#define PG8_STAGE(bufoff, gbase, voff) do { _Pragma("unroll") for (int _i = 0; _i < 2; ++_i) \
        __builtin_amdgcn_global_load_lds((const unsigned*)((const char*)(gbase) + (voff)[_i]), (PG8_LAS unsigned*)(lds + (bufoff) + ldsw + _i * 8192), 16, 0, 0); } while (0)
#define PG8_LDA(dst, b, h) do { _Pragma("unroll") for (int m = 0; m < 4; ++m) _Pragma("unroll") for (int k = 0; k < 2; ++k) dst[m][k] = *(const PG8_LAS bf16x8*)(lds + PG8_SA(b, h) + aoff + m * 2048 + k * 1024); } while (0)
#define PG8_LDB(dst, b, h) do { _Pragma("unroll") for (int n = 0; n < 2; ++n) _Pragma("unroll") for (int k = 0; k < 2; ++k) dst[n][k] = *(const PG8_LAS bf16x8*)(lds + PG8_SB(b, h) + boff + n * 2048 + k * 1024); } while (0)
#define PG8_MMA(ai, bj, At, Bt) do { __builtin_amdgcn_s_setprio(1); _Pragma("unroll") for (int m = 0; m < 4; ++m) _Pragma("unroll") for (int n = 0; n < 2; ++n) _Pragma("unroll") for (int k = 0; k < 2; ++k) \
        acc[ai][bj][m][n] = __builtin_amdgcn_mfma_f32_16x16x32_bf16(Bt[n][k], At[m][k], acc[ai][bj][m][n], 0, 0, 0); __builtin_amdgcn_s_setprio(0); } while (0)
#define PG8_WAIT_V(n) asm volatile("s_waitcnt vmcnt(" #n ")" ::: "memory")
#define PG8_WAIT_L(n) asm volatile("s_waitcnt lgkmcnt(" #n ")" ::: "memory")
#define PG8_BAR __builtin_amdgcn_s_barrier()
#define PG8_SCHED __builtin_amdgcn_sched_barrier(0)
#define PG8_BBASE(u) ((const char*)g.Bt + (size_t)(u).pn * tstepB + (g.bdiv ? (size_t)((u).pm / g.bdiv) * g.bstride * 2 : (size_t)0))
    Unit cur, nxt; int ui = 0;
    if (!S.next(0, cur)) return;
    f32x4 acc[2][2][4][2];
#pragma unroll
    for (int a = 0; a < 2; ++a)
#pragma unroll
        for (int b = 0; b < 2; ++b)
#pragma unroll
            for (int m = 0; m < 4; ++m)
#pragma unroll
                for (int n = 0; n < 2; ++n) acc[a][b][m][n] = (f32x4){0.f, 0.f, 0.f, 0.f};
    bf16x8 At[4][2], B0[2][2], B1[2][2];
    const char* cA = (const char*)g.A + (size_t)cur.pm * tstepA; const char* cB = PG8_BBASE(cur);
    if constexpr (SP2) {
        PG8_STAGE(PG8_SB(0, 0), cB, voffB); PG8_STAGE(PG8_SB(0, 1), cB + hstepB, voffB); PG8_STAGE(PG8_SA(0, 0), cA, voffA); PG8_STAGE(PG8_SA(0, 1), cA + hstepA, voffA);
        if (wr == 1) PG8_BAR;
        PG8_WAIT_V(2); PG8_BAR;
        PG8_STAGE(PG8_SB(1, 0), cB + kstep, voffB); PG8_STAGE(PG8_SA(1, 0), cA + kstep, voffA); PG8_STAGE(PG8_SB(1, 1), cB + hstepB + kstep, voffB);
        PG8_WAIT_V(6); PG8_BAR;
    } else {
        PG8_STAGE(PG8_SB(0, 0), cB, voffB); PG8_STAGE(PG8_SA(0, 0), cA, voffA); PG8_STAGE(PG8_SB(0, 1), cB + hstepB, voffB); PG8_STAGE(PG8_SA(0, 1), cA + hstepA, voffA);
        if (wr == 1) PG8_BAR;
        PG8_WAIT_V(4); PG8_BAR;
        PG8_STAGE(PG8_SB(1, 0), cB + kstep, voffB); PG8_STAGE(PG8_SA(1, 0), cA + kstep, voffA); PG8_STAGE(PG8_SB(1, 1), cB + hstepB + kstep, voffB);
        PG8_WAIT_V(6); PG8_BAR;
    }
    for (;;) {
        const bool has_next = S.next(ui + 1, nxt);
        const char* nA = has_next ? (const char*)g.A + (size_t)nxt.pm * tstepA : cA; const char* nB = has_next ? PG8_BBASE(nxt) : cB;
        for (int t = 0; t < nt; t += 2) {
            const bool last = (t == nt - 2);
            const char* a1 = cA + (size_t)(t + 1) * kstep;
            const char* a2 = last ? nA : cA + (size_t)(t + 2) * kstep; const char* b2 = last ? nB : cB + (size_t)(t + 2) * kstep;
            const char* a3 = a2 + kstep; const char* b3 = b2 + kstep;
            if constexpr (SP2) {
            PG8_LDB(B0, 0, 0); PG8_LDB(B1, 0, 1); PG8_SCHED; PG8_LDA(At, 0, 0); PG8_STAGE(PG8_SA(1, 1), a1 + hstepA, voffA);
            PG8_WAIT_V(8); PG8_WAIT_L(0); PG8_BAR; PG8_MMA(0, 0, At, B0); PG8_MMA(0, 1, At, B1); PG8_BAR; PG8_SCHED;
            PG8_LDA(At, 0, 1); PG8_STAGE(PG8_SB(0, 0), b2, voffB); PG8_STAGE(PG8_SB(0, 1), b2 + hstepB, voffB); PG8_STAGE(PG8_SA(0, 0), a2, voffA);
            PG8_WAIT_V(8); PG8_WAIT_L(0); PG8_BAR; PG8_MMA(1, 0, At, B0); PG8_MMA(1, 1, At, B1); PG8_BAR; PG8_SCHED;
            PG8_LDB(B0, 1, 0); PG8_LDB(B1, 1, 1); PG8_SCHED; PG8_LDA(At, 1, 0); PG8_STAGE(PG8_SA(0, 1), a2 + hstepA, voffA);
            PG8_WAIT_V(8); PG8_WAIT_L(0); PG8_BAR; PG8_MMA(0, 0, At, B0); PG8_MMA(0, 1, At, B1); PG8_BAR; PG8_SCHED;
            PG8_LDA(At, 1, 1); PG8_STAGE(PG8_SB(1, 0), b3, voffB); PG8_STAGE(PG8_SB(1, 1), b3 + hstepB, voffB); PG8_STAGE(PG8_SA(1, 0), a3, voffA);
            PG8_WAIT_V(8); PG8_WAIT_L(0); PG8_BAR; PG8_MMA(1, 0, At, B0); PG8_MMA(1, 1, At, B1); PG8_BAR; PG8_SCHED;
            } else {
            PG8_LDB(B0, 0, 0); PG8_SCHED; PG8_LDA(At, 0, 0); PG8_STAGE(PG8_SA(1, 1), a1 + hstepA, voffA);
            PG8_WAIT_L(8); PG8_BAR; PG8_WAIT_L(0); PG8_MMA(0, 0, At, B0); PG8_BAR; PG8_SCHED;
            PG8_LDB(B1, 0, 1); PG8_STAGE(PG8_SB(0, 0), b2, voffB);
            PG8_BAR; PG8_WAIT_L(0); PG8_MMA(0, 1, At, B1); PG8_BAR;
            PG8_LDA(At, 0, 1); PG8_STAGE(PG8_SA(0, 0), a2, voffA);
            PG8_BAR; PG8_WAIT_L(0); PG8_MMA(1, 0, At, B0); PG8_BAR; PG8_SCHED;
            PG8_STAGE(PG8_SB(0, 1), b2 + hstepB, voffB);
            PG8_WAIT_V(6); PG8_BAR; PG8_MMA(1, 1, At, B1); PG8_BAR;
            PG8_LDB(B0, 1, 0); PG8_SCHED; PG8_LDA(At, 1, 0); PG8_STAGE(PG8_SA(0, 1), a2 + hstepA, voffA);
            PG8_WAIT_L(8); PG8_BAR; PG8_WAIT_L(0); PG8_MMA(0, 0, At, B0); PG8_BAR; PG8_SCHED;
            PG8_LDB(B1, 1, 1); PG8_STAGE(PG8_SB(1, 0), b3, voffB);
            PG8_BAR; PG8_WAIT_L(0); PG8_MMA(0, 1, At, B1); PG8_BAR;
            PG8_LDA(At, 1, 1); PG8_STAGE(PG8_SA(1, 0), a3, voffA);
            PG8_BAR; PG8_WAIT_L(0); PG8_MMA(1, 0, At, B0); PG8_BAR; PG8_SCHED;
            PG8_STAGE(PG8_SB(1, 1), b3 + hstepB, voffB);
            PG8_WAIT_V(6); PG8_BAR; PG8_MMA(1, 1, At, B1); PG8_BAR;
            }
        }
        if constexpr (ALIGN_EPI) { if (wr == 0) PG8_BAR; }
        E(acc, cur, wr, wc, fr, fq);
        if (!has_next) break;
#pragma unroll
        for (int a = 0; a < 2; ++a)
#pragma unroll
            for (int b = 0; b < 2; ++b)
#pragma unroll
                for (int m = 0; m < 4; ++m)
#pragma unroll
                    for (int n = 0; n < 2; ++n) acc[a][b][m][n] = (f32x4){0.f, 0.f, 0.f, 0.f};
        cur = nxt; cA = nA; cB = nB; ++ui;
        if constexpr (ALIGN_EPI) { if (wr == 1) PG8_BAR; }
    }
    PG8_WAIT_V(0);
    if constexpr (!ALIGN_EPI) { if (wr == 0) PG8_BAR; }
    PG8_BAR;
#undef PG8_SA
#undef PG8_SB
#undef PG8_STAGE
#undef PG8_LDA
#undef PG8_LDB
#undef PG8_MMA
#undef PG8_WAIT_V
#undef PG8_WAIT_L
#undef PG8_BAR
#undef PG8_SCHED
#undef PG8_BBASE
}
}
namespace pg8 {
__device__ __forceinline__ float sigmoidf_(float x) { return 1.0f / (1.0f + __expf(-x)); }

struct EpiCols {
    static constexpr bool PERM = true;
    bf16_t* qkvz; bf16_t* rw; bf16_t* gab; float qscale;
    __device__ __forceinline__ void operator()(const f32x4 (&acc)[2][2][4][2], const Unit& u, int wr, int wc, int fr, int fq) const {
        const int pn = u.pn; bf16_t* base; int pitch, coff, nbj = 2; float sc = 1.f;
        if (pn < 8) { base = qkvz; pitch = 2048; coff = pn * 256; if (pn < 2) sc = qscale; }
        else if (pn < 16) { base = rw; pitch = 2176; coff = (pn - 8) * 256; }
        else if (pn < 24) { base = gab; pitch = 2048; coff = (pn - 16) * 256; }
        else { base = rw; pitch = 2176; coff = 2048; nbj = 1; }
        const int row0 = u.pm * BM + wr * 64 + fr; const int col0 = coff + wc * 32 + 8 * fq;
#pragma unroll
        for (int ai = 0; ai < 2; ++ai)
#pragma unroll
            for (int m = 0; m < 4; ++m) { bf16_t* rowp = base + (size_t)(row0 + ai * HALF + m * 16) * pitch + col0;
#pragma unroll
                for (int bj = 0; bj < 2; ++bj) { if (bj < nbj) { f32x4 v0 = acc[ai][bj][m][0] * sc, v1 = acc[ai][bj][m][1] * sc;
                    u32x4 w; w.x = cvt_pk_bf16(v0[0], v0[1]); w.y = cvt_pk_bf16(v0[2], v0[3]); w.z = cvt_pk_bf16(v1[0], v1[1]); w.w = cvt_pk_bf16(v1[2], v1[3]);
                    *(u32x4*)(rowp + bj * HALF) = w; } } }
    }
};
struct EpiBf16 {
    static constexpr bool PERM = true;
    bf16_t* O; int ldc;
    __device__ __forceinline__ void operator()(const f32x4 (&acc)[2][2][4][2], const Unit& u, int wr, int wc, int fr, int fq) const {
        const int row0 = u.pm * BM + wr * 64 + fr; const int col0 = u.pn * BM + wc * 32 + 8 * fq;
#pragma unroll
        for (int ai = 0; ai < 2; ++ai)
#pragma unroll
            for (int m = 0; m < 4; ++m) { bf16_t* rowp = O + (size_t)(row0 + ai * HALF + m * 16) * ldc + col0;
#pragma unroll
                for (int bj = 0; bj < 2; ++bj) { const f32x4 v0 = acc[ai][bj][m][0], v1 = acc[ai][bj][m][1];
                    u32x4 w; w.x = cvt_pk_bf16(v0[0], v0[1]); w.y = cvt_pk_bf16(v0[2], v0[3]); w.z = cvt_pk_bf16(v1[0], v1[1]); w.w = cvt_pk_bf16(v1[2], v1[3]);
                    *(u32x4*)(rowp + bj * HALF) = w; } }
    }
};
struct EpiF32 {
    static constexpr bool PERM = false;
    float* O; int ldc;
    __device__ __forceinline__ void operator()(const f32x4 (&acc)[2][2][4][2], const Unit& u, int wr, int wc, int fr, int fq) const {
        const int row0 = u.pm * BM + wr * 64 + fr; const int col0 = u.pn * BM + wc * 32 + 4 * fq;
#pragma unroll
        for (int ai = 0; ai < 2; ++ai)
#pragma unroll
            for (int m = 0; m < 4; ++m) { float* rowp = O + (size_t)(row0 + ai * HALF + m * 16) * ldc + col0;
#pragma unroll
                for (int bj = 0; bj < 2; ++bj)
#pragma unroll
                    for (int n = 0; n < 2; ++n) *(f32x4*)(rowp + bj * HALF + n * 16) = acc[ai][bj][m][n]; }
    }
};
template <bool ADD> struct EpiMerge {
    static constexpr bool PERM = true;
    bf16_t* O; int ldc; const bf16_t* G; int ldg;
    __device__ __forceinline__ void operator()(const f32x4 (&acc)[2][2][4][2], const Unit& u, int wr, int wc, int fr, int fq) const {
        const int row0 = u.pm * BM + wr * 64 + fr; const int col0 = u.pn * BM + wc * 32 + 8 * fq;
#pragma unroll
        for (int ai = 0; ai < 2; ++ai)
#pragma unroll
            for (int m = 0; m < 4; ++m) { const size_t r = (size_t)(row0 + ai * HALF + m * 16);
#pragma unroll
                for (int bj = 0; bj < 2; ++bj) { const f32x4 v0 = acc[ai][bj][m][0], v1 = acc[ai][bj][m][1];
                    const u32x4 gw = *(const u32x4*)(G + r * ldg + col0 + bj * HALF);
                    float o[8];
                    o[0] = sigmoidf_(bf_lo(gw.x)) * v0[0]; o[1] = sigmoidf_(bf_hi(gw.x)) * v0[1]; o[2] = sigmoidf_(bf_lo(gw.y)) * v0[2]; o[3] = sigmoidf_(bf_hi(gw.y)) * v0[3];
                    o[4] = sigmoidf_(bf_lo(gw.z)) * v1[0]; o[5] = sigmoidf_(bf_hi(gw.z)) * v1[1]; o[6] = sigmoidf_(bf_lo(gw.w)) * v1[2]; o[7] = sigmoidf_(bf_hi(gw.w)) * v1[3];
                    bf16_t* op = O + r * ldc + col0 + bj * HALF;
                    if (ADD) { const u32x4 pw = *(const u32x4*)op;
                        o[0] += bf_lo(pw.x); o[1] += bf_hi(pw.x); o[2] += bf_lo(pw.y); o[3] += bf_hi(pw.y); o[4] += bf_lo(pw.z); o[5] += bf_hi(pw.z); o[6] += bf_lo(pw.w); o[7] += bf_hi(pw.w); }
                    u32x4 w; w.x = cvt_pk_bf16(o[0], o[1]); w.y = cvt_pk_bf16(o[2], o[3]); w.z = cvt_pk_bf16(o[4], o[5]); w.w = cvt_pk_bf16(o[6], o[7]);
                    *(u32x4*)op = w; } }
    }
};
struct EpiFinal {
    static constexpr bool PERM = false;
    float* out; const float* x; const float* y; const float* rsy; const float* gpost; const bf16_t* E; int ldc;
    __device__ __forceinline__ void operator()(const f32x4 (&acc)[2][2][4][2], const Unit& u, int wr, int wc, int fr, int fq) const {
        const int row0 = u.pm * BM + wr * 64 + fr; const int col0 = u.pn * BM + wc * 32 + 4 * fq;
#pragma unroll
        for (int ai = 0; ai < 2; ++ai)
#pragma unroll
            for (int m = 0; m < 4; ++m) { const size_t r = (size_t)(row0 + ai * HALF + m * 16); const float rs = rsy[r];
#pragma unroll
                for (int bj = 0; bj < 2; ++bj)
#pragma unroll
                    for (int n = 0; n < 2; ++n) { const int c = col0 + bj * HALF + n * 16; const size_t off = r * ldc + c;
                        const f32x4 xv = *(const f32x4*)(x + off), yv = *(const f32x4*)(y + off), gp = *(const f32x4*)(gpost + c); const u32x2 ew = *(const u32x2*)(E + off);
                        const f32x4 a = acc[ai][bj][m][n]; f32x4 o;
                        o[0] = xv[0] + yv[0] * rs * gp[0] + sigmoidf_(a[0]) * bf_lo(ew.x);
                        o[1] = xv[1] + yv[1] * rs * gp[1] + sigmoidf_(a[1]) * bf_hi(ew.x);
                        o[2] = xv[2] + yv[2] * rs * gp[2] + sigmoidf_(a[2]) * bf_lo(ew.y);
                        o[3] = xv[3] + yv[3] * rs * gp[3] + sigmoidf_(a[3]) * bf_hi(ew.y);
                        *(f32x4*)(out + off) = o; } }
    }
};
}
#define GAS __attribute__((address_space(1)))
#define LAS __attribute__((address_space(3)))
typedef unsigned short bf16;
typedef unsigned v4u __attribute__((ext_vector_type(4)));
typedef unsigned v2u __attribute__((ext_vector_type(2)));
typedef float f32x4 __attribute__((ext_vector_type(4)));

constexpr int NWAVES = 8, NTHR = 512;
constexpr int BATCH = 16, SEQ = 4096, DM = 1024, M = BATCH * SEQ;
constexpr int NH = 8, HD = 64, AW = 512, PLE = 256;
constexpr int RWC = 2176, INC = 6272, INCP = 6400;
constexpr int NBLK = 16, BLK = 256;
constexpr float RMS_EPS = 1e-6f, GN_EPS = 64e-5f;
constexpr float LOG2E = 1.4426950408889634f;
constexpr float QSCALE = 0.125f * LOG2E;

constexpr size_t MiB = 1u << 20;
constexpr size_t WS_WIN = 2 * MiB;
constexpr size_t WS_WG = 16 * MiB;
constexpr size_t WS_PAB = 32 * MiB;
constexpr size_t WS_WOUT = 34 * MiB;
constexpr size_t WS_WPG = 36 * MiB;
constexpr size_t WS_WPU = 38 * MiB;
constexpr size_t WS_RSY = 39 * MiB;
constexpr size_t WS_PB = 42 * MiB;
constexpr size_t WS_GATE = 74 * MiB;
constexpr size_t WS_QKVZ = 138 * MiB;
constexpr size_t WS_RW = 394 * MiB;
constexpr size_t WS_GAB = 666 * MiB;
constexpr size_t WS_END = 922 * MiB;
constexpr size_t WS_CNT = 0;
constexpr size_t WS_QCTR = 16384;
constexpr size_t WS_WUPT = 39 * MiB + 512 * 1024, WS_AUPT = WS_WUPT + 65536;
constexpr size_t WS_BON = 922 * MiB;
constexpr size_t DO_PARTO = 0, DO_PARTML = 192 * MiB, DO_LISTS = 208 * MiB;

__device__ const unsigned char T5B[128] = {0, 1, 2, 3, 4, 5, 6, 7, 8, 9, 10, 11, 12, 13, 14, 15, 16, 16, 16, 17, 17, 18, 18, 18, 19, 19, 19, 20, 20, 20, 20, 21, 21, 21, 21, 22, 22, 22, 22, 22, 23, 23, 23, 23, 23, 23, 24, 24, 24, 24, 24, 24, 25, 25, 25, 25, 25, 25, 25, 26, 26, 26, 26, 26, 26, 26, 26, 27, 27, 27, 27, 27, 27, 27, 27, 27, 27, 28, 28, 28, 28, 28, 28, 28, 28, 28, 28, 29, 29, 29, 29, 29, 29, 29, 29, 29, 29, 29, 29, 30, 30, 30, 30, 30, 30, 30, 30, 30, 30, 30, 30, 30, 30, 31, 31, 31, 31, 31, 31, 31, 31, 31, 31, 31, 31, 31, 31, 31};

__device__ __forceinline__ unsigned f2bf(float f) { unsigned u = __builtin_bit_cast(unsigned, f); return (u + 0x7fffu + ((u >> 16) & 1u)) >> 16; }
__device__ __forceinline__ unsigned pk2(float lo, float hi) { return f2bf(lo) | (f2bf(hi) << 16); }
__device__ __forceinline__ float bf2f(unsigned short h) { return __uint_as_float((unsigned)h << 16); }
__device__ __forceinline__ float wave_sum(float v) {
#pragma unroll
    for (int o = 1; o < 64; o <<= 1) v += __shfl_xor(v, o);
    return v;
}
__device__ __forceinline__ float sigm(float x) { return 1.0f / (1.0f + __expf(-x)); }

struct Args {
    const float* in[21]; float* out; unsigned char* ws; int ph_lo, ph_hi;
};
struct Frame {
    LAS unsigned char* lds; int tid, lane, wave, vcu, G;
    const float *x, *p, *g_pre, *w_in, *rel_bias, *mu, *w0, *w_up, *a0, *a_up, *k_k, *k_a, *r_k, *ln_w, *ln_b, *p_a, *p_b, *w_out, *g_post, *w_pu, *w_pg;
    float* out; unsigned char* ws;
};

__device__ __forceinline__ void transpose_item(const float* W, int N, int k0, int n0, bf16* WT, int ldw, int drow0, int koff, LAS float* scr, int lane) {
#pragma unroll 8
    for (int i = 0; i < 32; ++i) { const int kk = 2 * i + (lane >> 5); scr[kk * 33 + (lane & 31)] = W[(size_t)(k0 + kk) * N + n0 + (lane & 31)]; }
    asm volatile("s_waitcnt lgkmcnt(0)" ::: "memory");
    const int c = lane & 7;
#pragma unroll
    for (int j = 0; j < 4; ++j) { const int n = (lane >> 3) + 8 * j; const LAS float* s = scr + (8 * c) * 33 + n;
        v4u o; o.x = pk2(s[0 * 33], s[1 * 33]); o.y = pk2(s[2 * 33], s[3 * 33]); o.z = pk2(s[4 * 33], s[5 * 33]); o.w = pk2(s[6 * 33], s[7 * 33]);
        *(v4u*)(WT + (size_t)(drow0 + n) * ldw + koff + k0 + 8 * c) = o; }
    asm volatile("s_waitcnt lgkmcnt(0)" ::: "memory");
}

__device__ __forceinline__ void p0_prologue(Frame& F) {
    if (blockIdx.x == 0) { for (int i = F.tid; i < 2048; i += NTHR) ((unsigned*)(F.ws + WS_CNT))[i] = 0u; if (F.tid == 0) *(unsigned*)(F.ws + WS_QCTR) = 0u; }
    LAS float* scr = (LAS float*)(F.lds + F.wave * 16384);
    const int gw = F.vcu * NWAVES + F.wave, NGW = F.G * NWAVES;
    bf16* WinT = (bf16*)(F.ws + WS_WIN); bf16* PabT = (bf16*)(F.ws + WS_PAB); bf16* WoutT = (bf16*)(F.ws + WS_WOUT); bf16* WpgT = (bf16*)(F.ws + WS_WPG); bf16* WpuT = (bf16*)(F.ws + WS_WPU);
    constexpr int I_IN = 16 * (INC / 32), I_PA = 8 * 32, I_PB = 8 * 32, I_WO = 16 * 32, I_PG = 16 * 32, I_PU = 4 * 32, I_UP = 16;
    constexpr int NIT = I_IN + I_PA + I_PB + I_WO + I_PG + I_PU + 2 * I_UP;
    for (int it = gw; it < NIT; it += NGW) {
        int r = it;
        if (r < I_IN) { const int nb = r % (INC / 32), kb = r / (INC / 32), n0 = nb * 32;
            const int d0 = n0 < 4096 ? n0 : (n0 < 4224 ? n0 + 2048 : n0 - 128);
            transpose_item(F.w_in, INC, kb * 64, n0, WinT, DM, d0, 0, scr, F.lane); continue; } r -= I_IN;
        if (r < I_PA) { transpose_item(F.p_a, DM, (r / 32) * 64, (r % 32) * 32, PabT, 1024, (r % 32) * 32, 0, scr, F.lane); continue; } r -= I_PA;
        if (r < I_PB) { transpose_item(F.p_b, DM, (r / 32) * 64, (r % 32) * 32, PabT, 1024, (r % 32) * 32, 512, scr, F.lane); continue; } r -= I_PB;
        if (r < I_WO) { transpose_item(F.w_out, DM, (r / 32) * 64, (r % 32) * 32, WoutT, 1024, (r % 32) * 32, 0, scr, F.lane); continue; } r -= I_WO;
        if (r < I_PG) { transpose_item(F.w_pg, DM, (r / 32) * 64, (r % 32) * 32, WpgT, 1024, (r % 32) * 32, 0, scr, F.lane); continue; } r -= I_PG;
        if (r < I_PU) { transpose_item(F.w_pu, DM, (r / 32) * 64, (r % 32) * 32, WpuT, 256, (r % 32) * 32, 0, scr, F.lane); continue; } r -= I_PU;
        if (r < I_UP) { transpose_item(F.w_up, AW, 0, r * 32, (bf16*)(F.ws + WS_WUPT), 64, r * 32, 0, scr, F.lane); continue; } r -= I_UP;
        transpose_item(F.a_up, AW, 0, r * 32, (bf16*)(F.ws + WS_AUPT), 64, r * 32, 0, scr, F.lane);
    }
    for (int i = gw * 64 + F.lane; i < 128 * 1024 / 8; i += NGW * 64) *(v4u*)(WinT + (size_t)INC * DM + (size_t)i * 8) = (v4u){0u, 0u, 0u, 0u};
    { bf16* PB = (bf16*)(F.ws + WS_PB); const size_t n8 = (size_t)M * PLE / 8;
      for (size_t i = (size_t)F.vcu * NTHR + F.tid; i < n8; i += (size_t)F.G * NTHR) { const f32x4 a = *(const f32x4*)(F.p + i * 8), b = *(const f32x4*)(F.p + i * 8 + 4);
          v4u o; o.x = pk2(a[0], a[1]); o.y = pk2(a[2], a[3]); o.z = pk2(b[0], b[1]); o.w = pk2(b[2], b[3]); *(v4u*)(PB + i * 8) = o; } }
    __syncthreads();
    LAS float* red = (LAS float*)F.lds;
    LAS float* ubar = (LAS float*)(F.lds + 32768);
    LAS float* kmean = (LAS float*)(F.lds + 36864);
    bf16* U2 = (bf16*)F.out; bf16* WgT = (bf16*)(F.ws + WS_WG);
    for (int blk = F.vcu; blk < M / BLK; blk += F.G) {
        float cs[16];
#pragma unroll
        for (int i = 0; i < 16; ++i) cs[i] = 0.f;
        f32x4 gv[4];
#pragma unroll
        for (int j = 0; j < 4; ++j) gv[j] = *((const f32x4*)F.g_pre + F.lane + 64 * j);
        for (int i = 0; i < 32; ++i) {
            const size_t row = (size_t)blk * BLK + F.wave + 8 * i;
            const f32x4* xr = (const f32x4*)(F.x + row * DM) + F.lane;
            f32x4 v[4]; float s = 0.f;
#pragma unroll
            for (int j = 0; j < 4; ++j) { v[j] = xr[64 * j]; s += (v[j][0] * v[j][0] + v[j][1] * v[j][1]) + (v[j][2] * v[j][2] + v[j][3] * v[j][3]); }
            const float rs = 1.0f / sqrtf(wave_sum(s) * (1.f / DM) + RMS_EPS);
#pragma unroll
            for (int j = 0; j < 4; ++j) {
                float u[4]; unsigned h[4], l[4];
#pragma unroll
                for (int e = 0; e < 4; ++e) { u[e] = v[j][e] * rs * gv[j][e]; cs[j * 4 + e] += u[e]; h[e] = f2bf(u[e]); l[e] = f2bf(u[e] - __uint_as_float(h[e] << 16)); }
                const int col = 4 * F.lane + 256 * j;
                *(v2u*)(U2 + row * 2048 + col) = (v2u){h[0] | (h[1] << 16), h[2] | (h[3] << 16)};
                *(v2u*)(U2 + row * 2048 + 1024 + col) = (v2u){l[0] | (l[1] << 16), l[2] | (l[3] << 16)};
            }
        }
#pragma unroll
        for (int j = 0; j < 4; ++j)
#pragma unroll
            for (int e = 0; e < 4; ++e) red[F.wave * 1024 + 4 * F.lane + 256 * j + e] = cs[j * 4 + e];
        __syncthreads();
        for (int k = F.tid; k < 1024; k += NTHR) { float s = 0.f;
#pragma unroll
            for (int w = 0; w < 8; ++w) s += red[w * 1024 + k];
            ubar[k] = s * (1.f / BLK); }
        __syncthreads();
        { float s = 0.f; const float* wk = F.w_in + 512 + F.tid;
          for (int k = 0; k < 1024; ++k) s += ubar[k] * wk[(size_t)k * INC];
          kmean[F.tid] = s; }
        __syncthreads();
        { const int b = blk / NBLK, n = blk % NBLK;
          for (int k = F.tid; k < 1024; k += NTHR) { const float* wq = F.w_in + (size_t)k * INC;
              for (int h = 0; h < NH; ++h) { float s = 0.f;
                  for (int d = 0; d < HD; d += 4) { const f32x4 w4 = *(const f32x4*)(wq + h * HD + d); s += w4[0] * kmean[h * HD + d] + w4[1] * kmean[h * HD + d + 1] + w4[2] * kmean[h * HD + d + 2] + w4[3] * kmean[h * HD + d + 3]; }
                  const unsigned hi = f2bf(s), lo = f2bf(s - __uint_as_float(hi << 16));
                  bf16* r0 = WgT + ((size_t)b * 256 + h * 16 + n) * 2048; bf16* r1 = WgT + ((size_t)b * 256 + 128 + h * 16 + n) * 2048;
                  r0[k] = (bf16)hi; r0[1024 + k] = (bf16)hi; r1[k] = (bf16)lo; r1[1024 + k] = (bf16)lo; } } }
        __syncthreads();
    }
}

__device__ __forceinline__ void post_norm(Frame& F) {
    const float* Y = (const float*)(F.ws + WS_RW); float* RSY = (float*)(F.ws + WS_RSY); bf16* H1 = (bf16*)(F.ws + WS_QKVZ);
    const int gw = F.vcu * NWAVES + F.wave, NGW = F.G * NWAVES;
    f32x4 gv[4];
#pragma unroll
    for (int j = 0; j < 4; ++j) gv[j] = *((const f32x4*)F.g_post + F.lane + 64 * j);
    for (int row = gw; row < M; row += NGW) {
        const f32x4* yr = (const f32x4*)(Y + (size_t)row * DM) + F.lane; const f32x4* xr = (const f32x4*)(F.x + (size_t)row * DM) + F.lane;
        f32x4 v[4]; float s = 0.f;
#pragma unroll
        for (int j = 0; j < 4; ++j) { v[j] = yr[64 * j]; s += (v[j][0] * v[j][0] + v[j][1] * v[j][1]) + (v[j][2] * v[j][2] + v[j][3] * v[j][3]); }
        const float rs = 1.0f / sqrtf(wave_sum(s) * (1.f / DM) + RMS_EPS);
        if (F.lane == 0) RSY[row] = rs;
#pragma unroll
        for (int j = 0; j < 4; ++j) { const f32x4 xv = xr[64 * j]; float h[4];
#pragma unroll
            for (int e = 0; e < 4; ++e) h[e] = xv[e] + v[j][e] * rs * gv[j][e];
            *(v2u*)(H1 + (size_t)row * DM + 4 * F.lane + 256 * j) = (v2u){pk2(h[0], h[1]), pk2(h[2], h[3])}; }
    }
}
namespace moba {
using bf16x8 = __attribute__((ext_vector_type(8))) short;
using s16x4 = __attribute__((ext_vector_type(4))) short;
using f32x16 = __attribute__((ext_vector_type(16))) float;
using u32x4 = __attribute__((ext_vector_type(4))) unsigned;
typedef short v4i16_t __attribute__((ext_vector_type(4)));
typedef float f32x2_t __attribute__((ext_vector_type(2))); typedef __bf16 bf16x2_t __attribute__((ext_vector_type(2)));
__device__ __forceinline__ int crow(int r, int hi) { return (r & 3) + 8 * (r >> 2) + 4 * hi; }
__device__ __forceinline__ unsigned cvtpk(float lo, float hi) { f32x2_t v = {lo, hi}; bf16x2_t b = __builtin_convertvector(v, bf16x2_t); return __builtin_bit_cast(unsigned, b); }
__device__ __forceinline__ float max3f(float a, float b, float c) { return fmaxf(fmaxf(a, b), c); }

constexpr int SLOTB = 8192;
__device__ __forceinline__ void qkt(f32x16& p0, f32x16& p1, const LAS unsigned char* Kslot, const bf16x8* qr, int r32, int hi) {
    const LAS unsigned char* kb = Kslot + hi * 1024 + r32 * 16;
    const f32x16 z = {};
#pragma unroll
    for (int d0 = 0; d0 < 4; ++d0) {
        const bf16x8 b0 = *(const LAS bf16x8*)(kb + d0 * 2048);
        const bf16x8 b1 = *(const LAS bf16x8*)(kb + d0 * 2048 + 512);
        if (d0 == 0) { p0 = __builtin_amdgcn_mfma_f32_32x32x16_bf16(b0, qr[0], z, 0, 0, 0); p1 = __builtin_amdgcn_mfma_f32_32x32x16_bf16(b1, qr[0], z, 0, 0, 0); }
        else { p0 = __builtin_amdgcn_mfma_f32_32x32x16_bf16(b0, qr[d0], p0, 0, 0, 0); p1 = __builtin_amdgcn_mfma_f32_32x32x16_bf16(b1, qr[d0], p1, 0, 0, 0); } }
}
__device__ __forceinline__ void pv(f32x16* o, int vb, bf16x8 pa0, bf16x8 pa1, bf16x8 pa2, bf16x8 pa3) {
#pragma unroll
    for (int d0 = 0; d0 < 2; ++d0) { s16x4 lo[4], hi[4];
#pragma unroll
        for (int ks = 0; ks < 4; ++ks) {
            asm volatile("ds_read_b64_tr_b16 %0,%1 offset:%c2" : "=&v"(lo[ks]) : "v"(vb), "i"(d0 * 4096 + ks * 1024) : "memory");
            asm volatile("ds_read_b64_tr_b16 %0,%1 offset:%c2" : "=&v"(hi[ks]) : "v"(vb), "i"(d0 * 4096 + ks * 1024 + 512) : "memory"); }
        asm volatile("s_waitcnt lgkmcnt(0)" ::: "memory"); __builtin_amdgcn_sched_barrier(0);
#define PK(k) (bf16x8){lo[k][0], lo[k][1], lo[k][2], lo[k][3], hi[k][0], hi[k][1], hi[k][2], hi[k][3]}
        o[d0] = __builtin_amdgcn_mfma_f32_32x32x16_bf16(pa0, PK(0), o[d0], 0, 0, 0);
        o[d0] = __builtin_amdgcn_mfma_f32_32x32x16_bf16(pa1, PK(1), o[d0], 0, 0, 0);
        o[d0] = __builtin_amdgcn_mfma_f32_32x32x16_bf16(pa2, PK(2), o[d0], 0, 0, 0);
        o[d0] = __builtin_amdgcn_mfma_f32_32x32x16_bf16(pa3, PK(3), o[d0], 0, 0, 0);
#undef PK
    }
}
__device__ __forceinline__ float rowmax2(const f32x16& p0, const f32x16& p1, float a) {
#pragma unroll
    for (int r = 0; r < 16; r += 2) { a = max3f(a, p0[r], p0[r + 1]); a = max3f(a, p1[r], p1[r + 1]); }
    return a;
}
__device__ __forceinline__ float swapmax(float m) { auto rr = __builtin_amdgcn_permlane32_swap(__float_as_uint(m), __float_as_uint(m), false, false); return fmaxf(__uint_as_float(rr[0]), __uint_as_float(rr[1])); }
__device__ __forceinline__ float swapsum(float m) { auto rr = __builtin_amdgcn_permlane32_swap(__float_as_uint(m), __float_as_uint(m), false, false); return __uint_as_float(rr[0]) + __uint_as_float(rr[1]); }

__device__ __forceinline__ void load_kv_block(LAS unsigned char* lds, int KOFF, int VOFF, const bf16* QKVZ, size_t krow0, int h, int wid, int lane) {
    const bf16* ksrc = QKVZ + (krow0 + lane) * 2048 + 512 + h * HD + wid * 8;
    const bf16* vsrc = QKVZ + (krow0 + 16 * (wid & 3) + (lane >> 2)) * 2048 + 1024 + h * HD + (wid >> 2) * 32 + (lane & 3) * 8;
#pragma unroll
    for (int t = 0; t < 4; ++t) {
        __builtin_amdgcn_global_load_lds((const unsigned*)(ksrc + (size_t)t * 64 * 2048), (LAS unsigned*)(lds + KOFF + t * SLOTB + wid * 1024), 16, 0, 0);
        __builtin_amdgcn_global_load_lds((const unsigned*)(vsrc + (size_t)t * 64 * 2048), (LAS unsigned*)(lds + VOFF + t * SLOTB + wid * 1024), 16, 0, 0); }
}
}

constexpr int LIST_CAP = 3840;

__device__ __forceinline__ void attn_select(Frame& F, const float* GATE, unsigned* CNT, unsigned short* LISTS) {
    const int gw = F.vcu * NWAVES + F.wave, NGW = F.G * NWAVES;
    for (int it = gw; it < BATCH * NH * (SEQ / 64); it += NGW) {
        const int sg = it % (SEQ / 64), h = (it / (SEQ / 64)) % NH, b = it / (SEQ / 64 * NH);
        const int s = sg * 64 + F.lane, qb = s >> 8; const size_t row = (size_t)b * SEQ + s;
        if (qb == 0) continue;
        float g0 = -INFINITY, g1 = -INFINITY, g2 = -INFINITY; int i0 = -1, i1 = -1, i2 = -1;
        const f32x4* gp = (const f32x4*)(GATE + row * 256 + h * 16); const f32x4* gl = (const f32x4*)(GATE + row * 256 + 128 + h * 16);
#pragma unroll
        for (int c = 0; c < 4; ++c) { const f32x4 a = gp[c], l = gl[c];
#pragma unroll
            for (int e = 0; e < 4; ++e) { const int n = c * 4 + e; const float g = (n < qb) ? a[e] + l[e] : -INFINITY;
                if (g > g0) { g2 = g1; i2 = i1; g1 = g0; i1 = i0; g0 = g; i0 = n; } else if (g > g1) { g2 = g1; i2 = i1; g1 = g; i1 = n; } else if (g > g2) { g2 = g; i2 = n; } } }
        unsigned* cnt = CNT + (b * NH + h) * 16; unsigned short* lst = LISTS + (size_t)(b * NH + h) * 16 * LIST_CAP;
        for (int n = 0; n < qb; ++n) {
            const int slot = (i0 == n) ? 0 : ((i1 == n) ? 1 : ((i2 == n) ? 2 : -1));
            const unsigned long long mask = __ballot(slot >= 0);
            if (mask == 0ull) continue;
            const int before = __builtin_amdgcn_mbcnt_hi((unsigned)(mask >> 32), __builtin_amdgcn_mbcnt_lo((unsigned)mask, 0u));
            unsigned base = 0u;
            if (F.lane == 0) base = atomicAdd(cnt + n, (unsigned)__popcll(mask));
            base = __builtin_amdgcn_readfirstlane(base);
            if (slot >= 0) lst[(size_t)n * LIST_CAP + base + before] = (unsigned short)(s | (slot << 12));
        }
    }
}

__device__ __forceinline__ void attn_partial(Frame& F, const bf16* QKVZ, const unsigned* CNT, const unsigned short* LISTS, bf16* PART_O, float* PART_ML, unsigned* QCTR) {
    using namespace moba;
    LAS unsigned char* lds = F.lds; const int wid = F.wave, lane = F.lane, r32 = lane & 31, hi = lane >> 5;
    LAS float* btab = (LAS float*)(lds + 102400); LAS unsigned* uword = (LAS unsigned*)(lds + 106496);
    LAS float* wsf = (LAS float*)(lds + 98304) + wid * 128; LAS bf16* stg = (LAS bf16*)(lds + 65536) + wid * 2048;
    for (int i = F.tid; i < NH * 128; i += NTHR) { const int h = i >> 7, d = i & 127; btab[i] = (F.rel_bias[T5B[d] * NH + h] - F.rel_bias[31 * NH + h]) * LOG2E; }
    const int vb0 = (int)(uintptr_t)(lds + 32768) + ((lane >> 4) & 1) * 32 + (lane & 3) * 8 + (4 * hi + ((lane & 15) >> 2)) * 64;
    const int NUNIT = BATCH * NH * 15;
    for (;;) {
        __syncthreads();
        if (F.tid == 0) uword[0] = atomicAdd(QCTR, 1u);
        __syncthreads();
        const int u = (int)uword[0];
        if (u >= NUNIT) break;
        const int n = u / (BATCH * NH), bh = u % (BATCH * NH), b = bh / NH, h = bh % NH;
        load_kv_block(lds, 0, 32768, QKVZ, (size_t)b * SEQ + n * BLK, h, wid, lane);
        const int cnt = (int)CNT[bh * 16 + n]; const unsigned short* lst = LISTS + ((size_t)bh * 16 + n) * LIST_CAP;
        const float b31 = F.rel_bias[31 * NH + h] * LOG2E;
        __syncthreads();
        const int ntile = (cnt + 31) >> 5;
        for (int tile = wid; tile < ntile; tile += NWAVES) {
            const int idx = tile * 32 + r32; const bool valid = idx < cnt;
            const unsigned e = lst[valid ? idx : 0]; const int s = e & 4095, slot = e >> 12; const size_t row = (size_t)b * SEQ + s;
            bf16x8 qr[4];
#pragma unroll
            for (int d0 = 0; d0 < 4; ++d0) qr[d0] = *(const bf16x8*)(QKVZ + row * 2048 + h * HD + d0 * 16 + hi * 8);
            f32x16 p[4][2];
#pragma unroll
            for (int t = 0; t < 4; ++t) qkt(p[t][0], p[t][1], lds + t * SLOTB, qr, r32, hi);
            const bool near = ((s >> 8) == n + 1);
            if (__any(near)) {
                const int dbase = near ? (s - (n * BLK + 128)) : 100000;
#pragma unroll
                for (int t = 2; t < 4; ++t)
#pragma unroll
                    for (int r = 0; r < 16; ++r) { const int kv = (t - 2) * 64 + crow(r, hi); int d0 = dbase - kv, d1 = d0 - 32; d0 = d0 > 127 ? 127 : d0; d1 = d1 > 127 ? 127 : d1;
                        p[t][0][r] += btab[h * 128 + d0]; p[t][1][r] += btab[h * 128 + d1]; }
            }
            float mx = -INFINITY;
#pragma unroll
            for (int t = 0; t < 4; ++t) mx = rowmax2(p[t][0], p[t][1], mx);
            mx = swapmax(mx);
            float l = 0.f;
#pragma unroll
            for (int t = 0; t < 4; ++t)
#pragma unroll
                for (int r = 0; r < 16; ++r) { p[t][0][r] = exp2f(p[t][0][r] - mx); p[t][1][r] = exp2f(p[t][1][r] - mx); l += p[t][0][r] + p[t][1][r]; }
            l = swapsum(l);
            f32x16 o[2]; o[0] = f32x16{}; o[1] = f32x16{};
#pragma unroll
            for (int t = 0; t < 4; ++t) {
                u32x4 w0, w1, w2, w3;
                w0 = (u32x4){cvtpk(p[t][0][0], p[t][0][1]), cvtpk(p[t][0][2], p[t][0][3]), cvtpk(p[t][0][4], p[t][0][5]), cvtpk(p[t][0][6], p[t][0][7])};
                w1 = (u32x4){cvtpk(p[t][0][8], p[t][0][9]), cvtpk(p[t][0][10], p[t][0][11]), cvtpk(p[t][0][12], p[t][0][13]), cvtpk(p[t][0][14], p[t][0][15])};
                w2 = (u32x4){cvtpk(p[t][1][0], p[t][1][1]), cvtpk(p[t][1][2], p[t][1][3]), cvtpk(p[t][1][4], p[t][1][5]), cvtpk(p[t][1][6], p[t][1][7])};
                w3 = (u32x4){cvtpk(p[t][1][8], p[t][1][9]), cvtpk(p[t][1][10], p[t][1][11]), cvtpk(p[t][1][12], p[t][1][13]), cvtpk(p[t][1][14], p[t][1][15])};
                pv(o, vb0 + t * SLOTB, __builtin_bit_cast(bf16x8, w0), __builtin_bit_cast(bf16x8, w1), __builtin_bit_cast(bf16x8, w2), __builtin_bit_cast(bf16x8, w3));
            }
            if (hi == 0) { wsf[r32] = 1.0f / l; ((LAS int*)wsf)[32 + r32] = valid ? (int)(((row * NH + h) * 3 + slot)) : -1;
                           if (valid) { float2 ml; ml.x = mx + b31; ml.y = l; *(float2*)(PART_ML + ((row * NH + h) * 3 + slot) * 2) = ml; } }
            asm volatile("s_waitcnt lgkmcnt(0)" ::: "memory");
#pragma unroll
            for (int r = 0; r < 16; ++r) { const int orow = crow(r, hi); const float il = wsf[orow];
#pragma unroll
                for (int d0 = 0; d0 < 2; ++d0) stg[orow * 64 + d0 * 32 + r32] = (bf16)f2bf(o[d0][r] * il); }
            asm volatile("s_waitcnt lgkmcnt(0)" ::: "memory");
#pragma unroll
            for (int i = 0; i < 4; ++i) { const int rr = i * 8 + (lane >> 3), ch = lane & 7; const int dst = ((LAS int*)wsf)[32 + rr];
                const u32x4 v = *(const LAS u32x4*)(stg + rr * 64 + ch * 8);
                if (dst >= 0) *(u32x4*)(PART_O + (size_t)dst * 64 + ch * 8) = v; }
            asm volatile("s_waitcnt lgkmcnt(0)" ::: "memory");
        }
    }
}

__device__ __forceinline__ void attn_own_combine(Frame& F, bf16* QKVZ, const bf16* PART_O, const float* PART_ML) {
    using namespace moba;
    LAS unsigned char* lds = F.lds; const int wid = F.wave, lane = F.lane, r32 = lane & 31, hi = lane >> 5;
    LAS float* btab = (LAS float*)(lds + 139264);
    LAS float* wsf = (LAS float*)(lds + 135168) + wid * 128; LAS float* ost = (LAS float*)(lds + 65536 + wid * 8704);
    __syncthreads();
    for (int i = F.tid; i < NH * 256; i += NTHR) { const int h = i >> 8, d = i & 255; btab[i] = F.rel_bias[T5B[d < 127 ? d : 127] * NH + h] * LOG2E; }
    const int vb0 = (int)(uintptr_t)(lds + 32768) + ((lane >> 4) & 1) * 32 + (lane & 3) * 8 + (4 * hi + ((lane & 15) >> 2)) * 64;
    for (int u = F.vcu; u < BATCH * NH * NBLK; u += F.G) {
        const int qb = u % NBLK, bh = u / NBLK, b = bh / NH, h = bh % NH;
        __syncthreads();
        load_kv_block(lds, 0, 32768, QKVZ, (size_t)b * SEQ + qb * BLK, h, wid, lane);
        const int sq = qb * BLK + wid * 32 + r32; const size_t row = (size_t)b * SEQ + sq;
        bf16x8 qr[4];
#pragma unroll
        for (int d0 = 0; d0 < 4; ++d0) qr[d0] = *(const bf16x8*)(QKVZ + row * 2048 + h * HD + d0 * 16 + hi * 8);
        __syncthreads();
        const int nt = (wid >> 1) + 1;
        int ql = wid * 32 + r32;
        asm volatile("" : "+v"(ql));
        const LAS float* bt = btab + h * 256;
        float mx = -INFINITY;
#define A2_SCORES(P0, P1, t) do { qkt(P0, P1, lds + (t) * SLOTB, qr, r32, hi); \
            if ((t) < nt - 1) { _Pragma("unroll") for (int r = 0; r < 16; ++r) { const int kv = (t) * 64 + crow(r, hi); const int d0 = ql - kv, d1 = d0 - 32; P0[r] += bt[d0]; P1[r] += bt[d1]; } } \
            else { _Pragma("unroll") for (int r = 0; r < 16; ++r) { const int kv = (t) * 64 + crow(r, hi); const int d0 = ql - kv, d1 = d0 - 32; const float b0 = bt[d0 < 0 ? 0 : d0], b1 = bt[d1 < 0 ? 0 : d1]; \
                P0[r] = d0 >= 0 ? P0[r] + b0 : -INFINITY; P1[r] = d1 >= 0 ? P1[r] + b1 : -INFINITY; } } } while (0)
#pragma unroll 1
        for (int t = 0; t < nt; ++t) { f32x16 p0, p1; A2_SCORES(p0, p1, t); mx = rowmax2(p0, p1, mx); }
        mx = swapmax(mx);
        float l = 0.f;
        f32x16 o[2]; o[0] = f32x16{}; o[1] = f32x16{};
#pragma unroll 1
        for (int t = 0; t < nt; ++t) { f32x16 p0, p1; A2_SCORES(p0, p1, t);
#pragma unroll
            for (int r = 0; r < 16; ++r) { p0[r] = exp2f(p0[r] - mx); p1[r] = exp2f(p1[r] - mx); l += p0[r] + p1[r]; }
            u32x4 w0, w1, w2, w3;
            w0 = (u32x4){cvtpk(p0[0], p0[1]), cvtpk(p0[2], p0[3]), cvtpk(p0[4], p0[5]), cvtpk(p0[6], p0[7])};
            w1 = (u32x4){cvtpk(p0[8], p0[9]), cvtpk(p0[10], p0[11]), cvtpk(p0[12], p0[13]), cvtpk(p0[14], p0[15])};
            w2 = (u32x4){cvtpk(p1[0], p1[1]), cvtpk(p1[2], p1[3]), cvtpk(p1[4], p1[5]), cvtpk(p1[6], p1[7])};
            w3 = (u32x4){cvtpk(p1[8], p1[9]), cvtpk(p1[10], p1[11]), cvtpk(p1[12], p1[13]), cvtpk(p1[14], p1[15])};
            pv(o, vb0 + t * SLOTB, __builtin_bit_cast(bf16x8, w0), __builtin_bit_cast(bf16x8, w1), __builtin_bit_cast(bf16x8, w2), __builtin_bit_cast(bf16x8, w3));
        }
#undef A2_SCORES
        l = swapsum(l);
        if (hi == 0) { wsf[r32] = mx; wsf[32 + r32] = l; }
#pragma unroll
        for (int r = 0; r < 16; ++r) { const int orow = crow(r, hi);
#pragma unroll
            for (int d0 = 0; d0 < 2; ++d0) ost[orow * 68 + d0 * 32 + r32] = o[d0][r]; }
        asm volatile("s_waitcnt lgkmcnt(0)" ::: "memory");
        { const int q = lane >> 1, c0 = (lane & 1) * 32; const int s2 = qb * BLK + wid * 32 + q; const size_t row2 = (size_t)b * SEQ + s2;
          const float m0 = wsf[q], l0 = wsf[32 + q]; const int np = qb < 3 ? qb : 3;
          float mj[3], lj[3]; float mt = m0;
#pragma unroll
          for (int j = 0; j < 3; ++j) { if (j < np) { const float2 ml = *(const float2*)(PART_ML + ((row2 * NH + h) * 3 + j) * 2); mj[j] = ml.x; lj[j] = ml.y; mt = fmaxf(mt, ml.x); } else { mj[j] = -INFINITY; lj[j] = 0.f; } }
          const float w0 = exp2f(m0 - mt); float wj[3]; float den = w0 * l0;
#pragma unroll
          for (int j = 0; j < 3; ++j) { wj[j] = (j < np) ? exp2f(mj[j] - mt) * lj[j] : 0.f; den += wj[j]; }
          const float iden = 1.0f / den;
          float acc[32];
#pragma unroll
          for (int c = 0; c < 32; c += 4) { const f32x4 v = *(const LAS f32x4*)(ost + q * 68 + c0 + c); acc[c] = v[0] * w0; acc[c + 1] = v[1] * w0; acc[c + 2] = v[2] * w0; acc[c + 3] = v[3] * w0; }
#pragma unroll
          for (int j = 0; j < 3; ++j) if (j < np) { const v4u* pp = (const v4u*)(PART_O + ((row2 * NH + h) * 3 + j) * 64 + c0);
#pragma unroll
              for (int c = 0; c < 4; ++c) { const v4u w = pp[c]; const float f = wj[j];
                  acc[c * 8 + 0] += f * __uint_as_float(w.x << 16); acc[c * 8 + 1] += f * __uint_as_float(w.x & 0xffff0000u); acc[c * 8 + 2] += f * __uint_as_float(w.y << 16); acc[c * 8 + 3] += f * __uint_as_float(w.y & 0xffff0000u);
                  acc[c * 8 + 4] += f * __uint_as_float(w.z << 16); acc[c * 8 + 5] += f * __uint_as_float(w.z & 0xffff0000u); acc[c * 8 + 6] += f * __uint_as_float(w.w << 16); acc[c * 8 + 7] += f * __uint_as_float(w.w & 0xffff0000u); } }
          const v4u* zp = (const v4u*)(QKVZ + row2 * 2048 + 1536 + h * HD + c0); v4u* op = (v4u*)(QKVZ + row2 * 2048 + h * HD + c0);
#pragma unroll
          for (int c = 0; c < 4; ++c) { const v4u w = zp[c]; const float z[8] = {__uint_as_float(w.x << 16), __uint_as_float(w.x & 0xffff0000u), __uint_as_float(w.y << 16), __uint_as_float(w.y & 0xffff0000u),
                                                                               __uint_as_float(w.z << 16), __uint_as_float(w.z & 0xffff0000u), __uint_as_float(w.w << 16), __uint_as_float(w.w & 0xffff0000u)};
              float rr[8];
#pragma unroll
              for (int e2 = 0; e2 < 8; ++e2) rr[e2] = acc[c * 8 + e2] * iden * z[e2] * sigm(z[e2]);
              v4u ow; ow.x = pk2(rr[0], rr[1]); ow.y = pk2(rr[2], rr[3]); ow.z = pk2(rr[4], rr[5]); ow.w = pk2(rr[6], rr[7]); op[c] = ow; } }
        asm volatile("s_waitcnt lgkmcnt(0)" ::: "memory");
    }
}
namespace rk {
using bf16x8 = __attribute__((ext_vector_type(8))) short;
using s16x4 = __attribute__((ext_vector_type(4))) short;
using f32x16 = __attribute__((ext_vector_type(16))) float;
using u32x4 = __attribute__((ext_vector_type(4))) unsigned;
using u32x2 = __attribute__((ext_vector_type(2))) unsigned;
typedef short v4i16_t __attribute__((ext_vector_type(4)));
typedef float f32x2_t __attribute__((ext_vector_type(2))); typedef __bf16 bf16x2_t __attribute__((ext_vector_type(2)));
constexpr int P = 144, IMG = 64 * P, GRP = 81920, MISC = 8 * IMG;
#define RK_MFMA(a, b, c) __builtin_amdgcn_mfma_f32_32x32x16_bf16((a), (b), (c), 0, 0, 0)
__device__ __forceinline__ int crow(int r, int hi) { return (r & 3) + 8 * (r >> 2) + 4 * hi; }
__device__ __forceinline__ unsigned cvtpk(float lo, float hi) { f32x2_t v = {lo, hi}; bf16x2_t b = __builtin_convertvector(v, bf16x2_t); return __builtin_bit_cast(unsigned, b); }
__device__ __forceinline__ float bflo(unsigned w) { return __uint_as_float(w << 16); }
__device__ __forceinline__ float bfhi(unsigned w) { return __uint_as_float(w & 0xffff0000u); }
__device__ __forceinline__ s16x4 trrd(const LAS unsigned char* p) { return __builtin_bit_cast(s16x4, __builtin_amdgcn_ds_read_tr16_b64_v4i16((LAS v4i16_t*)p)); }
struct Ln { int r, h, blk, q, p; };
__device__ __forceinline__ bf16x8 frag_row(const LAS unsigned char* img, const Ln& l, int tile, int s, int coloff = 0) { return *(const LAS bf16x8*)(img + (32 * tile + l.r) * P + (coloff + 16 * s + 8 * l.h) * 2); }
__device__ __forceinline__ bf16x8 frag_tr(const LAS unsigned char* img, const Ln& l, int tile, int s, int rowoff = 0) {
    const LAS unsigned char* b = img + (rowoff + 16 * s + 8 * l.h + l.q) * P + 64 * tile + 32 * l.blk + 8 * l.p;
    const s16x4 lo = trrd(b), hi = trrd(b + 4 * P);
    return (bf16x8){lo[0], lo[1], lo[2], lo[3], hi[0], hi[1], hi[2], hi[3]};
}
__device__ __forceinline__ bf16x8 frag_row_perm(const LAS unsigned char* img, const Ln& l, int tile, int s, int coloff = 0) {
    const LAS unsigned char* b = img + (32 * tile + l.r) * P + (coloff + 16 * s + 4 * l.h) * 2;
    const s16x4 lo = *(const LAS s16x4*)b, hi = *(const LAS s16x4*)(b + 16);
    return (bf16x8){lo[0], lo[1], lo[2], lo[3], hi[0], hi[1], hi[2], hi[3]};
}
__device__ __forceinline__ bf16x8 frag_tr_perm(const LAS unsigned char* img, const Ln& l, int tile, int s, int rowoff = 0) {
    const LAS unsigned char* b = img + (rowoff + 16 * s + 4 * l.h + l.q) * P + 64 * tile + 32 * l.blk + 8 * l.p;
    const s16x4 lo = trrd(b), hi = trrd(b + 8 * P);
    return (bf16x8){lo[0], lo[1], lo[2], lo[3], hi[0], hi[1], hi[2], hi[3]};
}
__device__ __forceinline__ bf16x8 pack(const f32x16& x, int s) {
    u32x4 w; w.x = cvtpk(x[8 * s], x[8 * s + 1]); w.y = cvtpk(x[8 * s + 2], x[8 * s + 3]); w.z = cvtpk(x[8 * s + 4], x[8 * s + 5]); w.w = cvtpk(x[8 * s + 6], x[8 * s + 7]);
    return __builtin_bit_cast(bf16x8, w);
}
__device__ __forceinline__ void store_T(LAS unsigned char* img, const Ln& l, const f32x16& x, int ti, int tj) {
#pragma unroll
    for (int g = 0; g < 4; ++g) { u32x2 w; w.x = cvtpk(x[4 * g], x[4 * g + 1]); w.y = cvtpk(x[4 * g + 2], x[4 * g + 3]);
        *(LAS u32x2*)(img + (32 * tj + l.r) * P + (32 * ti + 8 * g + 4 * l.h) * 2) = w; }
}
__device__ __forceinline__ float xhalf(float v) { return __shfl_xor(v, 32); }
__device__ __forceinline__ void tri_inv32(f32x16& D, f32x16& DT, f32x16 S, f32x16 ST) {
    const f32x16 z = {};
#pragma unroll
    for (int it = 0; it < 4; ++it) {
        f32x16 S2 = z, S2T = z;
#pragma unroll
        for (int s = 0; s < 2; ++s) { const bf16x8 ps = pack(S, s), pst = pack(ST, s); S2 = RK_MFMA(pst, ps, S2); S2T = RK_MFMA(ps, pst, S2T); }
        f32x16 DS = S2, DST = S2T;
#pragma unroll
        for (int s = 0; s < 2; ++s) { DS = RK_MFMA(pack(DT, s), pack(S2, s), DS); DST = RK_MFMA(pack(S2, s), pack(DT, s), DST); }
        D = D + DS; DT = DT + DST; S = S2; ST = S2T;
    }
}
}

constexpr size_t DO_NT = 0, DO_MT = 128 * MiB, DO_RH = 192 * MiB;

__device__ __forceinline__ void rwkv_chunk_ops(Frame& F) {
    using namespace rk;
    const int grp = F.wave >> 2, w4 = F.wave & 3, ti = w4 >> 1, tj = w4 & 1;
    int lane, tg; Ln l;
#define RK_RELANE() do { int t_ = F.tid; asm volatile("" : "+v"(t_)); lane = t_ & 63; tg = t_ & 255; l.r = lane & 31; l.h = lane >> 5; l.blk = (lane >> 4) & 1; l.q = (lane & 15) >> 2; l.p = lane & 3; } while (0)
    RK_RELANE();
    LAS unsigned char* G = F.lds + grp * GRP;
    LAS unsigned char* s0 = G, *s1 = G + IMG, *s2 = G + 2 * IMG, *s3 = G + 3 * IMG, *s4 = G + 4 * IMG, *s5 = G + 5 * IMG, *s6 = G + 6 * IMG, *s7 = G + 7 * IMG;
    LAS float* nrminv = (LAS float*)(G + MISC); LAS float* ltot = nrminv + 64; LAS float* gam = ltot + 64; LAS float* bonp = gam + 64;
    const bf16* RW = (const bf16*)(F.ws + WS_RW); const bf16* WupT = (const bf16*)(F.ws + WS_WUPT); const bf16* AupT = (const bf16*)(F.ws + WS_AUPT);
    float* NT = (float*)((unsigned char*)F.out + DO_NT); bf16* MT = (bf16*)((unsigned char*)F.out + DO_MT); bf16* RH = (bf16*)((unsigned char*)F.out + DO_RH);
    bf16* Y0 = (bf16*)(F.ws + WS_GATE); float* BON = (float*)(F.ws + WS_BON);
    const f32x16 z16 = {};
    for (int ip = F.vcu; ip < BATCH * NH * 64 / 2; ip += F.G) {
        const int item = ip * 2 + grp, c = item & 63, bh = item >> 6, h = bh % NH, b = bh / NH;
        RK_RELANE();
        { const int t = tg >> 2, q4 = tg & 3; const int sq = c * 64 + t; const size_t row = (size_t)b * SEQ + sq;
          const bf16* cur = RW + row * RWC; const bool hasp = sq > 0; const bf16* prv = hasp ? cur - RWC : cur; const float pm = hasp ? 1.f : 0.f;
          float nr = 0.f;
#pragma unroll
          for (int half = 0; half < 2; ++half) { const int k0 = 16 * q4 + 8 * half, col = h * HD + k0;
              const v4u cr = *(const v4u*)(cur + col), pr = *(const v4u*)(prv + col), ck = *(const v4u*)(cur + 512 + col), pk = *(const v4u*)(prv + 512 + col), cv = *(const v4u*)(cur + 1024 + col), pv = *(const v4u*)(prv + 1024 + col);
              const v4u cw = *(const v4u*)(cur + 2048 + k0), pw = *(const v4u*)(prv + 2048 + k0), ca = *(const v4u*)(cur + 2112 + k0), pa = *(const v4u*)(prv + 2112 + k0);
              float ro[8], ko[8], vo[8], wo[8], ao[8];
#pragma unroll
              for (int e = 0; e < 8; ++e) { const unsigned wcr = cr[e >> 1], wpr = pr[e >> 1], wck = ck[e >> 1], wpk = pk[e >> 1], wcv = cv[e >> 1], wpv = pv[e >> 1];
                  const unsigned wcw = cw[e >> 1], wpw = pw[e >> 1], wca = ca[e >> 1], wpa = pa[e >> 1];
                  const float xr = (e & 1) ? bfhi(wcr) : bflo(wcr), yr = pm * ((e & 1) ? bfhi(wpr) : bflo(wpr)); ro[e] = xr + (yr - xr) * F.mu[col + e];
                  const float xk = (e & 1) ? bfhi(wck) : bflo(wck), yk = pm * ((e & 1) ? bfhi(wpk) : bflo(wpk)); ko[e] = xk + (yk - xk) * F.mu[512 + col + e];
                  const float xv = (e & 1) ? bfhi(wcv) : bflo(wcv), yv = pm * ((e & 1) ? bfhi(wpv) : bflo(wpv)); vo[e] = xv + (yv - xv) * F.mu[1024 + col + e];
                  const float xw = (e & 1) ? bfhi(wcw) : bflo(wcw), yw = pm * ((e & 1) ? bfhi(wpw) : bflo(wpw)); wo[e] = tanhf(xw + (yw - xw) * F.mu[2048 + k0 + e]);
                  const float xa = (e & 1) ? bfhi(wca) : bflo(wca), ya = pm * ((e & 1) ? bfhi(wpa) : bflo(wpa)); ao[e] = xa + (ya - xa) * F.mu[2112 + k0 + e];
                  const float kkx = ko[e] * F.k_k[col + e]; nr += kkx * kkx; }
              const int off = t * P + k0 * 2;
              *(LAS u32x4*)(s0 + off) = (u32x4){cvtpk(wo[0], wo[1]), cvtpk(wo[2], wo[3]), cvtpk(wo[4], wo[5]), cvtpk(wo[6], wo[7])};
              *(LAS u32x4*)(s1 + off) = (u32x4){cvtpk(ao[0], ao[1]), cvtpk(ao[2], ao[3]), cvtpk(ao[4], ao[5]), cvtpk(ao[6], ao[7])};
              *(LAS u32x4*)(s2 + off) = (u32x4){cvtpk(ro[0], ro[1]), cvtpk(ro[2], ro[3]), cvtpk(ro[4], ro[5]), cvtpk(ro[6], ro[7])};
              *(LAS u32x4*)(s3 + off) = (u32x4){cvtpk(ko[0], ko[1]), cvtpk(ko[2], ko[3]), cvtpk(ko[4], ko[5]), cvtpk(ko[6], ko[7])};
              *(LAS u32x4*)(s4 + off) = (u32x4){cvtpk(vo[0], vo[1]), cvtpk(vo[2], vo[3]), cvtpk(vo[4], vo[5]), cvtpk(vo[6], vo[7])}; }
          nr += __shfl_xor(nr, 1); nr += __shfl_xor(nr, 2);
          if (q4 == 0) nrminv[t] = 1.0f / fmaxf(sqrtf(nr), 1e-12f); }
        __syncthreads();
        RK_RELANE();
        {
            const int kcol = 32 * tj + l.r, kc = h * HD + kcol;
            f32x16 W = z16, Aq = z16;
#pragma unroll
            for (int s = 0; s < 4; ++s) { const bf16x8 bw = *(const bf16x8*)(WupT + (size_t)kc * 64 + 16 * s + 8 * l.h), ba = *(const bf16x8*)(AupT + (size_t)kc * 64 + 16 * s + 8 * l.h);
                W = RK_MFMA(frag_row(s0, l, ti, s), bw, W); Aq = RK_MFMA(frag_row(s1, l, ti, s), ba, Aq); }
            const float w0 = F.w0[kc], a0 = F.a0[kc], kkc = F.k_k[kc], kac = F.k_a[kc], rkc = F.r_k[kc];
            float lw[16], L[16];
#pragma unroll
            for (int r = 0; r < 16; ++r) { const float x = W[r] + w0; const float sp = (-x > 20.f) ? -x : log1pf(__expf(-x)); lw[r] = -__expf(-sp - 0.5f); Aq[r] = sigm(Aq[r] + a0); }
            float gs[4], go[4];
#pragma unroll
            for (int g = 0; g < 4; ++g) { L[4 * g] = lw[4 * g]; L[4 * g + 1] = L[4 * g] + lw[4 * g + 1]; L[4 * g + 2] = L[4 * g + 1] + lw[4 * g + 2]; L[4 * g + 3] = L[4 * g + 2] + lw[4 * g + 3]; gs[g] = L[4 * g + 3]; }
            float run = 0.f;
#pragma unroll
            for (int g = 0; g < 4; ++g) { const float og = xhalf(gs[g]); const float lo = l.h ? og : gs[g], hi = l.h ? gs[g] : og;
                go[g] = run + (l.h ? lo : 0.f); run += lo + hi; }
#pragma unroll
            for (int r = 0; r < 16; ++r) L[r] += go[r >> 2];
            if (ti == 0 && l.h == 0) ltot[kcol] = run;
            __syncthreads();
            if (ti == 1) { const float add = ltot[kcol];
#pragma unroll
                for (int r = 0; r < 16; ++r) L[r] += add;
                if (l.h == 1) gam[kcol] = __expf(L[15]); }
            f32x16 At, Bt, Kt, Rt; float xb[16];
#pragma unroll
            for (int r = 0; r < 16; ++r) { const int t = 32 * ti + crow(r, l.h);
                const float rr = bf2f(*(const LAS unsigned short*)(s2 + t * P + kcol * 2)), kx = bf2f(*(const LAS unsigned short*)(s3 + t * P + kcol * 2));
                const float kn = kx * kkc * nrminv[t], a = Aq[r], km = kx * (1.0f + (a - 1.0f) * kac);
                const float eL = __expf(L[r]), eLn = __expf(-L[r]), eLp = __expf(L[r] - lw[r]);
                At[r] = -kn * eLp; Bt[r] = kn * a * eLn; Kt[r] = km * eLn; Rt[r] = rr * eL; xb[r] = rr * km * rkc; }
#pragma unroll
            for (int r = 0; r < 16; ++r) { float v = xb[r]; v += __shfl_xor(v, 1); v += __shfl_xor(v, 2); v += __shfl_xor(v, 4); v += __shfl_xor(v, 8); v += __shfl_xor(v, 16); xb[r] = v; }
            if (l.r == 0) {
#pragma unroll
                for (int r = 0; r < 16; ++r) bonp[tj * 64 + 32 * ti + crow(r, l.h)] = xb[r]; }
            store_T(s0, l, At, ti, tj); store_T(s1, l, Bt, ti, tj); store_T(s5, l, Kt, ti, tj); store_T(s6, l, Rt, ti, tj);
        }
        __syncthreads();
        RK_RELANE();
        {
            f32x16 X = z16;
            if (ti >= tj) {
#pragma unroll
                for (int s = 0; s < 4; ++s) X = RK_MFMA(frag_tr(s0, l, ti, s), frag_tr(s5, l, tj, s), X);
#pragma unroll
                for (int r = 0; r < 16; ++r) { const int t = 32 * ti + crow(r, l.h), i = 32 * tj + l.r; if (!(t > i)) X[r] = 0.f; } }
            store_T(s2, l, X, ti, tj);
            if (w4 == 0 || w4 == 3) { const int d = w4 == 3;
                f32x16 S = z16, ST = z16;
#pragma unroll
                for (int s = 0; s < 4; ++s) { const bf16x8 fa = frag_tr(s0, l, d, s), fb = frag_tr(s1, l, d, s); S = RK_MFMA(fa, fb, S); ST = RK_MFMA(fb, fa, ST); }
#pragma unroll
                for (int r = 0; r < 16; ++r) { const int rw = crow(r, l.h); if (!(rw > l.r)) S[r] = 0.f; if (!(l.r > rw)) ST[r] = 0.f; }
                f32x16 D = S, DT = ST;
                tri_inv32(D, DT, S, ST);
                store_T(s7, l, D, d, d);
                asm volatile("s_waitcnt lgkmcnt(0)" ::: "memory");
                if (l.h == 0) *(LAS unsigned short*)(s7 + (32 * d + l.r) * P + (32 * d + l.r) * 2) = 0x3f80;
            } else if (w4 == 2) {
                f32x16 X21 = z16;
#pragma unroll
                for (int s = 0; s < 4; ++s) X21 = RK_MFMA(frag_tr(s0, l, 1, s), frag_tr(s1, l, 0, s), X21);
                store_T(s3, l, X21, 0, 0);
            } else {
                store_T(s7, l, z16, 0, 1);
                if (lane < 64) { const int t = lane; BON[((size_t)b * SEQ + c * 64 + t) * NH + h] = bonp[t] + bonp[64 + t]; }
            }
        }
        __syncthreads();
        RK_RELANE();
        f32x16 Wt0 = z16, Wt1 = z16;
        {
            if (w4 == 2) {
                f32x16 E = z16;
#pragma unroll
                for (int s = 0; s < 2; ++s) E = RK_MFMA(frag_tr(s3, l, 0, s), frag_row(s7, l, 0, s), E);
                store_T(s3, l, E, 0, 1);
                f32x16 T21 = z16;
#pragma unroll
                for (int s = 0; s < 2; ++s) T21 = RK_MFMA(frag_tr(s7, l, 1, s, 32), frag_row(s3, l, 1, s), T21);
                store_T(s7, l, T21, 1, 0);
            }
#pragma unroll
            for (int s = 0; s < 4; ++s) Wt0 = RK_MFMA(frag_tr(s2, l, 0, s), frag_tr(s4, l, tj, s), Wt0);
            if (ti == 1) {
#pragma unroll
                for (int s = 0; s < 4; ++s) Wt1 = RK_MFMA(frag_tr(s2, l, 1, s), frag_tr(s4, l, tj, s), Wt1); }
        }
        __syncthreads();
        RK_RELANE();
        {
            f32x16 Ap = z16;
#pragma unroll
            for (int s = 0; s < 4; ++s) if (s < 2 || ti == 1) Ap = RK_MFMA(frag_tr(s7, l, ti, s), frag_row(s0, l, tj, s), Ap);
            f32x16 Uv = z16;
#pragma unroll
            for (int s = 0; s < 2; ++s) Uv = RK_MFMA(frag_tr_perm(s7, l, ti, s, 0), pack(Wt0, s), Uv);
            if (ti == 1) {
#pragma unroll
                for (int s = 0; s < 2; ++s) Uv = RK_MFMA(frag_tr_perm(s7, l, ti, s, 32), pack(Wt1, s), Uv); }
            store_T(s2, l, Ap, ti, tj); store_T(s3, l, Uv, ti, tj);
        }
        __syncthreads();
        RK_RELANE();
        {
            const size_t ib = (size_t)item * 4096;
            f32x16 Xrb0 = z16, Xrk0 = z16, Xrb1 = z16, Xrk1 = z16;
#pragma unroll
            for (int s = 0; s < 4; ++s) { const bf16x8 fr = frag_tr(s6, l, ti, s); Xrb0 = RK_MFMA(frag_tr(s1, l, 0, s), fr, Xrb0); Xrk0 = RK_MFMA(frag_tr(s5, l, 0, s), fr, Xrk0); }
            if (ti == 1) {
#pragma unroll
                for (int s = 0; s < 4; ++s) { const bf16x8 fr = frag_tr(s6, l, ti, s); Xrb1 = RK_MFMA(frag_tr(s1, l, 1, s), fr, Xrb1); Xrk1 = RK_MFMA(frag_tr(s5, l, 1, s), fr, Xrk1); } }
#pragma unroll
            for (int r = 0; r < 16; ++r) { const bool keep = crow(r, l.h) <= l.r; if (ti == 0) { if (!keep) { Xrb0[r] = 0.f; Xrk0[r] = 0.f; } } else { if (!keep) { Xrb1[r] = 0.f; Xrk1[r] = 0.f; } } }
            f32x16 acc;
#pragma unroll
            for (int g = 0; g < 4; ++g) { const u32x2 w = *(const LAS u32x2*)(s6 + (32 * tj + l.r) * P + (32 * ti + 8 * g + 4 * l.h) * 2); acc[4 * g] = bflo(w.x); acc[4 * g + 1] = bfhi(w.x); acc[4 * g + 2] = bflo(w.y); acc[4 * g + 3] = bfhi(w.y); }
#pragma unroll
            for (int s = 0; s < 2; ++s) acc = RK_MFMA(pack(Xrb0, s), frag_row_perm(s2, l, tj, s, 0), acc);
            if (ti == 1) {
#pragma unroll
                for (int s = 0; s < 2; ++s) acc = RK_MFMA(pack(Xrb1, s), frag_row_perm(s2, l, tj, s, 32), acc); }
#pragma unroll
            for (int r = 0; r < 16; ++r) RH[ib + (32 * ti + crow(r, l.h)) * 64 + 32 * tj + l.r] = (bf16)f2bf(acc[r]);
            acc = z16;
#pragma unroll
            for (int s = 0; s < 2; ++s) { acc = RK_MFMA(pack(Xrb0, s), frag_row_perm(s3, l, tj, s, 0), acc); acc = RK_MFMA(pack(Xrk0, s), frag_tr_perm(s4, l, tj, s, 0), acc); }
            if (ti == 1) {
#pragma unroll
                for (int s = 0; s < 2; ++s) { acc = RK_MFMA(pack(Xrb1, s), frag_row_perm(s3, l, tj, s, 32), acc); acc = RK_MFMA(pack(Xrk1, s), frag_tr_perm(s4, l, tj, s, 32), acc); } }
#pragma unroll
            for (int r = 0; r < 16; ++r) Y0[ib + (32 * ti + crow(r, l.h)) * 64 + 32 * tj + l.r] = (bf16)f2bf(acc[r]);
            acc = z16;
#pragma unroll
            for (int s = 0; s < 4; ++s) acc = RK_MFMA(frag_row(s1, l, ti, s), frag_row(s2, l, tj, s), acc);
#pragma unroll
            for (int r = 0; r < 16; ++r) { const int kp = 32 * ti + crow(r, l.h), k = 32 * tj + l.r; const float v = (acc[r] + (kp == k ? 1.f : 0.f)) * gam[kp]; MT[ib + kp * 64 + k] = (bf16)f2bf(v); }
            acc = z16;
#pragma unroll
            for (int s = 0; s < 4; ++s) { acc = RK_MFMA(frag_row(s1, l, ti, s), frag_row(s3, l, tj, s), acc); acc = RK_MFMA(frag_row(s5, l, ti, s), frag_tr(s4, l, tj, s), acc); }
#pragma unroll
            for (int r = 0; r < 16; ++r) NT[ib + ((ti * 2 + tj) * 16 + r) * 64 + lane] = acc[r] * gam[32 * ti + crow(r, l.h)];
        }
        __syncthreads();
    }
}

__device__ __forceinline__ void rwkv_scan(Frame& F) {
    using namespace rk;
    const int lane = F.lane, wid = F.wave; const int lr = lane & 31, lh = lane >> 5;
    LAS float* sbuf = (LAS float*)F.lds; LAS float* yst = (LAS float*)(F.lds + 32768 + wid * 8704); LAS float* cst = (LAS float*)(F.lds + 102400);
    volatile LAS int* flag = (volatile LAS int*)(F.lds + 103936);
    const bf16* RW = (const bf16*)(F.ws + WS_RW); bf16* QKVZ = (bf16*)(F.ws + WS_QKVZ);
    const float* NT = (const float*)((unsigned char*)F.out + DO_NT); const bf16* MT = (const bf16*)((unsigned char*)F.out + DO_MT); const bf16* RH = (const bf16*)((unsigned char*)F.out + DO_RH);
    const bf16* Y0 = (const bf16*)(F.ws + WS_GATE); const float* BON = (const float*)(F.ws + WS_BON);
    for (int bh = F.vcu; bh < BATCH * NH; bh += F.G) {
        const int h = bh % NH, b = bh / NH;
        __syncthreads();
        for (int i = F.tid; i < 6 * 64; i += NTHR) { const int a = i >> 6, v = i & 63, col = h * HD + v;
            cst[i] = a == 0 ? F.mu[1024 + col] : a == 1 ? F.mu[1536 + col] : a == 2 ? F.ln_w[col] : a == 3 ? F.ln_b[col] : 0.f; }
        for (int i = F.tid; i < 4096; i += NTHR) sbuf[i] = 0.f;
        if (F.tid == 0) flag[0] = 0;
        __syncthreads();
        for (int c = wid; c < 64; c += NWAVES) {
            const size_t ib = (size_t)(bh * 64 + c) * 4096;
            bf16x8 am[2][4], ar[2][4]; f32x16 sn[2][2];
#pragma unroll
            for (int rt = 0; rt < 2; ++rt)
#pragma unroll
                for (int s = 0; s < 4; ++s) { const bf16* pm = MT + ib + (32 * rt + lr) * 64 + 16 * s + 4 * lh; const bf16* pr = RH + ib + (32 * rt + lr) * 64 + 16 * s + 4 * lh;
                    const v2u m0 = *(const v2u*)pm, m1 = *(const v2u*)(pm + 8), r0 = *(const v2u*)pr, r1 = *(const v2u*)(pr + 8);
                    am[rt][s] = __builtin_bit_cast(bf16x8, (u32x4){m0.x, m0.y, m1.x, m1.y}); ar[rt][s] = __builtin_bit_cast(bf16x8, (u32x4){r0.x, r0.y, r1.x, r1.y}); }
#pragma unroll
            for (int rt = 0; rt < 2; ++rt)
#pragma unroll
                for (int ct = 0; ct < 2; ++ct)
#pragma unroll
                    for (int r = 0; r < 16; ++r) sn[rt][ct][r] = NT[ib + ((rt * 2 + ct) * 16 + r) * 64 + lane];
            while (flag[0] < c) __builtin_amdgcn_s_sleep(1);
            asm volatile("s_waitcnt lgkmcnt(0)" ::: "memory");
            const LAS float* sin = sbuf + (c & 1) * 4096; LAS float* sout = sbuf + ((c + 1) & 1) * 4096;
            bf16x8 sp[2][2][2];
#pragma unroll
            for (int kt = 0; kt < 2; ++kt)
#pragma unroll
                for (int ct = 0; ct < 2; ++ct) { f32x16 sv;
#pragma unroll
                    for (int r = 0; r < 16; ++r) sv[r] = sin[((kt * 2 + ct) * 16 + r) * 64 + lane];
                    sp[kt][ct][0] = pack(sv, 0); sp[kt][ct][1] = pack(sv, 1); }
#pragma unroll
            for (int rt = 0; rt < 2; ++rt)
#pragma unroll
                for (int ct = 0; ct < 2; ++ct)
#pragma unroll
                    for (int s = 0; s < 4; ++s) sn[rt][ct] = RK_MFMA(am[rt][s], sp[s >> 1][ct][s & 1], sn[rt][ct]);
#pragma unroll
            for (int rt = 0; rt < 2; ++rt)
#pragma unroll
                for (int ct = 0; ct < 2; ++ct)
#pragma unroll
                    for (int r = 0; r < 16; ++r) sout[((rt * 2 + ct) * 16 + r) * 64 + lane] = sn[rt][ct][r];
            asm volatile("s_waitcnt lgkmcnt(0)" ::: "memory");
            if (lane == 0) flag[0] = c + 1;
#pragma unroll
            for (int tt = 0; tt < 2; ++tt) {
                f32x16 y0 = {}, y1 = {};
#pragma unroll
                for (int s = 0; s < 4; ++s) { y0 = RK_MFMA(ar[tt][s], sp[s >> 1][0][s & 1], y0); y1 = RK_MFMA(ar[tt][s], sp[s >> 1][1][s & 1], y1); }
#pragma unroll
                for (int r = 0; r < 16; ++r) { yst[crow(r, lh) * 68 + lr] = y0[r]; yst[crow(r, lh) * 68 + 32 + lr] = y1[r]; }
                asm volatile("s_waitcnt lgkmcnt(0)" ::: "memory");
                const int q = lane >> 1, c0 = (lane & 1) * 32; const int sq = c * 64 + tt * 32 + q; const size_t row = (size_t)b * SEQ + sq;
                float y[32];
                const bf16* y0p = Y0 + ib + (tt * 32 + q) * 64 + c0;
#pragma unroll
                for (int e = 0; e < 32; e += 8) { const f32x4 a = *(const LAS f32x4*)(yst + q * 68 + c0 + e), bq = *(const LAS f32x4*)(yst + q * 68 + c0 + e + 4); const v4u w = *(const v4u*)(y0p + e);
                    y[e] = a[0] + bflo(w.x); y[e + 1] = a[1] + bfhi(w.x); y[e + 2] = a[2] + bflo(w.y); y[e + 3] = a[3] + bfhi(w.y); y[e + 4] = bq[0] + bflo(w.z); y[e + 5] = bq[1] + bfhi(w.z); y[e + 6] = bq[2] + bflo(w.w); y[e + 7] = bq[3] + bfhi(w.w); }
                float sm = 0.f;
#pragma unroll
                for (int e = 0; e < 32; ++e) sm += y[e];
                sm += __shfl_xor(sm, 1); const float mean = sm * (1.f / 64.f);
                float sv = 0.f;
#pragma unroll
                for (int e = 0; e < 32; ++e) { const float d = y[e] - mean; sv += d * d; }
                sv += __shfl_xor(sv, 1); const float rstd = 1.0f / sqrtf(sv * (1.f / 64.f) + GN_EPS);
                const float bon = BON[row * NH + h];
                const bf16* cur = RW + row * RWC + h * HD + c0; const bool hasp = sq > 0; const bf16* prv = hasp ? cur - RWC : cur; const float pmk = hasp ? 1.f : 0.f;
                bf16* op = QKVZ + row * 2048 + 512 + h * HD + c0;
#pragma unroll
                for (int e = 0; e < 32; e += 8) { const v4u cv = *(const v4u*)(cur + 1024 + e), pv = *(const v4u*)(prv + 1024 + e), cz = *(const v4u*)(cur + 1536 + e), pz = *(const v4u*)(prv + 1536 + e);
                    float o[8];
#pragma unroll
                    for (int j = 0; j < 8; ++j) { const unsigned wcv = cv[j >> 1], wpv = pv[j >> 1], wcz = cz[j >> 1], wpz = pz[j >> 1];
                        const float xv = (j & 1) ? bfhi(wcv) : bflo(wcv), yv = pmk * ((j & 1) ? bfhi(wpv) : bflo(wpv)); const float vv = xv + (yv - xv) * cst[c0 + e + j];
                        const float xz = (j & 1) ? bfhi(wcz) : bflo(wcz), yz = pmk * ((j & 1) ? bfhi(wpz) : bflo(wpz)); const float zz = xz + (yz - xz) * cst[64 + c0 + e + j];
                        const float gn = (y[e + j] - mean) * rstd * cst[128 + c0 + e + j] + cst[192 + c0 + e + j] + bon * vv;
                        o[j] = gn * zz * sigm(zz); }
                    *(v4u*)(op + e) = (v4u){pk2(o[0], o[1]), pk2(o[2], o[3]), pk2(o[4], o[5]), pk2(o[6], o[7])}; }
                asm volatile("s_waitcnt lgkmcnt(0)" ::: "memory");
            }
        }
    }
}
constexpr int LDS_BYTES = 163840;
constexpr int NPHASE = 12;

template <int PLO, int PHI> __global__ void __launch_bounds__(NTHR, 2) fwd(Args args) {
    extern __shared__ __attribute__((aligned(16))) unsigned char lds[];
    Frame F;
    F.lds = (LAS unsigned char*)lds;
#define RETID() do { int t_ = threadIdx.x; asm volatile("" : "+v"(t_)); F.tid = t_; F.lane = t_ & 63; F.wave = __builtin_amdgcn_readfirstlane(t_ >> 6); } while (0)
    RETID();
    F.G = gridDim.x; { const int bx = blockIdx.x; F.vcu = (F.G % 8 == 0) ? (bx % 8) * (F.G / 8) + bx / 8 : bx; }
#define LOADF() do { const __attribute__((address_space(4))) Args* ap_ = (const __attribute__((address_space(4))) Args*)__builtin_amdgcn_kernarg_segment_ptr(); asm volatile("" : "+s"(ap_)); \
    F.x = ap_->in[0]; F.p = ap_->in[1]; F.g_pre = ap_->in[2]; F.w_in = ap_->in[3]; F.rel_bias = ap_->in[4]; F.mu = ap_->in[5]; F.w0 = ap_->in[6]; F.w_up = ap_->in[7]; \
    F.a0 = ap_->in[8]; F.a_up = ap_->in[9]; F.k_k = ap_->in[10]; F.k_a = ap_->in[11]; F.r_k = ap_->in[12]; F.ln_w = ap_->in[13]; F.ln_b = ap_->in[14]; \
    F.p_a = ap_->in[15]; F.p_b = ap_->in[16]; F.w_out = ap_->in[17]; F.g_post = ap_->in[18]; F.w_pu = ap_->in[19]; F.w_pg = ap_->in[20]; F.out = ap_->out; F.ws = ap_->ws; ws = F.ws; \
    U2 = (pg8::bf16_t*)F.out; MERGED = (pg8::bf16_t*)F.out; QKVZ = (pg8::bf16_t*)(ws + WS_QKVZ); RWb = (pg8::bf16_t*)(ws + WS_RW); GAB = (pg8::bf16_t*)(ws + WS_GAB); } while (0)
    unsigned char* ws; pg8::bf16_t *U2, *MERGED, *QKVZ, *RWb, *GAB;
    constexpr int lo = PLO, hi = PHI;
    cg::grid_group grid = cg::this_grid();
#define IN(k) (lo <= (k) && (k) < hi)
#define SEAM(k) do { if constexpr (IN(k) && IN((k) + 1)) grid.sync(); } while (0)

    if constexpr (IN(0)) { RETID(); LOADF(); p0_prologue(F); } SEAM(0);
    if constexpr (IN(1)) { LOADF();
        { pg8::Gemm g{U2, (const pg8::bf16_t*)(ws + WS_WIN), M, INCP, DM, 2048, DM, 0, 0}; pg8::StaticOrder S; S.init(M, INCP, F.G, (int)blockIdx.x);
          pg8::EpiCols E{QKVZ, RWb, GAB, QSCALE};
          pg8::gemm_phase<pg8::EpiCols, pg8::StaticOrder, true, true>(F.lds, g, S, E); }
        { pg8::Gemm g{U2, (const pg8::bf16_t*)(ws + WS_WG), M, 256, 2048, 2048, 2048, 16, (size_t)256 * 2048}; pg8::StaticOrder S; S.init(M, 256, F.G, (int)blockIdx.x);
          pg8::EpiF32 E{(float*)(ws + WS_GATE), 256};
          pg8::gemm_phase<pg8::EpiF32, pg8::StaticOrder, true, true>(F.lds, g, S, E); }
    } SEAM(1);
    if constexpr (IN(2)) { RETID(); LOADF(); attn_select(F, (const float*)(ws + WS_GATE), (unsigned*)(ws + WS_CNT), (unsigned short*)((unsigned char*)F.out + DO_LISTS)); } SEAM(2);
    if constexpr (IN(3)) { RETID(); LOADF(); attn_partial(F, (const bf16*)(ws + WS_QKVZ), (const unsigned*)(ws + WS_CNT), (const unsigned short*)((unsigned char*)F.out + DO_LISTS),
                                         (bf16*)((unsigned char*)F.out + DO_PARTO), (float*)((unsigned char*)F.out + DO_PARTML), (unsigned*)(ws + WS_QCTR)); } SEAM(3);
    if constexpr (IN(4)) { RETID(); LOADF(); attn_own_combine(F, (bf16*)(ws + WS_QKVZ), (const bf16*)((unsigned char*)F.out + DO_PARTO), (const float*)((unsigned char*)F.out + DO_PARTML)); } SEAM(4);
    if constexpr (IN(5)) { RETID(); LOADF(); rwkv_chunk_ops(F); } SEAM(5);
    if constexpr (IN(6)) { RETID(); LOADF(); rwkv_scan(F); } SEAM(6);
    if constexpr (IN(7)) { LOADF();
        pg8::Gemm g{QKVZ, (const pg8::bf16_t*)(ws + WS_PAB), M, DM, 512, 2048, 1024, 0, 0}; pg8::StaticOrder S; S.init(M, DM, F.G, (int)blockIdx.x);
        pg8::EpiMerge<false> E{MERGED, DM, GAB, 2048};
        pg8::gemm_phase<pg8::EpiMerge<false>, pg8::StaticOrder, true, true>(F.lds, g, S, E);
    } SEAM(7);
    if constexpr (IN(8)) { LOADF();
        pg8::Gemm g{QKVZ + 512, (const pg8::bf16_t*)(ws + WS_PAB) + 512, M, DM, 512, 2048, 1024, 0, 0}; pg8::StaticOrder S; S.init(M, DM, F.G, (int)blockIdx.x);
        pg8::EpiMerge<true> E{MERGED, DM, GAB + 1024, 2048};
        pg8::gemm_phase<pg8::EpiMerge<true>, pg8::StaticOrder, true, true>(F.lds, g, S, E);
    } SEAM(8);
    if constexpr (IN(9)) { LOADF();
        { pg8::Gemm g{MERGED, (const pg8::bf16_t*)(ws + WS_WOUT), M, DM, DM, DM, DM, 0, 0}; pg8::StaticOrder S; S.init(M, DM, F.G, (int)blockIdx.x);
          pg8::EpiF32 E{(float*)(ws + WS_RW), DM};
          pg8::gemm_phase<pg8::EpiF32, pg8::StaticOrder, true, true>(F.lds, g, S, E); }
        { pg8::Gemm g{(const pg8::bf16_t*)(ws + WS_PB), (const pg8::bf16_t*)(ws + WS_WPU), M, DM, PLE, PLE, PLE, 0, 0}; pg8::StaticOrder S; S.init(M, DM, F.G, (int)blockIdx.x);
          pg8::EpiBf16 E{GAB, DM};
          pg8::gemm_phase<pg8::EpiBf16, pg8::StaticOrder, true, true>(F.lds, g, S, E); }
    } SEAM(9);
    if constexpr (IN(10)) { RETID(); LOADF(); post_norm(F); } SEAM(10);
    if constexpr (IN(11)) { LOADF();
        pg8::Gemm g{QKVZ, (const pg8::bf16_t*)(ws + WS_WPG), M, DM, DM, DM, DM, 0, 0}; pg8::StaticOrder S; S.init(M, DM, F.G, (int)blockIdx.x);
        pg8::EpiFinal E{F.out, F.x, (const float*)(ws + WS_RW), (const float*)(ws + WS_RSY), F.g_post, GAB, DM};
        pg8::gemm_phase<pg8::EpiFinal, pg8::StaticOrder, true, true>(F.lds, g, S, E);
    }
#undef IN
#undef SEAM
}

#ifndef MK_ONE_LAUNCH
#define MK_ONE_LAUNCH 1
#endif
extern "C" void kernel_launch(void* const* d_in, const int* in_sizes, int n_in, void* d_out, int out_size, void* d_ws, size_t ws_size, hipStream_t stream) {
    static int grid = 0;
    if (grid == 0) {
        if (n_in != 21 || out_size != M * DM || ws_size < WS_END) { fprintf(stderr, "kernel_launch: unexpected shapes n_in %d out %d ws %zu\n", n_in, out_size, ws_size); grid = -1; return; }
        int dev = 0, cus = 0, per_cu = 0;
        (void)hipGetDevice(&dev); (void)hipDeviceGetAttribute(&cus, hipDeviceAttributeMultiprocessorCount, dev);
        (void)per_cu;
        grid = cus;
    }
    if (grid < 0) return;
    Args a{};
    for (int i = 0; i < 21; ++i) a.in[i] = (const float*)d_in[i];
    a.out = (float*)d_out; a.ws = (unsigned char*)d_ws;
#if MK_ONE_LAUNCH
    a.ph_lo = 0; a.ph_hi = NPHASE;
    void* kargs[] = {&a};
    (void)hipFuncSetAttribute((const void*)fwd<0, NPHASE>, hipFuncAttributeMaxDynamicSharedMemorySize, LDS_BYTES);
    hipError_t e = hipLaunchCooperativeKernel((const void*)fwd<0, NPHASE>, dim3(grid), dim3(NTHR), kargs, LDS_BYTES, stream);
    if (e != hipSuccess) fprintf(stderr, "cooperative launch failed: %s\n", hipGetErrorString(e));
#else
#define LAUNCH_PH(k) do { (void)hipFuncSetAttribute((const void*)fwd<k, k + 1>, hipFuncAttributeMaxDynamicSharedMemorySize, LDS_BYTES); a.ph_lo = k; a.ph_hi = k + 1; hipLaunchKernelGGL((fwd<k, k + 1>), dim3(grid), dim3(NTHR), LDS_BYTES, stream, a); } while (0)
    LAUNCH_PH(0); LAUNCH_PH(1); LAUNCH_PH(2); LAUNCH_PH(3); LAUNCH_PH(4); LAUNCH_PH(5); LAUNCH_PH(6); LAUNCH_PH(7); LAUNCH_PH(8); LAUNCH_PH(9); LAUNCH_PH(10); LAUNCH_PH(11);
#endif
}
```

```cpp
#include <hip/hip_runtime.h>
#include <hip/hip_cooperative_groups.h>
#include <cstdio>
#include <cstdint>
#include <cmath>
namespace cg = cooperative_groups;
namespace pg8 {
#define PG8_LAS __attribute__((address_space(3)))
typedef unsigned short bf16_t;
typedef short bf16x8 __attribute__((ext_vector_type(8)));
typedef float f32x4 __attribute__((ext_vector_type(4)));
typedef float f32x2 __attribute__((ext_vector_type(2)));
typedef unsigned u32x4 __attribute__((ext_vector_type(4)));
typedef unsigned u32x2 __attribute__((ext_vector_type(2)));
constexpr int BM = 256, BK = 64, HALF = 128, HTB = HALF * BK * 2  , STAGE_BYTES = 8 * HTB, NXCD = 8, WGM = 8;

__host__ __device__ __forceinline__ int lds_byte(int r, int c) { const int st = (r >> 4) * 2 + (c >> 5), rr = r & 15, cc = c & 31, ob = rr * 64 + cc * 2; return st * 1024 + (ob ^ (((ob >> 9) & 1) << 5)); }
__host__ __device__ __forceinline__ void stage_rc(int b, int& R, int& C) { const int st = b / 1024, sb = b % 1024, swz = sb ^ (((sb >> 9) & 1) << 5); R = (st >> 1) * 16 + swz / 64; C = (st & 1) * 32 + (swz % 64) / 2; }
__host__ __device__ __forceinline__ int perm32(int rho) { const int n = rho >> 4, i = rho & 15; return 8 * (i >> 2) + 4 * n + (i & 3); }

struct Unit { int pm, pn; };
struct Gemm { const bf16_t* A; const bf16_t* Bt; int M, N, K, lda, ldb, bdiv; size_t bstride; };

struct StaticOrder {
    int nM, nN, nwg, G, c;
    __host__ __device__ void init(int M, int N, int G_, int c_) { nM = M / BM; nN = N / BM; nwg = nM * nN; G = G_; c = c_; }
    __host__ __device__ bool next(int i, Unit& u) const {
        const long L = (long)i * G + c; if (L >= nwg) return false;
        int wgid = (int)L; { const int q = nwg / NXCD, r = nwg % NXCD, xcd = wgid % NXCD, off = wgid / NXCD; wgid = (xcd < r ? xcd * (q + 1) : r * (q + 1) + (xcd - r) * q) + off; }
        const int nig = WGM * nN, gid = wgid / nig, fm = gid * WGM, gsz = (nM - fm) < WGM ? (nM - fm) : WGM;
        u.pm = fm + ((wgid % nig) % gsz); u.pn = (wgid % nig) / gsz; return true;
    }
};

__device__ __forceinline__ unsigned cvt_pk_bf16(float lo, float hi) { unsigned r; asm volatile("v_cvt_pk_bf16_f32 %0, %1, %2" : "=v"(r) : "v"(lo), "v"(hi)); return r; }
__device__ __forceinline__ float bf_lo(unsigned w) { return __uint_as_float(w << 16); }
__device__ __forceinline__ float bf_hi(unsigned w) { return __uint_as_float(w & 0xffff0000u); }

template <class Epi, class Sched, bool ALIGN_EPI = false, bool SP2 = false>
__device__ __forceinline__ void gemm_phase(PG8_LAS unsigned char* lds, const Gemm g, const Sched& S, const Epi& E) {
    int tid_ = threadIdx.x; asm volatile("" : "+v"(tid_));
    const int tid = tid_, wid = __builtin_amdgcn_readfirstlane(tid >> 6), lane = tid & 63, wr = wid >> 2, wc = wid & 3, fr = lane & 15, fq = lane >> 4;
    const int K = g.K, nt = K / BK;
    unsigned voffA[2], voffB[2];
#pragma unroll
    for (int i = 0; i < 2; ++i) { int R, C; stage_rc(tid * 16 + i * 8192, R, C); const int Rb = Epi::PERM ? ((R & ~31) + perm32(R & 31)) : R;
        voffA[i] = (unsigned)(R * g.lda + C) * 2u; voffB[i] = (unsigned)(Rb * g.ldb + C) * 2u; }
    const size_t kstep = (size_t)(BK * 2);
    const size_t hstepA = (size_t)HALF * g.lda * 2, hstepB = (size_t)HALF * g.ldb * 2;
    const size_t tstepA = 2 * hstepA, tstepB = 2 * hstepB;
    const unsigned ldsw = (unsigned)wid * 1024u;
    const int aoff = lds_byte(wr * 64 + fr, fq * 8), boff = lds_byte(wc * 32 + fr, fq * 8);
#define PG8_SA(b, h) (((b) * 2 + (h)) * HTB)
#define PG8_SB(b, h) ((4 + (b) * 2 + (h)) * HTB)
#define PG8_STAGE(bufoff, gbase, voff) do { _Pragma("unroll") for (int _i = 0; _i < 2; ++_i) \
        __builtin_amdgcn_global_load_lds((const unsigned*)((const char*)(gbase) + (voff)[_i]), (PG8_LAS unsigned*)(lds + (bufoff) + ldsw + _i * 8192), 16, 0, 0); } while (0)
#define PG8_LDA(dst, b, h) do { _Pragma("unroll") for (int m = 0; m < 4; ++m) _Pragma("unroll") for (int k = 0; k < 2; ++k) dst[m][k] = *(const PG8_LAS bf16x8*)(lds + PG8_SA(b, h) + aoff + m * 2048 + k * 1024); } while (0)
#define PG8_LDB(dst, b, h) do { _Pragma("unroll") for (int n = 0; n < 2; ++n) _Pragma("unroll") for (int k = 0; k < 2; ++k) dst[n][k] = *(const PG8_LAS bf16x8*)(lds + PG8_SB(b, h) + boff + n * 2048 + k * 1024); } while (0)
#define PG8_MMA(ai, bj, At, Bt) do { __builtin_amdgcn_s_setprio(1); _Pragma("unroll") for (int m = 0; m < 4; ++m) _Pragma("unroll") for (int n = 0; n < 2; ++n) _Pragma("unroll") for (int k = 0; k < 2; ++k) \
        acc[ai][bj][m][n] = __builtin_amdgcn_mfma_f32_16x16x32_bf16(Bt[n][k], At[m][k], acc[ai][bj][m][n], 0, 0, 0); __builtin_amdgcn_s_setprio(0); } while (0)
#define PG8_WAIT_V(n) asm volatile("s_waitcnt vmcnt(" #n ")" ::: "memory")
#define PG8_WAIT_L(n) asm volatile("s_waitcnt lgkmcnt(" #n ")" ::: "memory")
#define PG8_BAR __builtin_amdgcn_s_barrier()
#define PG8_SCHED __builtin_amdgcn_sched_barrier(0)
#define PG8_BBASE(u) ((const char*)g.Bt + (size_t)(u).pn * tstepB + (g.bdiv ? (size_t)((u).pm / g.bdiv) * g.bstride * 2 : (size_t)0))
    Unit cur, nxt; int ui = 0;
    if (!S.next(0, cur)) return;
    f32x4 acc[2][2][4][2];
#pragma unroll
    for (int a = 0; a < 2; ++a)
#pragma unroll
        for (int b = 0; b < 2; ++b)
#pragma unroll
            for (int m = 0; m < 4; ++m)
#pragma unroll
                for (int n = 0; n < 2; ++n) acc[a][b][m][n] = (f32x4){0.f, 0.f, 0.f, 0.f};
    bf16x8 At[4][2], B0[2][2], B1[2][2];
    const char* cA = (const char*)g.A + (size_t)cur.pm * tstepA; const char* cB = PG8_BBASE(cur);
    if constexpr (SP2) {
        PG8_STAGE(PG8_SB(0, 0), cB, voffB); PG8_STAGE(PG8_SB(0, 1), cB + hstepB, voffB); PG8_STAGE(PG8_SA(0, 0), cA, voffA); PG8_STAGE(PG8_SA(0, 1), cA + hstepA, voffA);
        if (wr == 1) PG8_BAR;
        PG8_WAIT_V(2); PG8_BAR;
        PG8_STAGE(PG8_SB(1, 0), cB + kstep, voffB); PG8_STAGE(PG8_SA(1, 0), cA + kstep, voffA); PG8_STAGE(PG8_SB(1, 1), cB + hstepB + kstep, voffB);
        PG8_WAIT_V(6); PG8_BAR;
    } else {
        PG8_STAGE(PG8_SB(0, 0), cB, voffB); PG8_STAGE(PG8_SA(0, 0), cA, voffA); PG8_STAGE(PG8_SB(0, 1), cB + hstepB, voffB); PG8_STAGE(PG8_SA(0, 1), cA + hstepA, voffA);
        if (wr == 1) PG8_BAR;
        PG8_WAIT_V(4); PG8_BAR;
        PG8_STAGE(PG8_SB(1, 0), cB + kstep, voffB); PG8_STAGE(PG8_SA(1, 0), cA + kstep, voffA); PG8_STAGE(PG8_SB(1, 1), cB + hstepB + kstep, voffB);
        PG8_WAIT_V(6); PG8_BAR;
    }
    for (;;) {
        const bool has_next = S.next(ui + 1, nxt);
        const char* nA = has_next ? (const char*)g.A + (size_t)nxt.pm * tstepA : cA; const char* nB = has_next ? PG8_BBASE(nxt) : cB;
        for (int t = 0; t < nt; t += 2) {
            const bool last = (t == nt - 2);
            const char* a1 = cA + (size_t)(t + 1) * kstep;
            const char* a2 = last ? nA : cA + (size_t)(t + 2) * kstep; const char* b2 = last ? nB : cB + (size_t)(t + 2) * kstep;
            const char* a3 = a2 + kstep; const char* b3 = b2 + kstep;
            if constexpr (SP2) {
            PG8_LDB(B0, 0, 0); PG8_LDB(B1, 0, 1); PG8_SCHED; PG8_LDA(At, 0, 0); PG8_STAGE(PG8_SA(1, 1), a1 + hstepA, voffA);
            PG8_WAIT_V(8); PG8_WAIT_L(0); PG8_BAR; PG8_MMA(0, 0, At, B0); PG8_MMA(0, 1, At, B1); PG8_BAR; PG8_SCHED;
            PG8_LDA(At, 0, 1); PG8_STAGE(PG8_SB(0, 0), b2, voffB); PG8_STAGE(PG8_SB(0, 1), b2 + hstepB, voffB); PG8_STAGE(PG8_SA(0, 0), a2, voffA);
            PG8_WAIT_V(8); PG8_WAIT_L(0); PG8_BAR; PG8_MMA(1, 0, At, B0); PG8_MMA(1, 1, At, B1); PG8_BAR; PG8_SCHED;
            PG8_LDB(B0, 1, 0); PG8_LDB(B1, 1, 1); PG8_SCHED; PG8_LDA(At, 1, 0); PG8_STAGE(PG8_SA(0, 1), a2 + hstepA, voffA);
            PG8_WAIT_V(8); PG8_WAIT_L(0); PG8_BAR; PG8_MMA(0, 0, At, B0); PG8_MMA(0, 1, At, B1); PG8_BAR; PG8_SCHED;
            PG8_LDA(At, 1, 1); PG8_STAGE(PG8_SB(1, 0), b3, voffB); PG8_STAGE(PG8_SB(1, 1), b3 + hstepB, voffB); PG8_STAGE(PG8_SA(1, 0), a3, voffA);
            PG8_WAIT_V(8); PG8_WAIT_L(0); PG8_BAR; PG8_MMA(1, 0, At, B0); PG8_MMA(1, 1, At, B1); PG8_BAR; PG8_SCHED;
            } else {
            PG8_LDB(B0, 0, 0); PG8_SCHED; PG8_LDA(At, 0, 0); PG8_STAGE(PG8_SA(1, 1), a1 + hstepA, voffA);
            PG8_WAIT_L(8); PG8_BAR; PG8_WAIT_L(0); PG8_MMA(0, 0, At, B0); PG8_BAR; PG8_SCHED;
            PG8_LDB(B1, 0, 1); PG8_STAGE(PG8_SB(0, 0), b2, voffB);
            PG8_BAR; PG8_WAIT_L(0); PG8_MMA(0, 1, At, B1); PG8_BAR;
            PG8_LDA(At, 0, 1); PG8_STAGE(PG8_SA(0, 0), a2, voffA);
            PG8_BAR; PG8_WAIT_L(0); PG8_MMA(1, 0, At, B0); PG8_BAR; PG8_SCHED;
            PG8_STAGE(PG8_SB(0, 1), b2 + hstepB, voffB);
            PG8_WAIT_V(6); PG8_BAR; PG8_MMA(1, 1, At, B1); PG8_BAR;
            PG8_LDB(B0, 1, 0); PG8_SCHED; PG8_LDA(At, 1, 0); PG8_STAGE(PG8_SA(0, 1), a2 + hstepA, voffA);
            PG8_WAIT_L(8); PG8_BAR; PG8_WAIT_L(0); PG8_MMA(0, 0, At, B0); PG8_BAR; PG8_SCHED;
            PG8_LDB(B1, 1, 1); PG8_STAGE(PG8_SB(1, 0), b3, voffB);
            PG8_BAR; PG8_WAIT_L(0); PG8_MMA(0, 1, At, B1); PG8_BAR;
            PG8_LDA(At, 1, 1); PG8_STAGE(PG8_SA(1, 0), a3, voffA);
            PG8_BAR; PG8_WAIT_L(0); PG8_MMA(1, 0, At, B0); PG8_BAR; PG8_SCHED;
            PG8_STAGE(PG8_SB(1, 1), b3 + hstepB, voffB);
            PG8_WAIT_V(6); PG8_BAR; PG8_MMA(1, 1, At, B1); PG8_BAR;
            }
        }
        if constexpr (ALIGN_EPI) { if (wr == 0) PG8_BAR; }
        E(acc, cur, wr, wc, fr, fq);
        if (!has_next) break;
#pragma unroll
        for (int a = 0; a < 2; ++a)
#pragma unroll
            for (int b = 0; b < 2; ++b)
#pragma unroll
                for (int m = 0; m < 4; ++m)
#pragma unroll
                    for (int n = 0; n < 2; ++n) acc[a][b][m][n] = (f32x4){0.f, 0.f, 0.f, 0.f};
        cur = nxt; cA = nA; cB = nB; ++ui;
        if constexpr (ALIGN_EPI) { if (wr == 1) PG8_BAR; }
    }
    PG8_WAIT_V(0);
    if constexpr (!ALIGN_EPI) { if (wr == 0) PG8_BAR; }
    PG8_BAR;
#undef PG8_SA
#undef PG8_SB
#undef PG8_STAGE
#undef PG8_LDA
#undef PG8_LDB
#undef PG8_MMA
#undef PG8_WAIT_V
#undef PG8_WAIT_L
#undef PG8_BAR
#undef PG8_SCHED
#undef PG8_BBASE
}
}
namespace pg8 {
__device__ __forceinline__ float sigmoidf_(float x) { return __builtin_amdgcn_rcpf(1.0f + __builtin_amdgcn_exp2f(x * -1.4426950408889634f)); }

struct EpiCols {
    static constexpr bool PERM = true;
    bf16_t* qkvz; bf16_t* rw; bf16_t* gab; float qscale;
    __device__ __forceinline__ void operator()(const f32x4 (&acc)[2][2][4][2], const Unit& u, int wr, int wc, int fr, int fq) const {
        const int pn = u.pn; bf16_t* base; int pitch, coff, nbj = 2; float sc = 1.f;
        if (pn < 8) { base = qkvz; pitch = 2048; coff = pn * 256; if (pn < 2) sc = qscale; }
        else if (pn < 16) { base = rw; pitch = 2176; coff = (pn - 8) * 256; }
        else if (pn < 24) { base = gab; pitch = 2048; coff = (pn - 16) * 256; }
        else { base = rw; pitch = 2176; coff = 2048; nbj = 1; }
        const int row0 = u.pm * BM + wr * 64 + fr; const int col0 = coff + wc * 32 + 8 * fq;
#pragma unroll
        for (int ai = 0; ai < 2; ++ai)
#pragma unroll
            for (int m = 0; m < 4; ++m) { bf16_t* rowp = base + (size_t)(row0 + ai * HALF + m * 16) * pitch + col0;
#pragma unroll
                for (int bj = 0; bj < 2; ++bj) { if (bj < nbj) { f32x4 v0 = acc[ai][bj][m][0] * sc, v1 = acc[ai][bj][m][1] * sc;
                    u32x4 w; w.x = cvt_pk_bf16(v0[0], v0[1]); w.y = cvt_pk_bf16(v0[2], v0[3]); w.z = cvt_pk_bf16(v1[0], v1[1]); w.w = cvt_pk_bf16(v1[2], v1[3]);
                    *(u32x4*)(rowp + bj * HALF) = w; } } }
    }
};
struct EpiBf16 {
    static constexpr bool PERM = true;
    bf16_t* O; int ldc;
    __device__ __forceinline__ void operator()(const f32x4 (&acc)[2][2][4][2], const Unit& u, int wr, int wc, int fr, int fq) const {
        const int row0 = u.pm * BM + wr * 64 + fr; const int col0 = u.pn * BM + wc * 32 + 8 * fq;
#pragma unroll
        for (int ai = 0; ai < 2; ++ai)
#pragma unroll
            for (int m = 0; m < 4; ++m) { bf16_t* rowp = O + (size_t)(row0 + ai * HALF + m * 16) * ldc + col0;
#pragma unroll
                for (int bj = 0; bj < 2; ++bj) { const f32x4 v0 = acc[ai][bj][m][0], v1 = acc[ai][bj][m][1];
                    u32x4 w; w.x = cvt_pk_bf16(v0[0], v0[1]); w.y = cvt_pk_bf16(v0[2], v0[3]); w.z = cvt_pk_bf16(v1[0], v1[1]); w.w = cvt_pk_bf16(v1[2], v1[3]);
                    *(u32x4*)(rowp + bj * HALF) = w; } }
    }
};
struct EpiF32 {
    static constexpr bool PERM = false;
    float* O; int ldc;
    __device__ __forceinline__ void operator()(const f32x4 (&acc)[2][2][4][2], const Unit& u, int wr, int wc, int fr, int fq) const {
        const int row0 = u.pm * BM + wr * 64 + fr; const int col0 = u.pn * BM + wc * 32 + 4 * fq;
#pragma unroll
        for (int ai = 0; ai < 2; ++ai)
#pragma unroll
            for (int m = 0; m < 4; ++m) { float* rowp = O + (size_t)(row0 + ai * HALF + m * 16) * ldc + col0;
#pragma unroll
                for (int bj = 0; bj < 2; ++bj)
#pragma unroll
                    for (int n = 0; n < 2; ++n) *(f32x4*)(rowp + bj * HALF + n * 16) = acc[ai][bj][m][n]; }
    }
};
template <bool ADD> struct EpiMerge {
    static constexpr bool PERM = true;
    bf16_t* O; int ldc; const bf16_t* G; int ldg;
    __device__ __forceinline__ void operator()(const f32x4 (&acc)[2][2][4][2], const Unit& u, int wr, int wc, int fr, int fq) const {
        const int row0 = u.pm * BM + wr * 64 + fr; const int col0 = u.pn * BM + wc * 32 + 8 * fq;
#pragma unroll
        for (int ai = 0; ai < 2; ++ai)
#pragma unroll
            for (int m = 0; m < 4; ++m) { const size_t r = (size_t)(row0 + ai * HALF + m * 16);
#pragma unroll
                for (int bj = 0; bj < 2; ++bj) { const f32x4 v0 = acc[ai][bj][m][0], v1 = acc[ai][bj][m][1];
                    const u32x4 gw = *(const u32x4*)(G + r * ldg + col0 + bj * HALF);
                    float o[8];
                    o[0] = sigmoidf_(bf_lo(gw.x)) * v0[0]; o[1] = sigmoidf_(bf_hi(gw.x)) * v0[1]; o[2] = sigmoidf_(bf_lo(gw.y)) * v0[2]; o[3] = sigmoidf_(bf_hi(gw.y)) * v0[3];
                    o[4] = sigmoidf_(bf_lo(gw.z)) * v1[0]; o[5] = sigmoidf_(bf_hi(gw.z)) * v1[1]; o[6] = sigmoidf_(bf_lo(gw.w)) * v1[2]; o[7] = sigmoidf_(bf_hi(gw.w)) * v1[3];
                    bf16_t* op = O + r * ldc + col0 + bj * HALF;
                    if (ADD) { const u32x4 pw = *(const u32x4*)op;
                        o[0] += bf_lo(pw.x); o[1] += bf_hi(pw.x); o[2] += bf_lo(pw.y); o[3] += bf_hi(pw.y); o[4] += bf_lo(pw.z); o[5] += bf_hi(pw.z); o[6] += bf_lo(pw.w); o[7] += bf_hi(pw.w); }
                    u32x4 w; w.x = cvt_pk_bf16(o[0], o[1]); w.y = cvt_pk_bf16(o[2], o[3]); w.z = cvt_pk_bf16(o[4], o[5]); w.w = cvt_pk_bf16(o[6], o[7]);
                    *(u32x4*)op = w; } }
    }
};
struct EpiFinal {
    static constexpr bool PERM = false;
    float* out; const float* x; const float* y; const float* rsy; const float* gpost; const bf16_t* E; int ldc;
    __device__ __forceinline__ void operator()(const f32x4 (&acc)[2][2][4][2], const Unit& u, int wr, int wc, int fr, int fq) const {
        const int row0 = u.pm * BM + wr * 64 + fr; const int col0 = u.pn * BM + wc * 32 + 4 * fq;
#pragma unroll
        for (int ai = 0; ai < 2; ++ai)
#pragma unroll
            for (int m = 0; m < 4; ++m) { const size_t r = (size_t)(row0 + ai * HALF + m * 16); const float rs = rsy[r];
#pragma unroll
                for (int bj = 0; bj < 2; ++bj)
#pragma unroll
                    for (int n = 0; n < 2; ++n) { const int c = col0 + bj * HALF + n * 16; const size_t off = r * ldc + c;
                        const f32x4 xv = *(const f32x4*)(x + off), yv = *(const f32x4*)(y + off), gp = *(const f32x4*)(gpost + c); const u32x2 ew = *(const u32x2*)(E + off);
                        const f32x4 a = acc[ai][bj][m][n]; f32x4 o;
                        o[0] = xv[0] + yv[0] * rs * gp[0] + sigmoidf_(a[0]) * bf_lo(ew.x);
                        o[1] = xv[1] + yv[1] * rs * gp[1] + sigmoidf_(a[1]) * bf_hi(ew.x);
                        o[2] = xv[2] + yv[2] * rs * gp[2] + sigmoidf_(a[2]) * bf_lo(ew.y);
                        o[3] = xv[3] + yv[3] * rs * gp[3] + sigmoidf_(a[3]) * bf_hi(ew.y);
                        *(f32x4*)(out + off) = o; } }
    }
};
}
#define GAS __attribute__((address_space(1)))
#define LAS __attribute__((address_space(3)))
typedef unsigned short bf16;
typedef unsigned v4u __attribute__((ext_vector_type(4)));
typedef unsigned v2u __attribute__((ext_vector_type(2)));
typedef float f32x4 __attribute__((ext_vector_type(4)));

constexpr int NWAVES = 8, NTHR = 512;
constexpr int BATCH = 16, SEQ = 4096, DM = 1024, M = BATCH * SEQ;
constexpr int NH = 8, HD = 64, AW = 512, PLE = 256;
constexpr int RWC = 2176, INC = 6272, INCP = 6400;
constexpr int NBLK = 16, BLK = 256;
constexpr float RMS_EPS = 1e-6f, GN_EPS = 64e-5f;
constexpr float LOG2E = 1.4426950408889634f;
constexpr float QSCALE = 0.125f * LOG2E;

constexpr size_t MiB = 1u << 20;
constexpr size_t WS_WIN = 2 * MiB;
constexpr size_t WS_WG = 16 * MiB;
constexpr size_t WS_PAB = 32 * MiB;
constexpr size_t WS_WOUT = 34 * MiB;
constexpr size_t WS_WPG = 36 * MiB;
constexpr size_t WS_WPU = 38 * MiB;
constexpr size_t WS_RSY = 39 * MiB;
constexpr size_t WS_PB = 42 * MiB;
constexpr size_t WS_GATE = 74 * MiB;
constexpr size_t WS_QKVZ = 138 * MiB;
constexpr size_t WS_RW = 394 * MiB;
constexpr size_t WS_GAB = 666 * MiB;
constexpr size_t WS_END = 922 * MiB;
constexpr size_t WS_CNT = 0;
constexpr size_t WS_QCTR = 16384;
constexpr size_t WS_WUPT = 39 * MiB + 512 * 1024, WS_AUPT = WS_WUPT + 65536;
constexpr size_t WS_BON = 922 * MiB;
constexpr size_t DO_PARTO = 0, DO_PARTML = 192 * MiB, DO_LISTS = 208 * MiB;

__device__ const unsigned char T5B[128] = {0, 1, 2, 3, 4, 5, 6, 7, 8, 9, 10, 11, 12, 13, 14, 15, 16, 16, 16, 17, 17, 18, 18, 18, 19, 19, 19, 20, 20, 20, 20, 21, 21, 21, 21, 22, 22, 22, 22, 22, 23, 23, 23, 23, 23, 23, 24, 24, 24, 24, 24, 24, 25, 25, 25, 25, 25, 25, 25, 26, 26, 26, 26, 26, 26, 26, 26, 27, 27, 27, 27, 27, 27, 27, 27, 27, 27, 28, 28, 28, 28, 28, 28, 28, 28, 28, 28, 29, 29, 29, 29, 29, 29, 29, 29, 29, 29, 29, 29, 30, 30, 30, 30, 30, 30, 30, 30, 30, 30, 30, 30, 30, 30, 31, 31, 31, 31, 31, 31, 31, 31, 31, 31, 31, 31, 31, 31, 31};

__device__ __forceinline__ unsigned f2bf(float f) { unsigned u = __builtin_bit_cast(unsigned, f); return (u + 0x7fffu + ((u >> 16) & 1u)) >> 16; }
__device__ __forceinline__ unsigned pk2(float lo, float hi) { return f2bf(lo) | (f2bf(hi) << 16); }
__device__ __forceinline__ float bf2f(unsigned short h) { return __uint_as_float((unsigned)h << 16); }
__device__ __forceinline__ float wave_sum(float v) {
#pragma unroll
    for (int o = 1; o < 64; o <<= 1) v += __shfl_xor(v, o);
    return v;
}
__device__ __forceinline__ float fexp2(float x) { return __builtin_amdgcn_exp2f(x); }
__device__ __forceinline__ float fexp(float x) { return __builtin_amdgcn_exp2f(x * LOG2E); }
__device__ __forceinline__ float frcp(float x) { return __builtin_amdgcn_rcpf(x); }
__device__ __forceinline__ float frsq(float x) { return __builtin_amdgcn_rsqf(x); }
__device__ __forceinline__ float sigm(float x) { return frcp(1.0f + fexp2(-x * LOG2E)); }
__device__ __forceinline__ float ftanh(float x) { return 1.0f - 2.0f * frcp(1.0f + fexp2(x * (2.0f * LOG2E))); }
__device__ __forceinline__ float dpp_sum32(float v) {
#define DPP_ADD_(ctrl, rmask) v += __builtin_bit_cast(float, __builtin_amdgcn_update_dpp(0, __builtin_bit_cast(int, v), ctrl, rmask, 0xf, true))
    DPP_ADD_(0x118, 0xf); DPP_ADD_(0x114, 0xf); DPP_ADD_(0x112, 0xf); DPP_ADD_(0x111, 0xf);
    v += __builtin_bit_cast(float, __builtin_amdgcn_update_dpp(0, __builtin_bit_cast(int, v), 0x142, 0xa, 0xf, false));
#undef DPP_ADD_
    return v;
}

struct Args {
    const float* in[21]; float* out; unsigned char* ws; int ph_lo, ph_hi;
};
struct Frame {
    LAS unsigned char* lds; int tid, lane, wave, vcu, G;
    const float *x, *p, *g_pre, *w_in, *rel_bias, *mu, *w0, *w_up, *a0, *a_up, *k_k, *k_a, *r_k, *ln_w, *ln_b, *p_a, *p_b, *w_out, *g_post, *w_pu, *w_pg;
    float* out; unsigned char* ws;
};

__device__ __forceinline__ void transpose_item(const float* W, int N, int k0, int n0, bf16* WT, int ldw, int drow0, int koff, LAS float* scr, int lane) {
#pragma unroll 8
    for (int i = 0; i < 32; ++i) { const int kk = 2 * i + (lane >> 5); scr[kk * 33 + (lane & 31)] = W[(size_t)(k0 + kk) * N + n0 + (lane & 31)]; }
    asm volatile("s_waitcnt lgkmcnt(0)" ::: "memory");
    const int c = lane & 7;
#pragma unroll
    for (int j = 0; j < 4; ++j) { const int n = (lane >> 3) + 8 * j; const LAS float* s = scr + (8 * c) * 33 + n;
        v4u o; o.x = pk2(s[0 * 33], s[1 * 33]); o.y = pk2(s[2 * 33], s[3 * 33]); o.z = pk2(s[4 * 33], s[5 * 33]); o.w = pk2(s[6 * 33], s[7 * 33]);
        *(v4u*)(WT + (size_t)(drow0 + n) * ldw + koff + k0 + 8 * c) = o; }
    asm volatile("s_waitcnt lgkmcnt(0)" ::: "memory");
}

__device__ __forceinline__ void p0_prologue(Frame& F) {
    if (blockIdx.x == 0) { for (int i = F.tid; i < 2048; i += NTHR) ((unsigned*)(F.ws + WS_CNT))[i] = 0u; if (F.tid == 0) *(unsigned*)(F.ws + WS_QCTR) = 0u; }
    LAS float* scr = (LAS float*)(F.lds + F.wave * 16384);
    const int gw = F.vcu * NWAVES + F.wave, NGW = F.G * NWAVES;
    bf16* WinT = (bf16*)(F.ws + WS_WIN); bf16* PabT = (bf16*)(F.ws + WS_PAB); bf16* WoutT = (bf16*)(F.ws + WS_WOUT); bf16* WpgT = (bf16*)(F.ws + WS_WPG); bf16* WpuT = (bf16*)(F.ws + WS_WPU);
    constexpr int I_IN = 16 * (INC / 32), I_PA = 8 * 32, I_PB = 8 * 32, I_WO = 16 * 32, I_PG = 16 * 32, I_PU = 4 * 32, I_UP = 16;
    constexpr int NIT = I_IN + I_PA + I_PB + I_WO + I_PG + I_PU + 2 * I_UP;
    for (int it = gw; it < NIT; it += NGW) {
        int r = it;
        if (r < I_IN) { const int nb = r % (INC / 32), kb = r / (INC / 32), n0 = nb * 32;
            const int d0 = n0 < 4096 ? n0 : (n0 < 4224 ? n0 + 2048 : n0 - 128);
            transpose_item(F.w_in, INC, kb * 64, n0, WinT, DM, d0, 0, scr, F.lane); continue; } r -= I_IN;
        if (r < I_PA) { transpose_item(F.p_a, DM, (r / 32) * 64, (r % 32) * 32, PabT, 1024, (r % 32) * 32, 0, scr, F.lane); continue; } r -= I_PA;
        if (r < I_PB) { transpose_item(F.p_b, DM, (r / 32) * 64, (r % 32) * 32, PabT, 1024, (r % 32) * 32, 512, scr, F.lane); continue; } r -= I_PB;
        if (r < I_WO) { transpose_item(F.w_out, DM, (r / 32) * 64, (r % 32) * 32, WoutT, 1024, (r % 32) * 32, 0, scr, F.lane); continue; } r -= I_WO;
        if (r < I_PG) { transpose_item(F.w_pg, DM, (r / 32) * 64, (r % 32) * 32, WpgT, 1024, (r % 32) * 32, 0, scr, F.lane); continue; } r -= I_PG;
        if (r < I_PU) { transpose_item(F.w_pu, DM, (r / 32) * 64, (r % 32) * 32, WpuT, 256, (r % 32) * 32, 0, scr, F.lane); continue; } r -= I_PU;
        if (r < I_UP) { transpose_item(F.w_up, AW, 0, r * 32, (bf16*)(F.ws + WS_WUPT), 64, r * 32, 0, scr, F.lane); continue; } r -= I_UP;
        transpose_item(F.a_up, AW, 0, r * 32, (bf16*)(F.ws + WS_AUPT), 64, r * 32, 0, scr, F.lane);
    }
    for (int i = gw * 64 + F.lane; i < 128 * 1024 / 8; i += NGW * 64) *(v4u*)(WinT + (size_t)INC * DM + (size_t)i * 8) = (v4u){0u, 0u, 0u, 0u};
    { bf16* PB = (bf16*)(F.ws + WS_PB); const size_t n8 = (size_t)M * PLE / 8;
      for (size_t i = (size_t)F.vcu * NTHR + F.tid; i < n8; i += (size_t)F.G * NTHR) { const f32x4 a = *(const f32x4*)(F.p + i * 8), b = *(const f32x4*)(F.p + i * 8 + 4);
          v4u o; o.x = pk2(a[0], a[1]); o.y = pk2(a[2], a[3]); o.z = pk2(b[0], b[1]); o.w = pk2(b[2], b[3]); *(v4u*)(PB + i * 8) = o; } }
    __syncthreads();
    LAS float* red = (LAS float*)F.lds;
    LAS float* ubar = (LAS float*)(F.lds + 32768);
    LAS float* kmean = (LAS float*)(F.lds + 36864);
    bf16* U2 = (bf16*)F.out; bf16* WgT = (bf16*)(F.ws + WS_WG);
    for (int blk = F.vcu; blk < M / BLK; blk += F.G) {
        float cs[16];
#pragma unroll
        for (int i = 0; i < 16; ++i) cs[i] = 0.f;
        f32x4 gv[4];
#pragma unroll
        for (int j = 0; j < 4; ++j) gv[j] = *((const f32x4*)F.g_pre + F.lane + 64 * j);
        for (int i = 0; i < 32; ++i) {
            const size_t row = (size_t)blk * BLK + F.wave + 8 * i;
            const f32x4* xr = (const f32x4*)(F.x + row * DM) + F.lane;
            f32x4 v[4]; float s = 0.f;
#pragma unroll
            for (int j = 0; j < 4; ++j) { v[j] = xr[64 * j]; s += (v[j][0] * v[j][0] + v[j][1] * v[j][1]) + (v[j][2] * v[j][2] + v[j][3] * v[j][3]); }
            const float rs = frsq(wave_sum(s) * (1.f / DM) + RMS_EPS);
#pragma unroll
            for (int j = 0; j < 4; ++j) {
                float u[4]; unsigned h[4], l[4];
#pragma unroll
                for (int e = 0; e < 4; ++e) { u[e] = v[j][e] * rs * gv[j][e]; cs[j * 4 + e] += u[e]; h[e] = f2bf(u[e]); l[e] = f2bf(u[e] - __uint_as_float(h[e] << 16)); }
                const int col = 4 * F.lane + 256 * j;
                *(v2u*)(U2 + row * 2048 + col) = (v2u){h[0] | (h[1] << 16), h[2] | (h[3] << 16)};
                *(v2u*)(U2 + row * 2048 + 1024 + col) = (v2u){l[0] | (l[1] << 16), l[2] | (l[3] << 16)};
            }
        }
#pragma unroll
        for (int j = 0; j < 4; ++j)
#pragma unroll
            for (int e = 0; e < 4; ++e) red[F.wave * 1024 + 4 * F.lane + 256 * j + e] = cs[j * 4 + e];
        __syncthreads();
        for (int k = F.tid; k < 1024; k += NTHR) { float s = 0.f;
#pragma unroll
            for (int w = 0; w < 8; ++w) s += red[w * 1024 + k];
            ubar[k] = s * (1.f / BLK); }
        __syncthreads();
        { float s = 0.f; const float* wk = F.w_in + 512 + F.tid;
          for (int k = 0; k < 1024; ++k) s += ubar[k] * wk[(size_t)k * INC];
          kmean[F.tid] = s; }
        __syncthreads();
        { const int b = blk / NBLK, n = blk % NBLK;
          for (int k = F.tid; k < 1024; k += NTHR) { const float* wq = F.w_in + (size_t)k * INC;
              for (int h = 0; h < NH; ++h) { float s = 0.f;
                  for (int d = 0; d < HD; d += 4) { const f32x4 w4 = *(const f32x4*)(wq + h * HD + d); s += w4[0] * kmean[h * HD + d] + w4[1] * kmean[h * HD + d + 1] + w4[2] * kmean[h * HD + d + 2] + w4[3] * kmean[h * HD + d + 3]; }
                  const unsigned hi = f2bf(s), lo = f2bf(s - __uint_as_float(hi << 16));
                  bf16* r0 = WgT + ((size_t)b * 256 + h * 16 + n) * 2048; bf16* r1 = WgT + ((size_t)b * 256 + 128 + h * 16 + n) * 2048;
                  r0[k] = (bf16)hi; r0[1024 + k] = (bf16)hi; r1[k] = (bf16)lo; r1[1024 + k] = (bf16)lo; } } }
        __syncthreads();
    }
}

__device__ __forceinline__ void post_norm(Frame& F) {
    const float* Y = (const float*)(F.ws + WS_RW); float* RSY = (float*)(F.ws + WS_RSY); bf16* H1 = (bf16*)(F.ws + WS_QKVZ);
    const int gw = F.vcu * NWAVES + F.wave, NGW = F.G * NWAVES;
    f32x4 gv[4];
#pragma unroll
    for (int j = 0; j < 4; ++j) gv[j] = *((const f32x4*)F.g_post + F.lane + 64 * j);
    for (int row = gw; row < M; row += NGW) {
        const f32x4* yr = (const f32x4*)(Y + (size_t)row * DM) + F.lane; const f32x4* xr = (const f32x4*)(F.x + (size_t)row * DM) + F.lane;
        f32x4 v[4]; float s = 0.f;
#pragma unroll
        for (int j = 0; j < 4; ++j) { v[j] = yr[64 * j]; s += (v[j][0] * v[j][0] + v[j][1] * v[j][1]) + (v[j][2] * v[j][2] + v[j][3] * v[j][3]); }
        const float rs = frsq(wave_sum(s) * (1.f / DM) + RMS_EPS);
        if (F.lane == 0) RSY[row] = rs;
#pragma unroll
        for (int j = 0; j < 4; ++j) { const f32x4 xv = xr[64 * j]; float h[4];
#pragma unroll
            for (int e = 0; e < 4; ++e) h[e] = xv[e] + v[j][e] * rs * gv[j][e];
            *(v2u*)(H1 + (size_t)row * DM + 4 * F.lane + 256 * j) = (v2u){pk2(h[0], h[1]), pk2(h[2], h[3])}; }
    }
}
namespace moba {
using bf16x8 = __attribute__((ext_vector_type(8))) short;
using s16x4 = __attribute__((ext_vector_type(4))) short;
using f32x16 = __attribute__((ext_vector_type(16))) float;
using u32x4 = __attribute__((ext_vector_type(4))) unsigned;
typedef short v4i16_t __attribute__((ext_vector_type(4)));
typedef float f32x2_t __attribute__((ext_vector_type(2))); typedef __bf16 bf16x2_t __attribute__((ext_vector_type(2)));
__device__ __forceinline__ int crow(int r, int hi) { return (r & 3) + 8 * (r >> 2) + 4 * hi; }
__device__ __forceinline__ unsigned cvtpk(float lo, float hi) { f32x2_t v = {lo, hi}; bf16x2_t b = __builtin_convertvector(v, bf16x2_t); return __builtin_bit_cast(unsigned, b); }
__device__ __forceinline__ float max3f(float a, float b, float c) { return fmaxf(fmaxf(a, b), c); }

constexpr int SLOTB = 8192;
__device__ __forceinline__ void qkt(f32x16& p0, f32x16& p1, const LAS unsigned char* Kslot, const bf16x8* qr, int r32, int hi) {
    const LAS unsigned char* kb = Kslot + hi * 1024 + r32 * 16;
    const f32x16 z = {};
#pragma unroll
    for (int d0 = 0; d0 < 4; ++d0) {
        const bf16x8 b0 = *(const LAS bf16x8*)(kb + d0 * 2048);
        const bf16x8 b1 = *(const LAS bf16x8*)(kb + d0 * 2048 + 512);
        if (d0 == 0) { p0 = __builtin_amdgcn_mfma_f32_32x32x16_bf16(b0, qr[0], z, 0, 0, 0); p1 = __builtin_amdgcn_mfma_f32_32x32x16_bf16(b1, qr[0], z, 0, 0, 0); }
        else { p0 = __builtin_amdgcn_mfma_f32_32x32x16_bf16(b0, qr[d0], p0, 0, 0, 0); p1 = __builtin_amdgcn_mfma_f32_32x32x16_bf16(b1, qr[d0], p1, 0, 0, 0); } }
}
__device__ __forceinline__ void pv(f32x16* o, int vb, bf16x8 pa0, bf16x8 pa1, bf16x8 pa2, bf16x8 pa3) {
#pragma unroll
    for (int d0 = 0; d0 < 2; ++d0) { s16x4 lo[4], hi[4];
#pragma unroll
        for (int ks = 0; ks < 4; ++ks) {
            asm volatile("ds_read_b64_tr_b16 %0,%1 offset:%c2" : "=&v"(lo[ks]) : "v"(vb), "i"(d0 * 4096 + ks * 1024) : "memory");
            asm volatile("ds_read_b64_tr_b16 %0,%1 offset:%c2" : "=&v"(hi[ks]) : "v"(vb), "i"(d0 * 4096 + ks * 1024 + 512) : "memory"); }
        asm volatile("s_waitcnt lgkmcnt(0)" ::: "memory"); __builtin_amdgcn_sched_barrier(0);
#define PK(k) (bf16x8){lo[k][0], lo[k][1], lo[k][2], lo[k][3], hi[k][0], hi[k][1], hi[k][2], hi[k][3]}
        o[d0] = __builtin_amdgcn_mfma_f32_32x32x16_bf16(pa0, PK(0), o[d0], 0, 0, 0);
        o[d0] = __builtin_amdgcn_mfma_f32_32x32x16_bf16(pa1, PK(1), o[d0], 0, 0, 0);
        o[d0] = __builtin_amdgcn_mfma_f32_32x32x16_bf16(pa2, PK(2), o[d0], 0, 0, 0);
        o[d0] = __builtin_amdgcn_mfma_f32_32x32x16_bf16(pa3, PK(3), o[d0], 0, 0, 0);
#undef PK
    }
}
__device__ __forceinline__ float rowmax2(const f32x16& p0, const f32x16& p1, float a) {
#pragma unroll
    for (int r = 0; r < 16; r += 2) { a = max3f(a, p0[r], p0[r + 1]); a = max3f(a, p1[r], p1[r + 1]); }
    return a;
}
__device__ __forceinline__ float swapmax(float m) { auto rr = __builtin_amdgcn_permlane32_swap(__float_as_uint(m), __float_as_uint(m), false, false); return fmaxf(__uint_as_float(rr[0]), __uint_as_float(rr[1])); }
__device__ __forceinline__ float swapsum(float m) { auto rr = __builtin_amdgcn_permlane32_swap(__float_as_uint(m), __float_as_uint(m), false, false); return __uint_as_float(rr[0]) + __uint_as_float(rr[1]); }

__device__ __forceinline__ void load_kv_block(LAS unsigned char* lds, int KOFF, int VOFF, const bf16* QKVZ, size_t krow0, int h, int wid, int lane) {
    const bf16* ksrc = QKVZ + (krow0 + lane) * 2048 + 512 + h * HD + wid * 8;
    const bf16* vsrc = QKVZ + (krow0 + 16 * (wid & 3) + (lane >> 2)) * 2048 + 1024 + h * HD + (wid >> 2) * 32 + (lane & 3) * 8;
#pragma unroll
    for (int t = 0; t < 4; ++t) {
        __builtin_amdgcn_global_load_lds((const unsigned*)(ksrc + (size_t)t * 64 * 2048), (LAS unsigned*)(lds + KOFF + t * SLOTB + wid * 1024), 16, 0, 0);
        __builtin_amdgcn_global_load_lds((const unsigned*)(vsrc + (size_t)t * 64 * 2048), (LAS unsigned*)(lds + VOFF + t * SLOTB + wid * 1024), 16, 0, 0); }
}
}

constexpr int LIST_CAP = 3840;

__device__ __forceinline__ void attn_select(Frame& F, const float* GATE, unsigned* CNT, unsigned short* LISTS) {
    const int gw = F.vcu * NWAVES + F.wave, NGW = F.G * NWAVES;
    for (int it = gw; it < BATCH * NH * (SEQ / 64); it += NGW) {
        const int sg = it % (SEQ / 64), h = (it / (SEQ / 64)) % NH, b = it / (SEQ / 64 * NH);
        const int s = sg * 64 + F.lane, qb = s >> 8; const size_t row = (size_t)b * SEQ + s;
        if (qb == 0) continue;
        float g0 = -INFINITY, g1 = -INFINITY, g2 = -INFINITY; int i0 = -1, i1 = -1, i2 = -1;
        const f32x4* gp = (const f32x4*)(GATE + row * 256 + h * 16); const f32x4* gl = (const f32x4*)(GATE + row * 256 + 128 + h * 16);
#pragma unroll
        for (int c = 0; c < 4; ++c) { const f32x4 a = gp[c], l = gl[c];
#pragma unroll
            for (int e = 0; e < 4; ++e) { const int n = c * 4 + e; const float g = (n < qb) ? a[e] + l[e] : -INFINITY;
                if (g > g0) { g2 = g1; i2 = i1; g1 = g0; i1 = i0; g0 = g; i0 = n; } else if (g > g1) { g2 = g1; i2 = i1; g1 = g; i1 = n; } else if (g > g2) { g2 = g; i2 = n; } } }
        unsigned* cnt = CNT + (b * NH + h) * 16; unsigned short* lst = LISTS + (size_t)(b * NH + h) * 16 * LIST_CAP;
        for (int n = 0; n < qb; ++n) {
            const int slot = (i0 == n) ? 0 : ((i1 == n) ? 1 : ((i2 == n) ? 2 : -1));
            const unsigned long long mask = __ballot(slot >= 0);
            if (mask == 0ull) continue;
            const int before = __builtin_amdgcn_mbcnt_hi((unsigned)(mask >> 32), __builtin_amdgcn_mbcnt_lo((unsigned)mask, 0u));
            unsigned base = 0u;
            if (F.lane == 0) base = atomicAdd(cnt + n, (unsigned)__popcll(mask));
            base = __builtin_amdgcn_readfirstlane(base);
            if (slot >= 0) lst[(size_t)n * LIST_CAP + base + before] = (unsigned short)(s | (slot << 12));
        }
    }
}

__device__ __forceinline__ void attn_partial(Frame& F, const bf16* QKVZ, const unsigned* CNT, const unsigned short* LISTS, bf16* PART_O, float* PART_ML, unsigned* QCTR) {
    using namespace moba;
    LAS unsigned char* lds = F.lds; const int wid = F.wave, lane = F.lane, r32 = lane & 31, hi = lane >> 5;
    LAS float* btab = (LAS float*)(lds + 102400); LAS unsigned* uword = (LAS unsigned*)(lds + 106496);
    LAS float* wsf = (LAS float*)(lds + 98304) + wid * 128; LAS bf16* stg = (LAS bf16*)(lds + 65536) + wid * 2048;
    for (int i = F.tid; i < NH * 128; i += NTHR) { const int h = i >> 7, d = i & 127; btab[i] = (F.rel_bias[T5B[d] * NH + h] - F.rel_bias[31 * NH + h]) * LOG2E; }
    const int vb0 = (int)(uintptr_t)(lds + 32768) + ((lane >> 4) & 1) * 32 + (lane & 3) * 8 + (4 * hi + ((lane & 15) >> 2)) * 64;
    const int NUNIT = BATCH * NH * 15;
    for (;;) {
        __syncthreads();
        if (F.tid == 0) uword[0] = atomicAdd(QCTR, 1u);
        __syncthreads();
        const int u = (int)uword[0];
        if (u >= NUNIT) break;
        const int n = u / (BATCH * NH), bh = u % (BATCH * NH), b = bh / NH, h = bh % NH;
        load_kv_block(lds, 0, 32768, QKVZ, (size_t)b * SEQ + n * BLK, h, wid, lane);
        const int cnt = (int)CNT[bh * 16 + n]; const unsigned short* lst = LISTS + ((size_t)bh * 16 + n) * LIST_CAP;
        const float b31 = F.rel_bias[31 * NH + h] * LOG2E;
        __syncthreads();
        const int ntile = (cnt + 31) >> 5;
        for (int tile = wid; tile < ntile; tile += NWAVES) {
            const int idx = tile * 32 + r32; const bool valid = idx < cnt;
            const unsigned e = lst[valid ? idx : 0]; const int s = e & 4095, slot = e >> 12; const size_t row = (size_t)b * SEQ + s;
            bf16x8 qr[4];
#pragma unroll
            for (int d0 = 0; d0 < 4; ++d0) qr[d0] = *(const bf16x8*)(QKVZ + row * 2048 + h * HD + d0 * 16 + hi * 8);
            f32x16 p[4][2];
#pragma unroll
            for (int t = 0; t < 4; ++t) qkt(p[t][0], p[t][1], lds + t * SLOTB, qr, r32, hi);
            const bool near = ((s >> 8) == n + 1);
            if (__any(near)) {
                const int dbase = near ? (s - (n * BLK + 128)) : 100000;
#pragma unroll
                for (int t = 2; t < 4; ++t)
#pragma unroll
                    for (int r = 0; r < 16; ++r) { const int kv = (t - 2) * 64 + crow(r, hi); int d0 = dbase - kv, d1 = d0 - 32; d0 = d0 > 127 ? 127 : d0; d1 = d1 > 127 ? 127 : d1;
                        p[t][0][r] += btab[h * 128 + d0]; p[t][1][r] += btab[h * 128 + d1]; }
            }
            float mx = -INFINITY;
#pragma unroll
            for (int t = 0; t < 4; ++t) mx = rowmax2(p[t][0], p[t][1], mx);
            mx = swapmax(mx);
            float l = 0.f;
            f32x16 o[2]; o[0] = f32x16{}; o[1] = f32x16{};
#pragma unroll
            for (int t = 0; t < 4; ++t) {
#pragma unroll
                for (int r = 0; r < 16; ++r) { p[t][0][r] = fexp2(p[t][0][r] - mx); p[t][1][r] = fexp2(p[t][1][r] - mx); l += p[t][0][r] + p[t][1][r]; }
                u32x4 w0, w1, w2, w3;
                w0 = (u32x4){cvtpk(p[t][0][0], p[t][0][1]), cvtpk(p[t][0][2], p[t][0][3]), cvtpk(p[t][0][4], p[t][0][5]), cvtpk(p[t][0][6], p[t][0][7])};
                w1 = (u32x4){cvtpk(p[t][0][8], p[t][0][9]), cvtpk(p[t][0][10], p[t][0][11]), cvtpk(p[t][0][12], p[t][0][13]), cvtpk(p[t][0][14], p[t][0][15])};
                w2 = (u32x4){cvtpk(p[t][1][0], p[t][1][1]), cvtpk(p[t][1][2], p[t][1][3]), cvtpk(p[t][1][4], p[t][1][5]), cvtpk(p[t][1][6], p[t][1][7])};
                w3 = (u32x4){cvtpk(p[t][1][8], p[t][1][9]), cvtpk(p[t][1][10], p[t][1][11]), cvtpk(p[t][1][12], p[t][1][13]), cvtpk(p[t][1][14], p[t][1][15])};
                pv(o, vb0 + t * SLOTB, __builtin_bit_cast(bf16x8, w0), __builtin_bit_cast(bf16x8, w1), __builtin_bit_cast(bf16x8, w2), __builtin_bit_cast(bf16x8, w3));
            }
            l = swapsum(l);
            if (hi == 0) { wsf[r32] = frcp(l); ((LAS int*)wsf)[32 + r32] = valid ? (int)(((row * NH + h) * 3 + slot)) : -1;
                           if (valid) { float2 ml; ml.x = mx + b31; ml.y = l; *(float2*)(PART_ML + ((row * NH + h) * 3 + slot) * 2) = ml; } }
            asm volatile("s_waitcnt lgkmcnt(0)" ::: "memory");
#pragma unroll
            for (int r = 0; r < 16; ++r) { const int orow = crow(r, hi); const float il = wsf[orow];
#pragma unroll
                for (int d0 = 0; d0 < 2; ++d0) stg[orow * 64 + d0 * 32 + r32] = (bf16)f2bf(o[d0][r] * il); }
            asm volatile("s_waitcnt lgkmcnt(0)" ::: "memory");
#pragma unroll
            for (int i = 0; i < 4; ++i) { const int rr = i * 8 + (lane >> 3), ch = lane & 7; const int dst = ((LAS int*)wsf)[32 + rr];
                const u32x4 v = *(const LAS u32x4*)(stg + rr * 64 + ch * 8);
                if (dst >= 0) *(u32x4*)(PART_O + (size_t)dst * 64 + ch * 8) = v; }
            asm volatile("s_waitcnt lgkmcnt(0)" ::: "memory");
        }
    }
}

__device__ __forceinline__ void attn_own_combine(Frame& F, bf16* QKVZ, const bf16* PART_O, const float* PART_ML, bf16* OUTB, int out_pitch) {
    using namespace moba;
    LAS unsigned char* lds = F.lds; const int wid = F.wave, lane = F.lane, r32 = lane & 31, hi = lane >> 5;
    LAS float* btab = (LAS float*)(lds + 139264);
    LAS float* wsf = (LAS float*)(lds + 135168) + wid * 128; LAS float* ost = (LAS float*)(lds + 65536 + wid * 8704);
    __syncthreads();
    for (int i = F.tid; i < NH * 256; i += NTHR) { const int h = i >> 8, d = i & 255; btab[i] = F.rel_bias[T5B[d < 127 ? d : 127] * NH + h] * LOG2E; }
    const int vb0 = (int)(uintptr_t)(lds + 32768) + ((lane >> 4) & 1) * 32 + (lane & 3) * 8 + (4 * hi + ((lane & 15) >> 2)) * 64;
    for (int u = F.vcu; u < BATCH * NH * NBLK; u += F.G) {
        const int qb = u % NBLK, bh = u / NBLK, b = bh / NH, h = bh % NH;
        __syncthreads();
        load_kv_block(lds, 0, 32768, QKVZ, (size_t)b * SEQ + qb * BLK, h, wid, lane);
        const int sq = qb * BLK + wid * 32 + r32; const size_t row = (size_t)b * SEQ + sq;
        bf16x8 qr[4];
#pragma unroll
        for (int d0 = 0; d0 < 4; ++d0) qr[d0] = *(const bf16x8*)(QKVZ + row * 2048 + h * HD + d0 * 16 + hi * 8);
        __syncthreads();
        const int nt = (wid >> 1) + 1;
        int ql = wid * 32 + r32;
        asm volatile("" : "+v"(ql));
        const LAS float* bt = btab + h * 256;
        float mx = -INFINITY;
#define A2_SCORES(P0, P1, t) do { qkt(P0, P1, lds + (t) * SLOTB, qr, r32, hi); \
            if ((t) < nt - 1) { _Pragma("unroll") for (int r = 0; r < 16; ++r) { const int kv = (t) * 64 + crow(r, hi); const int d0 = ql - kv, d1 = d0 - 32; P0[r] += bt[d0]; P1[r] += bt[d1]; } } \
            else { _Pragma("unroll") for (int r = 0; r < 16; ++r) { const int kv = (t) * 64 + crow(r, hi); const int d0 = ql - kv, d1 = d0 - 32; const float b0 = bt[d0 < 0 ? 0 : d0], b1 = bt[d1 < 0 ? 0 : d1]; \
                P0[r] = d0 >= 0 ? P0[r] + b0 : -INFINITY; P1[r] = d1 >= 0 ? P1[r] + b1 : -INFINITY; } } } while (0)
#pragma unroll 1
        for (int t = 0; t < nt; ++t) { f32x16 p0, p1; A2_SCORES(p0, p1, t); mx = rowmax2(p0, p1, mx); }
        mx = swapmax(mx);
        float l = 0.f;
        f32x16 o[2]; o[0] = f32x16{}; o[1] = f32x16{};
#pragma unroll 1
        for (int t = 0; t < nt; ++t) { f32x16 p0, p1; A2_SCORES(p0, p1, t);
#pragma unroll
            for (int r = 0; r < 16; ++r) { p0[r] = fexp2(p0[r] - mx); p1[r] = fexp2(p1[r] - mx); l += p0[r] + p1[r]; }
            u32x4 w0, w1, w2, w3;
            w0 = (u32x4){cvtpk(p0[0], p0[1]), cvtpk(p0[2], p0[3]), cvtpk(p0[4], p0[5]), cvtpk(p0[6], p0[7])};
            w1 = (u32x4){cvtpk(p0[8], p0[9]), cvtpk(p0[10], p0[11]), cvtpk(p0[12], p0[13]), cvtpk(p0[14], p0[15])};
            w2 = (u32x4){cvtpk(p1[0], p1[1]), cvtpk(p1[2], p1[3]), cvtpk(p1[4], p1[5]), cvtpk(p1[6], p1[7])};
            w3 = (u32x4){cvtpk(p1[8], p1[9]), cvtpk(p1[10], p1[11]), cvtpk(p1[12], p1[13]), cvtpk(p1[14], p1[15])};
            pv(o, vb0 + t * SLOTB, __builtin_bit_cast(bf16x8, w0), __builtin_bit_cast(bf16x8, w1), __builtin_bit_cast(bf16x8, w2), __builtin_bit_cast(bf16x8, w3));
        }
#undef A2_SCORES
        l = swapsum(l);
        if (hi == 0) { wsf[r32] = mx; wsf[32 + r32] = l; }
#pragma unroll
        for (int r = 0; r < 16; ++r) { const int orow = crow(r, hi);
#pragma unroll
            for (int d0 = 0; d0 < 2; ++d0) ost[orow * 68 + d0 * 32 + r32] = o[d0][r]; }
        asm volatile("s_waitcnt lgkmcnt(0)" ::: "memory");
        { const int q = lane >> 1, c0 = (lane & 1) * 32; const int s2 = qb * BLK + wid * 32 + q; const size_t row2 = (size_t)b * SEQ + s2;
          const float m0 = wsf[q], l0 = wsf[32 + q]; const int np = qb < 3 ? qb : 3;
          float mj[3], lj[3]; float mt = m0;
#pragma unroll
          for (int j = 0; j < 3; ++j) { if (j < np) { const float2 ml = *(const float2*)(PART_ML + ((row2 * NH + h) * 3 + j) * 2); mj[j] = ml.x; lj[j] = ml.y; mt = fmaxf(mt, ml.x); } else { mj[j] = -INFINITY; lj[j] = 0.f; } }
          const float w0 = fexp2(m0 - mt); float wj[3]; float den = w0 * l0;
#pragma unroll
          for (int j = 0; j < 3; ++j) { wj[j] = (j < np) ? fexp2(mj[j] - mt) * lj[j] : 0.f; den += wj[j]; }
          const float iden = frcp(den);
          float acc[32];
#pragma unroll
          for (int c = 0; c < 32; c += 4) { const f32x4 v = *(const LAS f32x4*)(ost + q * 68 + c0 + c); acc[c] = v[0] * w0; acc[c + 1] = v[1] * w0; acc[c + 2] = v[2] * w0; acc[c + 3] = v[3] * w0; }
#pragma unroll
          for (int j = 0; j < 3; ++j) if (j < np) { const v4u* pp = (const v4u*)(PART_O + ((row2 * NH + h) * 3 + j) * 64 + c0);
#pragma unroll
              for (int c = 0; c < 4; ++c) { const v4u w = pp[c]; const float f = wj[j];
                  acc[c * 8 + 0] += f * __uint_as_float(w.x << 16); acc[c * 8 + 1] += f * __uint_as_float(w.x & 0xffff0000u); acc[c * 8 + 2] += f * __uint_as_float(w.y << 16); acc[c * 8 + 3] += f * __uint_as_float(w.y & 0xffff0000u);
                  acc[c * 8 + 4] += f * __uint_as_float(w.z << 16); acc[c * 8 + 5] += f * __uint_as_float(w.z & 0xffff0000u); acc[c * 8 + 6] += f * __uint_as_float(w.w << 16); acc[c * 8 + 7] += f * __uint_as_float(w.w & 0xffff0000u); } }
          const v4u* zp = (const v4u*)(QKVZ + row2 * 2048 + 1536 + h * HD + c0); v4u* op = (v4u*)(OUTB + row2 * out_pitch + h * HD + c0);
#pragma unroll
          for (int c = 0; c < 4; ++c) { const v4u w = zp[c]; const float z[8] = {__uint_as_float(w.x << 16), __uint_as_float(w.x & 0xffff0000u), __uint_as_float(w.y << 16), __uint_as_float(w.y & 0xffff0000u),
                                                                               __uint_as_float(w.z << 16), __uint_as_float(w.z & 0xffff0000u), __uint_as_float(w.w << 16), __uint_as_float(w.w & 0xffff0000u)};
              float rr[8];
#pragma unroll
              for (int e2 = 0; e2 < 8; ++e2) rr[e2] = acc[c * 8 + e2] * iden * z[e2] * sigm(z[e2]);
              v4u ow; ow.x = pk2(rr[0], rr[1]); ow.y = pk2(rr[2], rr[3]); ow.z = pk2(rr[4], rr[5]); ow.w = pk2(rr[6], rr[7]); op[c] = ow; } }
        asm volatile("s_waitcnt lgkmcnt(0)" ::: "memory");
    }
}
namespace rk {
using bf16x8 = __attribute__((ext_vector_type(8))) short;
using s16x4 = __attribute__((ext_vector_type(4))) short;
using f32x16 = __attribute__((ext_vector_type(16))) float;
using u32x4 = __attribute__((ext_vector_type(4))) unsigned;
using u32x2 = __attribute__((ext_vector_type(2))) unsigned;
typedef short v4i16_t __attribute__((ext_vector_type(4)));
typedef float f32x2_t __attribute__((ext_vector_type(2))); typedef __bf16 bf16x2_t __attribute__((ext_vector_type(2)));
constexpr int P = 144, IMG = 64 * P, GRP = 81920, MISC = 8 * IMG;
#define RK_MFMA(a, b, c) __builtin_amdgcn_mfma_f32_32x32x16_bf16((a), (b), (c), 0, 0, 0)
__device__ __forceinline__ int crow(int r, int hi) { return (r & 3) + 8 * (r >> 2) + 4 * hi; }
__device__ __forceinline__ unsigned cvtpk(float lo, float hi) { f32x2_t v = {lo, hi}; bf16x2_t b = __builtin_convertvector(v, bf16x2_t); return __builtin_bit_cast(unsigned, b); }
__device__ __forceinline__ float bflo(unsigned w) { return __uint_as_float(w << 16); }
__device__ __forceinline__ float bfhi(unsigned w) { return __uint_as_float(w & 0xffff0000u); }
__device__ __forceinline__ s16x4 trrd(const LAS unsigned char* p) { return __builtin_bit_cast(s16x4, __builtin_amdgcn_ds_read_tr16_b64_v4i16((LAS v4i16_t*)p)); }
struct Ln { int r, h, blk, q, p; };
__device__ __forceinline__ bf16x8 frag_row(const LAS unsigned char* img, const Ln& l, int tile, int s, int coloff = 0) { return *(const LAS bf16x8*)(img + (32 * tile + l.r) * P + (coloff + 16 * s + 8 * l.h) * 2); }
__device__ __forceinline__ bf16x8 frag_tr(const LAS unsigned char* img, const Ln& l, int tile, int s, int rowoff = 0) {
    const LAS unsigned char* b = img + (rowoff + 16 * s + 8 * l.h + l.q) * P + 64 * tile + 32 * l.blk + 8 * l.p;
    const s16x4 lo = trrd(b), hi = trrd(b + 4 * P);
    return (bf16x8){lo[0], lo[1], lo[2], lo[3], hi[0], hi[1], hi[2], hi[3]};
}
__device__ __forceinline__ bf16x8 frag_row_perm(const LAS unsigned char* img, const Ln& l, int tile, int s, int coloff = 0) {
    const LAS unsigned char* b = img + (32 * tile + l.r) * P + (coloff + 16 * s + 4 * l.h) * 2;
    const s16x4 lo = *(const LAS s16x4*)b, hi = *(const LAS s16x4*)(b + 16);
    return (bf16x8){lo[0], lo[1], lo[2], lo[3], hi[0], hi[1], hi[2], hi[3]};
}
__device__ __forceinline__ bf16x8 frag_tr_perm(const LAS unsigned char* img, const Ln& l, int tile, int s, int rowoff = 0) {
    const LAS unsigned char* b = img + (rowoff + 16 * s + 4 * l.h + l.q) * P + 64 * tile + 32 * l.blk + 8 * l.p;
    const s16x4 lo = trrd(b), hi = trrd(b + 8 * P);
    return (bf16x8){lo[0], lo[1], lo[2], lo[3], hi[0], hi[1], hi[2], hi[3]};
}
__device__ __forceinline__ bf16x8 pack(const f32x16& x, int s) {
    u32x4 w; w.x = cvtpk(x[8 * s], x[8 * s + 1]); w.y = cvtpk(x[8 * s + 2], x[8 * s + 3]); w.z = cvtpk(x[8 * s + 4], x[8 * s + 5]); w.w = cvtpk(x[8 * s + 6], x[8 * s + 7]);
    return __builtin_bit_cast(bf16x8, w);
}
__device__ __forceinline__ void store_T(LAS unsigned char* img, const Ln& l, const f32x16& x, int ti, int tj) {
#pragma unroll
    for (int g = 0; g < 4; ++g) { u32x2 w; w.x = cvtpk(x[4 * g], x[4 * g + 1]); w.y = cvtpk(x[4 * g + 2], x[4 * g + 3]);
        *(LAS u32x2*)(img + (32 * tj + l.r) * P + (32 * ti + 8 * g + 4 * l.h) * 2) = w; }
}
__device__ __forceinline__ float xhalf(float v) { return __shfl_xor(v, 32); }
__device__ __forceinline__ void tri_inv32(f32x16& D, f32x16& DT, f32x16 S, f32x16 ST) {
    const f32x16 z = {};
#pragma unroll
    for (int it = 0; it < 4; ++it) {
        f32x16 S2 = z, S2T = z;
#pragma unroll
        for (int s = 0; s < 2; ++s) { const bf16x8 ps = pack(S, s), pst = pack(ST, s); S2 = RK_MFMA(pst, ps, S2); S2T = RK_MFMA(ps, pst, S2T); }
        f32x16 DS = S2, DST = S2T;
#pragma unroll
        for (int s = 0; s < 2; ++s) { DS = RK_MFMA(pack(DT, s), pack(S2, s), DS); DST = RK_MFMA(pack(S2, s), pack(DT, s), DST); }
        D = D + DS; DT = DT + DST; S = S2; ST = S2T;
    }
}
}

constexpr size_t DO_NT = 0, DO_MT = 128 * MiB, DO_RH = 192 * MiB;

struct R1Ctx { int item, c, h, b; rk::f32x16 Wt0, Wt1; };
#define RK_RELANE() do { int t_ = F.tid; asm volatile("" : "+v"(t_)); lane = t_ & 63; tg = t_ & 255; grp = t_ >> 8; w4 = (t_ >> 6) & 3; ti = w4 >> 1; tj = w4 & 1; l.r = lane & 31; l.h = lane >> 5; l.blk = (lane >> 4) & 1; l.q = (lane & 15) >> 2; l.p = lane & 3; G = F.lds + grp * GRP; } while (0)
#define RK_KA() const __attribute__((address_space(4))) Args* ka = (const __attribute__((address_space(4))) Args*)__builtin_amdgcn_kernarg_segment_ptr(); asm volatile("" : "+s"(ka))
#define s0 (G)
#define s1 (G + IMG)
#define s2 (G + 2 * IMG)
#define s3 (G + 3 * IMG)
#define s4 (G + 4 * IMG)
#define s5 (G + 5 * IMG)
#define s6 (G + 6 * IMG)
#define s7 (G + 7 * IMG)
#define nrminv ((LAS float*)(G + MISC))
#define ltot (nrminv + 64)
#define gam (nrminv + 128)
#define bonp (nrminv + 192)
__device__ __forceinline__ void r1_S1a(Frame& F, R1Ctx& X) {
    using namespace rk;
    int grp, w4, ti, tj, lane, tg; Ln l; LAS unsigned char* G; const f32x16 z16 = {};
    RK_RELANE(); (void)w4; (void)tg; (void)ti; (void)tj;
    const int item = X.item, c = X.c, h = X.h, b = X.b; (void)item; (void)c; (void)h; (void)b;
    { RK_KA(); const bf16* RW = (const bf16*)(ka->ws + WS_RW); const float* mu_ = ka->in[5]; const float* kk_ = ka->in[10];
      const int t = tg >> 2, q4 = tg & 3; const int sq = c * 64 + t; const size_t row = (size_t)b * SEQ + sq;
      const bf16* cur = RW + row * RWC; const bool hasp = sq > 0; const bf16* prv = hasp ? cur - RWC : cur; const float pm = hasp ? 1.f : 0.f;
      float nr = 0.f;
#pragma unroll
      for (int half = 0; half < 2; ++half) { const int k0 = 16 * q4 + 8 * half, col = h * HD + k0;
          const v4u cr = *(const v4u*)(cur + col), pr = *(const v4u*)(prv + col), ck = *(const v4u*)(cur + 512 + col), pk = *(const v4u*)(prv + 512 + col), cv = *(const v4u*)(cur + 1024 + col), pv = *(const v4u*)(prv + 1024 + col);
          const v4u cw = *(const v4u*)(cur + 2048 + k0), pw = *(const v4u*)(prv + 2048 + k0), ca = *(const v4u*)(cur + 2112 + k0), pa = *(const v4u*)(prv + 2112 + k0);
          float ro[8], ko[8], vo[8], wo[8], ao[8];
#pragma unroll
          for (int e = 0; e < 8; ++e) { const unsigned wcr = cr[e >> 1], wpr = pr[e >> 1], wck = ck[e >> 1], wpk = pk[e >> 1], wcv = cv[e >> 1], wpv = pv[e >> 1];
              const unsigned wcw = cw[e >> 1], wpw = pw[e >> 1], wca = ca[e >> 1], wpa = pa[e >> 1];
              const float xr = (e & 1) ? bfhi(wcr) : bflo(wcr), yr = pm * ((e & 1) ? bfhi(wpr) : bflo(wpr)); ro[e] = xr + (yr - xr) * mu_[col + e];
              const float xk = (e & 1) ? bfhi(wck) : bflo(wck), yk = pm * ((e & 1) ? bfhi(wpk) : bflo(wpk)); ko[e] = xk + (yk - xk) * mu_[512 + col + e];
              const float xv = (e & 1) ? bfhi(wcv) : bflo(wcv), yv = pm * ((e & 1) ? bfhi(wpv) : bflo(wpv)); vo[e] = xv + (yv - xv) * mu_[1024 + col + e];
              const float xw = (e & 1) ? bfhi(wcw) : bflo(wcw), yw = pm * ((e & 1) ? bfhi(wpw) : bflo(wpw)); wo[e] = ftanh(xw + (yw - xw) * mu_[2048 + k0 + e]);
              const float xa = (e & 1) ? bfhi(wca) : bflo(wca), ya = pm * ((e & 1) ? bfhi(wpa) : bflo(wpa)); ao[e] = xa + (ya - xa) * mu_[2112 + k0 + e];
              const float kkx = ko[e] * kk_[col + e]; nr += kkx * kkx; }
          const int off = t * P + k0 * 2;
          *(LAS u32x4*)(s0 + off) = (u32x4){cvtpk(wo[0], wo[1]), cvtpk(wo[2], wo[3]), cvtpk(wo[4], wo[5]), cvtpk(wo[6], wo[7])};
          *(LAS u32x4*)(s1 + off) = (u32x4){cvtpk(ao[0], ao[1]), cvtpk(ao[2], ao[3]), cvtpk(ao[4], ao[5]), cvtpk(ao[6], ao[7])};
          *(LAS u32x4*)(s2 + off) = (u32x4){cvtpk(ro[0], ro[1]), cvtpk(ro[2], ro[3]), cvtpk(ro[4], ro[5]), cvtpk(ro[6], ro[7])};
          *(LAS u32x4*)(s3 + off) = (u32x4){cvtpk(ko[0], ko[1]), cvtpk(ko[2], ko[3]), cvtpk(ko[4], ko[5]), cvtpk(ko[6], ko[7])};
          *(LAS u32x4*)(s4 + off) = (u32x4){cvtpk(vo[0], vo[1]), cvtpk(vo[2], vo[3]), cvtpk(vo[4], vo[5]), cvtpk(vo[6], vo[7])}; }
      nr += __shfl_xor(nr, 1); nr += __shfl_xor(nr, 2);
      if (q4 == 0) nrminv[t] = frsq(fmaxf(nr, 1e-24f)); }
}
__device__ __forceinline__ void r1_S1b(Frame& F, R1Ctx& X) {
    using namespace rk;
    int grp, w4, ti, tj, lane, tg; Ln l; LAS unsigned char* G; const f32x16 z16 = {};
    RK_RELANE(); (void)w4; (void)tg; (void)ti; (void)tj;
    const int item = X.item, c = X.c, h = X.h, b = X.b; (void)item; (void)c; (void)h; (void)b;
    {
        RK_KA(); const bf16* WupT = (const bf16*)(ka->ws + WS_WUPT); const bf16* AupT = (const bf16*)(ka->ws + WS_AUPT);
        const int kcol = 32 * tj + l.r, kc = h * HD + kcol;
        f32x16 W = z16, Aq = z16;
#pragma unroll
        for (int s = 0; s < 4; ++s) { const bf16x8 bw = *(const bf16x8*)(WupT + (size_t)kc * 64 + 16 * s + 8 * l.h), ba = *(const bf16x8*)(AupT + (size_t)kc * 64 + 16 * s + 8 * l.h);
            W = RK_MFMA(frag_row(s0, l, ti, s), bw, W); Aq = RK_MFMA(frag_row(s1, l, ti, s), ba, Aq); }
        const float w0 = ka->in[6][kc], a0 = ka->in[8][kc], kkc = ka->in[10][kc], kac = ka->in[11][kc], rkc = ka->in[12][kc];
        float lw[16], L[16];
#pragma unroll
        for (int r = 0; r < 16; ++r) { const float x = W[r] + w0; const float sp = (-x > 20.f) ? -x : 0.6931471805599453f * __builtin_amdgcn_logf(1.0f + fexp(-x)); lw[r] = -fexp(-sp - 0.5f); Aq[r] = sigm(Aq[r] + a0); }
        float gs[4], go[4];
#pragma unroll
        for (int g = 0; g < 4; ++g) { L[4 * g] = lw[4 * g]; L[4 * g + 1] = L[4 * g] + lw[4 * g + 1]; L[4 * g + 2] = L[4 * g + 1] + lw[4 * g + 2]; L[4 * g + 3] = L[4 * g + 2] + lw[4 * g + 3]; gs[g] = L[4 * g + 3]; }
        float run = 0.f;
#pragma unroll
        for (int g = 0; g < 4; ++g) { const float og = xhalf(gs[g]); const float lo = l.h ? og : gs[g], hi = l.h ? gs[g] : og;
            go[g] = run + (l.h ? lo : 0.f); run += lo + hi; }
#pragma unroll
        for (int r = 0; r < 16; ++r) L[r] += go[r >> 2];
        if (ti == 0 && l.h == 0) ltot[kcol] = run;
        __syncthreads();
        if (ti == 1) { const float add = ltot[kcol];
#pragma unroll
            for (int r = 0; r < 16; ++r) L[r] += add;
            if (l.h == 1) gam[kcol] = fexp(L[15]); }
        f32x16 At, Bt, Kt, Rt; float xb[16];
#pragma unroll
        for (int r = 0; r < 16; ++r) { const int t = 32 * ti + crow(r, l.h);
            const float rr = bf2f(*(const LAS unsigned short*)(s2 + t * P + kcol * 2)), kx = bf2f(*(const LAS unsigned short*)(s3 + t * P + kcol * 2));
            const float kn = kx * kkc * nrminv[t], a = Aq[r], km = kx * (1.0f + (a - 1.0f) * kac);
            const float eL = fexp(L[r]), eLn = fexp(-L[r]), eLp = fexp(L[r] - lw[r]);
            At[r] = -kn * eLp; Bt[r] = kn * a * eLn; Kt[r] = km * eLn; Rt[r] = rr * eL; xb[r] = rr * km * rkc; }
#pragma unroll
        for (int r = 0; r < 16; ++r) xb[r] = dpp_sum32(xb[r]);
        if (l.r == 31) {
#pragma unroll
            for (int r = 0; r < 16; ++r) bonp[tj * 64 + 32 * ti + crow(r, l.h)] = xb[r]; }
        store_T(s0, l, At, ti, tj); store_T(s1, l, Bt, ti, tj); store_T(s5, l, Kt, ti, tj); store_T(s6, l, Rt, ti, tj);
    }
}
__device__ __forceinline__ void r1_S2(Frame& F, R1Ctx& X) {
    using namespace rk;
    int grp, w4, ti, tj, lane, tg; Ln l; LAS unsigned char* G; const f32x16 z16 = {};
    RK_RELANE(); (void)w4; (void)tg; (void)ti; (void)tj;
    const int item = X.item, c = X.c, h = X.h, b = X.b; (void)item; (void)c; (void)h; (void)b;
    {
        f32x16 X = z16;
        if (ti >= tj) {
#pragma unroll
            for (int s = 0; s < 4; ++s) X = RK_MFMA(frag_tr(s0, l, ti, s), frag_tr(s5, l, tj, s), X);
#pragma unroll
            for (int r = 0; r < 16; ++r) { const int t = 32 * ti + crow(r, l.h), i = 32 * tj + l.r; if (!(t > i)) X[r] = 0.f; } }
        store_T(s2, l, X, ti, tj);
        if (w4 == 0 || w4 == 3) { const int d = w4 == 3;
            f32x16 S = z16, ST = z16;
#pragma unroll
            for (int s = 0; s < 4; ++s) { const bf16x8 fa = frag_tr(s0, l, d, s), fb = frag_tr(s1, l, d, s); S = RK_MFMA(fa, fb, S); ST = RK_MFMA(fb, fa, ST); }
#pragma unroll
            for (int r = 0; r < 16; ++r) { const int rw = crow(r, l.h); if (!(rw > l.r)) S[r] = 0.f; if (!(l.r > rw)) ST[r] = 0.f; }
            f32x16 D = S, DT = ST;
            tri_inv32(D, DT, S, ST);
            store_T(s7, l, D, d, d);
            asm volatile("s_waitcnt lgkmcnt(0)" ::: "memory");
            if (l.h == 0) *(LAS unsigned short*)(s7 + (32 * d + l.r) * P + (32 * d + l.r) * 2) = 0x3f80;
        } else if (w4 == 2) {
            f32x16 X21 = z16;
#pragma unroll
            for (int s = 0; s < 4; ++s) X21 = RK_MFMA(frag_tr(s0, l, 1, s), frag_tr(s1, l, 0, s), X21);
            store_T(s3, l, X21, 0, 0);
        } else {
            store_T(s7, l, z16, 0, 1);
            { RK_KA(); float* BON = (float*)(ka->ws + WS_BON); const int t = lane; BON[((size_t)b * SEQ + c * 64 + t) * NH + h] = bonp[t] + bonp[64 + t]; }
        }
    }
}
__device__ __forceinline__ void r1_S3(Frame& F, R1Ctx& X) {
    using namespace rk;
    int grp, w4, ti, tj, lane, tg; Ln l; LAS unsigned char* G; const f32x16 z16 = {};
    RK_RELANE(); (void)w4; (void)tg; (void)ti; (void)tj;
    const int item = X.item, c = X.c, h = X.h, b = X.b; (void)item; (void)c; (void)h; (void)b;
    f32x16& Wt0 = X.Wt0; f32x16& Wt1 = X.Wt1;
    Wt0 = z16; Wt1 = z16;
    {
        if (w4 == 2) {
            f32x16 E = z16;
#pragma unroll
            for (int s = 0; s < 2; ++s) E = RK_MFMA(frag_tr(s3, l, 0, s), frag_row(s7, l, 0, s), E);
            store_T(s3, l, E, 0, 1);
            f32x16 T21 = z16;
#pragma unroll
            for (int s = 0; s < 2; ++s) T21 = RK_MFMA(frag_tr(s7, l, 1, s, 32), frag_row(s3, l, 1, s), T21);
            store_T(s7, l, T21, 1, 0);
        }
#pragma unroll
        for (int s = 0; s < 4; ++s) Wt0 = RK_MFMA(frag_tr(s2, l, 0, s), frag_tr(s4, l, tj, s), Wt0);
        if (ti == 1) {
#pragma unroll
            for (int s = 0; s < 4; ++s) Wt1 = RK_MFMA(frag_tr(s2, l, 1, s), frag_tr(s4, l, tj, s), Wt1); }
    }
}
__device__ __forceinline__ void r1_S4(Frame& F, R1Ctx& X) {
    using namespace rk;
    int grp, w4, ti, tj, lane, tg; Ln l; LAS unsigned char* G; const f32x16 z16 = {};
    RK_RELANE(); (void)w4; (void)tg; (void)ti; (void)tj;
    const int item = X.item, c = X.c, h = X.h, b = X.b; (void)item; (void)c; (void)h; (void)b;
    f32x16& Wt0 = X.Wt0; f32x16& Wt1 = X.Wt1;
    {
        f32x16 Ap = z16;
#pragma unroll
        for (int s = 0; s < 4; ++s) if (s < 2 || ti == 1) Ap = RK_MFMA(frag_tr(s7, l, ti, s), frag_row(s0, l, tj, s), Ap);
        f32x16 Uv = z16;
#pragma unroll
        for (int s = 0; s < 2; ++s) Uv = RK_MFMA(frag_tr_perm(s7, l, ti, s, 0), pack(Wt0, s), Uv);
        if (ti == 1) {
#pragma unroll
            for (int s = 0; s < 2; ++s) Uv = RK_MFMA(frag_tr_perm(s7, l, ti, s, 32), pack(Wt1, s), Uv); }
        store_T(s2, l, Ap, ti, tj); store_T(s3, l, Uv, ti, tj);
    }
}
__device__ __forceinline__ void r1_S5(Frame& F, R1Ctx& X) {
    using namespace rk;
    int grp, w4, ti, tj, lane, tg; Ln l; LAS unsigned char* G; const f32x16 z16 = {};
    RK_RELANE(); (void)w4; (void)tg; (void)ti; (void)tj;
    const int item = X.item, c = X.c, h = X.h, b = X.b; (void)item; (void)c; (void)h; (void)b;
    {
        RK_KA(); float* NT = (float*)((unsigned char*)ka->out + DO_NT); bf16* MT = (bf16*)((unsigned char*)ka->out + DO_MT); bf16* RH = (bf16*)((unsigned char*)ka->out + DO_RH); bf16* Y0 = (bf16*)(ka->ws + WS_GATE);
        const size_t ib = (size_t)item * 4096;
        f32x16 Xrb0 = z16, Xrk0 = z16, Xrb1 = z16, Xrk1 = z16;
#pragma unroll
        for (int s = 0; s < 4; ++s) { const bf16x8 fr = frag_tr(s6, l, ti, s); Xrb0 = RK_MFMA(frag_tr(s1, l, 0, s), fr, Xrb0); Xrk0 = RK_MFMA(frag_tr(s5, l, 0, s), fr, Xrk0); }
        if (ti == 1) {
#pragma unroll
            for (int s = 0; s < 4; ++s) { const bf16x8 fr = frag_tr(s6, l, ti, s); Xrb1 = RK_MFMA(frag_tr(s1, l, 1, s), fr, Xrb1); Xrk1 = RK_MFMA(frag_tr(s5, l, 1, s), fr, Xrk1); } }
#pragma unroll
        for (int r = 0; r < 16; ++r) { const bool keep = crow(r, l.h) <= l.r; if (ti == 0) { if (!keep) { Xrb0[r] = 0.f; Xrk0[r] = 0.f; } } else { if (!keep) { Xrb1[r] = 0.f; Xrk1[r] = 0.f; } } }
        f32x16 acc;
#pragma unroll
        for (int g = 0; g < 4; ++g) { const u32x2 w = *(const LAS u32x2*)(s6 + (32 * tj + l.r) * P + (32 * ti + 8 * g + 4 * l.h) * 2); acc[4 * g] = bflo(w.x); acc[4 * g + 1] = bfhi(w.x); acc[4 * g + 2] = bflo(w.y); acc[4 * g + 3] = bfhi(w.y); }
#pragma unroll
        for (int s = 0; s < 2; ++s) acc = RK_MFMA(pack(Xrb0, s), frag_row_perm(s2, l, tj, s, 0), acc);
        if (ti == 1) {
#pragma unroll
            for (int s = 0; s < 2; ++s) acc = RK_MFMA(pack(Xrb1, s), frag_row_perm(s2, l, tj, s, 32), acc); }
#pragma unroll
        for (int r = 0; r < 16; ++r) RH[ib + (32 * ti + crow(r, l.h)) * 64 + 32 * tj + l.r] = (bf16)f2bf(acc[r]);
        acc = z16;
#pragma unroll
        for (int s = 0; s < 2; ++s) { acc = RK_MFMA(pack(Xrb0, s), frag_row_perm(s3, l, tj, s, 0), acc); acc = RK_MFMA(pack(Xrk0, s), frag_tr_perm(s4, l, tj, s, 0), acc); }
        if (ti == 1) {
#pragma unroll
            for (int s = 0; s < 2; ++s) { acc = RK_MFMA(pack(Xrb1, s), frag_row_perm(s3, l, tj, s, 32), acc); acc = RK_MFMA(pack(Xrk1, s), frag_tr_perm(s4, l, tj, s, 32), acc); } }
#pragma unroll
        for (int r = 0; r < 16; ++r) Y0[ib + (32 * ti + crow(r, l.h)) * 64 + 32 * tj + l.r] = (bf16)f2bf(acc[r]);
        acc = z16;
#pragma unroll
        for (int s = 0; s < 4; ++s) acc = RK_MFMA(frag_row(s1, l, ti, s), frag_row(s2, l, tj, s), acc);
#pragma unroll
        for (int r = 0; r < 16; ++r) { const int kp = 32 * ti + crow(r, l.h), k = 32 * tj + l.r; const float v = (acc[r] + (kp == k ? 1.f : 0.f)) * gam[kp]; MT[ib + kp * 64 + k] = (bf16)f2bf(v); }
        acc = z16;
#pragma unroll
        for (int s = 0; s < 4; ++s) { acc = RK_MFMA(frag_row(s1, l, ti, s), frag_row(s3, l, tj, s), acc); acc = RK_MFMA(frag_row(s5, l, ti, s), frag_tr(s4, l, tj, s), acc); }
#pragma unroll
        for (int r = 0; r < 16; ++r) NT[ib + ((ti * 2 + tj) * 16 + r) * 64 + lane] = acc[r] * gam[32 * ti + crow(r, l.h)];
    }
}
#ifndef MK_R1_REP
#define MK_R1_REP -1
#endif
__device__ __forceinline__ void rwkv_chunk_ops(Frame& F) {
    R1Ctx X;
    for (int ip = F.vcu; ip < BATCH * NH * 64 / 2; ip += F.G) {
        { int t_ = F.tid; asm volatile("" : "+v"(t_)); const int grp = t_ >> 8; X.item = ip * 2 + grp; X.c = X.item & 63; const int bh = X.item >> 6; X.h = bh % NH; X.b = bh / NH; }
        r1_S1a(F, X); __syncthreads();
        if constexpr (MK_R1_REP == 0) { r1_S1a(F, X); __syncthreads(); }
        r1_S1b(F, X); __syncthreads();
        if constexpr (MK_R1_REP == 1) { r1_S1a(F, X); __syncthreads(); r1_S1b(F, X); __syncthreads(); }
        r1_S2(F, X); __syncthreads();
        if constexpr (MK_R1_REP == 2) { r1_S2(F, X); __syncthreads(); }
        r1_S3(F, X); __syncthreads();
        r1_S4(F, X); __syncthreads();
        r1_S5(F, X); __syncthreads();
        if constexpr (MK_R1_REP == 5) { r1_S5(F, X); __syncthreads(); }
    }
}
#undef s0
#undef s1
#undef s2
#undef s3
#undef s4
#undef s5
#undef s6
#undef s7
#undef nrminv
#undef ltot
#undef gam
#undef bonp
__device__ __forceinline__ void rwkv_scan(Frame& F) {
    using namespace rk;
    const int lane = F.lane, wid = F.wave; const int lr = lane & 31, lh = lane >> 5;
    LAS float* sbuf = (LAS float*)F.lds; LAS float* yst = (LAS float*)(F.lds + 32768 + wid * 8704); LAS float* cst = (LAS float*)(F.lds + 102400);
    volatile LAS int* flag = (volatile LAS int*)(F.lds + 103936);
    const bf16* RW = (const bf16*)(F.ws + WS_RW); bf16* QKVZ = (bf16*)(F.ws + WS_QKVZ);
    const float* NT = (const float*)((unsigned char*)F.out + DO_NT); const bf16* MT = (const bf16*)((unsigned char*)F.out + DO_MT); const bf16* RH = (const bf16*)((unsigned char*)F.out + DO_RH);
    const bf16* Y0 = (const bf16*)(F.ws + WS_GATE); const float* BON = (const float*)(F.ws + WS_BON);
    for (int bh = F.vcu; bh < BATCH * NH; bh += F.G) {
        const int h = bh % NH, b = bh / NH;
        __syncthreads();
        for (int i = F.tid; i < 6 * 64; i += NTHR) { const int a = i >> 6, v = i & 63, col = h * HD + v;
            cst[i] = a == 0 ? F.mu[1024 + col] : a == 1 ? F.mu[1536 + col] : a == 2 ? F.ln_w[col] : a == 3 ? F.ln_b[col] : 0.f; }
        for (int i = F.tid; i < 4096; i += NTHR) sbuf[i] = 0.f;
        if (F.tid == 0) flag[0] = 0;
        __syncthreads();
        for (int c = wid; c < 64; c += NWAVES) {
            const size_t ib = (size_t)(bh * 64 + c) * 4096;
            bf16x8 am[2][4], ar[2][4]; f32x16 sn[2][2];
#pragma unroll
            for (int rt = 0; rt < 2; ++rt)
#pragma unroll
                for (int s = 0; s < 4; ++s) { const bf16* pm = MT + ib + (32 * rt + lr) * 64 + 16 * s + 4 * lh; const bf16* pr = RH + ib + (32 * rt + lr) * 64 + 16 * s + 4 * lh;
                    const v2u m0 = *(const v2u*)pm, m1 = *(const v2u*)(pm + 8), r0 = *(const v2u*)pr, r1 = *(const v2u*)(pr + 8);
                    am[rt][s] = __builtin_bit_cast(bf16x8, (u32x4){m0.x, m0.y, m1.x, m1.y}); ar[rt][s] = __builtin_bit_cast(bf16x8, (u32x4){r0.x, r0.y, r1.x, r1.y}); }
#pragma unroll
            for (int rt = 0; rt < 2; ++rt)
#pragma unroll
                for (int ct = 0; ct < 2; ++ct)
#pragma unroll
                    for (int r = 0; r < 16; ++r) sn[rt][ct][r] = NT[ib + ((rt * 2 + ct) * 16 + r) * 64 + lane];
            while (flag[0] < c) __builtin_amdgcn_s_sleep(1);
            asm volatile("s_waitcnt lgkmcnt(0)" ::: "memory");
            const LAS float* sin = sbuf + (c & 1) * 4096; LAS float* sout = sbuf + ((c + 1) & 1) * 4096;
            bf16x8 sp[2][2][2];
#pragma unroll
            for (int kt = 0; kt < 2; ++kt)
#pragma unroll
                for (int ct = 0; ct < 2; ++ct) { f32x16 sv;
#pragma unroll
                    for (int r = 0; r < 16; ++r) sv[r] = sin[((kt * 2 + ct) * 16 + r) * 64 + lane];
                    sp[kt][ct][0] = pack(sv, 0); sp[kt][ct][1] = pack(sv, 1); }
#pragma unroll
            for (int rt = 0; rt < 2; ++rt)
#pragma unroll
                for (int ct = 0; ct < 2; ++ct)
#pragma unroll
                    for (int s = 0; s < 4; ++s) sn[rt][ct] = RK_MFMA(am[rt][s], sp[s >> 1][ct][s & 1], sn[rt][ct]);
#pragma unroll
            for (int rt = 0; rt < 2; ++rt)
#pragma unroll
                for (int ct = 0; ct < 2; ++ct)
#pragma unroll
                    for (int r = 0; r < 16; ++r) sout[((rt * 2 + ct) * 16 + r) * 64 + lane] = sn[rt][ct][r];
            asm volatile("s_waitcnt lgkmcnt(0)" ::: "memory");
            if (lane == 0) flag[0] = c + 1;
#pragma unroll
            for (int tt = 0; tt < 2; ++tt) {
                f32x16 y0 = {}, y1 = {};
#pragma unroll
                for (int s = 0; s < 4; ++s) { y0 = RK_MFMA(ar[tt][s], sp[s >> 1][0][s & 1], y0); y1 = RK_MFMA(ar[tt][s], sp[s >> 1][1][s & 1], y1); }
#pragma unroll
                for (int r = 0; r < 16; ++r) { yst[crow(r, lh) * 68 + lr] = y0[r]; yst[crow(r, lh) * 68 + 32 + lr] = y1[r]; }
                asm volatile("s_waitcnt lgkmcnt(0)" ::: "memory");
                const int q = lane >> 1, c0 = (lane & 1) * 32; const int sq = c * 64 + tt * 32 + q; const size_t row = (size_t)b * SEQ + sq;
                float y[32];
                const bf16* y0p = Y0 + ib + (tt * 32 + q) * 64 + c0;
#pragma unroll
                for (int e = 0; e < 32; e += 8) { const f32x4 a = *(const LAS f32x4*)(yst + q * 68 + c0 + e), bq = *(const LAS f32x4*)(yst + q * 68 + c0 + e + 4); const v4u w = *(const v4u*)(y0p + e);
                    y[e] = a[0] + bflo(w.x); y[e + 1] = a[1] + bfhi(w.x); y[e + 2] = a[2] + bflo(w.y); y[e + 3] = a[3] + bfhi(w.y); y[e + 4] = bq[0] + bflo(w.z); y[e + 5] = bq[1] + bfhi(w.z); y[e + 6] = bq[2] + bflo(w.w); y[e + 7] = bq[3] + bfhi(w.w); }
                float sm = 0.f;
#pragma unroll
                for (int e = 0; e < 32; ++e) sm += y[e];
                sm += __shfl_xor(sm, 1); const float mean = sm * (1.f / 64.f);
                float sv = 0.f;
#pragma unroll
                for (int e = 0; e < 32; ++e) { const float d = y[e] - mean; sv += d * d; }
                sv += __shfl_xor(sv, 1); const float rstd = frsq(sv * (1.f / 64.f) + GN_EPS);
                const float bon = BON[row * NH + h];
                const bf16* cur = RW + row * RWC + h * HD + c0; const bool hasp = sq > 0; const bf16* prv = hasp ? cur - RWC : cur; const float pmk = hasp ? 1.f : 0.f;
                bf16* op = QKVZ + row * 2048 + 512 + h * HD + c0;
#pragma unroll
                for (int e = 0; e < 32; e += 8) { const v4u cv = *(const v4u*)(cur + 1024 + e), pv = *(const v4u*)(prv + 1024 + e), cz = *(const v4u*)(cur + 1536 + e), pz = *(const v4u*)(prv + 1536 + e);
                    float o[8];
#pragma unroll
                    for (int j = 0; j < 8; ++j) { const unsigned wcv = cv[j >> 1], wpv = pv[j >> 1], wcz = cz[j >> 1], wpz = pz[j >> 1];
                        const float xv = (j & 1) ? bfhi(wcv) : bflo(wcv), yv = pmk * ((j & 1) ? bfhi(wpv) : bflo(wpv)); const float vv = xv + (yv - xv) * cst[c0 + e + j];
                        const float xz = (j & 1) ? bfhi(wcz) : bflo(wcz), yz = pmk * ((j & 1) ? bfhi(wpz) : bflo(wpz)); const float zz = xz + (yz - xz) * cst[64 + c0 + e + j];
                        const float gn = (y[e + j] - mean) * rstd * cst[128 + c0 + e + j] + cst[192 + c0 + e + j] + bon * vv;
                        o[j] = gn * zz * sigm(zz); }
                    *(v4u*)(op + e) = (v4u){pk2(o[0], o[1]), pk2(o[2], o[3]), pk2(o[4], o[5]), pk2(o[6], o[7])}; }
                asm volatile("s_waitcnt lgkmcnt(0)" ::: "memory");
            }
        }
    }
}
constexpr int LDS_BYTES = 163840;
constexpr int NPHASE = 12;

template <int PLO, int PHI> __global__ void __launch_bounds__(NTHR, 2) fwd(Args args) {
    extern __shared__ __attribute__((aligned(16))) unsigned char lds[];
    Frame F;
    F.lds = (LAS unsigned char*)lds;
#define RETID() do { int t_ = threadIdx.x; asm volatile("" : "+v"(t_)); F.tid = t_; F.lane = t_ & 63; F.wave = __builtin_amdgcn_readfirstlane(t_ >> 6); } while (0)
    RETID();
    F.G = gridDim.x; { const int bx = blockIdx.x; F.vcu = (F.G % 8 == 0) ? (bx % 8) * (F.G / 8) + bx / 8 : bx; }
#define LOADF() do { const __attribute__((address_space(4))) Args* ap_ = (const __attribute__((address_space(4))) Args*)__builtin_amdgcn_kernarg_segment_ptr(); asm volatile("" : "+s"(ap_)); \
    F.x = ap_->in[0]; F.p = ap_->in[1]; F.g_pre = ap_->in[2]; F.w_in = ap_->in[3]; F.rel_bias = ap_->in[4]; F.mu = ap_->in[5]; F.w0 = ap_->in[6]; F.w_up = ap_->in[7]; \
    F.a0 = ap_->in[8]; F.a_up = ap_->in[9]; F.k_k = ap_->in[10]; F.k_a = ap_->in[11]; F.r_k = ap_->in[12]; F.ln_w = ap_->in[13]; F.ln_b = ap_->in[14]; \
    F.p_a = ap_->in[15]; F.p_b = ap_->in[16]; F.w_out = ap_->in[17]; F.g_post = ap_->in[18]; F.w_pu = ap_->in[19]; F.w_pg = ap_->in[20]; F.out = ap_->out; F.ws = ap_->ws; ws = F.ws; \
    U2 = (pg8::bf16_t*)F.out; MERGED = (pg8::bf16_t*)F.out; QKVZ = (pg8::bf16_t*)(ws + WS_QKVZ); RWb = (pg8::bf16_t*)(ws + WS_RW); GAB = (pg8::bf16_t*)(ws + WS_GAB); } while (0)
    unsigned char* ws; pg8::bf16_t *U2, *MERGED, *QKVZ, *RWb, *GAB;
    constexpr int lo = PLO, hi = PHI;
    cg::grid_group grid = cg::this_grid();
#define IN(k) (lo <= (k) && (k) < hi)
#define SEAM(k) do { if constexpr (IN(k) && IN((k) + 1)) grid.sync(); } while (0)
#ifndef MK_REPEAT_PHASE
#define MK_REPEAT_PHASE -1
#endif
#define NREP(k) (((k) == MK_REPEAT_PHASE) ? 2 : 1)

    if constexpr (IN(0)) { RETID(); LOADF(); p0_prologue(F); if constexpr (0 == MK_REPEAT_PHASE) { grid.sync(); RETID(); LOADF(); p0_prologue(F); } } SEAM(0);
    if constexpr (IN(1)) { LOADF();
        { pg8::Gemm g{U2, (const pg8::bf16_t*)(ws + WS_WIN), M, INCP, DM, 2048, DM, 0, 0}; pg8::StaticOrder S; S.init(M, INCP, F.G, (int)blockIdx.x);
          pg8::EpiCols E{QKVZ, RWb, GAB, QSCALE};
          pg8::gemm_phase<pg8::EpiCols, pg8::StaticOrder, true, true>(F.lds, g, S, E); }
        { pg8::Gemm g{U2, (const pg8::bf16_t*)(ws + WS_WG), M, 256, 2048, 2048, 2048, 16, (size_t)256 * 2048}; pg8::StaticOrder S; S.init(M, 256, F.G, (int)blockIdx.x);
          pg8::EpiF32 E{(float*)(ws + WS_GATE), 256};
          pg8::gemm_phase<pg8::EpiF32, pg8::StaticOrder, true, true>(F.lds, g, S, E); }
    } SEAM(1);
    if constexpr (IN(2)) { RETID(); LOADF(); attn_select(F, (const float*)(ws + WS_GATE), (unsigned*)(ws + WS_CNT), (unsigned short*)((unsigned char*)F.out + DO_LISTS));
        if constexpr (2 == MK_REPEAT_PHASE) { grid.sync(); if (blockIdx.x == 0) for (int i = threadIdx.x; i < 2048; i += NTHR) ((unsigned*)(args.ws + WS_CNT))[i] = 0u; grid.sync(); RETID(); LOADF();
            attn_select(F, (const float*)(ws + WS_GATE), (unsigned*)(ws + WS_CNT), (unsigned short*)((unsigned char*)F.out + DO_LISTS)); } } SEAM(2);
    if constexpr (IN(3)) { RETID(); LOADF(); attn_partial(F, (const bf16*)(ws + WS_QKVZ), (const unsigned*)(ws + WS_CNT), (const unsigned short*)((unsigned char*)F.out + DO_LISTS),
                                         (bf16*)((unsigned char*)F.out + DO_PARTO), (float*)((unsigned char*)F.out + DO_PARTML), (unsigned*)(ws + WS_QCTR)); if constexpr (3 == MK_REPEAT_PHASE) { { grid.sync(); if (blockIdx.x == 0 && threadIdx.x == 0) *(unsigned*)(args.ws + WS_QCTR) = 0u; grid.sync(); } RETID(); LOADF(); attn_partial(F, (const bf16*)(ws + WS_QKVZ), (const unsigned*)(ws + WS_CNT), (const unsigned short*)((unsigned char*)F.out + DO_LISTS),
                                         (bf16*)((unsigned char*)F.out + DO_PARTO), (float*)((unsigned char*)F.out + DO_PARTML), (unsigned*)(ws + WS_QCTR)); } } SEAM(3);
    if constexpr (IN(4)) { RETID(); LOADF();
        if constexpr (4 == MK_REPEAT_PHASE) { attn_own_combine(F, (bf16*)(ws + WS_QKVZ), (const bf16*)((unsigned char*)F.out + DO_PARTO), (const float*)((unsigned char*)F.out + DO_PARTML), (bf16*)(ws + WS_GATE), 512); grid.sync(); RETID(); LOADF(); }
        attn_own_combine(F, (bf16*)(ws + WS_QKVZ), (const bf16*)((unsigned char*)F.out + DO_PARTO), (const float*)((unsigned char*)F.out + DO_PARTML), (bf16*)(ws + WS_QKVZ), 2048); } SEAM(4);
    if constexpr (IN(5)) { RETID(); LOADF(); rwkv_chunk_ops(F); if constexpr (5 == MK_REPEAT_PHASE) { grid.sync(); RETID(); LOADF(); rwkv_chunk_ops(F); } } SEAM(5);
    if constexpr (IN(6)) { RETID(); LOADF(); rwkv_scan(F); if constexpr (6 == MK_REPEAT_PHASE) { grid.sync(); RETID(); LOADF(); rwkv_scan(F); } } SEAM(6);
    if constexpr (IN(7)) { LOADF();
        pg8::Gemm g{QKVZ, (const pg8::bf16_t*)(ws + WS_PAB), M, DM, 512, 2048, 1024, 0, 0}; pg8::StaticOrder S; S.init(M, DM, F.G, (int)blockIdx.x);
        pg8::EpiMerge<false> E{MERGED, DM, GAB, 2048};
        pg8::gemm_phase<pg8::EpiMerge<false>, pg8::StaticOrder, true, true>(F.lds, g, S, E);
    } SEAM(7);
    if constexpr (IN(8)) { LOADF();
        pg8::Gemm g{QKVZ + 512, (const pg8::bf16_t*)(ws + WS_PAB) + 512, M, DM, 512, 2048, 1024, 0, 0}; pg8::StaticOrder S; S.init(M, DM, F.G, (int)blockIdx.x);
        pg8::EpiMerge<true> E{MERGED, DM, GAB + 1024, 2048};
        pg8::gemm_phase<pg8::EpiMerge<true>, pg8::StaticOrder, true, true>(F.lds, g, S, E);
    } SEAM(8);
    if constexpr (IN(9)) { LOADF();
        { pg8::Gemm g{MERGED, (const pg8::bf16_t*)(ws + WS_WOUT), M, DM, DM, DM, DM, 0, 0}; pg8::StaticOrder S; S.init(M, DM, F.G, (int)blockIdx.x);
          pg8::EpiF32 E{(float*)(ws + WS_RW), DM};
          pg8::gemm_phase<pg8::EpiF32, pg8::StaticOrder, true, true>(F.lds, g, S, E); }
        { pg8::Gemm g{(const pg8::bf16_t*)(ws + WS_PB), (const pg8::bf16_t*)(ws + WS_WPU), M, DM, PLE, PLE, PLE, 0, 0}; pg8::StaticOrder S; S.init(M, DM, F.G, (int)blockIdx.x);
          pg8::EpiBf16 E{GAB, DM};
          pg8::gemm_phase<pg8::EpiBf16, pg8::StaticOrder, true, true>(F.lds, g, S, E); }
    } SEAM(9);
    if constexpr (IN(10)) { RETID(); LOADF(); post_norm(F); if constexpr (10 == MK_REPEAT_PHASE) { grid.sync(); RETID(); LOADF(); post_norm(F); } } SEAM(10);
    if constexpr (IN(11)) { LOADF();
        pg8::Gemm g{QKVZ, (const pg8::bf16_t*)(ws + WS_WPG), M, DM, DM, DM, DM, 0, 0}; pg8::StaticOrder S; S.init(M, DM, F.G, (int)blockIdx.x);
        pg8::EpiFinal E{F.out, F.x, (const float*)(ws + WS_RW), (const float*)(ws + WS_RSY), F.g_post, GAB, DM};
        pg8::gemm_phase<pg8::EpiFinal, pg8::StaticOrder, true, true>(F.lds, g, S, E);
    }
#undef IN
#undef SEAM
}

#ifndef MK_ONE_LAUNCH
#define MK_ONE_LAUNCH 1
#endif
extern "C" void kernel_launch(void* const* d_in, const int* in_sizes, int n_in, void* d_out, int out_size, void* d_ws, size_t ws_size, hipStream_t stream) {
    static int grid = 0;
    if (grid == 0) {
        if (n_in != 21 || out_size != M * DM || ws_size < WS_END) { fprintf(stderr, "kernel_launch: unexpected shapes n_in %d out %d ws %zu\n", n_in, out_size, ws_size); grid = -1; return; }
        int dev = 0, cus = 0, per_cu = 0;
        (void)hipGetDevice(&dev); (void)hipDeviceGetAttribute(&cus, hipDeviceAttributeMultiprocessorCount, dev);
        (void)per_cu;
        grid = cus;
    }
    if (grid < 0) return;
    Args a{};
    for (int i = 0; i < 21; ++i) a.in[i] = (const float*)d_in[i];
    a.out = (float*)d_out; a.ws = (unsigned char*)d_ws;
#if MK_ONE_LAUNCH
    a.ph_lo = 0; a.ph_hi = NPHASE;
    void* kargs[] = {&a};
    (void)hipFuncSetAttribute((const void*)fwd<0, NPHASE>, hipFuncAttributeMaxDynamicSharedMemorySize, LDS_BYTES);
    hipError_t e = hipLaunchCooperativeKernel((const void*)fwd<0, NPHASE>, dim3(grid), dim3(NTHR), kargs, LDS_BYTES, stream);
    if (e != hipSuccess) fprintf(stderr, "cooperative launch failed: %s\n", hipGetErrorString(e));
#else
#define LAUNCH_PH(k) do { (void)hipFuncSetAttribute((const void*)fwd<k, k + 1>, hipFuncAttributeMaxDynamicSharedMemorySize, LDS_BYTES); a.ph_lo = k; a.ph_hi = k + 1; hipLaunchKernelGGL((fwd<k, k + 1>), dim3(grid), dim3(NTHR), LDS_BYTES, stream, a); } while (0)
    LAUNCH_PH(0); LAUNCH_PH(1); LAUNCH_PH(2); LAUNCH_PH(3); LAUNCH_PH(4); LAUNCH_PH(5); LAUNCH_PH(6); LAUNCH_PH(7); LAUNCH_PH(8); LAUNCH_PH(9); LAUNCH_PH(10); LAUNCH_PH(11);
#endif
}
```

```cpp
#include <hip/hip_runtime.h>
#include <hip/hip_cooperative_groups.h>
#include <cstdio>
#include <cstdint>
#include <cmath>
namespace cg = cooperative_groups;
namespace pg8 {
#define PG8_LAS __attribute__((address_space(3)))
typedef unsigned short bf16_t;
typedef short bf16x8 __attribute__((ext_vector_type(8)));
typedef float f32x4 __attribute__((ext_vector_type(4)));
typedef float f32x2 __attribute__((ext_vector_type(2)));
typedef unsigned u32x4 __attribute__((ext_vector_type(4)));
typedef unsigned u32x2 __attribute__((ext_vector_type(2)));
constexpr int BM = 256, BK = 64, HALF = 128, HTB = HALF * BK * 2  , STAGE_BYTES = 8 * HTB, NXCD = 8, WGM = 8;

__host__ __device__ __forceinline__ int lds_byte(int r, int c) { const int st = (r >> 4) * 2 + (c >> 5), rr = r & 15, cc = c & 31, ob = rr * 64 + cc * 2; return st * 1024 + (ob ^ (((ob >> 9) & 1) << 5)); }
__host__ __device__ __forceinline__ void stage_rc(int b, int& R, int& C) { const int st = b / 1024, sb = b % 1024, swz = sb ^ (((sb >> 9) & 1) << 5); R = (st >> 1) * 16 + swz / 64; C = (st & 1) * 32 + (swz % 64) / 2; }
__host__ __device__ __forceinline__ int perm32(int rho) { const int n = rho >> 4, i = rho & 15; return 8 * (i >> 2) + 4 * n + (i & 3); }

struct Unit { int pm, pn; };
struct Gemm { const bf16_t* A; const bf16_t* Bt; int M, N, K, lda, ldb, bdiv; size_t bstride; };

struct StaticOrder {
    int nM, nN, nwg, G, c;
    __host__ __device__ void init(int M, int N, int G_, int c_) { nM = M / BM; nN = N / BM; nwg = nM * nN; G = G_; c = c_; }
    __host__ __device__ bool next(int i, Unit& u) const {
        const long L = (long)i * G + c; if (L >= nwg) return false;
        int wgid = (int)L; { const int q = nwg / NXCD, r = nwg % NXCD, xcd = wgid % NXCD, off = wgid / NXCD; wgid = (xcd < r ? xcd * (q + 1) : r * (q + 1) + (xcd - r) * q) + off; }
        const int nig = WGM * nN, gid = wgid / nig, fm = gid * WGM, gsz = (nM - fm) < WGM ? (nM - fm) : WGM;
        u.pm = fm + ((wgid % nig) % gsz); u.pn = (wgid % nig) / gsz; return true;
    }
};

__device__ __forceinline__ unsigned cvt_pk_bf16(float lo, float hi) { unsigned r; asm volatile("v_cvt_pk_bf16_f32 %0, %1, %2" : "=v"(r) : "v"(lo), "v"(hi)); return r; }
__device__ __forceinline__ float bf_lo(unsigned w) { return __uint_as_float(w << 16); }
__device__ __forceinline__ float bf_hi(unsigned w) { return __uint_as_float(w & 0xffff0000u); }

template <class Epi, class Sched, bool ALIGN_EPI = false, bool SP2 = false>
__device__ __forceinline__ void gemm_phase(PG8_LAS unsigned char* lds, const Gemm g, const Sched& S, const Epi& E) {
    int tid_ = threadIdx.x; asm volatile("" : "+v"(tid_));
    const int tid = tid_, wid = __builtin_amdgcn_readfirstlane(tid >> 6), lane = tid & 63, wr = wid >> 2, wc = wid & 3, fr = lane & 15, fq = lane >> 4;
    const int K = g.K, nt = K / BK;
    unsigned voffA[2], voffB[2];
#pragma unroll
    for (int i = 0; i < 2; ++i) { int R, C; stage_rc(tid * 16 + i * 8192, R, C); const int Rb = Epi::PERM ? ((R & ~31) + perm32(R & 31)) : R;
        voffA[i] = (unsigned)(R * g.lda + C) * 2u; voffB[i] = (unsigned)(Rb * g.ldb + C) * 2u; }
    const size_t kstep = (size_t)(BK * 2);
    const size_t hstepA = (size_t)HALF * g.lda * 2, hstepB = (size_t)HALF * g.ldb * 2;
    const size_t tstepA = 2 * hstepA, tstepB = 2 * hstepB;
    const unsigned ldsw = (unsigned)wid * 1024u;
    const int aoff = lds_byte(wr * 64 + fr, fq * 8), boff = lds_byte(wc * 32 + fr, fq * 8);
#define PG8_SA(b, h) (((b) * 2 + (h)) * HTB)
#define PG8_SB(b, h) ((4 + (b) * 2 + (h)) * HTB)
#define PG8_STAGE(bufoff, gbase, voff) do { _Pragma("unroll") for (int _i = 0; _i < 2; ++_i) \
        __builtin_amdgcn_global_load_lds((const unsigned*)((const char*)(gbase) + (voff)[_i]), (PG8_LAS unsigned*)(lds + (bufoff) + ldsw + _i * 8192), 16, 0, 0); } while (0)
#define PG8_LDA(dst, b, h) do { _Pragma("unroll") for (int m = 0; m < 4; ++m) _Pragma("unroll") for (int k = 0; k < 2; ++k) dst[m][k] = *(const PG8_LAS bf16x8*)(lds + PG8_SA(b, h) + aoff + m * 2048 + k * 1024); } while (0)
#define PG8_LDB(dst, b, h) do { _Pragma("unroll") for (int n = 0; n < 2; ++n) _Pragma("unroll") for (int k = 0; k < 2; ++k) dst[n][k] = *(const PG8_LAS bf16x8*)(lds + PG8_SB(b, h) + boff + n * 2048 + k * 1024); } while (0)
#define PG8_MMA(ai, bj, At, Bt) do { __builtin_amdgcn_s_setprio(1); _Pragma("unroll") for (int m = 0; m < 4; ++m) _Pragma("unroll") for (int n = 0; n < 2; ++n) _Pragma("unroll") for (int k = 0; k < 2; ++k) \
        acc[ai][bj][m][n] = __builtin_amdgcn_mfma_f32_16x16x32_bf16(Bt[n][k], At[m][k], acc[ai][bj][m][n], 0, 0, 0); __builtin_amdgcn_s_setprio(0); } while (0)
#define PG8_WAIT_V(n) asm volatile("s_waitcnt vmcnt(" #n ")" ::: "memory")
#define PG8_WAIT_L(n) asm volatile("s_waitcnt lgkmcnt(" #n ")" ::: "memory")
#define PG8_BAR __builtin_amdgcn_s_barrier()
#define PG8_SCHED __builtin_amdgcn_sched_barrier(0)
#define PG8_BBASE(u) ((const char*)g.Bt + (size_t)(u).pn * tstepB + (g.bdiv ? (size_t)((u).pm / g.bdiv) * g.bstride * 2 : (size_t)0))
    Unit cur, nxt; int ui = 0;
    if (!S.next(0, cur)) return;
    f32x4 acc[2][2][4][2];
#pragma unroll
    for (int a = 0; a < 2; ++a)
#pragma unroll
        for (int b = 0; b < 2; ++b)
#pragma unroll
            for (int m = 0; m < 4; ++m)
#pragma unroll
                for (int n = 0; n < 2; ++n) acc[a][b][m][n] = (f32x4){0.f, 0.f, 0.f, 0.f};
    bf16x8 At[4][2], B0[2][2], B1[2][2];
    const char* cA = (const char*)g.A + (size_t)cur.pm * tstepA; const char* cB = PG8_BBASE(cur);
    if constexpr (SP2) {
        PG8_STAGE(PG8_SB(0, 0), cB, voffB); PG8_STAGE(PG8_SB(0, 1), cB + hstepB, voffB); PG8_STAGE(PG8_SA(0, 0), cA, voffA); PG8_STAGE(PG8_SA(0, 1), cA + hstepA, voffA);
        if (wr == 1) PG8_BAR;
        PG8_WAIT_V(2); PG8_BAR;
        PG8_STAGE(PG8_SB(1, 0), cB + kstep, voffB); PG8_STAGE(PG8_SA(1, 0), cA + kstep, voffA); PG8_STAGE(PG8_SB(1, 1), cB + hstepB + kstep, voffB);
        PG8_WAIT_V(6); PG8_BAR;
    } else {
        PG8_STAGE(PG8_SB(0, 0), cB, voffB); PG8_STAGE(PG8_SA(0, 0), cA, voffA); PG8_STAGE(PG8_SB(0, 1), cB + hstepB, voffB); PG8_STAGE(PG8_SA(0, 1), cA + hstepA, voffA);
        if (wr == 1) PG8_BAR;
        PG8_WAIT_V(4); PG8_BAR;
        PG8_STAGE(PG8_SB(1, 0), cB + kstep, voffB); PG8_STAGE(PG8_SA(1, 0), cA + kstep, voffA); PG8_STAGE(PG8_SB(1, 1), cB + hstepB + kstep, voffB);
        PG8_WAIT_V(6); PG8_BAR;
    }
    for (;;) {
        const bool has_next = S.next(ui + 1, nxt);
        const char* nA = has_next ? (const char*)g.A + (size_t)nxt.pm * tstepA : cA; const char* nB = has_next ? PG8_BBASE(nxt) : cB;
        for (int t = 0; t < nt; t += 2) {
            if constexpr (Epi::HOOK_T > 0) { if (t == Epi::HOOK_T) { PG8_SCHED; E.mid(acc, cur, wr, wc, fr, fq); PG8_SCHED; } }
            const bool last = (t == nt - 2);
            const char* a1 = cA + (size_t)(t + 1) * kstep;
            const char* a2 = last ? nA : cA + (size_t)(t + 2) * kstep; const char* b2 = last ? nB : cB + (size_t)(t + 2) * kstep;
            const char* a3 = a2 + kstep; const char* b3 = b2 + kstep;
            if constexpr (SP2) {
            PG8_LDB(B0, 0, 0); PG8_LDB(B1, 0, 1); PG8_SCHED; PG8_LDA(At, 0, 0); PG8_STAGE(PG8_SA(1, 1), a1 + hstepA, voffA);
            PG8_WAIT_V(8); PG8_WAIT_L(0); PG8_BAR; PG8_MMA(0, 0, At, B0); PG8_MMA(0, 1, At, B1); PG8_BAR; PG8_SCHED;
            PG8_LDA(At, 0, 1); PG8_STAGE(PG8_SB(0, 0), b2, voffB); PG8_STAGE(PG8_SB(0, 1), b2 + hstepB, voffB); PG8_STAGE(PG8_SA(0, 0), a2, voffA);
            PG8_WAIT_V(8); PG8_WAIT_L(0); PG8_BAR; PG8_MMA(1, 0, At, B0); PG8_MMA(1, 1, At, B1); PG8_BAR; PG8_SCHED;
            PG8_LDB(B0, 1, 0); PG8_LDB(B1, 1, 1); PG8_SCHED; PG8_LDA(At, 1, 0); PG8_STAGE(PG8_SA(0, 1), a2 + hstepA, voffA);
            PG8_WAIT_V(8); PG8_WAIT_L(0); PG8_BAR; PG8_MMA(0, 0, At, B0); PG8_MMA(0, 1, At, B1); PG8_BAR; PG8_SCHED;
            PG8_LDA(At, 1, 1); PG8_STAGE(PG8_SB(1, 0), b3, voffB); PG8_STAGE(PG8_SB(1, 1), b3 + hstepB, voffB); PG8_STAGE(PG8_SA(1, 0), a3, voffA);
            PG8_WAIT_V(8); PG8_WAIT_L(0); PG8_BAR; PG8_MMA(1, 0, At, B0); PG8_MMA(1, 1, At, B1); PG8_BAR; PG8_SCHED;
            } else {
            PG8_LDB(B0, 0, 0); PG8_SCHED; PG8_LDA(At, 0, 0); PG8_STAGE(PG8_SA(1, 1), a1 + hstepA, voffA);
            PG8_WAIT_L(8); PG8_BAR; PG8_WAIT_L(0); PG8_MMA(0, 0, At, B0); PG8_BAR; PG8_SCHED;
            PG8_LDB(B1, 0, 1); PG8_STAGE(PG8_SB(0, 0), b2, voffB);
            PG8_BAR; PG8_WAIT_L(0); PG8_MMA(0, 1, At, B1); PG8_BAR;
            PG8_LDA(At, 0, 1); PG8_STAGE(PG8_SA(0, 0), a2, voffA);
            PG8_BAR; PG8_WAIT_L(0); PG8_MMA(1, 0, At, B0); PG8_BAR; PG8_SCHED;
            PG8_STAGE(PG8_SB(0, 1), b2 + hstepB, voffB);
            PG8_WAIT_V(6); PG8_BAR; PG8_MMA(1, 1, At, B1); PG8_BAR;
            PG8_LDB(B0, 1, 0); PG8_SCHED; PG8_LDA(At, 1, 0); PG8_STAGE(PG8_SA(0, 1), a2 + hstepA, voffA);
            PG8_WAIT_L(8); PG8_BAR; PG8_WAIT_L(0); PG8_MMA(0, 0, At, B0); PG8_BAR; PG8_SCHED;
            PG8_LDB(B1, 1, 1); PG8_STAGE(PG8_SB(1, 0), b3, voffB);
            PG8_BAR; PG8_WAIT_L(0); PG8_MMA(0, 1, At, B1); PG8_BAR;
            PG8_LDA(At, 1, 1); PG8_STAGE(PG8_SA(1, 0), a3, voffA);
            PG8_BAR; PG8_WAIT_L(0); PG8_MMA(1, 0, At, B0); PG8_BAR; PG8_SCHED;
            PG8_STAGE(PG8_SB(1, 1), b3 + hstepB, voffB);
            PG8_WAIT_V(6); PG8_BAR; PG8_MMA(1, 1, At, B1); PG8_BAR;
            }
        }
        if constexpr (ALIGN_EPI) { if (wr == 0) PG8_BAR; }
        E(acc, cur, wr, wc, fr, fq);
        if (!has_next) break;
#pragma unroll
        for (int a = 0; a < 2; ++a)
#pragma unroll
            for (int b = 0; b < 2; ++b)
#pragma unroll
                for (int m = 0; m < 4; ++m)
#pragma unroll
                    for (int n = 0; n < 2; ++n) acc[a][b][m][n] = (f32x4){0.f, 0.f, 0.f, 0.f};
        cur = nxt; cA = nA; cB = nB; ++ui;
        if constexpr (ALIGN_EPI) { if (wr == 1) PG8_BAR; }
    }
    PG8_WAIT_V(0);
    if constexpr (!ALIGN_EPI) { if (wr == 0) PG8_BAR; }
    PG8_BAR;
#undef PG8_SA
#undef PG8_SB
#undef PG8_STAGE
#undef PG8_LDA
#undef PG8_LDB
#undef PG8_MMA
#undef PG8_WAIT_V
#undef PG8_WAIT_L
#undef PG8_BAR
#undef PG8_SCHED
#undef PG8_BBASE
}
}
namespace pg8 {
__device__ __forceinline__ float sigmoidf_(float x) { return __builtin_amdgcn_rcpf(1.0f + __builtin_amdgcn_exp2f(x * -1.4426950408889634f)); }

struct EpiCols {
    static constexpr bool PERM = true; static constexpr int HOOK_T = 0;
    bf16_t* qkvz; bf16_t* rw; bf16_t* gab; float qscale;
    __device__ __forceinline__ void operator()(const f32x4 (&acc)[2][2][4][2], const Unit& u, int wr, int wc, int fr, int fq) const {
        const int pn = u.pn; bf16_t* base; int pitch, coff, nbj = 2; float sc = 1.f;
        if (pn < 8) { base = qkvz; pitch = 2112; coff = pn * 256; if (pn < 2) sc = qscale; }
        else if (pn < 16) { base = rw; pitch = 2176; coff = (pn - 8) * 256; }
        else if (pn < 24) { base = gab; pitch = 2112; coff = (pn - 16) * 256; }
        else { base = rw; pitch = 2176; coff = 2048; nbj = 1; }
        const int row0 = u.pm * BM + wr * 64 + fr; const int col0 = coff + wc * 32 + 8 * fq;
#pragma unroll
        for (int ai = 0; ai < 2; ++ai)
#pragma unroll
            for (int m = 0; m < 4; ++m) { bf16_t* rowp = base + (size_t)(row0 + ai * HALF + m * 16) * pitch + col0;
#pragma unroll
                for (int bj = 0; bj < 2; ++bj) { if (bj < nbj) { f32x4 v0 = acc[ai][bj][m][0] * sc, v1 = acc[ai][bj][m][1] * sc;
                    u32x4 w; w.x = cvt_pk_bf16(v0[0], v0[1]); w.y = cvt_pk_bf16(v0[2], v0[3]); w.z = cvt_pk_bf16(v1[0], v1[1]); w.w = cvt_pk_bf16(v1[2], v1[3]);
                    *(u32x4*)(rowp + bj * HALF) = w; } } }
    }
};
struct EpiBf16 {
    static constexpr bool PERM = true; static constexpr int HOOK_T = 0;
    bf16_t* O; int ldc;
    __device__ __forceinline__ void operator()(const f32x4 (&acc)[2][2][4][2], const Unit& u, int wr, int wc, int fr, int fq) const {
        const int row0 = u.pm * BM + wr * 64 + fr; const int col0 = u.pn * BM + wc * 32 + 8 * fq;
#pragma unroll
        for (int ai = 0; ai < 2; ++ai)
#pragma unroll
            for (int m = 0; m < 4; ++m) { bf16_t* rowp = O + (size_t)(row0 + ai * HALF + m * 16) * ldc + col0;
#pragma unroll
                for (int bj = 0; bj < 2; ++bj) { const f32x4 v0 = acc[ai][bj][m][0], v1 = acc[ai][bj][m][1];
                    u32x4 w; w.x = cvt_pk_bf16(v0[0], v0[1]); w.y = cvt_pk_bf16(v0[2], v0[3]); w.z = cvt_pk_bf16(v1[0], v1[1]); w.w = cvt_pk_bf16(v1[2], v1[3]);
                    *(u32x4*)(rowp + bj * HALF) = w; } }
    }
};
struct EpiF32 {
    static constexpr bool PERM = false; static constexpr int HOOK_T = 0;
    float* O; int ldc;
    __device__ __forceinline__ void operator()(const f32x4 (&acc)[2][2][4][2], const Unit& u, int wr, int wc, int fr, int fq) const {
        const int row0 = u.pm * BM + wr * 64 + fr; const int col0 = u.pn * BM + wc * 32 + 4 * fq;
#pragma unroll
        for (int ai = 0; ai < 2; ++ai)
#pragma unroll
            for (int m = 0; m < 4; ++m) { float* rowp = O + (size_t)(row0 + ai * HALF + m * 16) * ldc + col0;
#pragma unroll
                for (int bj = 0; bj < 2; ++bj)
#pragma unroll
                    for (int n = 0; n < 2; ++n) *(f32x4*)(rowp + bj * HALF + n * 16) = acc[ai][bj][m][n]; }
    }
};
template <bool ADD> struct EpiMerge {
    static constexpr bool PERM = true; static constexpr int HOOK_T = 0;
    bf16_t* O; int ldc; const bf16_t* G; int ldg;
    __device__ __forceinline__ void operator()(const f32x4 (&acc)[2][2][4][2], const Unit& u, int wr, int wc, int fr, int fq) const {
        const int row0 = u.pm * BM + wr * 64 + fr; const int col0 = u.pn * BM + wc * 32 + 8 * fq;
#pragma unroll
        for (int ai = 0; ai < 2; ++ai)
#pragma unroll
            for (int m = 0; m < 4; ++m) { const size_t r = (size_t)(row0 + ai * HALF + m * 16);
#pragma unroll
                for (int bj = 0; bj < 2; ++bj) { const f32x4 v0 = acc[ai][bj][m][0], v1 = acc[ai][bj][m][1];
                    const u32x4 gw = *(const u32x4*)(G + r * ldg + col0 + bj * HALF);
                    float o[8];
                    o[0] = sigmoidf_(bf_lo(gw.x)) * v0[0]; o[1] = sigmoidf_(bf_hi(gw.x)) * v0[1]; o[2] = sigmoidf_(bf_lo(gw.y)) * v0[2]; o[3] = sigmoidf_(bf_hi(gw.y)) * v0[3];
                    o[4] = sigmoidf_(bf_lo(gw.z)) * v1[0]; o[5] = sigmoidf_(bf_hi(gw.z)) * v1[1]; o[6] = sigmoidf_(bf_lo(gw.w)) * v1[2]; o[7] = sigmoidf_(bf_hi(gw.w)) * v1[3];
                    bf16_t* op = O + r * ldc + col0 + bj * HALF;
                    if (ADD) { const u32x4 pw = *(const u32x4*)op;
                        o[0] += bf_lo(pw.x); o[1] += bf_hi(pw.x); o[2] += bf_lo(pw.y); o[3] += bf_hi(pw.y); o[4] += bf_lo(pw.z); o[5] += bf_hi(pw.z); o[6] += bf_lo(pw.w); o[7] += bf_hi(pw.w); }
                    u32x4 w; w.x = cvt_pk_bf16(o[0], o[1]); w.y = cvt_pk_bf16(o[2], o[3]); w.z = cvt_pk_bf16(o[4], o[5]); w.w = cvt_pk_bf16(o[6], o[7]);
                    *(u32x4*)op = w; } }
    }
};
struct EpiMergeFused {
    static constexpr bool PERM = true; static constexpr int HOOK_T = 8;
    bf16_t* O; int ldc; const bf16_t* G; int ldg;
    __device__ __forceinline__ void mid(f32x4 (&acc)[2][2][4][2], const Unit& u, int wr, int wc, int fr, int fq) const {
        asm volatile("" : "+v"(fr), "+v"(fq));
        const int row0 = u.pm * BM + wr * 64 + fr; const int col0 = u.pn * BM + wc * 32 + 8 * fq;
#pragma unroll
        for (int ai = 0; ai < 2; ++ai)
#pragma unroll
            for (int m = 0; m < 4; ++m) { const size_t r = (size_t)(row0 + ai * HALF + m * 16);
#pragma unroll
                for (int bj = 0; bj < 2; ++bj) { const u32x4 ga = *(const u32x4*)(G + r * ldg + col0 + bj * HALF), gb = *(const u32x4*)(G + r * ldg + 1024 + col0 + bj * HALF);
#define MQ_(wa, wb, HI) ((1.0f + __builtin_amdgcn_exp2f(fmaxf(HI ? bf_hi(wb) : bf_lo(wb), -80.f) * -1.4426950408889634f)) * __builtin_amdgcn_rcpf(1.0f + __builtin_amdgcn_exp2f((HI ? bf_hi(wa) : bf_lo(wa)) * -1.4426950408889634f)))
                    acc[ai][bj][m][0][0] *= MQ_(ga.x, gb.x, 0); acc[ai][bj][m][0][1] *= MQ_(ga.x, gb.x, 1); acc[ai][bj][m][0][2] *= MQ_(ga.y, gb.y, 0); acc[ai][bj][m][0][3] *= MQ_(ga.y, gb.y, 1);
                    acc[ai][bj][m][1][0] *= MQ_(ga.z, gb.z, 0); acc[ai][bj][m][1][1] *= MQ_(ga.z, gb.z, 1); acc[ai][bj][m][1][2] *= MQ_(ga.w, gb.w, 0); acc[ai][bj][m][1][3] *= MQ_(ga.w, gb.w, 1);
#undef MQ_
                    __builtin_amdgcn_sched_barrier(0); }
                }
    }
    __device__ __forceinline__ void operator()(const f32x4 (&acc)[2][2][4][2], const Unit& u, int wr, int wc, int fr, int fq) const {
        asm volatile("" : "+v"(fr), "+v"(fq));
        const int row0 = u.pm * BM + wr * 64 + fr; const int col0 = u.pn * BM + wc * 32 + 8 * fq;
#pragma unroll
        for (int ai = 0; ai < 2; ++ai)
#pragma unroll
            for (int m = 0; m < 4; ++m) { const size_t r = (size_t)(row0 + ai * HALF + m * 16);
#pragma unroll
                for (int bj = 0; bj < 2; ++bj) { const f32x4 v0 = acc[ai][bj][m][0], v1 = acc[ai][bj][m][1];
                    const u32x4 gw = *(const u32x4*)(G + r * ldg + 1024 + col0 + bj * HALF);
                    u32x4 w; w.x = cvt_pk_bf16(sigmoidf_(fmaxf(bf_lo(gw.x), -80.f)) * v0[0], sigmoidf_(fmaxf(bf_hi(gw.x), -80.f)) * v0[1]); w.y = cvt_pk_bf16(sigmoidf_(fmaxf(bf_lo(gw.y), -80.f)) * v0[2], sigmoidf_(fmaxf(bf_hi(gw.y), -80.f)) * v0[3]);
                    w.z = cvt_pk_bf16(sigmoidf_(fmaxf(bf_lo(gw.z), -80.f)) * v1[0], sigmoidf_(fmaxf(bf_hi(gw.z), -80.f)) * v1[1]); w.w = cvt_pk_bf16(sigmoidf_(fmaxf(bf_lo(gw.w), -80.f)) * v1[2], sigmoidf_(fmaxf(bf_hi(gw.w), -80.f)) * v1[3]);
                    *(u32x4*)(O + r * ldc + col0 + bj * HALF) = w; } }
    }
};
struct EpiFinal {
    static constexpr bool PERM = false; static constexpr int HOOK_T = 0;
    float* out; const float* x; const bf16_t* y; const float* rsy; const float* gpost; const bf16_t* E; int ldc;
    __device__ __forceinline__ void operator()(const f32x4 (&acc)[2][2][4][2], const Unit& u, int wr, int wc, int fr, int fq) const {
        const int row0 = u.pm * BM + wr * 64 + fr; const int col0 = u.pn * BM + wc * 32 + 4 * fq;
#pragma unroll
        for (int ai = 0; ai < 2; ++ai)
#pragma unroll
            for (int m = 0; m < 4; ++m) { const size_t r = (size_t)(row0 + ai * HALF + m * 16); const float rs = rsy[r];
#pragma unroll
                for (int bj = 0; bj < 2; ++bj)
#pragma unroll
                    for (int n = 0; n < 2; ++n) { const int c = col0 + bj * HALF + n * 16; const size_t off = r * ldc + c;
                        const f32x4 xv = *(const f32x4*)(x + off), gp = *(const f32x4*)(gpost + c); const u32x2 ew = *(const u32x2*)(E + off), yw = *(const u32x2*)(y + off); const f32x4 yv = {bf_lo(yw.x), bf_hi(yw.x), bf_lo(yw.y), bf_hi(yw.y)};
                        const f32x4 a = acc[ai][bj][m][n]; f32x4 o;
                        o[0] = xv[0] + yv[0] * rs * gp[0] + sigmoidf_(a[0]) * bf_lo(ew.x);
                        o[1] = xv[1] + yv[1] * rs * gp[1] + sigmoidf_(a[1]) * bf_hi(ew.x);
                        o[2] = xv[2] + yv[2] * rs * gp[2] + sigmoidf_(a[2]) * bf_lo(ew.y);
                        o[3] = xv[3] + yv[3] * rs * gp[3] + sigmoidf_(a[3]) * bf_hi(ew.y);
                        *(f32x4*)(out + off) = o; } }
    }
};
}
#define GAS __attribute__((address_space(1)))
#define LAS __attribute__((address_space(3)))
typedef unsigned short bf16;
typedef unsigned v4u __attribute__((ext_vector_type(4)));
typedef unsigned v2u __attribute__((ext_vector_type(2)));
typedef float f32x4 __attribute__((ext_vector_type(4)));

constexpr int NWAVES = 8, NTHR = 512;
constexpr int BATCH = 16, SEQ = 4096, DM = 1024, M = BATCH * SEQ;
constexpr int NH = 8, HD = 64, AW = 512, PLE = 256;
constexpr int RWC = 2176, INC = 6272, INCP = 6400;
constexpr int NBLK = 16, BLK = 256;
constexpr float RMS_EPS = 1e-6f, GN_EPS = 64e-5f;
constexpr float LOG2E = 1.4426950408889634f;
constexpr float QSCALE = 0.125f * LOG2E;

constexpr size_t MiB = 1u << 20;
constexpr size_t WS_WIN = 2 * MiB;
constexpr size_t WS_WG = 16 * MiB;
constexpr size_t WS_PAB = 32 * MiB;
constexpr size_t WS_WOUT = 34 * MiB;
constexpr size_t WS_WPG = 36 * MiB;
constexpr size_t WS_WPU = 38 * MiB;
constexpr size_t WS_RSY = 39 * MiB;
constexpr size_t WS_PB = 42 * MiB;
constexpr size_t WS_GATE = 74 * MiB;
constexpr int QP = 2112, GP = 2112;
constexpr size_t WS_QKVZ = 138 * MiB;
constexpr size_t WS_RW = 402 * MiB;
constexpr size_t WS_GAB = 674 * MiB;
constexpr size_t WS_END = 1004 * MiB;
constexpr size_t WS_CNT = 0;
constexpr size_t WS_QCTR = 16384;
constexpr size_t WS_WUPT = 39 * MiB + 512 * 1024, WS_AUPT = WS_WUPT + 65536;
constexpr size_t WS_BON = 938 * MiB;
constexpr size_t WS_SC = 940 * MiB;
constexpr size_t DO_PARTO = 0, DO_PARTML = 192 * MiB, DO_LISTS = 208 * MiB;

__device__ const unsigned char T5B[128] = {0, 1, 2, 3, 4, 5, 6, 7, 8, 9, 10, 11, 12, 13, 14, 15, 16, 16, 16, 17, 17, 18, 18, 18, 19, 19, 19, 20, 20, 20, 20, 21, 21, 21, 21, 22, 22, 22, 22, 22, 23, 23, 23, 23, 23, 23, 24, 24, 24, 24, 24, 24, 25, 25, 25, 25, 25, 25, 25, 26, 26, 26, 26, 26, 26, 26, 26, 27, 27, 27, 27, 27, 27, 27, 27, 27, 27, 28, 28, 28, 28, 28, 28, 28, 28, 28, 28, 29, 29, 29, 29, 29, 29, 29, 29, 29, 29, 29, 29, 30, 30, 30, 30, 30, 30, 30, 30, 30, 30, 30, 30, 30, 30, 31, 31, 31, 31, 31, 31, 31, 31, 31, 31, 31, 31, 31, 31, 31};

__device__ __forceinline__ unsigned f2bf(float f) { unsigned u = __builtin_bit_cast(unsigned, f); return (u + 0x7fffu + ((u >> 16) & 1u)) >> 16; }
__device__ __forceinline__ unsigned pk2(float lo, float hi) { return f2bf(lo) | (f2bf(hi) << 16); }
__device__ __forceinline__ float bf2f(unsigned short h) { return __uint_as_float((unsigned)h << 16); }
__device__ __forceinline__ float wave_sum(float v) {
#pragma unroll
    for (int o = 1; o < 64; o <<= 1) v += __shfl_xor(v, o);
    return v;
}
__device__ __forceinline__ float fexp2(float x) { return __builtin_amdgcn_exp2f(x); }
__device__ __forceinline__ float fexp(float x) { return __builtin_amdgcn_exp2f(x * LOG2E); }
__device__ __forceinline__ float frcp(float x) { return __builtin_amdgcn_rcpf(x); }
__device__ __forceinline__ float frsq(float x) { return __builtin_amdgcn_rsqf(x); }
__device__ __forceinline__ float sigm(float x) { return frcp(1.0f + fexp2(-x * LOG2E)); }
__device__ __forceinline__ float ftanh(float x) { return 1.0f - 2.0f * frcp(1.0f + fexp2(x * (2.0f * LOG2E))); }
__device__ __forceinline__ float dpp_sum32(float v) {
#define DPP_ADD_(ctrl, rmask) v += __builtin_bit_cast(float, __builtin_amdgcn_update_dpp(0, __builtin_bit_cast(int, v), ctrl, rmask, 0xf, true))
    DPP_ADD_(0x118, 0xf); DPP_ADD_(0x114, 0xf); DPP_ADD_(0x112, 0xf); DPP_ADD_(0x111, 0xf);
    v += __builtin_bit_cast(float, __builtin_amdgcn_update_dpp(0, __builtin_bit_cast(int, v), 0x142, 0xa, 0xf, false));
#undef DPP_ADD_
    return v;
}

struct Args {
    const float* in[21]; float* out; unsigned char* ws; int ph_lo, ph_hi;
};
struct Frame {
    LAS unsigned char* lds; int tid, lane, wave, vcu, G;
    const float *x, *p, *g_pre, *w_in, *rel_bias, *mu, *w0, *w_up, *a0, *a_up, *k_k, *k_a, *r_k, *ln_w, *ln_b, *p_a, *p_b, *w_out, *g_post, *w_pu, *w_pg;
    float* out; unsigned char* ws;
};

__device__ __forceinline__ float wave_sum_fast(float v) { v = dpp_sum32(v); return __builtin_bit_cast(float, __builtin_amdgcn_readlane(__builtin_bit_cast(int, v), 31)) + __builtin_bit_cast(float, __builtin_amdgcn_readlane(__builtin_bit_cast(int, v), 63)); }
__device__ __forceinline__ void transpose_item(const float* W, int N, int k0, int n0, bf16* WT, int ldw, int drow0, int koff, LAS float* scr, int lane) {
#pragma unroll 8
    for (int i = 0; i < 32; ++i) { const int kk = 2 * i + (lane >> 5); scr[kk * 33 + (lane & 31)] = W[(size_t)(k0 + kk) * N + n0 + (lane & 31)]; }
    asm volatile("s_waitcnt lgkmcnt(0)" ::: "memory");
    const int c = lane & 7;
#pragma unroll
    for (int j = 0; j < 4; ++j) { const int n = (lane >> 3) + 8 * j; const LAS float* s = scr + (8 * c) * 33 + n;
        v4u o; o.x = pk2(s[0 * 33], s[1 * 33]); o.y = pk2(s[2 * 33], s[3 * 33]); o.z = pk2(s[4 * 33], s[5 * 33]); o.w = pk2(s[6 * 33], s[7 * 33]);
        *(v4u*)(WT + (size_t)(drow0 + n) * ldw + koff + k0 + 8 * c) = o; }
    asm volatile("s_waitcnt lgkmcnt(0)" ::: "memory");
}

__device__ __forceinline__ void p0_prologue(Frame& F) {
    if (blockIdx.x == 0) { for (int i = F.tid; i < 2048; i += NTHR) ((unsigned*)(F.ws + WS_CNT))[i] = 0u; if (F.tid == 0) *(unsigned*)(F.ws + WS_QCTR) = 0u; }
    LAS float* scr = (LAS float*)(F.lds + F.wave * 16384);
    const int gw = F.vcu * NWAVES + F.wave, NGW = F.G * NWAVES;
    bf16* WinT = (bf16*)(F.ws + WS_WIN); bf16* PabT = (bf16*)(F.ws + WS_PAB); bf16* WoutT = (bf16*)(F.ws + WS_WOUT); bf16* WpgT = (bf16*)(F.ws + WS_WPG); bf16* WpuT = (bf16*)(F.ws + WS_WPU);
    constexpr int I_IN = 16 * (INC / 32), I_PA = 8 * 32, I_PB = 8 * 32, I_WO = 16 * 32, I_PG = 16 * 32, I_PU = 4 * 32, I_UP = 16;
    constexpr int NIT = I_IN + I_PA + I_PB + I_WO + I_PG + I_PU + 2 * I_UP;
    for (int it = gw; it < NIT; it += NGW) {
        int r = it;
        if (r < I_IN) { const int nb = r % (INC / 32), kb = r / (INC / 32), n0 = nb * 32;
            const int d0 = n0 < 4096 ? n0 : (n0 < 4224 ? n0 + 2048 : n0 - 128);
            transpose_item(F.w_in, INC, kb * 64, n0, WinT, DM, d0, 0, scr, F.lane); continue; } r -= I_IN;
        if (r < I_PA) { transpose_item(F.p_a, DM, (r / 32) * 64, (r % 32) * 32, PabT, 1024, (r % 32) * 32, 0, scr, F.lane); continue; } r -= I_PA;
        if (r < I_PB) { transpose_item(F.p_b, DM, (r / 32) * 64, (r % 32) * 32, PabT, 1024, (r % 32) * 32, 512, scr, F.lane); continue; } r -= I_PB;
        if (r < I_WO) { transpose_item(F.w_out, DM, (r / 32) * 64, (r % 32) * 32, WoutT, 1024, (r % 32) * 32, 0, scr, F.lane); continue; } r -= I_WO;
        if (r < I_PG) { transpose_item(F.w_pg, DM, (r / 32) * 64, (r % 32) * 32, WpgT, 1024, (r % 32) * 32, 0, scr, F.lane); continue; } r -= I_PG;
        if (r < I_PU) { transpose_item(F.w_pu, DM, (r / 32) * 64, (r % 32) * 32, WpuT, 256, (r % 32) * 32, 0, scr, F.lane); continue; } r -= I_PU;
        if (r < I_UP) { transpose_item(F.w_up, AW, 0, r * 32, (bf16*)(F.ws + WS_WUPT), 64, r * 32, 0, scr, F.lane); continue; } r -= I_UP;
        transpose_item(F.a_up, AW, 0, r * 32, (bf16*)(F.ws + WS_AUPT), 64, r * 32, 0, scr, F.lane);
    }
    for (int i = gw * 64 + F.lane; i < 128 * 1024 / 8; i += NGW * 64) *(v4u*)(WinT + (size_t)INC * DM + (size_t)i * 8) = (v4u){0u, 0u, 0u, 0u};
    { bf16* PB = (bf16*)(F.ws + WS_PB); const size_t n8 = (size_t)M * PLE / 8;
      for (size_t i = (size_t)F.vcu * NTHR + F.tid; i < n8; i += (size_t)F.G * NTHR) { const f32x4 a = *(const f32x4*)(F.p + i * 8), b = *(const f32x4*)(F.p + i * 8 + 4);
          v4u o; o.x = pk2(a[0], a[1]); o.y = pk2(a[2], a[3]); o.z = pk2(b[0], b[1]); o.w = pk2(b[2], b[3]); *(v4u*)(PB + i * 8) = o; } }
    __syncthreads();
    LAS float* red = (LAS float*)F.lds;
    LAS float* ubar = (LAS float*)(F.lds + 32768);
    LAS float* kmean = (LAS float*)(F.lds + 36864);
    bf16* U2 = (bf16*)F.out; bf16* WgT = (bf16*)(F.ws + WS_WG);
    for (int blk = F.vcu; blk < M / BLK; blk += F.G) {
        float cs[16];
#pragma unroll
        for (int i = 0; i < 16; ++i) cs[i] = 0.f;
        f32x4 gv[4];
#pragma unroll
        for (int j = 0; j < 4; ++j) gv[j] = *((const f32x4*)F.g_pre + F.lane + 64 * j);
        for (int i = 0; i < 8; ++i) {
            f32x4 v[4][4];
#pragma unroll
            for (int r = 0; r < 4; ++r) { const f32x4* xr = (const f32x4*)(F.x + ((size_t)blk * BLK + F.wave + 8 * (4 * i + r)) * DM) + F.lane;
#pragma unroll
                for (int j = 0; j < 4; ++j) v[r][j] = xr[64 * j]; }
#pragma unroll
            for (int r = 0; r < 4; ++r) { const size_t row = (size_t)blk * BLK + F.wave + 8 * (4 * i + r); float s = 0.f;
#pragma unroll
                for (int j = 0; j < 4; ++j) s += (v[r][j][0] * v[r][j][0] + v[r][j][1] * v[r][j][1]) + (v[r][j][2] * v[r][j][2] + v[r][j][3] * v[r][j][3]);
                const float rs = frsq(wave_sum_fast(s) * (1.f / DM) + RMS_EPS);
#pragma unroll
                for (int j = 0; j < 4; ++j) {
                    float u[4]; unsigned h[4], l[4];
#pragma unroll
                    for (int e = 0; e < 4; ++e) { u[e] = v[r][j][e] * rs * gv[j][e]; cs[j * 4 + e] += u[e]; h[e] = f2bf(u[e]); l[e] = f2bf(u[e] - __uint_as_float(h[e] << 16)); }
                    const int col = 4 * F.lane + 256 * j;
                    *(v2u*)(U2 + row * 2048 + col) = (v2u){h[0] | (h[1] << 16), h[2] | (h[3] << 16)};
                    *(v2u*)(U2 + row * 2048 + 1024 + col) = (v2u){l[0] | (l[1] << 16), l[2] | (l[3] << 16)};
                } }
        }
#pragma unroll
        for (int j = 0; j < 4; ++j)
#pragma unroll
            for (int e = 0; e < 4; ++e) red[F.wave * 1024 + 4 * F.lane + 256 * j + e] = cs[j * 4 + e];
        __syncthreads();
        for (int k = F.tid; k < 1024; k += NTHR) { float s = 0.f;
#pragma unroll
            for (int w = 0; w < 8; ++w) s += red[w * 1024 + k];
            ubar[k] = s * (1.f / BLK); }
        __syncthreads();
        {
          float a0 = 0.f, a1 = 0.f, a2 = 0.f, a3 = 0.f; const float* wk = F.w_in + 512 + F.tid;
#pragma unroll 1
          for (int k0 = 0; k0 < 1024; k0 += 16) { float w[16];
#pragma unroll
              for (int i = 0; i < 16; ++i) w[i] = wk[(size_t)(k0 + i) * INC];
#pragma unroll
              for (int i = 0; i < 16; i += 4) { a0 += ubar[k0 + i] * w[i]; a1 += ubar[k0 + i + 1] * w[i + 1]; a2 += ubar[k0 + i + 2] * w[i + 2]; a3 += ubar[k0 + i + 3] * w[i + 3]; } }
          kmean[F.tid] = (a0 + a1) + (a2 + a3); }
        __syncthreads();
        {
          const int b = blk / NBLK, n = blk % NBLK; const int l8 = F.lane * 8;
          float km[8];
#pragma unroll
          for (int e = 0; e < 8; ++e) km[e] = kmean[l8 + e];
#pragma unroll 1
          for (int k0 = F.wave * 4; k0 < 1024; k0 += NWAVES * 4) { f32x4 w[4][2];
#pragma unroll
              for (int r = 0; r < 4; ++r) { const f32x4* wq = (const f32x4*)(F.w_in + (size_t)(k0 + r) * INC + l8); w[r][0] = wq[0]; w[r][1] = wq[1]; }
#pragma unroll
              for (int r = 0; r < 4; ++r) { float s = (w[r][0][0] * km[0] + w[r][0][1] * km[1]) + (w[r][0][2] * km[2] + w[r][0][3] * km[3]) + (w[r][1][0] * km[4] + w[r][1][1] * km[5]) + (w[r][1][2] * km[6] + w[r][1][3] * km[7]);
                  s += __builtin_bit_cast(float, __builtin_amdgcn_update_dpp(0, __builtin_bit_cast(int, s), 0x111, 0xf, 0xf, true));
                  s += __builtin_bit_cast(float, __builtin_amdgcn_update_dpp(0, __builtin_bit_cast(int, s), 0x112, 0xf, 0xf, true));
                  s += __builtin_bit_cast(float, __builtin_amdgcn_update_dpp(0, __builtin_bit_cast(int, s), 0x114, 0xf, 0xf, true));
                  if ((F.lane & 7) == 7) { const int h = F.lane >> 3, k = k0 + r; const unsigned hi = f2bf(s), lo = f2bf(s - __uint_as_float(hi << 16));
                      bf16* r0 = WgT + ((size_t)b * 256 + h * 16 + n) * 2048; bf16* r1 = WgT + ((size_t)b * 256 + 128 + h * 16 + n) * 2048;
                      r0[k] = (bf16)hi; r0[1024 + k] = (bf16)hi; r1[k] = (bf16)lo; r1[1024 + k] = (bf16)lo; } } } }
        __syncthreads();
    }
}

__device__ __forceinline__ void post_norm(Frame& F) {
    const bf16* Y = (const bf16*)(F.ws + WS_RW); float* RSY = (float*)(F.ws + WS_RSY); bf16* H1 = (bf16*)(F.ws + WS_QKVZ);
    const int gw = F.vcu * NWAVES + F.wave, NGW = F.G * NWAVES;
    f32x4 gv[4];
#pragma unroll
    for (int j = 0; j < 4; ++j) gv[j] = *((const f32x4*)F.g_post + F.lane + 64 * j);
    for (int row0 = gw * 4; row0 < M; row0 += NGW * 4) {
        v2u yw[4][4]; f32x4 xv[4][4];
#pragma unroll
        for (int r = 0; r < 4; ++r) { const v2u* yr = (const v2u*)(Y + (size_t)(row0 + r) * DM) + F.lane; const f32x4* xr = (const f32x4*)(F.x + (size_t)(row0 + r) * DM) + F.lane;
#pragma unroll
            for (int j = 0; j < 4; ++j) { yw[r][j] = yr[64 * j]; xv[r][j] = xr[64 * j]; } }
#pragma unroll
        for (int r = 0; r < 4; ++r) { f32x4 v[4]; float s = 0.f;
#pragma unroll
            for (int j = 0; j < 4; ++j) { const v2u w = yw[r][j]; v[j] = (f32x4){__uint_as_float(w.x << 16), __uint_as_float(w.x & 0xffff0000u), __uint_as_float(w.y << 16), __uint_as_float(w.y & 0xffff0000u)}; s += (v[j][0] * v[j][0] + v[j][1] * v[j][1]) + (v[j][2] * v[j][2] + v[j][3] * v[j][3]); }
            const float rs = frsq(wave_sum_fast(s) * (1.f / DM) + RMS_EPS);
            if (F.lane == 0) RSY[row0 + r] = rs;
#pragma unroll
            for (int j = 0; j < 4; ++j) { float h[4];
#pragma unroll
                for (int e = 0; e < 4; ++e) h[e] = xv[r][j][e] + v[j][e] * rs * gv[j][e];
                *(v2u*)(H1 + (size_t)(row0 + r) * DM + 4 * F.lane + 256 * j) = (v2u){pk2(h[0], h[1]), pk2(h[2], h[3])}; } }
    }
}
namespace moba {
using bf16x8 = __attribute__((ext_vector_type(8))) short;
using s16x4 = __attribute__((ext_vector_type(4))) short;
using f32x16 = __attribute__((ext_vector_type(16))) float;
using u32x4 = __attribute__((ext_vector_type(4))) unsigned;
typedef short v4i16_t __attribute__((ext_vector_type(4)));
typedef float f32x2_t __attribute__((ext_vector_type(2))); typedef __bf16 bf16x2_t __attribute__((ext_vector_type(2)));
__device__ __forceinline__ int crow(int r, int hi) { return (r & 3) + 8 * (r >> 2) + 4 * hi; }
__device__ __forceinline__ unsigned cvtpk(float lo, float hi) { f32x2_t v = {lo, hi}; bf16x2_t b = __builtin_convertvector(v, bf16x2_t); return __builtin_bit_cast(unsigned, b); }
__device__ __forceinline__ float max3f(float a, float b, float c) { return fmaxf(fmaxf(a, b), c); }

constexpr int SLOTB = 8192;
__device__ __forceinline__ void qkt(f32x16& p0, f32x16& p1, const LAS unsigned char* Kslot, const bf16x8* qr, int r32, int hi) {
    const LAS unsigned char* kb = Kslot + hi * 1024 + r32 * 16;
    const f32x16 z = {};
#pragma unroll
    for (int d0 = 0; d0 < 4; ++d0) {
        const bf16x8 b0 = *(const LAS bf16x8*)(kb + d0 * 2048);
        const bf16x8 b1 = *(const LAS bf16x8*)(kb + d0 * 2048 + 512);
        if (d0 == 0) { p0 = __builtin_amdgcn_mfma_f32_32x32x16_bf16(b0, qr[0], z, 0, 0, 0); p1 = __builtin_amdgcn_mfma_f32_32x32x16_bf16(b1, qr[0], z, 0, 0, 0); }
        else { p0 = __builtin_amdgcn_mfma_f32_32x32x16_bf16(b0, qr[d0], p0, 0, 0, 0); p1 = __builtin_amdgcn_mfma_f32_32x32x16_bf16(b1, qr[d0], p1, 0, 0, 0); } }
}
__device__ __forceinline__ void qkt_acc(f32x16& p0, f32x16& p1, const LAS unsigned char* Kslot, const bf16x8* qr, int r32, int hi) {
    const LAS unsigned char* kb = Kslot + hi * 1024 + r32 * 16;
#pragma unroll
    for (int d0 = 0; d0 < 4; ++d0) {
        const bf16x8 b0 = *(const LAS bf16x8*)(kb + d0 * 2048);
        const bf16x8 b1 = *(const LAS bf16x8*)(kb + d0 * 2048 + 512);
        p0 = __builtin_amdgcn_mfma_f32_32x32x16_bf16(b0, qr[d0], p0, 0, 0, 0); p1 = __builtin_amdgcn_mfma_f32_32x32x16_bf16(b1, qr[d0], p1, 0, 0, 0); }
}
__device__ __forceinline__ void pv(f32x16* o, int vb, bf16x8 pa0, bf16x8 pa1, bf16x8 pa2, bf16x8 pa3) {
#pragma unroll
    for (int d0 = 0; d0 < 2; ++d0) { s16x4 lo[4], hi[4];
#pragma unroll
        for (int ks = 0; ks < 4; ++ks) {
            asm volatile("ds_read_b64_tr_b16 %0,%1 offset:%c2" : "=&v"(lo[ks]) : "v"(vb), "i"(d0 * 4096 + ks * 1024) : "memory");
            asm volatile("ds_read_b64_tr_b16 %0,%1 offset:%c2" : "=&v"(hi[ks]) : "v"(vb), "i"(d0 * 4096 + ks * 1024 + 512) : "memory"); }
        asm volatile("s_waitcnt lgkmcnt(0)" ::: "memory"); __builtin_amdgcn_sched_barrier(0);
#define PK(k) (bf16x8){lo[k][0], lo[k][1], lo[k][2], lo[k][3], hi[k][0], hi[k][1], hi[k][2], hi[k][3]}
        o[d0] = __builtin_amdgcn_mfma_f32_32x32x16_bf16(pa0, PK(0), o[d0], 0, 0, 0);
        o[d0] = __builtin_amdgcn_mfma_f32_32x32x16_bf16(pa1, PK(1), o[d0], 0, 0, 0);
        o[d0] = __builtin_amdgcn_mfma_f32_32x32x16_bf16(pa2, PK(2), o[d0], 0, 0, 0);
        o[d0] = __builtin_amdgcn_mfma_f32_32x32x16_bf16(pa3, PK(3), o[d0], 0, 0, 0);
#undef PK
    }
}
__device__ __forceinline__ float rowmax2(const f32x16& p0, const f32x16& p1, float a) {
#pragma unroll
    for (int r = 0; r < 16; r += 2) { a = max3f(a, p0[r], p0[r + 1]); a = max3f(a, p1[r], p1[r + 1]); }
    return a;
}
__device__ __forceinline__ float swapmax(float m) { auto rr = __builtin_amdgcn_permlane32_swap(__float_as_uint(m), __float_as_uint(m), false, false); return fmaxf(__uint_as_float(rr[0]), __uint_as_float(rr[1])); }
__device__ __forceinline__ float swapsum(float m) { auto rr = __builtin_amdgcn_permlane32_swap(__float_as_uint(m), __float_as_uint(m), false, false); return __uint_as_float(rr[0]) + __uint_as_float(rr[1]); }

__device__ __forceinline__ void load_kv_block(LAS unsigned char* lds, int KOFF, int VOFF, const bf16* QKVZ, size_t krow0, int h, int wid, int lane) {
    const bf16* ksrc = QKVZ + (krow0 + lane) * QP + 512 + h * HD + wid * 8;
    const bf16* vsrc = QKVZ + (krow0 + 16 * (wid & 3) + (lane >> 2)) * QP + 1024 + h * HD + (wid >> 2) * 32 + (lane & 3) * 8;
#pragma unroll
    for (int t = 0; t < 4; ++t) {
        __builtin_amdgcn_global_load_lds((const unsigned*)(ksrc + (size_t)t * 64 * QP), (LAS unsigned*)(lds + KOFF + t * SLOTB + wid * 1024), 16, 0, 0);
        __builtin_amdgcn_global_load_lds((const unsigned*)(vsrc + (size_t)t * 64 * QP), (LAS unsigned*)(lds + VOFF + t * SLOTB + wid * 1024), 16, 0, 0); }
}
}

constexpr int LIST_CAP = 3840;

__device__ __forceinline__ void attn_select(Frame& F, const float* GATE, unsigned* CNT, unsigned short* LISTS) {
    const int gw = F.vcu * NWAVES + F.wave, NGW = F.G * NWAVES;
    for (int it = gw; it < BATCH * NH * (SEQ / 64); it += NGW) {
        const int sg = it % (SEQ / 64), h = (it / (SEQ / 64)) % NH, b = it / (SEQ / 64 * NH);
        const int s = sg * 64 + F.lane, qb = s >> 8; const size_t row = (size_t)b * SEQ + s;
        if (qb == 0) continue;
        float g0 = -INFINITY, g1 = -INFINITY, g2 = -INFINITY; int i0 = -1, i1 = -1, i2 = -1;
        const f32x4* gp = (const f32x4*)(GATE + row * 256 + h * 16); const f32x4* gl = (const f32x4*)(GATE + row * 256 + 128 + h * 16);
#pragma unroll
        for (int c = 0; c < 4; ++c) { const f32x4 a = gp[c], l = gl[c];
#pragma unroll
            for (int e = 0; e < 4; ++e) { const int n = c * 4 + e; const float g = (n < qb) ? a[e] + l[e] : -INFINITY;
                if (g > g0) { g2 = g1; i2 = i1; g1 = g0; i1 = i0; g0 = g; i0 = n; } else if (g > g1) { g2 = g1; i2 = i1; g1 = g; i1 = n; } else if (g > g2) { g2 = g; i2 = n; } } }
        unsigned* cnt = CNT + (b * NH + h) * 16; unsigned short* lst = LISTS + (size_t)(b * NH + h) * 16 * LIST_CAP;
        int r0 = 0, r1 = 0, r2 = 0; unsigned mycnt = 0u;
        for (int n = 0; n < qb; ++n) {
            const bool pick = (i0 == n) | (i1 == n) | (i2 == n);
            const unsigned long long mask = __ballot(pick);
            const int before = __builtin_amdgcn_mbcnt_hi((unsigned)(mask >> 32), __builtin_amdgcn_mbcnt_lo((unsigned)mask, 0u));
            if (i0 == n) r0 = before; if (i1 == n) r1 = before; if (i2 == n) r2 = before;
            if (F.lane == n) mycnt = (unsigned)__popcll(mask);
        }
        unsigned base = 0u;
        if (F.lane < qb && mycnt) base = atomicAdd(cnt + F.lane, mycnt);
        const unsigned b0 = __shfl(base, i0 < 0 ? 0 : i0), b1 = __shfl(base, i1 < 0 ? 0 : i1), b2 = __shfl(base, i2 < 0 ? 0 : i2);
        if (i0 >= 0) lst[(size_t)i0 * LIST_CAP + b0 + r0] = (unsigned short)(s | (0 << 12));
        if (i1 >= 0) lst[(size_t)i1 * LIST_CAP + b1 + r1] = (unsigned short)(s | (1 << 12));
        if (i2 >= 0) lst[(size_t)i2 * LIST_CAP + b2 + r2] = (unsigned short)(s | (2 << 12));
    }
}

__device__ __forceinline__ void attn_partial(Frame& F, const bf16* QKVZ, const unsigned* CNT, const unsigned short* LISTS, bf16* PART_O, float* PART_ML, unsigned* QCTR) {
    using namespace moba;
    LAS unsigned char* lds = F.lds; const int wid = F.wave, lane = F.lane, r32 = lane & 31, hi = lane >> 5;
    LAS float* btab = (LAS float*)(lds + 102400); LAS unsigned* uword = (LAS unsigned*)(lds + 106496); LAS unsigned short* llist = (LAS unsigned short*)(lds + 106624);
    LAS float* wsf = (LAS float*)(lds + 98304) + wid * 128; LAS bf16* stg = (LAS bf16*)(lds + 65536) + wid * 2048;
    for (int i = F.tid; i < NH * 128; i += NTHR) { const int h = i >> 7, d = i & 127; btab[i] = (F.rel_bias[T5B[d] * NH + h] - F.rel_bias[31 * NH + h]) * LOG2E; }
    const int vb0 = (int)(uintptr_t)(lds + 32768) + ((lane >> 4) & 1) * 32 + (lane & 3) * 8 + (4 * hi + ((lane & 15) >> 2)) * 64;
    const int NUNIT = BATCH * NH * 15;
    for (;;) {
        __syncthreads();
        if (F.tid == 0) uword[0] = atomicAdd(QCTR, 1u);
        __syncthreads();
        const int u = (int)uword[0];
        if (u >= NUNIT) break;
        const int n = u / (BATCH * NH), bh = u % (BATCH * NH), b = bh / NH, h = bh % NH;
        load_kv_block(lds, 0, 32768, QKVZ, (size_t)b * SEQ + n * BLK, h, wid, lane);
        const int cnt = (int)CNT[bh * 16 + n]; const unsigned short* lst = LISTS + ((size_t)bh * 16 + n) * LIST_CAP;
        for (int i = F.tid; i < (cnt + 1) / 2; i += NTHR) ((LAS unsigned*)llist)[i] = ((const unsigned*)lst)[i];
        const float b31 = F.rel_bias[31 * NH + h] * LOG2E;
        __syncthreads();
        const int ntile = (cnt + 31) >> 5;
        bf16x8 qn[4]; int tile = wid;
        if (tile < ntile) { const int idx = tile * 32 + r32; const unsigned e = llist[idx < cnt ? idx : 0]; const size_t row = (size_t)b * SEQ + (e & 4095);
#pragma unroll
            for (int d0 = 0; d0 < 4; ++d0) qn[d0] = *(const bf16x8*)(QKVZ + row * QP + h * HD + d0 * 16 + hi * 8); }
        for (; tile < ntile; tile += NWAVES) {
            int lane_ = F.tid; asm volatile("" : "+v"(lane_)); lane_ &= 63;
            const int lane = lane_, r32 = lane & 31, hi = lane >> 5;
            const int vb0 = (int)(uintptr_t)(lds + 32768) + ((lane >> 4) & 1) * 32 + (lane & 3) * 8 + (4 * hi + ((lane & 15) >> 2)) * 64;
            const int idx = tile * 32 + r32; const bool valid = idx < cnt;
            const unsigned e = llist[valid ? idx : 0]; const int s = e & 4095, slot = e >> 12; const size_t row = (size_t)b * SEQ + s;
            bf16x8 qr[4];
#pragma unroll
            for (int d0 = 0; d0 < 4; ++d0) qr[d0] = qn[d0];
            if (tile + NWAVES < ntile) { const int idx2 = (tile + NWAVES) * 32 + r32; const unsigned e2 = llist[idx2 < cnt ? idx2 : 0]; const size_t row2 = (size_t)b * SEQ + (e2 & 4095);
#pragma unroll
                for (int d0 = 0; d0 < 4; ++d0) qn[d0] = *(const bf16x8*)(QKVZ + row2 * QP + h * HD + d0 * 16 + hi * 8); }
            f32x16 o[2]; o[0] = f32x16{}; o[1] = f32x16{};
            float mx = -INFINITY, l = 0.f;
            const bool near = ((s >> 8) == n + 1);
            const int dbase = near ? (s - (n * BLK + 128)) : 100000;
#pragma unroll
            for (int half = 0; half < 2; ++half) {
                if (half) __builtin_amdgcn_sched_barrier(0);
                f32x16 p[2][2];
                if (half == 1) {
#pragma unroll
                    for (int t = 0; t < 2; ++t)
#pragma unroll
                        for (int r = 0; r < 16; ++r) { const int kv = t * 64 + crow(r, hi); int d0 = dbase - kv, d1 = d0 - 32; d0 = d0 > 127 ? 127 : d0; d1 = d1 > 127 ? 127 : d1;
                            p[t][0][r] = btab[h * 128 + d0]; p[t][1][r] = btab[h * 128 + d1]; }
                } else { p[0][0] = f32x16{}; p[0][1] = f32x16{}; p[1][0] = f32x16{}; p[1][1] = f32x16{}; }
#pragma unroll
                for (int t = 0; t < 2; ++t) qkt_acc(p[t][0], p[t][1], lds + (2 * half + t) * SLOTB, qr, r32, hi);
                float m2 = rowmax2(p[0][0], p[0][1], mx); m2 = rowmax2(p[1][0], p[1][1], m2); m2 = swapmax(m2);
                const float f = fexp2(mx - m2); l *= f; mx = m2;
                if (half == 1) {
                    if (hi == 0) wsf[64 + r32] = f;
                    asm volatile("s_waitcnt lgkmcnt(0)" ::: "memory");
#pragma unroll
                    for (int r = 0; r < 16; ++r) { const float fr_ = wsf[64 + crow(r, hi)]; o[0][r] *= fr_; o[1][r] *= fr_; } }
#pragma unroll
                for (int t = 0; t < 2; ++t) {
#pragma unroll
                    for (int r = 0; r < 16; ++r) { p[t][0][r] = fexp2(p[t][0][r] - mx); p[t][1][r] = fexp2(p[t][1][r] - mx); l += p[t][0][r] + p[t][1][r]; }
                    u32x4 w0, w1, w2, w3;
                    w0 = (u32x4){cvtpk(p[t][0][0], p[t][0][1]), cvtpk(p[t][0][2], p[t][0][3]), cvtpk(p[t][0][4], p[t][0][5]), cvtpk(p[t][0][6], p[t][0][7])};
                    w1 = (u32x4){cvtpk(p[t][0][8], p[t][0][9]), cvtpk(p[t][0][10], p[t][0][11]), cvtpk(p[t][0][12], p[t][0][13]), cvtpk(p[t][0][14], p[t][0][15])};
                    w2 = (u32x4){cvtpk(p[t][1][0], p[t][1][1]), cvtpk(p[t][1][2], p[t][1][3]), cvtpk(p[t][1][4], p[t][1][5]), cvtpk(p[t][1][6], p[t][1][7])};
                    w3 = (u32x4){cvtpk(p[t][1][8], p[t][1][9]), cvtpk(p[t][1][10], p[t][1][11]), cvtpk(p[t][1][12], p[t][1][13]), cvtpk(p[t][1][14], p[t][1][15])};
                    pv(o, vb0 + (2 * half + t) * SLOTB, __builtin_bit_cast(bf16x8, w0), __builtin_bit_cast(bf16x8, w1), __builtin_bit_cast(bf16x8, w2), __builtin_bit_cast(bf16x8, w3)); }
            }
            __builtin_amdgcn_sched_barrier(0);
            l = swapsum(l);
            if (hi == 0) { wsf[r32] = frcp(l); ((LAS int*)wsf)[32 + r32] = valid ? (int)(((row * NH + h) * 3 + slot)) : -1;
                           if (valid) { float2 ml; ml.x = mx + b31; ml.y = l; *(float2*)(PART_ML + ((row * NH + h) * 3 + slot) * 2) = ml; } }
            asm volatile("s_waitcnt lgkmcnt(0)" ::: "memory");
#pragma unroll
            for (int r = 0; r < 16; ++r) { const int orow = crow(r, hi); const float il = wsf[orow];
#pragma unroll
                for (int d0 = 0; d0 < 2; ++d0) stg[orow * 64 + d0 * 32 + r32] = (bf16)f2bf(o[d0][r] * il); }
            asm volatile("s_waitcnt lgkmcnt(0)" ::: "memory");
#pragma unroll
            for (int i = 0; i < 4; ++i) { const int rr = i * 8 + (lane >> 3), ch = lane & 7; const int dst = ((LAS int*)wsf)[32 + rr];
                const u32x4 v = *(const LAS u32x4*)(stg + rr * 64 + ch * 8);
                if (dst >= 0) *(u32x4*)(PART_O + (size_t)dst * 64 + ch * 8) = v; }
            asm volatile("s_waitcnt lgkmcnt(0)" ::: "memory");
        }
    }
}

__device__ __forceinline__ void attn_own_combine(Frame& F, bf16* QKVZ, const bf16* PART_O, const float* PART_ML, bf16* OUTB, int out_pitch) {
    using namespace moba;
    LAS unsigned char* lds = F.lds; const int wid = F.wave, lane = F.lane, r32 = lane & 31, hi = lane >> 5;
    LAS float* btab = (LAS float*)(lds + 139264);
    LAS float* wsf = (LAS float*)(lds + 135168) + wid * 128; LAS float* ost = (LAS float*)(lds + 65536 + wid * 8704);
    __syncthreads();
    for (int i = F.tid; i < NH * 256; i += NTHR) { const int h = i >> 8, d = i & 255; btab[i] = F.rel_bias[T5B[d < 127 ? d : 127] * NH + h] * LOG2E; }
    const int vb0 = (int)(uintptr_t)(lds + 32768) + ((lane >> 4) & 1) * 32 + (lane & 3) * 8 + (4 * hi + ((lane & 15) >> 2)) * 64;
    for (int u = F.vcu; u < BATCH * NH * NBLK; u += F.G) {
        const int qb = u % NBLK, bh = u / NBLK, b = bh / NH, h = bh % NH;
        __syncthreads();
        load_kv_block(lds, 0, 32768, QKVZ, (size_t)b * SEQ + qb * BLK, h, wid, lane);
        const int sq = qb * BLK + wid * 32 + r32; const size_t row = (size_t)b * SEQ + sq;
        bf16x8 qr[4];
#pragma unroll
        for (int d0 = 0; d0 < 4; ++d0) qr[d0] = *(const bf16x8*)(QKVZ + row * QP + h * HD + d0 * 16 + hi * 8);
        __syncthreads();
        const int nt = (wid >> 1) + 1;
        int ql = wid * 32 + r32;
        asm volatile("" : "+v"(ql));
        const LAS float* bt = btab + h * 256;
        float mx = -INFINITY;
#define A2_SCORES(P0, P1, t) do { qkt(P0, P1, lds + (t) * SLOTB, qr, r32, hi); \
            if ((t) < nt - 1) { _Pragma("unroll") for (int r = 0; r < 16; ++r) { const int kv = (t) * 64 + crow(r, hi); const int d0 = ql - kv, d1 = d0 - 32; P0[r] += bt[d0]; P1[r] += bt[d1]; } } \
            else { _Pragma("unroll") for (int r = 0; r < 16; ++r) { const int kv = (t) * 64 + crow(r, hi); const int d0 = ql - kv, d1 = d0 - 32; const float b0 = bt[d0 < 0 ? 0 : d0], b1 = bt[d1 < 0 ? 0 : d1]; \
                P0[r] = d0 >= 0 ? P0[r] + b0 : -INFINITY; P1[r] = d1 >= 0 ? P1[r] + b1 : -INFINITY; } } } while (0)
#pragma unroll 1
        for (int t = 0; t < nt; ++t) { f32x16 p0, p1; A2_SCORES(p0, p1, t); mx = rowmax2(p0, p1, mx); }
        mx = swapmax(mx);
        float l = 0.f;
        f32x16 o[2]; o[0] = f32x16{}; o[1] = f32x16{};
#pragma unroll 1
        for (int t = 0; t < nt; ++t) { f32x16 p0, p1; A2_SCORES(p0, p1, t);
#pragma unroll
            for (int r = 0; r < 16; ++r) { p0[r] = fexp2(p0[r] - mx); p1[r] = fexp2(p1[r] - mx); l += p0[r] + p1[r]; }
            u32x4 w0, w1, w2, w3;
            w0 = (u32x4){cvtpk(p0[0], p0[1]), cvtpk(p0[2], p0[3]), cvtpk(p0[4], p0[5]), cvtpk(p0[6], p0[7])};
            w1 = (u32x4){cvtpk(p0[8], p0[9]), cvtpk(p0[10], p0[11]), cvtpk(p0[12], p0[13]), cvtpk(p0[14], p0[15])};
            w2 = (u32x4){cvtpk(p1[0], p1[1]), cvtpk(p1[2], p1[3]), cvtpk(p1[4], p1[5]), cvtpk(p1[6], p1[7])};
            w3 = (u32x4){cvtpk(p1[8], p1[9]), cvtpk(p1[10], p1[11]), cvtpk(p1[12], p1[13]), cvtpk(p1[14], p1[15])};
            pv(o, vb0 + t * SLOTB, __builtin_bit_cast(bf16x8, w0), __builtin_bit_cast(bf16x8, w1), __builtin_bit_cast(bf16x8, w2), __builtin_bit_cast(bf16x8, w3));
        }
#undef A2_SCORES
        l = swapsum(l);
        if (hi == 0) { wsf[r32] = mx; wsf[32 + r32] = l; }
#pragma unroll
        for (int r = 0; r < 16; ++r) { const int orow = crow(r, hi);
#pragma unroll
            for (int d0 = 0; d0 < 2; ++d0) ost[orow * 68 + d0 * 32 + r32] = o[d0][r]; }
        asm volatile("s_waitcnt lgkmcnt(0)" ::: "memory");
        { const int q = lane >> 1, c0 = (lane & 1) * 32; const int s2 = qb * BLK + wid * 32 + q; const size_t row2 = (size_t)b * SEQ + s2;
          const float m0 = wsf[q], l0 = wsf[32 + q]; const int np = qb < 3 ? qb : 3;
          float mj[3], lj[3]; float mt = m0;
#pragma unroll
          for (int j = 0; j < 3; ++j) { if (j < np) { const float2 ml = *(const float2*)(PART_ML + ((row2 * NH + h) * 3 + j) * 2); mj[j] = ml.x; lj[j] = ml.y; mt = fmaxf(mt, ml.x); } else { mj[j] = -INFINITY; lj[j] = 0.f; } }
          const float w0 = fexp2(m0 - mt); float wj[3]; float den = w0 * l0;
#pragma unroll
          for (int j = 0; j < 3; ++j) { wj[j] = (j < np) ? fexp2(mj[j] - mt) * lj[j] : 0.f; den += wj[j]; }
          const float iden = frcp(den);
          float acc[32];
#pragma unroll
          for (int c = 0; c < 32; c += 4) { const f32x4 v = *(const LAS f32x4*)(ost + q * 68 + c0 + c); acc[c] = v[0] * w0; acc[c + 1] = v[1] * w0; acc[c + 2] = v[2] * w0; acc[c + 3] = v[3] * w0; }
#pragma unroll
          for (int j = 0; j < 3; ++j) if (j < np) { const v4u* pp = (const v4u*)(PART_O + ((row2 * NH + h) * 3 + j) * 64 + c0);
#pragma unroll
              for (int c = 0; c < 4; ++c) { const v4u w = pp[c]; const float f = wj[j];
                  acc[c * 8 + 0] += f * __uint_as_float(w.x << 16); acc[c * 8 + 1] += f * __uint_as_float(w.x & 0xffff0000u); acc[c * 8 + 2] += f * __uint_as_float(w.y << 16); acc[c * 8 + 3] += f * __uint_as_float(w.y & 0xffff0000u);
                  acc[c * 8 + 4] += f * __uint_as_float(w.z << 16); acc[c * 8 + 5] += f * __uint_as_float(w.z & 0xffff0000u); acc[c * 8 + 6] += f * __uint_as_float(w.w << 16); acc[c * 8 + 7] += f * __uint_as_float(w.w & 0xffff0000u); } }
          const v4u* zp = (const v4u*)(QKVZ + row2 * QP + 1536 + h * HD + c0);
          asm volatile("s_waitcnt lgkmcnt(0)" ::: "memory");
#pragma unroll
          for (int c = 0; c < 4; ++c) { const v4u w = zp[c]; const float z[8] = {__uint_as_float(w.x << 16), __uint_as_float(w.x & 0xffff0000u), __uint_as_float(w.y << 16), __uint_as_float(w.y & 0xffff0000u),
                                                                               __uint_as_float(w.z << 16), __uint_as_float(w.z & 0xffff0000u), __uint_as_float(w.w << 16), __uint_as_float(w.w & 0xffff0000u)};
              float rr[8];
#pragma unroll
              for (int e2 = 0; e2 < 8; ++e2) rr[e2] = acc[c * 8 + e2] * iden * z[e2] * sigm(z[e2]);
              v4u ow; ow.x = pk2(rr[0], rr[1]); ow.y = pk2(rr[2], rr[3]); ow.z = pk2(rr[4], rr[5]); ow.w = pk2(rr[6], rr[7]); *(LAS v4u*)((LAS bf16*)ost + q * 72 + c0 + c * 8) = ow; }
          asm volatile("s_waitcnt lgkmcnt(0)" ::: "memory");
#pragma unroll
          for (int i = 0; i < 4; ++i) { const int rr = i * 8 + (lane >> 3), chk = lane & 7; const v4u w = *(const LAS v4u*)((LAS bf16*)ost + rr * 72 + chk * 8);
              *(v4u*)(OUTB + ((size_t)b * SEQ + qb * BLK + wid * 32 + rr) * out_pitch + h * HD + chk * 8) = w; } }
        asm volatile("s_waitcnt lgkmcnt(0)" ::: "memory");
    }
}
namespace rk {
using bf16x8 = __attribute__((ext_vector_type(8))) short;
using s16x4 = __attribute__((ext_vector_type(4))) short;
using f32x16 = __attribute__((ext_vector_type(16))) float;
using u32x4 = __attribute__((ext_vector_type(4))) unsigned;
using u32x2 = __attribute__((ext_vector_type(2))) unsigned;
typedef short v4i16_t __attribute__((ext_vector_type(4)));
typedef float f32x2_t __attribute__((ext_vector_type(2))); typedef __bf16 bf16x2_t __attribute__((ext_vector_type(2)));
constexpr int P = 144, IMG = 64 * P, GRP = 81920, MISC = 8 * IMG;
#define RK_MFMA(a, b, c) __builtin_amdgcn_mfma_f32_32x32x16_bf16((a), (b), (c), 0, 0, 0)
__device__ __forceinline__ int crow(int r, int hi) { return (r & 3) + 8 * (r >> 2) + 4 * hi; }
__device__ __forceinline__ unsigned cvtpk(float lo, float hi) { f32x2_t v = {lo, hi}; bf16x2_t b = __builtin_convertvector(v, bf16x2_t); return __builtin_bit_cast(unsigned, b); }
__device__ __forceinline__ float bflo(unsigned w) { return __uint_as_float(w << 16); }
__device__ __forceinline__ float bfhi(unsigned w) { return __uint_as_float(w & 0xffff0000u); }
__device__ __forceinline__ s16x4 trrd(const LAS unsigned char* p) { return __builtin_bit_cast(s16x4, __builtin_amdgcn_ds_read_tr16_b64_v4i16((LAS v4i16_t*)p)); }
struct Ln { int r, h, blk, q, p; };
__device__ __forceinline__ bf16x8 frag_row(const LAS unsigned char* img, const Ln& l, int tile, int s, int coloff = 0) { return *(const LAS bf16x8*)(img + (32 * tile + l.r) * P + (coloff + 16 * s + 8 * l.h) * 2); }
__device__ __forceinline__ bf16x8 frag_tr(const LAS unsigned char* img, const Ln& l, int tile, int s, int rowoff = 0) {
    const LAS unsigned char* b = img + (rowoff + 16 * s + 8 * l.h + l.q) * P + 64 * tile + 32 * l.blk + 8 * l.p;
    const s16x4 lo = trrd(b), hi = trrd(b + 4 * P);
    return (bf16x8){lo[0], lo[1], lo[2], lo[3], hi[0], hi[1], hi[2], hi[3]};
}
__device__ __forceinline__ bf16x8 frag_row_perm(const LAS unsigned char* img, const Ln& l, int tile, int s, int coloff = 0) {
    const LAS unsigned char* b = img + (32 * tile + l.r) * P + (coloff + 16 * s + 4 * l.h) * 2;
    const s16x4 lo = *(const LAS s16x4*)b, hi = *(const LAS s16x4*)(b + 16);
    return (bf16x8){lo[0], lo[1], lo[2], lo[3], hi[0], hi[1], hi[2], hi[3]};
}
__device__ __forceinline__ bf16x8 frag_tr_perm(const LAS unsigned char* img, const Ln& l, int tile, int s, int rowoff = 0) {
    const LAS unsigned char* b = img + (rowoff + 16 * s + 4 * l.h + l.q) * P + 64 * tile + 32 * l.blk + 8 * l.p;
    const s16x4 lo = trrd(b), hi = trrd(b + 8 * P);
    return (bf16x8){lo[0], lo[1], lo[2], lo[3], hi[0], hi[1], hi[2], hi[3]};
}
__device__ __forceinline__ bf16x8 pack(const f32x16& x, int s) {
    u32x4 w; w.x = cvtpk(x[8 * s], x[8 * s + 1]); w.y = cvtpk(x[8 * s + 2], x[8 * s + 3]); w.z = cvtpk(x[8 * s + 4], x[8 * s + 5]); w.w = cvtpk(x[8 * s + 6], x[8 * s + 7]);
    return __builtin_bit_cast(bf16x8, w);
}
__device__ __forceinline__ void store_T(LAS unsigned char* img, const Ln& l, const f32x16& x, int ti, int tj) {
#pragma unroll
    for (int g = 0; g < 4; ++g) { u32x2 w; w.x = cvtpk(x[4 * g], x[4 * g + 1]); w.y = cvtpk(x[4 * g + 2], x[4 * g + 3]);
        *(LAS u32x2*)(img + (32 * tj + l.r) * P + (32 * ti + 8 * g + 4 * l.h) * 2) = w; }
}
__device__ __forceinline__ float xhalf(float v) { return __shfl_xor(v, 32); }
__device__ __forceinline__ void tri_inv32(f32x16& D, f32x16& DT, f32x16 S, f32x16 ST) {
    const f32x16 z = {};
#pragma unroll
    for (int it = 0; it < 4; ++it) {
        f32x16 S2 = z, S2T = z;
#pragma unroll
        for (int s = 0; s < 2; ++s) { const bf16x8 ps = pack(S, s), pst = pack(ST, s); S2 = RK_MFMA(pst, ps, S2); S2T = RK_MFMA(ps, pst, S2T); }
        f32x16 DS = S2, DST = S2T;
#pragma unroll
        for (int s = 0; s < 2; ++s) { DS = RK_MFMA(pack(DT, s), pack(S2, s), DS); DST = RK_MFMA(pack(S2, s), pack(DT, s), DST); }
        D = D + DS; DT = DT + DST; S = S2; ST = S2T;
    }
}
}

constexpr size_t DO_NT = 0, DO_MT = 128 * MiB, DO_RH = 192 * MiB;

struct R1Ctx { int item, c, h, b; rk::f32x16 Wt0, Wt1; };
#define RK_RELANE() do { int t_ = F.tid; asm volatile("" : "+v"(t_)); lane = t_ & 63; tg = t_ & 255; grp = t_ >> 8; w4 = (t_ >> 6) & 3; ti = w4 >> 1; tj = w4 & 1; l.r = lane & 31; l.h = lane >> 5; l.blk = (lane >> 4) & 1; l.q = (lane & 15) >> 2; l.p = lane & 3; G = F.lds + grp * GRP; } while (0)
#define RK_KA() const __attribute__((address_space(4))) Args* ka = (const __attribute__((address_space(4))) Args*)__builtin_amdgcn_kernarg_segment_ptr(); asm volatile("" : "+s"(ka))
#define s0 (G)
#define s1 (G + IMG)
#define s2 (G + 2 * IMG)
#define s3 (G + 3 * IMG)
#define s4 (G + 4 * IMG)
#define s5 (G + 5 * IMG)
#define s6 (G + 6 * IMG)
#define s7 (G + 7 * IMG)
#define nrminv ((LAS float*)(G + MISC))
#define ltot (nrminv + 64)
#define gam (nrminv + 128)
#define bonp (nrminv + 192)
__device__ __forceinline__ void r1_S1a(Frame& F, R1Ctx& X) {
    using namespace rk;
    int grp, w4, ti, tj, lane, tg; Ln l; LAS unsigned char* G; const f32x16 z16 = {};
    RK_RELANE(); (void)w4; (void)tg; (void)ti; (void)tj;
    const int item = X.item, c = X.c, h = X.h, b = X.b; (void)item; (void)c; (void)h; (void)b;
    { RK_KA(); const bf16* RW = (const bf16*)(ka->ws + WS_RW); const float* mu_ = ka->in[5]; const float* kk_ = ka->in[10];
      const int t = tg >> 2, q4 = tg & 3; const int sq = c * 64 + t; const size_t row = (size_t)b * SEQ + sq;
      const bf16* cur = RW + row * RWC; const bool hasp = sq > 0; const bf16* prv = hasp ? cur - RWC : cur; const float pm = hasp ? 1.f : 0.f;
      float nr = 0.f;
#pragma unroll
      for (int half = 0; half < 2; ++half) { const int k0 = 16 * q4 + 8 * half, col = h * HD + k0;
          const v4u cr = *(const v4u*)(cur + col), pr = *(const v4u*)(prv + col), ck = *(const v4u*)(cur + 512 + col), pk = *(const v4u*)(prv + 512 + col), cv = *(const v4u*)(cur + 1024 + col), pv = *(const v4u*)(prv + 1024 + col);
          const v4u cw = *(const v4u*)(cur + 2048 + k0), pw = *(const v4u*)(prv + 2048 + k0), ca = *(const v4u*)(cur + 2112 + k0), pa = *(const v4u*)(prv + 2112 + k0); const v4u cz = *(const v4u*)(cur + 1536 + col), pz = *(const v4u*)(prv + 1536 + col);
          float ro[8], ko[8], vo[8], wo[8], ao[8], zo[8];
#pragma unroll
          for (int e = 0; e < 8; ++e) { const unsigned wcr = cr[e >> 1], wpr = pr[e >> 1], wck = ck[e >> 1], wpk = pk[e >> 1], wcv = cv[e >> 1], wpv = pv[e >> 1];
              const unsigned wcw = cw[e >> 1], wpw = pw[e >> 1], wca = ca[e >> 1], wpa = pa[e >> 1];
              const float xr = (e & 1) ? bfhi(wcr) : bflo(wcr), yr = pm * ((e & 1) ? bfhi(wpr) : bflo(wpr)); ro[e] = xr + (yr - xr) * mu_[col + e];
              const float xk = (e & 1) ? bfhi(wck) : bflo(wck), yk = pm * ((e & 1) ? bfhi(wpk) : bflo(wpk)); ko[e] = xk + (yk - xk) * mu_[512 + col + e];
              const float xv = (e & 1) ? bfhi(wcv) : bflo(wcv), yv = pm * ((e & 1) ? bfhi(wpv) : bflo(wpv)); vo[e] = xv + (yv - xv) * mu_[1024 + col + e];
              const float xw = (e & 1) ? bfhi(wcw) : bflo(wcw), yw = pm * ((e & 1) ? bfhi(wpw) : bflo(wpw)); wo[e] = ftanh(xw + (yw - xw) * mu_[2048 + k0 + e]);
              const float xa = (e & 1) ? bfhi(wca) : bflo(wca), ya = pm * ((e & 1) ? bfhi(wpa) : bflo(wpa)); ao[e] = xa + (ya - xa) * mu_[2112 + k0 + e];
              { const unsigned wcz = cz[e >> 1], wpz = pz[e >> 1]; const float xz = (e & 1) ? bfhi(wcz) : bflo(wcz), yz = pm * ((e & 1) ? bfhi(wpz) : bflo(wpz)); const float zz = xz + (yz - xz) * mu_[1536 + col + e]; zo[e] = zz * sigm(zz); }
              const float kkx = ko[e] * kk_[col + e]; nr += kkx * kkx; }
          const int off = t * P + k0 * 2;
          *(LAS u32x4*)(s0 + off) = (u32x4){cvtpk(wo[0], wo[1]), cvtpk(wo[2], wo[3]), cvtpk(wo[4], wo[5]), cvtpk(wo[6], wo[7])};
          *(LAS u32x4*)(s1 + off) = (u32x4){cvtpk(ao[0], ao[1]), cvtpk(ao[2], ao[3]), cvtpk(ao[4], ao[5]), cvtpk(ao[6], ao[7])};
          *(LAS u32x4*)(s2 + off) = (u32x4){cvtpk(ro[0], ro[1]), cvtpk(ro[2], ro[3]), cvtpk(ro[4], ro[5]), cvtpk(ro[6], ro[7])};
          *(LAS u32x4*)(s3 + off) = (u32x4){cvtpk(ko[0], ko[1]), cvtpk(ko[2], ko[3]), cvtpk(ko[4], ko[5]), cvtpk(ko[6], ko[7])};
          const u32x4 vw = (u32x4){cvtpk(vo[0], vo[1]), cvtpk(vo[2], vo[3]), cvtpk(vo[4], vo[5]), cvtpk(vo[6], vo[7])};
          *(LAS u32x4*)(s4 + off) = vw;
          bf16* qz = (bf16*)(ka->ws + WS_QKVZ) + row * QP + col;
          *(u32x4*)(qz + 1024) = vw; *(u32x4*)(qz + 1536) = (u32x4){cvtpk(zo[0], zo[1]), cvtpk(zo[2], zo[3]), cvtpk(zo[4], zo[5]), cvtpk(zo[6], zo[7])}; }
      nr += __shfl_xor(nr, 1); nr += __shfl_xor(nr, 2);
      if (q4 == 0) nrminv[t] = frsq(fmaxf(nr, 1e-24f)); }
}
__device__ __forceinline__ void r1_S1b(Frame& F, R1Ctx& X) {
    using namespace rk;
    int grp, w4, ti, tj, lane, tg; Ln l; LAS unsigned char* G; const f32x16 z16 = {};
    RK_RELANE(); (void)w4; (void)tg; (void)ti; (void)tj;
    const int item = X.item, c = X.c, h = X.h, b = X.b; (void)item; (void)c; (void)h; (void)b;
    {
        RK_KA(); const bf16* WupT = (const bf16*)(ka->ws + WS_WUPT); const bf16* AupT = (const bf16*)(ka->ws + WS_AUPT);
        const int kcol = 32 * tj + l.r, kc = h * HD + kcol;
        f32x16 W = z16, Aq = z16;
#pragma unroll
        for (int s = 0; s < 4; ++s) { const bf16x8 bw = *(const bf16x8*)(WupT + (size_t)kc * 64 + 16 * s + 8 * l.h), ba = *(const bf16x8*)(AupT + (size_t)kc * 64 + 16 * s + 8 * l.h);
            W = RK_MFMA(frag_row(s0, l, ti, s), bw, W); Aq = RK_MFMA(frag_row(s1, l, ti, s), ba, Aq); }
        const float w0 = ka->in[6][kc], a0 = ka->in[8][kc], kkc = ka->in[10][kc], kac = ka->in[11][kc], rkc = ka->in[12][kc];
        float lw[16], L[16];
#pragma unroll
        for (int r = 0; r < 16; ++r) { const float x = W[r] + w0; const float sp = (-x > 20.f) ? -x : 0.6931471805599453f * __builtin_amdgcn_logf(1.0f + fexp(-x)); lw[r] = -fexp(-sp - 0.5f); Aq[r] = sigm(Aq[r] + a0); }
        float gs[4], go[4];
#pragma unroll
        for (int g = 0; g < 4; ++g) { L[4 * g] = lw[4 * g]; L[4 * g + 1] = L[4 * g] + lw[4 * g + 1]; L[4 * g + 2] = L[4 * g + 1] + lw[4 * g + 2]; L[4 * g + 3] = L[4 * g + 2] + lw[4 * g + 3]; gs[g] = L[4 * g + 3]; }
        float run = 0.f;
#pragma unroll
        for (int g = 0; g < 4; ++g) { const float og = xhalf(gs[g]); const float lo = l.h ? og : gs[g], hi = l.h ? gs[g] : og;
            go[g] = run + (l.h ? lo : 0.f); run += lo + hi; }
#pragma unroll
        for (int r = 0; r < 16; ++r) L[r] += go[r >> 2];
        if (ti == 0 && l.h == 0) ltot[kcol] = run;
        __syncthreads();
        if (ti == 1) { const float add = ltot[kcol];
#pragma unroll
            for (int r = 0; r < 16; ++r) L[r] += add;
            if (l.h == 1) gam[kcol] = fexp(L[15]); }
        f32x16 At, Bt, Kt, Rt; float xb[16];
#pragma unroll
        for (int r = 0; r < 16; ++r) { const int t = 32 * ti + crow(r, l.h);
            const float rr = bf2f(*(const LAS unsigned short*)(s2 + t * P + kcol * 2)), kx = bf2f(*(const LAS unsigned short*)(s3 + t * P + kcol * 2));
            const float kn = kx * kkc * nrminv[t], a = Aq[r], km = kx * (1.0f + (a - 1.0f) * kac);
            const float eL = fexp(L[r]), eLn = fexp(-L[r]), eLp = fexp(L[r] - lw[r]);
            At[r] = -kn * eLp; Bt[r] = kn * a * eLn; Kt[r] = km * eLn; Rt[r] = rr * eL; xb[r] = rr * km * rkc; }
#pragma unroll
        for (int r = 0; r < 16; ++r) xb[r] = dpp_sum32(xb[r]);
        if (l.r == 31) {
#pragma unroll
            for (int r = 0; r < 16; ++r) bonp[tj * 64 + 32 * ti + crow(r, l.h)] = xb[r]; }
        store_T(s0, l, At, ti, tj); store_T(s1, l, Bt, ti, tj); store_T(s5, l, Kt, ti, tj); store_T(s6, l, Rt, ti, tj);
    }
}
__device__ __forceinline__ void r1_S2(Frame& F, R1Ctx& X) {
    using namespace rk;
    int grp, w4, ti, tj, lane, tg; Ln l; LAS unsigned char* G; const f32x16 z16 = {};
    RK_RELANE(); (void)w4; (void)tg; (void)ti; (void)tj;
    const int item = X.item, c = X.c, h = X.h, b = X.b; (void)item; (void)c; (void)h; (void)b;
    {
        f32x16 X = z16;
        if (ti >= tj) {
#pragma unroll
            for (int s = 0; s < 4; ++s) X = RK_MFMA(frag_tr(s0, l, ti, s), frag_tr(s5, l, tj, s), X);
#pragma unroll
            for (int r = 0; r < 16; ++r) { const int t = 32 * ti + crow(r, l.h), i = 32 * tj + l.r; if (!(t > i)) X[r] = 0.f; } }
        store_T(s2, l, X, ti, tj);
        if (w4 == 0 || w4 == 3) { const int d = w4 == 3;
            f32x16 S = z16, ST = z16;
#pragma unroll
            for (int s = 0; s < 4; ++s) { const bf16x8 fa = frag_tr(s0, l, d, s), fb = frag_tr(s1, l, d, s); S = RK_MFMA(fa, fb, S); ST = RK_MFMA(fb, fa, ST); }
#pragma unroll
            for (int r = 0; r < 16; ++r) { const int rw = crow(r, l.h); if (!(rw > l.r)) S[r] = 0.f; if (!(l.r > rw)) ST[r] = 0.f; }
            f32x16 D = S, DT = ST;
            tri_inv32(D, DT, S, ST);
            store_T(s7, l, D, d, d);
            asm volatile("s_waitcnt lgkmcnt(0)" ::: "memory");
            if (l.h == 0) *(LAS unsigned short*)(s7 + (32 * d + l.r) * P + (32 * d + l.r) * 2) = 0x3f80;
        } else if (w4 == 2) {
            f32x16 X21 = z16;
#pragma unroll
            for (int s = 0; s < 4; ++s) X21 = RK_MFMA(frag_tr(s0, l, 1, s), frag_tr(s1, l, 0, s), X21);
            store_T(s3, l, X21, 0, 0);
        } else {
            store_T(s7, l, z16, 0, 1);
            { RK_KA(); float* BON = (float*)(ka->ws + WS_BON); const int t = lane; BON[((size_t)b * SEQ + c * 64 + t) * NH + h] = bonp[t] + bonp[64 + t]; }
        }
    }
}
__device__ __forceinline__ void r1_S3(Frame& F, R1Ctx& X) {
    using namespace rk;
    int grp, w4, ti, tj, lane, tg; Ln l; LAS unsigned char* G; const f32x16 z16 = {};
    RK_RELANE(); (void)w4; (void)tg; (void)ti; (void)tj;
    const int item = X.item, c = X.c, h = X.h, b = X.b; (void)item; (void)c; (void)h; (void)b;
    f32x16& Wt0 = X.Wt0; f32x16& Wt1 = X.Wt1;
    Wt0 = z16; Wt1 = z16;
    {
        if (w4 == 2) {
            f32x16 E = z16;
#pragma unroll
            for (int s = 0; s < 2; ++s) E = RK_MFMA(frag_tr(s3, l, 0, s), frag_row(s7, l, 0, s), E);
            store_T(s3, l, E, 0, 1);
            f32x16 T21 = z16;
#pragma unroll
            for (int s = 0; s < 2; ++s) T21 = RK_MFMA(frag_tr(s7, l, 1, s, 32), frag_row(s3, l, 1, s), T21);
            store_T(s7, l, T21, 1, 0);
        }
#pragma unroll
        for (int s = 0; s < 4; ++s) Wt0 = RK_MFMA(frag_tr(s2, l, 0, s), frag_tr(s4, l, tj, s), Wt0);
        if (ti == 1) {
#pragma unroll
            for (int s = 0; s < 4; ++s) Wt1 = RK_MFMA(frag_tr(s2, l, 1, s), frag_tr(s4, l, tj, s), Wt1); }
    }
}
__device__ __forceinline__ void r1_S4(Frame& F, R1Ctx& X) {
    using namespace rk;
    int grp, w4, ti, tj, lane, tg; Ln l; LAS unsigned char* G; const f32x16 z16 = {};
    RK_RELANE(); (void)w4; (void)tg; (void)ti; (void)tj;
    const int item = X.item, c = X.c, h = X.h, b = X.b; (void)item; (void)c; (void)h; (void)b;
    f32x16& Wt0 = X.Wt0; f32x16& Wt1 = X.Wt1;
    {
        f32x16 Ap = z16;
#pragma unroll
        for (int s = 0; s < 4; ++s) if (s < 2 || ti == 1) Ap = RK_MFMA(frag_tr(s7, l, ti, s), frag_row(s0, l, tj, s), Ap);
        f32x16 Uv = z16;
#pragma unroll
        for (int s = 0; s < 2; ++s) Uv = RK_MFMA(frag_tr_perm(s7, l, ti, s, 0), pack(Wt0, s), Uv);
        if (ti == 1) {
#pragma unroll
            for (int s = 0; s < 2; ++s) Uv = RK_MFMA(frag_tr_perm(s7, l, ti, s, 32), pack(Wt1, s), Uv); }
        store_T(s2, l, Ap, ti, tj); store_T(s3, l, Uv, ti, tj);
    }
}
__device__ __forceinline__ void r1_S5(Frame& F, R1Ctx& X) {
    using namespace rk;
    int grp, w4, ti, tj, lane, tg; Ln l; LAS unsigned char* G; const f32x16 z16 = {};
    RK_RELANE(); (void)w4; (void)tg; (void)ti; (void)tj;
    const int item = X.item, c = X.c, h = X.h, b = X.b; (void)item; (void)c; (void)h; (void)b;
    {
        RK_KA(); float* NT = (float*)((unsigned char*)ka->out + DO_NT); bf16* MT = (bf16*)((unsigned char*)ka->out + DO_MT); bf16* RH = (bf16*)((unsigned char*)ka->out + DO_RH); bf16* Y0 = (bf16*)(ka->ws + WS_GATE);
        const size_t ib = (size_t)((b * 64 + c) * NH + h) * 4096;
        f32x16 Xrb0 = z16, Xrk0 = z16, Xrb1 = z16, Xrk1 = z16;
#pragma unroll
        for (int s = 0; s < 4; ++s) { const bf16x8 fr = frag_tr(s6, l, ti, s); Xrb0 = RK_MFMA(frag_tr(s1, l, 0, s), fr, Xrb0); Xrk0 = RK_MFMA(frag_tr(s5, l, 0, s), fr, Xrk0); }
        if (ti == 1) {
#pragma unroll
            for (int s = 0; s < 4; ++s) { const bf16x8 fr = frag_tr(s6, l, ti, s); Xrb1 = RK_MFMA(frag_tr(s1, l, 1, s), fr, Xrb1); Xrk1 = RK_MFMA(frag_tr(s5, l, 1, s), fr, Xrk1); } }
#pragma unroll
        for (int r = 0; r < 16; ++r) { const bool keep = crow(r, l.h) <= l.r; if (ti == 0) { if (!keep) { Xrb0[r] = 0.f; Xrk0[r] = 0.f; } } else { if (!keep) { Xrb1[r] = 0.f; Xrk1[r] = 0.f; } } }
        f32x16 acc;
#pragma unroll
        for (int g = 0; g < 4; ++g) { const u32x2 w = *(const LAS u32x2*)(s6 + (32 * tj + l.r) * P + (32 * ti + 8 * g + 4 * l.h) * 2); acc[4 * g] = bflo(w.x); acc[4 * g + 1] = bfhi(w.x); acc[4 * g + 2] = bflo(w.y); acc[4 * g + 3] = bfhi(w.y); }
#pragma unroll
        for (int s = 0; s < 2; ++s) acc = RK_MFMA(pack(Xrb0, s), frag_row_perm(s2, l, tj, s, 0), acc);
        if (ti == 1) {
#pragma unroll
            for (int s = 0; s < 2; ++s) acc = RK_MFMA(pack(Xrb1, s), frag_row_perm(s2, l, tj, s, 32), acc); }
#pragma unroll
        for (int r = 0; r < 16; ++r) RH[ib + (32 * ti + crow(r, l.h)) * 64 + 32 * tj + l.r] = (bf16)f2bf(acc[r]);
        acc = z16;
#pragma unroll
        for (int s = 0; s < 2; ++s) { acc = RK_MFMA(pack(Xrb0, s), frag_row_perm(s3, l, tj, s, 0), acc); acc = RK_MFMA(pack(Xrk0, s), frag_tr_perm(s4, l, tj, s, 0), acc); }
        if (ti == 1) {
#pragma unroll
            for (int s = 0; s < 2; ++s) { acc = RK_MFMA(pack(Xrb1, s), frag_row_perm(s3, l, tj, s, 32), acc); acc = RK_MFMA(pack(Xrk1, s), frag_tr_perm(s4, l, tj, s, 32), acc); } }
#pragma unroll
        for (int r = 0; r < 16; ++r) Y0[ib + (32 * ti + crow(r, l.h)) * 64 + 32 * tj + l.r] = (bf16)f2bf(acc[r]);
        acc = z16;
#pragma unroll
        for (int s = 0; s < 4; ++s) acc = RK_MFMA(frag_row(s1, l, ti, s), frag_row(s2, l, tj, s), acc);
#pragma unroll
        for (int r = 0; r < 16; ++r) { const int kp = 32 * ti + crow(r, l.h), k = 32 * tj + l.r; const float v = (acc[r] + (kp == k ? 1.f : 0.f)) * gam[kp]; MT[ib + kp * 64 + k] = (bf16)f2bf(v); }
        acc = z16;
#pragma unroll
        for (int s = 0; s < 4; ++s) { acc = RK_MFMA(frag_row(s1, l, ti, s), frag_row(s3, l, tj, s), acc); acc = RK_MFMA(frag_row(s5, l, ti, s), frag_tr(s4, l, tj, s), acc); }
#pragma unroll
        for (int r = 0; r < 16; ++r) NT[ib + ((ti * 2 + tj) * 16 + r) * 64 + lane] = acc[r] * gam[32 * ti + crow(r, l.h)];
    }
}
#ifndef MK_R1_REP
#define MK_R1_REP -1
#endif
__device__ __forceinline__ void rwkv_chunk_ops(Frame& F) {
    R1Ctx X;
    for (int ip = F.vcu; ip < BATCH * NH * 64 / 2; ip += F.G) {
        { int t_ = F.tid; asm volatile("" : "+v"(t_)); const int grp = t_ >> 8; X.item = ip * 2 + grp; X.c = X.item & 63; const int bh = X.item >> 6; X.h = bh % NH; X.b = bh / NH; }
        r1_S1a(F, X); __syncthreads();
        if constexpr (MK_R1_REP == 0) { r1_S1a(F, X); __syncthreads(); }
        r1_S1b(F, X); __syncthreads();
        if constexpr (MK_R1_REP == 1) { r1_S1a(F, X); __syncthreads(); r1_S1b(F, X); __syncthreads(); }
        r1_S2(F, X); __syncthreads();
        if constexpr (MK_R1_REP == 2) { r1_S2(F, X); __syncthreads(); }
        r1_S3(F, X); __syncthreads();
        r1_S4(F, X); __syncthreads();
        r1_S5(F, X); __syncthreads();
        if constexpr (MK_R1_REP == 5) { r1_S5(F, X); __syncthreads(); }
    }
}
#undef s0
#undef s1
#undef s2
#undef s3
#undef s4
#undef s5
#undef s6
#undef s7
#undef nrminv
#undef ltot
#undef gam
#undef bonp
__device__ __forceinline__ void rwkv_relay(Frame& F) {
    using namespace rk;
    const int lane = F.lane, wid = F.wave; const int lr = lane & 31, lh = lane >> 5;
    LAS float* sbuf = (LAS float*)F.lds; volatile LAS int* flag = (volatile LAS int*)(F.lds + 16384);
    const float* NT = (const float*)((unsigned char*)F.out + DO_NT); bf16* MT = (bf16*)((unsigned char*)F.out + DO_MT);
    for (int ch = F.vcu; ch < BATCH * NH * 2; ch += F.G) {
        const int bh = ch >> 1, ct = ch & 1;
        __syncthreads();
        for (int i = F.tid; i < 2048; i += NTHR) sbuf[i] = 0.f;
        if (F.tid == 0) flag[0] = 0;
        __syncthreads();
        for (int c = wid; c < 64; c += NWAVES) {
            const size_t ib = (size_t)(((bh >> 3) * 64 + c) * NH + (bh & 7)) * 4096;
            bf16x8 am[2][4]; f32x16 sn[2];
#pragma unroll
            for (int rt = 0; rt < 2; ++rt)
#pragma unroll
                for (int s = 0; s < 4; ++s) { const bf16* pm = MT + ib + (32 * rt + lr) * 64 + 16 * s + 4 * lh;
                    const v2u m0 = *(const v2u*)pm, m1 = *(const v2u*)(pm + 8);
                    am[rt][s] = __builtin_bit_cast(bf16x8, (u32x4){m0.x, m0.y, m1.x, m1.y}); }
#pragma unroll
            for (int rt = 0; rt < 2; ++rt)
#pragma unroll
                for (int r = 0; r < 16; ++r) sn[rt][r] = NT[ib + ((rt * 2 + ct) * 16 + r) * 64 + lane];
            while (flag[0] < c) __builtin_amdgcn_s_sleep(1);
            asm volatile("s_waitcnt lgkmcnt(0)" ::: "memory");
            const LAS float* sin = sbuf + (c & 1) * 2048; LAS float* sout = sbuf + ((c + 1) & 1) * 2048;
            bf16x8 sp[2][2];
#pragma unroll
            for (int kt = 0; kt < 2; ++kt) { f32x16 sv;
#pragma unroll
                for (int r = 0; r < 16; ++r) sv[r] = sin[(kt * 16 + r) * 64 + lane];
                sp[kt][0] = pack(sv, 0); sp[kt][1] = pack(sv, 1); }
#pragma unroll
            for (int s = 0; s < 4; ++s)
#pragma unroll
                for (int rt = 0; rt < 2; ++rt) sn[rt] = RK_MFMA(am[rt][s], sp[s >> 1][s & 1], sn[rt]);
#pragma unroll
            for (int rt = 0; rt < 2; ++rt)
#pragma unroll
                for (int r = 0; r < 16; ++r) sout[(rt * 16 + r) * 64 + lane] = sn[rt][r];
            asm volatile("s_waitcnt lgkmcnt(0)" ::: "memory");
            if (lane == 0) flag[0] = c + 1;
            bf16* sc = (bf16*)(F.ws + WS_SC) + ib;
#pragma unroll
            for (int kt = 0; kt < 2; ++kt)
#pragma unroll
                for (int sl = 0; sl < 2; ++sl) *(bf16x8*)(sc + (((kt * 2 + ct) * 2 + sl) * 64 + lane) * 8) = sp[kt][sl];
        }
    }
}

struct R2Tile { v4u y0[4], vv[4], zg[4]; float bon; };
__device__ __forceinline__ void r2_load_tile(R2Tile& T, const bf16* Y0, const bf16* QKVZ, const float* BON, size_t ib, int b, int h, int c, int tt, int lane) {
    const int q = lane >> 1, c0 = (lane & 1) * 32; const size_t row = (size_t)b * SEQ + c * 64 + tt * 32 + q;
    const v4u* y0p = (const v4u*)(Y0 + ib + (tt * 32 + q) * 64 + c0); const v4u* vp = (const v4u*)(QKVZ + row * QP + 1024 + h * HD + c0); const v4u* zp = (const v4u*)(QKVZ + row * QP + 1536 + h * HD + c0);
#pragma unroll
    for (int i = 0; i < 4; ++i) { T.y0[i] = y0p[i]; T.vv[i] = vp[i]; T.zg[i] = zp[i]; }
    T.bon = BON[row * NH + h];
}
__device__ __forceinline__ void rwkv_output(Frame& F) {
    using namespace rk;
    const int wid = F.wave;
    LAS float* yst = (LAS float*)(F.lds + wid * 8704); LAS float* cst = (LAS float*)(F.lds + 69632);
    bf16* QKVZ = (bf16*)(F.ws + WS_QKVZ);
    const bf16* SC = (const bf16*)(F.ws + WS_SC); const bf16* RH = (const bf16*)((unsigned char*)F.out + DO_RH);
    const bf16* Y0 = (const bf16*)(F.ws + WS_GATE); const float* BON = (const float*)(F.ws + WS_BON);
    __syncthreads();
    for (int i = F.tid; i < 2 * 512; i += NTHR) { const int a = i >> 9, col = i & 511; cst[i] = a == 0 ? F.ln_w[col] : F.ln_b[col]; }
    __syncthreads();
    const int gw = F.vcu * NWAVES + wid, NGW = F.G * NWAVES;
    for (int idx = gw; idx < BATCH * NH * 64; idx += NGW) {
        const int h = idx & 7, c = (idx >> 3) & 63, b = idx >> 9; const size_t ib = (size_t)idx * 4096;
        bf16x8 sp[2][2][2];
        { const int lane = F.lane;
#pragma unroll
          for (int kt = 0; kt < 2; ++kt)
#pragma unroll
              for (int ct = 0; ct < 2; ++ct)
#pragma unroll
                  for (int sl = 0; sl < 2; ++sl) sp[kt][ct][sl] = *(const bf16x8*)(SC + ib + (((kt * 2 + ct) * 2 + sl) * 64 + lane) * 8); }
#pragma unroll 1
        for (int tt = 0; tt < 2; ++tt) {
            int lane_ = F.tid; asm volatile("" : "+v"(lane_)); const int lane = lane_ & 63, lr = lane & 31, lh = lane >> 5;
            bf16x8 ar[4];
#pragma unroll
            for (int s = 0; s < 4; ++s) { const bf16* pr = RH + ib + (32 * tt + lr) * 64 + 16 * s + 4 * lh; const v2u r0 = *(const v2u*)pr, r1 = *(const v2u*)(pr + 8);
                ar[s] = __builtin_bit_cast(bf16x8, (u32x4){r0.x, r0.y, r1.x, r1.y}); }
            R2Tile T; r2_load_tile(T, Y0, QKVZ, BON, ib, b, h, c, tt, lane);
            f32x16 y0 = {}, y1 = {};
#ifndef MK_R2B_X
#define MK_R2B_X 0
#endif
#pragma unroll 1
            for (int rep2 = 0; rep2 < (MK_R2B_X == 2 ? 4 : 1); ++rep2) {
            y0 = f32x16{}; y1 = f32x16{};
#pragma unroll
            for (int s = 0; s < 4; ++s) { y0 = RK_MFMA(ar[s], sp[s >> 1][0][s & 1], y0); y1 = RK_MFMA(ar[s], sp[s >> 1][1][s & 1], y1); }
#pragma unroll
            for (int r = 0; r < 16; ++r) { yst[crow(r, lh) * 68 + lr] = y0[r]; yst[crow(r, lh) * 68 + 32 + lr] = y1[r]; }
            asm volatile("s_waitcnt lgkmcnt(0)" ::: "memory"); }
            const int q = lane >> 1, c0 = (lane & 1) * 32; const int sq = c * 64 + tt * 32 + q; const size_t row = (size_t)b * SEQ + sq;
            const LAS float* cs = cst + h * HD + c0;
            float y[32];
#pragma unroll 1
            for (int rep1 = 0; rep1 < (MK_R2B_X == 1 ? 4 : 1); ++rep1) {
#pragma unroll
            for (int e = 0; e < 32; e += 8) { const f32x4 a = *(const LAS f32x4*)(yst + q * 68 + c0 + e), bq = *(const LAS f32x4*)(yst + q * 68 + c0 + e + 4); const v4u w = T.y0[e >> 3];
                y[e] = a[0] + bflo(w.x); y[e + 1] = a[1] + bfhi(w.x); y[e + 2] = a[2] + bflo(w.y); y[e + 3] = a[3] + bfhi(w.y); y[e + 4] = bq[0] + bflo(w.z); y[e + 5] = bq[1] + bfhi(w.z); y[e + 6] = bq[2] + bflo(w.w); y[e + 7] = bq[3] + bfhi(w.w); }
            float sm = 0.f;
#pragma unroll
            for (int e = 0; e < 32; ++e) sm += y[e];
            sm += __shfl_xor(sm, 1); const float mean = sm * (1.f / 64.f);
            float sv = 0.f;
#pragma unroll
            for (int e = 0; e < 32; ++e) { const float d = y[e] - mean; sv += d * d; }
            sv += __shfl_xor(sv, 1); const float rstd = frsq(sv * (1.f / 64.f) + GN_EPS);
            const float bon = T.bon;
#pragma unroll
            for (int e = 0; e < 32; e += 8) { const v4u vw = T.vv[e >> 3], zw = T.zg[e >> 3];
                const f32x4 lw0 = *(const LAS f32x4*)(cs + e), lw1 = *(const LAS f32x4*)(cs + e + 4), lb0 = *(const LAS f32x4*)(cs + 512 + e), lb1 = *(const LAS f32x4*)(cs + 512 + e + 4);
                float o[8];
#pragma unroll
                for (int j = 0; j < 8; ++j) { const unsigned wv = vw[j >> 1], wz = zw[j >> 1]; const float vv = (j & 1) ? bfhi(wv) : bflo(wv), zg = (j & 1) ? bfhi(wz) : bflo(wz);
                    const float lw = j < 4 ? lw0[j & 3] : lw1[j & 3], lb = j < 4 ? lb0[j & 3] : lb1[j & 3];
                    o[j] = ((y[e + j] - mean) * rstd * lw + lb + bon * vv) * zg; }
                *(LAS v4u*)((LAS bf16*)yst + q * 72 + c0 + e) = (v4u){pk2(o[0], o[1]), pk2(o[2], o[3]), pk2(o[4], o[5]), pk2(o[6], o[7])}; }
            asm volatile("s_waitcnt lgkmcnt(0)" ::: "memory");
#pragma unroll
            for (int i = 0; i < 4; ++i) { const int rr = i * 8 + (lane >> 3), chk = lane & 7; const v4u w = *(const LAS v4u*)((LAS bf16*)yst + rr * 72 + chk * 8);
                *(v4u*)(QKVZ + ((size_t)b * SEQ + c * 64 + tt * 32 + rr) * QP + 512 + h * HD + chk * 8) = w; }
            asm volatile("s_waitcnt lgkmcnt(0)" ::: "memory"); }
        }
    }
}
constexpr int LDS_BYTES = 163840;
constexpr int NPHASE = 13;

template <int PLO, int PHI> __global__ void __launch_bounds__(NTHR, 2) fwd(Args args) {
    extern __shared__ __attribute__((aligned(16))) unsigned char lds[];
    Frame F;
    F.lds = (LAS unsigned char*)lds;
#define RETID() do { int t_ = threadIdx.x; asm volatile("" : "+v"(t_)); F.tid = t_; F.lane = t_ & 63; F.wave = __builtin_amdgcn_readfirstlane(t_ >> 6); \
    int bx_ = blockIdx.x, g_ = gridDim.x; asm volatile("" : "+s"(bx_), "+s"(g_)); F.G = g_; F.vcu = (g_ % 8 == 0) ? (bx_ % 8) * (g_ / 8) + bx_ / 8 : bx_; } while (0)
    RETID();
#define LOADF() do { const __attribute__((address_space(4))) Args* ap_ = (const __attribute__((address_space(4))) Args*)__builtin_amdgcn_kernarg_segment_ptr(); asm volatile("" : "+s"(ap_)); \
    F.x = ap_->in[0]; F.p = ap_->in[1]; F.g_pre = ap_->in[2]; F.w_in = ap_->in[3]; F.rel_bias = ap_->in[4]; F.mu = ap_->in[5]; F.w0 = ap_->in[6]; F.w_up = ap_->in[7]; \
    F.a0 = ap_->in[8]; F.a_up = ap_->in[9]; F.k_k = ap_->in[10]; F.k_a = ap_->in[11]; F.r_k = ap_->in[12]; F.ln_w = ap_->in[13]; F.ln_b = ap_->in[14]; \
    F.p_a = ap_->in[15]; F.p_b = ap_->in[16]; F.w_out = ap_->in[17]; F.g_post = ap_->in[18]; F.w_pu = ap_->in[19]; F.w_pg = ap_->in[20]; F.out = ap_->out; F.ws = ap_->ws; ws = F.ws; \
    U2 = (pg8::bf16_t*)F.out; MERGED = (pg8::bf16_t*)F.out; QKVZ = (pg8::bf16_t*)(ws + WS_QKVZ); RWb = (pg8::bf16_t*)(ws + WS_RW); GAB = (pg8::bf16_t*)(ws + WS_GAB); } while (0)
    unsigned char* ws; pg8::bf16_t *U2, *MERGED, *QKVZ, *RWb, *GAB;
    constexpr int lo = PLO, hi = PHI;
    cg::grid_group grid = cg::this_grid();
#define IN(k) (lo <= (k) && (k) < hi)
#define SEAM(k) do { if constexpr (IN(k) && IN((k) + 1)) grid.sync(); } while (0)
#ifndef MK_REPEAT_PHASE
#define MK_REPEAT_PHASE -1
#endif
#define NREP(k) (((k) == MK_REPEAT_PHASE) ? 2 : 1)

    if constexpr (IN(0)) { RETID(); LOADF(); p0_prologue(F); if constexpr (0 == MK_REPEAT_PHASE) { grid.sync(); RETID(); LOADF(); p0_prologue(F); } } SEAM(0);
#ifdef MK_BWTEST
    if constexpr (IN(1)) { RETID(); LOADF();
        const f32x4* xp = (const f32x4*)F.x; f32x4 acc = {0.f, 0.f, 0.f, 0.f};
        const int gw = F.vcu * NWAVES + F.wave, NGW = F.G * NWAVES;
        if (MK_BWTEST == 1) { const size_t n4 = (size_t)M * DM / 4;
            for (size_t i = (size_t)F.vcu * NTHR + F.tid; i + (size_t)31 * F.G * NTHR < n4; i += (size_t)32 * F.G * NTHR) { f32x4 t[32];
#pragma unroll
                for (int j = 0; j < 32; ++j) t[j] = xp[i + (size_t)j * F.G * NTHR];
#pragma unroll
                for (int j = 0; j < 32; ++j) acc += t[j]; }
        } else {
            for (int it = gw; it < (M / 32) * 8; it += NGW) { const int rg = it >> 3, cb = it & 7; const int q = F.lane >> 1, hf = F.lane & 1;
                const f32x4* p = xp + ((size_t)(rg * 32 + q) * DM + cb * 128 + hf * 64) / 4; f32x4 t[16];
#pragma unroll
                for (int j = 0; j < 16; ++j) t[j] = p[j];
#pragma unroll
                for (int j = 0; j < 16; ++j) acc += t[j]; } }
        if (acc[0] + acc[1] + acc[2] + acc[3] == 1.2345e30f) ((float*)(ws + WS_RSY))[F.tid] = acc[0];
        grid.sync(); }
#endif
    if constexpr (IN(1)) { RETID(); LOADF();
        { pg8::Gemm g{U2, (const pg8::bf16_t*)(ws + WS_WIN), M, INCP, DM, 2048, DM, 0, 0}; pg8::StaticOrder S; S.init(M, INCP, F.G, (int)blockIdx.x);
          pg8::EpiCols E{QKVZ, RWb, GAB, QSCALE};
          pg8::gemm_phase<pg8::EpiCols, pg8::StaticOrder, true, true>(F.lds, g, S, E);
          if constexpr (MK_REPEAT_PHASE == 101) { __syncthreads(); pg8::gemm_phase<pg8::EpiCols, pg8::StaticOrder, true, true>(F.lds, g, S, E); } }
        { pg8::Gemm g{U2, (const pg8::bf16_t*)(ws + WS_WG), M, 256, 2048, 2048, 2048, 16, (size_t)256 * 2048}; pg8::StaticOrder S; S.init(M, 256, F.G, (int)blockIdx.x);
          pg8::EpiF32 E{(float*)(ws + WS_GATE), 256};
          pg8::gemm_phase<pg8::EpiF32, pg8::StaticOrder, true, true>(F.lds, g, S, E);
          if constexpr (MK_REPEAT_PHASE == 102) { __syncthreads(); pg8::gemm_phase<pg8::EpiF32, pg8::StaticOrder, true, true>(F.lds, g, S, E); } }
    } SEAM(1);
    if constexpr (IN(2)) { RETID(); LOADF(); attn_select(F, (const float*)(ws + WS_GATE), (unsigned*)(ws + WS_CNT), (unsigned short*)((unsigned char*)F.out + DO_LISTS));
        if constexpr (2 == MK_REPEAT_PHASE) { grid.sync(); if (blockIdx.x == 0) for (int i = threadIdx.x; i < 2048; i += NTHR) ((unsigned*)(args.ws + WS_CNT))[i] = 0u; grid.sync(); RETID(); LOADF();
            attn_select(F, (const float*)(ws + WS_GATE), (unsigned*)(ws + WS_CNT), (unsigned short*)((unsigned char*)F.out + DO_LISTS)); } } SEAM(2);
    if constexpr (IN(3)) { RETID(); LOADF(); attn_partial(F, (const bf16*)(ws + WS_QKVZ), (const unsigned*)(ws + WS_CNT), (const unsigned short*)((unsigned char*)F.out + DO_LISTS),
                                         (bf16*)((unsigned char*)F.out + DO_PARTO), (float*)((unsigned char*)F.out + DO_PARTML), (unsigned*)(ws + WS_QCTR)); if constexpr (3 == MK_REPEAT_PHASE) { { grid.sync(); if (blockIdx.x == 0 && threadIdx.x == 0) *(unsigned*)(args.ws + WS_QCTR) = 0u; grid.sync(); } RETID(); LOADF(); attn_partial(F, (const bf16*)(ws + WS_QKVZ), (const unsigned*)(ws + WS_CNT), (const unsigned short*)((unsigned char*)F.out + DO_LISTS),
                                         (bf16*)((unsigned char*)F.out + DO_PARTO), (float*)((unsigned char*)F.out + DO_PARTML), (unsigned*)(ws + WS_QCTR)); } } SEAM(3);
    if constexpr (IN(4)) { RETID(); LOADF();
        if constexpr (4 == MK_REPEAT_PHASE) { attn_own_combine(F, (bf16*)(ws + WS_QKVZ), (const bf16*)((unsigned char*)F.out + DO_PARTO), (const float*)((unsigned char*)F.out + DO_PARTML), (bf16*)(ws + WS_GATE), 512); grid.sync(); RETID(); LOADF(); }
        attn_own_combine(F, (bf16*)(ws + WS_QKVZ), (const bf16*)((unsigned char*)F.out + DO_PARTO), (const float*)((unsigned char*)F.out + DO_PARTML), (bf16*)(ws + WS_QKVZ), QP); } SEAM(4);
    if constexpr (IN(5)) { RETID(); LOADF(); rwkv_chunk_ops(F); if constexpr (5 == MK_REPEAT_PHASE) { grid.sync(); RETID(); LOADF(); rwkv_chunk_ops(F); } } SEAM(5);
    if constexpr (IN(6)) { RETID(); LOADF(); rwkv_relay(F); if constexpr (6 == MK_REPEAT_PHASE) { grid.sync(); RETID(); LOADF(); rwkv_relay(F); } } SEAM(6);
    if constexpr (IN(7)) { RETID(); LOADF(); rwkv_output(F); if constexpr (7 == MK_REPEAT_PHASE) { grid.sync(); RETID(); LOADF(); rwkv_output(F); } } SEAM(7);
    if constexpr (IN(8)) { RETID(); LOADF();
        pg8::Gemm g{QKVZ, (const pg8::bf16_t*)(ws + WS_PAB), M, DM, 1024, QP, 1024, 0, 0}; pg8::StaticOrder S; S.init(M, DM, F.G, (int)blockIdx.x);
        pg8::EpiMergeFused E{MERGED, DM, GAB, GP};
        pg8::gemm_phase<pg8::EpiMergeFused, pg8::StaticOrder, true, true>(F.lds, g, S, E);
    } SEAM(9);
    if constexpr (IN(10)) { RETID(); LOADF();
        { pg8::Gemm g{MERGED, (const pg8::bf16_t*)(ws + WS_WOUT), M, DM, DM, DM, DM, 0, 0}; pg8::StaticOrder S; S.init(M, DM, F.G, (int)blockIdx.x);
          pg8::EpiBf16 E{RWb, DM};
          pg8::gemm_phase<pg8::EpiBf16, pg8::StaticOrder, true, true>(F.lds, g, S, E); }
        { pg8::Gemm g{(const pg8::bf16_t*)(ws + WS_PB), (const pg8::bf16_t*)(ws + WS_WPU), M, DM, PLE, PLE, PLE, 0, 0}; pg8::StaticOrder S; S.init(M, DM, F.G, (int)blockIdx.x);
          pg8::EpiBf16 E{GAB, DM};
          pg8::gemm_phase<pg8::EpiBf16, pg8::StaticOrder, true, true>(F.lds, g, S, E); }
    } SEAM(10);
    if constexpr (IN(11)) { RETID(); LOADF(); post_norm(F); if constexpr (11 == MK_REPEAT_PHASE) { grid.sync(); RETID(); LOADF(); post_norm(F); } } SEAM(11);
    if constexpr (IN(12)) { RETID(); LOADF();
        pg8::Gemm g{QKVZ, (const pg8::bf16_t*)(ws + WS_WPG), M, DM, DM, DM, DM, 0, 0}; pg8::StaticOrder S; S.init(M, DM, F.G, (int)blockIdx.x);
        pg8::EpiFinal E{F.out, F.x, RWb, (const float*)(ws + WS_RSY), F.g_post, GAB, DM};
        pg8::gemm_phase<pg8::EpiFinal, pg8::StaticOrder, true, true>(F.lds, g, S, E);
        if constexpr (MK_REPEAT_PHASE == 112) { __syncthreads(); pg8::gemm_phase<pg8::EpiFinal, pg8::StaticOrder, true, true>(F.lds, g, S, E); }
    }
#undef IN
#undef SEAM
}

#ifndef MK_ONE_LAUNCH
#define MK_ONE_LAUNCH 1
#endif
extern "C" void kernel_launch(void* const* d_in, const int* in_sizes, int n_in, void* d_out, int out_size, void* d_ws, size_t ws_size, hipStream_t stream) {
    static int grid = 0;
    if (grid == 0) {
        if (n_in != 21 || out_size != M * DM || ws_size < WS_END) { fprintf(stderr, "kernel_launch: unexpected shapes n_in %d out %d ws %zu\n", n_in, out_size, ws_size); grid = -1; return; }
        int dev = 0, cus = 0, per_cu = 0;
        (void)hipGetDevice(&dev); (void)hipDeviceGetAttribute(&cus, hipDeviceAttributeMultiprocessorCount, dev);
        (void)per_cu;
        grid = cus;
    }
    if (grid < 0) return;
    Args a{};
    for (int i = 0; i < 21; ++i) a.in[i] = (const float*)d_in[i];
    a.out = (float*)d_out; a.ws = (unsigned char*)d_ws;
#if MK_ONE_LAUNCH
    a.ph_lo = 0; a.ph_hi = NPHASE;
    void* kargs[] = {&a};
    (void)hipFuncSetAttribute((const void*)fwd<0, NPHASE>, hipFuncAttributeMaxDynamicSharedMemorySize, LDS_BYTES);
    hipError_t e = hipLaunchCooperativeKernel((const void*)fwd<0, NPHASE>, dim3(grid), dim3(NTHR), kargs, LDS_BYTES, stream);
    if (e != hipSuccess) fprintf(stderr, "cooperative launch failed: %s\n", hipGetErrorString(e));
#else
#define LAUNCH_PH(k) do { (void)hipFuncSetAttribute((const void*)fwd<k, k + 1>, hipFuncAttributeMaxDynamicSharedMemorySize, LDS_BYTES); a.ph_lo = k; a.ph_hi = k + 1; hipLaunchKernelGGL((fwd<k, k + 1>), dim3(grid), dim3(NTHR), LDS_BYTES, stream, a); } while (0)
    LAUNCH_PH(0); LAUNCH_PH(1); LAUNCH_PH(2); LAUNCH_PH(3); LAUNCH_PH(4); LAUNCH_PH(5); LAUNCH_PH(6); LAUNCH_PH(7); LAUNCH_PH(8); LAUNCH_PH(9); LAUNCH_PH(10); LAUNCH_PH(11); LAUNCH_PH(12);
#endif
}
```

```cpp
#include <hip/hip_runtime.h>
#include <hip/hip_cooperative_groups.h>
#include <cstdio>
#include <cstdint>
#include <cmath>
namespace cg = cooperative_groups;
namespace pg8 {
#define PG8_LAS __attribute__((address_space(3)))
typedef unsigned short bf16_t;
typedef short bf16x8 __attribute__((ext_vector_type(8)));
typedef float f32x4 __attribute__((ext_vector_type(4)));
typedef float f32x2 __attribute__((ext_vector_type(2)));
typedef unsigned u32x4 __attribute__((ext_vector_type(4)));
typedef unsigned u32x2 __attribute__((ext_vector_type(2)));
constexpr int BM = 256, BK = 64, HALF = 128, HTB = HALF * BK * 2  , STAGE_BYTES = 8 * HTB, NXCD = 8, WGM = 8;

__host__ __device__ __forceinline__ int lds_byte(int r, int c) { const int st = (r >> 4) * 2 + (c >> 5), rr = r & 15, cc = c & 31, ob = rr * 64 + cc * 2; return st * 1024 + (ob ^ (((ob >> 9) & 1) << 5)); }
__host__ __device__ __forceinline__ void stage_rc(int b, int& R, int& C) { const int st = b / 1024, sb = b % 1024, swz = sb ^ (((sb >> 9) & 1) << 5); R = (st >> 1) * 16 + swz / 64; C = (st & 1) * 32 + (swz % 64) / 2; }
__host__ __device__ __forceinline__ int perm32(int rho) { const int n = rho >> 4, i = rho & 15; return 8 * (i >> 2) + 4 * n + (i & 3); }

struct Unit { int pm, pn; };
struct Gemm { const bf16_t* A; const bf16_t* Bt; int M, N, K, lda, ldb, bdiv; size_t bstride; };

struct StaticOrder {
    int nM, nN, nwg, G, c;
    __host__ __device__ void init(int M, int N, int G_, int c_) { nM = M / BM; nN = N / BM; nwg = nM * nN; G = G_; c = c_; }
    __host__ __device__ bool next(int i, Unit& u) const {
        const long L = (long)i * G + c; if (L >= nwg) return false;
        int wgid = (int)L; { const int q = nwg / NXCD, r = nwg % NXCD, xcd = wgid % NXCD, off = wgid / NXCD; wgid = (xcd < r ? xcd * (q + 1) : r * (q + 1) + (xcd - r) * q) + off; }
        const int nig = WGM * nN, gid = wgid / nig, fm = gid * WGM, gsz = (nM - fm) < WGM ? (nM - fm) : WGM;
        u.pm = fm + ((wgid % nig) % gsz); u.pn = (wgid % nig) / gsz; return true;
    }
};

struct PanelOrder { int pm; __host__ __device__ bool next(int i, Unit& u) const { if (i >= 4) return false; u.pm = pm; u.pn = i; return true; } };
__device__ __forceinline__ unsigned cvt_pk_bf16(float lo, float hi) { unsigned r; asm volatile("v_cvt_pk_bf16_f32 %0, %1, %2" : "=v"(r) : "v"(lo), "v"(hi)); return r; }
__device__ __forceinline__ float bf_lo(unsigned w) { return __uint_as_float(w << 16); }
__device__ __forceinline__ float bf_hi(unsigned w) { return __uint_as_float(w & 0xffff0000u); }

template <class Epi, class Sched, bool ALIGN_EPI = false, bool SP2 = false>
__device__ __forceinline__ void gemm_phase(PG8_LAS unsigned char* lds, const Gemm g, const Sched& S, const Epi& E) {
    int tid_ = threadIdx.x; asm volatile("" : "+v"(tid_));
    const int tid = tid_, wid = __builtin_amdgcn_readfirstlane(tid >> 6), lane = tid & 63, wr = wid >> 2, wc = wid & 3, fr = lane & 15, fq = lane >> 4;
    const int K = g.K, nt = K / BK;
    unsigned voffA[2], voffB[2];
#pragma unroll
    for (int i = 0; i < 2; ++i) { int R, C; stage_rc(tid * 16 + i * 8192, R, C); const int Rb = Epi::PERM ? ((R & ~31) + perm32(R & 31)) : R;
        voffA[i] = (unsigned)(R * g.lda + C) * 2u; voffB[i] = (unsigned)(Rb * g.ldb + C) * 2u; }
    const size_t kstep = (size_t)(BK * 2);
    const size_t hstepA = (size_t)HALF * g.lda * 2, hstepB = (size_t)HALF * g.ldb * 2;
    const size_t tstepA = 2 * hstepA, tstepB = 2 * hstepB;
    const unsigned ldsw = (unsigned)wid * 1024u;
    const int aoff = lds_byte(wr * 64 + fr, fq * 8), boff = lds_byte(wc * 32 + fr, fq * 8);
#define PG8_SA(b, h) (((b) * 2 + (h)) * HTB)
#define PG8_SB(b, h) ((4 + (b) * 2 + (h)) * HTB)
#define PG8_STAGE(bufoff, gbase, voff) do { _Pragma("unroll") for (int _i = 0; _i < 2; ++_i) \
        __builtin_amdgcn_global_load_lds((const unsigned*)((const char*)(gbase) + (voff)[_i]), (PG8_LAS unsigned*)(lds + (bufoff) + ldsw + _i * 8192), 16, 0, 0); } while (0)
#define PG8_LDA(dst, b, h) do { _Pragma("unroll") for (int m = 0; m < 4; ++m) _Pragma("unroll") for (int k = 0; k < 2; ++k) dst[m][k] = *(const PG8_LAS bf16x8*)(lds + PG8_SA(b, h) + aoff + m * 2048 + k * 1024); } while (0)
#define PG8_LDB(dst, b, h) do { _Pragma("unroll") for (int n = 0; n < 2; ++n) _Pragma("unroll") for (int k = 0; k < 2; ++k) dst[n][k] = *(const PG8_LAS bf16x8*)(lds + PG8_SB(b, h) + boff + n * 2048 + k * 1024); } while (0)
#define PG8_MMA(ai, bj, At, Bt) do { __builtin_amdgcn_s_setprio(1); _Pragma("unroll") for (int m = 0; m < 4; ++m) _Pragma("unroll") for (int n = 0; n < 2; ++n) _Pragma("unroll") for (int k = 0; k < 2; ++k) \
        acc[ai][bj][m][n] = __builtin_amdgcn_mfma_f32_16x16x32_bf16(Bt[n][k], At[m][k], acc[ai][bj][m][n], 0, 0, 0); __builtin_amdgcn_s_setprio(0); } while (0)
#define PG8_WAIT_V(n) asm volatile("s_waitcnt vmcnt(" #n ")" ::: "memory")
#define PG8_WAIT_L(n) asm volatile("s_waitcnt lgkmcnt(" #n ")" ::: "memory")
#define PG8_BAR __builtin_amdgcn_s_barrier()
#define PG8_SCHED __builtin_amdgcn_sched_barrier(0)
#define PG8_BBASE(u) ((const char*)g.Bt + (size_t)(u).pn * tstepB + (g.bdiv ? (size_t)((u).pm / g.bdiv) * g.bstride * 2 : (size_t)0))
    Unit cur, nxt; int ui = 0;
    if (!S.next(0, cur)) return;
    f32x4 acc[2][2][4][2];
#pragma unroll
    for (int a = 0; a < 2; ++a)
#pragma unroll
        for (int b = 0; b < 2; ++b)
#pragma unroll
            for (int m = 0; m < 4; ++m)
#pragma unroll
                for (int n = 0; n < 2; ++n) acc[a][b][m][n] = (f32x4){0.f, 0.f, 0.f, 0.f};
    bf16x8 At[4][2], B0[2][2], B1[2][2];
    const char* cA = (const char*)g.A + (size_t)cur.pm * tstepA; const char* cB = PG8_BBASE(cur);
    if constexpr (SP2) {
        PG8_STAGE(PG8_SB(0, 0), cB, voffB); PG8_STAGE(PG8_SB(0, 1), cB + hstepB, voffB); PG8_STAGE(PG8_SA(0, 0), cA, voffA); PG8_STAGE(PG8_SA(0, 1), cA + hstepA, voffA);
        if (wr == 1) PG8_BAR;
        PG8_WAIT_V(2); PG8_BAR;
        PG8_STAGE(PG8_SB(1, 0), cB + kstep, voffB); PG8_STAGE(PG8_SA(1, 0), cA + kstep, voffA); PG8_STAGE(PG8_SB(1, 1), cB + hstepB + kstep, voffB);
        PG8_WAIT_V(6); PG8_BAR;
    } else {
        PG8_STAGE(PG8_SB(0, 0), cB, voffB); PG8_STAGE(PG8_SA(0, 0), cA, voffA); PG8_STAGE(PG8_SB(0, 1), cB + hstepB, voffB); PG8_STAGE(PG8_SA(0, 1), cA + hstepA, voffA);
        if (wr == 1) PG8_BAR;
        PG8_WAIT_V(4); PG8_BAR;
        PG8_STAGE(PG8_SB(1, 0), cB + kstep, voffB); PG8_STAGE(PG8_SA(1, 0), cA + kstep, voffA); PG8_STAGE(PG8_SB(1, 1), cB + hstepB + kstep, voffB);
        PG8_WAIT_V(6); PG8_BAR;
    }
    for (;;) {
        const bool has_next = S.next(ui + 1, nxt);
        const char* nA = has_next ? (const char*)g.A + (size_t)nxt.pm * tstepA : cA; const char* nB = has_next ? PG8_BBASE(nxt) : cB;
        for (int t = 0; t < nt; t += 2) {
            if constexpr (Epi::HOOK_T > 0) { if (t == Epi::HOOK_T) { PG8_SCHED; E.mid(acc, cur, wr, wc, fr, fq); PG8_SCHED; } }
            const bool last = (t == nt - 2);
            const char* a1 = cA + (size_t)(t + 1) * kstep;
            const char* a2 = last ? nA : cA + (size_t)(t + 2) * kstep; const char* b2 = last ? nB : cB + (size_t)(t + 2) * kstep;
            const char* a3 = a2 + kstep; const char* b3 = b2 + kstep;
            if constexpr (SP2) {
            PG8_LDB(B0, 0, 0); PG8_LDB(B1, 0, 1); PG8_SCHED; PG8_LDA(At, 0, 0); PG8_STAGE(PG8_SA(1, 1), a1 + hstepA, voffA);
            PG8_WAIT_V(8); PG8_WAIT_L(0); PG8_BAR; PG8_MMA(0, 0, At, B0); PG8_MMA(0, 1, At, B1); PG8_BAR; PG8_SCHED;
            PG8_LDA(At, 0, 1); PG8_STAGE(PG8_SB(0, 0), b2, voffB); PG8_STAGE(PG8_SB(0, 1), b2 + hstepB, voffB); PG8_STAGE(PG8_SA(0, 0), a2, voffA);
            PG8_WAIT_V(8); PG8_WAIT_L(0); PG8_BAR; PG8_MMA(1, 0, At, B0); PG8_MMA(1, 1, At, B1); PG8_BAR; PG8_SCHED;
            PG8_LDB(B0, 1, 0); PG8_LDB(B1, 1, 1); PG8_SCHED; PG8_LDA(At, 1, 0); PG8_STAGE(PG8_SA(0, 1), a2 + hstepA, voffA);
            PG8_WAIT_V(8); PG8_WAIT_L(0); PG8_BAR; PG8_MMA(0, 0, At, B0); PG8_MMA(0, 1, At, B1); PG8_BAR; PG8_SCHED;
            PG8_LDA(At, 1, 1); PG8_STAGE(PG8_SB(1, 0), b3, voffB); PG8_STAGE(PG8_SB(1, 1), b3 + hstepB, voffB); PG8_STAGE(PG8_SA(1, 0), a3, voffA);
            PG8_WAIT_V(8); PG8_WAIT_L(0); PG8_BAR; PG8_MMA(1, 0, At, B0); PG8_MMA(1, 1, At, B1); PG8_BAR; PG8_SCHED;
            } else {
            PG8_LDB(B0, 0, 0); PG8_SCHED; PG8_LDA(At, 0, 0); PG8_STAGE(PG8_SA(1, 1), a1 + hstepA, voffA);
            PG8_WAIT_L(8); PG8_BAR; PG8_WAIT_L(0); PG8_MMA(0, 0, At, B0); PG8_BAR; PG8_SCHED;
            PG8_LDB(B1, 0, 1); PG8_STAGE(PG8_SB(0, 0), b2, voffB);
            PG8_BAR; PG8_WAIT_L(0); PG8_MMA(0, 1, At, B1); PG8_BAR;
            PG8_LDA(At, 0, 1); PG8_STAGE(PG8_SA(0, 0), a2, voffA);
            PG8_BAR; PG8_WAIT_L(0); PG8_MMA(1, 0, At, B0); PG8_BAR; PG8_SCHED;
            PG8_STAGE(PG8_SB(0, 1), b2 + hstepB, voffB);
            PG8_WAIT_V(6); PG8_BAR; PG8_MMA(1, 1, At, B1); PG8_BAR;
            PG8_LDB(B0, 1, 0); PG8_SCHED; PG8_LDA(At, 1, 0); PG8_STAGE(PG8_SA(0, 1), a2 + hstepA, voffA);
            PG8_WAIT_L(8); PG8_BAR; PG8_WAIT_L(0); PG8_MMA(0, 0, At, B0); PG8_BAR; PG8_SCHED;
            PG8_LDB(B1, 1, 1); PG8_STAGE(PG8_SB(1, 0), b3, voffB);
            PG8_BAR; PG8_WAIT_L(0); PG8_MMA(0, 1, At, B1); PG8_BAR;
            PG8_LDA(At, 1, 1); PG8_STAGE(PG8_SA(1, 0), a3, voffA);
            PG8_BAR; PG8_WAIT_L(0); PG8_MMA(1, 0, At, B0); PG8_BAR; PG8_SCHED;
            PG8_STAGE(PG8_SB(1, 1), b3 + hstepB, voffB);
            PG8_WAIT_V(6); PG8_BAR; PG8_MMA(1, 1, At, B1); PG8_BAR;
            }
        }
        if constexpr (ALIGN_EPI) { if (wr == 0) PG8_BAR; }
        E(acc, cur, wr, wc, fr, fq);
        if (!has_next) break;
#pragma unroll
        for (int a = 0; a < 2; ++a)
#pragma unroll
            for (int b = 0; b < 2; ++b)
#pragma unroll
                for (int m = 0; m < 4; ++m)
#pragma unroll
                    for (int n = 0; n < 2; ++n) acc[a][b][m][n] = (f32x4){0.f, 0.f, 0.f, 0.f};
        cur = nxt; cA = nA; cB = nB; ++ui;
        if constexpr (ALIGN_EPI) { if (wr == 1) PG8_BAR; }
    }
    PG8_WAIT_V(0);
    if constexpr (!ALIGN_EPI) { if (wr == 0) PG8_BAR; }
    PG8_BAR;
#undef PG8_SA
#undef PG8_SB
#undef PG8_STAGE
#undef PG8_LDA
#undef PG8_LDB
#undef PG8_MMA
#undef PG8_WAIT_V
#undef PG8_WAIT_L
#undef PG8_BAR
#undef PG8_SCHED
#undef PG8_BBASE
}
}
namespace pg8 {
__device__ __forceinline__ float sigmoidf_(float x) { return __builtin_amdgcn_rcpf(1.0f + __builtin_amdgcn_exp2f(x * -1.4426950408889634f)); }

struct EpiCols {
    static constexpr bool PERM = true; static constexpr int HOOK_T = 0;
    bf16_t* qkvz; bf16_t* rw; bf16_t* gab; float qscale;
    __device__ __forceinline__ void operator()(const f32x4 (&acc)[2][2][4][2], const Unit& u, int wr, int wc, int fr, int fq) const {
        const int pn = u.pn; bf16_t* base; int pitch, coff, nbj = 2; float sc = 1.f;
        if (pn < 8) { base = qkvz; pitch = 2112; coff = pn * 256; if (pn < 2) sc = qscale; }
        else if (pn < 16) { base = rw; pitch = 2176; coff = (pn - 8) * 256; }
        else if (pn < 24) { base = gab; pitch = 2112; coff = (pn - 16) * 256; }
        else { base = rw; pitch = 2176; coff = 2048; nbj = 1; }
        const int row0 = u.pm * BM + wr * 64 + fr; const int col0 = coff + wc * 32 + 8 * fq;
#pragma unroll
        for (int ai = 0; ai < 2; ++ai)
#pragma unroll
            for (int m = 0; m < 4; ++m) { bf16_t* rowp = base + (size_t)(row0 + ai * HALF + m * 16) * pitch + col0;
#pragma unroll
                for (int bj = 0; bj < 2; ++bj) { if (bj < nbj) { f32x4 v0 = acc[ai][bj][m][0] * sc, v1 = acc[ai][bj][m][1] * sc;
                    u32x4 w; w.x = cvt_pk_bf16(v0[0], v0[1]); w.y = cvt_pk_bf16(v0[2], v0[3]); w.z = cvt_pk_bf16(v1[0], v1[1]); w.w = cvt_pk_bf16(v1[2], v1[3]);
                    *(u32x4*)(rowp + bj * HALF) = w; } } }
    }
};
struct EpiBf16 {
    static constexpr bool PERM = true; static constexpr int HOOK_T = 0;
    bf16_t* O; int ldc;
    __device__ __forceinline__ void operator()(const f32x4 (&acc)[2][2][4][2], const Unit& u, int wr, int wc, int fr, int fq) const {
        const int row0 = u.pm * BM + wr * 64 + fr; const int col0 = u.pn * BM + wc * 32 + 8 * fq;
#pragma unroll
        for (int ai = 0; ai < 2; ++ai)
#pragma unroll
            for (int m = 0; m < 4; ++m) { bf16_t* rowp = O + (size_t)(row0 + ai * HALF + m * 16) * ldc + col0;
#pragma unroll
                for (int bj = 0; bj < 2; ++bj) { const f32x4 v0 = acc[ai][bj][m][0], v1 = acc[ai][bj][m][1];
                    u32x4 w; w.x = cvt_pk_bf16(v0[0], v0[1]); w.y = cvt_pk_bf16(v0[2], v0[3]); w.z = cvt_pk_bf16(v1[0], v1[1]); w.w = cvt_pk_bf16(v1[2], v1[3]);
                    *(u32x4*)(rowp + bj * HALF) = w; } }
    }
};
struct EpiF32 {
    static constexpr bool PERM = false; static constexpr int HOOK_T = 0;
    float* O; int ldc;
    __device__ __forceinline__ void operator()(const f32x4 (&acc)[2][2][4][2], const Unit& u, int wr, int wc, int fr, int fq) const {
        const int row0 = u.pm * BM + wr * 64 + fr; const int col0 = u.pn * BM + wc * 32 + 4 * fq;
#pragma unroll
        for (int ai = 0; ai < 2; ++ai)
#pragma unroll
            for (int m = 0; m < 4; ++m) { float* rowp = O + (size_t)(row0 + ai * HALF + m * 16) * ldc + col0;
#pragma unroll
                for (int bj = 0; bj < 2; ++bj)
#pragma unroll
                    for (int n = 0; n < 2; ++n) *(f32x4*)(rowp + bj * HALF + n * 16) = acc[ai][bj][m][n]; }
    }
};
template <bool ADD> struct EpiMerge {
    static constexpr bool PERM = true; static constexpr int HOOK_T = 0;
    bf16_t* O; int ldc; const bf16_t* G; int ldg;
    __device__ __forceinline__ void operator()(const f32x4 (&acc)[2][2][4][2], const Unit& u, int wr, int wc, int fr, int fq) const {
        const int row0 = u.pm * BM + wr * 64 + fr; const int col0 = u.pn * BM + wc * 32 + 8 * fq;
#pragma unroll
        for (int ai = 0; ai < 2; ++ai)
#pragma unroll
            for (int m = 0; m < 4; ++m) { const size_t r = (size_t)(row0 + ai * HALF + m * 16);
#pragma unroll
                for (int bj = 0; bj < 2; ++bj) { const f32x4 v0 = acc[ai][bj][m][0], v1 = acc[ai][bj][m][1];
                    const u32x4 gw = *(const u32x4*)(G + r * ldg + col0 + bj * HALF);
                    float o[8];
                    o[0] = sigmoidf_(bf_lo(gw.x)) * v0[0]; o[1] = sigmoidf_(bf_hi(gw.x)) * v0[1]; o[2] = sigmoidf_(bf_lo(gw.y)) * v0[2]; o[3] = sigmoidf_(bf_hi(gw.y)) * v0[3];
                    o[4] = sigmoidf_(bf_lo(gw.z)) * v1[0]; o[5] = sigmoidf_(bf_hi(gw.z)) * v1[1]; o[6] = sigmoidf_(bf_lo(gw.w)) * v1[2]; o[7] = sigmoidf_(bf_hi(gw.w)) * v1[3];
                    bf16_t* op = O + r * ldc + col0 + bj * HALF;
                    if (ADD) { const u32x4 pw = *(const u32x4*)op;
                        o[0] += bf_lo(pw.x); o[1] += bf_hi(pw.x); o[2] += bf_lo(pw.y); o[3] += bf_hi(pw.y); o[4] += bf_lo(pw.z); o[5] += bf_hi(pw.z); o[6] += bf_lo(pw.w); o[7] += bf_hi(pw.w); }
                    u32x4 w; w.x = cvt_pk_bf16(o[0], o[1]); w.y = cvt_pk_bf16(o[2], o[3]); w.z = cvt_pk_bf16(o[4], o[5]); w.w = cvt_pk_bf16(o[6], o[7]);
                    *(u32x4*)op = w; } }
    }
};
struct EpiYStat {
    static constexpr bool PERM = true; static constexpr int HOOK_T = 0;
    bf16_t* O; int ldc; PG8_LAS float* part;
    __device__ __forceinline__ void operator()(const f32x4 (&acc)[2][2][4][2], const Unit& u, int wr, int wc, int fr, int fq) const {
        const int row0 = u.pm * BM + wr * 64 + fr; const int col0 = u.pn * BM + wc * 32 + 8 * fq;
#pragma unroll
        for (int ai = 0; ai < 2; ++ai)
#pragma unroll
            for (int m = 0; m < 4; ++m) { bf16_t* rowp = O + (size_t)(row0 + ai * HALF + m * 16) * ldc + col0; float s = 0.f;
#pragma unroll
                for (int bj = 0; bj < 2; ++bj) { const f32x4 v0 = acc[ai][bj][m][0], v1 = acc[ai][bj][m][1];
                    u32x4 w; w.x = cvt_pk_bf16(v0[0], v0[1]); w.y = cvt_pk_bf16(v0[2], v0[3]); w.z = cvt_pk_bf16(v1[0], v1[1]); w.w = cvt_pk_bf16(v1[2], v1[3]);
                    *(u32x4*)(rowp + bj * HALF) = w;
                    s += (bf_lo(w.x) * bf_lo(w.x) + bf_hi(w.x) * bf_hi(w.x)) + (bf_lo(w.y) * bf_lo(w.y) + bf_hi(w.y) * bf_hi(w.y)) + (bf_lo(w.z) * bf_lo(w.z) + bf_hi(w.z) * bf_hi(w.z)) + (bf_lo(w.w) * bf_lo(w.w) + bf_hi(w.w) * bf_hi(w.w)); }
                s += __shfl_xor(s, 16); s += __shfl_xor(s, 32);
                if (fq == 0) part[(ai * HALF + wr * 64 + m * 16 + fr) * 16 + wc * 4 + u.pn] = s; }
    }
};
struct EpiMergeFused {
    static constexpr bool PERM = true; static constexpr int HOOK_T = 8;
    bf16_t* O; int ldc; const bf16_t* G; int ldg;
    __device__ __forceinline__ void mid(f32x4 (&acc)[2][2][4][2], const Unit& u, int wr, int wc, int fr, int fq) const {
        asm volatile("" : "+v"(fr), "+v"(fq));
        const int row0 = u.pm * BM + wr * 64 + fr; const int col0 = u.pn * BM + wc * 32 + 8 * fq;
#pragma unroll
        for (int ai = 0; ai < 2; ++ai)
#pragma unroll
            for (int m = 0; m < 4; ++m) { const size_t r = (size_t)(row0 + ai * HALF + m * 16);
#pragma unroll
                for (int bj = 0; bj < 2; ++bj) { const u32x4 ga = *(const u32x4*)(G + r * ldg + col0 + bj * HALF), gb = *(const u32x4*)(G + r * ldg + 1024 + col0 + bj * HALF);
#define MQ_(wa, wb, HI) ((1.0f + __builtin_amdgcn_exp2f(fmaxf(HI ? bf_hi(wb) : bf_lo(wb), -80.f) * -1.4426950408889634f)) * __builtin_amdgcn_rcpf(1.0f + __builtin_amdgcn_exp2f((HI ? bf_hi(wa) : bf_lo(wa)) * -1.4426950408889634f)))
                    acc[ai][bj][m][0][0] *= MQ_(ga.x, gb.x, 0); acc[ai][bj][m][0][1] *= MQ_(ga.x, gb.x, 1); acc[ai][bj][m][0][2] *= MQ_(ga.y, gb.y, 0); acc[ai][bj][m][0][3] *= MQ_(ga.y, gb.y, 1);
                    acc[ai][bj][m][1][0] *= MQ_(ga.z, gb.z, 0); acc[ai][bj][m][1][1] *= MQ_(ga.z, gb.z, 1); acc[ai][bj][m][1][2] *= MQ_(ga.w, gb.w, 0); acc[ai][bj][m][1][3] *= MQ_(ga.w, gb.w, 1);
#undef MQ_
                    __builtin_amdgcn_sched_barrier(0); }
                }
    }
    __device__ __forceinline__ void operator()(const f32x4 (&acc)[2][2][4][2], const Unit& u, int wr, int wc, int fr, int fq) const {
        asm volatile("" : "+v"(fr), "+v"(fq));
        const int row0 = u.pm * BM + wr * 64 + fr; const int col0 = u.pn * BM + wc * 32 + 8 * fq;
#pragma unroll
        for (int ai = 0; ai < 2; ++ai)
#pragma unroll
            for (int m = 0; m < 4; ++m) { const size_t r = (size_t)(row0 + ai * HALF + m * 16);
#pragma unroll
                for (int bj = 0; bj < 2; ++bj) { const f32x4 v0 = acc[ai][bj][m][0], v1 = acc[ai][bj][m][1];
                    const u32x4 gw = *(const u32x4*)(G + r * ldg + 1024 + col0 + bj * HALF);
                    u32x4 w; w.x = cvt_pk_bf16(sigmoidf_(fmaxf(bf_lo(gw.x), -80.f)) * v0[0], sigmoidf_(fmaxf(bf_hi(gw.x), -80.f)) * v0[1]); w.y = cvt_pk_bf16(sigmoidf_(fmaxf(bf_lo(gw.y), -80.f)) * v0[2], sigmoidf_(fmaxf(bf_hi(gw.y), -80.f)) * v0[3]);
                    w.z = cvt_pk_bf16(sigmoidf_(fmaxf(bf_lo(gw.z), -80.f)) * v1[0], sigmoidf_(fmaxf(bf_hi(gw.z), -80.f)) * v1[1]); w.w = cvt_pk_bf16(sigmoidf_(fmaxf(bf_lo(gw.w), -80.f)) * v1[2], sigmoidf_(fmaxf(bf_hi(gw.w), -80.f)) * v1[3]);
                    *(u32x4*)(O + r * ldc + col0 + bj * HALF) = w; } }
    }
};
struct EpiFinal {
    static constexpr bool PERM = false; static constexpr int HOOK_T = 0;
    float* out; const float* x; const bf16_t* y; const float* rsy; const float* gpost; const bf16_t* E; int ldc;
    __device__ __forceinline__ void operator()(const f32x4 (&acc)[2][2][4][2], const Unit& u, int wr, int wc, int fr, int fq) const {
        const int row0 = u.pm * BM + wr * 64 + fr; const int col0 = u.pn * BM + wc * 32 + 4 * fq;
#pragma unroll
        for (int ai = 0; ai < 2; ++ai)
#pragma unroll
            for (int m = 0; m < 4; ++m) { const size_t r = (size_t)(row0 + ai * HALF + m * 16); const float rs = rsy[r];
#pragma unroll
                for (int bj = 0; bj < 2; ++bj)
#pragma unroll
                    for (int n = 0; n < 2; ++n) { const int c = col0 + bj * HALF + n * 16; const size_t off = r * ldc + c;
                        const f32x4 xv = *(const f32x4*)(x + off), gp = *(const f32x4*)(gpost + c); const u32x2 ew = *(const u32x2*)(E + off), yw = *(const u32x2*)(y + off); const f32x4 yv = {bf_lo(yw.x), bf_hi(yw.x), bf_lo(yw.y), bf_hi(yw.y)};
                        const f32x4 a = acc[ai][bj][m][n]; f32x4 o;
                        o[0] = xv[0] + yv[0] * rs * gp[0] + sigmoidf_(a[0]) * bf_lo(ew.x);
                        o[1] = xv[1] + yv[1] * rs * gp[1] + sigmoidf_(a[1]) * bf_hi(ew.x);
                        o[2] = xv[2] + yv[2] * rs * gp[2] + sigmoidf_(a[2]) * bf_lo(ew.y);
                        o[3] = xv[3] + yv[3] * rs * gp[3] + sigmoidf_(a[3]) * bf_hi(ew.y);
                        *(f32x4*)(out + off) = o; } }
    }
};
}
#define GAS __attribute__((address_space(1)))
#define LAS __attribute__((address_space(3)))
typedef unsigned short bf16;
typedef unsigned v4u __attribute__((ext_vector_type(4)));
typedef unsigned v2u __attribute__((ext_vector_type(2)));
typedef float f32x4 __attribute__((ext_vector_type(4)));

constexpr int NWAVES = 8, NTHR = 512;
constexpr int BATCH = 16, SEQ = 4096, DM = 1024, M = BATCH * SEQ;
constexpr int NH = 8, HD = 64, AW = 512, PLE = 256;
constexpr int RWC = 2176, INC = 6272, INCP = 6400;
constexpr int NBLK = 16, BLK = 256;
constexpr float RMS_EPS = 1e-6f, GN_EPS = 64e-5f;
constexpr float LOG2E = 1.4426950408889634f;
constexpr float QSCALE = 0.125f * LOG2E;

constexpr size_t MiB = 1u << 20;
constexpr size_t WS_WIN = 2 * MiB;
constexpr size_t WS_WG = 16 * MiB;
constexpr size_t WS_PAB = 32 * MiB;
constexpr size_t WS_WOUT = 34 * MiB;
constexpr size_t WS_WPG = 36 * MiB;
constexpr size_t WS_WPU = 38 * MiB;
constexpr size_t WS_RSY = 39 * MiB;
constexpr size_t WS_PB = 42 * MiB;
constexpr size_t WS_GATE = 74 * MiB;
constexpr int QP = 2112, GP = 2112;
constexpr size_t WS_QKVZ = 138 * MiB;
constexpr size_t WS_RW = 402 * MiB;
constexpr size_t WS_GAB = 674 * MiB;
constexpr size_t WS_END = 1004 * MiB;
constexpr size_t WS_CNT = 0;
constexpr size_t WS_QCTR = 16384;
constexpr size_t WS_WUPT = 39 * MiB + 512 * 1024, WS_AUPT = WS_WUPT + 65536;
constexpr size_t WS_BON = 938 * MiB;
constexpr size_t WS_SC = 940 * MiB;
constexpr size_t DO_PARTO = 0, DO_PARTML = 192 * MiB, DO_LISTS = 208 * MiB;

__device__ const unsigned char T5B[128] = {0, 1, 2, 3, 4, 5, 6, 7, 8, 9, 10, 11, 12, 13, 14, 15, 16, 16, 16, 17, 17, 18, 18, 18, 19, 19, 19, 20, 20, 20, 20, 21, 21, 21, 21, 22, 22, 22, 22, 22, 23, 23, 23, 23, 23, 23, 24, 24, 24, 24, 24, 24, 25, 25, 25, 25, 25, 25, 25, 26, 26, 26, 26, 26, 26, 26, 26, 27, 27, 27, 27, 27, 27, 27, 27, 27, 27, 28, 28, 28, 28, 28, 28, 28, 28, 28, 28, 29, 29, 29, 29, 29, 29, 29, 29, 29, 29, 29, 29, 30, 30, 30, 30, 30, 30, 30, 30, 30, 30, 30, 30, 30, 30, 31, 31, 31, 31, 31, 31, 31, 31, 31, 31, 31, 31, 31, 31, 31};

__device__ __forceinline__ unsigned f2bf(float f) { unsigned u = __builtin_bit_cast(unsigned, f); return (u + 0x7fffu + ((u >> 16) & 1u)) >> 16; }
__device__ __forceinline__ unsigned pk2(float lo, float hi) { return f2bf(lo) | (f2bf(hi) << 16); }
__device__ __forceinline__ float bf2f(unsigned short h) { return __uint_as_float((unsigned)h << 16); }
__device__ __forceinline__ float wave_sum(float v) {
#pragma unroll
    for (int o = 1; o < 64; o <<= 1) v += __shfl_xor(v, o);
    return v;
}
__device__ __forceinline__ float fexp2(float x) { return __builtin_amdgcn_exp2f(x); }
__device__ __forceinline__ float fexp(float x) { return __builtin_amdgcn_exp2f(x * LOG2E); }
__device__ __forceinline__ float frcp(float x) { return __builtin_amdgcn_rcpf(x); }
__device__ __forceinline__ float frsq(float x) { return __builtin_amdgcn_rsqf(x); }
__device__ __forceinline__ float sigm(float x) { return frcp(1.0f + fexp2(-x * LOG2E)); }
__device__ __forceinline__ float ftanh(float x) { return 1.0f - 2.0f * frcp(1.0f + fexp2(x * (2.0f * LOG2E))); }
__device__ __forceinline__ float dpp_sum32(float v) {
#define DPP_ADD_(ctrl, rmask) v += __builtin_bit_cast(float, __builtin_amdgcn_update_dpp(0, __builtin_bit_cast(int, v), ctrl, rmask, 0xf, true))
    DPP_ADD_(0x118, 0xf); DPP_ADD_(0x114, 0xf); DPP_ADD_(0x112, 0xf); DPP_ADD_(0x111, 0xf);
    v += __builtin_bit_cast(float, __builtin_amdgcn_update_dpp(0, __builtin_bit_cast(int, v), 0x142, 0xa, 0xf, false));
#undef DPP_ADD_
    return v;
}

struct Args {
    const float* in[21]; float* out; unsigned char* ws; int ph_lo, ph_hi;
};
struct Frame {
    LAS unsigned char* lds; int tid, lane, wave, vcu, G;
    const float *x, *p, *g_pre, *w_in, *rel_bias, *mu, *w0, *w_up, *a0, *a_up, *k_k, *k_a, *r_k, *ln_w, *ln_b, *p_a, *p_b, *w_out, *g_post, *w_pu, *w_pg;
    float* out; unsigned char* ws;
};

__device__ __forceinline__ float wave_sum_fast(float v) { v = dpp_sum32(v); return __builtin_bit_cast(float, __builtin_amdgcn_readlane(__builtin_bit_cast(int, v), 31)) + __builtin_bit_cast(float, __builtin_amdgcn_readlane(__builtin_bit_cast(int, v), 63)); }
constexpr size_t WS_BAR = 32768;
#define XB_TMO      128
#define XB_XCNT(j)  (256  + 64 * (j))
#define XB_XSUB(j)  (1280 + 64 * (j))
#define XB_XGEN(j)  (2304 + 64 * (j))
#define XB_TOP      3328
#define XB_TOPGEN   3392
#define XB_SPIN_CAP (1u << 20)
__device__ __forceinline__ unsigned xb_ld(unsigned* p)              { return __hip_atomic_load(p, __ATOMIC_RELAXED, __HIP_MEMORY_SCOPE_AGENT); }
__device__ __forceinline__ unsigned xb_add(unsigned* p, unsigned v) { return __hip_atomic_fetch_add(p, v, __ATOMIC_RELAXED, __HIP_MEMORY_SCOPE_AGENT); }
__device__ __forceinline__ unsigned xb_xcc_id() { return (unsigned)__builtin_amdgcn_s_getreg((3 << 11) | 20) & 0xFu; }
#define XB_SPIN(cond, bar) do { unsigned _sp = 0; while (cond) { __builtin_amdgcn_s_sleep(1); \
    if ((++_sp & 255u) == 0u) { if (xb_ld(&(bar)[XB_TMO])) break; if (_sp > XB_SPIN_CAP) { atomicAdd(&(bar)[XB_TMO], 1u); break; } } } } while (0)
__device__ __forceinline__ void xcd_barrier_post(unsigned* bar) { if (threadIdx.x == 0) (void)xb_add(&bar[XB_XCNT(xb_xcc_id())], 1u); }
__device__ __forceinline__ void xcd_barrier_complete(unsigned* bar, unsigned x, unsigned& nloc, unsigned& nx) {
    const unsigned G = gridDim.x * gridDim.y * gridDim.z;
    unsigned sum, cnt, mine, sp = 0u;
    for (;;) {
        sum = 0u; cnt = 0u; mine = 0u;
#pragma unroll
        for (unsigned j = 0; j < 16; ++j) { const unsigned c = xb_ld(&bar[XB_XCNT(j)]); sum += c; cnt += (c > 0u) ? 1u : 0u; mine = (j == x) ? c : mine; }
        if (sum == G) break;
        __builtin_amdgcn_s_sleep(1);
        if ((++sp & 255u) == 0u) { if (xb_ld(&bar[XB_TMO])) break; if (sp > XB_SPIN_CAP) { atomicAdd(&bar[XB_TMO], 1u); break; } }
    }
    nloc = mine > 0u ? mine : 1u; nx = cnt > 0u ? cnt : 1u;
}
__device__ __forceinline__ void xcd_barrier(unsigned* bar, volatile LAS unsigned* st) {
    asm volatile("s_waitcnt vmcnt(0)" ::: "memory");
    __syncthreads();
    if (threadIdx.x == 0) {
        const unsigned x = xb_xcc_id();
        __builtin_amdgcn_s_waitcnt(0);
        unsigned nloc = st[0], nx = st[1];
        if (nloc == 0u) { xcd_barrier_complete(bar, x, nloc, nx); st[0] = nloc; st[1] = nx; }
        const unsigned old = xb_add(&bar[XB_XSUB(x)], 1u);
        const unsigned gen = old / nloc;
        if (old + 1u == (gen + 1u) * nloc) {
            __builtin_amdgcn_fence(__ATOMIC_RELEASE, "agent");
            asm volatile("s_waitcnt vmcnt(0)" ::: "memory");
            const unsigned og = xb_add(&bar[XB_TOP], 1u);
            const unsigned tg = og / nx;
            if (og + 1u == (tg + 1u) * nx) xb_add(&bar[XB_TOPGEN], 1u);
            else XB_SPIN(xb_ld(&bar[XB_TOPGEN]) == tg, bar);
            __builtin_amdgcn_fence(__ATOMIC_ACQUIRE, "agent");
            xb_add(&bar[XB_XGEN(x)], 1u);
            asm volatile("s_waitcnt vmcnt(0)" ::: "memory");
        } else {
            XB_SPIN(xb_ld(&bar[XB_XGEN(x)]) == gen, bar);
            __builtin_amdgcn_fence(__ATOMIC_ACQUIRE, "agent");
            asm volatile("s_waitcnt vmcnt(0)" ::: "memory");
        }
    }
    __syncthreads();
}

__device__ __forceinline__ void transpose_item(const float* W, int N, int k0, int n0, bf16* WT, int ldw, int drow0, int koff, LAS float* scr, int lane) {
#pragma unroll 8
    for (int i = 0; i < 32; ++i) { const int kk = 2 * i + (lane >> 5); scr[kk * 33 + (lane & 31)] = W[(size_t)(k0 + kk) * N + n0 + (lane & 31)]; }
    asm volatile("s_waitcnt lgkmcnt(0)" ::: "memory");
    const int c = lane & 7;
#pragma unroll
    for (int j = 0; j < 4; ++j) { const int n = (lane >> 3) + 8 * j; const LAS float* s = scr + (8 * c) * 33 + n;
        v4u o; o.x = pk2(s[0 * 33], s[1 * 33]); o.y = pk2(s[2 * 33], s[3 * 33]); o.z = pk2(s[4 * 33], s[5 * 33]); o.w = pk2(s[6 * 33], s[7 * 33]);
        *(v4u*)(WT + (size_t)(drow0 + n) * ldw + koff + k0 + 8 * c) = o; }
    asm volatile("s_waitcnt lgkmcnt(0)" ::: "memory");
}

__device__ __forceinline__ void p0_prologue(Frame& F) {
    LAS float* scr = (LAS float*)(F.lds + F.wave * 16384);
    const int gw = F.vcu * NWAVES + F.wave, NGW = F.G * NWAVES;
    bf16* WinT = (bf16*)(F.ws + WS_WIN); bf16* PabT = (bf16*)(F.ws + WS_PAB); bf16* WoutT = (bf16*)(F.ws + WS_WOUT); bf16* WpgT = (bf16*)(F.ws + WS_WPG); bf16* WpuT = (bf16*)(F.ws + WS_WPU);
    constexpr int I_IN = 16 * (INC / 32), I_PA = 8 * 32, I_PB = 8 * 32, I_WO = 16 * 32, I_PG = 16 * 32, I_PU = 4 * 32, I_UP = 16;
    constexpr int NIT = I_IN + I_PA + I_PB + I_WO + I_PG + I_PU + 2 * I_UP;
    for (int it = gw; it < NIT; it += NGW) {
        int r = it;
        if (r < I_IN) { const int nb = r % (INC / 32), kb = r / (INC / 32), n0 = nb * 32;
            const int d0 = n0 < 4096 ? n0 : (n0 < 4224 ? n0 + 2048 : n0 - 128);
            transpose_item(F.w_in, INC, kb * 64, n0, WinT, DM, d0, 0, scr, F.lane); continue; } r -= I_IN;
        if (r < I_PA) { transpose_item(F.p_a, DM, (r / 32) * 64, (r % 32) * 32, PabT, 1024, (r % 32) * 32, 0, scr, F.lane); continue; } r -= I_PA;
        if (r < I_PB) { transpose_item(F.p_b, DM, (r / 32) * 64, (r % 32) * 32, PabT, 1024, (r % 32) * 32, 512, scr, F.lane); continue; } r -= I_PB;
        if (r < I_WO) { transpose_item(F.w_out, DM, (r / 32) * 64, (r % 32) * 32, WoutT, 1024, (r % 32) * 32, 0, scr, F.lane); continue; } r -= I_WO;
        if (r < I_PG) { transpose_item(F.w_pg, DM, (r / 32) * 64, (r % 32) * 32, WpgT, 1024, (r % 32) * 32, 0, scr, F.lane); continue; } r -= I_PG;
        if (r < I_PU) { transpose_item(F.w_pu, DM, (r / 32) * 64, (r % 32) * 32, WpuT, 256, (r % 32) * 32, 0, scr, F.lane); continue; } r -= I_PU;
        if (r < I_UP) { transpose_item(F.w_up, AW, 0, r * 32, (bf16*)(F.ws + WS_WUPT), 64, r * 32, 0, scr, F.lane); continue; } r -= I_UP;
        transpose_item(F.a_up, AW, 0, r * 32, (bf16*)(F.ws + WS_AUPT), 64, r * 32, 0, scr, F.lane);
    }
    for (int i = gw * 64 + F.lane; i < 128 * 1024 / 8; i += NGW * 64) *(v4u*)(WinT + (size_t)INC * DM + (size_t)i * 8) = (v4u){0u, 0u, 0u, 0u};
    { bf16* PB = (bf16*)(F.ws + WS_PB); const size_t n8 = (size_t)M * PLE / 8;
      for (size_t i = (size_t)F.vcu * NTHR + F.tid; i < n8; i += (size_t)F.G * NTHR) { const f32x4 a = *(const f32x4*)(F.p + i * 8), b = *(const f32x4*)(F.p + i * 8 + 4);
          v4u o; o.x = pk2(a[0], a[1]); o.y = pk2(a[2], a[3]); o.z = pk2(b[0], b[1]); o.w = pk2(b[2], b[3]); *(v4u*)(PB + i * 8) = o; } }
    __syncthreads();
    LAS float* red = (LAS float*)F.lds;
    LAS float* ubar = (LAS float*)(F.lds + 32768);
    LAS float* kmean = (LAS float*)(F.lds + 36864);
    bf16* U2 = (bf16*)F.out; bf16* WgT = (bf16*)(F.ws + WS_WG);
    for (int blk = F.vcu; blk < M / BLK; blk += F.G) {
        float cs[16];
#pragma unroll
        for (int i = 0; i < 16; ++i) cs[i] = 0.f;
        f32x4 gv[4];
#pragma unroll
        for (int j = 0; j < 4; ++j) gv[j] = *((const f32x4*)F.g_pre + F.lane + 64 * j);
        for (int i = 0; i < 8; ++i) {
            f32x4 v[4][4];
#pragma unroll
            for (int r = 0; r < 4; ++r) { const f32x4* xr = (const f32x4*)(F.x + ((size_t)blk * BLK + F.wave + 8 * (4 * i + r)) * DM) + F.lane;
#pragma unroll
                for (int j = 0; j < 4; ++j) v[r][j] = xr[64 * j]; }
#pragma unroll
            for (int r = 0; r < 4; ++r) { const size_t row = (size_t)blk * BLK + F.wave + 8 * (4 * i + r); float s = 0.f;
#pragma unroll
                for (int j = 0; j < 4; ++j) s += (v[r][j][0] * v[r][j][0] + v[r][j][1] * v[r][j][1]) + (v[r][j][2] * v[r][j][2] + v[r][j][3] * v[r][j][3]);
                const float rs = frsq(wave_sum_fast(s) * (1.f / DM) + RMS_EPS);
#pragma unroll
                for (int j = 0; j < 4; ++j) {
                    float u[4]; unsigned h[4], l[4];
#pragma unroll
                    for (int e = 0; e < 4; ++e) { u[e] = v[r][j][e] * rs * gv[j][e]; cs[j * 4 + e] += u[e]; h[e] = f2bf(u[e]); l[e] = f2bf(u[e] - __uint_as_float(h[e] << 16)); }
                    const int col = 4 * F.lane + 256 * j;
                    *(v2u*)(U2 + row * 2048 + col) = (v2u){h[0] | (h[1] << 16), h[2] | (h[3] << 16)};
                    *(v2u*)(U2 + row * 2048 + 1024 + col) = (v2u){l[0] | (l[1] << 16), l[2] | (l[3] << 16)};
                } }
        }
#pragma unroll
        for (int j = 0; j < 4; ++j)
#pragma unroll
            for (int e = 0; e < 4; ++e) red[F.wave * 1024 + 4 * F.lane + 256 * j + e] = cs[j * 4 + e];
        __syncthreads();
        for (int k = F.tid; k < 1024; k += NTHR) { float s = 0.f;
#pragma unroll
            for (int w = 0; w < 8; ++w) s += red[w * 1024 + k];
            ubar[k] = s * (1.f / BLK); }
        __syncthreads();
        {
          float a0 = 0.f, a1 = 0.f, a2 = 0.f, a3 = 0.f; const float* wk = F.w_in + 512 + F.tid;
#pragma unroll 1
          for (int k0 = 0; k0 < 1024; k0 += 16) { float w[16];
#pragma unroll
              for (int i = 0; i < 16; ++i) w[i] = wk[(size_t)(k0 + i) * INC];
#pragma unroll
              for (int i = 0; i < 16; i += 4) { a0 += ubar[k0 + i] * w[i]; a1 += ubar[k0 + i + 1] * w[i + 1]; a2 += ubar[k0 + i + 2] * w[i + 2]; a3 += ubar[k0 + i + 3] * w[i + 3]; } }
          kmean[F.tid] = (a0 + a1) + (a2 + a3); }
        __syncthreads();
        {
          const int b = blk / NBLK, n = blk % NBLK; const int l8 = F.lane * 8;
          float km[8];
#pragma unroll
          for (int e = 0; e < 8; ++e) km[e] = kmean[l8 + e];
#pragma unroll 1
          for (int k0 = F.wave * 4; k0 < 1024; k0 += NWAVES * 4) { f32x4 w[4][2];
#pragma unroll
              for (int r = 0; r < 4; ++r) { const f32x4* wq = (const f32x4*)(F.w_in + (size_t)(k0 + r) * INC + l8); w[r][0] = wq[0]; w[r][1] = wq[1]; }
#pragma unroll
              for (int r = 0; r < 4; ++r) { float s = (w[r][0][0] * km[0] + w[r][0][1] * km[1]) + (w[r][0][2] * km[2] + w[r][0][3] * km[3]) + (w[r][1][0] * km[4] + w[r][1][1] * km[5]) + (w[r][1][2] * km[6] + w[r][1][3] * km[7]);
                  s += __builtin_bit_cast(float, __builtin_amdgcn_update_dpp(0, __builtin_bit_cast(int, s), 0x111, 0xf, 0xf, true));
                  s += __builtin_bit_cast(float, __builtin_amdgcn_update_dpp(0, __builtin_bit_cast(int, s), 0x112, 0xf, 0xf, true));
                  s += __builtin_bit_cast(float, __builtin_amdgcn_update_dpp(0, __builtin_bit_cast(int, s), 0x114, 0xf, 0xf, true));
                  if ((F.lane & 7) == 7) { const int h = F.lane >> 3, k = k0 + r; const unsigned hi = f2bf(s), lo = f2bf(s - __uint_as_float(hi << 16));
                      bf16* r0 = WgT + ((size_t)b * 256 + h * 16 + n) * 2048; bf16* r1 = WgT + ((size_t)b * 256 + 128 + h * 16 + n) * 2048;
                      r0[k] = (bf16)hi; r0[1024 + k] = (bf16)hi; r1[k] = (bf16)lo; r1[1024 + k] = (bf16)lo; } } } }
        __syncthreads();
    }
}

__device__ __forceinline__ void panel_norm(Frame& F, int pm, const bf16* Y, bf16* H1, float* RSY, const LAS float* part) {
    f32x4 gv[4];
#pragma unroll
    for (int j = 0; j < 4; ++j) gv[j] = *((const f32x4*)F.g_post + F.lane + 64 * j);
    for (int i = 0; i < 8; ++i) {
        v2u yw[4][4]; f32x4 xv[4][4]; float rs[4];
#pragma unroll
        for (int r = 0; r < 4; ++r) { const int rl = F.wave * 32 + 4 * i + r; const size_t row = (size_t)pm * 256 + rl;
            const v2u* yr = (const v2u*)(Y + row * DM) + F.lane; const f32x4* xr = (const f32x4*)(F.x + row * DM) + F.lane;
#pragma unroll
            for (int j = 0; j < 4; ++j) { yw[r][j] = yr[64 * j]; xv[r][j] = xr[64 * j]; }
            const LAS f32x4* pp = (const LAS f32x4*)(part + rl * 16); const f32x4 a = pp[0], b = pp[1], c = pp[2], d = pp[3];
            rs[r] = frsq((((a[0] + a[1]) + (a[2] + a[3])) + ((b[0] + b[1]) + (b[2] + b[3])) + ((c[0] + c[1]) + (c[2] + c[3])) + ((d[0] + d[1]) + (d[2] + d[3]))) * (1.f / DM) + RMS_EPS);
            if (F.lane == 0) RSY[row] = rs[r]; }
#pragma unroll
        for (int r = 0; r < 4; ++r) { const size_t row = (size_t)pm * 256 + F.wave * 32 + 4 * i + r;
#pragma unroll
            for (int j = 0; j < 4; ++j) { const v2u w = yw[r][j]; const float yv[4] = {__uint_as_float(w.x << 16), __uint_as_float(w.x & 0xffff0000u), __uint_as_float(w.y << 16), __uint_as_float(w.y & 0xffff0000u)}; float h[4];
#pragma unroll
                for (int e = 0; e < 4; ++e) h[e] = xv[r][j][e] + yv[e] * rs[r] * gv[j][e];
                *(v2u*)(H1 + row * DM + 4 * F.lane + 256 * j) = (v2u){pk2(h[0], h[1]), pk2(h[2], h[3])}; } }
    }
}

__device__ __forceinline__ void post_norm(Frame& F) {
    const bf16* Y = (const bf16*)(F.ws + WS_RW); float* RSY = (float*)(F.ws + WS_RSY); bf16* H1 = (bf16*)(F.ws + WS_QKVZ);
    const int gw = F.vcu * NWAVES + F.wave, NGW = F.G * NWAVES;
    f32x4 gv[4];
#pragma unroll
    for (int j = 0; j < 4; ++j) gv[j] = *((const f32x4*)F.g_post + F.lane + 64 * j);
    for (int row0 = gw * 4; row0 < M; row0 += NGW * 4) {
        v2u yw[4][4]; f32x4 xv[4][4];
#pragma unroll
        for (int r = 0; r < 4; ++r) { const v2u* yr = (const v2u*)(Y + (size_t)(row0 + r) * DM) + F.lane; const f32x4* xr = (const f32x4*)(F.x + (size_t)(row0 + r) * DM) + F.lane;
#pragma unroll
            for (int j = 0; j < 4; ++j) { yw[r][j] = yr[64 * j]; xv[r][j] = xr[64 * j]; } }
#pragma unroll
        for (int r = 0; r < 4; ++r) { f32x4 v[4]; float s = 0.f;
#pragma unroll
            for (int j = 0; j < 4; ++j) { const v2u w = yw[r][j]; v[j] = (f32x4){__uint_as_float(w.x << 16), __uint_as_float(w.x & 0xffff0000u), __uint_as_float(w.y << 16), __uint_as_float(w.y & 0xffff0000u)}; s += (v[j][0] * v[j][0] + v[j][1] * v[j][1]) + (v[j][2] * v[j][2] + v[j][3] * v[j][3]); }
            const float rs = frsq(wave_sum_fast(s) * (1.f / DM) + RMS_EPS);
            if (F.lane == 0) RSY[row0 + r] = rs;
#pragma unroll
            for (int j = 0; j < 4; ++j) { float h[4];
#pragma unroll
                for (int e = 0; e < 4; ++e) h[e] = xv[r][j][e] + v[j][e] * rs * gv[j][e];
                *(v2u*)(H1 + (size_t)(row0 + r) * DM + 4 * F.lane + 256 * j) = (v2u){pk2(h[0], h[1]), pk2(h[2], h[3])}; } }
    }
}
namespace moba {
using bf16x8 = __attribute__((ext_vector_type(8))) short;
using s16x4 = __attribute__((ext_vector_type(4))) short;
using f32x16 = __attribute__((ext_vector_type(16))) float;
using u32x4 = __attribute__((ext_vector_type(4))) unsigned;
typedef short v4i16_t __attribute__((ext_vector_type(4)));
typedef float f32x2_t __attribute__((ext_vector_type(2))); typedef __bf16 bf16x2_t __attribute__((ext_vector_type(2)));
__device__ __forceinline__ int crow(int r, int hi) { return (r & 3) + 8 * (r >> 2) + 4 * hi; }
__device__ __forceinline__ unsigned cvtpk(float lo, float hi) { f32x2_t v = {lo, hi}; bf16x2_t b = __builtin_convertvector(v, bf16x2_t); return __builtin_bit_cast(unsigned, b); }
__device__ __forceinline__ float max3f(float a, float b, float c) { return fmaxf(fmaxf(a, b), c); }

constexpr int SLOTB = 8192;
__device__ __forceinline__ void qkt(f32x16& p0, f32x16& p1, const LAS unsigned char* Kslot, const bf16x8* qr, int r32, int hi) {
    const LAS unsigned char* kb = Kslot + hi * 1024 + r32 * 16;
    const f32x16 z = {};
#pragma unroll
    for (int d0 = 0; d0 < 4; ++d0) {
        const bf16x8 b0 = *(const LAS bf16x8*)(kb + d0 * 2048);
        const bf16x8 b1 = *(const LAS bf16x8*)(kb + d0 * 2048 + 512);
        if (d0 == 0) { p0 = __builtin_amdgcn_mfma_f32_32x32x16_bf16(b0, qr[0], z, 0, 0, 0); p1 = __builtin_amdgcn_mfma_f32_32x32x16_bf16(b1, qr[0], z, 0, 0, 0); }
        else { p0 = __builtin_amdgcn_mfma_f32_32x32x16_bf16(b0, qr[d0], p0, 0, 0, 0); p1 = __builtin_amdgcn_mfma_f32_32x32x16_bf16(b1, qr[d0], p1, 0, 0, 0); } }
}
__device__ __forceinline__ void qkt_acc(f32x16& p0, f32x16& p1, const LAS unsigned char* Kslot, const bf16x8* qr, int r32, int hi) {
    const LAS unsigned char* kb = Kslot + hi * 1024 + r32 * 16;
#pragma unroll
    for (int d0 = 0; d0 < 4; ++d0) {
        const bf16x8 b0 = *(const LAS bf16x8*)(kb + d0 * 2048);
        const bf16x8 b1 = *(const LAS bf16x8*)(kb + d0 * 2048 + 512);
        p0 = __builtin_amdgcn_mfma_f32_32x32x16_bf16(b0, qr[d0], p0, 0, 0, 0); p1 = __builtin_amdgcn_mfma_f32_32x32x16_bf16(b1, qr[d0], p1, 0, 0, 0); }
}
__device__ __forceinline__ void pv(f32x16* o, int vb, bf16x8 pa0, bf16x8 pa1, bf16x8 pa2, bf16x8 pa3) {
#pragma unroll
    for (int d0 = 0; d0 < 2; ++d0) { s16x4 lo[4], hi[4];
#pragma unroll
        for (int ks = 0; ks < 4; ++ks) {
            asm volatile("ds_read_b64_tr_b16 %0,%1 offset:%c2" : "=&v"(lo[ks]) : "v"(vb), "i"(d0 * 4096 + ks * 1024) : "memory");
            asm volatile("ds_read_b64_tr_b16 %0,%1 offset:%c2" : "=&v"(hi[ks]) : "v"(vb), "i"(d0 * 4096 + ks * 1024 + 512) : "memory"); }
        asm volatile("s_waitcnt lgkmcnt(0)" ::: "memory"); __builtin_amdgcn_sched_barrier(0);
#define PK(k) (bf16x8){lo[k][0], lo[k][1], lo[k][2], lo[k][3], hi[k][0], hi[k][1], hi[k][2], hi[k][3]}
        o[d0] = __builtin_amdgcn_mfma_f32_32x32x16_bf16(pa0, PK(0), o[d0], 0, 0, 0);
        o[d0] = __builtin_amdgcn_mfma_f32_32x32x16_bf16(pa1, PK(1), o[d0], 0, 0, 0);
        o[d0] = __builtin_amdgcn_mfma_f32_32x32x16_bf16(pa2, PK(2), o[d0], 0, 0, 0);
        o[d0] = __builtin_amdgcn_mfma_f32_32x32x16_bf16(pa3, PK(3), o[d0], 0, 0, 0);
#undef PK
    }
}
__device__ __forceinline__ float rowmax2(const f32x16& p0, const f32x16& p1, float a) {
#pragma unroll
    for (int r = 0; r < 16; r += 2) { a = max3f(a, p0[r], p0[r + 1]); a = max3f(a, p1[r], p1[r + 1]); }
    return a;
}
__device__ __forceinline__ float swapmax(float m) { auto rr = __builtin_amdgcn_permlane32_swap(__float_as_uint(m), __float_as_uint(m), false, false); return fmaxf(__uint_as_float(rr[0]), __uint_as_float(rr[1])); }
__device__ __forceinline__ float swapsum(float m) { auto rr = __builtin_amdgcn_permlane32_swap(__float_as_uint(m), __float_as_uint(m), false, false); return __uint_as_float(rr[0]) + __uint_as_float(rr[1]); }

__device__ __forceinline__ void load_kv_block(LAS unsigned char* lds, int KOFF, int VOFF, const bf16* QKVZ, size_t krow0, int h, int wid, int lane) {
    const bf16* ksrc = QKVZ + (krow0 + lane) * QP + 512 + h * HD + wid * 8;
    const bf16* vsrc = QKVZ + (krow0 + 16 * (wid & 3) + (lane >> 2)) * QP + 1024 + h * HD + (wid >> 2) * 32 + (lane & 3) * 8;
#pragma unroll
    for (int t = 0; t < 4; ++t) {
        __builtin_amdgcn_global_load_lds((const unsigned*)(ksrc + (size_t)t * 64 * QP), (LAS unsigned*)(lds + KOFF + t * SLOTB + wid * 1024), 16, 0, 0);
        __builtin_amdgcn_global_load_lds((const unsigned*)(vsrc + (size_t)t * 64 * QP), (LAS unsigned*)(lds + VOFF + t * SLOTB + wid * 1024), 16, 0, 0); }
}
}

constexpr int LIST_CAP = 3840;

__device__ __forceinline__ void attn_select(Frame& F, const float* GATE, unsigned* CNT, unsigned short* LISTS) {
    const int gw = F.vcu * NWAVES + F.wave, NGW = F.G * NWAVES;
    for (int it = gw; it < BATCH * NH * (SEQ / 64); it += NGW) {
        const int sg = it % (SEQ / 64), h = (it / (SEQ / 64)) % NH, b = it / (SEQ / 64 * NH);
        const int s = sg * 64 + F.lane, qb = s >> 8; const size_t row = (size_t)b * SEQ + s;
        if (qb == 0) continue;
        float g0 = -INFINITY, g1 = -INFINITY, g2 = -INFINITY; int i0 = -1, i1 = -1, i2 = -1;
        const f32x4* gp = (const f32x4*)(GATE + row * 256 + h * 16); const f32x4* gl = (const f32x4*)(GATE + row * 256 + 128 + h * 16);
#pragma unroll
        for (int c = 0; c < 4; ++c) { const f32x4 a = gp[c], l = gl[c];
#pragma unroll
            for (int e = 0; e < 4; ++e) { const int n = c * 4 + e; const float g = (n < qb) ? a[e] + l[e] : -INFINITY;
                if (g > g0) { g2 = g1; i2 = i1; g1 = g0; i1 = i0; g0 = g; i0 = n; } else if (g > g1) { g2 = g1; i2 = i1; g1 = g; i1 = n; } else if (g > g2) { g2 = g; i2 = n; } } }
        unsigned* cnt = CNT + (b * NH + h) * 16; unsigned short* lst = LISTS + (size_t)(b * NH + h) * 16 * LIST_CAP;
        int r0 = 0, r1 = 0, r2 = 0; unsigned mycnt = 0u;
        for (int n = 0; n < qb; ++n) {
            const bool pick = (i0 == n) | (i1 == n) | (i2 == n);
            const unsigned long long mask = __ballot(pick);
            const int before = __builtin_amdgcn_mbcnt_hi((unsigned)(mask >> 32), __builtin_amdgcn_mbcnt_lo((unsigned)mask, 0u));
            if (i0 == n) r0 = before; if (i1 == n) r1 = before; if (i2 == n) r2 = before;
            if (F.lane == n) mycnt = (unsigned)__popcll(mask);
        }
        unsigned base = 0u;
        if (F.lane < qb && mycnt) base = atomicAdd(cnt + F.lane, mycnt);
        const unsigned b0 = __shfl(base, i0 < 0 ? 0 : i0), b1 = __shfl(base, i1 < 0 ? 0 : i1), b2 = __shfl(base, i2 < 0 ? 0 : i2);
        if (i0 >= 0) lst[(size_t)i0 * LIST_CAP + b0 + r0] = (unsigned short)(s | (0 << 12));
        if (i1 >= 0) lst[(size_t)i1 * LIST_CAP + b1 + r1] = (unsigned short)(s | (1 << 12));
        if (i2 >= 0) lst[(size_t)i2 * LIST_CAP + b2 + r2] = (unsigned short)(s | (2 << 12));
    }
}

__device__ __forceinline__ void attn_partial(Frame& F, const bf16* QKVZ, const unsigned* CNT, const unsigned short* LISTS, bf16* PART_O, float* PART_ML, unsigned* QCTR) {
    using namespace moba;
    LAS unsigned char* lds = F.lds; const int wid = F.wave, lane = F.lane, r32 = lane & 31, hi = lane >> 5;
    LAS float* btab = (LAS float*)(lds + 102400); LAS unsigned* uword = (LAS unsigned*)(lds + 106496); LAS unsigned short* llist = (LAS unsigned short*)(lds + 106624);
    LAS float* wsf = (LAS float*)(lds + 98304) + wid * 128; LAS bf16* stg = (LAS bf16*)(lds + 65536) + wid * 2048;
    for (int i = F.tid; i < NH * 128; i += NTHR) { const int h = i >> 7, d = i & 127; btab[i] = (F.rel_bias[T5B[d] * NH + h] - F.rel_bias[31 * NH + h]) * LOG2E; }
    const int vb0 = (int)(uintptr_t)(lds + 32768) + ((lane >> 4) & 1) * 32 + (lane & 3) * 8 + (4 * hi + ((lane & 15) >> 2)) * 64;
    const int NUNIT = BATCH * NH * 15;
    for (;;) {
        __syncthreads();
        if (F.tid == 0) uword[0] = atomicAdd(QCTR, 1u);
        __syncthreads();
        const int u = (int)uword[0];
        if (u >= NUNIT) break;
        const int n = u / (BATCH * NH), bh = u % (BATCH * NH), b = bh / NH, h = bh % NH;
        load_kv_block(lds, 0, 32768, QKVZ, (size_t)b * SEQ + n * BLK, h, wid, lane);
        const int cnt = (int)CNT[bh * 16 + n]; const unsigned short* lst = LISTS + ((size_t)bh * 16 + n) * LIST_CAP;
        for (int i = F.tid; i < (cnt + 1) / 2; i += NTHR) ((LAS unsigned*)llist)[i] = ((const unsigned*)lst)[i];
        const float b31 = F.rel_bias[31 * NH + h] * LOG2E;
        __syncthreads();
        const int ntile = (cnt + 31) >> 5;
        bf16x8 qn[4]; int tile = wid;
        if (tile < ntile) { const int idx = tile * 32 + r32; const unsigned e = llist[idx < cnt ? idx : 0]; const size_t row = (size_t)b * SEQ + (e & 4095);
#pragma unroll
            for (int d0 = 0; d0 < 4; ++d0) qn[d0] = *(const bf16x8*)(QKVZ + row * QP + h * HD + d0 * 16 + hi * 8); }
        for (; tile < ntile; tile += NWAVES) {
            int lane_ = F.tid; asm volatile("" : "+v"(lane_)); lane_ &= 63;
            const int lane = lane_, r32 = lane & 31, hi = lane >> 5;
            const int vb0 = (int)(uintptr_t)(lds + 32768) + ((lane >> 4) & 1) * 32 + (lane & 3) * 8 + (4 * hi + ((lane & 15) >> 2)) * 64;
            const int idx = tile * 32 + r32; const bool valid = idx < cnt;
            const unsigned e = llist[valid ? idx : 0]; const int s = e & 4095, slot = e >> 12; const size_t row = (size_t)b * SEQ + s;
            bf16x8 qr[4];
#pragma unroll
            for (int d0 = 0; d0 < 4; ++d0) qr[d0] = qn[d0];
            if (tile + NWAVES < ntile) { const int idx2 = (tile + NWAVES) * 32 + r32; const unsigned e2 = llist[idx2 < cnt ? idx2 : 0]; const size_t row2 = (size_t)b * SEQ + (e2 & 4095);
#pragma unroll
                for (int d0 = 0; d0 < 4; ++d0) qn[d0] = *(const bf16x8*)(QKVZ + row2 * QP + h * HD + d0 * 16 + hi * 8); }
            f32x16 o[2]; o[0] = f32x16{}; o[1] = f32x16{};
            float mx = -INFINITY, l = 0.f;
            const bool near = ((s >> 8) == n + 1);
            const int dbase = near ? (s - (n * BLK + 128)) : 100000;
#pragma unroll
            for (int half = 0; half < 2; ++half) {
                if (half) __builtin_amdgcn_sched_barrier(0);
                f32x16 p[2][2];
                if (half == 1) {
#pragma unroll
                    for (int t = 0; t < 2; ++t)
#pragma unroll
                        for (int r = 0; r < 16; ++r) { const int kv = t * 64 + crow(r, hi); int d0 = dbase - kv, d1 = d0 - 32; d0 = d0 > 127 ? 127 : d0; d1 = d1 > 127 ? 127 : d1;
                            p[t][0][r] = btab[h * 128 + d0]; p[t][1][r] = btab[h * 128 + d1]; }
                } else { p[0][0] = f32x16{}; p[0][1] = f32x16{}; p[1][0] = f32x16{}; p[1][1] = f32x16{}; }
#pragma unroll
                for (int t = 0; t < 2; ++t) qkt_acc(p[t][0], p[t][1], lds + (2 * half + t) * SLOTB, qr, r32, hi);
                float m2 = rowmax2(p[0][0], p[0][1], mx); m2 = rowmax2(p[1][0], p[1][1], m2); m2 = swapmax(m2);
                const float f = fexp2(mx - m2); l *= f; mx = m2;
                if (half == 1) {
                    if (hi == 0) wsf[64 + r32] = f;
                    asm volatile("s_waitcnt lgkmcnt(0)" ::: "memory");
#pragma unroll
                    for (int r = 0; r < 16; ++r) { const float fr_ = wsf[64 + crow(r, hi)]; o[0][r] *= fr_; o[1][r] *= fr_; } }
#pragma unroll
                for (int t = 0; t < 2; ++t) {
#pragma unroll
                    for (int r = 0; r < 16; ++r) { p[t][0][r] = fexp2(p[t][0][r] - mx); p[t][1][r] = fexp2(p[t][1][r] - mx); l += p[t][0][r] + p[t][1][r]; }
                    u32x4 w0, w1, w2, w3;
                    w0 = (u32x4){cvtpk(p[t][0][0], p[t][0][1]), cvtpk(p[t][0][2], p[t][0][3]), cvtpk(p[t][0][4], p[t][0][5]), cvtpk(p[t][0][6], p[t][0][7])};
                    w1 = (u32x4){cvtpk(p[t][0][8], p[t][0][9]), cvtpk(p[t][0][10], p[t][0][11]), cvtpk(p[t][0][12], p[t][0][13]), cvtpk(p[t][0][14], p[t][0][15])};
                    w2 = (u32x4){cvtpk(p[t][1][0], p[t][1][1]), cvtpk(p[t][1][2], p[t][1][3]), cvtpk(p[t][1][4], p[t][1][5]), cvtpk(p[t][1][6], p[t][1][7])};
                    w3 = (u32x4){cvtpk(p[t][1][8], p[t][1][9]), cvtpk(p[t][1][10], p[t][1][11]), cvtpk(p[t][1][12], p[t][1][13]), cvtpk(p[t][1][14], p[t][1][15])};
                    pv(o, vb0 + (2 * half + t) * SLOTB, __builtin_bit_cast(bf16x8, w0), __builtin_bit_cast(bf16x8, w1), __builtin_bit_cast(bf16x8, w2), __builtin_bit_cast(bf16x8, w3)); }
            }
            __builtin_amdgcn_sched_barrier(0);
            l = swapsum(l);
            if (hi == 0) { wsf[r32] = frcp(l); ((LAS int*)wsf)[32 + r32] = valid ? (int)(((row * NH + h) * 3 + slot)) : -1;
                           if (valid) { float2 ml; ml.x = mx + b31; ml.y = l; *(float2*)(PART_ML + ((row * NH + h) * 3 + slot) * 2) = ml; } }
            asm volatile("s_waitcnt lgkmcnt(0)" ::: "memory");
#pragma unroll
            for (int r = 0; r < 16; ++r) { const int orow = crow(r, hi); const float il = wsf[orow];
#pragma unroll
                for (int d0 = 0; d0 < 2; ++d0) stg[orow * 64 + d0 * 32 + r32] = (bf16)f2bf(o[d0][r] * il); }
            asm volatile("s_waitcnt lgkmcnt(0)" ::: "memory");
#pragma unroll
            for (int i = 0; i < 4; ++i) { const int rr = i * 8 + (lane >> 3), ch = lane & 7; const int dst = ((LAS int*)wsf)[32 + rr];
                const u32x4 v = *(const LAS u32x4*)(stg + rr * 64 + ch * 8);
                if (dst >= 0) *(u32x4*)(PART_O + (size_t)dst * 64 + ch * 8) = v; }
            asm volatile("s_waitcnt lgkmcnt(0)" ::: "memory");
        }
    }
}

__device__ __forceinline__ void attn_own_combine(Frame& F, bf16* QKVZ, const bf16* PART_O, const float* PART_ML, bf16* OUTB, int out_pitch) {
    using namespace moba;
    LAS unsigned char* lds = F.lds; const int wid = F.wave, lane = F.lane, r32 = lane & 31, hi = lane >> 5;
    LAS float* btab = (LAS float*)(lds + 139264);
    LAS float* wsf = (LAS float*)(lds + 135168) + wid * 128; LAS float* ost = (LAS float*)(lds + 65536 + wid * 8704);
    __syncthreads();
    for (int i = F.tid; i < NH * 256; i += NTHR) { const int h = i >> 8, d = i & 255; btab[i] = F.rel_bias[T5B[d < 127 ? d : 127] * NH + h] * LOG2E; }
    const int vb0 = (int)(uintptr_t)(lds + 32768) + ((lane >> 4) & 1) * 32 + (lane & 3) * 8 + (4 * hi + ((lane & 15) >> 2)) * 64;
    for (int u = F.vcu; u < BATCH * NH * NBLK; u += F.G) {
        const int qb = u % NBLK, bh = u / NBLK, b = bh / NH, h = bh % NH;
        __syncthreads();
        load_kv_block(lds, 0, 32768, QKVZ, (size_t)b * SEQ + qb * BLK, h, wid, lane);
        const int sq = qb * BLK + wid * 32 + r32; const size_t row = (size_t)b * SEQ + sq;
        bf16x8 qr[4];
#pragma unroll
        for (int d0 = 0; d0 < 4; ++d0) qr[d0] = *(const bf16x8*)(QKVZ + row * QP + h * HD + d0 * 16 + hi * 8);
        __syncthreads();
        const int nt = (wid >> 1) + 1;
        int ql = wid * 32 + r32;
        asm volatile("" : "+v"(ql));
        const LAS float* bt = btab + h * 256;
        float mx = -INFINITY;
#define A2_SCORES(P0, P1, t) do { qkt(P0, P1, lds + (t) * SLOTB, qr, r32, hi); \
            if ((t) < nt - 1) { _Pragma("unroll") for (int r = 0; r < 16; ++r) { const int kv = (t) * 64 + crow(r, hi); const int d0 = ql - kv, d1 = d0 - 32; P0[r] += bt[d0]; P1[r] += bt[d1]; } } \
            else { _Pragma("unroll") for (int r = 0; r < 16; ++r) { const int kv = (t) * 64 + crow(r, hi); const int d0 = ql - kv, d1 = d0 - 32; const float b0 = bt[d0 < 0 ? 0 : d0], b1 = bt[d1 < 0 ? 0 : d1]; \
                P0[r] = d0 >= 0 ? P0[r] + b0 : -INFINITY; P1[r] = d1 >= 0 ? P1[r] + b1 : -INFINITY; } } } while (0)
#pragma unroll 1
        for (int t = 0; t < nt; ++t) { f32x16 p0, p1; A2_SCORES(p0, p1, t); mx = rowmax2(p0, p1, mx); }
        mx = swapmax(mx);
        float l = 0.f;
        f32x16 o[2]; o[0] = f32x16{}; o[1] = f32x16{};
#pragma unroll 1
        for (int t = 0; t < nt; ++t) { f32x16 p0, p1; A2_SCORES(p0, p1, t);
#pragma unroll
            for (int r = 0; r < 16; ++r) { p0[r] = fexp2(p0[r] - mx); p1[r] = fexp2(p1[r] - mx); l += p0[r] + p1[r]; }
            u32x4 w0, w1, w2, w3;
            w0 = (u32x4){cvtpk(p0[0], p0[1]), cvtpk(p0[2], p0[3]), cvtpk(p0[4], p0[5]), cvtpk(p0[6], p0[7])};
            w1 = (u32x4){cvtpk(p0[8], p0[9]), cvtpk(p0[10], p0[11]), cvtpk(p0[12], p0[13]), cvtpk(p0[14], p0[15])};
            w2 = (u32x4){cvtpk(p1[0], p1[1]), cvtpk(p1[2], p1[3]), cvtpk(p1[4], p1[5]), cvtpk(p1[6], p1[7])};
            w3 = (u32x4){cvtpk(p1[8], p1[9]), cvtpk(p1[10], p1[11]), cvtpk(p1[12], p1[13]), cvtpk(p1[14], p1[15])};
            pv(o, vb0 + t * SLOTB, __builtin_bit_cast(bf16x8, w0), __builtin_bit_cast(bf16x8, w1), __builtin_bit_cast(bf16x8, w2), __builtin_bit_cast(bf16x8, w3));
        }
#undef A2_SCORES
        l = swapsum(l);
        if (hi == 0) { wsf[r32] = mx; wsf[32 + r32] = l; }
#pragma unroll
        for (int r = 0; r < 16; ++r) { const int orow = crow(r, hi);
#pragma unroll
            for (int d0 = 0; d0 < 2; ++d0) ost[orow * 68 + d0 * 32 + r32] = o[d0][r]; }
        asm volatile("s_waitcnt lgkmcnt(0)" ::: "memory");
        { const int q = lane >> 1, c0 = (lane & 1) * 32; const int s2 = qb * BLK + wid * 32 + q; const size_t row2 = (size_t)b * SEQ + s2;
          const float m0 = wsf[q], l0 = wsf[32 + q]; const int np = qb < 3 ? qb : 3;
          float mj[3], lj[3]; float mt = m0;
#pragma unroll
          for (int j = 0; j < 3; ++j) { if (j < np) { const float2 ml = *(const float2*)(PART_ML + ((row2 * NH + h) * 3 + j) * 2); mj[j] = ml.x; lj[j] = ml.y; mt = fmaxf(mt, ml.x); } else { mj[j] = -INFINITY; lj[j] = 0.f; } }
          const float w0 = fexp2(m0 - mt); float wj[3]; float den = w0 * l0;
#pragma unroll
          for (int j = 0; j < 3; ++j) { wj[j] = (j < np) ? fexp2(mj[j] - mt) * lj[j] : 0.f; den += wj[j]; }
          const float iden = frcp(den);
          float acc[32];
#pragma unroll
          for (int c = 0; c < 32; c += 4) { const f32x4 v = *(const LAS f32x4*)(ost + q * 68 + c0 + c); acc[c] = v[0] * w0; acc[c + 1] = v[1] * w0; acc[c + 2] = v[2] * w0; acc[c + 3] = v[3] * w0; }
#pragma unroll
          for (int j = 0; j < 3; ++j) if (j < np) { const v4u* pp = (const v4u*)(PART_O + ((row2 * NH + h) * 3 + j) * 64 + c0);
#pragma unroll
              for (int c = 0; c < 4; ++c) { const v4u w = pp[c]; const float f = wj[j];
                  acc[c * 8 + 0] += f * __uint_as_float(w.x << 16); acc[c * 8 + 1] += f * __uint_as_float(w.x & 0xffff0000u); acc[c * 8 + 2] += f * __uint_as_float(w.y << 16); acc[c * 8 + 3] += f * __uint_as_float(w.y & 0xffff0000u);
                  acc[c * 8 + 4] += f * __uint_as_float(w.z << 16); acc[c * 8 + 5] += f * __uint_as_float(w.z & 0xffff0000u); acc[c * 8 + 6] += f * __uint_as_float(w.w << 16); acc[c * 8 + 7] += f * __uint_as_float(w.w & 0xffff0000u); } }
          const v4u* zp = (const v4u*)(QKVZ + row2 * QP + 1536 + h * HD + c0);
          asm volatile("s_waitcnt lgkmcnt(0)" ::: "memory");
#pragma unroll
          for (int c = 0; c < 4; ++c) { const v4u w = zp[c]; const float z[8] = {__uint_as_float(w.x << 16), __uint_as_float(w.x & 0xffff0000u), __uint_as_float(w.y << 16), __uint_as_float(w.y & 0xffff0000u),
                                                                               __uint_as_float(w.z << 16), __uint_as_float(w.z & 0xffff0000u), __uint_as_float(w.w << 16), __uint_as_float(w.w & 0xffff0000u)};
              float rr[8];
#pragma unroll
              for (int e2 = 0; e2 < 8; ++e2) rr[e2] = acc[c * 8 + e2] * iden * z[e2] * sigm(z[e2]);
              v4u ow; ow.x = pk2(rr[0], rr[1]); ow.y = pk2(rr[2], rr[3]); ow.z = pk2(rr[4], rr[5]); ow.w = pk2(rr[6], rr[7]); *(LAS v4u*)((LAS bf16*)ost + q * 72 + c0 + c * 8) = ow; }
          asm volatile("s_waitcnt lgkmcnt(0)" ::: "memory");
#pragma unroll
          for (int i = 0; i < 4; ++i) { const int rr = i * 8 + (lane >> 3), chk = lane & 7; const v4u w = *(const LAS v4u*)((LAS bf16*)ost + rr * 72 + chk * 8);
              *(v4u*)(OUTB + ((size_t)b * SEQ + qb * BLK + wid * 32 + rr) * out_pitch + h * HD + chk * 8) = w; } }
        asm volatile("s_waitcnt lgkmcnt(0)" ::: "memory");
    }
}
namespace rk {
using bf16x8 = __attribute__((ext_vector_type(8))) short;
using s16x4 = __attribute__((ext_vector_type(4))) short;
using f32x16 = __attribute__((ext_vector_type(16))) float;
using u32x4 = __attribute__((ext_vector_type(4))) unsigned;
using u32x2 = __attribute__((ext_vector_type(2))) unsigned;
typedef short v4i16_t __attribute__((ext_vector_type(4)));
typedef float f32x2_t __attribute__((ext_vector_type(2))); typedef __bf16 bf16x2_t __attribute__((ext_vector_type(2)));
constexpr int P = 144, IMG = 64 * P, GRP = 81920, MISC = 8 * IMG;
#define RK_MFMA(a, b, c) __builtin_amdgcn_mfma_f32_32x32x16_bf16((a), (b), (c), 0, 0, 0)
__device__ __forceinline__ int crow(int r, int hi) { return (r & 3) + 8 * (r >> 2) + 4 * hi; }
__device__ __forceinline__ unsigned cvtpk(float lo, float hi) { f32x2_t v = {lo, hi}; bf16x2_t b = __builtin_convertvector(v, bf16x2_t); return __builtin_bit_cast(unsigned, b); }
__device__ __forceinline__ float bflo(unsigned w) { return __uint_as_float(w << 16); }
__device__ __forceinline__ float bfhi(unsigned w) { return __uint_as_float(w & 0xffff0000u); }
__device__ __forceinline__ s16x4 trrd(const LAS unsigned char* p) { return __builtin_bit_cast(s16x4, __builtin_amdgcn_ds_read_tr16_b64_v4i16((LAS v4i16_t*)p)); }
struct Ln { int r, h, blk, q, p; };
__device__ __forceinline__ bf16x8 frag_row(const LAS unsigned char* img, const Ln& l, int tile, int s, int coloff = 0) { return *(const LAS bf16x8*)(img + (32 * tile + l.r) * P + (coloff + 16 * s + 8 * l.h) * 2); }
__device__ __forceinline__ bf16x8 frag_tr(const LAS unsigned char* img, const Ln& l, int tile, int s, int rowoff = 0) {
    const LAS unsigned char* b = img + (rowoff + 16 * s + 8 * l.h + l.q) * P + 64 * tile + 32 * l.blk + 8 * l.p;
    const s16x4 lo = trrd(b), hi = trrd(b + 4 * P);
    return (bf16x8){lo[0], lo[1], lo[2], lo[3], hi[0], hi[1], hi[2], hi[3]};
}
__device__ __forceinline__ bf16x8 frag_row_perm(const LAS unsigned char* img, const Ln& l, int tile, int s, int coloff = 0) {
    const LAS unsigned char* b = img + (32 * tile + l.r) * P + (coloff + 16 * s + 4 * l.h) * 2;
    const s16x4 lo = *(const LAS s16x4*)b, hi = *(const LAS s16x4*)(b + 16);
    return (bf16x8){lo[0], lo[1], lo[2], lo[3], hi[0], hi[1], hi[2], hi[3]};
}
__device__ __forceinline__ bf16x8 frag_tr_perm(const LAS unsigned char* img, const Ln& l, int tile, int s, int rowoff = 0) {
    const LAS unsigned char* b = img + (rowoff + 16 * s + 4 * l.h + l.q) * P + 64 * tile + 32 * l.blk + 8 * l.p;
    const s16x4 lo = trrd(b), hi = trrd(b + 8 * P);
    return (bf16x8){lo[0], lo[1], lo[2], lo[3], hi[0], hi[1], hi[2], hi[3]};
}
__device__ __forceinline__ bf16x8 pack(const f32x16& x, int s) {
    u32x4 w; w.x = cvtpk(x[8 * s], x[8 * s + 1]); w.y = cvtpk(x[8 * s + 2], x[8 * s + 3]); w.z = cvtpk(x[8 * s + 4], x[8 * s + 5]); w.w = cvtpk(x[8 * s + 6], x[8 * s + 7]);
    return __builtin_bit_cast(bf16x8, w);
}
__device__ __forceinline__ void store_T(LAS unsigned char* img, const Ln& l, const f32x16& x, int ti, int tj) {
#pragma unroll
    for (int g = 0; g < 4; ++g) { u32x2 w; w.x = cvtpk(x[4 * g], x[4 * g + 1]); w.y = cvtpk(x[4 * g + 2], x[4 * g + 3]);
        *(LAS u32x2*)(img + (32 * tj + l.r) * P + (32 * ti + 8 * g + 4 * l.h) * 2) = w; }
}
__device__ __forceinline__ float xhalf(float v) { return __shfl_xor(v, 32); }
__device__ __forceinline__ void tri_inv32(f32x16& D, f32x16& DT, f32x16 S, f32x16 ST) {
    const f32x16 z = {};
#pragma unroll
    for (int it = 0; it < 4; ++it) {
        f32x16 S2 = z, S2T = z;
#pragma unroll
        for (int s = 0; s < 2; ++s) { const bf16x8 ps = pack(S, s), pst = pack(ST, s); S2 = RK_MFMA(pst, ps, S2); S2T = RK_MFMA(ps, pst, S2T); }
        f32x16 DS = S2, DST = S2T;
#pragma unroll
        for (int s = 0; s < 2; ++s) { DS = RK_MFMA(pack(DT, s), pack(S2, s), DS); DST = RK_MFMA(pack(S2, s), pack(DT, s), DST); }
        D = D + DS; DT = DT + DST; S = S2; ST = S2T;
    }
}
}

constexpr size_t DO_NT = 0, DO_MT = 128 * MiB, DO_RH = 192 * MiB;

struct R1Ctx { int item, c, h, b; rk::f32x16 Wt0, Wt1; };
#define RK_RELANE() do { int t_ = F.tid; asm volatile("" : "+v"(t_)); lane = t_ & 63; tg = t_ & 255; grp = t_ >> 8; w4 = (t_ >> 6) & 3; ti = w4 >> 1; tj = w4 & 1; l.r = lane & 31; l.h = lane >> 5; l.blk = (lane >> 4) & 1; l.q = (lane & 15) >> 2; l.p = lane & 3; G = F.lds + grp * GRP; } while (0)
#define RK_KA() const __attribute__((address_space(4))) Args* ka = (const __attribute__((address_space(4))) Args*)__builtin_amdgcn_kernarg_segment_ptr(); asm volatile("" : "+s"(ka))
#define s0 (G)
#define s1 (G + IMG)
#define s2 (G + 2 * IMG)
#define s3 (G + 3 * IMG)
#define s4 (G + 4 * IMG)
#define s5 (G + 5 * IMG)
#define s6 (G + 6 * IMG)
#define s7 (G + 7 * IMG)
#define nrminv ((LAS float*)(G + MISC))
#define ltot (nrminv + 64)
#define gam (nrminv + 128)
#define bonp (nrminv + 192)
__device__ __forceinline__ void r1_S1a(Frame& F, R1Ctx& X) {
    using namespace rk;
    int grp, w4, ti, tj, lane, tg; Ln l; LAS unsigned char* G; const f32x16 z16 = {};
    RK_RELANE(); (void)w4; (void)tg; (void)ti; (void)tj;
    const int item = X.item, c = X.c, h = X.h, b = X.b; (void)item; (void)c; (void)h; (void)b;
    { RK_KA(); const bf16* RW = (const bf16*)(ka->ws + WS_RW); const float* mu_ = ka->in[5]; const float* kk_ = ka->in[10];
      const int t = tg >> 2, q4 = tg & 3; const int sq = c * 64 + t; const size_t row = (size_t)b * SEQ + sq;
      const bf16* cur = RW + row * RWC; const bool hasp = sq > 0; const bf16* prv = hasp ? cur - RWC : cur; const float pm = hasp ? 1.f : 0.f;
      float nr = 0.f;
#pragma unroll
      for (int half = 0; half < 2; ++half) { const int k0 = 16 * q4 + 8 * half, col = h * HD + k0;
          const v4u cr = *(const v4u*)(cur + col), pr = *(const v4u*)(prv + col), ck = *(const v4u*)(cur + 512 + col), pk = *(const v4u*)(prv + 512 + col), cv = *(const v4u*)(cur + 1024 + col), pv = *(const v4u*)(prv + 1024 + col);
          const v4u cw = *(const v4u*)(cur + 2048 + k0), pw = *(const v4u*)(prv + 2048 + k0), ca = *(const v4u*)(cur + 2112 + k0), pa = *(const v4u*)(prv + 2112 + k0); const v4u cz = *(const v4u*)(cur + 1536 + col), pz = *(const v4u*)(prv + 1536 + col);
          float ro[8], ko[8], vo[8], wo[8], ao[8], zo[8];
#pragma unroll
          for (int e = 0; e < 8; ++e) { const unsigned wcr = cr[e >> 1], wpr = pr[e >> 1], wck = ck[e >> 1], wpk = pk[e >> 1], wcv = cv[e >> 1], wpv = pv[e >> 1];
              const unsigned wcw = cw[e >> 1], wpw = pw[e >> 1], wca = ca[e >> 1], wpa = pa[e >> 1];
              const float xr = (e & 1) ? bfhi(wcr) : bflo(wcr), yr = pm * ((e & 1) ? bfhi(wpr) : bflo(wpr)); ro[e] = xr + (yr - xr) * mu_[col + e];
              const float xk = (e & 1) ? bfhi(wck) : bflo(wck), yk = pm * ((e & 1) ? bfhi(wpk) : bflo(wpk)); ko[e] = xk + (yk - xk) * mu_[512 + col + e];
              const float xv = (e & 1) ? bfhi(wcv) : bflo(wcv), yv = pm * ((e & 1) ? bfhi(wpv) : bflo(wpv)); vo[e] = xv + (yv - xv) * mu_[1024 + col + e];
              const float xw = (e & 1) ? bfhi(wcw) : bflo(wcw), yw = pm * ((e & 1) ? bfhi(wpw) : bflo(wpw)); wo[e] = ftanh(xw + (yw - xw) * mu_[2048 + k0 + e]);
              const float xa = (e & 1) ? bfhi(wca) : bflo(wca), ya = pm * ((e & 1) ? bfhi(wpa) : bflo(wpa)); ao[e] = xa + (ya - xa) * mu_[2112 + k0 + e];
              { const unsigned wcz = cz[e >> 1], wpz = pz[e >> 1]; const float xz = (e & 1) ? bfhi(wcz) : bflo(wcz), yz = pm * ((e & 1) ? bfhi(wpz) : bflo(wpz)); const float zz = xz + (yz - xz) * mu_[1536 + col + e]; zo[e] = zz * sigm(zz); }
              const float kkx = ko[e] * kk_[col + e]; nr += kkx * kkx; }
          const int off = t * P + k0 * 2;
          *(LAS u32x4*)(s0 + off) = (u32x4){cvtpk(wo[0], wo[1]), cvtpk(wo[2], wo[3]), cvtpk(wo[4], wo[5]), cvtpk(wo[6], wo[7])};
          *(LAS u32x4*)(s1 + off) = (u32x4){cvtpk(ao[0], ao[1]), cvtpk(ao[2], ao[3]), cvtpk(ao[4], ao[5]), cvtpk(ao[6], ao[7])};
          *(LAS u32x4*)(s2 + off) = (u32x4){cvtpk(ro[0], ro[1]), cvtpk(ro[2], ro[3]), cvtpk(ro[4], ro[5]), cvtpk(ro[6], ro[7])};
          *(LAS u32x4*)(s3 + off) = (u32x4){cvtpk(ko[0], ko[1]), cvtpk(ko[2], ko[3]), cvtpk(ko[4], ko[5]), cvtpk(ko[6], ko[7])};
          const u32x4 vw = (u32x4){cvtpk(vo[0], vo[1]), cvtpk(vo[2], vo[3]), cvtpk(vo[4], vo[5]), cvtpk(vo[6], vo[7])};
          *(LAS u32x4*)(s4 + off) = vw;
          bf16* qz = (bf16*)(ka->ws + WS_QKVZ) + row * QP + col;
          *(u32x4*)(qz + 1024) = vw; *(u32x4*)(qz + 1536) = (u32x4){cvtpk(zo[0], zo[1]), cvtpk(zo[2], zo[3]), cvtpk(zo[4], zo[5]), cvtpk(zo[6], zo[7])}; }
      nr += __shfl_xor(nr, 1); nr += __shfl_xor(nr, 2);
      if (q4 == 0) nrminv[t] = frsq(fmaxf(nr, 1e-24f)); }
}
__device__ __forceinline__ void r1_S1b(Frame& F, R1Ctx& X) {
    using namespace rk;
    int grp, w4, ti, tj, lane, tg; Ln l; LAS unsigned char* G; const f32x16 z16 = {};
    RK_RELANE(); (void)w4; (void)tg; (void)ti; (void)tj;
    const int item = X.item, c = X.c, h = X.h, b = X.b; (void)item; (void)c; (void)h; (void)b;
    {
        RK_KA(); const bf16* WupT = (const bf16*)(ka->ws + WS_WUPT); const bf16* AupT = (const bf16*)(ka->ws + WS_AUPT);
        const int kcol = 32 * tj + l.r, kc = h * HD + kcol;
        f32x16 W = z16, Aq = z16;
#pragma unroll
        for (int s = 0; s < 4; ++s) { const bf16x8 bw = *(const bf16x8*)(WupT + (size_t)kc * 64 + 16 * s + 8 * l.h), ba = *(const bf16x8*)(AupT + (size_t)kc * 64 + 16 * s + 8 * l.h);
            W = RK_MFMA(frag_row(s0, l, ti, s), bw, W); Aq = RK_MFMA(frag_row(s1, l, ti, s), ba, Aq); }
        const float w0 = ka->in[6][kc], a0 = ka->in[8][kc], kkc = ka->in[10][kc], kac = ka->in[11][kc], rkc = ka->in[12][kc];
        float lw[16], L[16];
#pragma unroll
        for (int r = 0; r < 16; ++r) { const float x = W[r] + w0; const float sp = (-x > 20.f) ? -x : 0.6931471805599453f * __builtin_amdgcn_logf(1.0f + fexp(-x)); lw[r] = -fexp(-sp - 0.5f); Aq[r] = sigm(Aq[r] + a0); }
        float gs[4], go[4];
#pragma unroll
        for (int g = 0; g < 4; ++g) { L[4 * g] = lw[4 * g]; L[4 * g + 1] = L[4 * g] + lw[4 * g + 1]; L[4 * g + 2] = L[4 * g + 1] + lw[4 * g + 2]; L[4 * g + 3] = L[4 * g + 2] + lw[4 * g + 3]; gs[g] = L[4 * g + 3]; }
        float run = 0.f;
#pragma unroll
        for (int g = 0; g < 4; ++g) { const float og = xhalf(gs[g]); const float lo = l.h ? og : gs[g], hi = l.h ? gs[g] : og;
            go[g] = run + (l.h ? lo : 0.f); run += lo + hi; }
#pragma unroll
        for (int r = 0; r < 16; ++r) L[r] += go[r >> 2];
        if (ti == 0 && l.h == 0) ltot[kcol] = run;
        __syncthreads();
        if (ti == 1) { const float add = ltot[kcol];
#pragma unroll
            for (int r = 0; r < 16; ++r) L[r] += add;
            if (l.h == 1) gam[kcol] = fexp(L[15]); }
        f32x16 At, Bt, Kt, Rt; float xb[16];
#pragma unroll
        for (int r = 0; r < 16; ++r) { const int t = 32 * ti + crow(r, l.h);
            const float rr = bf2f(*(const LAS unsigned short*)(s2 + t * P + kcol * 2)), kx = bf2f(*(const LAS unsigned short*)(s3 + t * P + kcol * 2));
            const float kn = kx * kkc * nrminv[t], a = Aq[r], km = kx * (1.0f + (a - 1.0f) * kac);
            const float eL = fexp(L[r]), eLn = fexp(-L[r]), eLp = fexp(L[r] - lw[r]);
            At[r] = -kn * eLp; Bt[r] = kn * a * eLn; Kt[r] = km * eLn; Rt[r] = rr * eL; xb[r] = rr * km * rkc; }
#pragma unroll
        for (int r = 0; r < 16; ++r) xb[r] = dpp_sum32(xb[r]);
        if (l.r == 31) {
#pragma unroll
            for (int r = 0; r < 16; ++r) bonp[tj * 64 + 32 * ti + crow(r, l.h)] = xb[r]; }
        store_T(s0, l, At, ti, tj); store_T(s1, l, Bt, ti, tj); store_T(s5, l, Kt, ti, tj); store_T(s6, l, Rt, ti, tj);
    }
}
__device__ __forceinline__ void r1_S2(Frame& F, R1Ctx& X) {
    using namespace rk;
    int grp, w4, ti, tj, lane, tg; Ln l; LAS unsigned char* G; const f32x16 z16 = {};
    RK_RELANE(); (void)w4; (void)tg; (void)ti; (void)tj;
    const int item = X.item, c = X.c, h = X.h, b = X.b; (void)item; (void)c; (void)h; (void)b;
    {
        f32x16 X = z16;
        if (ti >= tj) {
#pragma unroll
            for (int s = 0; s < 4; ++s) X = RK_MFMA(frag_tr(s0, l, ti, s), frag_tr(s5, l, tj, s), X);
#pragma unroll
            for (int r = 0; r < 16; ++r) { const int t = 32 * ti + crow(r, l.h), i = 32 * tj + l.r; if (!(t > i)) X[r] = 0.f; } }
        store_T(s2, l, X, ti, tj);
        if (w4 == 0 || w4 == 3) { const int d = w4 == 3;
            f32x16 S = z16, ST = z16;
#pragma unroll
            for (int s = 0; s < 4; ++s) { const bf16x8 fa = frag_tr(s0, l, d, s), fb = frag_tr(s1, l, d, s); S = RK_MFMA(fa, fb, S); ST = RK_MFMA(fb, fa, ST); }
#pragma unroll
            for (int r = 0; r < 16; ++r) { const int rw = crow(r, l.h); if (!(rw > l.r)) S[r] = 0.f; if (!(l.r > rw)) ST[r] = 0.f; }
            f32x16 D = S, DT = ST;
            tri_inv32(D, DT, S, ST);
            store_T(s7, l, D, d, d);
            asm volatile("s_waitcnt lgkmcnt(0)" ::: "memory");
            if (l.h == 0) *(LAS unsigned short*)(s7 + (32 * d + l.r) * P + (32 * d + l.r) * 2) = 0x3f80;
        } else if (w4 == 2) {
            f32x16 X21 = z16;
#pragma unroll
            for (int s = 0; s < 4; ++s) X21 = RK_MFMA(frag_tr(s0, l, 1, s), frag_tr(s1, l, 0, s), X21);
            store_T(s3, l, X21, 0, 0);
        } else {
            store_T(s7, l, z16, 0, 1);
            { RK_KA(); float* BON = (float*)(ka->ws + WS_BON); const int t = lane; BON[((size_t)b * SEQ + c * 64 + t) * NH + h] = bonp[t] + bonp[64 + t]; }
        }
    }
}
__device__ __forceinline__ void r1_S3(Frame& F, R1Ctx& X) {
    using namespace rk;
    int grp, w4, ti, tj, lane, tg; Ln l; LAS unsigned char* G; const f32x16 z16 = {};
    RK_RELANE(); (void)w4; (void)tg; (void)ti; (void)tj;
    const int item = X.item, c = X.c, h = X.h, b = X.b; (void)item; (void)c; (void)h; (void)b;
    f32x16& Wt0 = X.Wt0; f32x16& Wt1 = X.Wt1;
    Wt0 = z16; Wt1 = z16;
    {
        if (w4 == 2) {
            f32x16 E = z16;
#pragma unroll
            for (int s = 0; s < 2; ++s) E = RK_MFMA(frag_tr(s3, l, 0, s), frag_row(s7, l, 0, s), E);
            store_T(s3, l, E, 0, 1);
            f32x16 T21 = z16;
#pragma unroll
            for (int s = 0; s < 2; ++s) T21 = RK_MFMA(frag_tr(s7, l, 1, s, 32), frag_row(s3, l, 1, s), T21);
            store_T(s7, l, T21, 1, 0);
        }
#pragma unroll
        for (int s = 0; s < 4; ++s) Wt0 = RK_MFMA(frag_tr(s2, l, 0, s), frag_tr(s4, l, tj, s), Wt0);
        if (ti == 1) {
#pragma unroll
            for (int s = 0; s < 4; ++s) Wt1 = RK_MFMA(frag_tr(s2, l, 1, s), frag_tr(s4, l, tj, s), Wt1); }
    }
}
__device__ __forceinline__ void r1_S4(Frame& F, R1Ctx& X) {
    using namespace rk;
    int grp, w4, ti, tj, lane, tg; Ln l; LAS unsigned char* G; const f32x16 z16 = {};
    RK_RELANE(); (void)w4; (void)tg; (void)ti; (void)tj;
    const int item = X.item, c = X.c, h = X.h, b = X.b; (void)item; (void)c; (void)h; (void)b;
    f32x16& Wt0 = X.Wt0; f32x16& Wt1 = X.Wt1;
    {
        f32x16 Ap = z16;
#pragma unroll
        for (int s = 0; s < 4; ++s) if (s < 2 || ti == 1) Ap = RK_MFMA(frag_tr(s7, l, ti, s), frag_row(s0, l, tj, s), Ap);
        f32x16 Uv = z16;
#pragma unroll
        for (int s = 0; s < 2; ++s) Uv = RK_MFMA(frag_tr_perm(s7, l, ti, s, 0), pack(Wt0, s), Uv);
        if (ti == 1) {
#pragma unroll
            for (int s = 0; s < 2; ++s) Uv = RK_MFMA(frag_tr_perm(s7, l, ti, s, 32), pack(Wt1, s), Uv); }
        store_T(s2, l, Ap, ti, tj); store_T(s3, l, Uv, ti, tj);
    }
}
__device__ __forceinline__ void r1_S5(Frame& F, R1Ctx& X) {
    using namespace rk;
    int grp, w4, ti, tj, lane, tg; Ln l; LAS unsigned char* G; const f32x16 z16 = {};
    RK_RELANE(); (void)w4; (void)tg; (void)ti; (void)tj;
    const int item = X.item, c = X.c, h = X.h, b = X.b; (void)item; (void)c; (void)h; (void)b;
    {
        RK_KA(); float* NT = (float*)((unsigned char*)ka->out + DO_NT); bf16* MT = (bf16*)((unsigned char*)ka->out + DO_MT); bf16* RH = (bf16*)((unsigned char*)ka->out + DO_RH); bf16* Y0 = (bf16*)(ka->ws + WS_GATE);
        const size_t ib = (size_t)((b * 64 + c) * NH + h) * 4096;
        f32x16 Xrb0 = z16, Xrk0 = z16, Xrb1 = z16, Xrk1 = z16;
#pragma unroll
        for (int s = 0; s < 4; ++s) { const bf16x8 fr = frag_tr(s6, l, ti, s); Xrb0 = RK_MFMA(frag_tr(s1, l, 0, s), fr, Xrb0); Xrk0 = RK_MFMA(frag_tr(s5, l, 0, s), fr, Xrk0); }
        if (ti == 1) {
#pragma unroll
            for (int s = 0; s < 4; ++s) { const bf16x8 fr = frag_tr(s6, l, ti, s); Xrb1 = RK_MFMA(frag_tr(s1, l, 1, s), fr, Xrb1); Xrk1 = RK_MFMA(frag_tr(s5, l, 1, s), fr, Xrk1); } }
#pragma unroll
        for (int r = 0; r < 16; ++r) { const bool keep = crow(r, l.h) <= l.r; if (ti == 0) { if (!keep) { Xrb0[r] = 0.f; Xrk0[r] = 0.f; } } else { if (!keep) { Xrb1[r] = 0.f; Xrk1[r] = 0.f; } } }
        f32x16 acc;
#pragma unroll
        for (int g = 0; g < 4; ++g) { const u32x2 w = *(const LAS u32x2*)(s6 + (32 * tj + l.r) * P + (32 * ti + 8 * g + 4 * l.h) * 2); acc[4 * g] = bflo(w.x); acc[4 * g + 1] = bfhi(w.x); acc[4 * g + 2] = bflo(w.y); acc[4 * g + 3] = bfhi(w.y); }
#pragma unroll
        for (int s = 0; s < 2; ++s) acc = RK_MFMA(pack(Xrb0, s), frag_row_perm(s2, l, tj, s, 0), acc);
        if (ti == 1) {
#pragma unroll
            for (int s = 0; s < 2; ++s) acc = RK_MFMA(pack(Xrb1, s), frag_row_perm(s2, l, tj, s, 32), acc); }
#pragma unroll
        for (int r = 0; r < 16; ++r) RH[ib + (32 * ti + crow(r, l.h)) * 64 + 32 * tj + l.r] = (bf16)f2bf(acc[r]);
        acc = z16;
#pragma unroll
        for (int s = 0; s < 2; ++s) { acc = RK_MFMA(pack(Xrb0, s), frag_row_perm(s3, l, tj, s, 0), acc); acc = RK_MFMA(pack(Xrk0, s), frag_tr_perm(s4, l, tj, s, 0), acc); }
        if (ti == 1) {
#pragma unroll
            for (int s = 0; s < 2; ++s) { acc = RK_MFMA(pack(Xrb1, s), frag_row_perm(s3, l, tj, s, 32), acc); acc = RK_MFMA(pack(Xrk1, s), frag_tr_perm(s4, l, tj, s, 32), acc); } }
#pragma unroll
        for (int r = 0; r < 16; ++r) Y0[ib + (32 * ti + crow(r, l.h)) * 64 + 32 * tj + l.r] = (bf16)f2bf(acc[r]);
        acc = z16;
#pragma unroll
        for (int s = 0; s < 4; ++s) acc = RK_MFMA(frag_row(s1, l, ti, s), frag_row(s2, l, tj, s), acc);
#pragma unroll
        for (int r = 0; r < 16; ++r) { const int kp = 32 * ti + crow(r, l.h), k = 32 * tj + l.r; const float v = (acc[r] + (kp == k ? 1.f : 0.f)) * gam[kp]; MT[ib + kp * 64 + k] = (bf16)f2bf(v); }
        acc = z16;
#pragma unroll
        for (int s = 0; s < 4; ++s) { acc = RK_MFMA(frag_row(s1, l, ti, s), frag_row(s3, l, tj, s), acc); acc = RK_MFMA(frag_row(s5, l, ti, s), frag_tr(s4, l, tj, s), acc); }
#pragma unroll
        for (int r = 0; r < 16; ++r) NT[ib + ((ti * 2 + tj) * 16 + r) * 64 + lane] = acc[r] * gam[32 * ti + crow(r, l.h)];
    }
}
#ifndef MK_R1_REP
#define MK_R1_REP -1
#endif
__device__ __forceinline__ void rwkv_chunk_ops(Frame& F) {
    R1Ctx X;
    for (int ip = F.vcu; ip < BATCH * NH * 64 / 2; ip += F.G) {
        { int t_ = F.tid; asm volatile("" : "+v"(t_)); const int grp = t_ >> 8; X.item = ip * 2 + grp; X.c = X.item & 63; const int bh = X.item >> 6; X.h = bh % NH; X.b = bh / NH; }
        r1_S1a(F, X); __syncthreads();
        if constexpr (MK_R1_REP == 0) { r1_S1a(F, X); __syncthreads(); }
        r1_S1b(F, X); __syncthreads();
        if constexpr (MK_R1_REP == 1) { r1_S1a(F, X); __syncthreads(); r1_S1b(F, X); __syncthreads(); }
        r1_S2(F, X); __syncthreads();
        if constexpr (MK_R1_REP == 2) { r1_S2(F, X); __syncthreads(); }
        r1_S3(F, X); __syncthreads();
        r1_S4(F, X); __syncthreads();
        r1_S5(F, X); __syncthreads();
        if constexpr (MK_R1_REP == 5) { r1_S5(F, X); __syncthreads(); }
    }
}
#undef s0
#undef s1
#undef s2
#undef s3
#undef s4
#undef s5
#undef s6
#undef s7
#undef nrminv
#undef ltot
#undef gam
#undef bonp
__device__ __forceinline__ void rwkv_relay(Frame& F) {
    using namespace rk;
    const int lane = F.lane, wid = F.wave; const int lr = lane & 31, lh = lane >> 5;
    LAS float* sbuf = (LAS float*)F.lds; volatile LAS int* flag = (volatile LAS int*)(F.lds + 16384);
    const float* NT = (const float*)((unsigned char*)F.out + DO_NT); bf16* MT = (bf16*)((unsigned char*)F.out + DO_MT);
    for (int ch = F.vcu; ch < BATCH * NH * 2; ch += F.G) {
        const int bh = ch >> 1, ct = ch & 1;
        __syncthreads();
        for (int i = F.tid; i < 2048; i += NTHR) sbuf[i] = 0.f;
        if (F.tid == 0) flag[0] = 0;
        __syncthreads();
        for (int c = wid; c < 64; c += NWAVES) {
            const size_t ib = (size_t)(((bh >> 3) * 64 + c) * NH + (bh & 7)) * 4096;
            bf16x8 am[2][4]; f32x16 sn[2];
#pragma unroll
            for (int rt = 0; rt < 2; ++rt)
#pragma unroll
                for (int s = 0; s < 4; ++s) { const bf16* pm = MT + ib + (32 * rt + lr) * 64 + 16 * s + 4 * lh;
                    const v2u m0 = *(const v2u*)pm, m1 = *(const v2u*)(pm + 8);
                    am[rt][s] = __builtin_bit_cast(bf16x8, (u32x4){m0.x, m0.y, m1.x, m1.y}); }
#pragma unroll
            for (int rt = 0; rt < 2; ++rt)
#pragma unroll
                for (int r = 0; r < 16; ++r) sn[rt][r] = NT[ib + ((rt * 2 + ct) * 16 + r) * 64 + lane];
            while (flag[0] < c) __builtin_amdgcn_s_sleep(1);
            asm volatile("s_waitcnt lgkmcnt(0)" ::: "memory");
            const LAS float* sin = sbuf + (c & 1) * 2048; LAS float* sout = sbuf + ((c + 1) & 1) * 2048;
            bf16x8 sp[2][2];
#pragma unroll
            for (int kt = 0; kt < 2; ++kt) { f32x16 sv;
#pragma unroll
                for (int r = 0; r < 16; ++r) sv[r] = sin[(kt * 16 + r) * 64 + lane];
                sp[kt][0] = pack(sv, 0); sp[kt][1] = pack(sv, 1); }
#pragma unroll
            for (int s = 0; s < 4; ++s)
#pragma unroll
                for (int rt = 0; rt < 2; ++rt) sn[rt] = RK_MFMA(am[rt][s], sp[s >> 1][s & 1], sn[rt]);
#pragma unroll
            for (int rt = 0; rt < 2; ++rt)
#pragma unroll
                for (int r = 0; r < 16; ++r) sout[(rt * 16 + r) * 64 + lane] = sn[rt][r];
            asm volatile("s_waitcnt lgkmcnt(0)" ::: "memory");
            if (lane == 0) flag[0] = c + 1;
            bf16* sc = (bf16*)(F.ws + WS_SC) + ib;
#pragma unroll
            for (int kt = 0; kt < 2; ++kt)
#pragma unroll
                for (int sl = 0; sl < 2; ++sl) *(bf16x8*)(sc + (((kt * 2 + ct) * 2 + sl) * 64 + lane) * 8) = sp[kt][sl];
        }
    }
}

struct R2Tile { v4u y0[4], vv[4], zg[4]; float bon; };
__device__ __forceinline__ void r2_load_tile(R2Tile& T, const bf16* Y0, const bf16* QKVZ, const float* BON, size_t ib, int b, int h, int c, int tt, int lane) {
    const int q = lane >> 1, c0 = (lane & 1) * 32; const size_t row = (size_t)b * SEQ + c * 64 + tt * 32 + q;
    const v4u* y0p = (const v4u*)(Y0 + ib + (tt * 32 + q) * 64 + c0); const v4u* vp = (const v4u*)(QKVZ + row * QP + 1024 + h * HD + c0); const v4u* zp = (const v4u*)(QKVZ + row * QP + 1536 + h * HD + c0);
#pragma unroll
    for (int i = 0; i < 4; ++i) { T.y0[i] = y0p[i]; T.vv[i] = vp[i]; T.zg[i] = zp[i]; }
    T.bon = BON[row * NH + h];
}
__device__ __forceinline__ void rwkv_output(Frame& F) {
    using namespace rk;
    const int wid = F.wave;
    LAS float* yst = (LAS float*)(F.lds + wid * 8704); LAS float* cst = (LAS float*)(F.lds + 69632);
    bf16* QKVZ = (bf16*)(F.ws + WS_QKVZ);
    const bf16* SC = (const bf16*)(F.ws + WS_SC); const bf16* RH = (const bf16*)((unsigned char*)F.out + DO_RH);
    const bf16* Y0 = (const bf16*)(F.ws + WS_GATE); const float* BON = (const float*)(F.ws + WS_BON);
    __syncthreads();
    for (int i = F.tid; i < 2 * 512; i += NTHR) { const int a = i >> 9, col = i & 511; cst[i] = a == 0 ? F.ln_w[col] : F.ln_b[col]; }
    __syncthreads();
    const int gw = F.vcu * NWAVES + wid, NGW = F.G * NWAVES;
    for (int idx = gw; idx < BATCH * NH * 64; idx += NGW) {
        const int h = idx & 7, c = (idx >> 3) & 63, b = idx >> 9; const size_t ib = (size_t)idx * 4096;
        bf16x8 sp[2][2][2];
        { const int lane = F.lane;
#pragma unroll
          for (int kt = 0; kt < 2; ++kt)
#pragma unroll
              for (int ct = 0; ct < 2; ++ct)
#pragma unroll
                  for (int sl = 0; sl < 2; ++sl) sp[kt][ct][sl] = *(const bf16x8*)(SC + ib + (((kt * 2 + ct) * 2 + sl) * 64 + lane) * 8); }
#pragma unroll 1
        for (int tt = 0; tt < 2; ++tt) {
            int lane_ = F.tid; asm volatile("" : "+v"(lane_)); const int lane = lane_ & 63, lr = lane & 31, lh = lane >> 5;
            bf16x8 ar[4];
#pragma unroll
            for (int s = 0; s < 4; ++s) { const bf16* pr = RH + ib + (32 * tt + lr) * 64 + 16 * s + 4 * lh; const v2u r0 = *(const v2u*)pr, r1 = *(const v2u*)(pr + 8);
                ar[s] = __builtin_bit_cast(bf16x8, (u32x4){r0.x, r0.y, r1.x, r1.y}); }
            R2Tile T; r2_load_tile(T, Y0, QKVZ, BON, ib, b, h, c, tt, lane);
            f32x16 y0 = {}, y1 = {};
#ifndef MK_R2B_X
#define MK_R2B_X 0
#endif
#pragma unroll 1
            for (int rep2 = 0; rep2 < (MK_R2B_X == 2 ? 4 : 1); ++rep2) {
            y0 = f32x16{}; y1 = f32x16{};
#pragma unroll
            for (int s = 0; s < 4; ++s) { y0 = RK_MFMA(ar[s], sp[s >> 1][0][s & 1], y0); y1 = RK_MFMA(ar[s], sp[s >> 1][1][s & 1], y1); }
#pragma unroll
            for (int r = 0; r < 16; ++r) { yst[crow(r, lh) * 68 + lr] = y0[r]; yst[crow(r, lh) * 68 + 32 + lr] = y1[r]; }
            asm volatile("s_waitcnt lgkmcnt(0)" ::: "memory"); }
            const int q = lane >> 1, c0 = (lane & 1) * 32; const int sq = c * 64 + tt * 32 + q; const size_t row = (size_t)b * SEQ + sq;
            const LAS float* cs = cst + h * HD + c0;
            float y[32];
#pragma unroll 1
            for (int rep1 = 0; rep1 < (MK_R2B_X == 1 ? 4 : 1); ++rep1) {
#pragma unroll
            for (int e = 0; e < 32; e += 8) { const f32x4 a = *(const LAS f32x4*)(yst + q * 68 + c0 + e), bq = *(const LAS f32x4*)(yst + q * 68 + c0 + e + 4); const v4u w = T.y0[e >> 3];
                y[e] = a[0] + bflo(w.x); y[e + 1] = a[1] + bfhi(w.x); y[e + 2] = a[2] + bflo(w.y); y[e + 3] = a[3] + bfhi(w.y); y[e + 4] = bq[0] + bflo(w.z); y[e + 5] = bq[1] + bfhi(w.z); y[e + 6] = bq[2] + bflo(w.w); y[e + 7] = bq[3] + bfhi(w.w); }
            float sm = 0.f;
#pragma unroll
            for (int e = 0; e < 32; ++e) sm += y[e];
            sm += __shfl_xor(sm, 1); const float mean = sm * (1.f / 64.f);
            float sv = 0.f;
#pragma unroll
            for (int e = 0; e < 32; ++e) { const float d = y[e] - mean; sv += d * d; }
            sv += __shfl_xor(sv, 1); const float rstd = frsq(sv * (1.f / 64.f) + GN_EPS);
            const float bon = T.bon;
#pragma unroll
            for (int e = 0; e < 32; e += 8) { const v4u vw = T.vv[e >> 3], zw = T.zg[e >> 3];
                const f32x4 lw0 = *(const LAS f32x4*)(cs + e), lw1 = *(const LAS f32x4*)(cs + e + 4), lb0 = *(const LAS f32x4*)(cs + 512 + e), lb1 = *(const LAS f32x4*)(cs + 512 + e + 4);
                float o[8];
#pragma unroll
                for (int j = 0; j < 8; ++j) { const unsigned wv = vw[j >> 1], wz = zw[j >> 1]; const float vv = (j & 1) ? bfhi(wv) : bflo(wv), zg = (j & 1) ? bfhi(wz) : bflo(wz);
                    const float lw = j < 4 ? lw0[j & 3] : lw1[j & 3], lb = j < 4 ? lb0[j & 3] : lb1[j & 3];
                    o[j] = ((y[e + j] - mean) * rstd * lw + lb + bon * vv) * zg; }
                *(LAS v4u*)((LAS bf16*)yst + q * 72 + c0 + e) = (v4u){pk2(o[0], o[1]), pk2(o[2], o[3]), pk2(o[4], o[5]), pk2(o[6], o[7])}; }
            asm volatile("s_waitcnt lgkmcnt(0)" ::: "memory");
#pragma unroll
            for (int i = 0; i < 4; ++i) { const int rr = i * 8 + (lane >> 3), chk = lane & 7; const v4u w = *(const LAS v4u*)((LAS bf16*)yst + rr * 72 + chk * 8);
                *(v4u*)(QKVZ + ((size_t)b * SEQ + c * 64 + tt * 32 + rr) * QP + 512 + h * HD + chk * 8) = w; }
            asm volatile("s_waitcnt lgkmcnt(0)" ::: "memory"); }
        }
    }
}
#define BAR_ST ((volatile LAS unsigned*)(F.lds + 163832))
constexpr int LDS_BYTES = 163840;
constexpr int NPHASE = 13;

template <int PLO, int PHI> __global__ void __launch_bounds__(NTHR, 2) fwd(Args args) {
    extern __shared__ __attribute__((aligned(16))) unsigned char lds[];
    Frame F;
    F.lds = (LAS unsigned char*)lds;
#define RETID() do { int t_ = threadIdx.x; asm volatile("" : "+v"(t_)); F.tid = t_; F.lane = t_ & 63; F.wave = __builtin_amdgcn_readfirstlane(t_ >> 6); \
    int bx_ = blockIdx.x, g_ = gridDim.x; asm volatile("" : "+s"(bx_), "+s"(g_)); F.G = g_; F.vcu = (g_ % 8 == 0) ? (bx_ % 8) * (g_ / 8) + bx_ / 8 : bx_; } while (0)
    RETID();
    if (threadIdx.x == 0) { BAR_ST[0] = 0u; BAR_ST[1] = 0u; }
    if constexpr (PHI - PLO > 1) xcd_barrier_post((unsigned*)(args.ws + WS_BAR));
    if (args.ph_hi == 0x7fffffff) cg::this_grid().sync();
#define LOADF() do { const __attribute__((address_space(4))) Args* ap_ = (const __attribute__((address_space(4))) Args*)__builtin_amdgcn_kernarg_segment_ptr(); asm volatile("" : "+s"(ap_)); \
    F.x = ap_->in[0]; F.p = ap_->in[1]; F.g_pre = ap_->in[2]; F.w_in = ap_->in[3]; F.rel_bias = ap_->in[4]; F.mu = ap_->in[5]; F.w0 = ap_->in[6]; F.w_up = ap_->in[7]; \
    F.a0 = ap_->in[8]; F.a_up = ap_->in[9]; F.k_k = ap_->in[10]; F.k_a = ap_->in[11]; F.r_k = ap_->in[12]; F.ln_w = ap_->in[13]; F.ln_b = ap_->in[14]; \
    F.p_a = ap_->in[15]; F.p_b = ap_->in[16]; F.w_out = ap_->in[17]; F.g_post = ap_->in[18]; F.w_pu = ap_->in[19]; F.w_pg = ap_->in[20]; F.out = ap_->out; F.ws = ap_->ws; ws = F.ws; \
    U2 = (pg8::bf16_t*)F.out; MERGED = (pg8::bf16_t*)(ws + WS_RW); QKVZ = (pg8::bf16_t*)(ws + WS_QKVZ); RWb = (pg8::bf16_t*)(ws + WS_RW); GAB = (pg8::bf16_t*)(ws + WS_GAB); } while (0)
    unsigned char* ws; pg8::bf16_t *U2, *MERGED, *QKVZ, *RWb, *GAB;
    constexpr int lo = PLO, hi = PHI;
    cg::grid_group grid = cg::this_grid();
#define IN(k) (lo <= (k) && (k) < hi)
#define GRIDBAR() do { const __attribute__((address_space(4))) Args* apb_ = (const __attribute__((address_space(4))) Args*)__builtin_amdgcn_kernarg_segment_ptr(); asm volatile("" : "+s"(apb_)); \
    xcd_barrier((unsigned*)(apb_->ws + WS_BAR), BAR_ST); } while (0)
#define SEAM(k) do { if constexpr (IN(k) && IN((k) + 1)) GRIDBAR(); } while (0)
#ifndef MK_REPEAT_PHASE
#define MK_REPEAT_PHASE -1
#endif
#define NREP(k) (((k) == MK_REPEAT_PHASE) ? 2 : 1)

    if constexpr (IN(0)) { RETID(); LOADF(); p0_prologue(F); if constexpr (0 == MK_REPEAT_PHASE) { GRIDBAR(); RETID(); LOADF(); p0_prologue(F); } } SEAM(0);
#ifdef MK_BWTEST
    if constexpr (IN(1)) { RETID(); LOADF();
        const f32x4* xp = (const f32x4*)F.x; f32x4 acc = {0.f, 0.f, 0.f, 0.f};
        const int gw = F.vcu * NWAVES + F.wave, NGW = F.G * NWAVES;
        if (MK_BWTEST == 1) { const size_t n4 = (size_t)M * DM / 4;
            for (size_t i = (size_t)F.vcu * NTHR + F.tid; i + (size_t)31 * F.G * NTHR < n4; i += (size_t)32 * F.G * NTHR) { f32x4 t[32];
#pragma unroll
                for (int j = 0; j < 32; ++j) t[j] = xp[i + (size_t)j * F.G * NTHR];
#pragma unroll
                for (int j = 0; j < 32; ++j) acc += t[j]; }
        } else {
            for (int it = gw; it < (M / 32) * 8; it += NGW) { const int rg = it >> 3, cb = it & 7; const int q = F.lane >> 1, hf = F.lane & 1;
                const f32x4* p = xp + ((size_t)(rg * 32 + q) * DM + cb * 128 + hf * 64) / 4; f32x4 t[16];
#pragma unroll
                for (int j = 0; j < 16; ++j) t[j] = p[j];
#pragma unroll
                for (int j = 0; j < 16; ++j) acc += t[j]; } }
        if (acc[0] + acc[1] + acc[2] + acc[3] == 1.2345e30f) ((float*)(ws + WS_RSY))[F.tid] = acc[0];
        grid.sync(); }
#endif
    if constexpr (IN(1)) { RETID(); LOADF();
        { pg8::Gemm g{U2, (const pg8::bf16_t*)(ws + WS_WIN), M, INCP, DM, 2048, DM, 0, 0}; pg8::StaticOrder S; S.init(M, INCP, F.G, (int)blockIdx.x);
          pg8::EpiCols E{QKVZ, RWb, GAB, QSCALE};
          pg8::gemm_phase<pg8::EpiCols, pg8::StaticOrder, true, true>(F.lds, g, S, E);
          if constexpr (MK_REPEAT_PHASE == 101) { __syncthreads(); pg8::gemm_phase<pg8::EpiCols, pg8::StaticOrder, true, true>(F.lds, g, S, E); } }
        { pg8::Gemm g{U2, (const pg8::bf16_t*)(ws + WS_WG), M, 256, 2048, 2048, 2048, 16, (size_t)256 * 2048}; pg8::StaticOrder S; S.init(M, 256, F.G, (int)blockIdx.x);
          pg8::EpiF32 E{(float*)(ws + WS_GATE), 256};
          pg8::gemm_phase<pg8::EpiF32, pg8::StaticOrder, true, true>(F.lds, g, S, E);
          if constexpr (MK_REPEAT_PHASE == 102) { __syncthreads(); pg8::gemm_phase<pg8::EpiF32, pg8::StaticOrder, true, true>(F.lds, g, S, E); } }
    } SEAM(1);
#ifdef MK_SYNCTEST
    for (int i_ = 0; i_ < 20; ++i_) GRIDBAR();
#endif
    if constexpr (IN(2)) { RETID(); LOADF(); attn_select(F, (const float*)(ws + WS_GATE), (unsigned*)(ws + WS_CNT), (unsigned short*)((unsigned char*)F.out + DO_LISTS));
        if constexpr (2 == MK_REPEAT_PHASE) { GRIDBAR(); if (blockIdx.x == 0) for (int i = threadIdx.x; i < 2048; i += NTHR) ((unsigned*)(args.ws + WS_CNT))[i] = 0u; GRIDBAR(); RETID(); LOADF();
            attn_select(F, (const float*)(ws + WS_GATE), (unsigned*)(ws + WS_CNT), (unsigned short*)((unsigned char*)F.out + DO_LISTS)); } } SEAM(2);
    if constexpr (IN(3)) { RETID(); LOADF(); attn_partial(F, (const bf16*)(ws + WS_QKVZ), (const unsigned*)(ws + WS_CNT), (const unsigned short*)((unsigned char*)F.out + DO_LISTS),
                                         (bf16*)((unsigned char*)F.out + DO_PARTO), (float*)((unsigned char*)F.out + DO_PARTML), (unsigned*)(ws + WS_QCTR)); if constexpr (3 == MK_REPEAT_PHASE) { { GRIDBAR(); if (blockIdx.x == 0 && threadIdx.x == 0) *(unsigned*)(args.ws + WS_QCTR) = 0u; GRIDBAR(); } RETID(); LOADF(); attn_partial(F, (const bf16*)(ws + WS_QKVZ), (const unsigned*)(ws + WS_CNT), (const unsigned short*)((unsigned char*)F.out + DO_LISTS),
                                         (bf16*)((unsigned char*)F.out + DO_PARTO), (float*)((unsigned char*)F.out + DO_PARTML), (unsigned*)(ws + WS_QCTR)); } } SEAM(3);
    if constexpr (IN(4)) { RETID(); LOADF();
        if constexpr (4 == MK_REPEAT_PHASE) { attn_own_combine(F, (bf16*)(ws + WS_QKVZ), (const bf16*)((unsigned char*)F.out + DO_PARTO), (const float*)((unsigned char*)F.out + DO_PARTML), (bf16*)(ws + WS_GATE), 512); grid.sync(); RETID(); LOADF(); }
        attn_own_combine(F, (bf16*)(ws + WS_QKVZ), (const bf16*)((unsigned char*)F.out + DO_PARTO), (const float*)((unsigned char*)F.out + DO_PARTML), (bf16*)(ws + WS_QKVZ), QP); } SEAM(4);
    if constexpr (IN(5)) { RETID(); LOADF(); rwkv_chunk_ops(F); if constexpr (5 == MK_REPEAT_PHASE) { GRIDBAR(); RETID(); LOADF(); rwkv_chunk_ops(F); } } SEAM(5);
    if constexpr (IN(6)) { RETID(); LOADF(); rwkv_relay(F); if constexpr (6 == MK_REPEAT_PHASE) { GRIDBAR(); RETID(); LOADF(); rwkv_relay(F); } } SEAM(6);
    if constexpr (IN(7)) { RETID(); LOADF(); rwkv_output(F); if constexpr (7 == MK_REPEAT_PHASE) { GRIDBAR(); RETID(); LOADF(); rwkv_output(F); } } SEAM(7);
    if constexpr (IN(8)) { RETID(); LOADF();
        pg8::Gemm g{QKVZ, (const pg8::bf16_t*)(ws + WS_PAB), M, DM, 1024, QP, 1024, 0, 0}; pg8::StaticOrder S; S.init(M, DM, F.G, (int)blockIdx.x);
        pg8::EpiMergeFused E{MERGED, DM, GAB, GP};
        pg8::gemm_phase<pg8::EpiMergeFused, pg8::StaticOrder, true, true>(F.lds, g, S, E);
    } SEAM(9);
    if constexpr (IN(10)) { RETID(); LOADF();
        pg8::bf16_t* YB = RWb + (size_t)M * DM; pg8::bf16_t* H1B = QKVZ; PG8_LAS float* part = (PG8_LAS float*)(F.lds + 131072);
        for (int pm = F.vcu; pm < M / 256; pm += F.G) {
            pg8::PanelOrder S{pm};
            { pg8::Gemm g{MERGED, (const pg8::bf16_t*)(ws + WS_WOUT), M, DM, DM, DM, DM, 0, 0}; pg8::EpiYStat E{YB, DM, part};
              pg8::gemm_phase<pg8::EpiYStat, pg8::PanelOrder, true, true>(F.lds, g, S, E); }
            { int kple = PLE; asm volatile("" : "+s"(kple));
              pg8::Gemm g{(const pg8::bf16_t*)(ws + WS_PB), (const pg8::bf16_t*)(ws + WS_WPU), M, DM, kple, PLE, PLE, 0, 0}; pg8::EpiBf16 E{GAB, DM};
              pg8::gemm_phase<pg8::EpiBf16, pg8::PanelOrder, true, true>(F.lds, g, S, E); }
            asm volatile("s_waitcnt vmcnt(0) lgkmcnt(0)" ::: "memory"); __syncthreads();
            RETID(); panel_norm(F, pm, (const bf16*)YB, (bf16*)H1B, (float*)(ws + WS_RSY), (const LAS float*)part);
            asm volatile("s_waitcnt vmcnt(0)" ::: "memory"); __syncthreads();
            { pg8::Gemm g{H1B, (const pg8::bf16_t*)(ws + WS_WPG), M, DM, DM, DM, DM, 0, 0}; pg8::EpiFinal E{F.out, F.x, YB, (const float*)(ws + WS_RSY), F.g_post, GAB, DM};
              pg8::gemm_phase<pg8::EpiFinal, pg8::PanelOrder, true, true>(F.lds, g, S, E); }
            __syncthreads();
        }
    }
#undef IN
#undef SEAM
}

#ifndef MK_ONE_LAUNCH
#define MK_ONE_LAUNCH 1
#endif
extern "C" void kernel_launch(void* const* d_in, const int* in_sizes, int n_in, void* d_out, int out_size, void* d_ws, size_t ws_size, hipStream_t stream) {
    static int grid = 0;
    if (grid == 0) {
        if (n_in != 21 || out_size != M * DM || ws_size < WS_END) { fprintf(stderr, "kernel_launch: unexpected shapes n_in %d out %d ws %zu\n", n_in, out_size, ws_size); grid = -1; return; }
        int dev = 0, cus = 0, per_cu = 0;
        (void)hipGetDevice(&dev); (void)hipDeviceGetAttribute(&cus, hipDeviceAttributeMultiprocessorCount, dev);
        (void)per_cu;
        grid = cus;
    }
    if (grid < 0) return;
    if (hipMemsetAsync(d_ws, 0, 65536, stream) != hipSuccess) { fprintf(stderr, "kernel_launch: hipMemsetAsync of the control words failed\n"); return; }
    Args a{};
    for (int i = 0; i < 21; ++i) a.in[i] = (const float*)d_in[i];
    a.out = (float*)d_out; a.ws = (unsigned char*)d_ws;
#if MK_ONE_LAUNCH
    a.ph_lo = 0; a.ph_hi = NPHASE;
    void* kargs[] = {&a};
    (void)hipFuncSetAttribute((const void*)fwd<0, NPHASE>, hipFuncAttributeMaxDynamicSharedMemorySize, LDS_BYTES);
    hipError_t e = hipLaunchCooperativeKernel((const void*)fwd<0, NPHASE>, dim3(grid), dim3(NTHR), kargs, LDS_BYTES, stream);
    if (e != hipSuccess) fprintf(stderr, "cooperative launch failed: %s\n", hipGetErrorString(e));
#else
#define LAUNCH_PH(k) do { (void)hipFuncSetAttribute((const void*)fwd<k, k + 1>, hipFuncAttributeMaxDynamicSharedMemorySize, LDS_BYTES); a.ph_lo = k; a.ph_hi = k + 1; hipLaunchKernelGGL((fwd<k, k + 1>), dim3(grid), dim3(NTHR), LDS_BYTES, stream, a); } while (0)
    LAUNCH_PH(0); LAUNCH_PH(1); LAUNCH_PH(2); LAUNCH_PH(3); LAUNCH_PH(4); LAUNCH_PH(5); LAUNCH_PH(6); LAUNCH_PH(7); LAUNCH_PH(8); LAUNCH_PH(9); LAUNCH_PH(10); LAUNCH_PH(11); LAUNCH_PH(12);
#endif
}
```

```cpp
#include <hip/hip_runtime.h>
#include <hip/hip_cooperative_groups.h>
#include <cstdio>
#include <cstdint>
#include <cmath>
namespace cg = cooperative_groups;
namespace pg8 {
#define PG8_LAS __attribute__((address_space(3)))
typedef unsigned short bf16_t;
typedef short bf16x8 __attribute__((ext_vector_type(8)));
typedef float f32x4 __attribute__((ext_vector_type(4)));
typedef float f32x2 __attribute__((ext_vector_type(2)));
typedef unsigned u32x4 __attribute__((ext_vector_type(4)));
typedef unsigned u32x2 __attribute__((ext_vector_type(2)));
constexpr int BM = 256, BK = 64, HALF = 128, HTB = HALF * BK * 2  , STAGE_BYTES = 8 * HTB, NXCD = 8, WGM = 8;

__host__ __device__ __forceinline__ int lds_byte(int r, int c) { const int st = (r >> 4) * 2 + (c >> 5), rr = r & 15, cc = c & 31, ob = rr * 64 + cc * 2; return st * 1024 + (ob ^ (((ob >> 9) & 1) << 5)); }
__host__ __device__ __forceinline__ void stage_rc(int b, int& R, int& C) { const int st = b / 1024, sb = b % 1024, swz = sb ^ (((sb >> 9) & 1) << 5); R = (st >> 1) * 16 + swz / 64; C = (st & 1) * 32 + (swz % 64) / 2; }
__host__ __device__ __forceinline__ int perm32(int rho) { const int n = rho >> 4, i = rho & 15; return 8 * (i >> 2) + 4 * n + (i & 3); }

struct Unit { int pm, pn; };
struct Gemm { const bf16_t* A; const bf16_t* Bt; int M, N, K, lda, ldb, bdiv; size_t bstride; };

struct StaticOrder {
    int nM, nN, nwg, G, c;
    __host__ __device__ void init(int M, int N, int G_, int c_) { nM = M / BM; nN = N / BM; nwg = nM * nN; G = G_; c = c_; }
    __host__ __device__ bool next(int i, Unit& u) const {
        const long L = (long)i * G + c; if (L >= nwg) return false;
        int wgid = (int)L; { const int q = nwg / NXCD, r = nwg % NXCD, xcd = wgid % NXCD, off = wgid / NXCD; wgid = (xcd < r ? xcd * (q + 1) : r * (q + 1) + (xcd - r) * q) + off; }
        const int nig = WGM * nN, gid = wgid / nig, fm = gid * WGM, gsz = (nM - fm) < WGM ? (nM - fm) : WGM;
        u.pm = fm + ((wgid % nig) % gsz); u.pn = (wgid % nig) / gsz; return true;
    }
};

struct PanelOrder { int pm; __host__ __device__ bool next(int i, Unit& u) const { if (i >= 4) return false; u.pm = pm; u.pn = i; return true; } };
__device__ __forceinline__ unsigned cvt_pk_bf16(float lo, float hi) { unsigned r; asm volatile("v_cvt_pk_bf16_f32 %0, %1, %2" : "=v"(r) : "v"(lo), "v"(hi)); return r; }
__device__ __forceinline__ float bf_lo(unsigned w) { return __uint_as_float(w << 16); }
__device__ __forceinline__ float bf_hi(unsigned w) { return __uint_as_float(w & 0xffff0000u); }

template <class Epi, class Sched, bool ALIGN_EPI = false, bool SP2 = false>
__device__ __forceinline__ void gemm_phase(PG8_LAS unsigned char* lds, const Gemm g, const Sched& S, const Epi& E) {
    int tid_ = threadIdx.x; asm volatile("" : "+v"(tid_));
    const int tid = tid_, wid = __builtin_amdgcn_readfirstlane(tid >> 6), lane = tid & 63, wr = wid >> 2, wc = wid & 3, fr = lane & 15, fq = lane >> 4;
    const int K = g.K, nt = K / BK;
    unsigned voffA[2], voffB[2];
#pragma unroll
    for (int i = 0; i < 2; ++i) { int R, C; stage_rc(tid * 16 + i * 8192, R, C); const int Rb = Epi::PERM ? ((R & ~31) + perm32(R & 31)) : R;
        voffA[i] = (unsigned)(R * g.lda + C) * 2u; voffB[i] = (unsigned)(Rb * g.ldb + C) * 2u; }
    const size_t kstep = (size_t)(BK * 2);
    const size_t hstepA = (size_t)HALF * g.lda * 2, hstepB = (size_t)HALF * g.ldb * 2;
    const size_t tstepA = 2 * hstepA, tstepB = 2 * hstepB;
    const unsigned ldsw = (unsigned)wid * 1024u;
    const int aoff = lds_byte(wr * 64 + fr, fq * 8), boff = lds_byte(wc * 32 + fr, fq * 8);
#define PG8_SA(b, h) (((b) * 2 + (h)) * HTB)
#define PG8_SB(b, h) ((4 + (b) * 2 + (h)) * HTB)
#define PG8_STAGE(bufoff, gbase, voff) do { _Pragma("unroll") for (int _i = 0; _i < 2; ++_i) \
        __builtin_amdgcn_global_load_lds((const unsigned*)((const char*)(gbase) + (voff)[_i]), (PG8_LAS unsigned*)(lds + (bufoff) + ldsw + _i * 8192), 16, 0, 0); } while (0)
#define PG8_LDA(dst, b, h) do { _Pragma("unroll") for (int m = 0; m < 4; ++m) _Pragma("unroll") for (int k = 0; k < 2; ++k) dst[m][k] = *(const PG8_LAS bf16x8*)(lds + PG8_SA(b, h) + aoff + m * 2048 + k * 1024); } while (0)
#define PG8_LDB(dst, b, h) do { _Pragma("unroll") for (int n = 0; n < 2; ++n) _Pragma("unroll") for (int k = 0; k < 2; ++k) dst[n][k] = *(const PG8_LAS bf16x8*)(lds + PG8_SB(b, h) + boff + n * 2048 + k * 1024); } while (0)
#define PG8_MMA(ai, bj, At, Bt) do { __builtin_amdgcn_s_setprio(1); _Pragma("unroll") for (int m = 0; m < 4; ++m) _Pragma("unroll") for (int n = 0; n < 2; ++n) _Pragma("unroll") for (int k = 0; k < 2; ++k) \
        acc[ai][bj][m][n] = __builtin_amdgcn_mfma_f32_16x16x32_bf16(Bt[n][k], At[m][k], acc[ai][bj][m][n], 0, 0, 0); __builtin_amdgcn_s_setprio(0); } while (0)
#define PG8_WAIT_V(n) asm volatile("s_waitcnt vmcnt(" #n ")" ::: "memory")
#define PG8_WAIT_L(n) asm volatile("s_waitcnt lgkmcnt(" #n ")" ::: "memory")
#define PG8_BAR __builtin_amdgcn_s_barrier()
#define PG8_SCHED __builtin_amdgcn_sched_barrier(0)
#define PG8_BBASE(u) ((const char*)g.Bt + (size_t)(u).pn * tstepB + (g.bdiv ? (size_t)((u).pm / g.bdiv) * g.bstride * 2 : (size_t)0))
    Unit cur, nxt; int ui = 0;
    if (!S.next(0, cur)) return;
    f32x4 acc[2][2][4][2];
#pragma unroll
    for (int a = 0; a < 2; ++a)
#pragma unroll
        for (int b = 0; b < 2; ++b)
#pragma unroll
            for (int m = 0; m < 4; ++m)
#pragma unroll
                for (int n = 0; n < 2; ++n) acc[a][b][m][n] = (f32x4){0.f, 0.f, 0.f, 0.f};
    bf16x8 At[4][2], B0[2][2], B1[2][2];
    const char* cA = (const char*)g.A + (size_t)cur.pm * tstepA; const char* cB = PG8_BBASE(cur);
    if constexpr (SP2) {
        PG8_STAGE(PG8_SB(0, 0), cB, voffB); PG8_STAGE(PG8_SB(0, 1), cB + hstepB, voffB); PG8_STAGE(PG8_SA(0, 0), cA, voffA); PG8_STAGE(PG8_SA(0, 1), cA + hstepA, voffA);
        if (wr == 1) PG8_BAR;
        PG8_WAIT_V(2); PG8_BAR;
        PG8_STAGE(PG8_SB(1, 0), cB + kstep, voffB); PG8_STAGE(PG8_SA(1, 0), cA + kstep, voffA); PG8_STAGE(PG8_SB(1, 1), cB + hstepB + kstep, voffB);
        PG8_WAIT_V(6); PG8_BAR;
    } else {
        PG8_STAGE(PG8_SB(0, 0), cB, voffB); PG8_STAGE(PG8_SA(0, 0), cA, voffA); PG8_STAGE(PG8_SB(0, 1), cB + hstepB, voffB); PG8_STAGE(PG8_SA(0, 1), cA + hstepA, voffA);
        if (wr == 1) PG8_BAR;
        PG8_WAIT_V(4); PG8_BAR;
        PG8_STAGE(PG8_SB(1, 0), cB + kstep, voffB); PG8_STAGE(PG8_SA(1, 0), cA + kstep, voffA); PG8_STAGE(PG8_SB(1, 1), cB + hstepB + kstep, voffB);
        PG8_WAIT_V(6); PG8_BAR;
    }
    for (;;) {
        const bool has_next = S.next(ui + 1, nxt);
        const char* nA = has_next ? (const char*)g.A + (size_t)nxt.pm * tstepA : cA; const char* nB = has_next ? PG8_BBASE(nxt) : cB;
        for (int t = 0; t < nt; t += 2) {
            if constexpr (Epi::HOOK_T > 0) { if (t == Epi::HOOK_T) { PG8_SCHED; E.mid(acc, cur, wr, wc, fr, fq); PG8_SCHED; } }
            const bool last = (t == nt - 2);
            const char* a1 = cA + (size_t)(t + 1) * kstep;
            const char* a2 = last ? nA : cA + (size_t)(t + 2) * kstep; const char* b2 = last ? nB : cB + (size_t)(t + 2) * kstep;
            const char* a3 = a2 + kstep; const char* b3 = b2 + kstep;
            if constexpr (SP2) {
            PG8_LDB(B0, 0, 0); PG8_LDB(B1, 0, 1); PG8_SCHED; PG8_LDA(At, 0, 0); PG8_STAGE(PG8_SA(1, 1), a1 + hstepA, voffA);
            PG8_WAIT_V(8); PG8_WAIT_L(0); PG8_BAR; PG8_MMA(0, 0, At, B0); PG8_MMA(0, 1, At, B1); PG8_BAR; PG8_SCHED;
            PG8_LDA(At, 0, 1); PG8_STAGE(PG8_SB(0, 0), b2, voffB); PG8_STAGE(PG8_SB(0, 1), b2 + hstepB, voffB); PG8_STAGE(PG8_SA(0, 0), a2, voffA);
            PG8_WAIT_V(8); PG8_WAIT_L(0); PG8_BAR; PG8_MMA(1, 0, At, B0); PG8_MMA(1, 1, At, B1); PG8_BAR; PG8_SCHED;
            PG8_LDB(B0, 1, 0); PG8_LDB(B1, 1, 1); PG8_SCHED; PG8_LDA(At, 1, 0); PG8_STAGE(PG8_SA(0, 1), a2 + hstepA, voffA);
            PG8_WAIT_V(8); PG8_WAIT_L(0); PG8_BAR; PG8_MMA(0, 0, At, B0); PG8_MMA(0, 1, At, B1); PG8_BAR; PG8_SCHED;
            PG8_LDA(At, 1, 1); PG8_STAGE(PG8_SB(1, 0), b3, voffB); PG8_STAGE(PG8_SB(1, 1), b3 + hstepB, voffB); PG8_STAGE(PG8_SA(1, 0), a3, voffA);
            PG8_WAIT_V(8); PG8_WAIT_L(0); PG8_BAR; PG8_MMA(1, 0, At, B0); PG8_MMA(1, 1, At, B1); PG8_BAR; PG8_SCHED;
            } else {
            PG8_LDB(B0, 0, 0); PG8_SCHED; PG8_LDA(At, 0, 0); PG8_STAGE(PG8_SA(1, 1), a1 + hstepA, voffA);
            PG8_WAIT_L(8); PG8_BAR; PG8_WAIT_L(0); PG8_MMA(0, 0, At, B0); PG8_BAR; PG8_SCHED;
            PG8_LDB(B1, 0, 1); PG8_STAGE(PG8_SB(0, 0), b2, voffB);
            PG8_BAR; PG8_WAIT_L(0); PG8_MMA(0, 1, At, B1); PG8_BAR;
            PG8_LDA(At, 0, 1); PG8_STAGE(PG8_SA(0, 0), a2, voffA);
            PG8_BAR; PG8_WAIT_L(0); PG8_MMA(1, 0, At, B0); PG8_BAR; PG8_SCHED;
            PG8_STAGE(PG8_SB(0, 1), b2 + hstepB, voffB);
            PG8_WAIT_V(6); PG8_BAR; PG8_MMA(1, 1, At, B1); PG8_BAR;
            PG8_LDB(B0, 1, 0); PG8_SCHED; PG8_LDA(At, 1, 0); PG8_STAGE(PG8_SA(0, 1), a2 + hstepA, voffA);
            PG8_WAIT_L(8); PG8_BAR; PG8_WAIT_L(0); PG8_MMA(0, 0, At, B0); PG8_BAR; PG8_SCHED;
            PG8_LDB(B1, 1, 1); PG8_STAGE(PG8_SB(1, 0), b3, voffB);
            PG8_BAR; PG8_WAIT_L(0); PG8_MMA(0, 1, At, B1); PG8_BAR;
            PG8_LDA(At, 1, 1); PG8_STAGE(PG8_SA(1, 0), a3, voffA);
            PG8_BAR; PG8_WAIT_L(0); PG8_MMA(1, 0, At, B0); PG8_BAR; PG8_SCHED;
            PG8_STAGE(PG8_SB(1, 1), b3 + hstepB, voffB);
            PG8_WAIT_V(6); PG8_BAR; PG8_MMA(1, 1, At, B1); PG8_BAR;
            }
        }
        if constexpr (ALIGN_EPI) { if (wr == 0) PG8_BAR; }
        E(acc, cur, wr, wc, fr, fq);
        if (!has_next) break;
#pragma unroll
        for (int a = 0; a < 2; ++a)
#pragma unroll
            for (int b = 0; b < 2; ++b)
#pragma unroll
                for (int m = 0; m < 4; ++m)
#pragma unroll
                    for (int n = 0; n < 2; ++n) acc[a][b][m][n] = (f32x4){0.f, 0.f, 0.f, 0.f};
        cur = nxt; cA = nA; cB = nB; ++ui;
        if constexpr (ALIGN_EPI) { if (wr == 1) PG8_BAR; }
    }
    PG8_WAIT_V(0);
    if constexpr (!ALIGN_EPI) { if (wr == 0) PG8_BAR; }
    PG8_BAR;
#undef PG8_SA
#undef PG8_SB
#undef PG8_STAGE
#undef PG8_LDA
#undef PG8_LDB
#undef PG8_MMA
#undef PG8_WAIT_V
#undef PG8_WAIT_L
#undef PG8_BAR
#undef PG8_SCHED
#undef PG8_BBASE
}
}
namespace pg8 {
__device__ __forceinline__ float sigmoidf_(float x) { return __builtin_amdgcn_rcpf(1.0f + __builtin_amdgcn_exp2f(x * -1.4426950408889634f)); }

struct EpiCols {
    static constexpr bool PERM = true; static constexpr int HOOK_T = 0;
    bf16_t* qkvz; bf16_t* rw; bf16_t* gab; float qscale;
    __device__ __forceinline__ void operator()(const f32x4 (&acc)[2][2][4][2], const Unit& u, int wr, int wc, int fr, int fq) const {
        const int pn = u.pn; bf16_t* base; int pitch, coff, nbj = 2; float sc = 1.f;
        if (pn < 8) { base = qkvz; pitch = 2112; coff = pn * 256; if (pn < 2) sc = qscale; }
        else if (pn < 16) { base = rw; pitch = 2176; coff = (pn - 8) * 256; }
        else if (pn < 24) { base = gab; pitch = 2112; coff = (pn - 16) * 256; }
        else { base = rw; pitch = 2176; coff = 2048; nbj = 1; }
        const int row0 = u.pm * BM + wr * 64 + fr; const int col0 = coff + wc * 32 + 8 * fq;
#pragma unroll
        for (int ai = 0; ai < 2; ++ai)
#pragma unroll
            for (int m = 0; m < 4; ++m) { bf16_t* rowp = base + (size_t)(row0 + ai * HALF + m * 16) * pitch + col0;
#pragma unroll
                for (int bj = 0; bj < 2; ++bj) { if (bj < nbj) { f32x4 v0 = acc[ai][bj][m][0] * sc, v1 = acc[ai][bj][m][1] * sc;
                    u32x4 w; w.x = cvt_pk_bf16(v0[0], v0[1]); w.y = cvt_pk_bf16(v0[2], v0[3]); w.z = cvt_pk_bf16(v1[0], v1[1]); w.w = cvt_pk_bf16(v1[2], v1[3]);
                    *(u32x4*)(rowp + bj * HALF) = w; } } }
    }
};
struct EpiBf16 {
    static constexpr bool PERM = true; static constexpr int HOOK_T = 0;
    bf16_t* O; int ldc;
    __device__ __forceinline__ void operator()(const f32x4 (&acc)[2][2][4][2], const Unit& u, int wr, int wc, int fr, int fq) const {
        const int row0 = u.pm * BM + wr * 64 + fr; const int col0 = u.pn * BM + wc * 32 + 8 * fq;
#pragma unroll
        for (int ai = 0; ai < 2; ++ai)
#pragma unroll
            for (int m = 0; m < 4; ++m) { bf16_t* rowp = O + (size_t)(row0 + ai * HALF + m * 16) * ldc + col0;
#pragma unroll
                for (int bj = 0; bj < 2; ++bj) { const f32x4 v0 = acc[ai][bj][m][0], v1 = acc[ai][bj][m][1];
                    u32x4 w; w.x = cvt_pk_bf16(v0[0], v0[1]); w.y = cvt_pk_bf16(v0[2], v0[3]); w.z = cvt_pk_bf16(v1[0], v1[1]); w.w = cvt_pk_bf16(v1[2], v1[3]);
                    *(u32x4*)(rowp + bj * HALF) = w; } }
    }
};
struct EpiF32 {
    static constexpr bool PERM = false; static constexpr int HOOK_T = 0;
    float* O; int ldc;
    __device__ __forceinline__ void operator()(const f32x4 (&acc)[2][2][4][2], const Unit& u, int wr, int wc, int fr, int fq) const {
        const int row0 = u.pm * BM + wr * 64 + fr; const int col0 = u.pn * BM + wc * 32 + 4 * fq;
#pragma unroll
        for (int ai = 0; ai < 2; ++ai)
#pragma unroll
            for (int m = 0; m < 4; ++m) { float* rowp = O + (size_t)(row0 + ai * HALF + m * 16) * ldc + col0;
#pragma unroll
                for (int bj = 0; bj < 2; ++bj)
#pragma unroll
                    for (int n = 0; n < 2; ++n) *(f32x4*)(rowp + bj * HALF + n * 16) = acc[ai][bj][m][n]; }
    }
};
template <bool ADD> struct EpiMerge {
    static constexpr bool PERM = true; static constexpr int HOOK_T = 0;
    bf16_t* O; int ldc; const bf16_t* G; int ldg;
    __device__ __forceinline__ void operator()(const f32x4 (&acc)[2][2][4][2], const Unit& u, int wr, int wc, int fr, int fq) const {
        const int row0 = u.pm * BM + wr * 64 + fr; const int col0 = u.pn * BM + wc * 32 + 8 * fq;
#pragma unroll
        for (int ai = 0; ai < 2; ++ai)
#pragma unroll
            for (int m = 0; m < 4; ++m) { const size_t r = (size_t)(row0 + ai * HALF + m * 16);
#pragma unroll
                for (int bj = 0; bj < 2; ++bj) { const f32x4 v0 = acc[ai][bj][m][0], v1 = acc[ai][bj][m][1];
                    const u32x4 gw = *(const u32x4*)(G + r * ldg + col0 + bj * HALF);
                    float o[8];
                    o[0] = sigmoidf_(bf_lo(gw.x)) * v0[0]; o[1] = sigmoidf_(bf_hi(gw.x)) * v0[1]; o[2] = sigmoidf_(bf_lo(gw.y)) * v0[2]; o[3] = sigmoidf_(bf_hi(gw.y)) * v0[3];
                    o[4] = sigmoidf_(bf_lo(gw.z)) * v1[0]; o[5] = sigmoidf_(bf_hi(gw.z)) * v1[1]; o[6] = sigmoidf_(bf_lo(gw.w)) * v1[2]; o[7] = sigmoidf_(bf_hi(gw.w)) * v1[3];
                    bf16_t* op = O + r * ldc + col0 + bj * HALF;
                    if (ADD) { const u32x4 pw = *(const u32x4*)op;
                        o[0] += bf_lo(pw.x); o[1] += bf_hi(pw.x); o[2] += bf_lo(pw.y); o[3] += bf_hi(pw.y); o[4] += bf_lo(pw.z); o[5] += bf_hi(pw.z); o[6] += bf_lo(pw.w); o[7] += bf_hi(pw.w); }
                    u32x4 w; w.x = cvt_pk_bf16(o[0], o[1]); w.y = cvt_pk_bf16(o[2], o[3]); w.z = cvt_pk_bf16(o[4], o[5]); w.w = cvt_pk_bf16(o[6], o[7]);
                    *(u32x4*)op = w; } }
    }
};
struct EpiYStat {
    static constexpr bool PERM = true; static constexpr int HOOK_T = 0;
    bf16_t* O; int ldc; PG8_LAS float* part;
    __device__ __forceinline__ void operator()(const f32x4 (&acc)[2][2][4][2], const Unit& u, int wr, int wc, int fr, int fq) const {
        const int row0 = u.pm * BM + wr * 64 + fr; const int col0 = u.pn * BM + wc * 32 + 8 * fq;
#pragma unroll
        for (int ai = 0; ai < 2; ++ai)
#pragma unroll
            for (int m = 0; m < 4; ++m) { bf16_t* rowp = O + (size_t)(row0 + ai * HALF + m * 16) * ldc + col0; float s = 0.f;
#pragma unroll
                for (int bj = 0; bj < 2; ++bj) { const f32x4 v0 = acc[ai][bj][m][0], v1 = acc[ai][bj][m][1];
                    u32x4 w; w.x = cvt_pk_bf16(v0[0], v0[1]); w.y = cvt_pk_bf16(v0[2], v0[3]); w.z = cvt_pk_bf16(v1[0], v1[1]); w.w = cvt_pk_bf16(v1[2], v1[3]);
                    *(u32x4*)(rowp + bj * HALF) = w;
                    s += (bf_lo(w.x) * bf_lo(w.x) + bf_hi(w.x) * bf_hi(w.x)) + (bf_lo(w.y) * bf_lo(w.y) + bf_hi(w.y) * bf_hi(w.y)) + (bf_lo(w.z) * bf_lo(w.z) + bf_hi(w.z) * bf_hi(w.z)) + (bf_lo(w.w) * bf_lo(w.w) + bf_hi(w.w) * bf_hi(w.w)); }
                s += __shfl_xor(s, 16); s += __shfl_xor(s, 32);
                if (fq == 0) part[(ai * HALF + wr * 64 + m * 16 + fr) * 16 + wc * 4 + u.pn] = s; }
    }
};
struct EpiMergeFused {
    static constexpr bool PERM = true; static constexpr int HOOK_T = 8;
    bf16_t* O; int ldc; const bf16_t* G; int ldg;
    struct GOps { u32x4 ga[2], gb[2]; };
    __device__ __forceinline__ void loadg(GOps& o, size_t r, int col0, bool both) const {
#pragma unroll
        for (int bj = 0; bj < 2; ++bj) { if (both) o.ga[bj] = *(const u32x4*)(G + r * ldg + col0 + bj * HALF); o.gb[bj] = *(const u32x4*)(G + r * ldg + 1024 + col0 + bj * HALF); }
    }
    __device__ __forceinline__ void mid(f32x4 (&acc)[2][2][4][2], const Unit& u, int wr, int wc, int fr, int fq) const {
        asm volatile("" : "+v"(fr), "+v"(fq));
        const int row0 = u.pm * BM + wr * 64 + fr; const int col0 = u.pn * BM + wc * 32 + 8 * fq;
        GOps A, B; loadg(A, (size_t)row0, col0, true);
#pragma unroll
        for (int g = 0; g < 8; ++g) { const int ai = g >> 2, m = g & 3; GOps& cur = (g & 1) ? B : A; GOps& nxt = (g & 1) ? A : B;
            if (g < 7) loadg(nxt, (size_t)(row0 + ((g + 1) >> 2) * HALF + ((g + 1) & 3) * 16), col0, true);
            __builtin_amdgcn_sched_barrier(0);
#pragma unroll
            for (int bj = 0; bj < 2; ++bj) { const u32x4 ga = cur.ga[bj], gb = cur.gb[bj];
#define MQ_(wa, wb, HI) ((1.0f + __builtin_amdgcn_exp2f(fmaxf(HI ? bf_hi(wb) : bf_lo(wb), -80.f) * -1.4426950408889634f)) * __builtin_amdgcn_rcpf(1.0f + __builtin_amdgcn_exp2f((HI ? bf_hi(wa) : bf_lo(wa)) * -1.4426950408889634f)))
                acc[ai][bj][m][0][0] *= MQ_(ga.x, gb.x, 0); acc[ai][bj][m][0][1] *= MQ_(ga.x, gb.x, 1); acc[ai][bj][m][0][2] *= MQ_(ga.y, gb.y, 0); acc[ai][bj][m][0][3] *= MQ_(ga.y, gb.y, 1);
                acc[ai][bj][m][1][0] *= MQ_(ga.z, gb.z, 0); acc[ai][bj][m][1][1] *= MQ_(ga.z, gb.z, 1); acc[ai][bj][m][1][2] *= MQ_(ga.w, gb.w, 0); acc[ai][bj][m][1][3] *= MQ_(ga.w, gb.w, 1);
#undef MQ_
            }
            __builtin_amdgcn_sched_barrier(0); }
    }
    __device__ __forceinline__ void operator()(const f32x4 (&acc)[2][2][4][2], const Unit& u, int wr, int wc, int fr, int fq) const {
        asm volatile("" : "+v"(fr), "+v"(fq));
        const int row0 = u.pm * BM + wr * 64 + fr; const int col0 = u.pn * BM + wc * 32 + 8 * fq;
        GOps A, B; loadg(A, (size_t)row0, col0, false);
#pragma unroll
        for (int g = 0; g < 8; ++g) { const int ai = g >> 2, m = g & 3; const size_t r = (size_t)(row0 + ai * HALF + m * 16); GOps& cur = (g & 1) ? B : A; GOps& nxt = (g & 1) ? A : B;
            if (g < 7) loadg(nxt, (size_t)(row0 + ((g + 1) >> 2) * HALF + ((g + 1) & 3) * 16), col0, false);
            __builtin_amdgcn_sched_barrier(0);
#pragma unroll
            for (int bj = 0; bj < 2; ++bj) { const f32x4 v0 = acc[ai][bj][m][0], v1 = acc[ai][bj][m][1]; const u32x4 gw = cur.gb[bj];
                u32x4 w; w.x = cvt_pk_bf16(sigmoidf_(fmaxf(bf_lo(gw.x), -80.f)) * v0[0], sigmoidf_(fmaxf(bf_hi(gw.x), -80.f)) * v0[1]); w.y = cvt_pk_bf16(sigmoidf_(fmaxf(bf_lo(gw.y), -80.f)) * v0[2], sigmoidf_(fmaxf(bf_hi(gw.y), -80.f)) * v0[3]);
                w.z = cvt_pk_bf16(sigmoidf_(fmaxf(bf_lo(gw.z), -80.f)) * v1[0], sigmoidf_(fmaxf(bf_hi(gw.z), -80.f)) * v1[1]); w.w = cvt_pk_bf16(sigmoidf_(fmaxf(bf_lo(gw.w), -80.f)) * v1[2], sigmoidf_(fmaxf(bf_hi(gw.w), -80.f)) * v1[3]);
                *(u32x4*)(O + r * ldc + col0 + bj * HALF) = w; }
            __builtin_amdgcn_sched_barrier(0); }
    }
};
struct EpiFinal {
    static constexpr bool PERM = false; static constexpr int HOOK_T = 0;
    float* out; const float* x; const bf16_t* y; const float* rsy; const float* gpost; const bf16_t* E; int ldc;
    struct Ops { f32x4 xv[4]; u32x2 yw[4], ew[4]; float rs; };
    __device__ __forceinline__ void load(Ops& o, size_t r, int col0) const {
#pragma unroll
        for (int q = 0; q < 4; ++q) { const size_t off = r * ldc + col0 + (q >> 1) * HALF + (q & 1) * 16; o.xv[q] = *(const f32x4*)(x + off); o.yw[q] = *(const u32x2*)(y + off); o.ew[q] = *(const u32x2*)(E + off); }
        o.rs = rsy[r];
    }
    __device__ __forceinline__ void operator()(const f32x4 (&acc)[2][2][4][2], const Unit& u, int wr, int wc, int fr, int fq) const {
        asm volatile("" : "+v"(fr), "+v"(fq));
        const int row0 = u.pm * BM + wr * 64 + fr; const int col0 = u.pn * BM + wc * 32 + 4 * fq;
        f32x4 gp[4];
#pragma unroll
        for (int q = 0; q < 4; ++q) gp[q] = *(const f32x4*)(gpost + col0 + (q >> 1) * HALF + (q & 1) * 16);
        Ops A, B;
        load(A, (size_t)row0, col0);
#pragma unroll
        for (int g = 0; g < 8; ++g) { const int ai = g >> 2, m = g & 3; const size_t r = (size_t)(row0 + ai * HALF + m * 16);
            Ops& cur = (g & 1) ? B : A; Ops& nxt = (g & 1) ? A : B;
            if (g < 7) load(nxt, (size_t)(row0 + ((g + 1) >> 2) * HALF + ((g + 1) & 3) * 16), col0);
            __builtin_amdgcn_sched_barrier(0);
#pragma unroll
            for (int q = 0; q < 4; ++q) { const int bj = q >> 1, n = q & 1; const f32x4 a = acc[ai][bj][m][n]; const f32x4 xv = cur.xv[q]; const u32x2 yw = cur.yw[q], ew = cur.ew[q]; const float rs = cur.rs; f32x4 o;
                o[0] = xv[0] + bf_lo(yw.x) * rs * gp[q][0] + sigmoidf_(a[0]) * bf_lo(ew.x);
                o[1] = xv[1] + bf_hi(yw.x) * rs * gp[q][1] + sigmoidf_(a[1]) * bf_hi(ew.x);
                o[2] = xv[2] + bf_lo(yw.y) * rs * gp[q][2] + sigmoidf_(a[2]) * bf_lo(ew.y);
                o[3] = xv[3] + bf_hi(yw.y) * rs * gp[q][3] + sigmoidf_(a[3]) * bf_hi(ew.y);
                *(f32x4*)(out + r * ldc + col0 + bj * HALF + n * 16) = o; }
            __builtin_amdgcn_sched_barrier(0); }
    }
};
}
#define GAS __attribute__((address_space(1)))
#define LAS __attribute__((address_space(3)))
typedef unsigned short bf16;
typedef unsigned v4u __attribute__((ext_vector_type(4)));
typedef unsigned v2u __attribute__((ext_vector_type(2)));
typedef float f32x4 __attribute__((ext_vector_type(4)));

constexpr int NWAVES = 8, NTHR = 512;
constexpr int BATCH = 16, SEQ = 4096, DM = 1024, M = BATCH * SEQ;
constexpr int NH = 8, HD = 64, AW = 512, PLE = 256;
constexpr int RWC = 2176, INC = 6272, INCP = 6400;
constexpr int NBLK = 16, BLK = 256;
constexpr float RMS_EPS = 1e-6f, GN_EPS = 64e-5f;
constexpr float LOG2E = 1.4426950408889634f;
constexpr float QSCALE = 0.125f * LOG2E;

constexpr size_t MiB = 1u << 20;
constexpr size_t WS_WIN = 2 * MiB;
constexpr size_t WS_WG = 16 * MiB;
constexpr size_t WS_PAB = 32 * MiB;
constexpr size_t WS_WOUT = 34 * MiB;
constexpr size_t WS_WPG = 36 * MiB;
constexpr size_t WS_WPU = 38 * MiB;
constexpr size_t WS_RSY = 39 * MiB;
constexpr size_t WS_PB = 42 * MiB;
constexpr size_t WS_GATE = 74 * MiB;
constexpr int QP = 2112, GP = 2112;
constexpr size_t WS_QKVZ = 138 * MiB;
constexpr size_t WS_RW = 402 * MiB;
constexpr size_t WS_GAB = 674 * MiB;
constexpr size_t WS_END = 1004 * MiB;
constexpr size_t WS_CNT = 0;
constexpr size_t WS_QCTR = 16384;
constexpr size_t WS_WUPT = 39 * MiB + 512 * 1024, WS_AUPT = WS_WUPT + 65536;
constexpr size_t WS_BON = 938 * MiB;
constexpr size_t WS_SC = 940 * MiB;
constexpr size_t DO_PARTO = 0, DO_PARTML = 192 * MiB, DO_LISTS = 208 * MiB;

__device__ const unsigned char T5B[128] = {0, 1, 2, 3, 4, 5, 6, 7, 8, 9, 10, 11, 12, 13, 14, 15, 16, 16, 16, 17, 17, 18, 18, 18, 19, 19, 19, 20, 20, 20, 20, 21, 21, 21, 21, 22, 22, 22, 22, 22, 23, 23, 23, 23, 23, 23, 24, 24, 24, 24, 24, 24, 25, 25, 25, 25, 25, 25, 25, 26, 26, 26, 26, 26, 26, 26, 26, 27, 27, 27, 27, 27, 27, 27, 27, 27, 27, 28, 28, 28, 28, 28, 28, 28, 28, 28, 28, 29, 29, 29, 29, 29, 29, 29, 29, 29, 29, 29, 29, 30, 30, 30, 30, 30, 30, 30, 30, 30, 30, 30, 30, 30, 30, 31, 31, 31, 31, 31, 31, 31, 31, 31, 31, 31, 31, 31, 31, 31};

typedef float f32x2_cv __attribute__((ext_vector_type(2))); typedef __bf16 bf16x2_cv __attribute__((ext_vector_type(2)));
__device__ __forceinline__ unsigned pk2(float lo, float hi) { f32x2_cv v = {lo, hi}; bf16x2_cv b = __builtin_convertvector(v, bf16x2_cv); return __builtin_bit_cast(unsigned, b); }
__device__ __forceinline__ unsigned f2bf(float f) { return pk2(f, 0.f) & 0xffffu; }
__device__ __forceinline__ float bf2f(unsigned short h) { return __uint_as_float((unsigned)h << 16); }
__device__ __forceinline__ float wave_sum(float v) {
#pragma unroll
    for (int o = 1; o < 64; o <<= 1) v += __shfl_xor(v, o);
    return v;
}
__device__ __forceinline__ float fexp2(float x) { return __builtin_amdgcn_exp2f(x); }
__device__ __forceinline__ float fexp(float x) { return __builtin_amdgcn_exp2f(x * LOG2E); }
__device__ __forceinline__ float frcp(float x) { return __builtin_amdgcn_rcpf(x); }
__device__ __forceinline__ float frsq(float x) { return __builtin_amdgcn_rsqf(x); }
__device__ __forceinline__ float sigm(float x) { return frcp(1.0f + fexp2(-x * LOG2E)); }
__device__ __forceinline__ float ftanh(float x) { return 1.0f - 2.0f * frcp(1.0f + fexp2(x * (2.0f * LOG2E))); }
__device__ __forceinline__ float dpp_sum32(float v) {
#define DPP_ADD_(ctrl, rmask) v += __builtin_bit_cast(float, __builtin_amdgcn_update_dpp(0, __builtin_bit_cast(int, v), ctrl, rmask, 0xf, true))
    DPP_ADD_(0x118, 0xf); DPP_ADD_(0x114, 0xf); DPP_ADD_(0x112, 0xf); DPP_ADD_(0x111, 0xf);
    v += __builtin_bit_cast(float, __builtin_amdgcn_update_dpp(0, __builtin_bit_cast(int, v), 0x142, 0xa, 0xf, false));
#undef DPP_ADD_
    return v;
}

struct Args {
    const float* in[21]; float* out; unsigned char* ws; int ph_lo, ph_hi;
};
struct Frame {
    LAS unsigned char* lds; int tid, lane, wave, vcu, G;
    const float *x, *p, *g_pre, *w_in, *rel_bias, *mu, *w0, *w_up, *a0, *a_up, *k_k, *k_a, *r_k, *ln_w, *ln_b, *p_a, *p_b, *w_out, *g_post, *w_pu, *w_pg;
    float* out; unsigned char* ws;
};

__device__ __forceinline__ float wave_sum_fast(float v) { v = dpp_sum32(v); return __builtin_bit_cast(float, __builtin_amdgcn_readlane(__builtin_bit_cast(int, v), 31)) + __builtin_bit_cast(float, __builtin_amdgcn_readlane(__builtin_bit_cast(int, v), 63)); }
constexpr size_t WS_BAR = 32768;
#define XB_TMO      128
#define XB_XCNT(j)  (256  + 64 * (j))
#define XB_XSUB(j)  (1280 + 64 * (j))
#define XB_XGEN(j)  (2304 + 64 * (j))
#define XB_TOP      3328
#define XB_TOPGEN   3392
#define XB_SPIN_CAP (1u << 20)
__device__ __forceinline__ unsigned xb_ld(unsigned* p)              { return __hip_atomic_load(p, __ATOMIC_RELAXED, __HIP_MEMORY_SCOPE_AGENT); }
__device__ __forceinline__ unsigned xb_add(unsigned* p, unsigned v) { return __hip_atomic_fetch_add(p, v, __ATOMIC_RELAXED, __HIP_MEMORY_SCOPE_AGENT); }
__device__ __forceinline__ unsigned xb_xcc_id() { return (unsigned)__builtin_amdgcn_s_getreg((3 << 11) | 20) & 0xFu; }
#define XB_SPIN(cond, bar) do { unsigned _sp = 0; while (cond) { __builtin_amdgcn_s_sleep(1); \
    if ((++_sp & 255u) == 0u) { if (xb_ld(&(bar)[XB_TMO])) break; if (_sp > XB_SPIN_CAP) { atomicAdd(&(bar)[XB_TMO], 1u); break; } } } } while (0)
__device__ __forceinline__ void xcd_barrier_post(unsigned* bar) { if (threadIdx.x == 0) (void)xb_add(&bar[XB_XCNT(xb_xcc_id())], 1u); }
__device__ __forceinline__ void xcd_barrier_complete(unsigned* bar, unsigned x, unsigned& nloc, unsigned& nx) {
    const unsigned G = gridDim.x * gridDim.y * gridDim.z;
    unsigned sum, cnt, mine, sp = 0u;
    for (;;) {
        sum = 0u; cnt = 0u; mine = 0u;
#pragma unroll
        for (unsigned j = 0; j < 16; ++j) { const unsigned c = xb_ld(&bar[XB_XCNT(j)]); sum += c; cnt += (c > 0u) ? 1u : 0u; mine = (j == x) ? c : mine; }
        if (sum == G) break;
        __builtin_amdgcn_s_sleep(1);
        if ((++sp & 255u) == 0u) { if (xb_ld(&bar[XB_TMO])) break; if (sp > XB_SPIN_CAP) { atomicAdd(&bar[XB_TMO], 1u); break; } }
    }
    nloc = mine > 0u ? mine : 1u; nx = cnt > 0u ? cnt : 1u;
}
__device__ __forceinline__ void xcd_barrier(unsigned* bar, volatile LAS unsigned* st) {
    asm volatile("s_waitcnt vmcnt(0)" ::: "memory");
    __syncthreads();
    if (threadIdx.x == 0) {
        const unsigned x = xb_xcc_id();
        __builtin_amdgcn_s_waitcnt(0);
        unsigned nloc = st[0], nx = st[1];
        if (nloc == 0u) { xcd_barrier_complete(bar, x, nloc, nx); st[0] = nloc; st[1] = nx; }
        const unsigned old = xb_add(&bar[XB_XSUB(x)], 1u);
        const unsigned gen = old / nloc;
        if (old + 1u == (gen + 1u) * nloc) {
            __builtin_amdgcn_fence(__ATOMIC_RELEASE, "agent");
            asm volatile("s_waitcnt vmcnt(0)" ::: "memory");
            const unsigned og = xb_add(&bar[XB_TOP], 1u);
            const unsigned tg = og / nx;
            if (og + 1u == (tg + 1u) * nx) xb_add(&bar[XB_TOPGEN], 1u);
            else XB_SPIN(xb_ld(&bar[XB_TOPGEN]) == tg, bar);
            __builtin_amdgcn_fence(__ATOMIC_ACQUIRE, "agent");
            xb_add(&bar[XB_XGEN(x)], 1u);
            asm volatile("s_waitcnt vmcnt(0)" ::: "memory");
        } else {
            XB_SPIN(xb_ld(&bar[XB_XGEN(x)]) == gen, bar);
            __builtin_amdgcn_fence(__ATOMIC_ACQUIRE, "agent");
            asm volatile("s_waitcnt vmcnt(0)" ::: "memory");
        }
    }
    __syncthreads();
}

__device__ __forceinline__ void transpose_item(const float* W, int N, int k0, int n0, bf16* WT, int ldw, int drow0, int koff, LAS float* scr, int lane) {
#pragma unroll 8
    for (int i = 0; i < 32; ++i) { const int kk = 2 * i + (lane >> 5); scr[kk * 33 + (lane & 31)] = W[(size_t)(k0 + kk) * N + n0 + (lane & 31)]; }
    asm volatile("s_waitcnt lgkmcnt(0)" ::: "memory");
    const int c = lane & 7;
#pragma unroll
    for (int j = 0; j < 4; ++j) { const int n = (lane >> 3) + 8 * j; const LAS float* s = scr + (8 * c) * 33 + n;
        v4u o; o.x = pk2(s[0 * 33], s[1 * 33]); o.y = pk2(s[2 * 33], s[3 * 33]); o.z = pk2(s[4 * 33], s[5 * 33]); o.w = pk2(s[6 * 33], s[7 * 33]);
        *(v4u*)(WT + (size_t)(drow0 + n) * ldw + koff + k0 + 8 * c) = o; }
    asm volatile("s_waitcnt lgkmcnt(0)" ::: "memory");
}

__device__ __forceinline__ void p0_prologue(Frame& F) {
    LAS float* scr = (LAS float*)(F.lds + F.wave * 16384);
    const int gw = F.vcu * NWAVES + F.wave, NGW = F.G * NWAVES;
    bf16* WinT = (bf16*)(F.ws + WS_WIN); bf16* PabT = (bf16*)(F.ws + WS_PAB); bf16* WoutT = (bf16*)(F.ws + WS_WOUT); bf16* WpgT = (bf16*)(F.ws + WS_WPG); bf16* WpuT = (bf16*)(F.ws + WS_WPU);
#ifndef MK_PRO_REP
#define MK_PRO_REP 0
#endif
    constexpr int I_IN = 16 * (INC / 32), I_PA = 8 * 32, I_PB = 8 * 32, I_WO = 16 * 32, I_PG = 16 * 32, I_PU = 4 * 32, I_UP = 16;
    constexpr int NIT = I_IN + I_PA + I_PB + I_WO + I_PG + I_PU + 2 * I_UP;
    for (int rpa = 0; rpa < (MK_PRO_REP == 1 ? 2 : 1); ++rpa)
    for (int it = gw; it < NIT; it += NGW) {
        int r = it;
        if (r < I_IN) { const int nb = r % (INC / 32), kb = r / (INC / 32), n0 = nb * 32;
            const int d0 = n0 < 4096 ? n0 : (n0 < 4224 ? n0 + 2048 : n0 - 128);
            transpose_item(F.w_in, INC, kb * 64, n0, WinT, DM, d0, 0, scr, F.lane); continue; } r -= I_IN;
        if (r < I_PA) { transpose_item(F.p_a, DM, (r / 32) * 64, (r % 32) * 32, PabT, 1024, (r % 32) * 32, 0, scr, F.lane); continue; } r -= I_PA;
        if (r < I_PB) { transpose_item(F.p_b, DM, (r / 32) * 64, (r % 32) * 32, PabT, 1024, (r % 32) * 32, 512, scr, F.lane); continue; } r -= I_PB;
        if (r < I_WO) { transpose_item(F.w_out, DM, (r / 32) * 64, (r % 32) * 32, WoutT, 1024, (r % 32) * 32, 0, scr, F.lane); continue; } r -= I_WO;
        if (r < I_PG) { transpose_item(F.w_pg, DM, (r / 32) * 64, (r % 32) * 32, WpgT, 1024, (r % 32) * 32, 0, scr, F.lane); continue; } r -= I_PG;
        if (r < I_PU) { transpose_item(F.w_pu, DM, (r / 32) * 64, (r % 32) * 32, WpuT, 256, (r % 32) * 32, 0, scr, F.lane); continue; } r -= I_PU;
        if (r < I_UP) { transpose_item(F.w_up, AW, 0, r * 32, (bf16*)(F.ws + WS_WUPT), 64, r * 32, 0, scr, F.lane); continue; } r -= I_UP;
        transpose_item(F.a_up, AW, 0, r * 32, (bf16*)(F.ws + WS_AUPT), 64, r * 32, 0, scr, F.lane);
    }
    for (int i = gw * 64 + F.lane; i < 128 * 1024 / 8; i += NGW * 64) *(v4u*)(WinT + (size_t)INC * DM + (size_t)i * 8) = (v4u){0u, 0u, 0u, 0u};
    for (int rpc = 0; rpc < (MK_PRO_REP == 2 ? 2 : 1); ++rpc) { bf16* PB = (bf16*)(F.ws + WS_PB); const size_t n8 = (size_t)M * PLE / 8;
      for (size_t i = (size_t)F.vcu * NTHR + F.tid; i < n8; i += (size_t)F.G * NTHR) { const f32x4 a = *(const f32x4*)(F.p + i * 8), b = *(const f32x4*)(F.p + i * 8 + 4);
          v4u o; o.x = pk2(a[0], a[1]); o.y = pk2(a[2], a[3]); o.z = pk2(b[0], b[1]); o.w = pk2(b[2], b[3]); *(v4u*)(PB + i * 8) = o; } }
    __syncthreads();
    LAS float* red = (LAS float*)F.lds;
    LAS float* ubar = (LAS float*)(F.lds + 32768);
    LAS float* kmean = (LAS float*)(F.lds + 36864);
    bf16* U2 = (bf16*)F.out; bf16* WgT = (bf16*)(F.ws + WS_WG);
    for (int blk = F.vcu; blk < M / BLK; blk += F.G) {
        float cs[16];
#pragma unroll
        for (int i = 0; i < 16; ++i) cs[i] = 0.f;
        f32x4 gv[4];
#pragma unroll
        for (int j = 0; j < 4; ++j) gv[j] = *((const f32x4*)F.g_pre + F.lane + 64 * j);
        for (int rpx = 0; rpx < (MK_PRO_REP == 3 ? 2 : 1); ++rpx)
        for (int i = 0; i < 8; ++i) {
            f32x4 v[4][4];
#pragma unroll
            for (int r = 0; r < 4; ++r) { const f32x4* xr = (const f32x4*)(F.x + ((size_t)blk * BLK + F.wave + 8 * (4 * i + r)) * DM) + F.lane;
#pragma unroll
                for (int j = 0; j < 4; ++j) v[r][j] = xr[64 * j]; }
#pragma unroll
            for (int r = 0; r < 4; ++r) { const size_t row = (size_t)blk * BLK + F.wave + 8 * (4 * i + r); float s = 0.f;
#pragma unroll
                for (int j = 0; j < 4; ++j) s += (v[r][j][0] * v[r][j][0] + v[r][j][1] * v[r][j][1]) + (v[r][j][2] * v[r][j][2] + v[r][j][3] * v[r][j][3]);
                const float rs = frsq(wave_sum_fast(s) * (1.f / DM) + RMS_EPS);
#pragma unroll
                for (int j = 0; j < 4; ++j) {
                    float u[4]; unsigned h[4], l[4];
#pragma unroll
                    for (int e = 0; e < 4; ++e) { u[e] = v[r][j][e] * rs * gv[j][e]; cs[j * 4 + e] += u[e]; h[e] = f2bf(u[e]); l[e] = f2bf(u[e] - __uint_as_float(h[e] << 16)); }
                    const int col = 4 * F.lane + 256 * j;
                    *(v2u*)(U2 + row * 2048 + col) = (v2u){h[0] | (h[1] << 16), h[2] | (h[3] << 16)};
                    *(v2u*)(U2 + row * 2048 + 1024 + col) = (v2u){l[0] | (l[1] << 16), l[2] | (l[3] << 16)};
                } }
        }
#pragma unroll
        for (int j = 0; j < 4; ++j)
#pragma unroll
            for (int e = 0; e < 4; ++e) red[F.wave * 1024 + 4 * F.lane + 256 * j + e] = cs[j * 4 + e];
        __syncthreads();
        for (int k = F.tid; k < 1024; k += NTHR) { float s = 0.f;
#pragma unroll
            for (int w = 0; w < 8; ++w) s += red[w * 1024 + k];
            ubar[k] = s * (1.f / BLK); }
        __syncthreads();
        for (int rpk = 0; rpk < (MK_PRO_REP == 4 ? 2 : 1); ++rpk) {
        {
          float acc[8];
#pragma unroll
          for (int e = 0; e < 8; ++e) acc[e] = 0.f;
          const float* wk = F.w_in + 512 + F.lane * 8;
#pragma unroll 1
          for (int k0 = F.wave * 128; k0 < F.wave * 128 + 128; k0 += 16) { f32x4 w[16][2];
#pragma unroll
              for (int i = 0; i < 16; ++i) { const f32x4* p = (const f32x4*)(wk + (size_t)(k0 + i) * INC); w[i][0] = p[0]; w[i][1] = p[1]; }
#pragma unroll
              for (int i = 0; i < 16; ++i) { const float ub = ubar[k0 + i];
#pragma unroll
                  for (int e = 0; e < 4; ++e) { acc[e] += ub * w[i][0][e]; acc[4 + e] += ub * w[i][1][e]; } } }
          __syncthreads();
#pragma unroll
          for (int e = 0; e < 8; ++e) red[F.wave * 512 + F.lane * 8 + e] = acc[e];
          __syncthreads();
          { float s = 0.f;
#pragma unroll
            for (int w = 0; w < 8; ++w) s += red[w * 512 + F.tid];
            kmean[F.tid] = s; } }
        __syncthreads();
        {
          const int b = blk / NBLK, n = blk % NBLK; const int l8 = F.lane * 8;
          float km[8];
#pragma unroll
          for (int e = 0; e < 8; ++e) km[e] = kmean[l8 + e];
#pragma unroll 1
          for (int k0 = F.wave * 8; k0 < 1024; k0 += NWAVES * 8) { f32x4 w[8][2];
#pragma unroll
              for (int r = 0; r < 8; ++r) { const f32x4* wq = (const f32x4*)(F.w_in + (size_t)(k0 + r) * INC + l8); w[r][0] = wq[0]; w[r][1] = wq[1]; }
#pragma unroll
              for (int r = 0; r < 8; ++r) { float s = (w[r][0][0] * km[0] + w[r][0][1] * km[1]) + (w[r][0][2] * km[2] + w[r][0][3] * km[3]) + (w[r][1][0] * km[4] + w[r][1][1] * km[5]) + (w[r][1][2] * km[6] + w[r][1][3] * km[7]);
                  s += __builtin_bit_cast(float, __builtin_amdgcn_update_dpp(0, __builtin_bit_cast(int, s), 0x111, 0xf, 0xf, true));
                  s += __builtin_bit_cast(float, __builtin_amdgcn_update_dpp(0, __builtin_bit_cast(int, s), 0x112, 0xf, 0xf, true));
                  s += __builtin_bit_cast(float, __builtin_amdgcn_update_dpp(0, __builtin_bit_cast(int, s), 0x114, 0xf, 0xf, true));
                  if ((F.lane & 7) == 7) { const int h = F.lane >> 3, k = k0 + r; const unsigned hi = f2bf(s), lo = f2bf(s - __uint_as_float(hi << 16));
                      bf16* r0 = WgT + ((size_t)b * 256 + h * 16 + n) * 2048; bf16* r1 = WgT + ((size_t)b * 256 + 128 + h * 16 + n) * 2048;
                      r0[k] = (bf16)hi; r0[1024 + k] = (bf16)hi; r1[k] = (bf16)lo; r1[1024 + k] = (bf16)lo; } } } }
        __syncthreads(); }
        __syncthreads();
    }
}

__device__ __forceinline__ void panel_norm(Frame& F, int pm, const bf16* Y, bf16* H1, float* RSY, const LAS float* part) {
    f32x4 gv[4];
#pragma unroll
    for (int j = 0; j < 4; ++j) gv[j] = *((const f32x4*)F.g_post + F.lane + 64 * j);
    for (int i = 0; i < 8; ++i) {
        v2u yw[4][4]; f32x4 xv[4][4]; float rs[4];
#pragma unroll
        for (int r = 0; r < 4; ++r) { const int rl = F.wave * 32 + 4 * i + r; const size_t row = (size_t)pm * 256 + rl;
            const v2u* yr = (const v2u*)(Y + row * DM) + F.lane; const f32x4* xr = (const f32x4*)(F.x + row * DM) + F.lane;
#pragma unroll
            for (int j = 0; j < 4; ++j) { yw[r][j] = yr[64 * j]; xv[r][j] = xr[64 * j]; }
            const LAS f32x4* pp = (const LAS f32x4*)(part + rl * 16); const f32x4 a = pp[0], b = pp[1], c = pp[2], d = pp[3];
            rs[r] = frsq((((a[0] + a[1]) + (a[2] + a[3])) + ((b[0] + b[1]) + (b[2] + b[3])) + ((c[0] + c[1]) + (c[2] + c[3])) + ((d[0] + d[1]) + (d[2] + d[3]))) * (1.f / DM) + RMS_EPS);
            if (F.lane == 0) RSY[row] = rs[r]; }
#pragma unroll
        for (int r = 0; r < 4; ++r) { const size_t row = (size_t)pm * 256 + F.wave * 32 + 4 * i + r;
#pragma unroll
            for (int j = 0; j < 4; ++j) { const v2u w = yw[r][j]; const float yv[4] = {__uint_as_float(w.x << 16), __uint_as_float(w.x & 0xffff0000u), __uint_as_float(w.y << 16), __uint_as_float(w.y & 0xffff0000u)}; float h[4];
#pragma unroll
                for (int e = 0; e < 4; ++e) h[e] = xv[r][j][e] + yv[e] * rs[r] * gv[j][e];
                *(v2u*)(H1 + row * DM + 4 * F.lane + 256 * j) = (v2u){pk2(h[0], h[1]), pk2(h[2], h[3])}; } }
    }
}

__device__ __forceinline__ void post_norm(Frame& F) {
    const bf16* Y = (const bf16*)(F.ws + WS_RW); float* RSY = (float*)(F.ws + WS_RSY); bf16* H1 = (bf16*)(F.ws + WS_QKVZ);
    const int gw = F.vcu * NWAVES + F.wave, NGW = F.G * NWAVES;
    f32x4 gv[4];
#pragma unroll
    for (int j = 0; j < 4; ++j) gv[j] = *((const f32x4*)F.g_post + F.lane + 64 * j);
    for (int row0 = gw * 4; row0 < M; row0 += NGW * 4) {
        v2u yw[4][4]; f32x4 xv[4][4];
#pragma unroll
        for (int r = 0; r < 4; ++r) { const v2u* yr = (const v2u*)(Y + (size_t)(row0 + r) * DM) + F.lane; const f32x4* xr = (const f32x4*)(F.x + (size_t)(row0 + r) * DM) + F.lane;
#pragma unroll
            for (int j = 0; j < 4; ++j) { yw[r][j] = yr[64 * j]; xv[r][j] = xr[64 * j]; } }
#pragma unroll
        for (int r = 0; r < 4; ++r) { f32x4 v[4]; float s = 0.f;
#pragma unroll
            for (int j = 0; j < 4; ++j) { const v2u w = yw[r][j]; v[j] = (f32x4){__uint_as_float(w.x << 16), __uint_as_float(w.x & 0xffff0000u), __uint_as_float(w.y << 16), __uint_as_float(w.y & 0xffff0000u)}; s += (v[j][0] * v[j][0] + v[j][1] * v[j][1]) + (v[j][2] * v[j][2] + v[j][3] * v[j][3]); }
            const float rs = frsq(wave_sum_fast(s) * (1.f / DM) + RMS_EPS);
            if (F.lane == 0) RSY[row0 + r] = rs;
#pragma unroll
            for (int j = 0; j < 4; ++j) { float h[4];
#pragma unroll
                for (int e = 0; e < 4; ++e) h[e] = xv[r][j][e] + v[j][e] * rs * gv[j][e];
                *(v2u*)(H1 + (size_t)(row0 + r) * DM + 4 * F.lane + 256 * j) = (v2u){pk2(h[0], h[1]), pk2(h[2], h[3])}; } }
    }
}
namespace moba {
using bf16x8 = __attribute__((ext_vector_type(8))) short;
using s16x4 = __attribute__((ext_vector_type(4))) short;
using f32x16 = __attribute__((ext_vector_type(16))) float;
using u32x4 = __attribute__((ext_vector_type(4))) unsigned;
typedef short v4i16_t __attribute__((ext_vector_type(4)));
typedef float f32x2_t __attribute__((ext_vector_type(2))); typedef __bf16 bf16x2_t __attribute__((ext_vector_type(2)));
__device__ __forceinline__ int crow(int r, int hi) { return (r & 3) + 8 * (r >> 2) + 4 * hi; }
__device__ __forceinline__ unsigned cvtpk(float lo, float hi) { f32x2_t v = {lo, hi}; bf16x2_t b = __builtin_convertvector(v, bf16x2_t); return __builtin_bit_cast(unsigned, b); }
__device__ __forceinline__ float max3f(float a, float b, float c) { return fmaxf(fmaxf(a, b), c); }

constexpr int SLOTB = 8192;
__device__ __forceinline__ void qkt(f32x16& p0, f32x16& p1, const LAS unsigned char* Kslot, const bf16x8* qr, int r32, int hi) {
    const LAS unsigned char* kb = Kslot + hi * 1024 + r32 * 16;
    const f32x16 z = {};
#pragma unroll
    for (int d0 = 0; d0 < 4; ++d0) {
        const bf16x8 b0 = *(const LAS bf16x8*)(kb + d0 * 2048);
        const bf16x8 b1 = *(const LAS bf16x8*)(kb + d0 * 2048 + 512);
        if (d0 == 0) { p0 = __builtin_amdgcn_mfma_f32_32x32x16_bf16(b0, qr[0], z, 0, 0, 0); p1 = __builtin_amdgcn_mfma_f32_32x32x16_bf16(b1, qr[0], z, 0, 0, 0); }
        else { p0 = __builtin_amdgcn_mfma_f32_32x32x16_bf16(b0, qr[d0], p0, 0, 0, 0); p1 = __builtin_amdgcn_mfma_f32_32x32x16_bf16(b1, qr[d0], p1, 0, 0, 0); } }
}
__device__ __forceinline__ void qkt_acc(f32x16& p0, f32x16& p1, const LAS unsigned char* Kslot, const bf16x8* qr, int r32, int hi) {
    const LAS unsigned char* kb = Kslot + hi * 1024 + r32 * 16;
#pragma unroll
    for (int d0 = 0; d0 < 4; ++d0) {
        const bf16x8 b0 = *(const LAS bf16x8*)(kb + d0 * 2048);
        const bf16x8 b1 = *(const LAS bf16x8*)(kb + d0 * 2048 + 512);
        p0 = __builtin_amdgcn_mfma_f32_32x32x16_bf16(b0, qr[d0], p0, 0, 0, 0); p1 = __builtin_amdgcn_mfma_f32_32x32x16_bf16(b1, qr[d0], p1, 0, 0, 0); }
}
__device__ __forceinline__ void pv(f32x16* o, int vb, bf16x8 pa0, bf16x8 pa1, bf16x8 pa2, bf16x8 pa3) {
#pragma unroll
    for (int d0 = 0; d0 < 2; ++d0) { s16x4 lo[4], hi[4];
#pragma unroll
        for (int ks = 0; ks < 4; ++ks) {
            asm volatile("ds_read_b64_tr_b16 %0,%1 offset:%c2" : "=&v"(lo[ks]) : "v"(vb), "i"(d0 * 4096 + ks * 1024) : "memory");
            asm volatile("ds_read_b64_tr_b16 %0,%1 offset:%c2" : "=&v"(hi[ks]) : "v"(vb), "i"(d0 * 4096 + ks * 1024 + 512) : "memory"); }
        asm volatile("s_waitcnt lgkmcnt(0)" ::: "memory"); __builtin_amdgcn_sched_barrier(0);
#define PK(k) (bf16x8){lo[k][0], lo[k][1], lo[k][2], lo[k][3], hi[k][0], hi[k][1], hi[k][2], hi[k][3]}
        o[d0] = __builtin_amdgcn_mfma_f32_32x32x16_bf16(pa0, PK(0), o[d0], 0, 0, 0);
        o[d0] = __builtin_amdgcn_mfma_f32_32x32x16_bf16(pa1, PK(1), o[d0], 0, 0, 0);
        o[d0] = __builtin_amdgcn_mfma_f32_32x32x16_bf16(pa2, PK(2), o[d0], 0, 0, 0);
        o[d0] = __builtin_amdgcn_mfma_f32_32x32x16_bf16(pa3, PK(3), o[d0], 0, 0, 0);
#undef PK
    }
}
__device__ __forceinline__ float rowmax2(const f32x16& p0, const f32x16& p1, float a) {
#pragma unroll
    for (int r = 0; r < 16; r += 2) { a = max3f(a, p0[r], p0[r + 1]); a = max3f(a, p1[r], p1[r + 1]); }
    return a;
}
__device__ __forceinline__ float swapmax(float m) { auto rr = __builtin_amdgcn_permlane32_swap(__float_as_uint(m), __float_as_uint(m), false, false); return fmaxf(__uint_as_float(rr[0]), __uint_as_float(rr[1])); }
__device__ __forceinline__ float swapsum(float m) { auto rr = __builtin_amdgcn_permlane32_swap(__float_as_uint(m), __float_as_uint(m), false, false); return __uint_as_float(rr[0]) + __uint_as_float(rr[1]); }

__device__ __forceinline__ void load_kv_block(LAS unsigned char* lds, int KOFF, int VOFF, const bf16* QKVZ, size_t krow0, int h, int wid, int lane) {
    const bf16* ksrc = QKVZ + (krow0 + lane) * QP + 512 + h * HD + wid * 8;
    const bf16* vsrc = QKVZ + (krow0 + 16 * (wid & 3) + (lane >> 2)) * QP + 1024 + h * HD + (wid >> 2) * 32 + (lane & 3) * 8;
#pragma unroll
    for (int t = 0; t < 4; ++t) {
        __builtin_amdgcn_global_load_lds((const unsigned*)(ksrc + (size_t)t * 64 * QP), (LAS unsigned*)(lds + KOFF + t * SLOTB + wid * 1024), 16, 0, 0);
        __builtin_amdgcn_global_load_lds((const unsigned*)(vsrc + (size_t)t * 64 * QP), (LAS unsigned*)(lds + VOFF + t * SLOTB + wid * 1024), 16, 0, 0); }
}
}

constexpr int LIST_CAP = 3840;

__device__ __forceinline__ void attn_select(Frame& F, const float* GATE, unsigned* CNT, unsigned short* LISTS) {
    const int gw = F.vcu * NWAVES + F.wave, NGW = F.G * NWAVES;
    for (int it = gw; it < BATCH * NH * (SEQ / 64); it += NGW) {
        const int sg = it % (SEQ / 64), h = (it / (SEQ / 64)) % NH, b = it / (SEQ / 64 * NH);
        const int s = sg * 64 + F.lane, qb = s >> 8; const size_t row = (size_t)b * SEQ + s;
        if (qb == 0) continue;
        float g0 = -INFINITY, g1 = -INFINITY, g2 = -INFINITY; int i0 = -1, i1 = -1, i2 = -1;
        const f32x4* gp = (const f32x4*)(GATE + row * 256 + h * 16); const f32x4* gl = (const f32x4*)(GATE + row * 256 + 128 + h * 16);
#pragma unroll
        for (int c = 0; c < 4; ++c) { const f32x4 a = gp[c], l = gl[c];
#pragma unroll
            for (int e = 0; e < 4; ++e) { const int n = c * 4 + e; const float g = (n < qb) ? a[e] + l[e] : -INFINITY;
                if (g > g0) { g2 = g1; i2 = i1; g1 = g0; i1 = i0; g0 = g; i0 = n; } else if (g > g1) { g2 = g1; i2 = i1; g1 = g; i1 = n; } else if (g > g2) { g2 = g; i2 = n; } } }
        unsigned* cnt = CNT + (b * NH + h) * 16; unsigned short* lst = LISTS + (size_t)(b * NH + h) * 16 * LIST_CAP;
        int r0 = 0, r1 = 0, r2 = 0; unsigned mycnt = 0u;
        for (int n = 0; n < qb; ++n) {
            const bool pick = (i0 == n) | (i1 == n) | (i2 == n);
            const unsigned long long mask = __ballot(pick);
            const int before = __builtin_amdgcn_mbcnt_hi((unsigned)(mask >> 32), __builtin_amdgcn_mbcnt_lo((unsigned)mask, 0u));
            if (i0 == n) r0 = before; if (i1 == n) r1 = before; if (i2 == n) r2 = before;
            if (F.lane == n) mycnt = (unsigned)__popcll(mask);
        }
        unsigned base = 0u;
        if (F.lane < qb && mycnt) base = atomicAdd(cnt + F.lane, mycnt);
        const unsigned b0 = __shfl(base, i0 < 0 ? 0 : i0), b1 = __shfl(base, i1 < 0 ? 0 : i1), b2 = __shfl(base, i2 < 0 ? 0 : i2);
        if (i0 >= 0) lst[(size_t)i0 * LIST_CAP + b0 + r0] = (unsigned short)(s | (0 << 12));
        if (i1 >= 0) lst[(size_t)i1 * LIST_CAP + b1 + r1] = (unsigned short)(s | (1 << 12));
        if (i2 >= 0) lst[(size_t)i2 * LIST_CAP + b2 + r2] = (unsigned short)(s | (2 << 12));
    }
}

__device__ __forceinline__ void attn_partial(Frame& F, const bf16* QKVZ, const unsigned* CNT, const unsigned short* LISTS, bf16* PART_O, float* PART_ML, unsigned* QCTR) {
    using namespace moba;
    LAS unsigned char* lds = F.lds; const int wid = F.wave, lane = F.lane, r32 = lane & 31, hi = lane >> 5;
    LAS float* btab = (LAS float*)(lds + 102400); LAS unsigned* uword = (LAS unsigned*)(lds + 106496); LAS unsigned short* llist = (LAS unsigned short*)(lds + 106624);
    LAS float* wsf = (LAS float*)(lds + 98304) + wid * 128; LAS bf16* stg = (LAS bf16*)(lds + 65536) + wid * 2048;
    for (int i = F.tid; i < NH * 128; i += NTHR) { const int h = i >> 7, d = i & 127; btab[i] = (F.rel_bias[T5B[d] * NH + h] - F.rel_bias[31 * NH + h]) * LOG2E; }
    const int vb0 = (int)(uintptr_t)(lds + 32768) + ((lane >> 4) & 1) * 32 + (lane & 3) * 8 + (4 * hi + ((lane & 15) >> 2)) * 64;
    const int NUNIT = BATCH * NH * 15;
    for (;;) {
        __syncthreads();
        if (F.tid == 0) uword[0] = atomicAdd(QCTR, 1u);
        __syncthreads();
        const int u = (int)uword[0];
        if (u >= NUNIT) break;
        const int n = u / (BATCH * NH), bh = u % (BATCH * NH), b = bh / NH, h = bh % NH;
        load_kv_block(lds, 0, 32768, QKVZ, (size_t)b * SEQ + n * BLK, h, wid, lane);
        const int cnt = (int)CNT[bh * 16 + n]; const unsigned short* lst = LISTS + ((size_t)bh * 16 + n) * LIST_CAP;
        for (int i = F.tid; i < (cnt + 1) / 2; i += NTHR) ((LAS unsigned*)llist)[i] = ((const unsigned*)lst)[i];
        const float b31 = F.rel_bias[31 * NH + h] * LOG2E;
        __syncthreads();
        const int ntile = (cnt + 31) >> 5;
        bf16x8 qn[4]; int tile = wid;
        if (tile < ntile) { const int idx = tile * 32 + r32; const unsigned e = llist[idx < cnt ? idx : 0]; const size_t row = (size_t)b * SEQ + (e & 4095);
#pragma unroll
            for (int d0 = 0; d0 < 4; ++d0) qn[d0] = *(const bf16x8*)(QKVZ + row * QP + h * HD + d0 * 16 + hi * 8); }
        for (; tile < ntile; tile += NWAVES) {
            int lane_ = F.tid; asm volatile("" : "+v"(lane_)); lane_ &= 63;
            const int lane = lane_, r32 = lane & 31, hi = lane >> 5;
            const int vb0 = (int)(uintptr_t)(lds + 32768) + ((lane >> 4) & 1) * 32 + (lane & 3) * 8 + (4 * hi + ((lane & 15) >> 2)) * 64;
            const int idx = tile * 32 + r32; const bool valid = idx < cnt;
            const unsigned e = llist[valid ? idx : 0]; const int s = e & 4095, slot = e >> 12; const size_t row = (size_t)b * SEQ + s;
            bf16x8 qr[4];
#pragma unroll
            for (int d0 = 0; d0 < 4; ++d0) qr[d0] = qn[d0];
            if (tile + NWAVES < ntile) { const int idx2 = (tile + NWAVES) * 32 + r32; const unsigned e2 = llist[idx2 < cnt ? idx2 : 0]; const size_t row2 = (size_t)b * SEQ + (e2 & 4095);
#pragma unroll
                for (int d0 = 0; d0 < 4; ++d0) qn[d0] = *(const bf16x8*)(QKVZ + row2 * QP + h * HD + d0 * 16 + hi * 8); }
            f32x16 o[2]; o[0] = f32x16{}; o[1] = f32x16{};
            float mx = -INFINITY, l = 0.f;
            const bool near = ((s >> 8) == n + 1);
            const int dbase = near ? (s - (n * BLK + 128)) : 100000;
#pragma unroll
            for (int half = 0; half < 2; ++half) {
                if (half) __builtin_amdgcn_sched_barrier(0);
                f32x16 p[2][2];
                if (half == 1) {
#pragma unroll
                    for (int t = 0; t < 2; ++t)
#pragma unroll
                        for (int r = 0; r < 16; ++r) { const int kv = t * 64 + crow(r, hi); int d0 = dbase - kv, d1 = d0 - 32; d0 = d0 > 127 ? 127 : d0; d1 = d1 > 127 ? 127 : d1;
                            p[t][0][r] = btab[h * 128 + d0]; p[t][1][r] = btab[h * 128 + d1]; }
                } else { p[0][0] = f32x16{}; p[0][1] = f32x16{}; p[1][0] = f32x16{}; p[1][1] = f32x16{}; }
#pragma unroll
                for (int t = 0; t < 2; ++t) qkt_acc(p[t][0], p[t][1], lds + (2 * half + t) * SLOTB, qr, r32, hi);
                float m2 = rowmax2(p[0][0], p[0][1], mx); m2 = rowmax2(p[1][0], p[1][1], m2); m2 = swapmax(m2);
                const float f = fexp2(mx - m2); l *= f; mx = m2;
                if (half == 1) {
                    if (hi == 0) wsf[64 + r32] = f;
                    asm volatile("s_waitcnt lgkmcnt(0)" ::: "memory");
#pragma unroll
                    for (int r = 0; r < 16; ++r) { const float fr_ = wsf[64 + crow(r, hi)]; o[0][r] *= fr_; o[1][r] *= fr_; } }
#pragma unroll
                for (int t = 0; t < 2; ++t) {
#pragma unroll
                    for (int r = 0; r < 16; ++r) { p[t][0][r] = fexp2(p[t][0][r] - mx); p[t][1][r] = fexp2(p[t][1][r] - mx); l += p[t][0][r] + p[t][1][r]; }
                    u32x4 w0, w1, w2, w3;
                    w0 = (u32x4){cvtpk(p[t][0][0], p[t][0][1]), cvtpk(p[t][0][2], p[t][0][3]), cvtpk(p[t][0][4], p[t][0][5]), cvtpk(p[t][0][6], p[t][0][7])};
                    w1 = (u32x4){cvtpk(p[t][0][8], p[t][0][9]), cvtpk(p[t][0][10], p[t][0][11]), cvtpk(p[t][0][12], p[t][0][13]), cvtpk(p[t][0][14], p[t][0][15])};
                    w2 = (u32x4){cvtpk(p[t][1][0], p[t][1][1]), cvtpk(p[t][1][2], p[t][1][3]), cvtpk(p[t][1][4], p[t][1][5]), cvtpk(p[t][1][6], p[t][1][7])};
                    w3 = (u32x4){cvtpk(p[t][1][8], p[t][1][9]), cvtpk(p[t][1][10], p[t][1][11]), cvtpk(p[t][1][12], p[t][1][13]), cvtpk(p[t][1][14], p[t][1][15])};
                    pv(o, vb0 + (2 * half + t) * SLOTB, __builtin_bit_cast(bf16x8, w0), __builtin_bit_cast(bf16x8, w1), __builtin_bit_cast(bf16x8, w2), __builtin_bit_cast(bf16x8, w3)); }
            }
            __builtin_amdgcn_sched_barrier(0);
            l = swapsum(l);
            if (hi == 0) { wsf[r32] = frcp(l); ((LAS int*)wsf)[32 + r32] = valid ? (int)(((row * NH + h) * 3 + slot)) : -1;
                           if (valid) { float2 ml; ml.x = mx + b31; ml.y = l; *(float2*)(PART_ML + ((row * NH + h) * 3 + slot) * 2) = ml; } }
            asm volatile("s_waitcnt lgkmcnt(0)" ::: "memory");
#pragma unroll
            for (int r = 0; r < 16; ++r) { const int orow = crow(r, hi); const float il = wsf[orow];
#pragma unroll
                for (int d0 = 0; d0 < 2; ++d0) stg[orow * 64 + d0 * 32 + r32] = (bf16)f2bf(o[d0][r] * il); }
            asm volatile("s_waitcnt lgkmcnt(0)" ::: "memory");
#pragma unroll
            for (int i = 0; i < 4; ++i) { const int rr = i * 8 + (lane >> 3), ch = lane & 7; const int dst = ((LAS int*)wsf)[32 + rr];
                const u32x4 v = *(const LAS u32x4*)(stg + rr * 64 + ch * 8);
                if (dst >= 0) *(u32x4*)(PART_O + (size_t)dst * 64 + ch * 8) = v; }
            asm volatile("s_waitcnt lgkmcnt(0)" ::: "memory");
        }
    }
}

__device__ __forceinline__ void attn_own_combine(Frame& F, bf16* QKVZ, const bf16* PART_O, const float* PART_ML, bf16* OUTB, int out_pitch) {
    using namespace moba;
    LAS unsigned char* lds = F.lds; const int wid = F.wave, lane = F.lane, r32 = lane & 31, hi = lane >> 5;
    LAS float* btab = (LAS float*)(lds + 139264);
    LAS float* wsf = (LAS float*)(lds + 135168) + wid * 128; LAS float* ost = (LAS float*)(lds + 65536 + wid * 8704);
    __syncthreads();
    for (int i = F.tid; i < NH * 256; i += NTHR) { const int h = i >> 8, d = i & 255; btab[i] = F.rel_bias[T5B[d < 127 ? d : 127] * NH + h] * LOG2E; }
    const int vb0 = (int)(uintptr_t)(lds + 32768) + ((lane >> 4) & 1) * 32 + (lane & 3) * 8 + (4 * hi + ((lane & 15) >> 2)) * 64;
    for (int u = F.vcu; u < BATCH * NH * NBLK; u += F.G) {
        const int qb = u % NBLK, bh = u / NBLK, b = bh / NH, h = bh % NH;
        __syncthreads();
        load_kv_block(lds, 0, 32768, QKVZ, (size_t)b * SEQ + qb * BLK, h, wid, lane);
        const int sq = qb * BLK + wid * 32 + r32; const size_t row = (size_t)b * SEQ + sq;
        bf16x8 qr[4];
#pragma unroll
        for (int d0 = 0; d0 < 4; ++d0) qr[d0] = *(const bf16x8*)(QKVZ + row * QP + h * HD + d0 * 16 + hi * 8);
        const int cq = lane >> 1, cc0 = (lane & 1) * 32; const size_t crow2 = (size_t)b * SEQ + qb * BLK + wid * 32 + cq;
        float2 pml[3]; v4u po[3][4], zw[4];
#pragma unroll
        for (int j = 0; j < 3; ++j) { pml[j] = *(const float2*)(PART_ML + ((crow2 * NH + h) * 3 + j) * 2);
#pragma unroll
            for (int c = 0; c < 4; ++c) po[j][c] = *((const v4u*)(PART_O + ((crow2 * NH + h) * 3 + j) * 64 + cc0) + c); }
#pragma unroll
        for (int c = 0; c < 4; ++c) zw[c] = *((const v4u*)(QKVZ + crow2 * QP + 1536 + h * HD + cc0) + c);
        __syncthreads();
        const int nt = (wid >> 1) + 1;
        int ql = wid * 32 + r32;
        asm volatile("" : "+v"(ql));
        const LAS float* bt = btab + h * 256;
        float mx = -INFINITY;
#define A2_SCORES(P0, P1, t) do { qkt(P0, P1, lds + (t) * SLOTB, qr, r32, hi); \
            if ((t) < nt - 1) { _Pragma("unroll") for (int r = 0; r < 16; ++r) { const int kv = (t) * 64 + crow(r, hi); const int d0 = ql - kv, d1 = d0 - 32; P0[r] += bt[d0]; P1[r] += bt[d1]; } } \
            else { _Pragma("unroll") for (int r = 0; r < 16; ++r) { const int kv = (t) * 64 + crow(r, hi); const int d0 = ql - kv, d1 = d0 - 32; const float b0 = bt[d0 < 0 ? 0 : d0], b1 = bt[d1 < 0 ? 0 : d1]; \
                P0[r] = d0 >= 0 ? P0[r] + b0 : -INFINITY; P1[r] = d1 >= 0 ? P1[r] + b1 : -INFINITY; } } } while (0)
#pragma unroll 1
        for (int t = 0; t < nt; ++t) { f32x16 p0, p1; A2_SCORES(p0, p1, t); mx = rowmax2(p0, p1, mx); }
        mx = swapmax(mx);
        float l = 0.f;
        f32x16 o[2]; o[0] = f32x16{}; o[1] = f32x16{};
#pragma unroll 1
        for (int t = 0; t < nt; ++t) { f32x16 p0, p1; A2_SCORES(p0, p1, t);
#pragma unroll
            for (int r = 0; r < 16; ++r) { p0[r] = fexp2(p0[r] - mx); p1[r] = fexp2(p1[r] - mx); l += p0[r] + p1[r]; }
            u32x4 w0, w1, w2, w3;
            w0 = (u32x4){cvtpk(p0[0], p0[1]), cvtpk(p0[2], p0[3]), cvtpk(p0[4], p0[5]), cvtpk(p0[6], p0[7])};
            w1 = (u32x4){cvtpk(p0[8], p0[9]), cvtpk(p0[10], p0[11]), cvtpk(p0[12], p0[13]), cvtpk(p0[14], p0[15])};
            w2 = (u32x4){cvtpk(p1[0], p1[1]), cvtpk(p1[2], p1[3]), cvtpk(p1[4], p1[5]), cvtpk(p1[6], p1[7])};
            w3 = (u32x4){cvtpk(p1[8], p1[9]), cvtpk(p1[10], p1[11]), cvtpk(p1[12], p1[13]), cvtpk(p1[14], p1[15])};
            pv(o, vb0 + t * SLOTB, __builtin_bit_cast(bf16x8, w0), __builtin_bit_cast(bf16x8, w1), __builtin_bit_cast(bf16x8, w2), __builtin_bit_cast(bf16x8, w3));
        }
#undef A2_SCORES
        l = swapsum(l);
        if (hi == 0) { wsf[r32] = mx; wsf[32 + r32] = l; }
#pragma unroll
        for (int r = 0; r < 16; ++r) { const int orow = crow(r, hi);
#pragma unroll
            for (int d0 = 0; d0 < 2; ++d0) ost[orow * 68 + d0 * 32 + r32] = o[d0][r]; }
        asm volatile("s_waitcnt lgkmcnt(0)" ::: "memory");
        { const int q = lane >> 1, c0 = (lane & 1) * 32; const int s2 = qb * BLK + wid * 32 + q; const size_t row2 = (size_t)b * SEQ + s2;
          const float m0 = wsf[q], l0 = wsf[32 + q]; const int np = qb < 3 ? qb : 3;
          float mj[3], lj[3]; float mt = m0;
#pragma unroll
          for (int j = 0; j < 3; ++j) { if (j < np) { const float2 ml = pml[j]; mj[j] = ml.x; lj[j] = ml.y; mt = fmaxf(mt, ml.x); } else { mj[j] = -INFINITY; lj[j] = 0.f; } }
          const float w0 = fexp2(m0 - mt); float wj[3]; float den = w0 * l0;
#pragma unroll
          for (int j = 0; j < 3; ++j) { wj[j] = (j < np) ? fexp2(mj[j] - mt) * lj[j] : 0.f; den += wj[j]; }
          const float iden = frcp(den);
          float acc[32];
#pragma unroll
          for (int c = 0; c < 32; c += 4) { const f32x4 v = *(const LAS f32x4*)(ost + q * 68 + c0 + c); acc[c] = v[0] * w0; acc[c + 1] = v[1] * w0; acc[c + 2] = v[2] * w0; acc[c + 3] = v[3] * w0; }
#pragma unroll
          for (int j = 0; j < 3; ++j) if (j < np) {
#pragma unroll
              for (int c = 0; c < 4; ++c) { const v4u w = po[j][c]; const float f = wj[j];
                  acc[c * 8 + 0] += f * __uint_as_float(w.x << 16); acc[c * 8 + 1] += f * __uint_as_float(w.x & 0xffff0000u); acc[c * 8 + 2] += f * __uint_as_float(w.y << 16); acc[c * 8 + 3] += f * __uint_as_float(w.y & 0xffff0000u);
                  acc[c * 8 + 4] += f * __uint_as_float(w.z << 16); acc[c * 8 + 5] += f * __uint_as_float(w.z & 0xffff0000u); acc[c * 8 + 6] += f * __uint_as_float(w.w << 16); acc[c * 8 + 7] += f * __uint_as_float(w.w & 0xffff0000u); } }
          asm volatile("s_waitcnt lgkmcnt(0)" ::: "memory");
#pragma unroll
          for (int c = 0; c < 4; ++c) { const v4u w = zw[c]; const float z[8] = {__uint_as_float(w.x << 16), __uint_as_float(w.x & 0xffff0000u), __uint_as_float(w.y << 16), __uint_as_float(w.y & 0xffff0000u),
                                                                               __uint_as_float(w.z << 16), __uint_as_float(w.z & 0xffff0000u), __uint_as_float(w.w << 16), __uint_as_float(w.w & 0xffff0000u)};
              float rr[8];
#pragma unroll
              for (int e2 = 0; e2 < 8; ++e2) rr[e2] = acc[c * 8 + e2] * iden * z[e2] * sigm(z[e2]);
              v4u ow; ow.x = pk2(rr[0], rr[1]); ow.y = pk2(rr[2], rr[3]); ow.z = pk2(rr[4], rr[5]); ow.w = pk2(rr[6], rr[7]); *(LAS v4u*)((LAS bf16*)ost + q * 72 + c0 + c * 8) = ow; }
          asm volatile("s_waitcnt lgkmcnt(0)" ::: "memory");
#pragma unroll
          for (int i = 0; i < 4; ++i) { const int rr = i * 8 + (lane >> 3), chk = lane & 7; const v4u w = *(const LAS v4u*)((LAS bf16*)ost + rr * 72 + chk * 8);
              *(v4u*)(OUTB + ((size_t)b * SEQ + qb * BLK + wid * 32 + rr) * out_pitch + h * HD + chk * 8) = w; } }
        asm volatile("s_waitcnt lgkmcnt(0)" ::: "memory");
    }
}
namespace rk {
using bf16x8 = __attribute__((ext_vector_type(8))) short;
using s16x4 = __attribute__((ext_vector_type(4))) short;
using f32x16 = __attribute__((ext_vector_type(16))) float;
using u32x4 = __attribute__((ext_vector_type(4))) unsigned;
using u32x2 = __attribute__((ext_vector_type(2))) unsigned;
typedef short v4i16_t __attribute__((ext_vector_type(4)));
typedef float f32x2_t __attribute__((ext_vector_type(2))); typedef __bf16 bf16x2_t __attribute__((ext_vector_type(2)));
constexpr int P = 144, IMG = 64 * P, GRP = 81920, MISC = 8 * IMG;
#define RK_MFMA(a, b, c) __builtin_amdgcn_mfma_f32_32x32x16_bf16((a), (b), (c), 0, 0, 0)
__device__ __forceinline__ int crow(int r, int hi) { return (r & 3) + 8 * (r >> 2) + 4 * hi; }
__device__ __forceinline__ unsigned cvtpk(float lo, float hi) { f32x2_t v = {lo, hi}; bf16x2_t b = __builtin_convertvector(v, bf16x2_t); return __builtin_bit_cast(unsigned, b); }
__device__ __forceinline__ float bflo(unsigned w) { return __uint_as_float(w << 16); }
__device__ __forceinline__ float bfhi(unsigned w) { return __uint_as_float(w & 0xffff0000u); }
__device__ __forceinline__ s16x4 trrd(const LAS unsigned char* p) { return __builtin_bit_cast(s16x4, __builtin_amdgcn_ds_read_tr16_b64_v4i16((LAS v4i16_t*)p)); }
struct Ln { int r, h, blk, q, p; };
__device__ __forceinline__ bf16x8 frag_row(const LAS unsigned char* img, const Ln& l, int tile, int s, int coloff = 0) { return *(const LAS bf16x8*)(img + (32 * tile + l.r) * P + (coloff + 16 * s + 8 * l.h) * 2); }
__device__ __forceinline__ bf16x8 frag_tr(const LAS unsigned char* img, const Ln& l, int tile, int s, int rowoff = 0) {
    const LAS unsigned char* b = img + (rowoff + 16 * s + 8 * l.h + l.q) * P + 64 * tile + 32 * l.blk + 8 * l.p;
    const s16x4 lo = trrd(b), hi = trrd(b + 4 * P);
    return (bf16x8){lo[0], lo[1], lo[2], lo[3], hi[0], hi[1], hi[2], hi[3]};
}
__device__ __forceinline__ bf16x8 frag_row_perm(const LAS unsigned char* img, const Ln& l, int tile, int s, int coloff = 0) {
    const LAS unsigned char* b = img + (32 * tile + l.r) * P + (coloff + 16 * s + 4 * l.h) * 2;
    const s16x4 lo = *(const LAS s16x4*)b, hi = *(const LAS s16x4*)(b + 16);
    return (bf16x8){lo[0], lo[1], lo[2], lo[3], hi[0], hi[1], hi[2], hi[3]};
}
__device__ __forceinline__ bf16x8 frag_tr_perm(const LAS unsigned char* img, const Ln& l, int tile, int s, int rowoff = 0) {
    const LAS unsigned char* b = img + (rowoff + 16 * s + 4 * l.h + l.q) * P + 64 * tile + 32 * l.blk + 8 * l.p;
    const s16x4 lo = trrd(b), hi = trrd(b + 8 * P);
    return (bf16x8){lo[0], lo[1], lo[2], lo[3], hi[0], hi[1], hi[2], hi[3]};
}
__device__ __forceinline__ bf16x8 pack(const f32x16& x, int s) {
    u32x4 w; w.x = cvtpk(x[8 * s], x[8 * s + 1]); w.y = cvtpk(x[8 * s + 2], x[8 * s + 3]); w.z = cvtpk(x[8 * s + 4], x[8 * s + 5]); w.w = cvtpk(x[8 * s + 6], x[8 * s + 7]);
    return __builtin_bit_cast(bf16x8, w);
}
__device__ __forceinline__ void store_T(LAS unsigned char* img, const Ln& l, const f32x16& x, int ti, int tj) {
#pragma unroll
    for (int g = 0; g < 4; ++g) { u32x2 w; w.x = cvtpk(x[4 * g], x[4 * g + 1]); w.y = cvtpk(x[4 * g + 2], x[4 * g + 3]);
        *(LAS u32x2*)(img + (32 * tj + l.r) * P + (32 * ti + 8 * g + 4 * l.h) * 2) = w; }
}
__device__ __forceinline__ float xhalf(float v) { return __shfl_xor(v, 32); }
__device__ __forceinline__ void tri_inv32(f32x16& D, f32x16& DT, f32x16 S, f32x16 ST) {
    const f32x16 z = {};
#pragma unroll
    for (int it = 0; it < 4; ++it) {
        f32x16 S2 = z, S2T = z;
#pragma unroll
        for (int s = 0; s < 2; ++s) { const bf16x8 ps = pack(S, s), pst = pack(ST, s); S2 = RK_MFMA(pst, ps, S2); S2T = RK_MFMA(ps, pst, S2T); }
        f32x16 DS = S2, DST = S2T;
#pragma unroll
        for (int s = 0; s < 2; ++s) { DS = RK_MFMA(pack(DT, s), pack(S2, s), DS); DST = RK_MFMA(pack(S2, s), pack(DT, s), DST); }
        D = D + DS; DT = DT + DST; S = S2; ST = S2T;
    }
}
}

constexpr size_t DO_NT = 0, DO_MT = 128 * MiB, DO_RH = 192 * MiB;

struct R1Ctx { int item, c, h, b; int nc, nh, nb; rk::f32x16 Wt0, Wt1; };
#define RK_RELANE() do { int t_ = F.tid; asm volatile("" : "+v"(t_)); lane = t_ & 63; tg = t_ & 255; grp = t_ >> 8; w4 = (t_ >> 6) & 3; ti = w4 >> 1; tj = w4 & 1; l.r = lane & 31; l.h = lane >> 5; l.blk = (lane >> 4) & 1; l.q = (lane & 15) >> 2; l.p = lane & 3; G = F.lds + grp * GRP; } while (0)
#define RK_KA() const __attribute__((address_space(4))) Args* ka = (const __attribute__((address_space(4))) Args*)__builtin_amdgcn_kernarg_segment_ptr(); asm volatile("" : "+s"(ka))
#define s0 (G)
#define s1 (G + IMG)
#define s2 (G + 2 * IMG)
#define s3 (G + 3 * IMG)
#define s4 (G + 4 * IMG)
#define s5 (G + 5 * IMG)
#define s6 (G + 6 * IMG)
#define s7 (G + 7 * IMG)
#define nrminv ((LAS float*)(G + MISC))
#define ltot (nrminv + 64)
#define gam (nrminv + 128)
#define bonp (nrminv + 192)
__device__ __forceinline__ void r1_S1a(Frame& F, R1Ctx& X) {
    using namespace rk;
    int grp, w4, ti, tj, lane, tg; Ln l; LAS unsigned char* G; const f32x16 z16 = {};
    RK_RELANE(); (void)w4; (void)tg; (void)ti; (void)tj;
    const int item = X.item, c = X.c, h = X.h, b = X.b; (void)item; (void)c; (void)h; (void)b;
    { RK_KA(); const bf16* RW = (const bf16*)(ka->ws + WS_RW); const float* mu_ = ka->in[5]; const float* kk_ = ka->in[10];
      const int t = tg >> 2, q4 = tg & 3; const int sq = c * 64 + t; const size_t row = (size_t)b * SEQ + sq;
      const bf16* cur = RW + row * RWC; const bool hasp = sq > 0; const bf16* prv = hasp ? cur - RWC : cur; const float pm = hasp ? 1.f : 0.f;
      float nr = 0.f;
      v4u cr_[2], pr_[2], ck_[2], pk_[2], cv_[2], pv_[2], cw_[2], pw_[2], ca_[2], pa_[2], cz_[2], pz_[2];
#pragma unroll
      for (int half = 0; half < 2; ++half) { const int k0 = 16 * q4 + 8 * half, col = h * HD + k0;
          cr_[half] = *(const v4u*)(cur + col); pr_[half] = *(const v4u*)(prv + col); ck_[half] = *(const v4u*)(cur + 512 + col); pk_[half] = *(const v4u*)(prv + 512 + col); cv_[half] = *(const v4u*)(cur + 1024 + col); pv_[half] = *(const v4u*)(prv + 1024 + col);
          cw_[half] = *(const v4u*)(cur + 2048 + k0); pw_[half] = *(const v4u*)(prv + 2048 + k0); ca_[half] = *(const v4u*)(cur + 2112 + k0); pa_[half] = *(const v4u*)(prv + 2112 + k0); cz_[half] = *(const v4u*)(cur + 1536 + col); pz_[half] = *(const v4u*)(prv + 1536 + col); }
      __builtin_amdgcn_sched_barrier(0);
#pragma unroll
      for (int half = 0; half < 2; ++half) { const int k0 = 16 * q4 + 8 * half, col = h * HD + k0;
          const v4u cr = cr_[half], pr = pr_[half], ck = ck_[half], pk = pk_[half], cv = cv_[half], pv = pv_[half], cw = cw_[half], pw = pw_[half], ca = ca_[half], pa = pa_[half], cz = cz_[half], pz = pz_[half];
          float ro[8], ko[8], vo[8], wo[8], ao[8], zo[8];
          float mr[8], mk[8], mv[8], mz[8], mw[8], ma[8], kkc[8];
          { const f32x4* p; f32x4 x0, x1;
#define LD8_(dst, ptr) p = (const f32x4*)(ptr); x0 = p[0]; x1 = p[1]; dst[0] = x0[0]; dst[1] = x0[1]; dst[2] = x0[2]; dst[3] = x0[3]; dst[4] = x1[0]; dst[5] = x1[1]; dst[6] = x1[2]; dst[7] = x1[3]
            LD8_(mr, mu_ + col); LD8_(mk, mu_ + 512 + col); LD8_(mv, mu_ + 1024 + col); LD8_(mz, mu_ + 1536 + col); LD8_(mw, mu_ + 2048 + k0); LD8_(ma, mu_ + 2112 + k0); LD8_(kkc, kk_ + col);
#undef LD8_
          }
#pragma unroll
          for (int e = 0; e < 8; ++e) { const unsigned wcr = cr[e >> 1], wpr = pr[e >> 1], wck = ck[e >> 1], wpk = pk[e >> 1], wcv = cv[e >> 1], wpv = pv[e >> 1];
              const unsigned wcw = cw[e >> 1], wpw = pw[e >> 1], wca = ca[e >> 1], wpa = pa[e >> 1];
              const float xr = (e & 1) ? bfhi(wcr) : bflo(wcr), yr = pm * ((e & 1) ? bfhi(wpr) : bflo(wpr)); ro[e] = xr + (yr - xr) * mr[e];
              const float xk = (e & 1) ? bfhi(wck) : bflo(wck), yk = pm * ((e & 1) ? bfhi(wpk) : bflo(wpk)); ko[e] = xk + (yk - xk) * mk[e];
              const float xv = (e & 1) ? bfhi(wcv) : bflo(wcv), yv = pm * ((e & 1) ? bfhi(wpv) : bflo(wpv)); vo[e] = xv + (yv - xv) * mv[e];
              const float xw = (e & 1) ? bfhi(wcw) : bflo(wcw), yw = pm * ((e & 1) ? bfhi(wpw) : bflo(wpw)); wo[e] = ftanh(xw + (yw - xw) * mw[e]);
              const float xa = (e & 1) ? bfhi(wca) : bflo(wca), ya = pm * ((e & 1) ? bfhi(wpa) : bflo(wpa)); ao[e] = xa + (ya - xa) * ma[e];
              { const unsigned wcz = cz[e >> 1], wpz = pz[e >> 1]; const float xz = (e & 1) ? bfhi(wcz) : bflo(wcz), yz = pm * ((e & 1) ? bfhi(wpz) : bflo(wpz)); const float zz = xz + (yz - xz) * mz[e]; zo[e] = zz * sigm(zz); }
              const float kkx = ko[e] * kkc[e]; nr += kkx * kkx; }
          const int off = t * P + k0 * 2;
          *(LAS u32x4*)(s0 + off) = (u32x4){cvtpk(wo[0], wo[1]), cvtpk(wo[2], wo[3]), cvtpk(wo[4], wo[5]), cvtpk(wo[6], wo[7])};
          *(LAS u32x4*)(s1 + off) = (u32x4){cvtpk(ao[0], ao[1]), cvtpk(ao[2], ao[3]), cvtpk(ao[4], ao[5]), cvtpk(ao[6], ao[7])};
          *(LAS u32x4*)(s2 + off) = (u32x4){cvtpk(ro[0], ro[1]), cvtpk(ro[2], ro[3]), cvtpk(ro[4], ro[5]), cvtpk(ro[6], ro[7])};
          *(LAS u32x4*)(s3 + off) = (u32x4){cvtpk(ko[0], ko[1]), cvtpk(ko[2], ko[3]), cvtpk(ko[4], ko[5]), cvtpk(ko[6], ko[7])};
          const u32x4 vw = (u32x4){cvtpk(vo[0], vo[1]), cvtpk(vo[2], vo[3]), cvtpk(vo[4], vo[5]), cvtpk(vo[6], vo[7])};
          *(LAS u32x4*)(s4 + off) = vw;
          bf16* qz = (bf16*)(ka->ws + WS_QKVZ) + row * QP + col;
          *(u32x4*)(qz + 1024) = vw; *(u32x4*)(qz + 1536) = (u32x4){cvtpk(zo[0], zo[1]), cvtpk(zo[2], zo[3]), cvtpk(zo[4], zo[5]), cvtpk(zo[6], zo[7])}; }
      nr += __shfl_xor(nr, 1); nr += __shfl_xor(nr, 2);
      if (q4 == 0) nrminv[t] = frsq(fmaxf(nr, 1e-24f)); }
}
__device__ __forceinline__ void r1_S1b(Frame& F, R1Ctx& X) {
    using namespace rk;
    int grp, w4, ti, tj, lane, tg; Ln l; LAS unsigned char* G; const f32x16 z16 = {};
    RK_RELANE(); (void)w4; (void)tg; (void)ti; (void)tj;
    const int item = X.item, c = X.c, h = X.h, b = X.b; (void)item; (void)c; (void)h; (void)b;
    {
        RK_KA(); const bf16* WupT = (const bf16*)(ka->ws + WS_WUPT); const bf16* AupT = (const bf16*)(ka->ws + WS_AUPT);
        const int kcol = 32 * tj + l.r, kc = h * HD + kcol;
        f32x16 W = z16, Aq = z16;
#pragma unroll
        for (int s = 0; s < 4; ++s) { const bf16x8 bw = *(const bf16x8*)(WupT + (size_t)kc * 64 + 16 * s + 8 * l.h), ba = *(const bf16x8*)(AupT + (size_t)kc * 64 + 16 * s + 8 * l.h);
            W = RK_MFMA(frag_row(s0, l, ti, s), bw, W); Aq = RK_MFMA(frag_row(s1, l, ti, s), ba, Aq); }
        const float w0 = ka->in[6][kc], a0 = ka->in[8][kc], kkc = ka->in[10][kc], kac = ka->in[11][kc], rkc = ka->in[12][kc];
        float lw[16], L[16];
#pragma unroll
        for (int r = 0; r < 16; ++r) { const float x = W[r] + w0; const float sp = (-x > 20.f) ? -x : 0.6931471805599453f * __builtin_amdgcn_logf(1.0f + fexp(-x)); lw[r] = -fexp(-sp - 0.5f); Aq[r] = sigm(Aq[r] + a0); }
        float gs[4], go[4];
#pragma unroll
        for (int g = 0; g < 4; ++g) { L[4 * g] = lw[4 * g]; L[4 * g + 1] = L[4 * g] + lw[4 * g + 1]; L[4 * g + 2] = L[4 * g + 1] + lw[4 * g + 2]; L[4 * g + 3] = L[4 * g + 2] + lw[4 * g + 3]; gs[g] = L[4 * g + 3]; }
        float run = 0.f;
#pragma unroll
        for (int g = 0; g < 4; ++g) { const float og = xhalf(gs[g]); const float lo = l.h ? og : gs[g], hi = l.h ? gs[g] : og;
            go[g] = run + (l.h ? lo : 0.f); run += lo + hi; }
#pragma unroll
        for (int r = 0; r < 16; ++r) L[r] += go[r >> 2];
        if (ti == 0 && l.h == 0) ltot[kcol] = run;
        __syncthreads();
        if (ti == 1) { const float add = ltot[kcol];
#pragma unroll
            for (int r = 0; r < 16; ++r) L[r] += add;
            if (l.h == 1) gam[kcol] = fexp(L[15]); }
        f32x16 At, Bt, Kt, Rt; float xb[16];
#pragma unroll
        for (int r = 0; r < 16; ++r) { const int t = 32 * ti + crow(r, l.h);
            const float rr = bf2f(*(const LAS unsigned short*)(s2 + t * P + kcol * 2)), kx = bf2f(*(const LAS unsigned short*)(s3 + t * P + kcol * 2));
            const float kn = kx * kkc * nrminv[t], a = Aq[r], km = kx * (1.0f + (a - 1.0f) * kac);
            const float eL = fexp(L[r]), eLn = fexp(-L[r]), eLp = fexp(L[r] - lw[r]);
            At[r] = -kn * eLp; Bt[r] = kn * a * eLn; Kt[r] = km * eLn; Rt[r] = rr * eL; xb[r] = rr * km * rkc; }
#pragma unroll
        for (int r = 0; r < 16; ++r) xb[r] = dpp_sum32(xb[r]);
        if (l.r == 31) {
#pragma unroll
            for (int r = 0; r < 16; ++r) bonp[tj * 64 + 32 * ti + crow(r, l.h)] = xb[r]; }
        store_T(s0, l, At, ti, tj); store_T(s1, l, Bt, ti, tj); store_T(s5, l, Kt, ti, tj); store_T(s6, l, Rt, ti, tj);
    }
}
__device__ __forceinline__ void r1_S2(Frame& F, R1Ctx& X) {
    using namespace rk;
    int grp, w4, ti, tj, lane, tg; Ln l; LAS unsigned char* G; const f32x16 z16 = {};
    RK_RELANE(); (void)w4; (void)tg; (void)ti; (void)tj;
    const int item = X.item, c = X.c, h = X.h, b = X.b; (void)item; (void)c; (void)h; (void)b;
    unsigned pf0 = 0u, pf1 = 0u;
    if (X.nb >= 0) { RK_KA(); const bf16* RW = (const bf16*)(ka->ws + WS_RW);
        { const int j = tg; const int rr = j / 6, pc = j % 6; const long sq = (long)X.nb * SEQ + X.nc * 64 + rr - 1;
          if (sq >= (long)X.nb * SEQ) pf0 = *(const volatile unsigned char*)(RW + (size_t)sq * RWC + (pc < 4 ? pc * 512 + X.nh * HD : 2048 + (pc - 4) * 64)); }
        { const int j = tg + 256; const int rr = j / 6, pc = j % 6; const long sq = (long)X.nb * SEQ + X.nc * 64 + rr - 1;
          if (j < 65 * 6) pf1 = *(const volatile unsigned char*)(RW + (size_t)sq * RWC + (pc < 4 ? pc * 512 + X.nh * HD : 2048 + (pc - 4) * 64)); } }
    {
        f32x16 X = z16;
        if (ti >= tj) {
#pragma unroll
            for (int s = 0; s < 4; ++s) X = RK_MFMA(frag_tr(s0, l, ti, s), frag_tr(s5, l, tj, s), X);
#pragma unroll
            for (int r = 0; r < 16; ++r) { const int t = 32 * ti + crow(r, l.h), i = 32 * tj + l.r; if (!(t > i)) X[r] = 0.f; } }
        store_T(s2, l, X, ti, tj);
        if (w4 == 0 || w4 == 3) { const int d = w4 == 3;
            f32x16 S = z16, ST = z16;
#pragma unroll
            for (int s = 0; s < 4; ++s) { const bf16x8 fa = frag_tr(s0, l, d, s), fb = frag_tr(s1, l, d, s); S = RK_MFMA(fa, fb, S); ST = RK_MFMA(fb, fa, ST); }
#pragma unroll
            for (int r = 0; r < 16; ++r) { const int rw = crow(r, l.h); if (!(rw > l.r)) S[r] = 0.f; if (!(l.r > rw)) ST[r] = 0.f; }
            f32x16 D = S, DT = ST;
            tri_inv32(D, DT, S, ST);
            store_T(s7, l, D, d, d);
            asm volatile("s_waitcnt lgkmcnt(0)" ::: "memory");
            if (l.h == 0) *(LAS unsigned short*)(s7 + (32 * d + l.r) * P + (32 * d + l.r) * 2) = 0x3f80;
        } else if (w4 == 2) {
            f32x16 X21 = z16;
#pragma unroll
            for (int s = 0; s < 4; ++s) X21 = RK_MFMA(frag_tr(s0, l, 1, s), frag_tr(s1, l, 0, s), X21);
            store_T(s3, l, X21, 0, 0);
        } else {
            store_T(s7, l, z16, 0, 1);
            { RK_KA(); float* BON = (float*)(ka->ws + WS_BON); const int t = lane; BON[((size_t)b * SEQ + c * 64 + t) * NH + h] = bonp[t] + bonp[64 + t]; }
        }
    }
    asm volatile("" :: "v"(pf0), "v"(pf1));
}
__device__ __forceinline__ void r1_S3(Frame& F, R1Ctx& X) {
    using namespace rk;
    int grp, w4, ti, tj, lane, tg; Ln l; LAS unsigned char* G; const f32x16 z16 = {};
    RK_RELANE(); (void)w4; (void)tg; (void)ti; (void)tj;
    const int item = X.item, c = X.c, h = X.h, b = X.b; (void)item; (void)c; (void)h; (void)b;
    f32x16& Wt0 = X.Wt0; f32x16& Wt1 = X.Wt1;
    Wt0 = z16; Wt1 = z16;
    {
        if (w4 == 2) {
            f32x16 E = z16;
#pragma unroll
            for (int s = 0; s < 2; ++s) E = RK_MFMA(frag_tr(s3, l, 0, s), frag_row(s7, l, 0, s), E);
            store_T(s3, l, E, 0, 1);
            f32x16 T21 = z16;
#pragma unroll
            for (int s = 0; s < 2; ++s) T21 = RK_MFMA(frag_tr(s7, l, 1, s, 32), frag_row(s3, l, 1, s), T21);
            store_T(s7, l, T21, 1, 0);
        }
#pragma unroll
        for (int s = 0; s < 4; ++s) Wt0 = RK_MFMA(frag_tr(s2, l, 0, s), frag_tr(s4, l, tj, s), Wt0);
        if (ti == 1) {
#pragma unroll
            for (int s = 0; s < 4; ++s) Wt1 = RK_MFMA(frag_tr(s2, l, 1, s), frag_tr(s4, l, tj, s), Wt1); }
    }
}
__device__ __forceinline__ void r1_S4(Frame& F, R1Ctx& X) {
    using namespace rk;
    int grp, w4, ti, tj, lane, tg; Ln l; LAS unsigned char* G; const f32x16 z16 = {};
    RK_RELANE(); (void)w4; (void)tg; (void)ti; (void)tj;
    const int item = X.item, c = X.c, h = X.h, b = X.b; (void)item; (void)c; (void)h; (void)b;
    f32x16& Wt0 = X.Wt0; f32x16& Wt1 = X.Wt1;
    {
        f32x16 Ap = z16;
#pragma unroll
        for (int s = 0; s < 4; ++s) if (s < 2 || ti == 1) Ap = RK_MFMA(frag_tr(s7, l, ti, s), frag_row(s0, l, tj, s), Ap);
        f32x16 Uv = z16;
#pragma unroll
        for (int s = 0; s < 2; ++s) Uv = RK_MFMA(frag_tr_perm(s7, l, ti, s, 0), pack(Wt0, s), Uv);
        if (ti == 1) {
#pragma unroll
            for (int s = 0; s < 2; ++s) Uv = RK_MFMA(frag_tr_perm(s7, l, ti, s, 32), pack(Wt1, s), Uv); }
        store_T(s2, l, Ap, ti, tj); store_T(s3, l, Uv, ti, tj);
    }
}
__device__ __forceinline__ void r1_S5(Frame& F, R1Ctx& X) {
    using namespace rk;
    int grp, w4, ti, tj, lane, tg; Ln l; LAS unsigned char* G; const f32x16 z16 = {};
    RK_RELANE(); (void)w4; (void)tg; (void)ti; (void)tj;
    const int item = X.item, c = X.c, h = X.h, b = X.b; (void)item; (void)c; (void)h; (void)b;
    {
        RK_KA(); float* NT = (float*)((unsigned char*)ka->out + DO_NT); bf16* MT = (bf16*)((unsigned char*)ka->out + DO_MT); bf16* RH = (bf16*)((unsigned char*)ka->out + DO_RH); bf16* Y0 = (bf16*)(ka->ws + WS_GATE);
        const size_t ib = (size_t)((b * 64 + c) * NH + h) * 4096;
        f32x16 Xrb0 = z16, Xrk0 = z16, Xrb1 = z16, Xrk1 = z16;
#pragma unroll
        for (int s = 0; s < 4; ++s) { const bf16x8 fr = frag_tr(s6, l, ti, s); Xrb0 = RK_MFMA(frag_tr(s1, l, 0, s), fr, Xrb0); Xrk0 = RK_MFMA(frag_tr(s5, l, 0, s), fr, Xrk0); }
        if (ti == 1) {
#pragma unroll
            for (int s = 0; s < 4; ++s) { const bf16x8 fr = frag_tr(s6, l, ti, s); Xrb1 = RK_MFMA(frag_tr(s1, l, 1, s), fr, Xrb1); Xrk1 = RK_MFMA(frag_tr(s5, l, 1, s), fr, Xrk1); } }
#pragma unroll
        for (int r = 0; r < 16; ++r) { const bool keep = crow(r, l.h) <= l.r; if (ti == 0) { if (!keep) { Xrb0[r] = 0.f; Xrk0[r] = 0.f; } } else { if (!keep) { Xrb1[r] = 0.f; Xrk1[r] = 0.f; } } }
        f32x16 acc;
#pragma unroll
        for (int g = 0; g < 4; ++g) { const u32x2 w = *(const LAS u32x2*)(s6 + (32 * tj + l.r) * P + (32 * ti + 8 * g + 4 * l.h) * 2); acc[4 * g] = bflo(w.x); acc[4 * g + 1] = bfhi(w.x); acc[4 * g + 2] = bflo(w.y); acc[4 * g + 3] = bfhi(w.y); }
#pragma unroll
        for (int s = 0; s < 2; ++s) acc = RK_MFMA(pack(Xrb0, s), frag_row_perm(s2, l, tj, s, 0), acc);
        if (ti == 1) {
#pragma unroll
            for (int s = 0; s < 2; ++s) acc = RK_MFMA(pack(Xrb1, s), frag_row_perm(s2, l, tj, s, 32), acc); }
#pragma unroll
        for (int r = 0; r < 16; ++r) RH[ib + (32 * ti + crow(r, l.h)) * 64 + 32 * tj + l.r] = (bf16)f2bf(acc[r]);
        acc = z16;
#pragma unroll
        for (int s = 0; s < 2; ++s) { acc = RK_MFMA(pack(Xrb0, s), frag_row_perm(s3, l, tj, s, 0), acc); acc = RK_MFMA(pack(Xrk0, s), frag_tr_perm(s4, l, tj, s, 0), acc); }
        if (ti == 1) {
#pragma unroll
            for (int s = 0; s < 2; ++s) { acc = RK_MFMA(pack(Xrb1, s), frag_row_perm(s3, l, tj, s, 32), acc); acc = RK_MFMA(pack(Xrk1, s), frag_tr_perm(s4, l, tj, s, 32), acc); } }
#pragma unroll
        for (int r = 0; r < 16; ++r) Y0[ib + (32 * ti + crow(r, l.h)) * 64 + 32 * tj + l.r] = (bf16)f2bf(acc[r]);
        acc = z16;
#pragma unroll
        for (int s = 0; s < 4; ++s) acc = RK_MFMA(frag_row(s1, l, ti, s), frag_row(s2, l, tj, s), acc);
#pragma unroll
        for (int r = 0; r < 16; ++r) { const int kp = 32 * ti + crow(r, l.h), k = 32 * tj + l.r; const float v = (acc[r] + (kp == k ? 1.f : 0.f)) * gam[kp]; MT[ib + kp * 64 + k] = (bf16)f2bf(v); }
        acc = z16;
#pragma unroll
        for (int s = 0; s < 4; ++s) { acc = RK_MFMA(frag_row(s1, l, ti, s), frag_row(s3, l, tj, s), acc); acc = RK_MFMA(frag_row(s5, l, ti, s), frag_tr(s4, l, tj, s), acc); }
#pragma unroll
        for (int r = 0; r < 16; ++r) NT[ib + ((ti * 2 + tj) * 16 + r) * 64 + lane] = acc[r] * gam[32 * ti + crow(r, l.h)];
    }
}
#ifndef MK_R1_REP
#define MK_R1_REP -1
#endif
__device__ __forceinline__ void rwkv_chunk_ops(Frame& F) {
    R1Ctx X;
    for (int ip = F.vcu; ip < BATCH * NH * 64 / 2; ip += F.G) {
        { int t_ = F.tid; asm volatile("" : "+v"(t_)); const int grp = t_ >> 8; X.item = ip * 2 + grp; X.c = X.item & 63; const int bh = X.item >> 6; X.h = bh % NH; X.b = bh / NH;
          const int nit = (ip + F.G) * 2 + grp; const int nbh = nit >> 6; X.nc = nit & 63; X.nh = nbh % NH; X.nb = (ip + F.G < BATCH * NH * 64 / 2) ? nbh / NH : -1; }
        r1_S1a(F, X); __syncthreads();
        if constexpr (MK_R1_REP == 0) { r1_S1a(F, X); __syncthreads(); }
        r1_S1b(F, X); __syncthreads();
        if constexpr (MK_R1_REP == 1) { r1_S1a(F, X); __syncthreads(); r1_S1b(F, X); __syncthreads(); }
        r1_S2(F, X); __syncthreads();
        if constexpr (MK_R1_REP == 2) { r1_S2(F, X); __syncthreads(); }
        r1_S3(F, X); __syncthreads();
        r1_S4(F, X); __syncthreads();
        r1_S5(F, X); __syncthreads();
        if constexpr (MK_R1_REP == 5) { r1_S5(F, X); __syncthreads(); }
    }
}
#undef s0
#undef s1
#undef s2
#undef s3
#undef s4
#undef s5
#undef s6
#undef s7
#undef nrminv
#undef ltot
#undef gam
#undef bonp
__device__ __forceinline__ void rwkv_relay(Frame& F) {
    using namespace rk;
    const int lane = F.lane, wid = F.wave; const int lr = lane & 31, lh = lane >> 5;
    LAS float* sbuf = (LAS float*)F.lds; volatile LAS int* flag = (volatile LAS int*)(F.lds + 16384);
    const float* NT = (const float*)((unsigned char*)F.out + DO_NT); bf16* MT = (bf16*)((unsigned char*)F.out + DO_MT);
    for (int ch = F.vcu; ch < BATCH * NH * 2; ch += F.G) {
        const int bh = ch >> 1, ct = ch & 1;
        __syncthreads();
        for (int i = F.tid; i < 2048; i += NTHR) sbuf[i] = 0.f;
        if (F.tid == 0) flag[0] = 0;
        __syncthreads();
        for (int c = wid; c < 64; c += NWAVES) {
            const size_t ib = (size_t)(((bh >> 3) * 64 + c) * NH + (bh & 7)) * 4096;
            bf16x8 am[2][4]; f32x16 sn[2];
#pragma unroll
            for (int rt = 0; rt < 2; ++rt)
#pragma unroll
                for (int s = 0; s < 4; ++s) { const bf16* pm = MT + ib + (32 * rt + lr) * 64 + 16 * s + 4 * lh;
                    const v2u m0 = *(const v2u*)pm, m1 = *(const v2u*)(pm + 8);
                    am[rt][s] = __builtin_bit_cast(bf16x8, (u32x4){m0.x, m0.y, m1.x, m1.y}); }
#pragma unroll
            for (int rt = 0; rt < 2; ++rt)
#pragma unroll
                for (int r = 0; r < 16; ++r) sn[rt][r] = NT[ib + ((rt * 2 + ct) * 16 + r) * 64 + lane];
            while (flag[0] < c) __builtin_amdgcn_s_sleep(1);
            asm volatile("s_waitcnt lgkmcnt(0)" ::: "memory");
            const LAS float* sin = sbuf + (c & 1) * 2048; LAS float* sout = sbuf + ((c + 1) & 1) * 2048;
            bf16x8 sp[2][2];
#pragma unroll
            for (int kt = 0; kt < 2; ++kt) { f32x16 sv;
#pragma unroll
                for (int r = 0; r < 16; ++r) sv[r] = sin[(kt * 16 + r) * 64 + lane];
                sp[kt][0] = pack(sv, 0); sp[kt][1] = pack(sv, 1); }
#pragma unroll
            for (int s = 0; s < 4; ++s)
#pragma unroll
                for (int rt = 0; rt < 2; ++rt) sn[rt] = RK_MFMA(am[rt][s], sp[s >> 1][s & 1], sn[rt]);
#pragma unroll
            for (int rt = 0; rt < 2; ++rt)
#pragma unroll
                for (int r = 0; r < 16; ++r) sout[(rt * 16 + r) * 64 + lane] = sn[rt][r];
            asm volatile("s_waitcnt lgkmcnt(0)" ::: "memory");
            if (lane == 0) flag[0] = c + 1;
            bf16* sc = (bf16*)(F.ws + WS_SC) + ib;
#pragma unroll
            for (int kt = 0; kt < 2; ++kt)
#pragma unroll
                for (int sl = 0; sl < 2; ++sl) *(bf16x8*)(sc + (((kt * 2 + ct) * 2 + sl) * 64 + lane) * 8) = sp[kt][sl];
        }
    }
}

struct R2Tile { v4u y0[4], vv[4], zg[4]; float bon; };
__device__ __forceinline__ void r2_load_tile(R2Tile& T, const bf16* Y0, const bf16* QKVZ, const float* BON, size_t ib, int b, int h, int c, int tt, int lane) {
    const int q = lane >> 1, c0 = (lane & 1) * 32; const size_t row = (size_t)b * SEQ + c * 64 + tt * 32 + q;
    const v4u* y0p = (const v4u*)(Y0 + ib + (tt * 32 + q) * 64 + c0); const v4u* vp = (const v4u*)(QKVZ + row * QP + 1024 + h * HD + c0); const v4u* zp = (const v4u*)(QKVZ + row * QP + 1536 + h * HD + c0);
#pragma unroll
    for (int i = 0; i < 4; ++i) { T.y0[i] = y0p[i]; T.vv[i] = vp[i]; T.zg[i] = zp[i]; }
    T.bon = BON[row * NH + h];
}
__device__ __forceinline__ void rwkv_output(Frame& F) {
    using namespace rk;
    const int wid = F.wave;
    LAS float* yst = (LAS float*)(F.lds + wid * 8704); LAS float* cst = (LAS float*)(F.lds + 69632);
    bf16* QKVZ = (bf16*)(F.ws + WS_QKVZ);
    const bf16* SC = (const bf16*)(F.ws + WS_SC); const bf16* RH = (const bf16*)((unsigned char*)F.out + DO_RH);
    const bf16* Y0 = (const bf16*)(F.ws + WS_GATE); const float* BON = (const float*)(F.ws + WS_BON);
    __syncthreads();
    for (int i = F.tid; i < 2 * 512; i += NTHR) { const int a = i >> 9, col = i & 511; cst[i] = a == 0 ? F.ln_w[col] : F.ln_b[col]; }
    __syncthreads();
    const int gw = F.vcu * NWAVES + wid, NGW = F.G * NWAVES;
    for (int idx = gw; idx < BATCH * NH * 64; idx += NGW) {
        const int h = idx & 7, c = (idx >> 3) & 63, b = idx >> 9; const size_t ib = (size_t)idx * 4096;
        bf16x8 sp[2][2][2];
        { const int lane = F.lane;
#pragma unroll
          for (int kt = 0; kt < 2; ++kt)
#pragma unroll
              for (int ct = 0; ct < 2; ++ct)
#pragma unroll
                  for (int sl = 0; sl < 2; ++sl) sp[kt][ct][sl] = *(const bf16x8*)(SC + ib + (((kt * 2 + ct) * 2 + sl) * 64 + lane) * 8); }
#pragma unroll 1
        for (int tt = 0; tt < 2; ++tt) {
            int lane_ = F.tid; asm volatile("" : "+v"(lane_)); const int lane = lane_ & 63, lr = lane & 31, lh = lane >> 5;
            bf16x8 ar[4];
#pragma unroll
            for (int s = 0; s < 4; ++s) { const bf16* pr = RH + ib + (32 * tt + lr) * 64 + 16 * s + 4 * lh; const v2u r0 = *(const v2u*)pr, r1 = *(const v2u*)(pr + 8);
                ar[s] = __builtin_bit_cast(bf16x8, (u32x4){r0.x, r0.y, r1.x, r1.y}); }
            R2Tile T; r2_load_tile(T, Y0, QKVZ, BON, ib, b, h, c, tt, lane);
            f32x16 y0 = {}, y1 = {};
#ifndef MK_R2B_X
#define MK_R2B_X 0
#endif
#pragma unroll 1
            for (int rep2 = 0; rep2 < (MK_R2B_X == 2 ? 4 : 1); ++rep2) {
            y0 = f32x16{}; y1 = f32x16{};
#pragma unroll
            for (int s = 0; s < 4; ++s) { y0 = RK_MFMA(ar[s], sp[s >> 1][0][s & 1], y0); y1 = RK_MFMA(ar[s], sp[s >> 1][1][s & 1], y1); }
#pragma unroll
            for (int r = 0; r < 16; ++r) { yst[crow(r, lh) * 68 + lr] = y0[r]; yst[crow(r, lh) * 68 + 32 + lr] = y1[r]; }
            asm volatile("s_waitcnt lgkmcnt(0)" ::: "memory"); }
            const int q = lane >> 1, c0 = (lane & 1) * 32; const int sq = c * 64 + tt * 32 + q; const size_t row = (size_t)b * SEQ + sq;
            const LAS float* cs = cst + h * HD + c0;
            float y[32];
#pragma unroll 1
            for (int rep1 = 0; rep1 < (MK_R2B_X == 1 ? 4 : 1); ++rep1) {
#pragma unroll
            for (int e = 0; e < 32; e += 8) { const f32x4 a = *(const LAS f32x4*)(yst + q * 68 + c0 + e), bq = *(const LAS f32x4*)(yst + q * 68 + c0 + e + 4); const v4u w = T.y0[e >> 3];
                y[e] = a[0] + bflo(w.x); y[e + 1] = a[1] + bfhi(w.x); y[e + 2] = a[2] + bflo(w.y); y[e + 3] = a[3] + bfhi(w.y); y[e + 4] = bq[0] + bflo(w.z); y[e + 5] = bq[1] + bfhi(w.z); y[e + 6] = bq[2] + bflo(w.w); y[e + 7] = bq[3] + bfhi(w.w); }
            float sm = 0.f;
#pragma unroll
            for (int e = 0; e < 32; ++e) sm += y[e];
            sm += __shfl_xor(sm, 1); const float mean = sm * (1.f / 64.f);
            float sv = 0.f;
#pragma unroll
            for (int e = 0; e < 32; ++e) { const float d = y[e] - mean; sv += d * d; }
            sv += __shfl_xor(sv, 1); const float rstd = frsq(sv * (1.f / 64.f) + GN_EPS);
            const float bon = T.bon;
#pragma unroll
            for (int e = 0; e < 32; e += 8) { const v4u vw = T.vv[e >> 3], zw = T.zg[e >> 3];
                const f32x4 lw0 = *(const LAS f32x4*)(cs + e), lw1 = *(const LAS f32x4*)(cs + e + 4), lb0 = *(const LAS f32x4*)(cs + 512 + e), lb1 = *(const LAS f32x4*)(cs + 512 + e + 4);
                float o[8];
#pragma unroll
                for (int j = 0; j < 8; ++j) { const unsigned wv = vw[j >> 1], wz = zw[j >> 1]; const float vv = (j & 1) ? bfhi(wv) : bflo(wv), zg = (j & 1) ? bfhi(wz) : bflo(wz);
                    const float lw = j < 4 ? lw0[j & 3] : lw1[j & 3], lb = j < 4 ? lb0[j & 3] : lb1[j & 3];
                    o[j] = ((y[e + j] - mean) * rstd * lw + lb + bon * vv) * zg; }
                *(LAS v4u*)((LAS bf16*)yst + q * 72 + c0 + e) = (v4u){pk2(o[0], o[1]), pk2(o[2], o[3]), pk2(o[4], o[5]), pk2(o[6], o[7])}; }
            asm volatile("s_waitcnt lgkmcnt(0)" ::: "memory");
#pragma unroll
            for (int i = 0; i < 4; ++i) { const int rr = i * 8 + (lane >> 3), chk = lane & 7; const v4u w = *(const LAS v4u*)((LAS bf16*)yst + rr * 72 + chk * 8);
                *(v4u*)(QKVZ + ((size_t)b * SEQ + c * 64 + tt * 32 + rr) * QP + 512 + h * HD + chk * 8) = w; }
            asm volatile("s_waitcnt lgkmcnt(0)" ::: "memory"); }
        }
    }
}
#define BAR_ST ((volatile LAS unsigned*)(F.lds + 163832))
constexpr int LDS_BYTES = 163840;
constexpr int NPHASE = 13;

template <int PLO, int PHI> __global__ void __launch_bounds__(NTHR, 2) fwd(Args args) {
    extern __shared__ __attribute__((aligned(16))) unsigned char lds[];
    Frame F;
    F.lds = (LAS unsigned char*)lds;
#define RETID() do { int t_ = threadIdx.x; asm volatile("" : "+v"(t_)); F.tid = t_; F.lane = t_ & 63; F.wave = __builtin_amdgcn_readfirstlane(t_ >> 6); \
    int bx_ = blockIdx.x, g_ = gridDim.x; asm volatile("" : "+s"(bx_), "+s"(g_)); F.G = g_; F.vcu = (g_ % 8 == 0) ? (bx_ % 8) * (g_ / 8) + bx_ / 8 : bx_; } while (0)
    RETID();
    if (threadIdx.x == 0) { BAR_ST[0] = 0u; BAR_ST[1] = 0u; }
    if constexpr (PHI - PLO > 1) xcd_barrier_post((unsigned*)(args.ws + WS_BAR));
    if (args.ph_hi == 0x7fffffff) cg::this_grid().sync();
#define LOADF() do { const __attribute__((address_space(4))) Args* ap_ = (const __attribute__((address_space(4))) Args*)__builtin_amdgcn_kernarg_segment_ptr(); asm volatile("" : "+s"(ap_)); \
    F.x = ap_->in[0]; F.p = ap_->in[1]; F.g_pre = ap_->in[2]; F.w_in = ap_->in[3]; F.rel_bias = ap_->in[4]; F.mu = ap_->in[5]; F.w0 = ap_->in[6]; F.w_up = ap_->in[7]; \
    F.a0 = ap_->in[8]; F.a_up = ap_->in[9]; F.k_k = ap_->in[10]; F.k_a = ap_->in[11]; F.r_k = ap_->in[12]; F.ln_w = ap_->in[13]; F.ln_b = ap_->in[14]; \
    F.p_a = ap_->in[15]; F.p_b = ap_->in[16]; F.w_out = ap_->in[17]; F.g_post = ap_->in[18]; F.w_pu = ap_->in[19]; F.w_pg = ap_->in[20]; F.out = ap_->out; F.ws = ap_->ws; ws = F.ws; \
    U2 = (pg8::bf16_t*)F.out; MERGED = (pg8::bf16_t*)(ws + WS_RW); QKVZ = (pg8::bf16_t*)(ws + WS_QKVZ); RWb = (pg8::bf16_t*)(ws + WS_RW); GAB = (pg8::bf16_t*)(ws + WS_GAB); } while (0)
    unsigned char* ws; pg8::bf16_t *U2, *MERGED, *QKVZ, *RWb, *GAB;
    constexpr int lo = PLO, hi = PHI;
    cg::grid_group grid = cg::this_grid();
#define IN(k) (lo <= (k) && (k) < hi)
#define GRIDBAR() do { const __attribute__((address_space(4))) Args* apb_ = (const __attribute__((address_space(4))) Args*)__builtin_amdgcn_kernarg_segment_ptr(); asm volatile("" : "+s"(apb_)); \
    xcd_barrier((unsigned*)(apb_->ws + WS_BAR), BAR_ST); } while (0)
#define SEAM(k) do { if constexpr (IN(k) && IN((k) + 1)) GRIDBAR(); } while (0)
#ifndef MK_REPEAT_PHASE
#define MK_REPEAT_PHASE -1
#endif
#define NREP(k) (((k) == MK_REPEAT_PHASE) ? 2 : 1)

    if constexpr (IN(0)) { RETID(); LOADF(); p0_prologue(F); if constexpr (0 == MK_REPEAT_PHASE) { GRIDBAR(); RETID(); LOADF(); p0_prologue(F); } } SEAM(0);
#ifdef MK_BWTEST
    if constexpr (IN(1)) { RETID(); LOADF();
        const f32x4* xp = (const f32x4*)F.x; f32x4 acc = {0.f, 0.f, 0.f, 0.f};
        const int gw = F.vcu * NWAVES + F.wave, NGW = F.G * NWAVES;
        if (MK_BWTEST == 1) { const size_t n4 = (size_t)M * DM / 4;
            for (size_t i = (size_t)F.vcu * NTHR + F.tid; i + (size_t)31 * F.G * NTHR < n4; i += (size_t)32 * F.G * NTHR) { f32x4 t[32];
#pragma unroll
                for (int j = 0; j < 32; ++j) t[j] = xp[i + (size_t)j * F.G * NTHR];
#pragma unroll
                for (int j = 0; j < 32; ++j) acc += t[j]; }
        } else {
            for (int it = gw; it < (M / 32) * 8; it += NGW) { const int rg = it >> 3, cb = it & 7; const int q = F.lane >> 1, hf = F.lane & 1;
                const f32x4* p = xp + ((size_t)(rg * 32 + q) * DM + cb * 128 + hf * 64) / 4; f32x4 t[16];
#pragma unroll
                for (int j = 0; j < 16; ++j) t[j] = p[j];
#pragma unroll
                for (int j = 0; j < 16; ++j) acc += t[j]; } }
        if (acc[0] + acc[1] + acc[2] + acc[3] == 1.2345e30f) ((float*)(ws + WS_RSY))[F.tid] = acc[0];
        grid.sync(); }
#endif
    if constexpr (IN(1)) { RETID(); LOADF();
        { pg8::Gemm g{U2, (const pg8::bf16_t*)(ws + WS_WIN), M, INCP, DM, 2048, DM, 0, 0}; pg8::StaticOrder S; S.init(M, INCP, F.G, (int)blockIdx.x);
          pg8::EpiCols E{QKVZ, RWb, GAB, QSCALE};
          pg8::gemm_phase<pg8::EpiCols, pg8::StaticOrder, true, true>(F.lds, g, S, E);
          if constexpr (MK_REPEAT_PHASE == 101) { __syncthreads(); pg8::gemm_phase<pg8::EpiCols, pg8::StaticOrder, true, true>(F.lds, g, S, E); } }
        { pg8::Gemm g{U2, (const pg8::bf16_t*)(ws + WS_WG), M, 256, 2048, 2048, 2048, 16, (size_t)256 * 2048}; pg8::StaticOrder S; S.init(M, 256, F.G, (int)blockIdx.x);
          pg8::EpiF32 E{(float*)(ws + WS_GATE), 256};
          pg8::gemm_phase<pg8::EpiF32, pg8::StaticOrder, true, true>(F.lds, g, S, E);
          if constexpr (MK_REPEAT_PHASE == 102) { __syncthreads(); pg8::gemm_phase<pg8::EpiF32, pg8::StaticOrder, true, true>(F.lds, g, S, E); } }
    } SEAM(1);
#ifdef MK_SYNCTEST
    for (int i_ = 0; i_ < 20; ++i_) GRIDBAR();
#endif
    if constexpr (IN(2)) { RETID(); LOADF(); attn_select(F, (const float*)(ws + WS_GATE), (unsigned*)(ws + WS_CNT), (unsigned short*)((unsigned char*)F.out + DO_LISTS));
        if constexpr (2 == MK_REPEAT_PHASE) { GRIDBAR(); if (blockIdx.x == 0) for (int i = threadIdx.x; i < 2048; i += NTHR) ((unsigned*)(args.ws + WS_CNT))[i] = 0u; GRIDBAR(); RETID(); LOADF();
            attn_select(F, (const float*)(ws + WS_GATE), (unsigned*)(ws + WS_CNT), (unsigned short*)((unsigned char*)F.out + DO_LISTS)); } } SEAM(2);
    if constexpr (IN(3)) { RETID(); LOADF(); attn_partial(F, (const bf16*)(ws + WS_QKVZ), (const unsigned*)(ws + WS_CNT), (const unsigned short*)((unsigned char*)F.out + DO_LISTS),
                                         (bf16*)((unsigned char*)F.out + DO_PARTO), (float*)((unsigned char*)F.out + DO_PARTML), (unsigned*)(ws + WS_QCTR)); if constexpr (3 == MK_REPEAT_PHASE) { { GRIDBAR(); if (blockIdx.x == 0 && threadIdx.x == 0) *(unsigned*)(args.ws + WS_QCTR) = 0u; GRIDBAR(); } RETID(); LOADF(); attn_partial(F, (const bf16*)(ws + WS_QKVZ), (const unsigned*)(ws + WS_CNT), (const unsigned short*)((unsigned char*)F.out + DO_LISTS),
                                         (bf16*)((unsigned char*)F.out + DO_PARTO), (float*)((unsigned char*)F.out + DO_PARTML), (unsigned*)(ws + WS_QCTR)); } } SEAM(3);
    if constexpr (IN(4)) { RETID(); LOADF();
        if constexpr (4 == MK_REPEAT_PHASE) { attn_own_combine(F, (bf16*)(ws + WS_QKVZ), (const bf16*)((unsigned char*)F.out + DO_PARTO), (const float*)((unsigned char*)F.out + DO_PARTML), (bf16*)(ws + WS_GATE), 512); grid.sync(); RETID(); LOADF(); }
        attn_own_combine(F, (bf16*)(ws + WS_QKVZ), (const bf16*)((unsigned char*)F.out + DO_PARTO), (const float*)((unsigned char*)F.out + DO_PARTML), (bf16*)(ws + WS_QKVZ), QP); } SEAM(4);
    if constexpr (IN(5)) { RETID(); LOADF(); rwkv_chunk_ops(F); if constexpr (5 == MK_REPEAT_PHASE) { GRIDBAR(); RETID(); LOADF(); rwkv_chunk_ops(F); } } SEAM(5);
    if constexpr (IN(6)) { RETID(); LOADF(); rwkv_relay(F); if constexpr (6 == MK_REPEAT_PHASE) { GRIDBAR(); RETID(); LOADF(); rwkv_relay(F); } } SEAM(6);
    if constexpr (IN(7)) { RETID(); LOADF(); rwkv_output(F); if constexpr (7 == MK_REPEAT_PHASE) { GRIDBAR(); RETID(); LOADF(); rwkv_output(F); } } SEAM(7);
    if constexpr (IN(8)) { RETID(); LOADF();
        pg8::Gemm g{QKVZ, (const pg8::bf16_t*)(ws + WS_PAB), M, DM, 1024, QP, 1024, 0, 0}; pg8::StaticOrder S; S.init(M, DM, F.G, (int)blockIdx.x);
        pg8::EpiMergeFused E{MERGED, DM, GAB, GP};
        pg8::gemm_phase<pg8::EpiMergeFused, pg8::StaticOrder, true, true>(F.lds, g, S, E);
    } SEAM(9);
    if constexpr (IN(10)) { RETID(); LOADF();
        pg8::bf16_t* YB = RWb + (size_t)M * DM; pg8::bf16_t* H1B = QKVZ; PG8_LAS float* part = (PG8_LAS float*)(F.lds + 131072);
        for (int pm = F.vcu; pm < M / 256; pm += F.G) {
            pg8::PanelOrder S{pm};
            { pg8::Gemm g{MERGED, (const pg8::bf16_t*)(ws + WS_WOUT), M, DM, DM, DM, DM, 0, 0}; pg8::EpiYStat E{YB, DM, part};
              pg8::gemm_phase<pg8::EpiYStat, pg8::PanelOrder, true, true>(F.lds, g, S, E); }
            { int kple = PLE; asm volatile("" : "+s"(kple));
              pg8::Gemm g{(const pg8::bf16_t*)(ws + WS_PB), (const pg8::bf16_t*)(ws + WS_WPU), M, DM, kple, PLE, PLE, 0, 0}; pg8::EpiBf16 E{GAB, DM};
              pg8::gemm_phase<pg8::EpiBf16, pg8::PanelOrder, true, true>(F.lds, g, S, E); }
            asm volatile("s_waitcnt vmcnt(0) lgkmcnt(0)" ::: "memory"); __syncthreads();
            RETID(); panel_norm(F, pm, (const bf16*)YB, (bf16*)H1B, (float*)(ws + WS_RSY), (const LAS float*)part);
            asm volatile("s_waitcnt vmcnt(0)" ::: "memory"); __syncthreads();
            { pg8::Gemm g{H1B, (const pg8::bf16_t*)(ws + WS_WPG), M, DM, DM, DM, DM, 0, 0}; pg8::EpiFinal E{F.out, F.x, YB, (const float*)(ws + WS_RSY), F.g_post, GAB, DM};
              pg8::gemm_phase<pg8::EpiFinal, pg8::PanelOrder, true, true>(F.lds, g, S, E); }
            __syncthreads();
        }
    }
#undef IN
#undef SEAM
}

#ifndef MK_ONE_LAUNCH
#define MK_ONE_LAUNCH 1
#endif
extern "C" void kernel_launch(void* const* d_in, const int* in_sizes, int n_in, void* d_out, int out_size, void* d_ws, size_t ws_size, hipStream_t stream) {
    static int grid = 0;
    if (grid == 0) {
        if (n_in != 21 || out_size != M * DM || ws_size < WS_END) { fprintf(stderr, "kernel_launch: unexpected shapes n_in %d out %d ws %zu\n", n_in, out_size, ws_size); grid = -1; return; }
        int dev = 0, cus = 0, per_cu = 0;
        (void)hipGetDevice(&dev); (void)hipDeviceGetAttribute(&cus, hipDeviceAttributeMultiprocessorCount, dev);
        (void)per_cu;
        grid = cus;
    }
    if (grid < 0) return;
    if (hipMemsetAsync(d_ws, 0, 65536, stream) != hipSuccess) { fprintf(stderr, "kernel_launch: hipMemsetAsync of the control words failed\n"); return; }
    Args a{};
    for (int i = 0; i < 21; ++i) a.in[i] = (const float*)d_in[i];
    a.out = (float*)d_out; a.ws = (unsigned char*)d_ws;
#if MK_ONE_LAUNCH
    a.ph_lo = 0; a.ph_hi = NPHASE;
    void* kargs[] = {&a};
    (void)hipFuncSetAttribute((const void*)fwd<0, NPHASE>, hipFuncAttributeMaxDynamicSharedMemorySize, LDS_BYTES);
    hipError_t e = hipLaunchCooperativeKernel((const void*)fwd<0, NPHASE>, dim3(grid), dim3(NTHR), kargs, LDS_BYTES, stream);
    if (e != hipSuccess) fprintf(stderr, "cooperative launch failed: %s\n", hipGetErrorString(e));
#else
#define LAUNCH_PH(k) do { (void)hipFuncSetAttribute((const void*)fwd<k, k + 1>, hipFuncAttributeMaxDynamicSharedMemorySize, LDS_BYTES); a.ph_lo = k; a.ph_hi = k + 1; hipLaunchKernelGGL((fwd<k, k + 1>), dim3(grid), dim3(NTHR), LDS_BYTES, stream, a); } while (0)
    LAUNCH_PH(0); LAUNCH_PH(1); LAUNCH_PH(2); LAUNCH_PH(3); LAUNCH_PH(4); LAUNCH_PH(5); LAUNCH_PH(6); LAUNCH_PH(7); LAUNCH_PH(8); LAUNCH_PH(9); LAUNCH_PH(10); LAUNCH_PH(11); LAUNCH_PH(12);
#endif
}
```

```cpp
#include <hip/hip_runtime.h>
#include <hip/hip_cooperative_groups.h>
#include <cstdio>
#include <cstdint>
#include <cmath>
namespace cg = cooperative_groups;
namespace pg8 {
#define PG8_LAS __attribute__((address_space(3)))
typedef unsigned short bf16_t;
typedef short bf16x8 __attribute__((ext_vector_type(8)));
typedef float f32x4 __attribute__((ext_vector_type(4)));
typedef float f32x2 __attribute__((ext_vector_type(2)));
typedef unsigned u32x4 __attribute__((ext_vector_type(4)));
typedef unsigned u32x2 __attribute__((ext_vector_type(2)));
constexpr int BM = 256, BK = 64, HALF = 128, HTB = HALF * BK * 2  , STAGE_BYTES = 8 * HTB, NXCD = 8, WGM = 8;

__host__ __device__ __forceinline__ int lds_byte(int r, int c) { const int st = (r >> 4) * 2 + (c >> 5), rr = r & 15, cc = c & 31, ob = rr * 64 + cc * 2; return st * 1024 + (ob ^ (((ob >> 9) & 1) << 5)); }
__host__ __device__ __forceinline__ void stage_rc(int b, int& R, int& C) { const int st = b / 1024, sb = b % 1024, swz = sb ^ (((sb >> 9) & 1) << 5); R = (st >> 1) * 16 + swz / 64; C = (st & 1) * 32 + (swz % 64) / 2; }
__host__ __device__ __forceinline__ int perm32(int rho) { const int n = rho >> 4, i = rho & 15; return 8 * (i >> 2) + 4 * n + (i & 3); }

struct Unit { int pm, pn; };
struct Gemm { const bf16_t* A; const bf16_t* Bt; int M, N, K, lda, ldb, bdiv; size_t bstride; };

struct StaticOrder {
    int nM, nN, nwg, G, c;
    __host__ __device__ void init(int M, int N, int G_, int c_) { nM = M / BM; nN = N / BM; nwg = nM * nN; G = G_; c = c_; }
    __host__ __device__ bool next(int i, Unit& u) const {
        const long L = (long)i * G + c; if (L >= nwg) return false;
        int wgid = (int)L; { const int q = nwg / NXCD, r = nwg % NXCD, xcd = wgid % NXCD, off = wgid / NXCD; wgid = (xcd < r ? xcd * (q + 1) : r * (q + 1) + (xcd - r) * q) + off; }
        const int nig = WGM * nN, gid = wgid / nig, fm = gid * WGM, gsz = (nM - fm) < WGM ? (nM - fm) : WGM;
        u.pm = fm + ((wgid % nig) % gsz); u.pn = (wgid % nig) / gsz; return true;
    }
};

struct PanelOrder { int pm; __host__ __device__ bool next(int i, Unit& u) const { if (i >= 4) return false; u.pm = pm; u.pn = i; return true; } };
__device__ __forceinline__ unsigned cvt_pk_bf16(float lo, float hi) { unsigned r; asm volatile("v_cvt_pk_bf16_f32 %0, %1, %2" : "=v"(r) : "v"(lo), "v"(hi)); return r; }
__device__ __forceinline__ float bf_lo(unsigned w) { return __uint_as_float(w << 16); }
__device__ __forceinline__ float bf_hi(unsigned w) { return __uint_as_float(w & 0xffff0000u); }

template <class Epi, class Sched, bool ALIGN_EPI = false, bool SP2 = false>
__device__ __forceinline__ void gemm_phase(PG8_LAS unsigned char* lds, const Gemm g, const Sched& S, const Epi& E) {
    int tid_ = threadIdx.x; asm volatile("" : "+v"(tid_));
    const int tid = tid_, wid = __builtin_amdgcn_readfirstlane(tid >> 6), lane = tid & 63, wr = wid >> 2, wc = wid & 3, fr = lane & 15, fq = lane >> 4;
    const int K = g.K, nt = K / BK;
    unsigned voffA[2], voffB[2];
#pragma unroll
    for (int i = 0; i < 2; ++i) { int R, C; stage_rc(tid * 16 + i * 8192, R, C); const int Rb = Epi::PERM ? ((R & ~31) + perm32(R & 31)) : R;
        voffA[i] = (unsigned)(R * g.lda + C) * 2u; voffB[i] = (unsigned)(Rb * g.ldb + C) * 2u; }
    const size_t kstep = (size_t)(BK * 2);
    const size_t hstepA = (size_t)HALF * g.lda * 2, hstepB = (size_t)HALF * g.ldb * 2;
    const size_t tstepA = 2 * hstepA, tstepB = 2 * hstepB;
    const unsigned ldsw = (unsigned)wid * 1024u;
    const int aoff = lds_byte(wr * 64 + fr, fq * 8), boff = lds_byte(wc * 32 + fr, fq * 8);
#define PG8_SA(b, h) (((b) * 2 + (h)) * HTB)
#define PG8_SB(b, h) ((4 + (b) * 2 + (h)) * HTB)
#define PG8_STAGE(bufoff, gbase, voff) do { _Pragma("unroll") for (int _i = 0; _i < 2; ++_i) \
        __builtin_amdgcn_global_load_lds((const unsigned*)((const char*)(gbase) + (voff)[_i]), (PG8_LAS unsigned*)(lds + (bufoff) + ldsw + _i * 8192), 16, 0, 0); } while (0)
#define PG8_LDA(dst, b, h) do { _Pragma("unroll") for (int m = 0; m < 4; ++m) _Pragma("unroll") for (int k = 0; k < 2; ++k) dst[m][k] = *(const PG8_LAS bf16x8*)(lds + PG8_SA(b, h) + aoff + m * 2048 + k * 1024); } while (0)
#define PG8_LDB(dst, b, h) do { _Pragma("unroll") for (int n = 0; n < 2; ++n) _Pragma("unroll") for (int k = 0; k < 2; ++k) dst[n][k] = *(const PG8_LAS bf16x8*)(lds + PG8_SB(b, h) + boff + n * 2048 + k * 1024); } while (0)
#define PG8_MMA(ai, bj, At, Bt) do { __builtin_amdgcn_s_setprio(1); _Pragma("unroll") for (int m = 0; m < 4; ++m) _Pragma("unroll") for (int n = 0; n < 2; ++n) _Pragma("unroll") for (int k = 0; k < 2; ++k) \
        acc[ai][bj][m][n] = __builtin_amdgcn_mfma_f32_16x16x32_bf16(Bt[n][k], At[m][k], acc[ai][bj][m][n], 0, 0, 0); __builtin_amdgcn_s_setprio(0); } while (0)
#define PG8_WAIT_V(n) asm volatile("s_waitcnt vmcnt(" #n ")" ::: "memory")
#define PG8_WAIT_L(n) asm volatile("s_waitcnt lgkmcnt(" #n ")" ::: "memory")
#define PG8_BAR __builtin_amdgcn_s_barrier()
#define PG8_SCHED __builtin_amdgcn_sched_barrier(0)
#define PG8_BBASE(u) ((const char*)g.Bt + (size_t)(u).pn * tstepB + (g.bdiv ? (size_t)((u).pm / g.bdiv) * g.bstride * 2 : (size_t)0))
    Unit cur, nxt; int ui = 0;
    if (!S.next(0, cur)) return;
    f32x4 acc[2][2][4][2];
#pragma unroll
    for (int a = 0; a < 2; ++a)
#pragma unroll
        for (int b = 0; b < 2; ++b)
#pragma unroll
            for (int m = 0; m < 4; ++m)
#pragma unroll
                for (int n = 0; n < 2; ++n) acc[a][b][m][n] = (f32x4){0.f, 0.f, 0.f, 0.f};
    bf16x8 At[4][2], B0[2][2], B1[2][2];
    const char* cA = (const char*)g.A + (size_t)cur.pm * tstepA; const char* cB = PG8_BBASE(cur);
    if constexpr (SP2) {
        PG8_STAGE(PG8_SB(0, 0), cB, voffB); PG8_STAGE(PG8_SB(0, 1), cB + hstepB, voffB); PG8_STAGE(PG8_SA(0, 0), cA, voffA); PG8_STAGE(PG8_SA(0, 1), cA + hstepA, voffA);
        if (wr == 1) PG8_BAR;
        PG8_WAIT_V(2); PG8_BAR;
        PG8_STAGE(PG8_SB(1, 0), cB + kstep, voffB); PG8_STAGE(PG8_SA(1, 0), cA + kstep, voffA); PG8_STAGE(PG8_SB(1, 1), cB + hstepB + kstep, voffB);
        PG8_WAIT_V(6); PG8_BAR;
    } else {
        PG8_STAGE(PG8_SB(0, 0), cB, voffB); PG8_STAGE(PG8_SA(0, 0), cA, voffA); PG8_STAGE(PG8_SB(0, 1), cB + hstepB, voffB); PG8_STAGE(PG8_SA(0, 1), cA + hstepA, voffA);
        if (wr == 1) PG8_BAR;
        PG8_WAIT_V(4); PG8_BAR;
        PG8_STAGE(PG8_SB(1, 0), cB + kstep, voffB); PG8_STAGE(PG8_SA(1, 0), cA + kstep, voffA); PG8_STAGE(PG8_SB(1, 1), cB + hstepB + kstep, voffB);
        PG8_WAIT_V(6); PG8_BAR;
    }
    for (;;) {
        const bool has_next = S.next(ui + 1, nxt);
        const char* nA = has_next ? (const char*)g.A + (size_t)nxt.pm * tstepA : cA; const char* nB = has_next ? PG8_BBASE(nxt) : cB;
        for (int t = 0; t < nt; t += 2) {
            if constexpr (Epi::HOOK_T > 0) { if (t == Epi::HOOK_T) { PG8_SCHED; E.mid(acc, cur, wr, wc, fr, fq); PG8_SCHED; } }
            const bool last = (t == nt - 2);
            const char* a1 = cA + (size_t)(t + 1) * kstep;
            const char* a2 = last ? nA : cA + (size_t)(t + 2) * kstep; const char* b2 = last ? nB : cB + (size_t)(t + 2) * kstep;
            const char* a3 = a2 + kstep; const char* b3 = b2 + kstep;
            if constexpr (SP2) {
            PG8_LDB(B0, 0, 0); PG8_LDB(B1, 0, 1); PG8_SCHED; PG8_LDA(At, 0, 0); PG8_STAGE(PG8_SA(1, 1), a1 + hstepA, voffA);
            PG8_WAIT_V(8); PG8_WAIT_L(0); PG8_BAR; PG8_MMA(0, 0, At, B0); PG8_MMA(0, 1, At, B1); PG8_BAR; PG8_SCHED;
            PG8_LDA(At, 0, 1); PG8_STAGE(PG8_SB(0, 0), b2, voffB); PG8_STAGE(PG8_SB(0, 1), b2 + hstepB, voffB); PG8_STAGE(PG8_SA(0, 0), a2, voffA);
            PG8_WAIT_V(8); PG8_WAIT_L(0); PG8_BAR; PG8_MMA(1, 0, At, B0); PG8_MMA(1, 1, At, B1); PG8_BAR; PG8_SCHED;
            PG8_LDB(B0, 1, 0); PG8_LDB(B1, 1, 1); PG8_SCHED; PG8_LDA(At, 1, 0); PG8_STAGE(PG8_SA(0, 1), a2 + hstepA, voffA);
            PG8_WAIT_V(8); PG8_WAIT_L(0); PG8_BAR; PG8_MMA(0, 0, At, B0); PG8_MMA(0, 1, At, B1); PG8_BAR; PG8_SCHED;
            PG8_LDA(At, 1, 1); PG8_STAGE(PG8_SB(1, 0), b3, voffB); PG8_STAGE(PG8_SB(1, 1), b3 + hstepB, voffB); PG8_STAGE(PG8_SA(1, 0), a3, voffA);
            PG8_WAIT_V(8); PG8_WAIT_L(0); PG8_BAR; PG8_MMA(1, 0, At, B0); PG8_MMA(1, 1, At, B1); PG8_BAR; PG8_SCHED;
            } else {
            PG8_LDB(B0, 0, 0); PG8_SCHED; PG8_LDA(At, 0, 0); PG8_STAGE(PG8_SA(1, 1), a1 + hstepA, voffA);
            PG8_WAIT_L(8); PG8_BAR; PG8_WAIT_L(0); PG8_MMA(0, 0, At, B0); PG8_BAR; PG8_SCHED;
            PG8_LDB(B1, 0, 1); PG8_STAGE(PG8_SB(0, 0), b2, voffB);
            PG8_BAR; PG8_WAIT_L(0); PG8_MMA(0, 1, At, B1); PG8_BAR;
            PG8_LDA(At, 0, 1); PG8_STAGE(PG8_SA(0, 0), a2, voffA);
            PG8_BAR; PG8_WAIT_L(0); PG8_MMA(1, 0, At, B0); PG8_BAR; PG8_SCHED;
            PG8_STAGE(PG8_SB(0, 1), b2 + hstepB, voffB);
            PG8_WAIT_V(6); PG8_BAR; PG8_MMA(1, 1, At, B1); PG8_BAR;
            PG8_LDB(B0, 1, 0); PG8_SCHED; PG8_LDA(At, 1, 0); PG8_STAGE(PG8_SA(0, 1), a2 + hstepA, voffA);
            PG8_WAIT_L(8); PG8_BAR; PG8_WAIT_L(0); PG8_MMA(0, 0, At, B0); PG8_BAR; PG8_SCHED;
            PG8_LDB(B1, 1, 1); PG8_STAGE(PG8_SB(1, 0), b3, voffB);
            PG8_BAR; PG8_WAIT_L(0); PG8_MMA(0, 1, At, B1); PG8_BAR;
            PG8_LDA(At, 1, 1); PG8_STAGE(PG8_SA(1, 0), a3, voffA);
            PG8_BAR; PG8_WAIT_L(0); PG8_MMA(1, 0, At, B0); PG8_BAR; PG8_SCHED;
            PG8_STAGE(PG8_SB(1, 1), b3 + hstepB, voffB);
            PG8_WAIT_V(6); PG8_BAR; PG8_MMA(1, 1, At, B1); PG8_BAR;
            }
        }
        if constexpr (ALIGN_EPI) { if (wr == 0) PG8_BAR; }
        E(acc, cur, wr, wc, fr, fq);
        if (!has_next) break;
#pragma unroll
        for (int a = 0; a < 2; ++a)
#pragma unroll
            for (int b = 0; b < 2; ++b)
#pragma unroll
                for (int m = 0; m < 4; ++m)
#pragma unroll
                    for (int n = 0; n < 2; ++n) acc[a][b][m][n] = (f32x4){0.f, 0.f, 0.f, 0.f};
        cur = nxt; cA = nA; cB = nB; ++ui;
        if constexpr (ALIGN_EPI) { if (wr == 1) PG8_BAR; }
    }
    PG8_WAIT_V(0);
    if constexpr (!ALIGN_EPI) { if (wr == 0) PG8_BAR; }
    PG8_BAR;
#undef PG8_SA
#undef PG8_SB
#undef PG8_STAGE
#undef PG8_LDA
#undef PG8_LDB
#undef PG8_MMA
#undef PG8_WAIT_V
#undef PG8_WAIT_L
#undef PG8_BAR
#undef PG8_SCHED
#undef PG8_BBASE
}
}
namespace pg8 {
__device__ __forceinline__ float sigmoidf_(float x) { return __builtin_amdgcn_rcpf(1.0f + __builtin_amdgcn_exp2f(x * -1.4426950408889634f)); }

struct EpiCols {
    static constexpr bool PERM = true; static constexpr int HOOK_T = 0;
    bf16_t* qkvz; bf16_t* rw; bf16_t* gab; float qscale;
    __device__ __forceinline__ void operator()(const f32x4 (&acc)[2][2][4][2], const Unit& u, int wr, int wc, int fr, int fq) const {
        const int pn = u.pn; bf16_t* base; int pitch, coff, nbj = 2; float sc = 1.f;
        if (pn < 8) { base = qkvz; pitch = 2112; coff = pn * 256; if (pn < 2) sc = qscale; }
        else if (pn < 16) { base = rw; pitch = 2176; coff = (pn - 8) * 256; }
        else if (pn < 24) { base = gab; pitch = 2112; coff = (pn - 16) * 256; }
        else { base = rw; pitch = 2176; coff = 2048; nbj = 1; }
        const int row0 = u.pm * BM + wr * 64 + fr; const int col0 = coff + wc * 32 + 8 * fq;
#pragma unroll
        for (int ai = 0; ai < 2; ++ai)
#pragma unroll
            for (int m = 0; m < 4; ++m) { bf16_t* rowp = base + (size_t)(row0 + ai * HALF + m * 16) * pitch + col0;
#pragma unroll
                for (int bj = 0; bj < 2; ++bj) { if (bj < nbj) { f32x4 v0 = acc[ai][bj][m][0] * sc, v1 = acc[ai][bj][m][1] * sc;
                    u32x4 w; w.x = cvt_pk_bf16(v0[0], v0[1]); w.y = cvt_pk_bf16(v0[2], v0[3]); w.z = cvt_pk_bf16(v1[0], v1[1]); w.w = cvt_pk_bf16(v1[2], v1[3]);
                    *(u32x4*)(rowp + bj * HALF) = w; } } }
    }
};
struct EpiBf16 {
    static constexpr bool PERM = true; static constexpr int HOOK_T = 0;
    bf16_t* O; int ldc;
    __device__ __forceinline__ void operator()(const f32x4 (&acc)[2][2][4][2], const Unit& u, int wr, int wc, int fr, int fq) const {
        const int row0 = u.pm * BM + wr * 64 + fr; const int col0 = u.pn * BM + wc * 32 + 8 * fq;
#pragma unroll
        for (int ai = 0; ai < 2; ++ai)
#pragma unroll
            for (int m = 0; m < 4; ++m) { bf16_t* rowp = O + (size_t)(row0 + ai * HALF + m * 16) * ldc + col0;
#pragma unroll
                for (int bj = 0; bj < 2; ++bj) { const f32x4 v0 = acc[ai][bj][m][0], v1 = acc[ai][bj][m][1];
                    u32x4 w; w.x = cvt_pk_bf16(v0[0], v0[1]); w.y = cvt_pk_bf16(v0[2], v0[3]); w.z = cvt_pk_bf16(v1[0], v1[1]); w.w = cvt_pk_bf16(v1[2], v1[3]);
                    *(u32x4*)(rowp + bj * HALF) = w; } }
    }
};
struct EpiF32 {
    static constexpr bool PERM = false; static constexpr int HOOK_T = 0;
    float* O; int ldc;
    __device__ __forceinline__ void operator()(const f32x4 (&acc)[2][2][4][2], const Unit& u, int wr, int wc, int fr, int fq) const {
        const int row0 = u.pm * BM + wr * 64 + fr; const int col0 = u.pn * BM + wc * 32 + 4 * fq;
#pragma unroll
        for (int ai = 0; ai < 2; ++ai)
#pragma unroll
            for (int m = 0; m < 4; ++m) { float* rowp = O + (size_t)(row0 + ai * HALF + m * 16) * ldc + col0;
#pragma unroll
                for (int bj = 0; bj < 2; ++bj)
#pragma unroll
                    for (int n = 0; n < 2; ++n) *(f32x4*)(rowp + bj * HALF + n * 16) = acc[ai][bj][m][n]; }
    }
};
template <bool ADD> struct EpiMerge {
    static constexpr bool PERM = true; static constexpr int HOOK_T = 0;
    bf16_t* O; int ldc; const bf16_t* G; int ldg;
    __device__ __forceinline__ void operator()(const f32x4 (&acc)[2][2][4][2], const Unit& u, int wr, int wc, int fr, int fq) const {
        const int row0 = u.pm * BM + wr * 64 + fr; const int col0 = u.pn * BM + wc * 32 + 8 * fq;
#pragma unroll
        for (int ai = 0; ai < 2; ++ai)
#pragma unroll
            for (int m = 0; m < 4; ++m) { const size_t r = (size_t)(row0 + ai * HALF + m * 16);
#pragma unroll
                for (int bj = 0; bj < 2; ++bj) { const f32x4 v0 = acc[ai][bj][m][0], v1 = acc[ai][bj][m][1];
                    const u32x4 gw = *(const u32x4*)(G + r * ldg + col0 + bj * HALF);
                    float o[8];
                    o[0] = sigmoidf_(bf_lo(gw.x)) * v0[0]; o[1] = sigmoidf_(bf_hi(gw.x)) * v0[1]; o[2] = sigmoidf_(bf_lo(gw.y)) * v0[2]; o[3] = sigmoidf_(bf_hi(gw.y)) * v0[3];
                    o[4] = sigmoidf_(bf_lo(gw.z)) * v1[0]; o[5] = sigmoidf_(bf_hi(gw.z)) * v1[1]; o[6] = sigmoidf_(bf_lo(gw.w)) * v1[2]; o[7] = sigmoidf_(bf_hi(gw.w)) * v1[3];
                    bf16_t* op = O + r * ldc + col0 + bj * HALF;
                    if (ADD) { const u32x4 pw = *(const u32x4*)op;
                        o[0] += bf_lo(pw.x); o[1] += bf_hi(pw.x); o[2] += bf_lo(pw.y); o[3] += bf_hi(pw.y); o[4] += bf_lo(pw.z); o[5] += bf_hi(pw.z); o[6] += bf_lo(pw.w); o[7] += bf_hi(pw.w); }
                    u32x4 w; w.x = cvt_pk_bf16(o[0], o[1]); w.y = cvt_pk_bf16(o[2], o[3]); w.z = cvt_pk_bf16(o[4], o[5]); w.w = cvt_pk_bf16(o[6], o[7]);
                    *(u32x4*)op = w; } }
    }
};
struct EpiYStat {
    static constexpr bool PERM = true; static constexpr int HOOK_T = 0;
    bf16_t* O; int ldc; PG8_LAS float* part;
    __device__ __forceinline__ void operator()(const f32x4 (&acc)[2][2][4][2], const Unit& u, int wr, int wc, int fr, int fq) const {
        const int row0 = u.pm * BM + wr * 64 + fr; const int col0 = u.pn * BM + wc * 32 + 8 * fq;
#pragma unroll
        for (int ai = 0; ai < 2; ++ai)
#pragma unroll
            for (int m = 0; m < 4; ++m) { bf16_t* rowp = O + (size_t)(row0 + ai * HALF + m * 16) * ldc + col0; float s = 0.f;
#pragma unroll
                for (int bj = 0; bj < 2; ++bj) { const f32x4 v0 = acc[ai][bj][m][0], v1 = acc[ai][bj][m][1];
                    u32x4 w; w.x = cvt_pk_bf16(v0[0], v0[1]); w.y = cvt_pk_bf16(v0[2], v0[3]); w.z = cvt_pk_bf16(v1[0], v1[1]); w.w = cvt_pk_bf16(v1[2], v1[3]);
                    *(u32x4*)(rowp + bj * HALF) = w;
                    s += (bf_lo(w.x) * bf_lo(w.x) + bf_hi(w.x) * bf_hi(w.x)) + (bf_lo(w.y) * bf_lo(w.y) + bf_hi(w.y) * bf_hi(w.y)) + (bf_lo(w.z) * bf_lo(w.z) + bf_hi(w.z) * bf_hi(w.z)) + (bf_lo(w.w) * bf_lo(w.w) + bf_hi(w.w) * bf_hi(w.w)); }
                s += __shfl_xor(s, 16); s += __shfl_xor(s, 32);
                if (fq == 0) part[(ai * HALF + wr * 64 + m * 16 + fr) * 16 + wc * 4 + u.pn] = s; }
    }
};
struct EpiMergeFused {
    static constexpr bool PERM = true; static constexpr int HOOK_T = 8;
    bf16_t* O; int ldc; const bf16_t* G; int ldg;
    struct GOps { u32x4 ga[2], gb[2]; };
    __device__ __forceinline__ void loadg(GOps& o, size_t r, int col0, bool both) const {
#pragma unroll
        for (int bj = 0; bj < 2; ++bj) { if (both) o.ga[bj] = *(const u32x4*)(G + r * ldg + col0 + bj * HALF); o.gb[bj] = *(const u32x4*)(G + r * ldg + 1024 + col0 + bj * HALF); }
    }
    __device__ __forceinline__ void mid(f32x4 (&acc)[2][2][4][2], const Unit& u, int wr, int wc, int fr, int fq) const {
        asm volatile("" : "+v"(fr), "+v"(fq));
        const int row0 = u.pm * BM + wr * 64 + fr; const int col0 = u.pn * BM + wc * 32 + 8 * fq;
        GOps A, B; loadg(A, (size_t)row0, col0, true);
#pragma unroll
        for (int g = 0; g < 8; ++g) { const int ai = g >> 2, m = g & 3; GOps& cur = (g & 1) ? B : A; GOps& nxt = (g & 1) ? A : B;
            if (g < 7) loadg(nxt, (size_t)(row0 + ((g + 1) >> 2) * HALF + ((g + 1) & 3) * 16), col0, true);
            __builtin_amdgcn_sched_barrier(0);
#pragma unroll
            for (int bj = 0; bj < 2; ++bj) { const u32x4 ga = cur.ga[bj], gb = cur.gb[bj];
#define MQ_(wa, wb, HI) ((1.0f + __builtin_amdgcn_exp2f(fmaxf(HI ? bf_hi(wb) : bf_lo(wb), -80.f) * -1.4426950408889634f)) * __builtin_amdgcn_rcpf(1.0f + __builtin_amdgcn_exp2f((HI ? bf_hi(wa) : bf_lo(wa)) * -1.4426950408889634f)))
                acc[ai][bj][m][0][0] *= MQ_(ga.x, gb.x, 0); acc[ai][bj][m][0][1] *= MQ_(ga.x, gb.x, 1); acc[ai][bj][m][0][2] *= MQ_(ga.y, gb.y, 0); acc[ai][bj][m][0][3] *= MQ_(ga.y, gb.y, 1);
                acc[ai][bj][m][1][0] *= MQ_(ga.z, gb.z, 0); acc[ai][bj][m][1][1] *= MQ_(ga.z, gb.z, 1); acc[ai][bj][m][1][2] *= MQ_(ga.w, gb.w, 0); acc[ai][bj][m][1][3] *= MQ_(ga.w, gb.w, 1);
#undef MQ_
            }
            __builtin_amdgcn_sched_barrier(0); }
    }
    __device__ __forceinline__ void operator()(const f32x4 (&acc)[2][2][4][2], const Unit& u, int wr, int wc, int fr, int fq) const {
        asm volatile("" : "+v"(fr), "+v"(fq));
        const int row0 = u.pm * BM + wr * 64 + fr; const int col0 = u.pn * BM + wc * 32 + 8 * fq;
        GOps A, B; loadg(A, (size_t)row0, col0, false);
#pragma unroll
        for (int g = 0; g < 8; ++g) { const int ai = g >> 2, m = g & 3; const size_t r = (size_t)(row0 + ai * HALF + m * 16); GOps& cur = (g & 1) ? B : A; GOps& nxt = (g & 1) ? A : B;
            if (g < 7) loadg(nxt, (size_t)(row0 + ((g + 1) >> 2) * HALF + ((g + 1) & 3) * 16), col0, false);
            __builtin_amdgcn_sched_barrier(0);
#pragma unroll
            for (int bj = 0; bj < 2; ++bj) { const f32x4 v0 = acc[ai][bj][m][0], v1 = acc[ai][bj][m][1]; const u32x4 gw = cur.gb[bj];
                u32x4 w; w.x = cvt_pk_bf16(sigmoidf_(fmaxf(bf_lo(gw.x), -80.f)) * v0[0], sigmoidf_(fmaxf(bf_hi(gw.x), -80.f)) * v0[1]); w.y = cvt_pk_bf16(sigmoidf_(fmaxf(bf_lo(gw.y), -80.f)) * v0[2], sigmoidf_(fmaxf(bf_hi(gw.y), -80.f)) * v0[3]);
                w.z = cvt_pk_bf16(sigmoidf_(fmaxf(bf_lo(gw.z), -80.f)) * v1[0], sigmoidf_(fmaxf(bf_hi(gw.z), -80.f)) * v1[1]); w.w = cvt_pk_bf16(sigmoidf_(fmaxf(bf_lo(gw.w), -80.f)) * v1[2], sigmoidf_(fmaxf(bf_hi(gw.w), -80.f)) * v1[3]);
                *(u32x4*)(O + r * ldc + col0 + bj * HALF) = w; }
            __builtin_amdgcn_sched_barrier(0); }
    }
};
struct EpiFinal {
    static constexpr bool PERM = false; static constexpr int HOOK_T = 0;
    float* out; const float* x; const bf16_t* y; const float* rsy; const float* gpost; const bf16_t* E; int ldc;
    struct Ops { f32x4 xv[4]; u32x2 yw[4], ew[4]; float rs; };
    __device__ __forceinline__ void load(Ops& o, size_t r, int col0) const {
#pragma unroll
        for (int q = 0; q < 4; ++q) { const size_t off = r * ldc + col0 + (q >> 1) * HALF + (q & 1) * 16; o.xv[q] = *(const f32x4*)(x + off); o.yw[q] = *(const u32x2*)(y + off); o.ew[q] = *(const u32x2*)(E + off); }
        o.rs = rsy[r];
    }
    __device__ __forceinline__ void operator()(const f32x4 (&acc)[2][2][4][2], const Unit& u, int wr, int wc, int fr, int fq) const {
        asm volatile("" : "+v"(fr), "+v"(fq));
        const int row0 = u.pm * BM + wr * 64 + fr; const int col0 = u.pn * BM + wc * 32 + 4 * fq;
        f32x4 gp[4];
#pragma unroll
        for (int q = 0; q < 4; ++q) gp[q] = *(const f32x4*)(gpost + col0 + (q >> 1) * HALF + (q & 1) * 16);
        Ops A, B;
        load(A, (size_t)row0, col0);
#pragma unroll
        for (int g = 0; g < 8; ++g) { const int ai = g >> 2, m = g & 3; const size_t r = (size_t)(row0 + ai * HALF + m * 16);
            Ops& cur = (g & 1) ? B : A; Ops& nxt = (g & 1) ? A : B;
            if (g < 7) load(nxt, (size_t)(row0 + ((g + 1) >> 2) * HALF + ((g + 1) & 3) * 16), col0);
            __builtin_amdgcn_sched_barrier(0);
#pragma unroll
            for (int q = 0; q < 4; ++q) { const int bj = q >> 1, n = q & 1; const f32x4 a = acc[ai][bj][m][n]; const f32x4 xv = cur.xv[q]; const u32x2 yw = cur.yw[q], ew = cur.ew[q]; const float rs = cur.rs; f32x4 o;
                o[0] = xv[0] + bf_lo(yw.x) * rs * gp[q][0] + sigmoidf_(a[0]) * bf_lo(ew.x);
                o[1] = xv[1] + bf_hi(yw.x) * rs * gp[q][1] + sigmoidf_(a[1]) * bf_hi(ew.x);
                o[2] = xv[2] + bf_lo(yw.y) * rs * gp[q][2] + sigmoidf_(a[2]) * bf_lo(ew.y);
                o[3] = xv[3] + bf_hi(yw.y) * rs * gp[q][3] + sigmoidf_(a[3]) * bf_hi(ew.y);
                *(f32x4*)(out + r * ldc + col0 + bj * HALF + n * 16) = o; }
            __builtin_amdgcn_sched_barrier(0); }
    }
};
}
#define GAS __attribute__((address_space(1)))
#define LAS __attribute__((address_space(3)))
typedef unsigned short bf16;
typedef unsigned v4u __attribute__((ext_vector_type(4)));
typedef unsigned v2u __attribute__((ext_vector_type(2)));
typedef float f32x4 __attribute__((ext_vector_type(4)));

constexpr int NWAVES = 8, NTHR = 512;
constexpr int BATCH = 16, SEQ = 4096, DM = 1024, M = BATCH * SEQ;
constexpr int NH = 8, HD = 64, AW = 512, PLE = 256;
constexpr int RWC = 2176, INC = 6272, INCP = 6400;
constexpr int NBLK = 16, BLK = 256;
constexpr float RMS_EPS = 1e-6f, GN_EPS = 64e-5f;
constexpr float LOG2E = 1.4426950408889634f;
constexpr float QSCALE = 0.125f * LOG2E;

constexpr size_t MiB = 1u << 20;
constexpr size_t WS_WIN = 2 * MiB;
constexpr size_t WS_WG = 16 * MiB;
constexpr size_t WS_PAB = 32 * MiB;
constexpr size_t WS_WOUT = 34 * MiB;
constexpr size_t WS_WPG = 36 * MiB;
constexpr size_t WS_WPU = 38 * MiB;
constexpr size_t WS_RSY = 39 * MiB;
constexpr size_t WS_PB = 42 * MiB;
constexpr size_t WS_GATE = 74 * MiB;
constexpr int QP = 2112, GP = 2112;
constexpr size_t WS_QKVZ = 138 * MiB;
constexpr size_t WS_RW = 402 * MiB;
constexpr size_t WS_GAB = 674 * MiB;
constexpr size_t WS_END = 1004 * MiB;
constexpr size_t WS_CNT = 0;
constexpr size_t WS_QCTR = 16384;
constexpr size_t WS_WUPT = 39 * MiB + 512 * 1024, WS_AUPT = WS_WUPT + 65536;
constexpr size_t WS_BON = 938 * MiB;
constexpr size_t WS_SC = 940 * MiB;
constexpr size_t DO_PARTO = 0, DO_PARTML = 192 * MiB, DO_LISTS = 208 * MiB;

__device__ const unsigned char T5B[128] = {0, 1, 2, 3, 4, 5, 6, 7, 8, 9, 10, 11, 12, 13, 14, 15, 16, 16, 16, 17, 17, 18, 18, 18, 19, 19, 19, 20, 20, 20, 20, 21, 21, 21, 21, 22, 22, 22, 22, 22, 23, 23, 23, 23, 23, 23, 24, 24, 24, 24, 24, 24, 25, 25, 25, 25, 25, 25, 25, 26, 26, 26, 26, 26, 26, 26, 26, 27, 27, 27, 27, 27, 27, 27, 27, 27, 27, 28, 28, 28, 28, 28, 28, 28, 28, 28, 28, 29, 29, 29, 29, 29, 29, 29, 29, 29, 29, 29, 29, 30, 30, 30, 30, 30, 30, 30, 30, 30, 30, 30, 30, 30, 30, 31, 31, 31, 31, 31, 31, 31, 31, 31, 31, 31, 31, 31, 31, 31};

typedef float f32x2_cv __attribute__((ext_vector_type(2))); typedef __bf16 bf16x2_cv __attribute__((ext_vector_type(2)));
__device__ __forceinline__ unsigned pk2(float lo, float hi) { f32x2_cv v = {lo, hi}; bf16x2_cv b = __builtin_convertvector(v, bf16x2_cv); return __builtin_bit_cast(unsigned, b); }
__device__ __forceinline__ unsigned f2bf(float f) { return pk2(f, 0.f) & 0xffffu; }
__device__ __forceinline__ float bf2f(unsigned short h) { return __uint_as_float((unsigned)h << 16); }
__device__ __forceinline__ float wave_sum(float v) {
#pragma unroll
    for (int o = 1; o < 64; o <<= 1) v += __shfl_xor(v, o);
    return v;
}
__device__ __forceinline__ float fexp2(float x) { return __builtin_amdgcn_exp2f(x); }
__device__ __forceinline__ float fexp(float x) { return __builtin_amdgcn_exp2f(x * LOG2E); }
__device__ __forceinline__ float frcp(float x) { return __builtin_amdgcn_rcpf(x); }
__device__ __forceinline__ float frsq(float x) { return __builtin_amdgcn_rsqf(x); }
__device__ __forceinline__ float sigm(float x) { return frcp(1.0f + fexp2(-x * LOG2E)); }
__device__ __forceinline__ float ftanh(float x) { return 1.0f - 2.0f * frcp(1.0f + fexp2(x * (2.0f * LOG2E))); }
__device__ __forceinline__ float dpp_sum32(float v) {
#define DPP_ADD_(ctrl, rmask) v += __builtin_bit_cast(float, __builtin_amdgcn_update_dpp(0, __builtin_bit_cast(int, v), ctrl, rmask, 0xf, true))
    DPP_ADD_(0x118, 0xf); DPP_ADD_(0x114, 0xf); DPP_ADD_(0x112, 0xf); DPP_ADD_(0x111, 0xf);
    v += __builtin_bit_cast(float, __builtin_amdgcn_update_dpp(0, __builtin_bit_cast(int, v), 0x142, 0xa, 0xf, false));
#undef DPP_ADD_
    return v;
}

struct Args {
    const float* in[21]; float* out; unsigned char* ws; int ph_lo, ph_hi;
};
struct Frame {
    LAS unsigned char* lds; int tid, lane, wave, vcu, G;
    const float *x, *p, *g_pre, *w_in, *rel_bias, *mu, *w0, *w_up, *a0, *a_up, *k_k, *k_a, *r_k, *ln_w, *ln_b, *p_a, *p_b, *w_out, *g_post, *w_pu, *w_pg;
    float* out; unsigned char* ws;
};

__device__ __forceinline__ float wave_sum_fast(float v) { v = dpp_sum32(v); return __builtin_bit_cast(float, __builtin_amdgcn_readlane(__builtin_bit_cast(int, v), 31)) + __builtin_bit_cast(float, __builtin_amdgcn_readlane(__builtin_bit_cast(int, v), 63)); }
constexpr size_t WS_BAR = 32768;
#define XB_TMO      128
#define XB_XCNT(j)  (256  + 64 * (j))
#define XB_XSUB(j)  (1280 + 64 * (j))
#define XB_XGEN(j)  (2304 + 64 * (j))
#define XB_TOP      3328
#define XB_TOPGEN   3392
#define XB_SPIN_CAP (1u << 20)
__device__ __forceinline__ unsigned xb_ld(unsigned* p)              { return __hip_atomic_load(p, __ATOMIC_RELAXED, __HIP_MEMORY_SCOPE_AGENT); }
__device__ __forceinline__ unsigned xb_add(unsigned* p, unsigned v) { return __hip_atomic_fetch_add(p, v, __ATOMIC_RELAXED, __HIP_MEMORY_SCOPE_AGENT); }
__device__ __forceinline__ unsigned xb_xcc_id() { return (unsigned)__builtin_amdgcn_s_getreg((3 << 11) | 20) & 0xFu; }
#define XB_SPIN(cond, bar) do { unsigned _sp = 0; while (cond) { __builtin_amdgcn_s_sleep(1); \
    if ((++_sp & 255u) == 0u) { if (xb_ld(&(bar)[XB_TMO])) break; if (_sp > XB_SPIN_CAP) { atomicAdd(&(bar)[XB_TMO], 1u); break; } } } } while (0)
__device__ __forceinline__ void xcd_barrier_post(unsigned* bar) { if (threadIdx.x == 0) (void)xb_add(&bar[XB_XCNT(xb_xcc_id())], 1u); }
__device__ __forceinline__ void xcd_barrier_complete(unsigned* bar, unsigned x, unsigned& nloc, unsigned& nx) {
    const unsigned G = gridDim.x * gridDim.y * gridDim.z;
    unsigned sum, cnt, mine, sp = 0u;
    for (;;) {
        sum = 0u; cnt = 0u; mine = 0u;
#pragma unroll
        for (unsigned j = 0; j < 16; ++j) { const unsigned c = xb_ld(&bar[XB_XCNT(j)]); sum += c; cnt += (c > 0u) ? 1u : 0u; mine = (j == x) ? c : mine; }
        if (sum == G) break;
        __builtin_amdgcn_s_sleep(1);
        if ((++sp & 255u) == 0u) { if (xb_ld(&bar[XB_TMO])) break; if (sp > XB_SPIN_CAP) { atomicAdd(&bar[XB_TMO], 1u); break; } }
    }
    nloc = mine > 0u ? mine : 1u; nx = cnt > 0u ? cnt : 1u;
}
__device__ __forceinline__ void xcd_barrier(unsigned* bar, volatile LAS unsigned* st) {
    asm volatile("s_waitcnt vmcnt(0)" ::: "memory");
    __syncthreads();
    if (threadIdx.x == 0) {
        const unsigned x = xb_xcc_id();
        __builtin_amdgcn_s_waitcnt(0);
        unsigned nloc = st[0], nx = st[1];
        if (nloc == 0u) { xcd_barrier_complete(bar, x, nloc, nx); st[0] = nloc; st[1] = nx; }
        const unsigned old = xb_add(&bar[XB_XSUB(x)], 1u);
        const unsigned gen = old / nloc;
        if (old + 1u == (gen + 1u) * nloc) {
            __builtin_amdgcn_fence(__ATOMIC_RELEASE, "agent");
            asm volatile("s_waitcnt vmcnt(0)" ::: "memory");
            const unsigned og = xb_add(&bar[XB_TOP], 1u);
            const unsigned tg = og / nx;
            if (og + 1u == (tg + 1u) * nx) xb_add(&bar[XB_TOPGEN], 1u);
            else XB_SPIN(xb_ld(&bar[XB_TOPGEN]) == tg, bar);
            __builtin_amdgcn_fence(__ATOMIC_ACQUIRE, "agent");
            xb_add(&bar[XB_XGEN(x)], 1u);
            asm volatile("s_waitcnt vmcnt(0)" ::: "memory");
        } else {
            XB_SPIN(xb_ld(&bar[XB_XGEN(x)]) == gen, bar);
            __builtin_amdgcn_fence(__ATOMIC_ACQUIRE, "agent");
            asm volatile("s_waitcnt vmcnt(0)" ::: "memory");
        }
    }
    __syncthreads();
}

__device__ __forceinline__ void transpose_item(const float* W, int N, int k0, int n0, bf16* WT, int ldw, int drow0, int koff, LAS float* scr, int lane) {
#pragma unroll 8
    for (int i = 0; i < 32; ++i) { const int kk = 2 * i + (lane >> 5); scr[kk * 33 + (lane & 31)] = W[(size_t)(k0 + kk) * N + n0 + (lane & 31)]; }
    asm volatile("s_waitcnt lgkmcnt(0)" ::: "memory");
    const int c = lane & 7;
#pragma unroll
    for (int j = 0; j < 4; ++j) { const int n = (lane >> 3) + 8 * j; const LAS float* s = scr + (8 * c) * 33 + n;
        v4u o; o.x = pk2(s[0 * 33], s[1 * 33]); o.y = pk2(s[2 * 33], s[3 * 33]); o.z = pk2(s[4 * 33], s[5 * 33]); o.w = pk2(s[6 * 33], s[7 * 33]);
        *(v4u*)(WT + (size_t)(drow0 + n) * ldw + koff + k0 + 8 * c) = o; }
    asm volatile("s_waitcnt lgkmcnt(0)" ::: "memory");
}

__device__ __forceinline__ void pro_side(Frame& F, int part, int gw, int ngw, int lt, int nlt) {
    LAS float* scr = (LAS float*)(F.lds + F.wave * 16384);
    bf16* WinT = (bf16*)(F.ws + WS_WIN); bf16* PabT = (bf16*)(F.ws + WS_PAB); bf16* WoutT = (bf16*)(F.ws + WS_WOUT); bf16* WpgT = (bf16*)(F.ws + WS_WPG); bf16* WpuT = (bf16*)(F.ws + WS_WPU);
    if (part == 0) {
        constexpr int I_IN = 16 * (INC / 32), I_PA = 8 * 32, I_PB = 8 * 32, I_WO = 16 * 32, I_PG = 16 * 32, I_PU = 4 * 32, I_UP = 16;
        constexpr int NIT = I_IN + I_PA + I_PB + I_WO + I_PG + I_PU + 2 * I_UP;
        for (int it = gw; it < NIT; it += ngw) {
            int r = it;
            if (r < I_IN) { const int nb = r % (INC / 32), kb = r / (INC / 32), n0 = nb * 32;
                const int d0 = n0 < 4096 ? n0 : (n0 < 4224 ? n0 + 2048 : n0 - 128);
                transpose_item(F.w_in, INC, kb * 64, n0, WinT, DM, d0, 0, scr, F.lane); continue; } r -= I_IN;
            if (r < I_PA) { transpose_item(F.p_a, DM, (r / 32) * 64, (r % 32) * 32, PabT, 1024, (r % 32) * 32, 0, scr, F.lane); continue; } r -= I_PA;
            if (r < I_PB) { transpose_item(F.p_b, DM, (r / 32) * 64, (r % 32) * 32, PabT, 1024, (r % 32) * 32, 512, scr, F.lane); continue; } r -= I_PB;
            if (r < I_WO) { transpose_item(F.w_out, DM, (r / 32) * 64, (r % 32) * 32, WoutT, 1024, (r % 32) * 32, 0, scr, F.lane); continue; } r -= I_WO;
            if (r < I_PG) { transpose_item(F.w_pg, DM, (r / 32) * 64, (r % 32) * 32, WpgT, 1024, (r % 32) * 32, 0, scr, F.lane); continue; } r -= I_PG;
            if (r < I_PU) { transpose_item(F.w_pu, DM, (r / 32) * 64, (r % 32) * 32, WpuT, 256, (r % 32) * 32, 0, scr, F.lane); continue; } r -= I_PU;
            if (r < I_UP) { transpose_item(F.w_up, AW, 0, r * 32, (bf16*)(F.ws + WS_WUPT), 64, r * 32, 0, scr, F.lane); continue; } r -= I_UP;
            transpose_item(F.a_up, AW, 0, r * 32, (bf16*)(F.ws + WS_AUPT), 64, r * 32, 0, scr, F.lane);
        }
        for (int i = gw * 64 + F.lane; i < 128 * 1024 / 8; i += ngw * 64) *(v4u*)(WinT + (size_t)INC * DM + (size_t)i * 8) = (v4u){0u, 0u, 0u, 0u};
    } else {
        bf16* PB = (bf16*)(F.ws + WS_PB); const size_t n8 = (size_t)M * PLE / 8;
        for (size_t i = (size_t)lt; i < n8; i += (size_t)nlt) { const f32x4 a = *(const f32x4*)(F.p + i * 8), b = *(const f32x4*)(F.p + i * 8 + 4);
            v4u o; o.x = pk2(a[0], a[1]); o.y = pk2(a[2], a[3]); o.z = pk2(b[0], b[1]); o.w = pk2(b[2], b[3]); *(v4u*)(PB + i * 8) = o; }
    }
}
__device__ __forceinline__ void p0_prologue(Frame& F) {
    LAS float* red = (LAS float*)F.lds;
    LAS float* ubar = (LAS float*)(F.lds + 32768);
    LAS float* kmean = (LAS float*)(F.lds + 36864);
    bf16* U2 = (bf16*)F.out; bf16* WgT = (bf16*)(F.ws + WS_WG);
    const bool helper = F.wave >= 4; const int sgw = F.vcu * 4 + (F.wave - 4), sngw = F.G * 4, slt = F.vcu * 256 + (F.tid - 256), snlt = F.G * 256;
    bool side_done = false;
    if (F.vcu >= M / BLK) { if (helper) { pro_side(F, 0, sgw, sngw, slt, snlt); pro_side(F, 1, sgw, sngw, slt, snlt); } side_done = true; }
    for (int blk = F.vcu; blk < M / BLK; blk += F.G) {
        float cs[16];
#pragma unroll
        for (int i = 0; i < 16; ++i) cs[i] = 0.f;
        f32x4 gv[4];
#pragma unroll
        for (int j = 0; j < 4; ++j) gv[j] = *((const f32x4*)F.g_pre + F.lane + 64 * j);
        for (int i = 0; i < 8; ++i) {
            f32x4 v[4][4];
#pragma unroll
            for (int r = 0; r < 4; ++r) { const f32x4* xr = (const f32x4*)(F.x + ((size_t)blk * BLK + F.wave + 8 * (4 * i + r)) * DM) + F.lane;
#pragma unroll
                for (int j = 0; j < 4; ++j) v[r][j] = xr[64 * j]; }
#pragma unroll
            for (int r = 0; r < 4; ++r) { const size_t row = (size_t)blk * BLK + F.wave + 8 * (4 * i + r); float s = 0.f;
#pragma unroll
                for (int j = 0; j < 4; ++j) s += (v[r][j][0] * v[r][j][0] + v[r][j][1] * v[r][j][1]) + (v[r][j][2] * v[r][j][2] + v[r][j][3] * v[r][j][3]);
                const float rs = frsq(wave_sum_fast(s) * (1.f / DM) + RMS_EPS);
#pragma unroll
                for (int j = 0; j < 4; ++j) {
                    float u[4]; unsigned h[4], l[4];
#pragma unroll
                    for (int e = 0; e < 4; ++e) { u[e] = v[r][j][e] * rs * gv[j][e]; cs[j * 4 + e] += u[e]; h[e] = f2bf(u[e]); l[e] = f2bf(u[e] - __uint_as_float(h[e] << 16)); }
                    const int col = 4 * F.lane + 256 * j;
                    *(v2u*)(U2 + row * 2048 + col) = (v2u){h[0] | (h[1] << 16), h[2] | (h[3] << 16)};
                    *(v2u*)(U2 + row * 2048 + 1024 + col) = (v2u){l[0] | (l[1] << 16), l[2] | (l[3] << 16)};
                } }
        }
#pragma unroll
        for (int j = 0; j < 4; ++j)
#pragma unroll
            for (int e = 0; e < 4; ++e) red[F.wave * 1024 + 4 * F.lane + 256 * j + e] = cs[j * 4 + e];
        __syncthreads();
        for (int k = F.tid; k < 1024; k += NTHR) { float s = 0.f;
#pragma unroll
            for (int w = 0; w < 8; ++w) s += red[w * 1024 + k];
            ubar[k] = s * (1.f / BLK); }
        __syncthreads();
        float acc[8];
#pragma unroll
        for (int e = 0; e < 8; ++e) acc[e] = 0.f;
        if (!helper) {
            const float* wk = F.w_in + 512 + F.lane * 8;
#pragma unroll 1
            for (int k0 = F.wave * 256; k0 < F.wave * 256 + 256; k0 += 16) { f32x4 w[16][2];
#pragma unroll
                for (int i = 0; i < 16; ++i) { const f32x4* p = (const f32x4*)(wk + (size_t)(k0 + i) * INC); w[i][0] = p[0]; w[i][1] = p[1]; }
#pragma unroll
                for (int i = 0; i < 16; ++i) { const float ub = ubar[k0 + i];
#pragma unroll
                    for (int e = 0; e < 4; ++e) { acc[e] += ub * w[i][0][e]; acc[4 + e] += ub * w[i][1][e]; } } }
        } else if (!side_done) pro_side(F, 0, sgw, sngw, slt, snlt);
        __syncthreads();
        if (!helper) {
#pragma unroll
            for (int e = 0; e < 8; ++e) red[F.wave * 512 + F.lane * 8 + e] = acc[e]; }
        __syncthreads();
        kmean[F.tid] = (red[F.tid] + red[512 + F.tid]) + (red[1024 + F.tid] + red[1536 + F.tid]);
        __syncthreads();
        if (!helper) {
            const int b = blk / NBLK, n = blk % NBLK; const int l8 = F.lane * 8;
            float km[8];
#pragma unroll
            for (int e = 0; e < 8; ++e) km[e] = kmean[l8 + e];
#pragma unroll 1
            for (int k0 = F.wave * 8; k0 < 1024; k0 += 4 * 8) { f32x4 w[8][2];
#pragma unroll
                for (int r = 0; r < 8; ++r) { const f32x4* wq = (const f32x4*)(F.w_in + (size_t)(k0 + r) * INC + l8); w[r][0] = wq[0]; w[r][1] = wq[1]; }
#pragma unroll
                for (int r = 0; r < 8; ++r) { float s = (w[r][0][0] * km[0] + w[r][0][1] * km[1]) + (w[r][0][2] * km[2] + w[r][0][3] * km[3]) + (w[r][1][0] * km[4] + w[r][1][1] * km[5]) + (w[r][1][2] * km[6] + w[r][1][3] * km[7]);
                    s += __builtin_bit_cast(float, __builtin_amdgcn_update_dpp(0, __builtin_bit_cast(int, s), 0x111, 0xf, 0xf, true));
                    s += __builtin_bit_cast(float, __builtin_amdgcn_update_dpp(0, __builtin_bit_cast(int, s), 0x112, 0xf, 0xf, true));
                    s += __builtin_bit_cast(float, __builtin_amdgcn_update_dpp(0, __builtin_bit_cast(int, s), 0x114, 0xf, 0xf, true));
                    if ((F.lane & 7) == 7) { const int h = F.lane >> 3, k = k0 + r; const unsigned hi = f2bf(s), lo = f2bf(s - __uint_as_float(hi << 16));
                        bf16* r0 = WgT + ((size_t)b * 256 + h * 16 + n) * 2048; bf16* r1 = WgT + ((size_t)b * 256 + 128 + h * 16 + n) * 2048;
                        r0[k] = (bf16)hi; r0[1024 + k] = (bf16)hi; r1[k] = (bf16)lo; r1[1024 + k] = (bf16)lo; } } }
        } else if (!side_done) pro_side(F, 1, sgw, sngw, slt, snlt);
        side_done = true;
        __syncthreads();
    }
}

__device__ __forceinline__ void panel_norm(Frame& F, int pm, const bf16* Y, bf16* H1, float* RSY, const LAS float* part) {
    f32x4 gv[4];
#pragma unroll
    for (int j = 0; j < 4; ++j) gv[j] = *((const f32x4*)F.g_post + F.lane + 64 * j);
    for (int i = 0; i < 8; ++i) {
        v2u yw[4][4]; f32x4 xv[4][4]; float rs[4];
#pragma unroll
        for (int r = 0; r < 4; ++r) { const int rl = F.wave * 32 + 4 * i + r; const size_t row = (size_t)pm * 256 + rl;
            const v2u* yr = (const v2u*)(Y + row * DM) + F.lane; const f32x4* xr = (const f32x4*)(F.x + row * DM) + F.lane;
#pragma unroll
            for (int j = 0; j < 4; ++j) { yw[r][j] = yr[64 * j]; xv[r][j] = xr[64 * j]; }
            const LAS f32x4* pp = (const LAS f32x4*)(part + rl * 16); const f32x4 a = pp[0], b = pp[1], c = pp[2], d = pp[3];
            rs[r] = frsq((((a[0] + a[1]) + (a[2] + a[3])) + ((b[0] + b[1]) + (b[2] + b[3])) + ((c[0] + c[1]) + (c[2] + c[3])) + ((d[0] + d[1]) + (d[2] + d[3]))) * (1.f / DM) + RMS_EPS);
            if (F.lane == 0) RSY[row] = rs[r]; }
#pragma unroll
        for (int r = 0; r < 4; ++r) { const size_t row = (size_t)pm * 256 + F.wave * 32 + 4 * i + r;
#pragma unroll
            for (int j = 0; j < 4; ++j) { const v2u w = yw[r][j]; const float yv[4] = {__uint_as_float(w.x << 16), __uint_as_float(w.x & 0xffff0000u), __uint_as_float(w.y << 16), __uint_as_float(w.y & 0xffff0000u)}; float h[4];
#pragma unroll
                for (int e = 0; e < 4; ++e) h[e] = xv[r][j][e] + yv[e] * rs[r] * gv[j][e];
                *(v2u*)(H1 + row * DM + 4 * F.lane + 256 * j) = (v2u){pk2(h[0], h[1]), pk2(h[2], h[3])}; } }
    }
}

__device__ __forceinline__ void post_norm(Frame& F) {
    const bf16* Y = (const bf16*)(F.ws + WS_RW); float* RSY = (float*)(F.ws + WS_RSY); bf16* H1 = (bf16*)(F.ws + WS_QKVZ);
    const int gw = F.vcu * NWAVES + F.wave, NGW = F.G * NWAVES;
    f32x4 gv[4];
#pragma unroll
    for (int j = 0; j < 4; ++j) gv[j] = *((const f32x4*)F.g_post + F.lane + 64 * j);
    for (int row0 = gw * 4; row0 < M; row0 += NGW * 4) {
        v2u yw[4][4]; f32x4 xv[4][4];
#pragma unroll
        for (int r = 0; r < 4; ++r) { const v2u* yr = (const v2u*)(Y + (size_t)(row0 + r) * DM) + F.lane; const f32x4* xr = (const f32x4*)(F.x + (size_t)(row0 + r) * DM) + F.lane;
#pragma unroll
            for (int j = 0; j < 4; ++j) { yw[r][j] = yr[64 * j]; xv[r][j] = xr[64 * j]; } }
#pragma unroll
        for (int r = 0; r < 4; ++r) { f32x4 v[4]; float s = 0.f;
#pragma unroll
            for (int j = 0; j < 4; ++j) { const v2u w = yw[r][j]; v[j] = (f32x4){__uint_as_float(w.x << 16), __uint_as_float(w.x & 0xffff0000u), __uint_as_float(w.y << 16), __uint_as_float(w.y & 0xffff0000u)}; s += (v[j][0] * v[j][0] + v[j][1] * v[j][1]) + (v[j][2] * v[j][2] + v[j][3] * v[j][3]); }
            const float rs = frsq(wave_sum_fast(s) * (1.f / DM) + RMS_EPS);
            if (F.lane == 0) RSY[row0 + r] = rs;
#pragma unroll
            for (int j = 0; j < 4; ++j) { float h[4];
#pragma unroll
                for (int e = 0; e < 4; ++e) h[e] = xv[r][j][e] + v[j][e] * rs * gv[j][e];
                *(v2u*)(H1 + (size_t)(row0 + r) * DM + 4 * F.lane + 256 * j) = (v2u){pk2(h[0], h[1]), pk2(h[2], h[3])}; } }
    }
}
namespace moba {
using bf16x8 = __attribute__((ext_vector_type(8))) short;
using s16x4 = __attribute__((ext_vector_type(4))) short;
using f32x16 = __attribute__((ext_vector_type(16))) float;
using u32x4 = __attribute__((ext_vector_type(4))) unsigned;
typedef short v4i16_t __attribute__((ext_vector_type(4)));
typedef float f32x2_t __attribute__((ext_vector_type(2))); typedef __bf16 bf16x2_t __attribute__((ext_vector_type(2)));
__device__ __forceinline__ int crow(int r, int hi) { return (r & 3) + 8 * (r >> 2) + 4 * hi; }
__device__ __forceinline__ unsigned cvtpk(float lo, float hi) { f32x2_t v = {lo, hi}; bf16x2_t b = __builtin_convertvector(v, bf16x2_t); return __builtin_bit_cast(unsigned, b); }
__device__ __forceinline__ float max3f(float a, float b, float c) { return fmaxf(fmaxf(a, b), c); }

constexpr int SLOTB = 8192;
__device__ __forceinline__ void qkt(f32x16& p0, f32x16& p1, const LAS unsigned char* Kslot, const bf16x8* qr, int r32, int hi) {
    const LAS unsigned char* kb = Kslot + hi * 1024 + r32 * 16;
    const f32x16 z = {};
#pragma unroll
    for (int d0 = 0; d0 < 4; ++d0) {
        const bf16x8 b0 = *(const LAS bf16x8*)(kb + d0 * 2048);
        const bf16x8 b1 = *(const LAS bf16x8*)(kb + d0 * 2048 + 512);
        if (d0 == 0) { p0 = __builtin_amdgcn_mfma_f32_32x32x16_bf16(b0, qr[0], z, 0, 0, 0); p1 = __builtin_amdgcn_mfma_f32_32x32x16_bf16(b1, qr[0], z, 0, 0, 0); }
        else { p0 = __builtin_amdgcn_mfma_f32_32x32x16_bf16(b0, qr[d0], p0, 0, 0, 0); p1 = __builtin_amdgcn_mfma_f32_32x32x16_bf16(b1, qr[d0], p1, 0, 0, 0); } }
}
__device__ __forceinline__ void qkt_acc(f32x16& p0, f32x16& p1, const LAS unsigned char* Kslot, const bf16x8* qr, int r32, int hi) {
    const LAS unsigned char* kb = Kslot + hi * 1024 + r32 * 16;
#pragma unroll
    for (int d0 = 0; d0 < 4; ++d0) {
        const bf16x8 b0 = *(const LAS bf16x8*)(kb + d0 * 2048);
        const bf16x8 b1 = *(const LAS bf16x8*)(kb + d0 * 2048 + 512);
        p0 = __builtin_amdgcn_mfma_f32_32x32x16_bf16(b0, qr[d0], p0, 0, 0, 0); p1 = __builtin_amdgcn_mfma_f32_32x32x16_bf16(b1, qr[d0], p1, 0, 0, 0); }
}
__device__ __forceinline__ void pv(f32x16* o, int vb, bf16x8 pa0, bf16x8 pa1, bf16x8 pa2, bf16x8 pa3) {
#pragma unroll
    for (int d0 = 0; d0 < 2; ++d0) { s16x4 lo[4], hi[4];
#pragma unroll
        for (int ks = 0; ks < 4; ++ks) {
            asm volatile("ds_read_b64_tr_b16 %0,%1 offset:%c2" : "=&v"(lo[ks]) : "v"(vb), "i"(d0 * 4096 + ks * 1024) : "memory");
            asm volatile("ds_read_b64_tr_b16 %0,%1 offset:%c2" : "=&v"(hi[ks]) : "v"(vb), "i"(d0 * 4096 + ks * 1024 + 512) : "memory"); }
        asm volatile("s_waitcnt lgkmcnt(0)" ::: "memory"); __builtin_amdgcn_sched_barrier(0);
#define PK(k) (bf16x8){lo[k][0], lo[k][1], lo[k][2], lo[k][3], hi[k][0], hi[k][1], hi[k][2], hi[k][3]}
        o[d0] = __builtin_amdgcn_mfma_f32_32x32x16_bf16(pa0, PK(0), o[d0], 0, 0, 0);
        o[d0] = __builtin_amdgcn_mfma_f32_32x32x16_bf16(pa1, PK(1), o[d0], 0, 0, 0);
        o[d0] = __builtin_amdgcn_mfma_f32_32x32x16_bf16(pa2, PK(2), o[d0], 0, 0, 0);
        o[d0] = __builtin_amdgcn_mfma_f32_32x32x16_bf16(pa3, PK(3), o[d0], 0, 0, 0);
#undef PK
    }
}
__device__ __forceinline__ float rowmax2(const f32x16& p0, const f32x16& p1, float a) {
#pragma unroll
    for (int r = 0; r < 16; r += 2) { a = max3f(a, p0[r], p0[r + 1]); a = max3f(a, p1[r], p1[r + 1]); }
    return a;
}
__device__ __forceinline__ float swapmax(float m) { auto rr = __builtin_amdgcn_permlane32_swap(__float_as_uint(m), __float_as_uint(m), false, false); return fmaxf(__uint_as_float(rr[0]), __uint_as_float(rr[1])); }
__device__ __forceinline__ float swapsum(float m) { auto rr = __builtin_amdgcn_permlane32_swap(__float_as_uint(m), __float_as_uint(m), false, false); return __uint_as_float(rr[0]) + __uint_as_float(rr[1]); }

__device__ __forceinline__ void load_kv_block(LAS unsigned char* lds, int KOFF, int VOFF, const bf16* QKVZ, size_t krow0, int h, int wid, int lane) {
    const bf16* ksrc = QKVZ + (krow0 + lane) * QP + 512 + h * HD + wid * 8;
    const bf16* vsrc = QKVZ + (krow0 + 16 * (wid & 3) + (lane >> 2)) * QP + 1024 + h * HD + (wid >> 2) * 32 + (lane & 3) * 8;
#pragma unroll
    for (int t = 0; t < 4; ++t) {
        __builtin_amdgcn_global_load_lds((const unsigned*)(ksrc + (size_t)t * 64 * QP), (LAS unsigned*)(lds + KOFF + t * SLOTB + wid * 1024), 16, 0, 0);
        __builtin_amdgcn_global_load_lds((const unsigned*)(vsrc + (size_t)t * 64 * QP), (LAS unsigned*)(lds + VOFF + t * SLOTB + wid * 1024), 16, 0, 0); }
}
}

constexpr int LIST_CAP = 3840;

__device__ __forceinline__ void attn_select(Frame& F, const float* GATE, unsigned* CNT, unsigned short* LISTS) {
    const int gw = F.vcu * NWAVES + F.wave, NGW = F.G * NWAVES;
    for (int it = gw; it < BATCH * NH * (SEQ / 64); it += NGW) {
        const int sg = it % (SEQ / 64), h = (it / (SEQ / 64)) % NH, b = it / (SEQ / 64 * NH);
        const int s = sg * 64 + F.lane, qb = s >> 8; const size_t row = (size_t)b * SEQ + s;
        if (qb == 0) continue;
        float g0 = -INFINITY, g1 = -INFINITY, g2 = -INFINITY; int i0 = -1, i1 = -1, i2 = -1;
        const f32x4* gp = (const f32x4*)(GATE + row * 256 + h * 16); const f32x4* gl = (const f32x4*)(GATE + row * 256 + 128 + h * 16);
#pragma unroll
        for (int c = 0; c < 4; ++c) { const f32x4 a = gp[c], l = gl[c];
#pragma unroll
            for (int e = 0; e < 4; ++e) { const int n = c * 4 + e; const float g = (n < qb) ? a[e] + l[e] : -INFINITY;
                if (g > g0) { g2 = g1; i2 = i1; g1 = g0; i1 = i0; g0 = g; i0 = n; } else if (g > g1) { g2 = g1; i2 = i1; g1 = g; i1 = n; } else if (g > g2) { g2 = g; i2 = n; } } }
        unsigned* cnt = CNT + (b * NH + h) * 16; unsigned short* lst = LISTS + (size_t)(b * NH + h) * 16 * LIST_CAP;
        int r0 = 0, r1 = 0, r2 = 0; unsigned mycnt = 0u;
        for (int n = 0; n < qb; ++n) {
            const bool pick = (i0 == n) | (i1 == n) | (i2 == n);
            const unsigned long long mask = __ballot(pick);
            const int before = __builtin_amdgcn_mbcnt_hi((unsigned)(mask >> 32), __builtin_amdgcn_mbcnt_lo((unsigned)mask, 0u));
            if (i0 == n) r0 = before; if (i1 == n) r1 = before; if (i2 == n) r2 = before;
            if (F.lane == n) mycnt = (unsigned)__popcll(mask);
        }
        unsigned base = 0u;
        if (F.lane < qb && mycnt) base = atomicAdd(cnt + F.lane, mycnt);
        const unsigned b0 = __shfl(base, i0 < 0 ? 0 : i0), b1 = __shfl(base, i1 < 0 ? 0 : i1), b2 = __shfl(base, i2 < 0 ? 0 : i2);
        if (i0 >= 0) lst[(size_t)i0 * LIST_CAP + b0 + r0] = (unsigned short)(s | (0 << 12));
        if (i1 >= 0) lst[(size_t)i1 * LIST_CAP + b1 + r1] = (unsigned short)(s | (1 << 12));
        if (i2 >= 0) lst[(size_t)i2 * LIST_CAP + b2 + r2] = (unsigned short)(s | (2 << 12));
    }
}

__device__ __forceinline__ void attn_partial(Frame& F, const bf16* QKVZ, const unsigned* CNT, const unsigned short* LISTS, bf16* PART_O, float* PART_ML, unsigned* QCTR) {
    using namespace moba;
    LAS unsigned char* lds = F.lds; const int wid = F.wave, lane = F.lane, r32 = lane & 31, hi = lane >> 5;
    LAS float* btab = (LAS float*)(lds + 114688); LAS unsigned* uword = (LAS unsigned*)(lds + 106496); LAS unsigned short* llist = (LAS unsigned short*)(lds + 106624);
    LAS float* wsf = (LAS float*)(lds + 98304) + wid * 128; LAS bf16* stg = (LAS bf16*)(lds + 65536) + wid * 2048;
    for (int i = F.tid; i < NH * 512; i += NTHR) { const int h = i >> 9, d = i & 511; btab[i] = d < 113 ? (F.rel_bias[T5B[d] * NH + h] - F.rel_bias[31 * NH + h]) * LOG2E : 0.f; }
    const int vb0 = (int)(uintptr_t)(lds + 32768) + ((lane >> 4) & 1) * 32 + (lane & 3) * 8 + (4 * hi + ((lane & 15) >> 2)) * 64;
    const int NUNIT = BATCH * NH * 15;
    if (F.tid == 0) { const unsigned u0 = atomicAdd(QCTR, 1u); uword[0] = u0; uword[1] = (u0 < (unsigned)NUNIT) ? CNT[(u0 % (BATCH * NH)) * 16 + u0 / (BATCH * NH)] : 0u; }
    for (;;) {
        __syncthreads();
        const int u = (int)uword[0]; const int cnt = (int)uword[1];
        if (u >= NUNIT) break;
        const int n = u / (BATCH * NH), bh = u % (BATCH * NH), b = bh / NH, h = bh % NH;
        load_kv_block(lds, 0, 32768, QKVZ, (size_t)b * SEQ + n * BLK, h, wid, lane);
        const unsigned short* lst = LISTS + ((size_t)bh * 16 + n) * LIST_CAP;
        for (int i = F.tid; i < (cnt + 1) / 2; i += NTHR) ((LAS unsigned*)llist)[i] = ((const unsigned*)lst)[i];
        unsigned nu = 0u, nc = 0u;
        if (F.tid == 0) { nu = atomicAdd(QCTR, 1u); nc = (nu < (unsigned)NUNIT) ? CNT[(nu % (BATCH * NH)) * 16 + nu / (BATCH * NH)] : 0u; }
        const float b31 = F.rel_bias[31 * NH + h] * LOG2E;
        __syncthreads();
        const int ntile = (cnt + 31) >> 5;
        bf16x8 qn[4]; int tile = wid;
        if (tile < ntile) { const int idx = tile * 32 + r32; const unsigned e = llist[idx < cnt ? idx : 0]; const size_t row = (size_t)b * SEQ + (e & 4095);
#pragma unroll
            for (int d0 = 0; d0 < 4; ++d0) qn[d0] = *(const bf16x8*)(QKVZ + row * QP + h * HD + d0 * 16 + hi * 8); }
        for (; tile < ntile; tile += NWAVES) {
            int lane_ = F.tid; asm volatile("" : "+v"(lane_)); lane_ &= 63;
            const int lane = lane_, r32 = lane & 31, hi = lane >> 5;
            const int vb0 = (int)(uintptr_t)(lds + 32768) + ((lane >> 4) & 1) * 32 + (lane & 3) * 8 + (4 * hi + ((lane & 15) >> 2)) * 64;
            const int idx = tile * 32 + r32; const bool valid = idx < cnt;
            const unsigned e = llist[valid ? idx : 0]; const int s = e & 4095, slot = e >> 12; const size_t row = (size_t)b * SEQ + s;
            bf16x8 qr[4];
#pragma unroll
            for (int d0 = 0; d0 < 4; ++d0) qr[d0] = qn[d0];
            if (tile + NWAVES < ntile) { const int idx2 = (tile + NWAVES) * 32 + r32; const unsigned e2 = llist[idx2 < cnt ? idx2 : 0]; const size_t row2 = (size_t)b * SEQ + (e2 & 4095);
#pragma unroll
                for (int d0 = 0; d0 < 4; ++d0) qn[d0] = *(const bf16x8*)(QKVZ + row2 * QP + h * HD + d0 * 16 + hi * 8); }
            f32x16 o[2]; o[0] = f32x16{}; o[1] = f32x16{};
            float mx = -INFINITY, l = 0.f;
            const bool near = ((s >> 8) == n + 1);
            const int dbase = near ? (s - (n * BLK + 128)) : 400;
            const LAS float* bq = btab + h * 512 + dbase - 127;
#pragma unroll
            for (int half = 0; half < 2; ++half) {
                if (half) __builtin_amdgcn_sched_barrier(0);
                f32x16 p[2][2];
                if (half == 1) {
#pragma unroll
                    for (int t = 0; t < 2; ++t)
#pragma unroll
                        for (int r = 0; r < 16; ++r) { const int kvc = t * 64 + (r & 3) + 8 * (r >> 2);
                            p[t][0][r] = (bq - 4 * hi)[127 - kvc]; p[t][1][r] = (bq - 4 * hi)[127 - kvc - 32]; }
                } else { p[0][0] = f32x16{}; p[0][1] = f32x16{}; p[1][0] = f32x16{}; p[1][1] = f32x16{}; }
#pragma unroll
                for (int t = 0; t < 2; ++t) qkt_acc(p[t][0], p[t][1], lds + (2 * half + t) * SLOTB, qr, r32, hi);
                float m2 = rowmax2(p[0][0], p[0][1], mx); m2 = rowmax2(p[1][0], p[1][1], m2); m2 = swapmax(m2);
                const float f = fexp2(mx - m2); l *= f; mx = m2;
                if (half == 1) {
                    if (hi == 0) wsf[64 + r32] = f;
                    asm volatile("s_waitcnt lgkmcnt(0)" ::: "memory");
#pragma unroll
                    for (int r = 0; r < 16; ++r) { const float fr_ = wsf[64 + crow(r, hi)]; o[0][r] *= fr_; o[1][r] *= fr_; } }
#pragma unroll
                for (int t = 0; t < 2; ++t) {
#pragma unroll
                    for (int r = 0; r < 16; ++r) { p[t][0][r] = fexp2(p[t][0][r] - mx); p[t][1][r] = fexp2(p[t][1][r] - mx); l += p[t][0][r] + p[t][1][r]; }
                    u32x4 w0, w1, w2, w3;
                    w0 = (u32x4){cvtpk(p[t][0][0], p[t][0][1]), cvtpk(p[t][0][2], p[t][0][3]), cvtpk(p[t][0][4], p[t][0][5]), cvtpk(p[t][0][6], p[t][0][7])};
                    w1 = (u32x4){cvtpk(p[t][0][8], p[t][0][9]), cvtpk(p[t][0][10], p[t][0][11]), cvtpk(p[t][0][12], p[t][0][13]), cvtpk(p[t][0][14], p[t][0][15])};
                    w2 = (u32x4){cvtpk(p[t][1][0], p[t][1][1]), cvtpk(p[t][1][2], p[t][1][3]), cvtpk(p[t][1][4], p[t][1][5]), cvtpk(p[t][1][6], p[t][1][7])};
                    w3 = (u32x4){cvtpk(p[t][1][8], p[t][1][9]), cvtpk(p[t][1][10], p[t][1][11]), cvtpk(p[t][1][12], p[t][1][13]), cvtpk(p[t][1][14], p[t][1][15])};
                    pv(o, vb0 + (2 * half + t) * SLOTB, __builtin_bit_cast(bf16x8, w0), __builtin_bit_cast(bf16x8, w1), __builtin_bit_cast(bf16x8, w2), __builtin_bit_cast(bf16x8, w3)); }
            }
            __builtin_amdgcn_sched_barrier(0);
            l = swapsum(l);
            if (hi == 0) { wsf[r32] = frcp(l); ((LAS int*)wsf)[32 + r32] = valid ? (int)(((row * NH + h) * 3 + slot)) : -1;
                           if (valid) { float2 ml; ml.x = mx + b31; ml.y = l; *(float2*)(PART_ML + ((row * NH + h) * 3 + slot) * 2) = ml; } }
            asm volatile("s_waitcnt lgkmcnt(0)" ::: "memory");
#pragma unroll
            for (int r = 0; r < 16; ++r) { const int orow = crow(r, hi); const float il = wsf[orow];
#pragma unroll
                for (int d0 = 0; d0 < 2; ++d0) stg[orow * 64 + d0 * 32 + r32] = (bf16)f2bf(o[d0][r] * il); }
            asm volatile("s_waitcnt lgkmcnt(0)" ::: "memory");
#pragma unroll
            for (int i = 0; i < 4; ++i) { const int rr = i * 8 + (lane >> 3), ch = lane & 7; const int dst = ((LAS int*)wsf)[32 + rr];
                const u32x4 v = *(const LAS u32x4*)(stg + rr * 64 + ch * 8);
                if (dst >= 0) *(u32x4*)(PART_O + (size_t)dst * 64 + ch * 8) = v; }
            asm volatile("s_waitcnt lgkmcnt(0)" ::: "memory");
        }
        if (F.tid == 0) { uword[0] = nu; uword[1] = nc; }
    }
}

__device__ __forceinline__ void attn_own_combine(Frame& F, bf16* QKVZ, const bf16* PART_O, const float* PART_ML, bf16* OUTB, int out_pitch) {
    using namespace moba;
    LAS unsigned char* lds = F.lds; const int wid = F.wave, lane = F.lane, r32 = lane & 31, hi = lane >> 5;
    LAS float* btab = (LAS float*)(lds + 139264);
    LAS float* wsf = (LAS float*)(lds + 135168) + wid * 128; LAS float* ost = (LAS float*)(lds + 65536 + wid * 8704);
    __syncthreads();
    for (int i = F.tid; i < NH * 256; i += NTHR) { const int h = i >> 8, d = i & 255; btab[i] = F.rel_bias[T5B[d < 127 ? d : 127] * NH + h] * LOG2E; }
    const int vb0 = (int)(uintptr_t)(lds + 32768) + ((lane >> 4) & 1) * 32 + (lane & 3) * 8 + (4 * hi + ((lane & 15) >> 2)) * 64;
    for (int u = F.vcu; u < BATCH * NH * NBLK; u += F.G) {
        const int qb = u % NBLK, bh = u / NBLK, b = bh / NH, h = bh % NH;
        __syncthreads();
        load_kv_block(lds, 0, 32768, QKVZ, (size_t)b * SEQ + qb * BLK, h, wid, lane);
        const int sq = qb * BLK + wid * 32 + r32; const size_t row = (size_t)b * SEQ + sq;
        bf16x8 qr[4];
#pragma unroll
        for (int d0 = 0; d0 < 4; ++d0) qr[d0] = *(const bf16x8*)(QKVZ + row * QP + h * HD + d0 * 16 + hi * 8);
        const int cq = lane >> 1, cc0 = (lane & 1) * 32; const size_t crow2 = (size_t)b * SEQ + qb * BLK + wid * 32 + cq;
        float2 pml[3]; v4u po[3][4], zw[4];
#pragma unroll
        for (int j = 0; j < 3; ++j) { pml[j] = *(const float2*)(PART_ML + ((crow2 * NH + h) * 3 + j) * 2);
#pragma unroll
            for (int c = 0; c < 4; ++c) po[j][c] = *((const v4u*)(PART_O + ((crow2 * NH + h) * 3 + j) * 64 + cc0) + c); }
#pragma unroll
        for (int c = 0; c < 4; ++c) zw[c] = *((const v4u*)(QKVZ + crow2 * QP + 1536 + h * HD + cc0) + c);
        __syncthreads();
        const int nt = (wid >> 1) + 1;
        int ql = wid * 32 + r32;
        asm volatile("" : "+v"(ql));
        const LAS float* bt = btab + h * 256;
        float mx = -INFINITY, l = 0.f;
        f32x16 o[2]; o[0] = f32x16{}; o[1] = f32x16{};
#pragma unroll 1
        for (int t = 0; t < nt; ++t) { f32x16 p0, p1;
            qkt(p0, p1, lds + t * SLOTB, qr, r32, hi);
            if (t < nt - 1) {
#pragma unroll
                for (int r = 0; r < 16; ++r) { const int kv = t * 64 + crow(r, hi); const int d0 = ql - kv, d1 = d0 - 32; p0[r] += bt[d0]; p1[r] += bt[d1]; }
            } else {
#pragma unroll
                for (int r = 0; r < 16; ++r) { const int kv = t * 64 + crow(r, hi); const int d0 = ql - kv, d1 = d0 - 32; const float b0 = bt[d0 < 0 ? 0 : d0], b1 = bt[d1 < 0 ? 0 : d1];
                    p0[r] = d0 >= 0 ? p0[r] + b0 : -INFINITY; p1[r] = d1 >= 0 ? p1[r] + b1 : -INFINITY; } }
            const float m2 = swapmax(rowmax2(p0, p1, mx));
            const float f = fexp2(mx - m2); l *= f; mx = m2;
            if (t > 0) { if (hi == 0) wsf[64 + r32] = f;
                asm volatile("s_waitcnt lgkmcnt(0)" ::: "memory");
#pragma unroll
                for (int r = 0; r < 16; ++r) { const float fr_ = wsf[64 + crow(r, hi)]; o[0][r] *= fr_; o[1][r] *= fr_; } }
#pragma unroll
            for (int r = 0; r < 16; ++r) { p0[r] = fexp2(p0[r] - mx); p1[r] = fexp2(p1[r] - mx); l += p0[r] + p1[r]; }
            u32x4 w0, w1, w2, w3;
            w0 = (u32x4){cvtpk(p0[0], p0[1]), cvtpk(p0[2], p0[3]), cvtpk(p0[4], p0[5]), cvtpk(p0[6], p0[7])};
            w1 = (u32x4){cvtpk(p0[8], p0[9]), cvtpk(p0[10], p0[11]), cvtpk(p0[12], p0[13]), cvtpk(p0[14], p0[15])};
            w2 = (u32x4){cvtpk(p1[0], p1[1]), cvtpk(p1[2], p1[3]), cvtpk(p1[4], p1[5]), cvtpk(p1[6], p1[7])};
            w3 = (u32x4){cvtpk(p1[8], p1[9]), cvtpk(p1[10], p1[11]), cvtpk(p1[12], p1[13]), cvtpk(p1[14], p1[15])};
            pv(o, vb0 + t * SLOTB, __builtin_bit_cast(bf16x8, w0), __builtin_bit_cast(bf16x8, w1), __builtin_bit_cast(bf16x8, w2), __builtin_bit_cast(bf16x8, w3));
        }
        l = swapsum(l);
        if (hi == 0) { wsf[r32] = mx; wsf[32 + r32] = l; }
#pragma unroll
        for (int r = 0; r < 16; ++r) { const int orow = crow(r, hi);
#pragma unroll
            for (int d0 = 0; d0 < 2; ++d0) ost[orow * 68 + d0 * 32 + r32] = o[d0][r]; }
        asm volatile("s_waitcnt lgkmcnt(0)" ::: "memory");
        { const int q = lane >> 1, c0 = (lane & 1) * 32; const int s2 = qb * BLK + wid * 32 + q; const size_t row2 = (size_t)b * SEQ + s2;
          const float m0 = wsf[q], l0 = wsf[32 + q]; const int np = qb < 3 ? qb : 3;
          float mj[3], lj[3]; float mt = m0;
#pragma unroll
          for (int j = 0; j < 3; ++j) { if (j < np) { const float2 ml = pml[j]; mj[j] = ml.x; lj[j] = ml.y; mt = fmaxf(mt, ml.x); } else { mj[j] = -INFINITY; lj[j] = 0.f; } }
          const float w0 = fexp2(m0 - mt); float wj[3]; float den = w0 * l0;
#pragma unroll
          for (int j = 0; j < 3; ++j) { wj[j] = (j < np) ? fexp2(mj[j] - mt) * lj[j] : 0.f; den += wj[j]; }
          const float iden = frcp(den);
          float acc[32];
#pragma unroll
          for (int c = 0; c < 32; c += 4) { const f32x4 v = *(const LAS f32x4*)(ost + q * 68 + c0 + c); acc[c] = v[0] * w0; acc[c + 1] = v[1] * w0; acc[c + 2] = v[2] * w0; acc[c + 3] = v[3] * w0; }
#pragma unroll
          for (int j = 0; j < 3; ++j) if (j < np) {
#pragma unroll
              for (int c = 0; c < 4; ++c) { const v4u w = po[j][c]; const float f = wj[j];
                  acc[c * 8 + 0] += f * __uint_as_float(w.x << 16); acc[c * 8 + 1] += f * __uint_as_float(w.x & 0xffff0000u); acc[c * 8 + 2] += f * __uint_as_float(w.y << 16); acc[c * 8 + 3] += f * __uint_as_float(w.y & 0xffff0000u);
                  acc[c * 8 + 4] += f * __uint_as_float(w.z << 16); acc[c * 8 + 5] += f * __uint_as_float(w.z & 0xffff0000u); acc[c * 8 + 6] += f * __uint_as_float(w.w << 16); acc[c * 8 + 7] += f * __uint_as_float(w.w & 0xffff0000u); } }
          asm volatile("s_waitcnt lgkmcnt(0)" ::: "memory");
#pragma unroll
          for (int c = 0; c < 4; ++c) { const v4u w = zw[c]; const float z[8] = {__uint_as_float(w.x << 16), __uint_as_float(w.x & 0xffff0000u), __uint_as_float(w.y << 16), __uint_as_float(w.y & 0xffff0000u),
                                                                               __uint_as_float(w.z << 16), __uint_as_float(w.z & 0xffff0000u), __uint_as_float(w.w << 16), __uint_as_float(w.w & 0xffff0000u)};
              float rr[8];
#pragma unroll
              for (int e2 = 0; e2 < 8; ++e2) rr[e2] = acc[c * 8 + e2] * iden * z[e2] * sigm(z[e2]);
              v4u ow; ow.x = pk2(rr[0], rr[1]); ow.y = pk2(rr[2], rr[3]); ow.z = pk2(rr[4], rr[5]); ow.w = pk2(rr[6], rr[7]); *(LAS v4u*)((LAS bf16*)ost + q * 72 + c0 + c * 8) = ow; }
          asm volatile("s_waitcnt lgkmcnt(0)" ::: "memory");
#pragma unroll
          for (int i = 0; i < 4; ++i) { const int rr = i * 8 + (lane >> 3), chk = lane & 7; const v4u w = *(const LAS v4u*)((LAS bf16*)ost + rr * 72 + chk * 8);
              *(v4u*)(OUTB + ((size_t)b * SEQ + qb * BLK + wid * 32 + rr) * out_pitch + h * HD + chk * 8) = w; } }
        asm volatile("s_waitcnt lgkmcnt(0)" ::: "memory");
    }
}
namespace rk {
using bf16x8 = __attribute__((ext_vector_type(8))) short;
using s16x4 = __attribute__((ext_vector_type(4))) short;
using f32x16 = __attribute__((ext_vector_type(16))) float;
using u32x4 = __attribute__((ext_vector_type(4))) unsigned;
using u32x2 = __attribute__((ext_vector_type(2))) unsigned;
typedef short v4i16_t __attribute__((ext_vector_type(4)));
typedef float f32x2_t __attribute__((ext_vector_type(2))); typedef __bf16 bf16x2_t __attribute__((ext_vector_type(2)));
constexpr int P = 144, IMG = 64 * P, GRP = 81920, MISC = 8 * IMG;
#define RK_MFMA(a, b, c) __builtin_amdgcn_mfma_f32_32x32x16_bf16((a), (b), (c), 0, 0, 0)
__device__ __forceinline__ int crow(int r, int hi) { return (r & 3) + 8 * (r >> 2) + 4 * hi; }
__device__ __forceinline__ unsigned cvtpk(float lo, float hi) { f32x2_t v = {lo, hi}; bf16x2_t b = __builtin_convertvector(v, bf16x2_t); return __builtin_bit_cast(unsigned, b); }
__device__ __forceinline__ float bflo(unsigned w) { return __uint_as_float(w << 16); }
__device__ __forceinline__ float bfhi(unsigned w) { return __uint_as_float(w & 0xffff0000u); }
__device__ __forceinline__ s16x4 trrd(const LAS unsigned char* p) { return __builtin_bit_cast(s16x4, __builtin_amdgcn_ds_read_tr16_b64_v4i16((LAS v4i16_t*)p)); }
struct Ln { int r, h, blk, q, p; };
__device__ __forceinline__ bf16x8 frag_row(const LAS unsigned char* img, const Ln& l, int tile, int s, int coloff = 0) { return *(const LAS bf16x8*)(img + (32 * tile + l.r) * P + (coloff + 16 * s + 8 * l.h) * 2); }
__device__ __forceinline__ bf16x8 frag_tr(const LAS unsigned char* img, const Ln& l, int tile, int s, int rowoff = 0) {
    const LAS unsigned char* b = img + (rowoff + 16 * s + 8 * l.h + l.q) * P + 64 * tile + 32 * l.blk + 8 * l.p;
    const s16x4 lo = trrd(b), hi = trrd(b + 4 * P);
    return (bf16x8){lo[0], lo[1], lo[2], lo[3], hi[0], hi[1], hi[2], hi[3]};
}
__device__ __forceinline__ bf16x8 frag_row_perm(const LAS unsigned char* img, const Ln& l, int tile, int s, int coloff = 0) {
    const LAS unsigned char* b = img + (32 * tile + l.r) * P + (coloff + 16 * s + 4 * l.h) * 2;
    const s16x4 lo = *(const LAS s16x4*)b, hi = *(const LAS s16x4*)(b + 16);
    return (bf16x8){lo[0], lo[1], lo[2], lo[3], hi[0], hi[1], hi[2], hi[3]};
}
__device__ __forceinline__ bf16x8 frag_tr_perm(const LAS unsigned char* img, const Ln& l, int tile, int s, int rowoff = 0) {
    const LAS unsigned char* b = img + (rowoff + 16 * s + 4 * l.h + l.q) * P + 64 * tile + 32 * l.blk + 8 * l.p;
    const s16x4 lo = trrd(b), hi = trrd(b + 8 * P);
    return (bf16x8){lo[0], lo[1], lo[2], lo[3], hi[0], hi[1], hi[2], hi[3]};
}
__device__ __forceinline__ bf16x8 pack(const f32x16& x, int s) {
    u32x4 w; w.x = cvtpk(x[8 * s], x[8 * s + 1]); w.y = cvtpk(x[8 * s + 2], x[8 * s + 3]); w.z = cvtpk(x[8 * s + 4], x[8 * s + 5]); w.w = cvtpk(x[8 * s + 6], x[8 * s + 7]);
    return __builtin_bit_cast(bf16x8, w);
}
__device__ __forceinline__ void store_T(LAS unsigned char* img, const Ln& l, const f32x16& x, int ti, int tj) {
#pragma unroll
    for (int g = 0; g < 4; ++g) { u32x2 w; w.x = cvtpk(x[4 * g], x[4 * g + 1]); w.y = cvtpk(x[4 * g + 2], x[4 * g + 3]);
        *(LAS u32x2*)(img + (32 * tj + l.r) * P + (32 * ti + 8 * g + 4 * l.h) * 2) = w; }
}
__device__ __forceinline__ float xhalf(float v) { return __shfl_xor(v, 32); }
__device__ __forceinline__ void tri_inv32(f32x16& D, f32x16& DT, f32x16 S, f32x16 ST) {
    const f32x16 z = {};
#pragma unroll
    for (int it = 0; it < 4; ++it) {
        f32x16 S2 = z, S2T = z;
#pragma unroll
        for (int s = 0; s < 2; ++s) { const bf16x8 ps = pack(S, s), pst = pack(ST, s); S2 = RK_MFMA(pst, ps, S2); S2T = RK_MFMA(ps, pst, S2T); }
        f32x16 DS = S2, DST = S2T;
#pragma unroll
        for (int s = 0; s < 2; ++s) { DS = RK_MFMA(pack(DT, s), pack(S2, s), DS); DST = RK_MFMA(pack(S2, s), pack(DT, s), DST); }
        D = D + DS; DT = DT + DST; S = S2; ST = S2T;
    }
}
}

constexpr size_t DO_NT = 0, DO_MT = 128 * MiB, DO_RH = 192 * MiB;

struct R1Ctx { int item, c, h, b; int nc, nh, nb; rk::f32x16 Wt0, Wt1; };
#define RK_RELANE() do { int t_ = F.tid; asm volatile("" : "+v"(t_)); lane = t_ & 63; tg = t_ & 255; grp = t_ >> 8; w4 = (t_ >> 6) & 3; ti = w4 >> 1; tj = w4 & 1; l.r = lane & 31; l.h = lane >> 5; l.blk = (lane >> 4) & 1; l.q = (lane & 15) >> 2; l.p = lane & 3; G = F.lds + grp * GRP; } while (0)
#define RK_KA() const __attribute__((address_space(4))) Args* ka = (const __attribute__((address_space(4))) Args*)__builtin_amdgcn_kernarg_segment_ptr(); asm volatile("" : "+s"(ka))
#define s0 (G)
#define s1 (G + IMG)
#define s2 (G + 2 * IMG)
#define s3 (G + 3 * IMG)
#define s4 (G + 4 * IMG)
#define s5 (G + 5 * IMG)
#define s6 (G + 6 * IMG)
#define s7 (G + 7 * IMG)
#define nrminv ((LAS float*)(G + MISC))
#define ltot (nrminv + 64)
#define gam (nrminv + 128)
#define bonp (nrminv + 192)
__device__ __forceinline__ void r1_S1a(Frame& F, R1Ctx& X) {
    using namespace rk;
    int grp, w4, ti, tj, lane, tg; Ln l; LAS unsigned char* G; const f32x16 z16 = {};
    RK_RELANE(); (void)w4; (void)tg; (void)ti; (void)tj;
    const int item = X.item, c = X.c, h = X.h, b = X.b; (void)item; (void)c; (void)h; (void)b;
    { RK_KA(); const bf16* RW = (const bf16*)(ka->ws + WS_RW); const float* mu_ = ka->in[5]; const float* kk_ = ka->in[10];
      const int t = tg >> 2, q4 = tg & 3; const int sq = c * 64 + t; const size_t row = (size_t)b * SEQ + sq;
      const bf16* cur = RW + row * RWC; const bool hasp = sq > 0; const bf16* prv = hasp ? cur - RWC : cur; const float pm = hasp ? 1.f : 0.f;
      float nr = 0.f;
      v4u cr_[2], pr_[2], ck_[2], pk_[2], cv_[2], pv_[2], cw_[2], pw_[2], ca_[2], pa_[2], cz_[2], pz_[2];
#pragma unroll
      for (int half = 0; half < 2; ++half) { const int k0 = 16 * q4 + 8 * half, col = h * HD + k0;
          cr_[half] = *(const v4u*)(cur + col); pr_[half] = *(const v4u*)(prv + col); ck_[half] = *(const v4u*)(cur + 512 + col); pk_[half] = *(const v4u*)(prv + 512 + col); cv_[half] = *(const v4u*)(cur + 1024 + col); pv_[half] = *(const v4u*)(prv + 1024 + col);
          cw_[half] = *(const v4u*)(cur + 2048 + k0); pw_[half] = *(const v4u*)(prv + 2048 + k0); ca_[half] = *(const v4u*)(cur + 2112 + k0); pa_[half] = *(const v4u*)(prv + 2112 + k0); cz_[half] = *(const v4u*)(cur + 1536 + col); pz_[half] = *(const v4u*)(prv + 1536 + col); }
      __builtin_amdgcn_sched_barrier(0);
#pragma unroll
      for (int half = 0; half < 2; ++half) { const int k0 = 16 * q4 + 8 * half, col = h * HD + k0;
          const v4u cr = cr_[half], pr = pr_[half], ck = ck_[half], pk = pk_[half], cv = cv_[half], pv = pv_[half], cw = cw_[half], pw = pw_[half], ca = ca_[half], pa = pa_[half], cz = cz_[half], pz = pz_[half];
          float ro[8], ko[8], vo[8], wo[8], ao[8], zo[8];
          float mr[8], mk[8], mv[8], mz[8], mw[8], ma[8], kkc[8];
          { const f32x4* p; f32x4 x0, x1;
#define LD8_(dst, ptr) p = (const f32x4*)(ptr); x0 = p[0]; x1 = p[1]; dst[0] = x0[0]; dst[1] = x0[1]; dst[2] = x0[2]; dst[3] = x0[3]; dst[4] = x1[0]; dst[5] = x1[1]; dst[6] = x1[2]; dst[7] = x1[3]
            LD8_(mr, mu_ + col); LD8_(mk, mu_ + 512 + col); LD8_(mv, mu_ + 1024 + col); LD8_(mz, mu_ + 1536 + col); LD8_(mw, mu_ + 2048 + k0); LD8_(ma, mu_ + 2112 + k0); LD8_(kkc, kk_ + col);
#undef LD8_
          }
#pragma unroll
          for (int e = 0; e < 8; ++e) { const unsigned wcr = cr[e >> 1], wpr = pr[e >> 1], wck = ck[e >> 1], wpk = pk[e >> 1], wcv = cv[e >> 1], wpv = pv[e >> 1];
              const unsigned wcw = cw[e >> 1], wpw = pw[e >> 1], wca = ca[e >> 1], wpa = pa[e >> 1];
              const float xr = (e & 1) ? bfhi(wcr) : bflo(wcr), yr = pm * ((e & 1) ? bfhi(wpr) : bflo(wpr)); ro[e] = xr + (yr - xr) * mr[e];
              const float xk = (e & 1) ? bfhi(wck) : bflo(wck), yk = pm * ((e & 1) ? bfhi(wpk) : bflo(wpk)); ko[e] = xk + (yk - xk) * mk[e];
              const float xv = (e & 1) ? bfhi(wcv) : bflo(wcv), yv = pm * ((e & 1) ? bfhi(wpv) : bflo(wpv)); vo[e] = xv + (yv - xv) * mv[e];
              const float xw = (e & 1) ? bfhi(wcw) : bflo(wcw), yw = pm * ((e & 1) ? bfhi(wpw) : bflo(wpw)); wo[e] = ftanh(xw + (yw - xw) * mw[e]);
              const float xa = (e & 1) ? bfhi(wca) : bflo(wca), ya = pm * ((e & 1) ? bfhi(wpa) : bflo(wpa)); ao[e] = xa + (ya - xa) * ma[e];
              { const unsigned wcz = cz[e >> 1], wpz = pz[e >> 1]; const float xz = (e & 1) ? bfhi(wcz) : bflo(wcz), yz = pm * ((e & 1) ? bfhi(wpz) : bflo(wpz)); const float zz = xz + (yz - xz) * mz[e]; zo[e] = zz * sigm(zz); }
              const float kkx = ko[e] * kkc[e]; nr += kkx * kkx; }
          const int off = t * P + k0 * 2;
          *(LAS u32x4*)(s0 + off) = (u32x4){cvtpk(wo[0], wo[1]), cvtpk(wo[2], wo[3]), cvtpk(wo[4], wo[5]), cvtpk(wo[6], wo[7])};
          *(LAS u32x4*)(s1 + off) = (u32x4){cvtpk(ao[0], ao[1]), cvtpk(ao[2], ao[3]), cvtpk(ao[4], ao[5]), cvtpk(ao[6], ao[7])};
          *(LAS u32x4*)(s2 + off) = (u32x4){cvtpk(ro[0], ro[1]), cvtpk(ro[2], ro[3]), cvtpk(ro[4], ro[5]), cvtpk(ro[6], ro[7])};
          *(LAS u32x4*)(s3 + off) = (u32x4){cvtpk(ko[0], ko[1]), cvtpk(ko[2], ko[3]), cvtpk(ko[4], ko[5]), cvtpk(ko[6], ko[7])};
          const u32x4 vw = (u32x4){cvtpk(vo[0], vo[1]), cvtpk(vo[2], vo[3]), cvtpk(vo[4], vo[5]), cvtpk(vo[6], vo[7])};
          *(LAS u32x4*)(s4 + off) = vw;
          bf16* qz = (bf16*)(ka->ws + WS_QKVZ) + row * QP + col;
          *(u32x4*)(qz + 1024) = vw; *(u32x4*)(qz + 1536) = (u32x4){cvtpk(zo[0], zo[1]), cvtpk(zo[2], zo[3]), cvtpk(zo[4], zo[5]), cvtpk(zo[6], zo[7])}; }
      nr += __shfl_xor(nr, 1); nr += __shfl_xor(nr, 2);
      if (q4 == 0) nrminv[t] = frsq(fmaxf(nr, 1e-24f)); }
}
__device__ __forceinline__ void r1_S1b(Frame& F, R1Ctx& X) {
    using namespace rk;
    int grp, w4, ti, tj, lane, tg; Ln l; LAS unsigned char* G; const f32x16 z16 = {};
    RK_RELANE(); (void)w4; (void)tg; (void)ti; (void)tj;
    const int item = X.item, c = X.c, h = X.h, b = X.b; (void)item; (void)c; (void)h; (void)b;
    {
        RK_KA(); const bf16* WupT = (const bf16*)(ka->ws + WS_WUPT); const bf16* AupT = (const bf16*)(ka->ws + WS_AUPT);
        const int kcol = 32 * tj + l.r, kc = h * HD + kcol;
        f32x16 W = z16, Aq = z16;
#pragma unroll
        for (int s = 0; s < 4; ++s) { const bf16x8 bw = *(const bf16x8*)(WupT + (size_t)kc * 64 + 16 * s + 8 * l.h), ba = *(const bf16x8*)(AupT + (size_t)kc * 64 + 16 * s + 8 * l.h);
            W = RK_MFMA(frag_row(s0, l, ti, s), bw, W); Aq = RK_MFMA(frag_row(s1, l, ti, s), ba, Aq); }
        const float w0 = ka->in[6][kc], a0 = ka->in[8][kc], kkc = ka->in[10][kc], kac = ka->in[11][kc], rkc = ka->in[12][kc];
        float lw[16], L[16];
#pragma unroll
        for (int r = 0; r < 16; ++r) { const float x = W[r] + w0; const float sp = (-x > 20.f) ? -x : 0.6931471805599453f * __builtin_amdgcn_logf(1.0f + fexp(-x)); lw[r] = -fexp(-sp - 0.5f); Aq[r] = sigm(Aq[r] + a0); }
        float gs[4], go[4];
#pragma unroll
        for (int g = 0; g < 4; ++g) { L[4 * g] = lw[4 * g]; L[4 * g + 1] = L[4 * g] + lw[4 * g + 1]; L[4 * g + 2] = L[4 * g + 1] + lw[4 * g + 2]; L[4 * g + 3] = L[4 * g + 2] + lw[4 * g + 3]; gs[g] = L[4 * g + 3]; }
        float run = 0.f;
#pragma unroll
        for (int g = 0; g < 4; ++g) { const float og = xhalf(gs[g]); const float lo = l.h ? og : gs[g], hi = l.h ? gs[g] : og;
            go[g] = run + (l.h ? lo : 0.f); run += lo + hi; }
#pragma unroll
        for (int r = 0; r < 16; ++r) L[r] += go[r >> 2];
        if (ti == 0 && l.h == 0) ltot[kcol] = run;
        __syncthreads();
        if (ti == 1) { const float add = ltot[kcol];
#pragma unroll
            for (int r = 0; r < 16; ++r) L[r] += add;
            if (l.h == 1) gam[kcol] = fexp(L[15]); }
        f32x16 At, Bt, Kt, Rt; float xb[16];
#pragma unroll
        for (int r = 0; r < 16; ++r) { const int t = 32 * ti + crow(r, l.h);
            const float rr = bf2f(*(const LAS unsigned short*)(s2 + t * P + kcol * 2)), kx = bf2f(*(const LAS unsigned short*)(s3 + t * P + kcol * 2));
            const float kn = kx * kkc * nrminv[t], a = Aq[r], km = kx * (1.0f + (a - 1.0f) * kac);
            const float eL = fexp(L[r]), eLn = fexp(-L[r]), eLp = fexp(L[r] - lw[r]);
            At[r] = -kn * eLp; Bt[r] = kn * a * eLn; Kt[r] = km * eLn; Rt[r] = rr * eL; xb[r] = rr * km * rkc; }
#pragma unroll
        for (int r = 0; r < 16; ++r) xb[r] = dpp_sum32(xb[r]);
        if (l.r == 31) {
#pragma unroll
            for (int r = 0; r < 16; ++r) bonp[tj * 64 + 32 * ti + crow(r, l.h)] = xb[r]; }
        store_T(s0, l, At, ti, tj); store_T(s1, l, Bt, ti, tj); store_T(s5, l, Kt, ti, tj); store_T(s6, l, Rt, ti, tj);
    }
}
__device__ __forceinline__ void r1_S2(Frame& F, R1Ctx& X) {
    using namespace rk;
    int grp, w4, ti, tj, lane, tg; Ln l; LAS unsigned char* G; const f32x16 z16 = {};
    RK_RELANE(); (void)w4; (void)tg; (void)ti; (void)tj;
    const int item = X.item, c = X.c, h = X.h, b = X.b; (void)item; (void)c; (void)h; (void)b;
    unsigned pf0 = 0u, pf1 = 0u;
    if (X.nb >= 0) { RK_KA(); const bf16* RW = (const bf16*)(ka->ws + WS_RW);
        { const int j = tg; const int rr = j / 6, pc = j % 6; const long sq = (long)X.nb * SEQ + X.nc * 64 + rr - 1;
          if (sq >= (long)X.nb * SEQ) pf0 = *(const volatile unsigned char*)(RW + (size_t)sq * RWC + (pc < 4 ? pc * 512 + X.nh * HD : 2048 + (pc - 4) * 64)); }
        { const int j = tg + 256; const int rr = j / 6, pc = j % 6; const long sq = (long)X.nb * SEQ + X.nc * 64 + rr - 1;
          if (j < 65 * 6) pf1 = *(const volatile unsigned char*)(RW + (size_t)sq * RWC + (pc < 4 ? pc * 512 + X.nh * HD : 2048 + (pc - 4) * 64)); } }
    {
        f32x16 X = z16;
        if (ti >= tj) {
#pragma unroll
            for (int s = 0; s < 4; ++s) X = RK_MFMA(frag_tr(s0, l, ti, s), frag_tr(s5, l, tj, s), X);
#pragma unroll
            for (int r = 0; r < 16; ++r) { const int t = 32 * ti + crow(r, l.h), i = 32 * tj + l.r; if (!(t > i)) X[r] = 0.f; } }
        store_T(s2, l, X, ti, tj);
        if (w4 == 0 || w4 == 3) { const int d = w4 == 3;
            f32x16 S = z16, ST = z16;
#pragma unroll
            for (int s = 0; s < 4; ++s) { const bf16x8 fa = frag_tr(s0, l, d, s), fb = frag_tr(s1, l, d, s); S = RK_MFMA(fa, fb, S); ST = RK_MFMA(fb, fa, ST); }
#pragma unroll
            for (int r = 0; r < 16; ++r) { const int rw = crow(r, l.h); if (!(rw > l.r)) S[r] = 0.f; if (!(l.r > rw)) ST[r] = 0.f; }
            f32x16 D = S, DT = ST;
            tri_inv32(D, DT, S, ST);
            store_T(s7, l, D, d, d);
            asm volatile("s_waitcnt lgkmcnt(0)" ::: "memory");
            if (l.h == 0) *(LAS unsigned short*)(s7 + (32 * d + l.r) * P + (32 * d + l.r) * 2) = 0x3f80;
        } else if (w4 == 2) {
            f32x16 X21 = z16;
#pragma unroll
            for (int s = 0; s < 4; ++s) X21 = RK_MFMA(frag_tr(s0, l, 1, s), frag_tr(s1, l, 0, s), X21);
            store_T(s3, l, X21, 0, 0);
        } else {
            store_T(s7, l, z16, 0, 1);
            { RK_KA(); float* BON = (float*)(ka->ws + WS_BON); const int t = lane; BON[((size_t)b * SEQ + c * 64 + t) * NH + h] = bonp[t] + bonp[64 + t]; }
        }
    }
    asm volatile("" :: "v"(pf0), "v"(pf1));
}
__device__ __forceinline__ void r1_S3(Frame& F, R1Ctx& X) {
    using namespace rk;
    int grp, w4, ti, tj, lane, tg; Ln l; LAS unsigned char* G; const f32x16 z16 = {};
    RK_RELANE(); (void)w4; (void)tg; (void)ti; (void)tj;
    const int item = X.item, c = X.c, h = X.h, b = X.b; (void)item; (void)c; (void)h; (void)b;
    f32x16& Wt0 = X.Wt0; f32x16& Wt1 = X.Wt1;
    Wt0 = z16; Wt1 = z16;
    {
        if (w4 == 2) {
            f32x16 E = z16;
#pragma unroll
            for (int s = 0; s < 2; ++s) E = RK_MFMA(frag_tr(s3, l, 0, s), frag_row(s7, l, 0, s), E);
            store_T(s3, l, E, 0, 1);
            f32x16 T21 = z16;
#pragma unroll
            for (int s = 0; s < 2; ++s) T21 = RK_MFMA(frag_tr(s7, l, 1, s, 32), frag_row(s3, l, 1, s), T21);
            store_T(s7, l, T21, 1, 0);
        }
#pragma unroll
        for (int s = 0; s < 4; ++s) Wt0 = RK_MFMA(frag_tr(s2, l, 0, s), frag_tr(s4, l, tj, s), Wt0);
        if (ti == 1) {
#pragma unroll
            for (int s = 0; s < 4; ++s) Wt1 = RK_MFMA(frag_tr(s2, l, 1, s), frag_tr(s4, l, tj, s), Wt1); }
    }
}
__device__ __forceinline__ void r1_S4(Frame& F, R1Ctx& X) {
    using namespace rk;
    int grp, w4, ti, tj, lane, tg; Ln l; LAS unsigned char* G; const f32x16 z16 = {};
    RK_RELANE(); (void)w4; (void)tg; (void)ti; (void)tj;
    const int item = X.item, c = X.c, h = X.h, b = X.b; (void)item; (void)c; (void)h; (void)b;
    f32x16& Wt0 = X.Wt0; f32x16& Wt1 = X.Wt1;
    {
        f32x16 Ap = z16;
#pragma unroll
        for (int s = 0; s < 4; ++s) if (s < 2 || ti == 1) Ap = RK_MFMA(frag_tr(s7, l, ti, s), frag_row(s0, l, tj, s), Ap);
        f32x16 Uv = z16;
#pragma unroll
        for (int s = 0; s < 2; ++s) Uv = RK_MFMA(frag_tr_perm(s7, l, ti, s, 0), pack(Wt0, s), Uv);
        if (ti == 1) {
#pragma unroll
            for (int s = 0; s < 2; ++s) Uv = RK_MFMA(frag_tr_perm(s7, l, ti, s, 32), pack(Wt1, s), Uv); }
        store_T(s2, l, Ap, ti, tj); store_T(s3, l, Uv, ti, tj);
    }
}
__device__ __forceinline__ void r1_S5(Frame& F, R1Ctx& X) {
    using namespace rk;
    int grp, w4, ti, tj, lane, tg; Ln l; LAS unsigned char* G; const f32x16 z16 = {};
    RK_RELANE(); (void)w4; (void)tg; (void)ti; (void)tj;
    const int item = X.item, c = X.c, h = X.h, b = X.b; (void)item; (void)c; (void)h; (void)b;
    {
        RK_KA(); float* NT = (float*)((unsigned char*)ka->out + DO_NT); bf16* MT = (bf16*)((unsigned char*)ka->out + DO_MT); bf16* RH = (bf16*)((unsigned char*)ka->out + DO_RH); bf16* Y0 = (bf16*)(ka->ws + WS_GATE);
        const size_t ib = (size_t)((b * 64 + c) * NH + h) * 4096;
        f32x16 Xrb0 = z16, Xrk0 = z16, Xrb1 = z16, Xrk1 = z16;
#pragma unroll
        for (int s = 0; s < 4; ++s) { const bf16x8 fr = frag_tr(s6, l, ti, s); Xrb0 = RK_MFMA(frag_tr(s1, l, 0, s), fr, Xrb0); Xrk0 = RK_MFMA(frag_tr(s5, l, 0, s), fr, Xrk0); }
        if (ti == 1) {
#pragma unroll
            for (int s = 0; s < 4; ++s) { const bf16x8 fr = frag_tr(s6, l, ti, s); Xrb1 = RK_MFMA(frag_tr(s1, l, 1, s), fr, Xrb1); Xrk1 = RK_MFMA(frag_tr(s5, l, 1, s), fr, Xrk1); } }
#pragma unroll
        for (int r = 0; r < 16; ++r) { const bool keep = crow(r, l.h) <= l.r; if (ti == 0) { if (!keep) { Xrb0[r] = 0.f; Xrk0[r] = 0.f; } } else { if (!keep) { Xrb1[r] = 0.f; Xrk1[r] = 0.f; } } }
        f32x16 acc;
#pragma unroll
        for (int g = 0; g < 4; ++g) { const u32x2 w = *(const LAS u32x2*)(s6 + (32 * tj + l.r) * P + (32 * ti + 8 * g + 4 * l.h) * 2); acc[4 * g] = bflo(w.x); acc[4 * g + 1] = bfhi(w.x); acc[4 * g + 2] = bflo(w.y); acc[4 * g + 3] = bfhi(w.y); }
#pragma unroll
        for (int s = 0; s < 2; ++s) acc = RK_MFMA(pack(Xrb0, s), frag_row_perm(s2, l, tj, s, 0), acc);
        if (ti == 1) {
#pragma unroll
            for (int s = 0; s < 2; ++s) acc = RK_MFMA(pack(Xrb1, s), frag_row_perm(s2, l, tj, s, 32), acc); }
#pragma unroll
        for (int r = 0; r < 16; ++r) RH[ib + (32 * ti + crow(r, l.h)) * 64 + 32 * tj + l.r] = (bf16)f2bf(acc[r]);
        acc = z16;
#pragma unroll
        for (int s = 0; s < 2; ++s) { acc = RK_MFMA(pack(Xrb0, s), frag_row_perm(s3, l, tj, s, 0), acc); acc = RK_MFMA(pack(Xrk0, s), frag_tr_perm(s4, l, tj, s, 0), acc); }
        if (ti == 1) {
#pragma unroll
            for (int s = 0; s < 2; ++s) { acc = RK_MFMA(pack(Xrb1, s), frag_row_perm(s3, l, tj, s, 32), acc); acc = RK_MFMA(pack(Xrk1, s), frag_tr_perm(s4, l, tj, s, 32), acc); } }
#pragma unroll
        for (int r = 0; r < 16; ++r) Y0[ib + (32 * ti + crow(r, l.h)) * 64 + 32 * tj + l.r] = (bf16)f2bf(acc[r]);
        acc = z16;
#pragma unroll
        for (int s = 0; s < 4; ++s) acc = RK_MFMA(frag_row(s1, l, ti, s), frag_row(s2, l, tj, s), acc);
#pragma unroll
        for (int r = 0; r < 16; ++r) { const int kp = 32 * ti + crow(r, l.h), k = 32 * tj + l.r; const float v = (acc[r] + (kp == k ? 1.f : 0.f)) * gam[kp]; MT[ib + kp * 64 + k] = (bf16)f2bf(v); }
        acc = z16;
#pragma unroll
        for (int s = 0; s < 4; ++s) { acc = RK_MFMA(frag_row(s1, l, ti, s), frag_row(s3, l, tj, s), acc); acc = RK_MFMA(frag_row(s5, l, ti, s), frag_tr(s4, l, tj, s), acc); }
#pragma unroll
        for (int r = 0; r < 16; ++r) NT[ib + ((ti * 2 + tj) * 16 + r) * 64 + lane] = acc[r] * gam[32 * ti + crow(r, l.h)];
    }
}
#ifndef MK_R1_REP
#define MK_R1_REP -1
#endif
__device__ __forceinline__ void rwkv_chunk_ops(Frame& F) {
    R1Ctx X;
    for (int ip = F.vcu; ip < BATCH * NH * 64 / 2; ip += F.G) {
        { int t_ = F.tid; asm volatile("" : "+v"(t_)); const int grp = t_ >> 8; X.item = ip * 2 + grp; X.c = X.item & 63; const int bh = X.item >> 6; X.h = bh % NH; X.b = bh / NH;
          const int nit = (ip + F.G) * 2 + grp; const int nbh = nit >> 6; X.nc = nit & 63; X.nh = nbh % NH; X.nb = (ip + F.G < BATCH * NH * 64 / 2) ? nbh / NH : -1; }
        r1_S1a(F, X); __syncthreads();
        if constexpr (MK_R1_REP == 0) { r1_S1a(F, X); __syncthreads(); }
        r1_S1b(F, X); __syncthreads();
        if constexpr (MK_R1_REP == 1) { r1_S1a(F, X); __syncthreads(); r1_S1b(F, X); __syncthreads(); }
        r1_S2(F, X); __syncthreads();
        if constexpr (MK_R1_REP == 2) { r1_S2(F, X); __syncthreads(); }
        r1_S3(F, X); __syncthreads();
        r1_S4(F, X); __syncthreads();
        r1_S5(F, X); __syncthreads();
        if constexpr (MK_R1_REP == 5) { r1_S5(F, X); __syncthreads(); }
    }
}
#undef s0
#undef s1
#undef s2
#undef s3
#undef s4
#undef s5
#undef s6
#undef s7
#undef nrminv
#undef ltot
#undef gam
#undef bonp
__device__ __forceinline__ void rwkv_relay(Frame& F) {
    using namespace rk;
    const int lane = F.lane, wid = F.wave; const int lr = lane & 31, lh = lane >> 5;
    LAS float* sbuf = (LAS float*)F.lds; volatile LAS int* flag = (volatile LAS int*)(F.lds + 16384);
    const float* NT = (const float*)((unsigned char*)F.out + DO_NT); bf16* MT = (bf16*)((unsigned char*)F.out + DO_MT);
    for (int ch = F.vcu; ch < BATCH * NH * 2; ch += F.G) {
        const int bh = ch >> 1, ct = ch & 1;
        __syncthreads();
        for (int i = F.tid; i < 2048; i += NTHR) sbuf[i] = 0.f;
        if (F.tid == 0) flag[0] = 0;
        __syncthreads();
        for (int c = wid; c < 64; c += NWAVES) {
            const size_t ib = (size_t)(((bh >> 3) * 64 + c) * NH + (bh & 7)) * 4096;
            bf16x8 am[2][4]; f32x16 sn[2];
#pragma unroll
            for (int rt = 0; rt < 2; ++rt)
#pragma unroll
                for (int s = 0; s < 4; ++s) { const bf16* pm = MT + ib + (32 * rt + lr) * 64 + 16 * s + 4 * lh;
                    const v2u m0 = *(const v2u*)pm, m1 = *(const v2u*)(pm + 8);
                    am[rt][s] = __builtin_bit_cast(bf16x8, (u32x4){m0.x, m0.y, m1.x, m1.y}); }
#pragma unroll
            for (int rt = 0; rt < 2; ++rt)
#pragma unroll
                for (int r = 0; r < 16; ++r) sn[rt][r] = NT[ib + ((rt * 2 + ct) * 16 + r) * 64 + lane];
            while (flag[0] < c) __builtin_amdgcn_s_sleep(1);
            asm volatile("s_waitcnt lgkmcnt(0)" ::: "memory");
            const LAS float* sin = sbuf + (c & 1) * 2048; LAS float* sout = sbuf + ((c + 1) & 1) * 2048;
            bf16x8 sp[2][2];
#pragma unroll
            for (int kt = 0; kt < 2; ++kt) { f32x16 sv;
#pragma unroll
                for (int r = 0; r < 16; ++r) sv[r] = sin[(kt * 16 + r) * 64 + lane];
                sp[kt][0] = pack(sv, 0); sp[kt][1] = pack(sv, 1); }
#pragma unroll
            for (int s = 0; s < 4; ++s)
#pragma unroll
                for (int rt = 0; rt < 2; ++rt) sn[rt] = RK_MFMA(am[rt][s], sp[s >> 1][s & 1], sn[rt]);
#pragma unroll
            for (int rt = 0; rt < 2; ++rt)
#pragma unroll
                for (int r = 0; r < 16; ++r) sout[(rt * 16 + r) * 64 + lane] = sn[rt][r];
            asm volatile("s_waitcnt lgkmcnt(0)" ::: "memory");
            if (lane == 0) flag[0] = c + 1;
            bf16* sc = (bf16*)(F.ws + WS_SC) + ib;
#pragma unroll
            for (int kt = 0; kt < 2; ++kt)
#pragma unroll
                for (int sl = 0; sl < 2; ++sl) *(bf16x8*)(sc + (((kt * 2 + ct) * 2 + sl) * 64 + lane) * 8) = sp[kt][sl];
        }
    }
}

struct R2Tile { v4u y0[4], vv[4], zg[4]; float bon; };
__device__ __forceinline__ void r2_load_tile(R2Tile& T, const bf16* Y0, const bf16* QKVZ, const float* BON, size_t ib, int b, int h, int c, int tt, int lane) {
    const int q = lane >> 1, c0 = (lane & 1) * 32; const size_t row = (size_t)b * SEQ + c * 64 + tt * 32 + q;
    const v4u* y0p = (const v4u*)(Y0 + ib + (tt * 32 + q) * 64 + c0); const v4u* vp = (const v4u*)(QKVZ + row * QP + 1024 + h * HD + c0); const v4u* zp = (const v4u*)(QKVZ + row * QP + 1536 + h * HD + c0);
#pragma unroll
    for (int i = 0; i < 4; ++i) { T.y0[i] = y0p[i]; T.vv[i] = vp[i]; T.zg[i] = zp[i]; }
    T.bon = BON[row * NH + h];
}
__device__ __forceinline__ void rwkv_output(Frame& F) {
    using namespace rk;
    const int wid = F.wave;
    LAS float* yst = (LAS float*)(F.lds + wid * 8704); LAS float* cst = (LAS float*)(F.lds + 69632);
    bf16* QKVZ = (bf16*)(F.ws + WS_QKVZ);
    const bf16* SC = (const bf16*)(F.ws + WS_SC); const bf16* RH = (const bf16*)((unsigned char*)F.out + DO_RH);
    const bf16* Y0 = (const bf16*)(F.ws + WS_GATE); const float* BON = (const float*)(F.ws + WS_BON);
    __syncthreads();
    for (int i = F.tid; i < 2 * 512; i += NTHR) { const int a = i >> 9, col = i & 511; cst[i] = a == 0 ? F.ln_w[col] : F.ln_b[col]; }
    __syncthreads();
    const int gw = F.vcu * NWAVES + wid, NGW = F.G * NWAVES;
    for (int idx = gw; idx < BATCH * NH * 64; idx += NGW) {
        const int h = idx & 7, c = (idx >> 3) & 63, b = idx >> 9; const size_t ib = (size_t)idx * 4096;
        bf16x8 sp[2][2][2];
        { const int lane = F.lane;
#pragma unroll
          for (int kt = 0; kt < 2; ++kt)
#pragma unroll
              for (int ct = 0; ct < 2; ++ct)
#pragma unroll
                  for (int sl = 0; sl < 2; ++sl) sp[kt][ct][sl] = *(const bf16x8*)(SC + ib + (((kt * 2 + ct) * 2 + sl) * 64 + lane) * 8); }
#pragma unroll 1
        for (int tt = 0; tt < 2; ++tt) {
            int lane_ = F.tid; asm volatile("" : "+v"(lane_)); const int lane = lane_ & 63, lr = lane & 31, lh = lane >> 5;
            bf16x8 ar[4];
#pragma unroll
            for (int s = 0; s < 4; ++s) { const bf16* pr = RH + ib + (32 * tt + lr) * 64 + 16 * s + 4 * lh; const v2u r0 = *(const v2u*)pr, r1 = *(const v2u*)(pr + 8);
                ar[s] = __builtin_bit_cast(bf16x8, (u32x4){r0.x, r0.y, r1.x, r1.y}); }
            R2Tile T; r2_load_tile(T, Y0, QKVZ, BON, ib, b, h, c, tt, lane);
            f32x16 y0 = {}, y1 = {};
#ifndef MK_R2B_X
#define MK_R2B_X 0
#endif
#pragma unroll 1
            for (int rep2 = 0; rep2 < (MK_R2B_X == 2 ? 4 : 1); ++rep2) {
            y0 = f32x16{}; y1 = f32x16{};
#pragma unroll
            for (int s = 0; s < 4; ++s) { y0 = RK_MFMA(ar[s], sp[s >> 1][0][s & 1], y0); y1 = RK_MFMA(ar[s], sp[s >> 1][1][s & 1], y1); }
#pragma unroll
            for (int r = 0; r < 16; ++r) { yst[crow(r, lh) * 68 + lr] = y0[r]; yst[crow(r, lh) * 68 + 32 + lr] = y1[r]; }
            asm volatile("s_waitcnt lgkmcnt(0)" ::: "memory"); }
            const int q = lane >> 1, c0 = (lane & 1) * 32; const int sq = c * 64 + tt * 32 + q; const size_t row = (size_t)b * SEQ + sq;
            const LAS float* cs = cst + h * HD + c0;
            float y[32];
#pragma unroll 1
            for (int rep1 = 0; rep1 < (MK_R2B_X == 1 ? 4 : 1); ++rep1) {
#pragma unroll
            for (int e = 0; e < 32; e += 8) { const f32x4 a = *(const LAS f32x4*)(yst + q * 68 + c0 + e), bq = *(const LAS f32x4*)(yst + q * 68 + c0 + e + 4); const v4u w = T.y0[e >> 3];
                y[e] = a[0] + bflo(w.x); y[e + 1] = a[1] + bfhi(w.x); y[e + 2] = a[2] + bflo(w.y); y[e + 3] = a[3] + bfhi(w.y); y[e + 4] = bq[0] + bflo(w.z); y[e + 5] = bq[1] + bfhi(w.z); y[e + 6] = bq[2] + bflo(w.w); y[e + 7] = bq[3] + bfhi(w.w); }
            float sm = 0.f;
#pragma unroll
            for (int e = 0; e < 32; ++e) sm += y[e];
            sm += __shfl_xor(sm, 1); const float mean = sm * (1.f / 64.f);
            float sv = 0.f;
#pragma unroll
            for (int e = 0; e < 32; ++e) { const float d = y[e] - mean; sv += d * d; }
            sv += __shfl_xor(sv, 1); const float rstd = frsq(sv * (1.f / 64.f) + GN_EPS);
            const float bon = T.bon;
#pragma unroll
            for (int e = 0; e < 32; e += 8) { const v4u vw = T.vv[e >> 3], zw = T.zg[e >> 3];
                const f32x4 lw0 = *(const LAS f32x4*)(cs + e), lw1 = *(const LAS f32x4*)(cs + e + 4), lb0 = *(const LAS f32x4*)(cs + 512 + e), lb1 = *(const LAS f32x4*)(cs + 512 + e + 4);
                float o[8];
#pragma unroll
                for (int j = 0; j < 8; ++j) { const unsigned wv = vw[j >> 1], wz = zw[j >> 1]; const float vv = (j & 1) ? bfhi(wv) : bflo(wv), zg = (j & 1) ? bfhi(wz) : bflo(wz);
                    const float lw = j < 4 ? lw0[j & 3] : lw1[j & 3], lb = j < 4 ? lb0[j & 3] : lb1[j & 3];
                    o[j] = ((y[e + j] - mean) * rstd * lw + lb + bon * vv) * zg; }
                *(LAS v4u*)((LAS bf16*)yst + q * 72 + c0 + e) = (v4u){pk2(o[0], o[1]), pk2(o[2], o[3]), pk2(o[4], o[5]), pk2(o[6], o[7])}; }
            asm volatile("s_waitcnt lgkmcnt(0)" ::: "memory");
#pragma unroll
            for (int i = 0; i < 4; ++i) { const int rr = i * 8 + (lane >> 3), chk = lane & 7; const v4u w = *(const LAS v4u*)((LAS bf16*)yst + rr * 72 + chk * 8);
                *(v4u*)(QKVZ + ((size_t)b * SEQ + c * 64 + tt * 32 + rr) * QP + 512 + h * HD + chk * 8) = w; }
            asm volatile("s_waitcnt lgkmcnt(0)" ::: "memory"); }
        }
    }
}
#define BAR_ST ((volatile LAS unsigned*)(F.lds + 163832))
constexpr int LDS_BYTES = 163840;
constexpr int NPHASE = 13;

template <int PLO, int PHI> __global__ void __launch_bounds__(NTHR, 2) fwd(Args args) {
    extern __shared__ __attribute__((aligned(16))) unsigned char lds[];
    Frame F;
    F.lds = (LAS unsigned char*)lds;
#define RETID() do { int t_ = threadIdx.x; asm volatile("" : "+v"(t_)); F.tid = t_; F.lane = t_ & 63; F.wave = __builtin_amdgcn_readfirstlane(t_ >> 6); \
    int bx_ = blockIdx.x, g_ = gridDim.x; asm volatile("" : "+s"(bx_), "+s"(g_)); F.G = g_; F.vcu = (g_ % 8 == 0) ? (bx_ % 8) * (g_ / 8) + bx_ / 8 : bx_; } while (0)
    RETID();
    if (threadIdx.x == 0) { BAR_ST[0] = 0u; BAR_ST[1] = 0u; }
    if constexpr (PHI - PLO > 1) xcd_barrier_post((unsigned*)(args.ws + WS_BAR));
    if (args.ph_hi == 0x7fffffff) cg::this_grid().sync();
#define LOADF() do { const __attribute__((address_space(4))) Args* ap_ = (const __attribute__((address_space(4))) Args*)__builtin_amdgcn_kernarg_segment_ptr(); asm volatile("" : "+s"(ap_)); \
    F.x = ap_->in[0]; F.p = ap_->in[1]; F.g_pre = ap_->in[2]; F.w_in = ap_->in[3]; F.rel_bias = ap_->in[4]; F.mu = ap_->in[5]; F.w0 = ap_->in[6]; F.w_up = ap_->in[7]; \
    F.a0 = ap_->in[8]; F.a_up = ap_->in[9]; F.k_k = ap_->in[10]; F.k_a = ap_->in[11]; F.r_k = ap_->in[12]; F.ln_w = ap_->in[13]; F.ln_b = ap_->in[14]; \
    F.p_a = ap_->in[15]; F.p_b = ap_->in[16]; F.w_out = ap_->in[17]; F.g_post = ap_->in[18]; F.w_pu = ap_->in[19]; F.w_pg = ap_->in[20]; F.out = ap_->out; F.ws = ap_->ws; ws = F.ws; \
    U2 = (pg8::bf16_t*)F.out; MERGED = (pg8::bf16_t*)(ws + WS_RW); QKVZ = (pg8::bf16_t*)(ws + WS_QKVZ); RWb = (pg8::bf16_t*)(ws + WS_RW); GAB = (pg8::bf16_t*)(ws + WS_GAB); } while (0)
    unsigned char* ws; pg8::bf16_t *U2, *MERGED, *QKVZ, *RWb, *GAB;
    constexpr int lo = PLO, hi = PHI;
    cg::grid_group grid = cg::this_grid();
#define IN(k) (lo <= (k) && (k) < hi)
#define GRIDBAR() do { const __attribute__((address_space(4))) Args* apb_ = (const __attribute__((address_space(4))) Args*)__builtin_amdgcn_kernarg_segment_ptr(); asm volatile("" : "+s"(apb_)); \
    xcd_barrier((unsigned*)(apb_->ws + WS_BAR), BAR_ST); } while (0)
#define SEAM(k) do { if constexpr (IN(k) && IN((k) + 1)) GRIDBAR(); } while (0)
#ifndef MK_REPEAT_PHASE
#define MK_REPEAT_PHASE -1
#endif
#define NREP(k) (((k) == MK_REPEAT_PHASE) ? 2 : 1)

    if constexpr (IN(0)) { RETID(); LOADF(); p0_prologue(F); if constexpr (0 == MK_REPEAT_PHASE) { GRIDBAR(); RETID(); LOADF(); p0_prologue(F); } } SEAM(0);
#ifdef MK_BWTEST
    if constexpr (IN(1)) { RETID(); LOADF();
        const f32x4* xp = (const f32x4*)F.x; f32x4 acc = {0.f, 0.f, 0.f, 0.f};
        const int gw = F.vcu * NWAVES + F.wave, NGW = F.G * NWAVES;
        if (MK_BWTEST == 1) { const size_t n4 = (size_t)M * DM / 4;
            for (size_t i = (size_t)F.vcu * NTHR + F.tid; i + (size_t)31 * F.G * NTHR < n4; i += (size_t)32 * F.G * NTHR) { f32x4 t[32];
#pragma unroll
                for (int j = 0; j < 32; ++j) t[j] = xp[i + (size_t)j * F.G * NTHR];
#pragma unroll
                for (int j = 0; j < 32; ++j) acc += t[j]; }
        } else {
            for (int it = gw; it < (M / 32) * 8; it += NGW) { const int rg = it >> 3, cb = it & 7; const int q = F.lane >> 1, hf = F.lane & 1;
                const f32x4* p = xp + ((size_t)(rg * 32 + q) * DM + cb * 128 + hf * 64) / 4; f32x4 t[16];
#pragma unroll
                for (int j = 0; j < 16; ++j) t[j] = p[j];
#pragma unroll
                for (int j = 0; j < 16; ++j) acc += t[j]; } }
        if (acc[0] + acc[1] + acc[2] + acc[3] == 1.2345e30f) ((float*)(ws + WS_RSY))[F.tid] = acc[0];
        grid.sync(); }
#endif
    if constexpr (IN(1)) { RETID(); LOADF();
        { pg8::Gemm g{U2, (const pg8::bf16_t*)(ws + WS_WIN), M, INCP, DM, 2048, DM, 0, 0}; pg8::StaticOrder S; S.init(M, INCP, F.G, (int)blockIdx.x);
          pg8::EpiCols E{QKVZ, RWb, GAB, QSCALE};
          pg8::gemm_phase<pg8::EpiCols, pg8::StaticOrder, true, true>(F.lds, g, S, E);
          if constexpr (MK_REPEAT_PHASE == 101) { __syncthreads(); pg8::gemm_phase<pg8::EpiCols, pg8::StaticOrder, true, true>(F.lds, g, S, E); } }
        { pg8::Gemm g{U2, (const pg8::bf16_t*)(ws + WS_WG), M, 256, 2048, 2048, 2048, 16, (size_t)256 * 2048}; pg8::StaticOrder S; S.init(M, 256, F.G, (int)blockIdx.x);
          pg8::EpiF32 E{(float*)(ws + WS_GATE), 256};
          pg8::gemm_phase<pg8::EpiF32, pg8::StaticOrder, true, true>(F.lds, g, S, E);
          if constexpr (MK_REPEAT_PHASE == 102) { __syncthreads(); pg8::gemm_phase<pg8::EpiF32, pg8::StaticOrder, true, true>(F.lds, g, S, E); } }
    } SEAM(1);
#ifdef MK_SYNCTEST
    for (int i_ = 0; i_ < 20; ++i_) GRIDBAR();
#endif
    if constexpr (IN(2)) { RETID(); LOADF(); attn_select(F, (const float*)(ws + WS_GATE), (unsigned*)(ws + WS_CNT), (unsigned short*)((unsigned char*)F.out + DO_LISTS));
        if constexpr (2 == MK_REPEAT_PHASE) { GRIDBAR(); if (blockIdx.x == 0) for (int i = threadIdx.x; i < 2048; i += NTHR) ((unsigned*)(args.ws + WS_CNT))[i] = 0u; GRIDBAR(); RETID(); LOADF();
            attn_select(F, (const float*)(ws + WS_GATE), (unsigned*)(ws + WS_CNT), (unsigned short*)((unsigned char*)F.out + DO_LISTS)); } } SEAM(2);
    if constexpr (IN(3)) { RETID(); LOADF(); attn_partial(F, (const bf16*)(ws + WS_QKVZ), (const unsigned*)(ws + WS_CNT), (const unsigned short*)((unsigned char*)F.out + DO_LISTS),
                                         (bf16*)((unsigned char*)F.out + DO_PARTO), (float*)((unsigned char*)F.out + DO_PARTML), (unsigned*)(ws + WS_QCTR)); if constexpr (3 == MK_REPEAT_PHASE) { { GRIDBAR(); if (blockIdx.x == 0 && threadIdx.x == 0) *(unsigned*)(args.ws + WS_QCTR) = 0u; GRIDBAR(); } RETID(); LOADF(); attn_partial(F, (const bf16*)(ws + WS_QKVZ), (const unsigned*)(ws + WS_CNT), (const unsigned short*)((unsigned char*)F.out + DO_LISTS),
                                         (bf16*)((unsigned char*)F.out + DO_PARTO), (float*)((unsigned char*)F.out + DO_PARTML), (unsigned*)(ws + WS_QCTR)); } } SEAM(3);
    if constexpr (IN(4)) { RETID(); LOADF();
        if constexpr (4 == MK_REPEAT_PHASE) { attn_own_combine(F, (bf16*)(ws + WS_QKVZ), (const bf16*)((unsigned char*)F.out + DO_PARTO), (const float*)((unsigned char*)F.out + DO_PARTML), (bf16*)(ws + WS_GATE), 512); grid.sync(); RETID(); LOADF(); }
        attn_own_combine(F, (bf16*)(ws + WS_QKVZ), (const bf16*)((unsigned char*)F.out + DO_PARTO), (const float*)((unsigned char*)F.out + DO_PARTML), (bf16*)(ws + WS_QKVZ), QP); } SEAM(4);
    if constexpr (IN(5)) { RETID(); LOADF(); rwkv_chunk_ops(F); if constexpr (5 == MK_REPEAT_PHASE) { GRIDBAR(); RETID(); LOADF(); rwkv_chunk_ops(F); } } SEAM(5);
    if constexpr (IN(6)) { RETID(); LOADF(); rwkv_relay(F); if constexpr (6 == MK_REPEAT_PHASE) { GRIDBAR(); RETID(); LOADF(); rwkv_relay(F); } } SEAM(6);
    if constexpr (IN(7)) { RETID(); LOADF(); rwkv_output(F); if constexpr (7 == MK_REPEAT_PHASE) { GRIDBAR(); RETID(); LOADF(); rwkv_output(F); } } SEAM(7);
    if constexpr (IN(8)) { RETID(); LOADF();
        pg8::Gemm g{QKVZ, (const pg8::bf16_t*)(ws + WS_PAB), M, DM, 1024, QP, 1024, 0, 0}; pg8::StaticOrder S; S.init(M, DM, F.G, (int)blockIdx.x);
        pg8::EpiMergeFused E{MERGED, DM, GAB, GP};
        pg8::gemm_phase<pg8::EpiMergeFused, pg8::StaticOrder, true, true>(F.lds, g, S, E);
    } SEAM(9);
    if constexpr (IN(10)) { RETID(); LOADF();
        pg8::bf16_t* YB = RWb + (size_t)M * DM; pg8::bf16_t* H1B = QKVZ; PG8_LAS float* part = (PG8_LAS float*)(F.lds + 131072);
        for (int pm = F.vcu; pm < M / 256; pm += F.G) {
            pg8::PanelOrder S{pm};
            { pg8::Gemm g{MERGED, (const pg8::bf16_t*)(ws + WS_WOUT), M, DM, DM, DM, DM, 0, 0}; pg8::EpiYStat E{YB, DM, part};
              pg8::gemm_phase<pg8::EpiYStat, pg8::PanelOrder, true, true>(F.lds, g, S, E); }
            { int kple = PLE; asm volatile("" : "+s"(kple));
              pg8::Gemm g{(const pg8::bf16_t*)(ws + WS_PB), (const pg8::bf16_t*)(ws + WS_WPU), M, DM, kple, PLE, PLE, 0, 0}; pg8::EpiBf16 E{GAB, DM};
              pg8::gemm_phase<pg8::EpiBf16, pg8::PanelOrder, true, true>(F.lds, g, S, E); }
            asm volatile("s_waitcnt vmcnt(0) lgkmcnt(0)" ::: "memory"); __syncthreads();
            RETID(); panel_norm(F, pm, (const bf16*)YB, (bf16*)H1B, (float*)(ws + WS_RSY), (const LAS float*)part);
            asm volatile("s_waitcnt vmcnt(0)" ::: "memory"); __syncthreads();
            { pg8::Gemm g{H1B, (const pg8::bf16_t*)(ws + WS_WPG), M, DM, DM, DM, DM, 0, 0}; pg8::EpiFinal E{F.out, F.x, YB, (const float*)(ws + WS_RSY), F.g_post, GAB, DM};
              pg8::gemm_phase<pg8::EpiFinal, pg8::PanelOrder, true, true>(F.lds, g, S, E); }
            __syncthreads();
        }
    }
#undef IN
#undef SEAM
}

#ifndef MK_ONE_LAUNCH
#define MK_ONE_LAUNCH 1
#endif
extern "C" void kernel_launch(void* const* d_in, const int* in_sizes, int n_in, void* d_out, int out_size, void* d_ws, size_t ws_size, hipStream_t stream) {
    static int grid = 0;
    if (grid == 0) {
        if (n_in != 21 || out_size != M * DM || ws_size < WS_END) { fprintf(stderr, "kernel_launch: unexpected shapes n_in %d out %d ws %zu\n", n_in, out_size, ws_size); grid = -1; return; }
        int dev = 0, cus = 0, per_cu = 0;
        (void)hipGetDevice(&dev); (void)hipDeviceGetAttribute(&cus, hipDeviceAttributeMultiprocessorCount, dev);
        (void)per_cu;
        grid = cus;
    }
    if (grid < 0) return;
    if (hipMemsetAsync(d_ws, 0, 65536, stream) != hipSuccess) { fprintf(stderr, "kernel_launch: hipMemsetAsync of the control words failed\n"); return; }
    Args a{};
    for (int i = 0; i < 21; ++i) a.in[i] = (const float*)d_in[i];
    a.out = (float*)d_out; a.ws = (unsigned char*)d_ws;
#if MK_ONE_LAUNCH
    a.ph_lo = 0; a.ph_hi = NPHASE;
    void* kargs[] = {&a};
    (void)hipFuncSetAttribute((const void*)fwd<0, NPHASE>, hipFuncAttributeMaxDynamicSharedMemorySize, LDS_BYTES);
    hipError_t e = hipLaunchCooperativeKernel((const void*)fwd<0, NPHASE>, dim3(grid), dim3(NTHR), kargs, LDS_BYTES, stream);
    if (e != hipSuccess) fprintf(stderr, "cooperative launch failed: %s\n", hipGetErrorString(e));
#else
#define LAUNCH_PH(k) do { (void)hipFuncSetAttribute((const void*)fwd<k, k + 1>, hipFuncAttributeMaxDynamicSharedMemorySize, LDS_BYTES); a.ph_lo = k; a.ph_hi = k + 1; hipLaunchKernelGGL((fwd<k, k + 1>), dim3(grid), dim3(NTHR), LDS_BYTES, stream, a); } while (0)
    LAUNCH_PH(0); LAUNCH_PH(1); LAUNCH_PH(2); LAUNCH_PH(3); LAUNCH_PH(4); LAUNCH_PH(5); LAUNCH_PH(6); LAUNCH_PH(7); LAUNCH_PH(8); LAUNCH_PH(9); LAUNCH_PH(10); LAUNCH_PH(11); LAUNCH_PH(12);
#endif
}
```

```cpp
#include <hip/hip_runtime.h>
#include <hip/hip_cooperative_groups.h>
#include <cstdio>
#include <cstdint>
#include <cmath>
namespace cg = cooperative_groups;
namespace pg8 {
#define PG8_LAS __attribute__((address_space(3)))
typedef unsigned short bf16_t;
typedef short bf16x8 __attribute__((ext_vector_type(8)));
typedef float f32x4 __attribute__((ext_vector_type(4)));
typedef float f32x2 __attribute__((ext_vector_type(2)));
typedef unsigned u32x4 __attribute__((ext_vector_type(4)));
typedef unsigned u32x2 __attribute__((ext_vector_type(2)));
constexpr int BM = 256, BK = 64, HALF = 128, HTB = HALF * BK * 2  , STAGE_BYTES = 8 * HTB, NXCD = 8, WGM = 8;

__host__ __device__ __forceinline__ int lds_byte(int r, int c) { const int st = (r >> 4) * 2 + (c >> 5), rr = r & 15, cc = c & 31, ob = rr * 64 + cc * 2; return st * 1024 + (ob ^ (((ob >> 9) & 1) << 5)); }
__host__ __device__ __forceinline__ void stage_rc(int b, int& R, int& C) { const int st = b / 1024, sb = b % 1024, swz = sb ^ (((sb >> 9) & 1) << 5); R = (st >> 1) * 16 + swz / 64; C = (st & 1) * 32 + (swz % 64) / 2; }
__host__ __device__ __forceinline__ int perm32(int rho) { const int n = rho >> 4, i = rho & 15; return 8 * (i >> 2) + 4 * n + (i & 3); }

struct Unit { int pm, pn; };
struct Gemm { const bf16_t* A; const bf16_t* Bt; int M, N, K, lda, ldb, bdiv; size_t bstride; };

struct StaticOrder {
    int nM, nN, nwg, G, c;
    __host__ __device__ void init(int M, int N, int G_, int c_) { nM = M / BM; nN = N / BM; nwg = nM * nN; G = G_; c = c_; }
    __host__ __device__ __forceinline__ bool next(int i, Unit& u) const {
        const long L = (long)i * G + c; if (L >= nwg) return false;
        int wgid = (int)L; { const int q = nwg / NXCD, r = nwg % NXCD, xcd = wgid % NXCD, off = wgid / NXCD; wgid = (xcd < r ? xcd * (q + 1) : r * (q + 1) + (xcd - r) * q) + off; }
        const int nig = WGM * nN, gid = wgid / nig, fm = gid * WGM, gsz = (nM - fm) < WGM ? (nM - fm) : WGM;
        u.pm = fm + ((wgid % nig) % gsz); u.pn = (wgid % nig) / gsz; return true;
    }
};

struct PanelOrder { int pm; __host__ __device__ bool next(int i, Unit& u) const { if (i >= 4) return false; u.pm = pm; u.pn = i; return true; } };
__device__ __forceinline__ unsigned cvt_pk_bf16(float lo, float hi) { unsigned r; asm volatile("v_cvt_pk_bf16_f32 %0, %1, %2" : "=v"(r) : "v"(lo), "v"(hi)); return r; }
__device__ __forceinline__ float bf_lo(unsigned w) { return __uint_as_float(w << 16); }
__device__ __forceinline__ float bf_hi(unsigned w) { return __uint_as_float(w & 0xffff0000u); }

template <class Epi, class Sched, bool ALIGN_EPI = false, bool SP2 = false>
__device__ __forceinline__ void gemm_phase(PG8_LAS unsigned char* lds, const Gemm g, const Sched& S, const Epi& E) {
    int tid_ = threadIdx.x; asm volatile("" : "+v"(tid_));
    const int tid = tid_, wid = __builtin_amdgcn_readfirstlane(tid >> 6), lane = tid & 63, wr = wid >> 2, wc = wid & 3, fr = lane & 15, fq = lane >> 4;
    const int K = g.K, nt = K / BK;
    unsigned voffA[2], voffB[2];
#pragma unroll
    for (int i = 0; i < 2; ++i) { int R, C; stage_rc(tid * 16 + i * 8192, R, C); const int Rb = Epi::PERM ? ((R & ~31) + perm32(R & 31)) : R;
        voffA[i] = (unsigned)(R * g.lda + C) * 2u; voffB[i] = (unsigned)(Rb * g.ldb + C) * 2u; }
    const size_t kstep = (size_t)(BK * 2);
    const size_t hstepA = (size_t)HALF * g.lda * 2, hstepB = (size_t)HALF * g.ldb * 2;
    const size_t tstepA = 2 * hstepA, tstepB = 2 * hstepB;
    const unsigned ldsw = (unsigned)wid * 1024u;
    const int aoff = lds_byte(wr * 64 + fr, fq * 8), boff = lds_byte(wc * 32 + fr, fq * 8);
#define PG8_SA(b, h) (((b) * 2 + (h)) * HTB)
#define PG8_SB(b, h) ((4 + (b) * 2 + (h)) * HTB)
#define PG8_STAGE(bufoff, gbase, voff) do { _Pragma("unroll") for (int _i = 0; _i < 2; ++_i) \
        __builtin_amdgcn_global_load_lds((const unsigned*)((const char*)(gbase) + (voff)[_i]), (PG8_LAS unsigned*)(lds + (bufoff) + ldsw + _i * 8192), 16, 0, 0); } while (0)
#define PG8_LDA(dst, b, h) do { _Pragma("unroll") for (int m = 0; m < 4; ++m) _Pragma("unroll") for (int k = 0; k < 2; ++k) dst[m][k] = *(const PG8_LAS bf16x8*)(lds + PG8_SA(b, h) + aoff + m * 2048 + k * 1024); } while (0)
#define PG8_LDB(dst, b, h) do { _Pragma("unroll") for (int n = 0; n < 2; ++n) _Pragma("unroll") for (int k = 0; k < 2; ++k) dst[n][k] = *(const PG8_LAS bf16x8*)(lds + PG8_SB(b, h) + boff + n * 2048 + k * 1024); } while (0)
#define PG8_MMA(ai, bj, At, Bt) do { __builtin_amdgcn_s_setprio(1); _Pragma("unroll") for (int m = 0; m < 4; ++m) _Pragma("unroll") for (int n = 0; n < 2; ++n) _Pragma("unroll") for (int k = 0; k < 2; ++k) \
        acc[ai][bj][m][n] = __builtin_amdgcn_mfma_f32_16x16x32_bf16(Bt[n][k], At[m][k], acc[ai][bj][m][n], 0, 0, 0); __builtin_amdgcn_s_setprio(0); } while (0)
#define PG8_WAIT_V(n) asm volatile("s_waitcnt vmcnt(" #n ")" ::: "memory")
#define PG8_WAIT_L(n) asm volatile("s_waitcnt lgkmcnt(" #n ")" ::: "memory")
#define PG8_BAR __builtin_amdgcn_s_barrier()
#define PG8_SCHED __builtin_amdgcn_sched_barrier(0)
#define PG8_BBASE(u) ((const char*)g.Bt + (size_t)(u).pn * tstepB + (g.bdiv ? (size_t)((u).pm / g.bdiv) * g.bstride * 2 : (size_t)0))
    Unit cur, nxt; int ui = 0;
    if (!S.next(0, cur)) return;
    f32x4 acc[2][2][4][2];
#pragma unroll
    for (int a = 0; a < 2; ++a)
#pragma unroll
        for (int b = 0; b < 2; ++b)
#pragma unroll
            for (int m = 0; m < 4; ++m)
#pragma unroll
                for (int n = 0; n < 2; ++n) acc[a][b][m][n] = (f32x4){0.f, 0.f, 0.f, 0.f};
    bf16x8 At[4][2], B0[2][2], B1[2][2];
    const char* cA = (const char*)g.A + (size_t)cur.pm * tstepA; const char* cB = PG8_BBASE(cur);
    if constexpr (SP2) {
        PG8_STAGE(PG8_SB(0, 0), cB, voffB); PG8_STAGE(PG8_SB(0, 1), cB + hstepB, voffB); PG8_STAGE(PG8_SA(0, 0), cA, voffA); PG8_STAGE(PG8_SA(0, 1), cA + hstepA, voffA);
        if (wr == 1) PG8_BAR;
        PG8_WAIT_V(2); PG8_BAR;
        PG8_STAGE(PG8_SB(1, 0), cB + kstep, voffB); PG8_STAGE(PG8_SA(1, 0), cA + kstep, voffA); PG8_STAGE(PG8_SB(1, 1), cB + hstepB + kstep, voffB);
        PG8_WAIT_V(6); PG8_BAR;
    } else {
        PG8_STAGE(PG8_SB(0, 0), cB, voffB); PG8_STAGE(PG8_SA(0, 0), cA, voffA); PG8_STAGE(PG8_SB(0, 1), cB + hstepB, voffB); PG8_STAGE(PG8_SA(0, 1), cA + hstepA, voffA);
        if (wr == 1) PG8_BAR;
        PG8_WAIT_V(4); PG8_BAR;
        PG8_STAGE(PG8_SB(1, 0), cB + kstep, voffB); PG8_STAGE(PG8_SA(1, 0), cA + kstep, voffA); PG8_STAGE(PG8_SB(1, 1), cB + hstepB + kstep, voffB);
        PG8_WAIT_V(6); PG8_BAR;
    }
    for (;;) {
        const bool has_next = S.next(ui + 1, nxt);
        const char* nA = has_next ? (const char*)g.A + (size_t)nxt.pm * tstepA : cA; const char* nB = has_next ? PG8_BBASE(nxt) : cB;
        for (int t = 0; t < nt; t += 2) {
            if constexpr (Epi::HOOK_T > 0) { if (t == Epi::HOOK_T) { PG8_SCHED; E.mid(acc, cur, wr, wc, fr, fq); PG8_SCHED; } }
            const bool last = (t == nt - 2);
            const char* a1 = cA + (size_t)(t + 1) * kstep;
            const char* a2 = last ? nA : cA + (size_t)(t + 2) * kstep; const char* b2 = last ? nB : cB + (size_t)(t + 2) * kstep;
            const char* a3 = a2 + kstep; const char* b3 = b2 + kstep;
            if constexpr (SP2) {
            PG8_LDB(B0, 0, 0); PG8_LDB(B1, 0, 1); PG8_SCHED; PG8_LDA(At, 0, 0); PG8_STAGE(PG8_SA(1, 1), a1 + hstepA, voffA);
            PG8_WAIT_V(8); PG8_WAIT_L(0); PG8_BAR; PG8_MMA(0, 0, At, B0); PG8_MMA(0, 1, At, B1); PG8_BAR; PG8_SCHED;
            PG8_LDA(At, 0, 1); PG8_STAGE(PG8_SB(0, 0), b2, voffB); PG8_STAGE(PG8_SB(0, 1), b2 + hstepB, voffB); PG8_STAGE(PG8_SA(0, 0), a2, voffA);
            PG8_WAIT_V(8); PG8_WAIT_L(0); PG8_BAR; PG8_MMA(1, 0, At, B0); PG8_MMA(1, 1, At, B1); PG8_BAR; PG8_SCHED;
            PG8_LDB(B0, 1, 0); PG8_LDB(B1, 1, 1); PG8_SCHED; PG8_LDA(At, 1, 0); PG8_STAGE(PG8_SA(0, 1), a2 + hstepA, voffA);
            PG8_WAIT_V(8); PG8_WAIT_L(0); PG8_BAR; PG8_MMA(0, 0, At, B0); PG8_MMA(0, 1, At, B1); PG8_BAR; PG8_SCHED;
            PG8_LDA(At, 1, 1); PG8_STAGE(PG8_SB(1, 0), b3, voffB); PG8_STAGE(PG8_SB(1, 1), b3 + hstepB, voffB); PG8_STAGE(PG8_SA(1, 0), a3, voffA);
            PG8_WAIT_V(8); PG8_WAIT_L(0); PG8_BAR; PG8_MMA(1, 0, At, B0); PG8_MMA(1, 1, At, B1); PG8_BAR; PG8_SCHED;
            } else {
            PG8_LDB(B0, 0, 0); PG8_SCHED; PG8_LDA(At, 0, 0); PG8_STAGE(PG8_SA(1, 1), a1 + hstepA, voffA);
            PG8_WAIT_L(8); PG8_BAR; PG8_WAIT_L(0); PG8_MMA(0, 0, At, B0); PG8_BAR; PG8_SCHED;
            PG8_LDB(B1, 0, 1); PG8_STAGE(PG8_SB(0, 0), b2, voffB);
            PG8_BAR; PG8_WAIT_L(0); PG8_MMA(0, 1, At, B1); PG8_BAR;
            PG8_LDA(At, 0, 1); PG8_STAGE(PG8_SA(0, 0), a2, voffA);
            PG8_BAR; PG8_WAIT_L(0); PG8_MMA(1, 0, At, B0); PG8_BAR; PG8_SCHED;
            PG8_STAGE(PG8_SB(0, 1), b2 + hstepB, voffB);
            PG8_WAIT_V(6); PG8_BAR; PG8_MMA(1, 1, At, B1); PG8_BAR;
            PG8_LDB(B0, 1, 0); PG8_SCHED; PG8_LDA(At, 1, 0); PG8_STAGE(PG8_SA(0, 1), a2 + hstepA, voffA);
            PG8_WAIT_L(8); PG8_BAR; PG8_WAIT_L(0); PG8_MMA(0, 0, At, B0); PG8_BAR; PG8_SCHED;
            PG8_LDB(B1, 1, 1); PG8_STAGE(PG8_SB(1, 0), b3, voffB);
            PG8_BAR; PG8_WAIT_L(0); PG8_MMA(0, 1, At, B1); PG8_BAR;
            PG8_LDA(At, 1, 1); PG8_STAGE(PG8_SA(1, 0), a3, voffA);
            PG8_BAR; PG8_WAIT_L(0); PG8_MMA(1, 0, At, B0); PG8_BAR; PG8_SCHED;
            PG8_STAGE(PG8_SB(1, 1), b3 + hstepB, voffB);
            PG8_WAIT_V(6); PG8_BAR; PG8_MMA(1, 1, At, B1); PG8_BAR;
            }
        }
        if constexpr (ALIGN_EPI) { if (wr == 0) PG8_BAR; }
        E(acc, cur, wr, wc, fr, fq);
        if (!has_next) break;
#pragma unroll
        for (int a = 0; a < 2; ++a)
#pragma unroll
            for (int b = 0; b < 2; ++b)
#pragma unroll
                for (int m = 0; m < 4; ++m)
#pragma unroll
                    for (int n = 0; n < 2; ++n) acc[a][b][m][n] = (f32x4){0.f, 0.f, 0.f, 0.f};
        cur = nxt; cA = nA; cB = nB; ++ui;
        if constexpr (ALIGN_EPI) { if (wr == 1) PG8_BAR; }
    }
    PG8_WAIT_V(0);
    if constexpr (!ALIGN_EPI) { if (wr == 0) PG8_BAR; }
    PG8_BAR;
#undef PG8_SA
#undef PG8_SB
#undef PG8_STAGE
#undef PG8_LDA
#undef PG8_LDB
#undef PG8_MMA
#undef PG8_WAIT_V
#undef PG8_WAIT_L
#undef PG8_BAR
#undef PG8_SCHED
#undef PG8_BBASE
}
}
#ifndef MK_NT
#define MK_NT 1
#endif
#if MK_NT
#define PG8_NTSTORE(p, v) __builtin_nontemporal_store((v), (p))
#else
#define PG8_NTSTORE(p, v) (*(p) = (v))
#endif
namespace pg8 {
__device__ __forceinline__ float sigmoidf_(float x) { return __builtin_amdgcn_rcpf(1.0f + __builtin_amdgcn_exp2f(x * -1.4426950408889634f)); }

struct EpiCols {
    static constexpr bool PERM = true; static constexpr int HOOK_T = 0;
    bf16_t* qkvz; bf16_t* rw; bf16_t* gab; float qscale;
    __device__ __forceinline__ void operator()(const f32x4 (&acc)[2][2][4][2], const Unit& u, int wr, int wc, int fr, int fq) const {
        const int pn = u.pn; bf16_t* base; int pitch, coff, nbj = 2; float sc = 1.f;
        if (pn < 8) { base = qkvz; pitch = 2112; coff = pn * 256; if (pn < 2) sc = qscale; }
        else if (pn < 16) { base = rw; pitch = 2176; coff = (pn - 8) * 256; }
        else if (pn < 24) { base = gab; pitch = 2112; coff = (pn - 16) * 256; }
        else { base = rw; pitch = 2176; coff = 2048; nbj = 1; }
        const int row0 = u.pm * BM + wr * 64 + fr; const int col0 = coff + wc * 32 + 8 * fq;
#pragma unroll
        for (int ai = 0; ai < 2; ++ai)
#pragma unroll
            for (int m = 0; m < 4; ++m) { bf16_t* rowp = base + (size_t)(row0 + ai * HALF + m * 16) * pitch + col0;
#pragma unroll
                for (int bj = 0; bj < 2; ++bj) { if (bj < nbj) { f32x4 v0 = acc[ai][bj][m][0] * sc, v1 = acc[ai][bj][m][1] * sc;
                    u32x4 w; w.x = cvt_pk_bf16(v0[0], v0[1]); w.y = cvt_pk_bf16(v0[2], v0[3]); w.z = cvt_pk_bf16(v1[0], v1[1]); w.w = cvt_pk_bf16(v1[2], v1[3]);
                    PG8_NTSTORE((u32x4*)(rowp + bj * HALF), w); } } }
    }
};
struct EpiBf16 {
    static constexpr bool PERM = true; static constexpr int HOOK_T = 0;
    bf16_t* O; int ldc;
    __device__ __forceinline__ void operator()(const f32x4 (&acc)[2][2][4][2], const Unit& u, int wr, int wc, int fr, int fq) const {
        const int row0 = u.pm * BM + wr * 64 + fr; const int col0 = u.pn * BM + wc * 32 + 8 * fq;
#pragma unroll
        for (int ai = 0; ai < 2; ++ai)
#pragma unroll
            for (int m = 0; m < 4; ++m) { bf16_t* rowp = O + (size_t)(row0 + ai * HALF + m * 16) * ldc + col0;
#pragma unroll
                for (int bj = 0; bj < 2; ++bj) { const f32x4 v0 = acc[ai][bj][m][0], v1 = acc[ai][bj][m][1];
                    u32x4 w; w.x = cvt_pk_bf16(v0[0], v0[1]); w.y = cvt_pk_bf16(v0[2], v0[3]); w.z = cvt_pk_bf16(v1[0], v1[1]); w.w = cvt_pk_bf16(v1[2], v1[3]);
                    *(u32x4*)(rowp + bj * HALF) = w; } }
    }
};
struct EpiF32 {
    static constexpr bool PERM = false; static constexpr int HOOK_T = 0;
    float* O; int ldc;
    __device__ __forceinline__ void operator()(const f32x4 (&acc)[2][2][4][2], const Unit& u, int wr, int wc, int fr, int fq) const {
        const int row0 = u.pm * BM + wr * 64 + fr; const int col0 = u.pn * BM + wc * 32 + 4 * fq;
#pragma unroll
        for (int ai = 0; ai < 2; ++ai)
#pragma unroll
            for (int m = 0; m < 4; ++m) { float* rowp = O + (size_t)(row0 + ai * HALF + m * 16) * ldc + col0;
#pragma unroll
                for (int bj = 0; bj < 2; ++bj)
#pragma unroll
                    for (int n = 0; n < 2; ++n) *(f32x4*)(rowp + bj * HALF + n * 16) = acc[ai][bj][m][n]; }
    }
};
struct EpiGate {
    static constexpr bool PERM = false; static constexpr int HOOK_T = 0;
    float* O;
    __device__ __forceinline__ void operator()(const f32x4 (&acc)[2][2][4][2], const Unit& u, int wr, int wc, int fr, int fq) const {
        const int row0 = u.pm * BM + wr * 64 + fr; const int col0 = wc * 32 + 4 * fq;
#pragma unroll
        for (int ai = 0; ai < 2; ++ai)
#pragma unroll
            for (int m = 0; m < 4; ++m) { float* rowp = O + (size_t)(row0 + ai * HALF + m * 16) * 128 + col0;
#pragma unroll
                for (int n = 0; n < 2; ++n) *(f32x4*)(rowp + n * 16) = acc[ai][0][m][n] + acc[ai][1][m][n]; }
    }
};
template <bool ADD> struct EpiMerge {
    static constexpr bool PERM = true; static constexpr int HOOK_T = 0;
    bf16_t* O; int ldc; const bf16_t* G; int ldg;
    __device__ __forceinline__ void operator()(const f32x4 (&acc)[2][2][4][2], const Unit& u, int wr, int wc, int fr, int fq) const {
        const int row0 = u.pm * BM + wr * 64 + fr; const int col0 = u.pn * BM + wc * 32 + 8 * fq;
#pragma unroll
        for (int ai = 0; ai < 2; ++ai)
#pragma unroll
            for (int m = 0; m < 4; ++m) { const size_t r = (size_t)(row0 + ai * HALF + m * 16);
#pragma unroll
                for (int bj = 0; bj < 2; ++bj) { const f32x4 v0 = acc[ai][bj][m][0], v1 = acc[ai][bj][m][1];
                    const u32x4 gw = *(const u32x4*)(G + r * ldg + col0 + bj * HALF);
                    float o[8];
                    o[0] = sigmoidf_(bf_lo(gw.x)) * v0[0]; o[1] = sigmoidf_(bf_hi(gw.x)) * v0[1]; o[2] = sigmoidf_(bf_lo(gw.y)) * v0[2]; o[3] = sigmoidf_(bf_hi(gw.y)) * v0[3];
                    o[4] = sigmoidf_(bf_lo(gw.z)) * v1[0]; o[5] = sigmoidf_(bf_hi(gw.z)) * v1[1]; o[6] = sigmoidf_(bf_lo(gw.w)) * v1[2]; o[7] = sigmoidf_(bf_hi(gw.w)) * v1[3];
                    bf16_t* op = O + r * ldc + col0 + bj * HALF;
                    if (ADD) { const u32x4 pw = *(const u32x4*)op;
                        o[0] += bf_lo(pw.x); o[1] += bf_hi(pw.x); o[2] += bf_lo(pw.y); o[3] += bf_hi(pw.y); o[4] += bf_lo(pw.z); o[5] += bf_hi(pw.z); o[6] += bf_lo(pw.w); o[7] += bf_hi(pw.w); }
                    u32x4 w; w.x = cvt_pk_bf16(o[0], o[1]); w.y = cvt_pk_bf16(o[2], o[3]); w.z = cvt_pk_bf16(o[4], o[5]); w.w = cvt_pk_bf16(o[6], o[7]);
                    *(u32x4*)op = w; } }
    }
};
struct EpiYStat {
    static constexpr bool PERM = true; static constexpr int HOOK_T = 0;
    bf16_t* O; int ldc; PG8_LAS float* part;
    __device__ __forceinline__ void operator()(const f32x4 (&acc)[2][2][4][2], const Unit& u, int wr, int wc, int fr, int fq) const {
        const int row0 = u.pm * BM + wr * 64 + fr; const int col0 = u.pn * BM + wc * 32 + 8 * fq;
#pragma unroll
        for (int ai = 0; ai < 2; ++ai)
#pragma unroll
            for (int m = 0; m < 4; ++m) { bf16_t* rowp = O + (size_t)(row0 + ai * HALF + m * 16) * ldc + col0; float s = 0.f;
#pragma unroll
                for (int bj = 0; bj < 2; ++bj) { const f32x4 v0 = acc[ai][bj][m][0], v1 = acc[ai][bj][m][1];
                    u32x4 w; w.x = cvt_pk_bf16(v0[0], v0[1]); w.y = cvt_pk_bf16(v0[2], v0[3]); w.z = cvt_pk_bf16(v1[0], v1[1]); w.w = cvt_pk_bf16(v1[2], v1[3]);
                    *(u32x4*)(rowp + bj * HALF) = w;
                    s += (bf_lo(w.x) * bf_lo(w.x) + bf_hi(w.x) * bf_hi(w.x)) + (bf_lo(w.y) * bf_lo(w.y) + bf_hi(w.y) * bf_hi(w.y)) + (bf_lo(w.z) * bf_lo(w.z) + bf_hi(w.z) * bf_hi(w.z)) + (bf_lo(w.w) * bf_lo(w.w) + bf_hi(w.w) * bf_hi(w.w)); }
                s += __shfl_xor(s, 16); s += __shfl_xor(s, 32);
                if (fq == 0) part[(ai * HALF + wr * 64 + m * 16 + fr) * 16 + wc * 4 + u.pn] = s; }
    }
};
struct EpiYStatG {
    static constexpr bool PERM = true; static constexpr int HOOK_T = 0;
    bf16_t* O; int ldc; float* part;
    __device__ __forceinline__ void operator()(const f32x4 (&acc)[2][2][4][2], const Unit& u, int wr, int wc, int fr, int fq) const {
        const int row0 = u.pm * BM + wr * 64 + fr; const int col0 = u.pn * BM + wc * 32 + 8 * fq;
#pragma unroll
        for (int ai = 0; ai < 2; ++ai)
#pragma unroll
            for (int m = 0; m < 4; ++m) { bf16_t* rowp = O + (size_t)(row0 + ai * HALF + m * 16) * ldc + col0; float s = 0.f;
#pragma unroll
                for (int bj = 0; bj < 2; ++bj) { const f32x4 v0 = acc[ai][bj][m][0], v1 = acc[ai][bj][m][1];
                    u32x4 w; w.x = cvt_pk_bf16(v0[0], v0[1]); w.y = cvt_pk_bf16(v0[2], v0[3]); w.z = cvt_pk_bf16(v1[0], v1[1]); w.w = cvt_pk_bf16(v1[2], v1[3]);
                    *(u32x4*)(rowp + bj * HALF) = w;
                    s += (bf_lo(w.x) * bf_lo(w.x) + bf_hi(w.x) * bf_hi(w.x)) + (bf_lo(w.y) * bf_lo(w.y) + bf_hi(w.y) * bf_hi(w.y)) + (bf_lo(w.z) * bf_lo(w.z) + bf_hi(w.z) * bf_hi(w.z)) + (bf_lo(w.w) * bf_lo(w.w) + bf_hi(w.w) * bf_hi(w.w)); }
                s += __shfl_xor(s, 16); s += __shfl_xor(s, 32);
                if (fq == 0) part[(size_t)(row0 + ai * HALF + m * 16) * 16 + wc * 4 + u.pn] = s; }
    }
};
struct EpiMergeFused {
    static constexpr bool PERM = true; static constexpr int HOOK_T = 8;
    bf16_t* O; int ldc; const bf16_t* G; int ldg;
    struct GOps { u32x4 ga[2], gb[2]; };
    __device__ __forceinline__ void loadg(GOps& o, size_t r, int col0, bool both) const {
#pragma unroll
        for (int bj = 0; bj < 2; ++bj) { if (both) o.ga[bj] = __builtin_nontemporal_load((const u32x4*)(G + r * ldg + col0 + bj * HALF)); o.gb[bj] = *(const u32x4*)(G + r * ldg + 1024 + col0 + bj * HALF); }
    }
    __device__ __forceinline__ void mid(f32x4 (&acc)[2][2][4][2], const Unit& u, int wr, int wc, int fr, int fq) const {
        asm volatile("" : "+v"(fr), "+v"(fq));
        const int row0 = u.pm * BM + wr * 64 + fr; const int col0 = u.pn * BM + wc * 32 + 8 * fq;
        GOps A, B; loadg(A, (size_t)row0, col0, true);
#pragma unroll
        for (int g = 0; g < 8; ++g) { const int ai = g >> 2, m = g & 3; GOps& cur = (g & 1) ? B : A; GOps& nxt = (g & 1) ? A : B;
            if (g < 7) loadg(nxt, (size_t)(row0 + ((g + 1) >> 2) * HALF + ((g + 1) & 3) * 16), col0, true);
            __builtin_amdgcn_sched_barrier(0);
#pragma unroll
            for (int bj = 0; bj < 2; ++bj) { const u32x4 ga = cur.ga[bj], gb = cur.gb[bj];
#define MQ_(wa, wb, HI) ((1.0f + __builtin_amdgcn_exp2f(fmaxf(HI ? bf_hi(wb) : bf_lo(wb), -80.f) * -1.4426950408889634f)) * __builtin_amdgcn_rcpf(1.0f + __builtin_amdgcn_exp2f((HI ? bf_hi(wa) : bf_lo(wa)) * -1.4426950408889634f)))
                acc[ai][bj][m][0][0] *= MQ_(ga.x, gb.x, 0); acc[ai][bj][m][0][1] *= MQ_(ga.x, gb.x, 1); acc[ai][bj][m][0][2] *= MQ_(ga.y, gb.y, 0); acc[ai][bj][m][0][3] *= MQ_(ga.y, gb.y, 1);
                acc[ai][bj][m][1][0] *= MQ_(ga.z, gb.z, 0); acc[ai][bj][m][1][1] *= MQ_(ga.z, gb.z, 1); acc[ai][bj][m][1][2] *= MQ_(ga.w, gb.w, 0); acc[ai][bj][m][1][3] *= MQ_(ga.w, gb.w, 1);
#undef MQ_
            }
            __builtin_amdgcn_sched_barrier(0); }
    }
    __device__ __forceinline__ void operator()(const f32x4 (&acc)[2][2][4][2], const Unit& u, int wr, int wc, int fr, int fq) const {
        asm volatile("" : "+v"(fr), "+v"(fq));
        const int row0 = u.pm * BM + wr * 64 + fr; const int col0 = u.pn * BM + wc * 32 + 8 * fq;
        GOps A, B; loadg(A, (size_t)row0, col0, false);
#pragma unroll
        for (int g = 0; g < 8; ++g) { const int ai = g >> 2, m = g & 3; const size_t r = (size_t)(row0 + ai * HALF + m * 16); GOps& cur = (g & 1) ? B : A; GOps& nxt = (g & 1) ? A : B;
            if (g < 7) loadg(nxt, (size_t)(row0 + ((g + 1) >> 2) * HALF + ((g + 1) & 3) * 16), col0, false);
            __builtin_amdgcn_sched_barrier(0);
#pragma unroll
            for (int bj = 0; bj < 2; ++bj) { const f32x4 v0 = acc[ai][bj][m][0], v1 = acc[ai][bj][m][1]; const u32x4 gw = cur.gb[bj];
                u32x4 w; w.x = cvt_pk_bf16(sigmoidf_(fmaxf(bf_lo(gw.x), -80.f)) * v0[0], sigmoidf_(fmaxf(bf_hi(gw.x), -80.f)) * v0[1]); w.y = cvt_pk_bf16(sigmoidf_(fmaxf(bf_lo(gw.y), -80.f)) * v0[2], sigmoidf_(fmaxf(bf_hi(gw.y), -80.f)) * v0[3]);
                w.z = cvt_pk_bf16(sigmoidf_(fmaxf(bf_lo(gw.z), -80.f)) * v1[0], sigmoidf_(fmaxf(bf_hi(gw.z), -80.f)) * v1[1]); w.w = cvt_pk_bf16(sigmoidf_(fmaxf(bf_lo(gw.w), -80.f)) * v1[2], sigmoidf_(fmaxf(bf_hi(gw.w), -80.f)) * v1[3]);
                *(u32x4*)(O + r * ldc + col0 + bj * HALF) = w; }
            __builtin_amdgcn_sched_barrier(0); }
    }
};
struct EpiFinal {
    static constexpr bool PERM = false; static constexpr int HOOK_T = 4;
    float* out; const bf16_t* h; u32x4* park; int ldc, ldh, tid;
    struct Ops { u32x2 hw[4]; u32x4 ew[2]; };
    __device__ __forceinline__ void load(Ops& o, size_t r, int col0, int g) const {
#pragma unroll
        for (int q = 0; q < 4; ++q) { const int c = col0 + (q >> 1) * HALF + (q & 1) * 16; o.hw[q] = *(const u32x2*)(h + r * ldh + c); }
        o.ew[0] = park[(g * 2 + 0) * 512 + tid]; o.ew[1] = park[(g * 2 + 1) * 512 + tid];
    }
    __device__ __forceinline__ void mid(f32x4 (&acc)[2][2][4][2], const Unit& u, int wr, int wc, int fr, int fq) const {
#pragma unroll
        for (int g = 0; g < 8; ++g) { const int ai = g >> 2, m = g & 3;
#pragma unroll
            for (int bj = 0; bj < 2; ++bj) { const f32x4 a0 = acc[ai][bj][m][0], a1 = acc[ai][bj][m][1];
                park[(g * 2 + bj) * 512 + tid] = (u32x4){cvt_pk_bf16(a0[0], a0[1]), cvt_pk_bf16(a0[2], a0[3]), cvt_pk_bf16(a1[0], a1[1]), cvt_pk_bf16(a1[2], a1[3])};
                acc[ai][bj][m][0] = (f32x4){0.f, 0.f, 0.f, 0.f}; acc[ai][bj][m][1] = (f32x4){0.f, 0.f, 0.f, 0.f}; } }
    }
    __device__ __forceinline__ void operator()(const f32x4 (&acc)[2][2][4][2], const Unit& u, int wr, int wc, int fr, int fq) const {
        asm volatile("" : "+v"(fr), "+v"(fq));
        const int row0 = u.pm * BM + wr * 64 + fr; const int col0 = u.pn * BM + wc * 32 + 4 * fq;
        Ops O[3];
        load(O[0], (size_t)row0, col0, 0); load(O[1], (size_t)(row0 + 16), col0, 1);
#pragma unroll
        for (int g = 0; g < 8; ++g) { const int ai = g >> 2, m = g & 3; const size_t r = (size_t)(row0 + ai * HALF + m * 16);
            Ops& cur = O[g % 3];
            if (g < 6) load(O[(g + 2) % 3], (size_t)(row0 + ((g + 2) >> 2) * HALF + ((g + 2) & 3) * 16), col0, g + 2);
            __builtin_amdgcn_sched_barrier(0);
#pragma unroll
            for (int q = 0; q < 4; ++q) { const int bj = q >> 1, n = q & 1; const f32x4 a = acc[ai][bj][m][n]; const u32x2 hw = cur.hw[q]; const unsigned e0 = n ? cur.ew[bj].z : cur.ew[bj].x, e1 = n ? cur.ew[bj].w : cur.ew[bj].y; f32x4 o;
                o[0] = bf_lo(hw.x) + sigmoidf_(a[0]) * bf_lo(e0);
                o[1] = bf_hi(hw.x) + sigmoidf_(a[1]) * bf_hi(e0);
                o[2] = bf_lo(hw.y) + sigmoidf_(a[2]) * bf_lo(e1);
                o[3] = bf_hi(hw.y) + sigmoidf_(a[3]) * bf_hi(e1);
                PG8_NTSTORE((f32x4*)(out + r * ldc + col0 + bj * HALF + n * 16), o); }
            __builtin_amdgcn_sched_barrier(0); }
    }
};
}
#define GAS __attribute__((address_space(1)))
#define LAS __attribute__((address_space(3)))
typedef unsigned short bf16;
typedef unsigned v4u __attribute__((ext_vector_type(4)));
typedef unsigned v2u __attribute__((ext_vector_type(2)));
typedef float f32x4 __attribute__((ext_vector_type(4)));

constexpr int NWAVES = 8, NTHR = 512;
constexpr int BATCH = 16, SEQ = 4096, DM = 1024, M = BATCH * SEQ;
constexpr int NH = 8, HD = 64, AW = 512, PLE = 256;
constexpr int RWC = 2176, INC = 6272, INCP = 6400;
constexpr int NBLK = 16, BLK = 256;
constexpr float RMS_EPS = 1e-6f, GN_EPS = 64e-5f;
constexpr float LOG2E = 1.4426950408889634f;
constexpr float QSCALE = 0.125f * LOG2E;

constexpr size_t MiB = 1u << 20;
constexpr size_t WS_WIN = 2 * MiB;
constexpr size_t WS_WG = 16 * MiB;
constexpr size_t WS_PAB = 32 * MiB;
constexpr size_t WS_WOUT = 34 * MiB;
constexpr size_t WS_WPG = 36 * MiB;
constexpr int ACP = 1280;
constexpr size_t WS_RSY = 39 * MiB;
constexpr size_t WS_UBAR = 40 * MiB, WS_KMEAN = 41 * MiB;
constexpr size_t WS_PARTS = 42 * MiB;
constexpr size_t WS_GATE = 74 * MiB;
constexpr int WINP = 1088;
constexpr int QP = 2112, GP = 2112;
constexpr size_t WS_QKVZ = 138 * MiB;
constexpr size_t WS_RW = 402 * MiB;
constexpr size_t WS_GAB = 674 * MiB;
constexpr size_t WS_END = 1004 * MiB;
constexpr size_t WS_CNT = 0;
constexpr size_t WS_QCTR = 16384;
constexpr size_t WS_WUPT = 39 * MiB + 512 * 1024, WS_AUPT = WS_WUPT + 65536;
constexpr size_t WS_BON = 938 * MiB;
constexpr size_t WS_SC = 940 * MiB;
constexpr size_t DO_PARTO = 0, DO_PARTML = 192 * MiB;
constexpr size_t WS_LISTS = 46 * MiB;

__device__ const unsigned char T5B[128] = {0, 1, 2, 3, 4, 5, 6, 7, 8, 9, 10, 11, 12, 13, 14, 15, 16, 16, 16, 17, 17, 18, 18, 18, 19, 19, 19, 20, 20, 20, 20, 21, 21, 21, 21, 22, 22, 22, 22, 22, 23, 23, 23, 23, 23, 23, 24, 24, 24, 24, 24, 24, 25, 25, 25, 25, 25, 25, 25, 26, 26, 26, 26, 26, 26, 26, 26, 27, 27, 27, 27, 27, 27, 27, 27, 27, 27, 28, 28, 28, 28, 28, 28, 28, 28, 28, 28, 29, 29, 29, 29, 29, 29, 29, 29, 29, 29, 29, 29, 30, 30, 30, 30, 30, 30, 30, 30, 30, 30, 30, 30, 30, 30, 31, 31, 31, 31, 31, 31, 31, 31, 31, 31, 31, 31, 31, 31, 31};

typedef float f32x2_cv __attribute__((ext_vector_type(2))); typedef __bf16 bf16x2_cv __attribute__((ext_vector_type(2)));
__device__ __forceinline__ unsigned pk2(float lo, float hi) { f32x2_cv v = {lo, hi}; bf16x2_cv b = __builtin_convertvector(v, bf16x2_cv); return __builtin_bit_cast(unsigned, b); }
__device__ __forceinline__ unsigned f2bf(float f) { return pk2(f, 0.f) & 0xffffu; }
__device__ __forceinline__ float bf2f(unsigned short h) { return __uint_as_float((unsigned)h << 16); }
__device__ __forceinline__ float wave_sum(float v) {
#pragma unroll
    for (int o = 1; o < 64; o <<= 1) v += __shfl_xor(v, o);
    return v;
}
__device__ __forceinline__ float fexp2(float x) { return __builtin_amdgcn_exp2f(x); }
__device__ __forceinline__ float fexp(float x) { return __builtin_amdgcn_exp2f(x * LOG2E); }
__device__ __forceinline__ float frcp(float x) { return __builtin_amdgcn_rcpf(x); }
__device__ __forceinline__ float frsq(float x) { return __builtin_amdgcn_rsqf(x); }
__device__ __forceinline__ float sigm(float x) { return frcp(1.0f + fexp2(-x * LOG2E)); }
__device__ __forceinline__ float ftanh(float x) { return 1.0f - 2.0f * frcp(1.0f + fexp2(x * (2.0f * LOG2E))); }
__device__ __forceinline__ float dpp_sum32(float v) {
#define DPP_ADD_(ctrl, rmask) v += __builtin_bit_cast(float, __builtin_amdgcn_update_dpp(0, __builtin_bit_cast(int, v), ctrl, rmask, 0xf, true))
    DPP_ADD_(0x118, 0xf); DPP_ADD_(0x114, 0xf); DPP_ADD_(0x112, 0xf); DPP_ADD_(0x111, 0xf);
    v += __builtin_bit_cast(float, __builtin_amdgcn_update_dpp(0, __builtin_bit_cast(int, v), 0x142, 0xa, 0xf, false));
#undef DPP_ADD_
    return v;
}

struct Args {
    const float* in[21]; float* out; unsigned char* ws; int ph_lo, ph_hi;
};
struct Frame {
    LAS unsigned char* lds; int tid, lane, wave, vcu, G;
    const float *x, *p, *g_pre, *w_in, *rel_bias, *mu, *w0, *w_up, *a0, *a_up, *k_k, *k_a, *r_k, *ln_w, *ln_b, *p_a, *p_b, *w_out, *g_post, *w_pu, *w_pg;
    float* out; unsigned char* ws;
};

__device__ __forceinline__ float wave_sum_fast(float v) { v = dpp_sum32(v); return __builtin_bit_cast(float, __builtin_amdgcn_readlane(__builtin_bit_cast(int, v), 31)) + __builtin_bit_cast(float, __builtin_amdgcn_readlane(__builtin_bit_cast(int, v), 63)); }
constexpr size_t WS_BAR = 32768;
#define XB_TMO      128
#define XB_XCNT(j)  (256  + 64 * (j))
#define XB_XSUB(j)  (1280 + 64 * (j))
#define XB_XGEN(j)  (2304 + 64 * (j))
#define XB_TOP      3328
#define XB_TOPGEN   3392
#define XB_SPIN_CAP (1u << 20)
__device__ __forceinline__ unsigned xb_ld(unsigned* p)              { return __hip_atomic_load(p, __ATOMIC_RELAXED, __HIP_MEMORY_SCOPE_AGENT); }
__device__ __forceinline__ unsigned xb_add(unsigned* p, unsigned v) { return __hip_atomic_fetch_add(p, v, __ATOMIC_RELAXED, __HIP_MEMORY_SCOPE_AGENT); }
__device__ __forceinline__ unsigned xb_xcc_id() { return (unsigned)__builtin_amdgcn_s_getreg((3 << 11) | 20) & 0xFu; }
#define XB_SPIN(cond, bar) do { unsigned _sp = 0; while (cond) { __builtin_amdgcn_s_sleep(1); \
    if ((++_sp & 255u) == 0u) { if (xb_ld(&(bar)[XB_TMO])) break; if (_sp > XB_SPIN_CAP) { atomicAdd(&(bar)[XB_TMO], 1u); break; } } } } while (0)
__device__ __forceinline__ void xcd_barrier_post(unsigned* bar) { if (threadIdx.x == 0) (void)xb_add(&bar[XB_XCNT(xb_xcc_id())], 1u); }
__device__ __forceinline__ void xcd_barrier_complete(unsigned* bar, unsigned x, unsigned& nloc, unsigned& nx) {
    const unsigned G = gridDim.x * gridDim.y * gridDim.z;
    unsigned sum, cnt, mine, sp = 0u;
    for (;;) {
        sum = 0u; cnt = 0u; mine = 0u;
#pragma unroll
        for (unsigned j = 0; j < 16; ++j) { const unsigned c = xb_ld(&bar[XB_XCNT(j)]); sum += c; cnt += (c > 0u) ? 1u : 0u; mine = (j == x) ? c : mine; }
        if (sum == G) break;
        __builtin_amdgcn_s_sleep(1);
        if ((++sp & 255u) == 0u) { if (xb_ld(&bar[XB_TMO])) break; if (sp > XB_SPIN_CAP) { atomicAdd(&bar[XB_TMO], 1u); break; } }
    }
    nloc = mine > 0u ? mine : 1u; nx = cnt > 0u ? cnt : 1u;
}
__device__ __forceinline__ void xcd_barrier(unsigned* bar, volatile LAS unsigned* st) {
    asm volatile("s_waitcnt vmcnt(0)" ::: "memory");
    __syncthreads();
    if (threadIdx.x == 0) {
        const unsigned x = xb_xcc_id();
        __builtin_amdgcn_s_waitcnt(0);
        unsigned nloc = st[0], nx = st[1];
        if (nloc == 0u) { xcd_barrier_complete(bar, x, nloc, nx); st[0] = nloc; st[1] = nx; }
        const unsigned old = xb_add(&bar[XB_XSUB(x)], 1u);
        const unsigned gen = old / nloc;
        if (old + 1u == (gen + 1u) * nloc) {
            __builtin_amdgcn_fence(__ATOMIC_RELEASE, "agent");
            asm volatile("s_waitcnt vmcnt(0)" ::: "memory");
            const unsigned og = xb_add(&bar[XB_TOP], 1u);
            const unsigned tg = og / nx;
            if (og + 1u == (tg + 1u) * nx) xb_add(&bar[XB_TOPGEN], 1u);
            else XB_SPIN(xb_ld(&bar[XB_TOPGEN]) == tg, bar);
            __builtin_amdgcn_fence(__ATOMIC_ACQUIRE, "agent");
            xb_add(&bar[XB_XGEN(x)], 1u);
            asm volatile("s_waitcnt vmcnt(0)" ::: "memory");
        } else {
            XB_SPIN(xb_ld(&bar[XB_XGEN(x)]) == gen, bar);
            __builtin_amdgcn_fence(__ATOMIC_ACQUIRE, "agent");
            asm volatile("s_waitcnt vmcnt(0)" ::: "memory");
        }
    }
    __syncthreads();
}

__device__ __forceinline__ void transpose_item(const float* W, int N, int k0, int n0, bf16* WT, int ldw, int drow0, int koff, LAS float* scr, int lane) {
    float t[32];
#pragma unroll
    for (int i = 0; i < 32; ++i) t[i] = W[(size_t)(k0 + 2 * i + (lane >> 5)) * N + n0 + (lane & 31)];
#pragma unroll
    for (int i = 0; i < 32; ++i) scr[(2 * i + (lane >> 5)) * 33 + (lane & 31)] = t[i];
    asm volatile("s_waitcnt lgkmcnt(0)" ::: "memory");
    const int c = lane & 7;
#pragma unroll
    for (int j = 0; j < 4; ++j) { const int n = (lane >> 3) + 8 * j; const LAS float* s = scr + (8 * c) * 33 + n;
        v4u o; o.x = pk2(s[0 * 33], s[1 * 33]); o.y = pk2(s[2 * 33], s[3 * 33]); o.z = pk2(s[4 * 33], s[5 * 33]); o.w = pk2(s[6 * 33], s[7 * 33]);
        *(v4u*)(WT + (size_t)(drow0 + n) * ldw + koff + k0 + 8 * c) = o; }
    asm volatile("s_waitcnt lgkmcnt(0)" ::: "memory");
}

__device__ __forceinline__ void pro_side(Frame& F, int part, int gw, int ngw, int lt, int nlt) {
    LAS float* scr = (LAS float*)(F.lds + F.wave * 16384);
    bf16* WinT = (bf16*)(F.ws + WS_WIN); bf16* PabT = (bf16*)(F.ws + WS_PAB); bf16* WoutT = (bf16*)(F.ws + WS_WOUT); bf16* WpgT = (bf16*)(F.ws + WS_WPG);
    if (part == 0) {
        constexpr int I_IN = 16 * (INC / 32), I_PA = 8 * 32, I_PB = 8 * 32, I_WO = 16 * 32, I_PG = 16 * 32, I_PU = 4 * 32, I_UP = 16;
        constexpr int NIT = I_IN + I_PA + I_PB + I_WO + I_PG + I_PU + 2 * I_UP;
        for (int it = gw; it < NIT; it += ngw) {
            int r = it;
            if (r < I_IN) { const int nb = r % (INC / 32), kb = r / (INC / 32), n0 = nb * 32;
                const int d0 = n0 < 4096 ? n0 : (n0 < 4224 ? n0 + 2048 : n0 - 128);
                transpose_item(F.w_in, INC, kb * 64, n0, WinT, WINP, d0, 0, scr, F.lane); continue; } r -= I_IN;
            if (r < I_PA) { transpose_item(F.p_a, DM, (r / 32) * 64, (r % 32) * 32, PabT, 1024, (r % 32) * 32, 0, scr, F.lane); continue; } r -= I_PA;
            if (r < I_PB) { transpose_item(F.p_b, DM, (r / 32) * 64, (r % 32) * 32, PabT, 1024, (r % 32) * 32, 512, scr, F.lane); continue; } r -= I_PB;
            if (r < I_WO) { transpose_item(F.w_out, DM, (r / 32) * 64, (r % 32) * 32, WoutT, 1024, (r % 32) * 32, 0, scr, F.lane); continue; } r -= I_WO;
            if (r < I_PG) { transpose_item(F.w_pg, DM, (r / 32) * 64, (r % 32) * 32, WpgT, ACP, (r % 32) * 32, PLE, scr, F.lane); continue; } r -= I_PG;
            if (r < I_PU) { transpose_item(F.w_pu, DM, (r / 32) * 64, (r % 32) * 32, WpgT, ACP, (r % 32) * 32, 0, scr, F.lane); continue; } r -= I_PU;
            if (r < I_UP) { transpose_item(F.w_up, AW, 0, r * 32, (bf16*)(F.ws + WS_WUPT), 64, r * 32, 0, scr, F.lane); continue; } r -= I_UP;
            transpose_item(F.a_up, AW, 0, r * 32, (bf16*)(F.ws + WS_AUPT), 64, r * 32, 0, scr, F.lane);
        }
        for (int i = gw * 64 + F.lane; i < 128 * WINP / 8; i += ngw * 64) *(v4u*)(WinT + (size_t)INC * WINP + (size_t)i * 8) = (v4u){0u, 0u, 0u, 0u};
    }
}
__device__ __forceinline__ void p0_xpass(Frame& F) {
    LAS float* red = (LAS float*)F.lds;
    bf16* U2 = (bf16*)F.out; float* UBAR = (float*)(F.ws + WS_UBAR);
    for (int blk = F.vcu; blk < M / BLK; blk += F.G) {
        float cs[16];
#pragma unroll
        for (int i = 0; i < 16; ++i) cs[i] = 0.f;
        f32x4 gv[4];
#pragma unroll
        for (int j = 0; j < 4; ++j) gv[j] = *((const f32x4*)F.g_pre + F.lane + 64 * j);
        for (int i = 0; i < 8; ++i) {
            f32x4 v[4][4];
#pragma unroll
            for (int r = 0; r < 4; ++r) { const f32x4* xr = (const f32x4*)(F.x + ((size_t)blk * BLK + F.wave + 8 * (4 * i + r)) * DM) + F.lane;
#pragma unroll
                for (int j = 0; j < 4; ++j) v[r][j] = __builtin_nontemporal_load(xr + 64 * j); }
#pragma unroll
            for (int r = 0; r < 4; ++r) { const size_t row = (size_t)blk * BLK + F.wave + 8 * (4 * i + r); float s = 0.f;
#pragma unroll
                for (int j = 0; j < 4; ++j) s += (v[r][j][0] * v[r][j][0] + v[r][j][1] * v[r][j][1]) + (v[r][j][2] * v[r][j][2] + v[r][j][3] * v[r][j][3]);
                const float rs = frsq(wave_sum_fast(s) * (1.f / DM) + RMS_EPS);
#pragma unroll
                for (int j = 0; j < 4; ++j) {
                    float u[4]; unsigned h[4], l[4];
#pragma unroll
                    for (int e = 0; e < 4; ++e) { u[e] = v[r][j][e] * rs * gv[j][e]; cs[j * 4 + e] += u[e]; h[e] = f2bf(u[e]); l[e] = f2bf(u[e] - __uint_as_float(h[e] << 16)); }
                    const int col = 4 * F.lane + 256 * j;
                    *(v2u*)(U2 + row * 2048 + col) = (v2u){h[0] | (h[1] << 16), h[2] | (h[3] << 16)};
                    *(v2u*)(U2 + row * 2048 + 1024 + col) = (v2u){l[0] | (l[1] << 16), l[2] | (l[3] << 16)};
                } }
        }
        __syncthreads();
#pragma unroll
        for (int j = 0; j < 4; ++j)
#pragma unroll
            for (int e = 0; e < 4; ++e) red[F.wave * 1024 + 4 * F.lane + 256 * j + e] = cs[j * 4 + e];
        __syncthreads();
        for (int k = F.tid; k < 1024; k += NTHR) { float s = 0.f;
#pragma unroll
            for (int w = 0; w < 8; ++w) s += red[w * 1024 + k];
            UBAR[(size_t)blk * 1024 + k] = s * (1.f / BLK); }
    }
    __syncthreads();
}
__device__ __forceinline__ void p0_kmean(Frame& F) {
    LAS float* ub = (LAS float*)F.lds;
    LAS float* red = (LAS float*)(F.lds + 65536);
    const float* UBAR = (const float*)(F.ws + WS_UBAR); float* KMEAN = (float*)(F.ws + WS_KMEAN);
    for (int item = F.vcu; item < BATCH * 16; item += F.G) { const int bi = item >> 4, j = item & 15;
        __syncthreads();
        const int col = F.lane & 31, kp = F.lane >> 5, kb = F.wave * 128 + kp * 64;
        const float* wp = F.w_in + (size_t)kb * INC + 512 + 32 * j + col;
        float w[64];
#pragma unroll
        for (int i = 0; i < 64; ++i) w[i] = wp[(size_t)i * INC];
        for (int i = F.tid; i < 16 * 1024 / 4; i += NTHR) *(LAS f32x4*)(ub + 4 * i) = *(const f32x4*)(UBAR + (size_t)bi * 16 * 1024 + 4 * i);
        __syncthreads();
        float acc[16];
#pragma unroll
        for (int n = 0; n < 16; ++n) acc[n] = 0.f;
#pragma unroll
        for (int i = 0; i < 64; i += 4)
#pragma unroll
            for (int n = 0; n < 16; ++n) { const f32x4 u4 = *(const LAS f32x4*)(ub + n * 1024 + kb + i); acc[n] += (u4[0] * w[i] + u4[1] * w[i + 1]) + (u4[2] * w[i + 2] + u4[3] * w[i + 3]); }
#pragma unroll
        for (int n = 0; n < 16; ++n) red[((F.wave * 2 + kp) * 16 + n) * 32 + col] = acc[n];
        __syncthreads();
        { const int n = F.tid >> 5, c = F.tid & 31; float s = 0.f;
#pragma unroll
          for (int p = 0; p < 16; ++p) s += red[(p * 16 + n) * 32 + c];
          KMEAN[(size_t)(bi * 16 + n) * 512 + 32 * j + c] = s; }
    }
    __syncthreads();
}
__device__ __forceinline__ void p0_gvec(Frame& F) {
    LAS float* km = (LAS float*)F.lds;
    LAS float* wt = (LAS float*)(F.lds + 32768 + F.wave * 8704);
    const float* KMEAN = (const float*)(F.ws + WS_KMEAN); bf16* WgT = (bf16*)(F.ws + WS_WG);
    for (int item = F.vcu; item < BATCH * 16; item += F.G) { const int bi = item >> 4, j = item & 15, h = F.wave;
        __syncthreads();
        for (int i = F.tid; i < 16 * 512 / 4; i += NTHR) *(LAS f32x4*)(km + 4 * i) = *(const f32x4*)(KMEAN + (size_t)bi * 16 * 512 + 4 * i);
        __syncthreads();
#pragma unroll 1
        for (int p = 0; p < 2; ++p) {
            f32x4 t[8];
#pragma unroll
            for (int i = 0; i < 8; ++i) t[i] = *(const f32x4*)(F.w_in + (size_t)(64 * j + 32 * p + 4 * i + (F.lane >> 4)) * INC + h * 64 + 4 * (F.lane & 15));
#pragma unroll
            for (int i = 0; i < 8; ++i) *(LAS f32x4*)(wt + (4 * i + (F.lane >> 4)) * 68 + 4 * (F.lane & 15)) = t[i];
            asm volatile("s_waitcnt lgkmcnt(0)" ::: "memory");
            const int r = F.lane & 31, hf = F.lane >> 5;
            float acc[8];
#pragma unroll
            for (int n = 0; n < 8; ++n) acc[n] = 0.f;
#pragma unroll
            for (int c = 0; c < 16; ++c) { const f32x4 wv = *(const LAS f32x4*)(wt + r * 68 + 4 * c);
#pragma unroll
                for (int n = 0; n < 8; ++n) { const f32x4 kv = *(const LAS f32x4*)(km + (8 * hf + n) * 512 + h * 64 + 4 * c); acc[n] += (wv[0] * kv[0] + wv[1] * kv[1]) + (wv[2] * kv[2] + wv[3] * kv[3]); } }
            asm volatile("s_waitcnt lgkmcnt(0)" ::: "memory");
            const int k = 64 * j + 32 * p + r;
#pragma unroll
            for (int n = 0; n < 8; ++n) { const float s = acc[n]; const unsigned hi = f2bf(s), lo = f2bf(s - __uint_as_float(hi << 16));
                bf16* r0 = WgT + ((size_t)bi * 256 + h * 16 + 8 * hf + n) * 2048; bf16* r1 = r0 + (size_t)128 * 2048;
                r0[k] = (bf16)hi; r0[1024 + k] = (bf16)hi; r1[k] = (bf16)lo; r1[1024 + k] = (bf16)lo; }
        }
    }
    __syncthreads();
}

template <typename PartPtr> __device__ __forceinline__ void panel_norm(Frame& F, int pm, const bf16* Y, bf16* H1, float* RSY, PartPtr part, int part_row0) {
    f32x4 gv[4];
#pragma unroll
    for (int j = 0; j < 4; ++j) gv[j] = *((const f32x4*)F.g_post + F.lane + 64 * j);
    for (int i = 0; i < 8; ++i) {
        v2u yw[4][4]; f32x4 xv[4][4], pv[4]; float rs[4];
#pragma unroll
        for (int r = 0; r < 4; ++r) { const int rl = F.wave * 32 + 4 * i + r; const size_t row = (size_t)pm * 256 + rl;
            const v2u* yr = (const v2u*)(Y + row * DM) + F.lane; const f32x4* xr = (const f32x4*)(F.x + row * DM) + F.lane;
#pragma unroll
            for (int j = 0; j < 4; ++j) { yw[r][j] = __builtin_nontemporal_load(yr + 64 * j); xv[r][j] = __builtin_nontemporal_load(xr + 64 * j); }
            pv[r] = __builtin_nontemporal_load((const f32x4*)(F.p + row * PLE) + F.lane);
            const auto* pp = part + (size_t)(part_row0 + rl) * 4; const f32x4 a = pp[0], b = pp[1], c = pp[2], d = pp[3];
            rs[r] = frsq((((a[0] + a[1]) + (a[2] + a[3])) + ((b[0] + b[1]) + (b[2] + b[3])) + ((c[0] + c[1]) + (c[2] + c[3])) + ((d[0] + d[1]) + (d[2] + d[3]))) * (1.f / DM) + RMS_EPS);
            if (F.lane == 0) RSY[row] = rs[r]; }
#pragma unroll
        for (int r = 0; r < 4; ++r) { const size_t row = (size_t)pm * 256 + F.wave * 32 + 4 * i + r;
            *(v2u*)(H1 + row * ACP + 4 * F.lane) = (v2u){pk2(pv[r][0], pv[r][1]), pk2(pv[r][2], pv[r][3])};
#pragma unroll
            for (int j = 0; j < 4; ++j) { const v2u w = yw[r][j]; const float yv[4] = {__uint_as_float(w.x << 16), __uint_as_float(w.x & 0xffff0000u), __uint_as_float(w.y << 16), __uint_as_float(w.y & 0xffff0000u)}; float h[4];
#pragma unroll
                for (int e = 0; e < 4; ++e) h[e] = xv[r][j][e] + yv[e] * rs[r] * gv[j][e];
                *(v2u*)(H1 + row * ACP + PLE + 4 * F.lane + 256 * j) = (v2u){pk2(h[0], h[1]), pk2(h[2], h[3])}; } }
    }
}

__device__ __forceinline__ void post_norm(Frame& F) {
    const bf16* Y = (const bf16*)(F.ws + WS_RW); float* RSY = (float*)(F.ws + WS_RSY); bf16* H1 = (bf16*)(F.ws + WS_QKVZ);
    const int gw = F.vcu * NWAVES + F.wave, NGW = F.G * NWAVES;
    f32x4 gv[4];
#pragma unroll
    for (int j = 0; j < 4; ++j) gv[j] = *((const f32x4*)F.g_post + F.lane + 64 * j);
    for (int row0 = gw * 4; row0 < M; row0 += NGW * 4) {
        v2u yw[4][4]; f32x4 xv[4][4];
#pragma unroll
        for (int r = 0; r < 4; ++r) { const v2u* yr = (const v2u*)(Y + (size_t)(row0 + r) * DM) + F.lane; const f32x4* xr = (const f32x4*)(F.x + (size_t)(row0 + r) * DM) + F.lane;
#pragma unroll
            for (int j = 0; j < 4; ++j) { yw[r][j] = yr[64 * j]; xv[r][j] = xr[64 * j]; } }
#pragma unroll
        for (int r = 0; r < 4; ++r) { f32x4 v[4]; float s = 0.f;
#pragma unroll
            for (int j = 0; j < 4; ++j) { const v2u w = yw[r][j]; v[j] = (f32x4){__uint_as_float(w.x << 16), __uint_as_float(w.x & 0xffff0000u), __uint_as_float(w.y << 16), __uint_as_float(w.y & 0xffff0000u)}; s += (v[j][0] * v[j][0] + v[j][1] * v[j][1]) + (v[j][2] * v[j][2] + v[j][3] * v[j][3]); }
            const float rs = frsq(wave_sum_fast(s) * (1.f / DM) + RMS_EPS);
            if (F.lane == 0) RSY[row0 + r] = rs;
#pragma unroll
            for (int j = 0; j < 4; ++j) { float h[4];
#pragma unroll
                for (int e = 0; e < 4; ++e) h[e] = xv[r][j][e] + v[j][e] * rs * gv[j][e];
                *(v2u*)(H1 + (size_t)(row0 + r) * DM + 4 * F.lane + 256 * j) = (v2u){pk2(h[0], h[1]), pk2(h[2], h[3])}; } }
    }
}
namespace moba {
using bf16x8 = __attribute__((ext_vector_type(8))) short;
using s16x4 = __attribute__((ext_vector_type(4))) short;
using f32x16 = __attribute__((ext_vector_type(16))) float;
using u32x4 = __attribute__((ext_vector_type(4))) unsigned;
typedef short v4i16_t __attribute__((ext_vector_type(4)));
typedef float f32x2_t __attribute__((ext_vector_type(2))); typedef __bf16 bf16x2_t __attribute__((ext_vector_type(2)));
__device__ __forceinline__ int crow(int r, int hi) { return (r & 3) + 8 * (r >> 2) + 4 * hi; }
__device__ __forceinline__ unsigned cvtpk(float lo, float hi) { f32x2_t v = {lo, hi}; bf16x2_t b = __builtin_convertvector(v, bf16x2_t); return __builtin_bit_cast(unsigned, b); }
__device__ __forceinline__ float max3f(float a, float b, float c) { return fmaxf(fmaxf(a, b), c); }

constexpr int SLOTB = 8192;
__device__ __forceinline__ void qkt(f32x16& p0, f32x16& p1, const LAS unsigned char* Kslot, const bf16x8* qr, int r32, int hi) {
    const LAS unsigned char* kb = Kslot + hi * 1024 + r32 * 16;
    const f32x16 z = {};
#pragma unroll
    for (int d0 = 0; d0 < 4; ++d0) {
        const bf16x8 b0 = *(const LAS bf16x8*)(kb + d0 * 2048);
        const bf16x8 b1 = *(const LAS bf16x8*)(kb + d0 * 2048 + 512);
        if (d0 == 0) { p0 = __builtin_amdgcn_mfma_f32_32x32x16_bf16(b0, qr[0], z, 0, 0, 0); p1 = __builtin_amdgcn_mfma_f32_32x32x16_bf16(b1, qr[0], z, 0, 0, 0); }
        else { p0 = __builtin_amdgcn_mfma_f32_32x32x16_bf16(b0, qr[d0], p0, 0, 0, 0); p1 = __builtin_amdgcn_mfma_f32_32x32x16_bf16(b1, qr[d0], p1, 0, 0, 0); } }
}
__device__ __forceinline__ void qkt_acc(f32x16& p0, f32x16& p1, const LAS unsigned char* Kslot, const bf16x8* qr, int r32, int hi) {
    const LAS unsigned char* kb = Kslot + hi * 1024 + r32 * 16;
#pragma unroll
    for (int d0 = 0; d0 < 4; ++d0) {
        const bf16x8 b0 = *(const LAS bf16x8*)(kb + d0 * 2048);
        const bf16x8 b1 = *(const LAS bf16x8*)(kb + d0 * 2048 + 512);
        p0 = __builtin_amdgcn_mfma_f32_32x32x16_bf16(b0, qr[d0], p0, 0, 0, 0); p1 = __builtin_amdgcn_mfma_f32_32x32x16_bf16(b1, qr[d0], p1, 0, 0, 0); }
}
__device__ __forceinline__ void pv(f32x16* o, int vb, bf16x8 pa0, bf16x8 pa1, bf16x8 pa2, bf16x8 pa3) {
#pragma unroll
    for (int d0 = 0; d0 < 2; ++d0) { s16x4 lo[4], hi[4];
#pragma unroll
        for (int ks = 0; ks < 4; ++ks) {
            asm volatile("ds_read_b64_tr_b16 %0,%1 offset:%c2" : "=&v"(lo[ks]) : "v"(vb), "i"(d0 * 4096 + ks * 1024) : "memory");
            asm volatile("ds_read_b64_tr_b16 %0,%1 offset:%c2" : "=&v"(hi[ks]) : "v"(vb), "i"(d0 * 4096 + ks * 1024 + 512) : "memory"); }
        asm volatile("s_waitcnt lgkmcnt(0)" ::: "memory"); __builtin_amdgcn_sched_barrier(0);
#define PK(k) (bf16x8){lo[k][0], lo[k][1], lo[k][2], lo[k][3], hi[k][0], hi[k][1], hi[k][2], hi[k][3]}
        o[d0] = __builtin_amdgcn_mfma_f32_32x32x16_bf16(pa0, PK(0), o[d0], 0, 0, 0);
        o[d0] = __builtin_amdgcn_mfma_f32_32x32x16_bf16(pa1, PK(1), o[d0], 0, 0, 0);
        o[d0] = __builtin_amdgcn_mfma_f32_32x32x16_bf16(pa2, PK(2), o[d0], 0, 0, 0);
        o[d0] = __builtin_amdgcn_mfma_f32_32x32x16_bf16(pa3, PK(3), o[d0], 0, 0, 0);
#undef PK
    }
}
__device__ __forceinline__ float rowmax2(const f32x16& p0, const f32x16& p1, float a) {
#pragma unroll
    for (int r = 0; r < 16; r += 2) { a = max3f(a, p0[r], p0[r + 1]); a = max3f(a, p1[r], p1[r + 1]); }
    return a;
}
__device__ __forceinline__ float swapmax(float m) { auto rr = __builtin_amdgcn_permlane32_swap(__float_as_uint(m), __float_as_uint(m), false, false); return fmaxf(__uint_as_float(rr[0]), __uint_as_float(rr[1])); }
__device__ __forceinline__ float swapsum(float m) { auto rr = __builtin_amdgcn_permlane32_swap(__float_as_uint(m), __float_as_uint(m), false, false); return __uint_as_float(rr[0]) + __uint_as_float(rr[1]); }

__device__ __forceinline__ void load_kv_block(LAS unsigned char* lds, int KOFF, int VOFF, const bf16* QKVZ, size_t krow0, int h, int wid, int lane) {
    const bf16* ksrc = QKVZ + (krow0 + lane) * QP + 512 + h * HD + wid * 8;
    const bf16* vsrc = QKVZ + (krow0 + 16 * (wid & 3) + (lane >> 2)) * QP + 1024 + h * HD + (wid >> 2) * 32 + (lane & 3) * 8;
#pragma unroll
    for (int t = 0; t < 4; ++t) {
        __builtin_amdgcn_global_load_lds((const unsigned*)(ksrc + (size_t)t * 64 * QP), (LAS unsigned*)(lds + KOFF + t * SLOTB + wid * 1024), 16, 0, 0);
        __builtin_amdgcn_global_load_lds((const unsigned*)(vsrc + (size_t)t * 64 * QP), (LAS unsigned*)(lds + VOFF + t * SLOTB + wid * 1024), 16, 0, 0); }
}
}

constexpr int LIST_CAP = 3840;

__device__ __forceinline__ void attn_select(Frame& F, const float* GATE, unsigned* CNT, unsigned short* LISTS, int panel = -1) {
    constexpr int NIT = BATCH * NH * (SEQ / 64);
    const int gw = F.vcu * NWAVES + F.wave, NGW = F.G * NWAVES;
#pragma unroll 1
    for (int it0 = gw; it0 < NIT; it0 += 4 * NGW) {
        f32x4 ga[4][4]; int sb[4], sh[4], ss[4]; bool act[4];
#pragma unroll
        for (int k = 0; k < 4; ++k) { const int it = it0 + k * NGW; bool v = it < NIT; const int itc = v ? it : gw;
            int sg = itc % (SEQ / 64), h = (itc / (SEQ / 64)) % NH, b = itc / (SEQ / 64 * NH);
            if (panel >= 0) { const int j = F.wave * 4 + k; h = j & 7; sg = (panel & 15) * 4 + (j >> 3); b = panel >> 4; v = true; }
            const int s = sg * 64 + F.lane;
            sb[k] = b; sh[k] = h; ss[k] = s; act[k] = v && (s >> 8) > 0;
            const size_t row = (size_t)b * SEQ + s; const f32x4* gp = (const f32x4*)(GATE + row * 128 + h * 16);
#pragma unroll
            for (int c = 0; c < 4; ++c) ga[k][c] = __builtin_nontemporal_load(gp + c); }
        int i0[4], i1[4], i2[4], r0[4], r1[4], r2[4]; unsigned mycnt[4], base[4];
#pragma unroll
        for (int k = 0; k < 4; ++k) { const int qb = ss[k] >> 8;
            float g0 = -INFINITY, g1 = -INFINITY, g2 = -INFINITY; int j0 = -1, j1 = -1, j2 = -1;
#pragma unroll
            for (int c = 0; c < 4; ++c)
#pragma unroll
                for (int e = 0; e < 4; ++e) { const int n = c * 4 + e; const float g = (n < qb) ? ga[k][c][e] : -INFINITY;
                    if (g > g0) { g2 = g1; j2 = j1; g1 = g0; j1 = j0; g0 = g; j0 = n; } else if (g > g1) { g2 = g1; j2 = j1; g1 = g; j1 = n; } else if (g > g2) { g2 = g; j2 = n; } }
            if (!act[k]) { j0 = -1; j1 = -1; j2 = -1; }
            i0[k] = j0; i1[k] = j1; i2[k] = j2;
            int q0 = 0, q1 = 0, q2 = 0; unsigned mc = 0u;
            const int qbu = act[k] ? __builtin_amdgcn_readfirstlane(qb) : 0;
            for (int n = 0; n < qbu; ++n) {
                const bool pick = (j0 == n) | (j1 == n) | (j2 == n);
                const unsigned long long mask = __ballot(pick);
                const int before = __builtin_amdgcn_mbcnt_hi((unsigned)(mask >> 32), __builtin_amdgcn_mbcnt_lo((unsigned)mask, 0u));
                if (j0 == n) q0 = before; if (j1 == n) q1 = before; if (j2 == n) q2 = before;
                if (F.lane == n) mc = (unsigned)__popcll(mask);
            }
            r0[k] = q0; r1[k] = q1; r2[k] = q2; mycnt[k] = mc; }
#pragma unroll
        for (int k = 0; k < 4; ++k) { base[k] = 0u; if (mycnt[k]) base[k] = atomicAdd(CNT + (sb[k] * NH + sh[k]) * 16 + F.lane, mycnt[k]); }
#pragma unroll
        for (int k = 0; k < 4; ++k) { unsigned short* lst = LISTS + (size_t)(sb[k] * NH + sh[k]) * 16 * LIST_CAP; const int s = ss[k];
            const unsigned b0 = __shfl(base[k], i0[k] < 0 ? 0 : i0[k]), b1 = __shfl(base[k], i1[k] < 0 ? 0 : i1[k]), b2 = __shfl(base[k], i2[k] < 0 ? 0 : i2[k]);
            if (i0[k] >= 0) lst[(size_t)i0[k] * LIST_CAP + b0 + r0[k]] = (unsigned short)(s | (0 << 12));
            if (i1[k] >= 0) lst[(size_t)i1[k] * LIST_CAP + b1 + r1[k]] = (unsigned short)(s | (1 << 12));
            if (i2[k] >= 0) lst[(size_t)i2[k] * LIST_CAP + b2 + r2[k]] = (unsigned short)(s | (2 << 12)); }
        if (panel >= 0) break;
    }
}

__device__ __forceinline__ void attn_partial(Frame& F, const bf16* QKVZ, const unsigned* CNT, const unsigned short* LISTS, bf16* PART_O, float* PART_ML, unsigned* QCTR) {
    using namespace moba;
    LAS unsigned char* lds = F.lds; const int wid = F.wave, lane = F.lane, r32 = lane & 31, hi = lane >> 5;
    LAS float* btab = (LAS float*)(lds + 114688); LAS unsigned* uword = (LAS unsigned*)(lds + 106496); LAS unsigned short* llist = (LAS unsigned short*)(lds + 106624);
    LAS float* wsf = (LAS float*)(lds + 98304) + wid * 128; LAS bf16* stg = (LAS bf16*)(lds + 65536) + wid * 2048;
    for (int i = F.tid; i < NH * 512; i += NTHR) { const int h = i >> 9, d = i & 511; btab[i] = d < 113 ? (F.rel_bias[T5B[d] * NH + h] - F.rel_bias[31 * NH + h]) * LOG2E : 0.f; }
    const int vb0 = (int)(uintptr_t)(lds + 32768) + ((lane >> 4) & 1) * 32 + (lane & 3) * 8 + (4 * hi + ((lane & 15) >> 2)) * 64;
    const int NUNIT = BATCH * NH * 15;
    if (F.tid == 0) { const unsigned u0 = atomicAdd(QCTR, 1u); uword[0] = u0; uword[1] = (u0 < (unsigned)NUNIT) ? CNT[(u0 % (BATCH * NH)) * 16 + u0 / (BATCH * NH)] : 0u; }
    for (;;) {
        __syncthreads();
        const int u = (int)uword[0]; const int cnt = (int)uword[1];
        if (u >= NUNIT) break;
        const int n = u / (BATCH * NH), bh = u % (BATCH * NH), b = bh / NH, h = bh % NH;
        load_kv_block(lds, 0, 32768, QKVZ, (size_t)b * SEQ + n * BLK, h, wid, lane);
        const unsigned short* lst = LISTS + ((size_t)bh * 16 + n) * LIST_CAP;
        for (int i = F.tid; i < (cnt + 1) / 2; i += NTHR) ((LAS unsigned*)llist)[i] = ((const unsigned*)lst)[i];
        unsigned nu = 0u, nc = 0u;
        if (F.tid == 0) { nu = atomicAdd(QCTR, 1u); nc = (nu < (unsigned)NUNIT) ? CNT[(nu % (BATCH * NH)) * 16 + nu / (BATCH * NH)] : 0u; }
        const float b31 = F.rel_bias[31 * NH + h] * LOG2E;
        __syncthreads();
        const int ntile = (cnt + 31) >> 5;
        bf16x8 qn[4]; int tile = wid;
        if (tile < ntile) { const int idx = tile * 32 + r32; const unsigned e = llist[idx < cnt ? idx : 0]; const size_t row = (size_t)b * SEQ + (e & 4095);
#pragma unroll
            for (int d0 = 0; d0 < 4; ++d0) qn[d0] = *(const bf16x8*)(QKVZ + row * QP + h * HD + d0 * 16 + hi * 8); }
        for (; tile < ntile; tile += NWAVES) {
            int lane_ = F.tid; asm volatile("" : "+v"(lane_)); lane_ &= 63;
            const int lane = lane_, r32 = lane & 31, hi = lane >> 5;
            const int vb0 = (int)(uintptr_t)(lds + 32768) + ((lane >> 4) & 1) * 32 + (lane & 3) * 8 + (4 * hi + ((lane & 15) >> 2)) * 64;
            const int idx = tile * 32 + r32; const bool valid = idx < cnt;
            const unsigned e = llist[valid ? idx : 0]; const int s = e & 4095, slot = e >> 12; const size_t row = (size_t)b * SEQ + s;
            bf16x8 qr[4];
#pragma unroll
            for (int d0 = 0; d0 < 4; ++d0) qr[d0] = qn[d0];
            if (tile + NWAVES < ntile) { const int idx2 = (tile + NWAVES) * 32 + r32; const unsigned e2 = llist[idx2 < cnt ? idx2 : 0]; const size_t row2 = (size_t)b * SEQ + (e2 & 4095);
#pragma unroll
                for (int d0 = 0; d0 < 4; ++d0) qn[d0] = *(const bf16x8*)(QKVZ + row2 * QP + h * HD + d0 * 16 + hi * 8); }
            f32x16 o[2]; o[0] = f32x16{}; o[1] = f32x16{};
            float mx = -INFINITY, l = 0.f;
            const bool near = ((s >> 8) == n + 1);
            const int dbase = near ? (s - (n * BLK + 128)) : 400;
            const LAS float* bq = btab + h * 512 + dbase - 127;
#pragma unroll
            for (int half = 0; half < 2; ++half) {
                if (half) __builtin_amdgcn_sched_barrier(0);
                f32x16 p[2][2];
                if (half == 1) {
#pragma unroll
                    for (int t = 0; t < 2; ++t)
#pragma unroll
                        for (int r = 0; r < 16; ++r) { const int kvc = t * 64 + (r & 3) + 8 * (r >> 2);
                            p[t][0][r] = (bq - 4 * hi)[127 - kvc]; p[t][1][r] = (bq - 4 * hi)[127 - kvc - 32]; }
                } else { p[0][0] = f32x16{}; p[0][1] = f32x16{}; p[1][0] = f32x16{}; p[1][1] = f32x16{}; }
#pragma unroll
                for (int t = 0; t < 2; ++t) qkt_acc(p[t][0], p[t][1], lds + (2 * half + t) * SLOTB, qr, r32, hi);
                float m2 = rowmax2(p[0][0], p[0][1], mx); m2 = rowmax2(p[1][0], p[1][1], m2); m2 = swapmax(m2);
                const float f = fexp2(mx - m2); l *= f; mx = m2;
                if (half == 1) {
                    if (hi == 0) wsf[64 + r32] = f;
                    asm volatile("s_waitcnt lgkmcnt(0)" ::: "memory");
#pragma unroll
                    for (int r = 0; r < 16; ++r) { const float fr_ = wsf[64 + crow(r, hi)]; o[0][r] *= fr_; o[1][r] *= fr_; } }
#pragma unroll
                for (int t = 0; t < 2; ++t) {
#pragma unroll
                    for (int r = 0; r < 16; ++r) { p[t][0][r] = fexp2(p[t][0][r] - mx); p[t][1][r] = fexp2(p[t][1][r] - mx); l += p[t][0][r] + p[t][1][r]; }
                    u32x4 w0, w1, w2, w3;
                    w0 = (u32x4){cvtpk(p[t][0][0], p[t][0][1]), cvtpk(p[t][0][2], p[t][0][3]), cvtpk(p[t][0][4], p[t][0][5]), cvtpk(p[t][0][6], p[t][0][7])};
                    w1 = (u32x4){cvtpk(p[t][0][8], p[t][0][9]), cvtpk(p[t][0][10], p[t][0][11]), cvtpk(p[t][0][12], p[t][0][13]), cvtpk(p[t][0][14], p[t][0][15])};
                    w2 = (u32x4){cvtpk(p[t][1][0], p[t][1][1]), cvtpk(p[t][1][2], p[t][1][3]), cvtpk(p[t][1][4], p[t][1][5]), cvtpk(p[t][1][6], p[t][1][7])};
                    w3 = (u32x4){cvtpk(p[t][1][8], p[t][1][9]), cvtpk(p[t][1][10], p[t][1][11]), cvtpk(p[t][1][12], p[t][1][13]), cvtpk(p[t][1][14], p[t][1][15])};
                    pv(o, vb0 + (2 * half + t) * SLOTB, __builtin_bit_cast(bf16x8, w0), __builtin_bit_cast(bf16x8, w1), __builtin_bit_cast(bf16x8, w2), __builtin_bit_cast(bf16x8, w3)); }
            }
            __builtin_amdgcn_sched_barrier(0);
            l = swapsum(l);
            if (hi == 0) { wsf[r32] = frcp(l); ((LAS int*)wsf)[32 + r32] = valid ? (int)(((row * NH + h) * 3 + slot)) : -1;
                           if (valid) { float2 ml; ml.x = mx + b31; ml.y = l; *(float2*)(PART_ML + ((row * NH + h) * 3 + slot) * 2) = ml; } }
            asm volatile("s_waitcnt lgkmcnt(0)" ::: "memory");
#pragma unroll
            for (int r = 0; r < 16; ++r) { const int orow = crow(r, hi); const float il = wsf[orow];
#pragma unroll
                for (int d0 = 0; d0 < 2; ++d0) stg[orow * 64 + d0 * 32 + r32] = (bf16)f2bf(o[d0][r] * il); }
            asm volatile("s_waitcnt lgkmcnt(0)" ::: "memory");
#pragma unroll
            for (int i = 0; i < 4; ++i) { const int rr = i * 8 + (lane >> 3), ch = lane & 7; const int dst = ((LAS int*)wsf)[32 + rr];
                const u32x4 v = *(const LAS u32x4*)(stg + rr * 64 + ch * 8);
                if (dst >= 0) *(u32x4*)(PART_O + (size_t)dst * 64 + ch * 8) = v; }
            asm volatile("s_waitcnt lgkmcnt(0)" ::: "memory");
        }
        if (F.tid == 0) { uword[0] = nu; uword[1] = nc; }
    }
}

__device__ __forceinline__ void attn_own_combine(Frame& F, bf16* QKVZ, const bf16* PART_O, const float* PART_ML, bf16* OUTB, int out_pitch) {
    using namespace moba;
    LAS unsigned char* lds = F.lds; const int wid = F.wave, lane = F.lane, r32 = lane & 31, hi = lane >> 5;
    LAS float* btab = (LAS float*)(lds + 139264);
    LAS float* wsf = (LAS float*)(lds + 135168) + wid * 128; LAS float* ost = (LAS float*)(lds + 65536 + wid * 8704);
    __syncthreads();
    for (int i = F.tid; i < NH * 256; i += NTHR) { const int h = i >> 8, d = i & 255; btab[i] = F.rel_bias[T5B[d < 127 ? d : 127] * NH + h] * LOG2E; }
    const int vb0 = (int)(uintptr_t)(lds + 32768) + ((lane >> 4) & 1) * 32 + (lane & 3) * 8 + (4 * hi + ((lane & 15) >> 2)) * 64;
    for (int u = F.vcu; u < BATCH * NH * NBLK; u += F.G) {
        const int qb = u % NBLK, bh = u / NBLK, b = bh / NH, h = bh % NH;
        __syncthreads();
        load_kv_block(lds, 0, 32768, QKVZ, (size_t)b * SEQ + qb * BLK, h, wid, lane);
        const int sq = qb * BLK + wid * 32 + r32; const size_t row = (size_t)b * SEQ + sq;
        bf16x8 qr[4];
#pragma unroll
        for (int d0 = 0; d0 < 4; ++d0) qr[d0] = *(const bf16x8*)(QKVZ + row * QP + h * HD + d0 * 16 + hi * 8);
        const int cq = lane >> 1, cc0 = (lane & 1) * 32; const size_t crow2 = (size_t)b * SEQ + qb * BLK + wid * 32 + cq;
        float2 pml[3]; v4u po[3][4], zw[4];
#pragma unroll
        for (int j = 0; j < 3; ++j) { pml[j] = *(const float2*)(PART_ML + ((crow2 * NH + h) * 3 + j) * 2);
#pragma unroll
            for (int c = 0; c < 4; ++c) po[j][c] = __builtin_nontemporal_load((const v4u*)(PART_O + ((crow2 * NH + h) * 3 + j) * 64 + cc0) + c); }
#pragma unroll
        for (int c = 0; c < 4; ++c) zw[c] = *((const v4u*)(QKVZ + crow2 * QP + 1536 + h * HD + cc0) + c);
        __syncthreads();
        const int nt = (wid >> 1) + 1;
        int ql = wid * 32 + r32;
        asm volatile("" : "+v"(ql));
        const LAS float* bt = btab + h * 256;
        float mx = -INFINITY, l = 0.f;
        f32x16 o[2]; o[0] = f32x16{}; o[1] = f32x16{};
#pragma unroll 1
        for (int t = 0; t < nt; ++t) { f32x16 p0, p1;
            qkt(p0, p1, lds + t * SLOTB, qr, r32, hi);
            if (t < nt - 1) {
#pragma unroll
                for (int r = 0; r < 16; ++r) { const int kv = t * 64 + crow(r, hi); const int d0 = ql - kv, d1 = d0 - 32; p0[r] += bt[d0]; p1[r] += bt[d1]; }
            } else {
#pragma unroll
                for (int r = 0; r < 16; ++r) { const int kv = t * 64 + crow(r, hi); const int d0 = ql - kv, d1 = d0 - 32; const float b0 = bt[d0 < 0 ? 0 : d0], b1 = bt[d1 < 0 ? 0 : d1];
                    p0[r] = d0 >= 0 ? p0[r] + b0 : -INFINITY; p1[r] = d1 >= 0 ? p1[r] + b1 : -INFINITY; } }
            const float m2 = swapmax(rowmax2(p0, p1, mx));
            const float f = fexp2(mx - m2); l *= f; mx = m2;
            if (t > 0) { if (hi == 0) wsf[64 + r32] = f;
                asm volatile("s_waitcnt lgkmcnt(0)" ::: "memory");
#pragma unroll
                for (int r = 0; r < 16; ++r) { const float fr_ = wsf[64 + crow(r, hi)]; o[0][r] *= fr_; o[1][r] *= fr_; } }
#pragma unroll
            for (int r = 0; r < 16; ++r) { p0[r] = fexp2(p0[r] - mx); p1[r] = fexp2(p1[r] - mx); l += p0[r] + p1[r]; }
            u32x4 w0, w1, w2, w3;
            w0 = (u32x4){cvtpk(p0[0], p0[1]), cvtpk(p0[2], p0[3]), cvtpk(p0[4], p0[5]), cvtpk(p0[6], p0[7])};
            w1 = (u32x4){cvtpk(p0[8], p0[9]), cvtpk(p0[10], p0[11]), cvtpk(p0[12], p0[13]), cvtpk(p0[14], p0[15])};
            w2 = (u32x4){cvtpk(p1[0], p1[1]), cvtpk(p1[2], p1[3]), cvtpk(p1[4], p1[5]), cvtpk(p1[6], p1[7])};
            w3 = (u32x4){cvtpk(p1[8], p1[9]), cvtpk(p1[10], p1[11]), cvtpk(p1[12], p1[13]), cvtpk(p1[14], p1[15])};
            pv(o, vb0 + t * SLOTB, __builtin_bit_cast(bf16x8, w0), __builtin_bit_cast(bf16x8, w1), __builtin_bit_cast(bf16x8, w2), __builtin_bit_cast(bf16x8, w3));
        }
        l = swapsum(l);
        if (hi == 0) { wsf[r32] = mx; wsf[32 + r32] = l; }
#pragma unroll
        for (int r = 0; r < 16; ++r) { const int orow = crow(r, hi);
#pragma unroll
            for (int d0 = 0; d0 < 2; ++d0) ost[orow * 68 + d0 * 32 + r32] = o[d0][r]; }
        asm volatile("s_waitcnt lgkmcnt(0)" ::: "memory");
        { const int q = lane >> 1, c0 = (lane & 1) * 32; const int s2 = qb * BLK + wid * 32 + q; const size_t row2 = (size_t)b * SEQ + s2;
          const float m0 = wsf[q], l0 = wsf[32 + q]; const int np = qb < 3 ? qb : 3;
          float mj[3], lj[3]; float mt = m0;
#pragma unroll
          for (int j = 0; j < 3; ++j) { if (j < np) { const float2 ml = pml[j]; mj[j] = ml.x; lj[j] = ml.y; mt = fmaxf(mt, ml.x); } else { mj[j] = -INFINITY; lj[j] = 0.f; } }
          const float w0 = fexp2(m0 - mt); float wj[3]; float den = w0 * l0;
#pragma unroll
          for (int j = 0; j < 3; ++j) { wj[j] = (j < np) ? fexp2(mj[j] - mt) * lj[j] : 0.f; den += wj[j]; }
          const float iden = frcp(den);
          float acc[32];
#pragma unroll
          for (int c = 0; c < 32; c += 4) { const f32x4 v = *(const LAS f32x4*)(ost + q * 68 + c0 + c); acc[c] = v[0] * w0; acc[c + 1] = v[1] * w0; acc[c + 2] = v[2] * w0; acc[c + 3] = v[3] * w0; }
#pragma unroll
          for (int j = 0; j < 3; ++j) if (j < np) {
#pragma unroll
              for (int c = 0; c < 4; ++c) { const v4u w = po[j][c]; const float f = wj[j];
                  acc[c * 8 + 0] += f * __uint_as_float(w.x << 16); acc[c * 8 + 1] += f * __uint_as_float(w.x & 0xffff0000u); acc[c * 8 + 2] += f * __uint_as_float(w.y << 16); acc[c * 8 + 3] += f * __uint_as_float(w.y & 0xffff0000u);
                  acc[c * 8 + 4] += f * __uint_as_float(w.z << 16); acc[c * 8 + 5] += f * __uint_as_float(w.z & 0xffff0000u); acc[c * 8 + 6] += f * __uint_as_float(w.w << 16); acc[c * 8 + 7] += f * __uint_as_float(w.w & 0xffff0000u); } }
          asm volatile("s_waitcnt lgkmcnt(0)" ::: "memory");
#pragma unroll
          for (int c = 0; c < 4; ++c) { const v4u w = zw[c]; const float z[8] = {__uint_as_float(w.x << 16), __uint_as_float(w.x & 0xffff0000u), __uint_as_float(w.y << 16), __uint_as_float(w.y & 0xffff0000u),
                                                                               __uint_as_float(w.z << 16), __uint_as_float(w.z & 0xffff0000u), __uint_as_float(w.w << 16), __uint_as_float(w.w & 0xffff0000u)};
              float rr[8];
#pragma unroll
              for (int e2 = 0; e2 < 8; ++e2) rr[e2] = acc[c * 8 + e2] * iden * z[e2] * sigm(z[e2]);
              v4u ow; ow.x = pk2(rr[0], rr[1]); ow.y = pk2(rr[2], rr[3]); ow.z = pk2(rr[4], rr[5]); ow.w = pk2(rr[6], rr[7]); *(LAS v4u*)((LAS bf16*)ost + q * 72 + c0 + c * 8) = ow; }
          asm volatile("s_waitcnt lgkmcnt(0)" ::: "memory");
#pragma unroll
          for (int i = 0; i < 4; ++i) { const int rr = i * 8 + (lane >> 3), chk = lane & 7; const v4u w = *(const LAS v4u*)((LAS bf16*)ost + rr * 72 + chk * 8);
              __builtin_nontemporal_store(w, (v4u*)(OUTB + ((size_t)b * SEQ + qb * BLK + wid * 32 + rr) * out_pitch + h * HD + chk * 8)); } }
        asm volatile("s_waitcnt lgkmcnt(0)" ::: "memory");
    }
}
namespace rk {
using bf16x8 = __attribute__((ext_vector_type(8))) short;
using s16x4 = __attribute__((ext_vector_type(4))) short;
using f32x16 = __attribute__((ext_vector_type(16))) float;
using u32x4 = __attribute__((ext_vector_type(4))) unsigned;
using u32x2 = __attribute__((ext_vector_type(2))) unsigned;
typedef short v4i16_t __attribute__((ext_vector_type(4)));
typedef float f32x2_t __attribute__((ext_vector_type(2))); typedef __bf16 bf16x2_t __attribute__((ext_vector_type(2)));
constexpr int P = 144, IMG = 64 * P, GRP = 81920, MISC = 8 * IMG;
#define RK_MFMA(a, b, c) __builtin_amdgcn_mfma_f32_32x32x16_bf16((a), (b), (c), 0, 0, 0)
__device__ __forceinline__ int crow(int r, int hi) { return (r & 3) + 8 * (r >> 2) + 4 * hi; }
__device__ __forceinline__ unsigned cvtpk(float lo, float hi) { f32x2_t v = {lo, hi}; bf16x2_t b = __builtin_convertvector(v, bf16x2_t); return __builtin_bit_cast(unsigned, b); }
__device__ __forceinline__ float bflo(unsigned w) { return __uint_as_float(w << 16); }
__device__ __forceinline__ float bfhi(unsigned w) { return __uint_as_float(w & 0xffff0000u); }
__device__ __forceinline__ s16x4 trrd(const LAS unsigned char* p) { return __builtin_bit_cast(s16x4, __builtin_amdgcn_ds_read_tr16_b64_v4i16((LAS v4i16_t*)p)); }
struct Ln { int r, h, blk, q, p; };
__device__ __forceinline__ bf16x8 frag_row(const LAS unsigned char* img, const Ln& l, int tile, int s, int coloff = 0) { return *(const LAS bf16x8*)(img + (32 * tile + l.r) * P + (coloff + 16 * s + 8 * l.h) * 2); }
__device__ __forceinline__ bf16x8 frag_tr(const LAS unsigned char* img, const Ln& l, int tile, int s, int rowoff = 0) {
    const LAS unsigned char* b = img + (rowoff + 16 * s + 8 * l.h + l.q) * P + 64 * tile + 32 * l.blk + 8 * l.p;
    const s16x4 lo = trrd(b), hi = trrd(b + 4 * P);
    return (bf16x8){lo[0], lo[1], lo[2], lo[3], hi[0], hi[1], hi[2], hi[3]};
}
__device__ __forceinline__ bf16x8 frag_row_perm(const LAS unsigned char* img, const Ln& l, int tile, int s, int coloff = 0) {
    const LAS unsigned char* b = img + (32 * tile + l.r) * P + (coloff + 16 * s + 4 * l.h) * 2;
    const s16x4 lo = *(const LAS s16x4*)b, hi = *(const LAS s16x4*)(b + 16);
    return (bf16x8){lo[0], lo[1], lo[2], lo[3], hi[0], hi[1], hi[2], hi[3]};
}
__device__ __forceinline__ bf16x8 frag_tr_perm(const LAS unsigned char* img, const Ln& l, int tile, int s, int rowoff = 0) {
    const LAS unsigned char* b = img + (rowoff + 16 * s + 4 * l.h + l.q) * P + 64 * tile + 32 * l.blk + 8 * l.p;
    const s16x4 lo = trrd(b), hi = trrd(b + 8 * P);
    return (bf16x8){lo[0], lo[1], lo[2], lo[3], hi[0], hi[1], hi[2], hi[3]};
}
__device__ __forceinline__ bf16x8 pack(const f32x16& x, int s) {
    u32x4 w; w.x = cvtpk(x[8 * s], x[8 * s + 1]); w.y = cvtpk(x[8 * s + 2], x[8 * s + 3]); w.z = cvtpk(x[8 * s + 4], x[8 * s + 5]); w.w = cvtpk(x[8 * s + 6], x[8 * s + 7]);
    return __builtin_bit_cast(bf16x8, w);
}
__device__ __forceinline__ void store_T(LAS unsigned char* img, const Ln& l, const f32x16& x, int ti, int tj) {
#pragma unroll
    for (int g = 0; g < 4; ++g) { u32x2 w; w.x = cvtpk(x[4 * g], x[4 * g + 1]); w.y = cvtpk(x[4 * g + 2], x[4 * g + 3]);
        *(LAS u32x2*)(img + (32 * tj + l.r) * P + (32 * ti + 8 * g + 4 * l.h) * 2) = w; }
}
__device__ __forceinline__ float xhalf(float v) { return __shfl_xor(v, 32); }
__device__ __forceinline__ void tri_inv32(f32x16& D, f32x16& DT, f32x16 S, f32x16 ST) {
    const f32x16 z = {};
#pragma unroll
    for (int it = 0; it < 4; ++it) {
        f32x16 S2 = z, S2T = z;
#pragma unroll
        for (int s = 0; s < 2; ++s) { const bf16x8 ps = pack(S, s), pst = pack(ST, s); S2 = RK_MFMA(pst, ps, S2); S2T = RK_MFMA(ps, pst, S2T); }
        f32x16 DS = S2, DST = S2T;
#pragma unroll
        for (int s = 0; s < 2; ++s) { DS = RK_MFMA(pack(DT, s), pack(S2, s), DS); DST = RK_MFMA(pack(S2, s), pack(DT, s), DST); }
        D = D + DS; DT = DT + DST; S = S2; ST = S2T;
    }
}
}

constexpr size_t DO_NT = 0, DO_MT = 128 * MiB, DO_RH = 192 * MiB;

struct R1Ctx { int item, c, h, b; int nc, nh, nb; rk::f32x16 Wt0, Wt1; unsigned bcnt; };
#ifndef MK_R1_GBAR
#define MK_R1_GBAR 0
#endif
__device__ __forceinline__ void r1_gbar(Frame& F, unsigned& cnt) {
#if MK_R1_GBAR
    int t_ = F.tid; asm volatile("" : "+v"(t_));
    LAS unsigned* ctr = (LAS unsigned*)(F.lds + (t_ >> 8) * rk::GRP + rk::MISC + 8000);
    asm volatile("s_waitcnt lgkmcnt(0)" ::: "memory");
    cnt += 4u;
    if ((t_ & 63) == 0) __hip_atomic_fetch_add(ctr, 1u, __ATOMIC_RELAXED, __HIP_MEMORY_SCOPE_WORKGROUP);
    while (__hip_atomic_load(ctr, __ATOMIC_RELAXED, __HIP_MEMORY_SCOPE_WORKGROUP) < cnt) __builtin_amdgcn_s_sleep(1);
    asm volatile("" ::: "memory");
#else
    (void)cnt; __syncthreads();
#endif
}
#define RK_RELANE() do { int t_ = F.tid; asm volatile("" : "+v"(t_)); lane = t_ & 63; tg = t_ & 255; grp = t_ >> 8; w4 = (t_ >> 6) & 3; ti = w4 >> 1; tj = w4 & 1; l.r = lane & 31; l.h = lane >> 5; l.blk = (lane >> 4) & 1; l.q = (lane & 15) >> 2; l.p = lane & 3; G = F.lds + grp * GRP; } while (0)
#define RK_KA() const __attribute__((address_space(4))) Args* ka = (const __attribute__((address_space(4))) Args*)__builtin_amdgcn_kernarg_segment_ptr(); asm volatile("" : "+s"(ka))
#define s0 (G)
#define s1 (G + IMG)
#define s2 (G + 2 * IMG)
#define s3 (G + 3 * IMG)
#define s4 (G + 4 * IMG)
#define s5 (G + 5 * IMG)
#define s6 (G + 6 * IMG)
#define s7 (G + 7 * IMG)
#define nrminv ((LAS float*)(G + MISC))
#define ltot (nrminv + 64)
#define gam (nrminv + 128)
#define bonp (nrminv + 192)
#define hcst (nrminv + 384)
template <int VAR> __device__ __forceinline__ void r1_S1a_t(Frame& F, R1Ctx& X) {
    using namespace rk;
    if (VAR == 3) { int t_ = F.tid; asm volatile("" : "+v"(t_)); if ((t_ & 255) < 64) ((LAS float*)(F.lds + (t_ >> 8) * GRP + MISC))[t_ & 63] = 1.0f; return; }
    int grp, w4, ti, tj, lane, tg; Ln l; LAS unsigned char* G; const f32x16 z16 = {};
    RK_RELANE(); (void)w4; (void)tg; (void)ti; (void)tj;
    const int item = X.item, c = X.c, h = X.h, b = X.b; (void)item; (void)c; (void)h; (void)b;
    { RK_KA(); const bf16* RW = (const bf16*)(ka->ws + WS_RW); const float* mu_ = ka->in[5]; const float* kk_ = ka->in[10];
      const int t = tg >> 2, q4 = tg & 3; const int sq = c * 64 + t; const size_t row = (size_t)b * SEQ + sq;
      const bf16* cur = RW + row * RWC; const bool hasp = sq > 0; const bf16* prv = hasp ? cur - RWC : cur; const float pm = hasp ? 1.f : 0.f;
      float nr = 0.f;
      v4u cr_[2], pr_[2], ck_[2], pk_[2], cv_[2], pv_[2], cw_[2], pw_[2], ca_[2], pa_[2];
#pragma unroll
      for (int half = 0; half < 2; ++half) { const int k0 = 16 * q4 + 8 * half, col = h * HD + k0;
          if (VAR == 2) { const v4u c_ = {0x3f803f80u + (unsigned)col, 0x3f003f00u, 0x3e803e80u, 0x3f803f00u}; cr_[half] = c_; pr_[half] = c_; ck_[half] = c_; pk_[half] = c_; cv_[half] = c_; pv_[half] = c_; cw_[half] = c_; pw_[half] = c_; ca_[half] = c_; pa_[half] = c_; } else {
          cr_[half] = *(const v4u*)(cur + col); pr_[half] = *(const v4u*)(prv + col); ck_[half] = *(const v4u*)(cur + 512 + col); pk_[half] = *(const v4u*)(prv + 512 + col); cv_[half] = *(const v4u*)(cur + 1024 + col); pv_[half] = *(const v4u*)(prv + 1024 + col);
          cw_[half] = *(const v4u*)(cur + 2048 + k0); pw_[half] = *(const v4u*)(prv + 2048 + k0); ca_[half] = *(const v4u*)(cur + 2112 + k0); pa_[half] = *(const v4u*)(prv + 2112 + k0); } }
      __builtin_amdgcn_sched_barrier(0);
#pragma unroll
      for (int half = 0; half < 2; ++half) { const int k0 = 16 * q4 + 8 * half, col = h * HD + k0;
          const v4u cr = cr_[half], pr = pr_[half], ck = ck_[half], pk = pk_[half], cv = cv_[half], pv = pv_[half], cw = cw_[half], pw = pw_[half], ca = ca_[half], pa = pa_[half];
          float ro[8], ko[8], vo[8], wo[8], ao[8];
          float mr[8], mk[8], mv[8], mw[8], ma[8], kkc[8];
          { const LAS f32x4* p; f32x4 x0, x1;
#define LD8_(dst, ptr) p = (const LAS f32x4*)(ptr); x0 = p[0]; x1 = p[1]; dst[0] = x0[0]; dst[1] = x0[1]; dst[2] = x0[2]; dst[3] = x0[3]; dst[4] = x1[0]; dst[5] = x1[1]; dst[6] = x1[2]; dst[7] = x1[3]
            LD8_(mr, hcst + k0); LD8_(mk, hcst + 64 + k0); LD8_(mv, hcst + 128 + k0); LD8_(mw, hcst + 256 + k0); LD8_(ma, hcst + 320 + k0); LD8_(kkc, hcst + 384 + k0);
#undef LD8_
          }
#pragma unroll
          for (int e = 0; e < 8; ++e) { const unsigned wcr = cr[e >> 1], wpr = pr[e >> 1], wck = ck[e >> 1], wpk = pk[e >> 1], wcv = cv[e >> 1], wpv = pv[e >> 1];
              const unsigned wcw = cw[e >> 1], wpw = pw[e >> 1], wca = ca[e >> 1], wpa = pa[e >> 1];
              const float xr = (e & 1) ? bfhi(wcr) : bflo(wcr), yr = pm * ((e & 1) ? bfhi(wpr) : bflo(wpr)); ro[e] = xr + (yr - xr) * mr[e];
              const float xk = (e & 1) ? bfhi(wck) : bflo(wck), yk = pm * ((e & 1) ? bfhi(wpk) : bflo(wpk)); ko[e] = xk + (yk - xk) * mk[e];
              const float xv = (e & 1) ? bfhi(wcv) : bflo(wcv), yv = pm * ((e & 1) ? bfhi(wpv) : bflo(wpv)); vo[e] = xv + (yv - xv) * mv[e];
              const float xw = (e & 1) ? bfhi(wcw) : bflo(wcw), yw = pm * ((e & 1) ? bfhi(wpw) : bflo(wpw)); wo[e] = ftanh(xw + (yw - xw) * mw[e]);
              const float xa = (e & 1) ? bfhi(wca) : bflo(wca), ya = pm * ((e & 1) ? bfhi(wpa) : bflo(wpa)); ao[e] = xa + (ya - xa) * ma[e];
              const float kkx = ko[e] * kkc[e]; nr += kkx * kkx; }
          const int off = t * P + k0 * 2;
          *(LAS u32x4*)(s0 + off) = (u32x4){cvtpk(wo[0], wo[1]), cvtpk(wo[2], wo[3]), cvtpk(wo[4], wo[5]), cvtpk(wo[6], wo[7])};
          *(LAS u32x4*)(s1 + off) = (u32x4){cvtpk(ao[0], ao[1]), cvtpk(ao[2], ao[3]), cvtpk(ao[4], ao[5]), cvtpk(ao[6], ao[7])};
          *(LAS u32x4*)(s2 + off) = (u32x4){cvtpk(ro[0], ro[1]), cvtpk(ro[2], ro[3]), cvtpk(ro[4], ro[5]), cvtpk(ro[6], ro[7])};
          *(LAS u32x4*)(s3 + off) = (u32x4){cvtpk(ko[0], ko[1]), cvtpk(ko[2], ko[3]), cvtpk(ko[4], ko[5]), cvtpk(ko[6], ko[7])};
          const u32x4 vw = (u32x4){cvtpk(vo[0], vo[1]), cvtpk(vo[2], vo[3]), cvtpk(vo[4], vo[5]), cvtpk(vo[6], vo[7])};
          *(LAS u32x4*)(s4 + off) = vw;
          }
      nr += __shfl_xor(nr, 1); nr += __shfl_xor(nr, 2);
      if (q4 == 0) nrminv[t] = frsq(fmaxf(nr, 1e-24f)); }
}
__device__ __forceinline__ void r1_S1a(Frame& F, R1Ctx& X) { r1_S1a_t<0>(F, X); }
__device__ __forceinline__ void r1_S1b(Frame& F, R1Ctx& X) {
    using namespace rk;
    int grp, w4, ti, tj, lane, tg; Ln l; LAS unsigned char* G; const f32x16 z16 = {};
    RK_RELANE(); (void)w4; (void)tg; (void)ti; (void)tj;
    const int item = X.item, c = X.c, h = X.h, b = X.b; (void)item; (void)c; (void)h; (void)b;
    {
        RK_KA(); const bf16* WupT = (const bf16*)(ka->ws + WS_WUPT); const bf16* AupT = (const bf16*)(ka->ws + WS_AUPT);
        const int kcol = 32 * tj + l.r, kc = h * HD + kcol;
        f32x16 W = z16, Aq = z16;
#pragma unroll
        for (int s = 0; s < 4; ++s) { const bf16x8 bw = *(const bf16x8*)(WupT + (size_t)kc * 64 + 16 * s + 8 * l.h), ba = *(const bf16x8*)(AupT + (size_t)kc * 64 + 16 * s + 8 * l.h);
            W = RK_MFMA(frag_row(s0, l, ti, s), bw, W); Aq = RK_MFMA(frag_row(s1, l, ti, s), ba, Aq); }
        const float w0 = hcst[448 + kcol], a0 = hcst[512 + kcol], kkc = hcst[384 + kcol], kac = hcst[576 + kcol], rkc = hcst[640 + kcol];
        float lw[16], L[16];
#pragma unroll
        for (int r = 0; r < 16; ++r) { const float x = W[r] + w0; const float sp = (-x > 20.f) ? -x : 0.6931471805599453f * __builtin_amdgcn_logf(1.0f + fexp(-x)); lw[r] = -fexp(-sp - 0.5f); Aq[r] = sigm(Aq[r] + a0); }
        float gs[4], go[4];
#pragma unroll
        for (int g = 0; g < 4; ++g) { L[4 * g] = lw[4 * g]; L[4 * g + 1] = L[4 * g] + lw[4 * g + 1]; L[4 * g + 2] = L[4 * g + 1] + lw[4 * g + 2]; L[4 * g + 3] = L[4 * g + 2] + lw[4 * g + 3]; gs[g] = L[4 * g + 3]; }
        float run = 0.f;
#pragma unroll
        for (int g = 0; g < 4; ++g) { const float og = xhalf(gs[g]); const float lo = l.h ? og : gs[g], hi = l.h ? gs[g] : og;
            go[g] = run + (l.h ? lo : 0.f); run += lo + hi; }
#pragma unroll
        for (int r = 0; r < 16; ++r) L[r] += go[r >> 2];
        if (ti == 0 && l.h == 0) ltot[kcol] = run;
        r1_gbar(F, X.bcnt);
        if (ti == 1) { const float add = ltot[kcol];
#pragma unroll
            for (int r = 0; r < 16; ++r) L[r] += add;
            if (l.h == 1) gam[kcol] = fexp(L[15]); }
        f32x16 At, Bt, Kt, Rt; float xb[16];
#pragma unroll
        for (int r = 0; r < 16; ++r) { const int t = 32 * ti + crow(r, l.h);
            const float rr = bf2f(*(const LAS unsigned short*)(s2 + t * P + kcol * 2)), kx = bf2f(*(const LAS unsigned short*)(s3 + t * P + kcol * 2));
            const float kn = kx * kkc * nrminv[t], a = Aq[r], km = kx * (1.0f + (a - 1.0f) * kac);
            const float eL = fexp(L[r]), eLn = fexp(-L[r]), eLp = fexp(L[r] - lw[r]);
            At[r] = -kn * eLp; Bt[r] = kn * a * eLn; Kt[r] = km * eLn; Rt[r] = rr * eL; xb[r] = rr * km * rkc; }
#pragma unroll
        for (int r = 0; r < 16; ++r) xb[r] = dpp_sum32(xb[r]);
        if (l.r == 31) {
#pragma unroll
            for (int r = 0; r < 16; ++r) bonp[tj * 64 + 32 * ti + crow(r, l.h)] = xb[r]; }
        store_T(s0, l, At, ti, tj); store_T(s1, l, Bt, ti, tj); store_T(s5, l, Kt, ti, tj); store_T(s6, l, Rt, ti, tj);
    }
}
__device__ __forceinline__ void r1_S2(Frame& F, R1Ctx& X) {
    using namespace rk;
    int grp, w4, ti, tj, lane, tg; Ln l; LAS unsigned char* G; const f32x16 z16 = {};
    RK_RELANE(); (void)w4; (void)tg; (void)ti; (void)tj;
    const int item = X.item, c = X.c, h = X.h, b = X.b; (void)item; (void)c; (void)h; (void)b;
    unsigned pf0 = 0u, pf1 = 0u;
    if (X.nb >= 0) { RK_KA(); const bf16* RW = (const bf16*)(ka->ws + WS_RW);
        { const int j = tg; const int rr = j / 6, pc = j % 6; const long sq = (long)X.nb * SEQ + X.nc * 64 + rr - 1;
          if (sq >= (long)X.nb * SEQ) pf0 = *(const volatile unsigned char*)(RW + (size_t)sq * RWC + (pc < 4 ? pc * 512 + X.nh * HD : 2048 + (pc - 4) * 64)); }
        { const int j = tg + 256; const int rr = j / 6, pc = j % 6; const long sq = (long)X.nb * SEQ + X.nc * 64 + rr - 1;
          if (j < 65 * 6) pf1 = *(const volatile unsigned char*)(RW + (size_t)sq * RWC + (pc < 4 ? pc * 512 + X.nh * HD : 2048 + (pc - 4) * 64)); } }
    {
        f32x16 X = z16;
        if (ti >= tj) {
#pragma unroll
            for (int s = 0; s < 4; ++s) X = RK_MFMA(frag_tr(s0, l, ti, s), frag_tr(s5, l, tj, s), X);
#pragma unroll
            for (int r = 0; r < 16; ++r) { const int t = 32 * ti + crow(r, l.h), i = 32 * tj + l.r; if (!(t > i)) X[r] = 0.f; } }
        store_T(s2, l, X, ti, tj);
        if (w4 == 0 || w4 == 3) { const int d = w4 == 3;
            f32x16 S = z16, ST = z16;
#pragma unroll
            for (int s = 0; s < 4; ++s) { const bf16x8 fa = frag_tr(s0, l, d, s), fb = frag_tr(s1, l, d, s); S = RK_MFMA(fa, fb, S); ST = RK_MFMA(fb, fa, ST); }
#pragma unroll
            for (int r = 0; r < 16; ++r) { const int rw = crow(r, l.h); if (!(rw > l.r)) S[r] = 0.f; if (!(l.r > rw)) ST[r] = 0.f; }
            f32x16 D = S, DT = ST;
            tri_inv32(D, DT, S, ST);
            store_T(s7, l, D, d, d);
            asm volatile("s_waitcnt lgkmcnt(0)" ::: "memory");
            if (l.h == 0) *(LAS unsigned short*)(s7 + (32 * d + l.r) * P + (32 * d + l.r) * 2) = 0x3f80;
        } else if (w4 == 2) {
            f32x16 X21 = z16;
#pragma unroll
            for (int s = 0; s < 4; ++s) X21 = RK_MFMA(frag_tr(s0, l, 1, s), frag_tr(s1, l, 0, s), X21);
            store_T(s3, l, X21, 0, 0);
        } else {
            store_T(s7, l, z16, 0, 1);
            { RK_KA(); float* BON = (float*)(ka->ws + WS_BON); const int t = lane; BON[((size_t)b * SEQ + c * 64 + t) * NH + h] = bonp[t] + bonp[64 + t]; }
        }
    }
    asm volatile("" :: "v"(pf0), "v"(pf1));
}
__device__ __forceinline__ void r1_S3(Frame& F, R1Ctx& X) {
    using namespace rk;
    int grp, w4, ti, tj, lane, tg; Ln l; LAS unsigned char* G; const f32x16 z16 = {};
    RK_RELANE(); (void)w4; (void)tg; (void)ti; (void)tj;
    const int item = X.item, c = X.c, h = X.h, b = X.b; (void)item; (void)c; (void)h; (void)b;
    f32x16& Wt0 = X.Wt0; f32x16& Wt1 = X.Wt1;
    Wt0 = z16; Wt1 = z16;
    {
        if (w4 == 2) {
            f32x16 E = z16;
#pragma unroll
            for (int s = 0; s < 2; ++s) E = RK_MFMA(frag_tr(s3, l, 0, s), frag_row(s7, l, 0, s), E);
            store_T(s3, l, E, 0, 1);
            f32x16 T21 = z16;
#pragma unroll
            for (int s = 0; s < 2; ++s) T21 = RK_MFMA(frag_tr(s7, l, 1, s, 32), frag_row(s3, l, 1, s), T21);
            store_T(s7, l, T21, 1, 0);
        }
#pragma unroll
        for (int s = 0; s < 4; ++s) Wt0 = RK_MFMA(frag_tr(s2, l, 0, s), frag_tr(s4, l, tj, s), Wt0);
        if (ti == 1) {
#pragma unroll
            for (int s = 0; s < 4; ++s) Wt1 = RK_MFMA(frag_tr(s2, l, 1, s), frag_tr(s4, l, tj, s), Wt1); }
    }
}
__device__ __forceinline__ void r1_S4(Frame& F, R1Ctx& X) {
    using namespace rk;
    int grp, w4, ti, tj, lane, tg; Ln l; LAS unsigned char* G; const f32x16 z16 = {};
    RK_RELANE(); (void)w4; (void)tg; (void)ti; (void)tj;
    const int item = X.item, c = X.c, h = X.h, b = X.b; (void)item; (void)c; (void)h; (void)b;
    f32x16& Wt0 = X.Wt0; f32x16& Wt1 = X.Wt1;
    {
        f32x16 Ap = z16;
#pragma unroll
        for (int s = 0; s < 4; ++s) if (s < 2 || ti == 1) Ap = RK_MFMA(frag_tr(s7, l, ti, s), frag_row(s0, l, tj, s), Ap);
        f32x16 Uv = z16;
#pragma unroll
        for (int s = 0; s < 2; ++s) Uv = RK_MFMA(frag_tr_perm(s7, l, ti, s, 0), pack(Wt0, s), Uv);
        if (ti == 1) {
#pragma unroll
            for (int s = 0; s < 2; ++s) Uv = RK_MFMA(frag_tr_perm(s7, l, ti, s, 32), pack(Wt1, s), Uv); }
        store_T(s2, l, Ap, ti, tj); store_T(s3, l, Uv, ti, tj);
    }
}
__device__ __forceinline__ void r1_S5(Frame& F, R1Ctx& X) {
    using namespace rk;
    int grp, w4, ti, tj, lane, tg; Ln l; LAS unsigned char* G; const f32x16 z16 = {};
    RK_RELANE(); (void)w4; (void)tg; (void)ti; (void)tj;
    const int item = X.item, c = X.c, h = X.h, b = X.b; (void)item; (void)c; (void)h; (void)b;
    {
        RK_KA(); float* NT = (float*)((unsigned char*)ka->out + DO_NT); bf16* MT = (bf16*)((unsigned char*)ka->out + DO_MT); bf16* RH = (bf16*)((unsigned char*)ka->out + DO_RH); bf16* Y0 = (bf16*)(ka->ws + WS_GATE);
        const size_t ib = (size_t)((b * 64 + c) * NH + h) * 4096;
        f32x16 Xrb0 = z16, Xrk0 = z16, Xrb1 = z16, Xrk1 = z16;
#pragma unroll
        for (int s = 0; s < 4; ++s) { const bf16x8 fr = frag_tr(s6, l, ti, s); Xrb0 = RK_MFMA(frag_tr(s1, l, 0, s), fr, Xrb0); Xrk0 = RK_MFMA(frag_tr(s5, l, 0, s), fr, Xrk0); }
        if (ti == 1) {
#pragma unroll
            for (int s = 0; s < 4; ++s) { const bf16x8 fr = frag_tr(s6, l, ti, s); Xrb1 = RK_MFMA(frag_tr(s1, l, 1, s), fr, Xrb1); Xrk1 = RK_MFMA(frag_tr(s5, l, 1, s), fr, Xrk1); } }
#pragma unroll
        for (int r = 0; r < 16; ++r) { const bool keep = crow(r, l.h) <= l.r; if (ti == 0) { if (!keep) { Xrb0[r] = 0.f; Xrk0[r] = 0.f; } } else { if (!keep) { Xrb1[r] = 0.f; Xrk1[r] = 0.f; } } }
        f32x16 acc;
#pragma unroll
        for (int g = 0; g < 4; ++g) { const u32x2 w = *(const LAS u32x2*)(s6 + (32 * tj + l.r) * P + (32 * ti + 8 * g + 4 * l.h) * 2); acc[4 * g] = bflo(w.x); acc[4 * g + 1] = bfhi(w.x); acc[4 * g + 2] = bflo(w.y); acc[4 * g + 3] = bfhi(w.y); }
#pragma unroll
        for (int s = 0; s < 2; ++s) acc = RK_MFMA(pack(Xrb0, s), frag_row_perm(s2, l, tj, s, 0), acc);
        if (ti == 1) {
#pragma unroll
            for (int s = 0; s < 2; ++s) acc = RK_MFMA(pack(Xrb1, s), frag_row_perm(s2, l, tj, s, 32), acc); }
#pragma unroll
        for (int r = 0; r < 16; ++r) RH[ib + (32 * ti + crow(r, l.h)) * 64 + 32 * tj + l.r] = (bf16)f2bf(acc[r]);
        acc = z16;
#pragma unroll
        for (int s = 0; s < 2; ++s) { acc = RK_MFMA(pack(Xrb0, s), frag_row_perm(s3, l, tj, s, 0), acc); acc = RK_MFMA(pack(Xrk0, s), frag_tr_perm(s4, l, tj, s, 0), acc); }
        if (ti == 1) {
#pragma unroll
            for (int s = 0; s < 2; ++s) { acc = RK_MFMA(pack(Xrb1, s), frag_row_perm(s3, l, tj, s, 32), acc); acc = RK_MFMA(pack(Xrk1, s), frag_tr_perm(s4, l, tj, s, 32), acc); } }
#pragma unroll
        for (int r = 0; r < 16; ++r) Y0[ib + (32 * ti + crow(r, l.h)) * 64 + 32 * tj + l.r] = (bf16)f2bf(acc[r]);
        acc = z16;
#pragma unroll
        for (int s = 0; s < 4; ++s) acc = RK_MFMA(frag_row(s1, l, ti, s), frag_row(s2, l, tj, s), acc);
#pragma unroll
        for (int r = 0; r < 16; ++r) { const int kp = 32 * ti + crow(r, l.h), k = 32 * tj + l.r; const float v = (acc[r] + (kp == k ? 1.f : 0.f)) * gam[kp]; MT[ib + kp * 64 + k] = (bf16)f2bf(v); }
        acc = z16;
#pragma unroll
        for (int s = 0; s < 4; ++s) { acc = RK_MFMA(frag_row(s1, l, ti, s), frag_row(s3, l, tj, s), acc); acc = RK_MFMA(frag_row(s5, l, ti, s), frag_tr(s4, l, tj, s), acc); }
#pragma unroll
        for (int r = 0; r < 16; ++r) NT[ib + ((ti * 2 + tj) * 16 + r) * 64 + lane] = acc[r] * gam[32 * ti + crow(r, l.h)];
    }
}
__device__ __forceinline__ void r1_consts(Frame& F, int h) {
    using namespace rk;
    int t_ = F.tid; asm volatile("" : "+v"(t_)); const int grp = t_ >> 8, tg = t_ & 255; LAS unsigned char* G = F.lds + grp * GRP;
    for (int i = tg; i < 11 * 64; i += 256) { const int a = i >> 6, k = i & 63, col = h * HD + k; float v;
        switch (a) { case 0: v = F.mu[col]; break; case 1: v = F.mu[512 + col]; break; case 2: v = F.mu[1024 + col]; break; case 3: v = F.mu[1536 + col]; break; case 4: v = F.mu[2048 + k]; break; case 5: v = F.mu[2112 + k]; break;
                     case 6: v = F.k_k[col]; break; case 7: v = F.w0[col]; break; case 8: v = F.a0[col]; break; case 9: v = F.k_a[col]; break; default: v = F.r_k[col]; break; }
        hcst[i] = v; }
}
#ifndef MK_R1_REP
#define MK_R1_REP -1
#endif
__device__ __forceinline__ void rwkv_chunk_ops(Frame& F) {
    R1Ctx X; int cur_h = -1; X.bcnt = 0u; bool first = true;
    { int t_ = F.tid; asm volatile("" : "+v"(t_)); if ((t_ & 255) == 0) *(LAS unsigned*)(F.lds + (t_ >> 8) * rk::GRP + rk::MISC + 8000) = 0u; }
    __syncthreads();
    for (int ip = F.vcu; ip < BATCH * NH * 64 / 2; ip += F.G) {
        { const int hh = ((ip * 2) >> 6) % NH; if (hh != cur_h) { r1_consts(F, hh); cur_h = hh; __syncthreads(); } }
#if MK_R1_GBAR
        if (first) { first = false; if (F.wave >= 4) { for (int i_ = 0; i_ < MK_R1_GBAR * 3; ++i_) __builtin_amdgcn_s_sleep(127); } }
#endif
        { int t_ = F.tid; asm volatile("" : "+v"(t_)); const int grp = t_ >> 8; X.item = ip * 2 + grp; X.c = X.item & 63; const int bh = X.item >> 6; X.h = bh % NH; X.b = bh / NH;
          const int nit = (ip + F.G) * 2 + grp; const int nbh = nit >> 6; X.nc = nit & 63; X.nh = nbh % NH; X.nb = (ip + F.G < BATCH * NH * 64 / 2) ? nbh / NH : -1; }
        r1_S1a(F, X); r1_gbar(F, X.bcnt);
        if constexpr (MK_R1_REP == 0) { r1_S1a(F, X); r1_gbar(F, X.bcnt); }
        r1_S1b(F, X); r1_gbar(F, X.bcnt);
        if constexpr (MK_R1_REP == 1) { r1_S1a(F, X); r1_gbar(F, X.bcnt); r1_S1b(F, X); r1_gbar(F, X.bcnt); }
        r1_S2(F, X); r1_gbar(F, X.bcnt);
        if constexpr (MK_R1_REP == 2) { r1_S2(F, X); r1_gbar(F, X.bcnt); }
        r1_S3(F, X); r1_gbar(F, X.bcnt);
        r1_S4(F, X); r1_gbar(F, X.bcnt);
        r1_S5(F, X); r1_gbar(F, X.bcnt);
        if constexpr (MK_R1_REP == 5) { r1_S5(F, X); r1_gbar(F, X.bcnt); }
    }
}
#undef s0
#undef s1
#undef s2
#undef s3
#undef s4
#undef s5
#undef s6
#undef s7
#undef nrminv
#undef ltot
#undef gam
#undef bonp
#undef hcst
__device__ __forceinline__ void rwkv_relay(Frame& F) {
    using namespace rk;
    const int lane = F.lane, wid = F.wave; const int lr = lane & 31, lh = lane >> 5;
    LAS float* sbuf = (LAS float*)F.lds; volatile LAS int* flag = (volatile LAS int*)(F.lds + 16384);
    const float* NT = (const float*)((unsigned char*)F.out + DO_NT); bf16* MT = (bf16*)((unsigned char*)F.out + DO_MT);
    for (int ch = F.vcu; ch < BATCH * NH * 2; ch += F.G) {
        const int bh = ch >> 1, ct = ch & 1;
        __syncthreads();
        for (int i = F.tid; i < 2048; i += NTHR) sbuf[i] = 0.f;
        if (F.tid == 0) flag[0] = 0;
        __syncthreads();
        for (int c = wid; c < 64; c += NWAVES) {
            const size_t ib = (size_t)(((bh >> 3) * 64 + c) * NH + (bh & 7)) * 4096;
            bf16x8 am[2][4]; f32x16 sn[2];
#pragma unroll
            for (int rt = 0; rt < 2; ++rt)
#pragma unroll
                for (int s = 0; s < 4; ++s) { const bf16* pm = MT + ib + (32 * rt + lr) * 64 + 16 * s + 4 * lh;
                    const v2u m0 = *(const v2u*)pm, m1 = *(const v2u*)(pm + 8);
                    am[rt][s] = __builtin_bit_cast(bf16x8, (u32x4){m0.x, m0.y, m1.x, m1.y}); }
#pragma unroll
            for (int rt = 0; rt < 2; ++rt)
#pragma unroll
                for (int r = 0; r < 16; ++r) sn[rt][r] = __builtin_nontemporal_load(NT + ib + ((rt * 2 + ct) * 16 + r) * 64 + lane);
            while (flag[0] < c) __builtin_amdgcn_s_sleep(1);
            asm volatile("s_waitcnt lgkmcnt(0)" ::: "memory");
            const LAS float* sin = sbuf + (c & 1) * 2048; LAS float* sout = sbuf + ((c + 1) & 1) * 2048;
            bf16x8 sp[2][2];
#pragma unroll
            for (int kt = 0; kt < 2; ++kt) { f32x16 sv;
#pragma unroll
                for (int r = 0; r < 16; ++r) sv[r] = sin[(kt * 16 + r) * 64 + lane];
                sp[kt][0] = pack(sv, 0); sp[kt][1] = pack(sv, 1); }
#pragma unroll
            for (int s = 0; s < 4; ++s)
#pragma unroll
                for (int rt = 0; rt < 2; ++rt) sn[rt] = RK_MFMA(am[rt][s], sp[s >> 1][s & 1], sn[rt]);
#pragma unroll
            for (int rt = 0; rt < 2; ++rt)
#pragma unroll
                for (int r = 0; r < 16; ++r) sout[(rt * 16 + r) * 64 + lane] = sn[rt][r];
            asm volatile("s_waitcnt lgkmcnt(0)" ::: "memory");
            if (lane == 0) flag[0] = c + 1;
            bf16* sc = (bf16*)(F.ws + WS_SC) + ib;
#pragma unroll
            for (int kt = 0; kt < 2; ++kt)
#pragma unroll
                for (int sl = 0; sl < 2; ++sl) *(bf16x8*)(sc + (((kt * 2 + ct) * 2 + sl) * 64 + lane) * 8) = sp[kt][sl];
        }
    }
}

struct R2Tile { v4u y0[4], cv[4], pv[4], cz[4], pz[4]; float bon, pm; };
__device__ __forceinline__ void r2_load_tile(R2Tile& T, const bf16* Y0, const bf16* RW, const float* BON, size_t ib, int b, int h, int c, int tt, int lane) {
    const int q = lane >> 1, c0 = (lane & 1) * 32; const int sq = c * 64 + tt * 32 + q; const size_t row = (size_t)b * SEQ + sq;
    const v4u* y0p = (const v4u*)(Y0 + ib + (tt * 32 + q) * 64 + c0);
    const bf16* cur = RW + row * RWC + h * HD + c0; const bool hasp = sq > 0; const bf16* prv = hasp ? cur - RWC : cur; T.pm = hasp ? 1.f : 0.f;
#pragma unroll
    for (int i = 0; i < 4; ++i) { T.y0[i] = __builtin_nontemporal_load(y0p + i); T.cv[i] = *((const v4u*)(cur + 1024) + i); T.pv[i] = *((const v4u*)(prv + 1024) + i); T.cz[i] = *((const v4u*)(cur + 1536) + i); T.pz[i] = *((const v4u*)(prv + 1536) + i); }
    T.bon = BON[row * NH + h];
}
__device__ __forceinline__ void rwkv_output(Frame& F) {
    using namespace rk;
    const int wid = F.wave;
    LAS float* yst = (LAS float*)(F.lds + wid * 8704); LAS float* cst = (LAS float*)(F.lds + 69632);
    bf16* QKVZ = (bf16*)(F.ws + WS_QKVZ); const bf16* RW = (const bf16*)(F.ws + WS_RW);
    const bf16* SC = (const bf16*)(F.ws + WS_SC); const bf16* RH = (const bf16*)((unsigned char*)F.out + DO_RH);
    const bf16* Y0 = (const bf16*)(F.ws + WS_GATE); const float* BON = (const float*)(F.ws + WS_BON);
    __syncthreads();
    for (int i = F.tid; i < 4 * 512; i += NTHR) { const int a = i >> 9, col = i & 511; cst[i] = a == 0 ? F.ln_w[col] : a == 1 ? F.ln_b[col] : a == 2 ? F.mu[1024 + col] : F.mu[1536 + col]; }
    __syncthreads();
    const int gw = F.vcu * NWAVES + wid, NGW = F.G * NWAVES;
    for (int idx = gw; idx < BATCH * NH * 64; idx += NGW) {
        const int h = idx & 7, c = (idx >> 3) & 63, b = idx >> 9; const size_t ib = (size_t)idx * 4096;
        bf16x8 sp[2][2][2];
        { const int lane = F.lane;
#pragma unroll
          for (int kt = 0; kt < 2; ++kt)
#pragma unroll
              for (int ct = 0; ct < 2; ++ct)
#pragma unroll
                  for (int sl = 0; sl < 2; ++sl) sp[kt][ct][sl] = __builtin_nontemporal_load((const bf16x8*)(SC + ib + (((kt * 2 + ct) * 2 + sl) * 64 + lane) * 8)); }
#pragma unroll 1
        for (int tt = 0; tt < 2; ++tt) {
            int lane_ = F.tid; asm volatile("" : "+v"(lane_)); const int lane = lane_ & 63, lr = lane & 31, lh = lane >> 5;
            bf16x8 ar[4];
#pragma unroll
            for (int s = 0; s < 4; ++s) { const bf16* pr = RH + ib + (32 * tt + lr) * 64 + 16 * s + 4 * lh; const v2u r0 = __builtin_nontemporal_load((const v2u*)pr), r1 = __builtin_nontemporal_load((const v2u*)(pr + 8));
                ar[s] = __builtin_bit_cast(bf16x8, (u32x4){r0.x, r0.y, r1.x, r1.y}); }
            R2Tile T; r2_load_tile(T, Y0, RW, BON, ib, b, h, c, tt, lane);
            f32x16 y0 = {}, y1 = {};
#ifndef MK_R2B_X
#define MK_R2B_X 0
#endif
#pragma unroll 1
            for (int rep2 = 0; rep2 < (MK_R2B_X == 2 ? 4 : 1); ++rep2) {
            y0 = f32x16{}; y1 = f32x16{};
#pragma unroll
            for (int s = 0; s < 4; ++s) { y0 = RK_MFMA(ar[s], sp[s >> 1][0][s & 1], y0); y1 = RK_MFMA(ar[s], sp[s >> 1][1][s & 1], y1); }
#pragma unroll
            for (int r = 0; r < 16; ++r) { yst[crow(r, lh) * 68 + lr] = y0[r]; yst[crow(r, lh) * 68 + 32 + lr] = y1[r]; }
            asm volatile("s_waitcnt lgkmcnt(0)" ::: "memory"); }
            const int q = lane >> 1, c0 = (lane & 1) * 32; const int sq = c * 64 + tt * 32 + q; const size_t row = (size_t)b * SEQ + sq;
            const LAS float* cs = cst + h * HD + c0;
            float y[32];
#pragma unroll 1
            for (int rep1 = 0; rep1 < (MK_R2B_X == 1 ? 4 : 1); ++rep1) {
#pragma unroll
            for (int e = 0; e < 32; e += 8) { const f32x4 a = *(const LAS f32x4*)(yst + q * 68 + c0 + e), bq = *(const LAS f32x4*)(yst + q * 68 + c0 + e + 4); const v4u w = T.y0[e >> 3];
                y[e] = a[0] + bflo(w.x); y[e + 1] = a[1] + bfhi(w.x); y[e + 2] = a[2] + bflo(w.y); y[e + 3] = a[3] + bfhi(w.y); y[e + 4] = bq[0] + bflo(w.z); y[e + 5] = bq[1] + bfhi(w.z); y[e + 6] = bq[2] + bflo(w.w); y[e + 7] = bq[3] + bfhi(w.w); }
            float sm = 0.f;
#pragma unroll
            for (int e = 0; e < 32; ++e) sm += y[e];
            sm += __shfl_xor(sm, 1); const float mean = sm * (1.f / 64.f);
            float sv = 0.f;
#pragma unroll
            for (int e = 0; e < 32; ++e) { const float d = y[e] - mean; sv += d * d; }
            sv += __shfl_xor(sv, 1); const float rstd = frsq(sv * (1.f / 64.f) + GN_EPS);
            const float bon = T.bon;
#pragma unroll
            for (int e = 0; e < 32; e += 8) { const v4u cvw = T.cv[e >> 3], pvw = T.pv[e >> 3], czw = T.cz[e >> 3], pzw = T.pz[e >> 3];
                float o[8];
#pragma unroll
                for (int j4 = 0; j4 < 8; j4 += 4) {
                    const f32x4 lw = *(const LAS f32x4*)(cs + e + j4), lb = *(const LAS f32x4*)(cs + 512 + e + j4), mv = *(const LAS f32x4*)(cs + 1024 + e + j4), mz = *(const LAS f32x4*)(cs + 1536 + e + j4);
#pragma unroll
                    for (int jj = 0; jj < 4; ++jj) { const int j = j4 + jj; const unsigned wcv = cvw[j >> 1], wpv = pvw[j >> 1], wcz = czw[j >> 1], wpz = pzw[j >> 1];
                        const float xv = (j & 1) ? bfhi(wcv) : bflo(wcv), yv = T.pm * ((j & 1) ? bfhi(wpv) : bflo(wpv)), xz = (j & 1) ? bfhi(wcz) : bflo(wcz), yz = T.pm * ((j & 1) ? bfhi(wpz) : bflo(wpz));
                        const float vv = xv + (yv - xv) * mv[jj], zz = xz + (yz - xz) * mz[jj];
                        o[j] = ((y[e + j] - mean) * rstd * lw[jj] + lb[jj] + bon * vv) * (zz * sigm(zz)); }
                    __builtin_amdgcn_sched_barrier(0); }
                *(LAS v4u*)((LAS bf16*)yst + q * 72 + c0 + e) = (v4u){pk2(o[0], o[1]), pk2(o[2], o[3]), pk2(o[4], o[5]), pk2(o[6], o[7])}; }
            asm volatile("s_waitcnt lgkmcnt(0)" ::: "memory");
#pragma unroll
            for (int i = 0; i < 4; ++i) { const int rr = i * 8 + (lane >> 3), chk = lane & 7; const v4u w = *(const LAS v4u*)((LAS bf16*)yst + rr * 72 + chk * 8);
                *(v4u*)(QKVZ + ((size_t)b * SEQ + c * 64 + tt * 32 + rr) * QP + 512 + h * HD + chk * 8) = w; }
            asm volatile("s_waitcnt lgkmcnt(0)" ::: "memory"); }
        }
    }
}
#define BAR_ST ((volatile LAS unsigned*)(F.lds + 163832))
constexpr int LDS_BYTES = 163840;
constexpr int NPHASE = 13;

template <int PLO, int PHI> __global__ void __launch_bounds__(NTHR, 2) fwd(Args args) {
    extern __shared__ __attribute__((aligned(16))) unsigned char lds[];
    Frame F;
    F.lds = (LAS unsigned char*)lds;
#define RETID() do { int t_ = threadIdx.x; asm volatile("" : "+v"(t_)); F.tid = t_; F.lane = t_ & 63; F.wave = __builtin_amdgcn_readfirstlane(t_ >> 6); \
    int bx_ = blockIdx.x, g_ = gridDim.x; asm volatile("" : "+s"(bx_), "+s"(g_)); F.G = g_; F.vcu = (g_ % 8 == 0) ? (bx_ % 8) * (g_ / 8) + bx_ / 8 : bx_; } while (0)
    RETID();
    if (threadIdx.x == 0) { BAR_ST[0] = 0u; BAR_ST[1] = 0u; }
    if constexpr (PHI - PLO > 1) xcd_barrier_post((unsigned*)(args.ws + WS_BAR));
    if (args.ph_hi == 0x7fffffff) cg::this_grid().sync();
#define LOADF() do { const __attribute__((address_space(4))) Args* ap_ = (const __attribute__((address_space(4))) Args*)__builtin_amdgcn_kernarg_segment_ptr(); asm volatile("" : "+s"(ap_)); \
    F.x = ap_->in[0]; F.p = ap_->in[1]; F.g_pre = ap_->in[2]; F.w_in = ap_->in[3]; F.rel_bias = ap_->in[4]; F.mu = ap_->in[5]; F.w0 = ap_->in[6]; F.w_up = ap_->in[7]; \
    F.a0 = ap_->in[8]; F.a_up = ap_->in[9]; F.k_k = ap_->in[10]; F.k_a = ap_->in[11]; F.r_k = ap_->in[12]; F.ln_w = ap_->in[13]; F.ln_b = ap_->in[14]; \
    F.p_a = ap_->in[15]; F.p_b = ap_->in[16]; F.w_out = ap_->in[17]; F.g_post = ap_->in[18]; F.w_pu = ap_->in[19]; F.w_pg = ap_->in[20]; F.out = ap_->out; F.ws = ap_->ws; ws = F.ws; \
    U2 = (pg8::bf16_t*)F.out; MERGED = (pg8::bf16_t*)(ws + WS_RW); QKVZ = (pg8::bf16_t*)(ws + WS_QKVZ); RWb = (pg8::bf16_t*)(ws + WS_RW); GAB = (pg8::bf16_t*)(ws + WS_GAB); } while (0)
    unsigned char* ws; pg8::bf16_t *U2, *MERGED, *QKVZ, *RWb, *GAB;
    constexpr int lo = PLO, hi = PHI;
    cg::grid_group grid = cg::this_grid();
#define IN(k) (lo <= (k) && (k) < hi)
#define GRIDBAR() do { const __attribute__((address_space(4))) Args* apb_ = (const __attribute__((address_space(4))) Args*)__builtin_amdgcn_kernarg_segment_ptr(); asm volatile("" : "+s"(apb_)); \
    xcd_barrier((unsigned*)(apb_->ws + WS_BAR), BAR_ST); } while (0)
#define SEAM(k) do { if constexpr (IN(k) && IN((k) + 1)) GRIDBAR(); } while (0)
#ifndef MK_REPEAT_PHASE
#define MK_REPEAT_PHASE -1
#endif
#define NREP(k) (((k) == MK_REPEAT_PHASE) ? 2 : 1)
#ifndef MK_STAGM
#define MK_STAGM 3
#endif
#define STAGGER(steps) do { const int d_ = (F.vcu & MK_STAGM) * (steps); for (int i_ = 0; i_ < d_; ++i_) __builtin_amdgcn_s_sleep(107); } while (0)
#ifndef MK_SELFUSE
#define MK_SELFUSE 0
#endif
#ifndef MK_STAG4
#define MK_STAG4 0
#endif
#ifndef MK_STAG5
#define MK_STAG5 0
#endif
#ifndef MK_STAG7
#define MK_STAG7 0
#endif

#define P0SEQ() do { RETID(); LOADF(); p0_xpass(F); pro_side(F, 0, F.vcu * NWAVES + F.wave, F.G * NWAVES, F.vcu * NTHR + F.tid, F.G * NTHR); GRIDBAR(); \
    RETID(); LOADF(); p0_kmean(F); GRIDBAR(); RETID(); LOADF(); p0_gvec(F); } while (0)
    if constexpr (IN(0)) { P0SEQ(); if constexpr (0 == MK_REPEAT_PHASE) { GRIDBAR(); P0SEQ(); } } SEAM(0);
#ifdef MK_BWTEST
    if constexpr (IN(1)) { RETID(); LOADF();
        const f32x4* xp = (const f32x4*)F.x; f32x4 acc = {0.f, 0.f, 0.f, 0.f};
        const int gw = F.vcu * NWAVES + F.wave, NGW = F.G * NWAVES;
        if (MK_BWTEST == 1) { const size_t n4 = (size_t)M * DM / 4;
            for (size_t i = (size_t)F.vcu * NTHR + F.tid; i + (size_t)31 * F.G * NTHR < n4; i += (size_t)32 * F.G * NTHR) { f32x4 t[32];
#pragma unroll
                for (int j = 0; j < 32; ++j) t[j] = xp[i + (size_t)j * F.G * NTHR];
#pragma unroll
                for (int j = 0; j < 32; ++j) acc += t[j]; }
        } else {
            for (int it = gw; it < (M / 32) * 8; it += NGW) { const int rg = it >> 3, cb = it & 7; const int q = F.lane >> 1, hf = F.lane & 1;
                const f32x4* p = xp + ((size_t)(rg * 32 + q) * DM + cb * 128 + hf * 64) / 4; f32x4 t[16];
#pragma unroll
                for (int j = 0; j < 16; ++j) t[j] = p[j];
#pragma unroll
                for (int j = 0; j < 16; ++j) acc += t[j]; } }
        if (acc[0] + acc[1] + acc[2] + acc[3] == 1.2345e30f) ((float*)(ws + WS_RSY))[F.tid] = acc[0];
        grid.sync(); }
#endif
    if constexpr (IN(1)) { RETID(); LOADF();
#ifndef MK_STAG1
#define MK_STAG1 2
#endif
        STAGGER(MK_STAG1);
        { pg8::Gemm g{U2, (const pg8::bf16_t*)(ws + WS_WIN), M, INCP, DM, 2048, WINP, 0, 0}; pg8::StaticOrder S; S.init(M, INCP, F.G, (int)blockIdx.x);
          pg8::EpiCols E{QKVZ, RWb, GAB, QSCALE};
          pg8::gemm_phase<pg8::EpiCols, pg8::StaticOrder, true, true>(F.lds, g, S, E);
          if constexpr (MK_REPEAT_PHASE == 101) { __syncthreads(); pg8::gemm_phase<pg8::EpiCols, pg8::StaticOrder, true, true>(F.lds, g, S, E); } }
        { pg8::Gemm g{U2, (const pg8::bf16_t*)(ws + WS_WG), M, 256, 2048, 2048, 2048, 16, (size_t)256 * 2048}; pg8::StaticOrder S; S.init(M, 256, F.G, (int)blockIdx.x);
          pg8::EpiGate E{(float*)(ws + WS_GATE)};
          pg8::gemm_phase<pg8::EpiGate, pg8::StaticOrder, true, true>(F.lds, g, S, E);
          if constexpr (MK_REPEAT_PHASE == 102) { __syncthreads(); pg8::gemm_phase<pg8::EpiGate, pg8::StaticOrder, true, true>(F.lds, g, S, E); }
#if MK_SELFUSE
          __syncthreads();
          { pg8::Unit u; for (int i = 0; S.next(i, u); ++i) { RETID(); attn_select(F, (const float*)(ws + WS_GATE), (unsigned*)(ws + WS_CNT), (unsigned short*)(ws + WS_LISTS), u.pm); } }
#endif
        }
    } SEAM(1);
#ifdef MK_SYNCTEST
    for (int i_ = 0; i_ < 20; ++i_) GRIDBAR();
#endif
#if !MK_SELFUSE
    if constexpr (IN(2)) { RETID(); LOADF(); attn_select(F, (const float*)(ws + WS_GATE), (unsigned*)(ws + WS_CNT), (unsigned short*)(ws + WS_LISTS));
        if constexpr (2 == MK_REPEAT_PHASE) { GRIDBAR(); if (blockIdx.x == 0) for (int i = threadIdx.x; i < 2048; i += NTHR) ((unsigned*)(args.ws + WS_CNT))[i] = 0u; GRIDBAR(); RETID(); LOADF();
            attn_select(F, (const float*)(ws + WS_GATE), (unsigned*)(ws + WS_CNT), (unsigned short*)(ws + WS_LISTS)); } } SEAM(2);
#endif
    if constexpr (IN(3)) { RETID(); LOADF(); attn_partial(F, (const bf16*)(ws + WS_QKVZ), (const unsigned*)(ws + WS_CNT), (const unsigned short*)(ws + WS_LISTS),
                                         (bf16*)((unsigned char*)F.out + DO_PARTO), (float*)((unsigned char*)F.out + DO_PARTML), (unsigned*)(ws + WS_QCTR)); if constexpr (3 == MK_REPEAT_PHASE) { { GRIDBAR(); if (blockIdx.x == 0 && threadIdx.x == 0) *(unsigned*)(args.ws + WS_QCTR) = 0u; GRIDBAR(); } RETID(); LOADF(); attn_partial(F, (const bf16*)(ws + WS_QKVZ), (const unsigned*)(ws + WS_CNT), (const unsigned short*)(ws + WS_LISTS),
                                         (bf16*)((unsigned char*)F.out + DO_PARTO), (float*)((unsigned char*)F.out + DO_PARTML), (unsigned*)(ws + WS_QCTR)); } } SEAM(3);
    if constexpr (IN(4)) { RETID(); LOADF();
        if constexpr (4 == MK_REPEAT_PHASE) { attn_own_combine(F, (bf16*)(ws + WS_QKVZ), (const bf16*)((unsigned char*)F.out + DO_PARTO), (const float*)((unsigned char*)F.out + DO_PARTML), (bf16*)(ws + WS_GATE), 512); grid.sync(); RETID(); LOADF(); }
        STAGGER(MK_STAG4);
        attn_own_combine(F, (bf16*)(ws + WS_QKVZ), (const bf16*)((unsigned char*)F.out + DO_PARTO), (const float*)((unsigned char*)F.out + DO_PARTML), (bf16*)(ws + WS_QKVZ), QP); } SEAM(4);
    if constexpr (IN(5)) { RETID(); LOADF(); STAGGER(MK_STAG5); rwkv_chunk_ops(F); if constexpr (5 == MK_REPEAT_PHASE) { GRIDBAR(); RETID(); LOADF(); rwkv_chunk_ops(F); } } SEAM(5);
    if constexpr (IN(6)) { RETID(); LOADF(); rwkv_relay(F); if constexpr (6 == MK_REPEAT_PHASE) { GRIDBAR(); RETID(); LOADF(); rwkv_relay(F); } } SEAM(6);
    if constexpr (IN(7)) { RETID(); LOADF(); STAGGER(MK_STAG7); rwkv_output(F); if constexpr (7 == MK_REPEAT_PHASE) { GRIDBAR(); RETID(); LOADF(); rwkv_output(F); } } SEAM(7);
#ifndef MK_STAG8
#define MK_STAG8 0
#endif
#ifndef MK_STAG10
#define MK_STAG10 0
#endif
#ifndef MK_STAG12
#define MK_STAG12 0
#endif
    if constexpr (IN(8)) { RETID(); LOADF(); STAGGER(MK_STAG8);
        pg8::Gemm g{QKVZ, (const pg8::bf16_t*)(ws + WS_PAB), M, DM, 1024, QP, 1024, 0, 0}; pg8::StaticOrder S; S.init(M, DM, F.G, (int)blockIdx.x);
        pg8::EpiMergeFused E{MERGED, DM, GAB, GP};
        pg8::gemm_phase<pg8::EpiMergeFused, pg8::StaticOrder, true, true>(F.lds, g, S, E);
    } SEAM(9);
    if constexpr (IN(10)) { RETID(); LOADF(); STAGGER(MK_STAG10);
        pg8::bf16_t* YB = RWb + (size_t)M * DM;
        pg8::Gemm g{MERGED, (const pg8::bf16_t*)(ws + WS_WOUT), M, DM, DM, DM, DM, 0, 0}; pg8::StaticOrder S; S.init(M, DM, F.G, (int)blockIdx.x); pg8::EpiYStatG E{YB, DM, (float*)(ws + WS_PARTS)};
        pg8::gemm_phase<pg8::EpiYStatG, pg8::StaticOrder, true, true>(F.lds, g, S, E);
    } SEAM(10);
    if constexpr (IN(11)) { RETID(); LOADF();
        const pg8::bf16_t* YB = RWb + (size_t)M * DM;
        for (int pm = F.vcu; pm < M / 256; pm += F.G) panel_norm(F, pm, (const bf16*)YB, (bf16*)QKVZ, (float*)(ws + WS_RSY), (const f32x4*)(ws + WS_PARTS), pm * 256);
    } SEAM(11);
    if constexpr (IN(12)) { RETID(); LOADF(); STAGGER(MK_STAG12);
        pg8::bf16_t* H1B = QKVZ;
        pg8::Gemm g{H1B, (const pg8::bf16_t*)(ws + WS_WPG), M, DM, ACP, ACP, ACP, 0, 0}; pg8::StaticOrder S; S.init(M, DM, F.G, (int)blockIdx.x);
        pg8::EpiFinal E{F.out, H1B + PLE, (pg8::u32x4*)((unsigned char*)GAB + (size_t)F.vcu * 131072), DM, ACP, F.tid};
        pg8::gemm_phase<pg8::EpiFinal, pg8::StaticOrder, true, true>(F.lds, g, S, E);
    }
#undef IN
#undef SEAM
}

#ifndef MK_ONE_LAUNCH
#define MK_ONE_LAUNCH 1
#endif
extern "C" void kernel_launch(void* const* d_in, const int* in_sizes, int n_in, void* d_out, int out_size, void* d_ws, size_t ws_size, hipStream_t stream) {
    static int grid = 0;
    if (grid == 0) {
        if (n_in != 21 || out_size != M * DM || ws_size < WS_END) { fprintf(stderr, "kernel_launch: unexpected shapes n_in %d out %d ws %zu\n", n_in, out_size, ws_size); grid = -1; return; }
        int dev = 0, cus = 0, per_cu = 0;
        (void)hipGetDevice(&dev); (void)hipDeviceGetAttribute(&cus, hipDeviceAttributeMultiprocessorCount, dev);
        (void)per_cu;
        grid = cus;
    }
    if (grid < 0) return;
    if (hipMemsetAsync(d_ws, 0, 65536, stream) != hipSuccess) { fprintf(stderr, "kernel_launch: hipMemsetAsync of the control words failed\n"); return; }
    Args a{};
    for (int i = 0; i < 21; ++i) a.in[i] = (const float*)d_in[i];
    a.out = (float*)d_out; a.ws = (unsigned char*)d_ws;
#if MK_ONE_LAUNCH
    a.ph_lo = 0; a.ph_hi = NPHASE;
    void* kargs[] = {&a};
    (void)hipFuncSetAttribute((const void*)fwd<0, NPHASE>, hipFuncAttributeMaxDynamicSharedMemorySize, LDS_BYTES);
    hipError_t e = hipLaunchCooperativeKernel((const void*)fwd<0, NPHASE>, dim3(grid), dim3(NTHR), kargs, LDS_BYTES, stream);
    if (e != hipSuccess) fprintf(stderr, "cooperative launch failed: %s\n", hipGetErrorString(e));
#else
#define LAUNCH_PH(k) do { (void)hipFuncSetAttribute((const void*)fwd<k, k + 1>, hipFuncAttributeMaxDynamicSharedMemorySize, LDS_BYTES); a.ph_lo = k; a.ph_hi = k + 1; hipLaunchKernelGGL((fwd<k, k + 1>), dim3(grid), dim3(NTHR), LDS_BYTES, stream, a); } while (0)
    LAUNCH_PH(0); LAUNCH_PH(1); LAUNCH_PH(2); LAUNCH_PH(3); LAUNCH_PH(4); LAUNCH_PH(5); LAUNCH_PH(6); LAUNCH_PH(7); LAUNCH_PH(8); LAUNCH_PH(9); LAUNCH_PH(10); LAUNCH_PH(11); LAUNCH_PH(12);
#endif
}
```

```cpp
#include <hip/hip_runtime.h>
#include <hip/hip_cooperative_groups.h>
#include <cstdio>
#include <cstdint>
#include <cmath>
namespace cg = cooperative_groups;
namespace pg8 {
#define PG8_LAS __attribute__((address_space(3)))
typedef unsigned short bf16_t;
typedef short bf16x8 __attribute__((ext_vector_type(8)));
typedef float f32x4 __attribute__((ext_vector_type(4)));
typedef float f32x2 __attribute__((ext_vector_type(2)));
typedef unsigned u32x4 __attribute__((ext_vector_type(4)));
typedef unsigned u32x2 __attribute__((ext_vector_type(2)));
constexpr int BM = 256, BK = 64, HALF = 128, HTB = HALF * BK * 2  , STAGE_BYTES = 8 * HTB, NXCD = 8, WGM = 8;

__host__ __device__ __forceinline__ int lds_byte(int r, int c) { const int st = (r >> 4) * 2 + (c >> 5), rr = r & 15, cc = c & 31, ob = rr * 64 + cc * 2; return st * 1024 + (ob ^ (((ob >> 9) & 1) << 5)); }
__host__ __device__ __forceinline__ void stage_rc(int b, int& R, int& C) { const int st = b / 1024, sb = b % 1024, swz = sb ^ (((sb >> 9) & 1) << 5); R = (st >> 1) * 16 + swz / 64; C = (st & 1) * 32 + (swz % 64) / 2; }
__host__ __device__ __forceinline__ int perm32(int rho) { const int n = rho >> 4, i = rho & 15; return 8 * (i >> 2) + 4 * n + (i & 3); }

struct Unit { int pm, pn; };
struct Gemm { const bf16_t* A; const bf16_t* Bt; int M, N, K, lda, ldb, bdiv; size_t bstride; };

struct StaticOrder {
    int nM, nN, nwg, G, c;
    __host__ __device__ void init(int M, int N, int G_, int c_) { nM = M / BM; nN = N / BM; nwg = nM * nN; G = G_; c = c_; }
    __host__ __device__ __forceinline__ bool next(int i, Unit& u) const {
        const long L = (long)i * G + c; if (L >= nwg) return false;
        int wgid = (int)L; { const int q = nwg / NXCD, r = nwg % NXCD, xcd = wgid % NXCD, off = wgid / NXCD; wgid = (xcd < r ? xcd * (q + 1) : r * (q + 1) + (xcd - r) * q) + off; }
        const int nig = WGM * nN, gid = wgid / nig, fm = gid * WGM, gsz = (nM - fm) < WGM ? (nM - fm) : WGM;
        u.pm = fm + ((wgid % nig) % gsz); u.pn = (wgid % nig) / gsz; return true;
    }
};

struct PanelOrder { int pm; __host__ __device__ bool next(int i, Unit& u) const { if (i >= 4) return false; u.pm = pm; u.pn = i; return true; } };
__device__ __forceinline__ unsigned cvt_pk_bf16(float lo, float hi) { unsigned r; asm volatile("v_cvt_pk_bf16_f32 %0, %1, %2" : "=v"(r) : "v"(lo), "v"(hi)); return r; }
__device__ __forceinline__ float bf_lo(unsigned w) { return __uint_as_float(w << 16); }
__device__ __forceinline__ float bf_hi(unsigned w) { return __uint_as_float(w & 0xffff0000u); }

template <class Epi, class Sched, bool ALIGN_EPI = false, bool SP2 = false>
__device__ __forceinline__ void gemm_phase(PG8_LAS unsigned char* lds, const Gemm g, const Sched& S, const Epi& E) {
    int tid_ = threadIdx.x; asm volatile("" : "+v"(tid_));
    const int tid = tid_, wid = __builtin_amdgcn_readfirstlane(tid >> 6), lane = tid & 63, wr = wid >> 2, wc = wid & 3, fr = lane & 15, fq = lane >> 4;
    const int K = g.K, nt = K / BK;
    unsigned voffA[2], voffB[2];
#pragma unroll
    for (int i = 0; i < 2; ++i) { int R, C; stage_rc(tid * 16 + i * 8192, R, C); const int Rb = Epi::PERM ? ((R & ~31) + perm32(R & 31)) : R;
        voffA[i] = (unsigned)(R * g.lda + C) * 2u; voffB[i] = (unsigned)(Rb * g.ldb + C) * 2u; }
    const size_t kstep = (size_t)(BK * 2);
    const size_t hstepA = (size_t)HALF * g.lda * 2, hstepB = (size_t)HALF * g.ldb * 2;
    const size_t tstepA = 2 * hstepA, tstepB = 2 * hstepB;
    const unsigned ldsw = (unsigned)wid * 1024u;
    const int aoff = lds_byte(wr * 64 + fr, fq * 8), boff = lds_byte(wc * 32 + fr, fq * 8);
#define PG8_SA(b, h) (((b) * 2 + (h)) * HTB)
#define PG8_SB(b, h) ((4 + (b) * 2 + (h)) * HTB)
#define PG8_STAGE(bufoff, gbase, voff) do { _Pragma("unroll") for (int _i = 0; _i < 2; ++_i) \
        __builtin_amdgcn_global_load_lds((const unsigned*)((const char*)(gbase) + (voff)[_i]), (PG8_LAS unsigned*)(lds + (bufoff) + ldsw + _i * 8192), 16, 0, 0); } while (0)
#define PG8_LDA(dst, b, h) do { _Pragma("unroll") for (int m = 0; m < 4; ++m) _Pragma("unroll") for (int k = 0; k < 2; ++k) dst[m][k] = *(const PG8_LAS bf16x8*)(lds + PG8_SA(b, h) + aoff + m * 2048 + k * 1024); } while (0)
#define PG8_LDB(dst, b, h) do { _Pragma("unroll") for (int n = 0; n < 2; ++n) _Pragma("unroll") for (int k = 0; k < 2; ++k) dst[n][k] = *(const PG8_LAS bf16x8*)(lds + PG8_SB(b, h) + boff + n * 2048 + k * 1024); } while (0)
#define PG8_MMA(ai, bj, At, Bt) do { __builtin_amdgcn_s_setprio(1); _Pragma("unroll") for (int m = 0; m < 4; ++m) _Pragma("unroll") for (int n = 0; n < 2; ++n) _Pragma("unroll") for (int k = 0; k < 2; ++k) \
        acc[ai][bj][m][n] = __builtin_amdgcn_mfma_f32_16x16x32_bf16(Bt[n][k], At[m][k], acc[ai][bj][m][n], 0, 0, 0); __builtin_amdgcn_s_setprio(0); } while (0)
#define PG8_WAIT_V(n) asm volatile("s_waitcnt vmcnt(" #n ")" ::: "memory")
#define PG8_WAIT_L(n) asm volatile("s_waitcnt lgkmcnt(" #n ")" ::: "memory")
#define PG8_BAR __builtin_amdgcn_s_barrier()
#define PG8_SCHED __builtin_amdgcn_sched_barrier(0)
#define PG8_BBASE(u) ((const char*)g.Bt + (size_t)(u).pn * tstepB + (g.bdiv ? (size_t)((u).pm / g.bdiv) * g.bstride * 2 : (size_t)0))
    Unit cur, nxt; int ui = 0;
    if (!S.next(0, cur)) return;
    f32x4 acc[2][2][4][2];
#pragma unroll
    for (int a = 0; a < 2; ++a)
#pragma unroll
        for (int b = 0; b < 2; ++b)
#pragma unroll
            for (int m = 0; m < 4; ++m)
#pragma unroll
                for (int n = 0; n < 2; ++n) acc[a][b][m][n] = (f32x4){0.f, 0.f, 0.f, 0.f};
    bf16x8 At[4][2], B0[2][2], B1[2][2];
    const char* cA = (const char*)g.A + (size_t)cur.pm * tstepA; const char* cB = PG8_BBASE(cur);
    if constexpr (SP2) {
        PG8_STAGE(PG8_SB(0, 0), cB, voffB); PG8_STAGE(PG8_SB(0, 1), cB + hstepB, voffB); PG8_STAGE(PG8_SA(0, 0), cA, voffA); PG8_STAGE(PG8_SA(0, 1), cA + hstepA, voffA);
        if (wr == 1) PG8_BAR;
        PG8_WAIT_V(2); PG8_BAR;
        PG8_STAGE(PG8_SB(1, 0), cB + kstep, voffB); PG8_STAGE(PG8_SA(1, 0), cA + kstep, voffA); PG8_STAGE(PG8_SB(1, 1), cB + hstepB + kstep, voffB);
        PG8_WAIT_V(6); PG8_BAR;
    } else {
        PG8_STAGE(PG8_SB(0, 0), cB, voffB); PG8_STAGE(PG8_SA(0, 0), cA, voffA); PG8_STAGE(PG8_SB(0, 1), cB + hstepB, voffB); PG8_STAGE(PG8_SA(0, 1), cA + hstepA, voffA);
        if (wr == 1) PG8_BAR;
        PG8_WAIT_V(4); PG8_BAR;
        PG8_STAGE(PG8_SB(1, 0), cB + kstep, voffB); PG8_STAGE(PG8_SA(1, 0), cA + kstep, voffA); PG8_STAGE(PG8_SB(1, 1), cB + hstepB + kstep, voffB);
        PG8_WAIT_V(6); PG8_BAR;
    }
    for (;;) {
        const bool has_next = S.next(ui + 1, nxt);
        const char* nA = has_next ? (const char*)g.A + (size_t)nxt.pm * tstepA : cA; const char* nB = has_next ? PG8_BBASE(nxt) : cB;
        for (int t = 0; t < nt; t += 2) {
            if constexpr (Epi::HOOK_T > 0) { if (t == Epi::HOOK_T) { PG8_SCHED; E.mid(acc, cur, wr, wc, fr, fq); PG8_SCHED; } }
            const bool last = (t == nt - 2);
            const char* a1 = cA + (size_t)(t + 1) * kstep;
            const char* a2 = last ? nA : cA + (size_t)(t + 2) * kstep; const char* b2 = last ? nB : cB + (size_t)(t + 2) * kstep;
            const char* a3 = a2 + kstep; const char* b3 = b2 + kstep;
            if constexpr (SP2) {
            PG8_LDB(B0, 0, 0); PG8_LDB(B1, 0, 1); PG8_SCHED; PG8_LDA(At, 0, 0); PG8_STAGE(PG8_SA(1, 1), a1 + hstepA, voffA);
            PG8_WAIT_V(8); PG8_WAIT_L(0); PG8_BAR; PG8_MMA(0, 0, At, B0); PG8_MMA(0, 1, At, B1); PG8_BAR; PG8_SCHED;
            PG8_LDA(At, 0, 1); PG8_STAGE(PG8_SB(0, 0), b2, voffB); PG8_STAGE(PG8_SB(0, 1), b2 + hstepB, voffB); PG8_STAGE(PG8_SA(0, 0), a2, voffA);
            PG8_WAIT_V(8); PG8_WAIT_L(0); PG8_BAR; PG8_MMA(1, 0, At, B0); PG8_MMA(1, 1, At, B1); PG8_BAR; PG8_SCHED;
            PG8_LDB(B0, 1, 0); PG8_LDB(B1, 1, 1); PG8_SCHED; PG8_LDA(At, 1, 0); PG8_STAGE(PG8_SA(0, 1), a2 + hstepA, voffA);
            PG8_WAIT_V(8); PG8_WAIT_L(0); PG8_BAR; PG8_MMA(0, 0, At, B0); PG8_MMA(0, 1, At, B1); PG8_BAR; PG8_SCHED;
            PG8_LDA(At, 1, 1); PG8_STAGE(PG8_SB(1, 0), b3, voffB); PG8_STAGE(PG8_SB(1, 1), b3 + hstepB, voffB); PG8_STAGE(PG8_SA(1, 0), a3, voffA);
            PG8_WAIT_V(8); PG8_WAIT_L(0); PG8_BAR; PG8_MMA(1, 0, At, B0); PG8_MMA(1, 1, At, B1); PG8_BAR; PG8_SCHED;
            } else {
            PG8_LDB(B0, 0, 0); PG8_SCHED; PG8_LDA(At, 0, 0); PG8_STAGE(PG8_SA(1, 1), a1 + hstepA, voffA);
            PG8_WAIT_L(8); PG8_BAR; PG8_WAIT_L(0); PG8_MMA(0, 0, At, B0); PG8_BAR; PG8_SCHED;
            PG8_LDB(B1, 0, 1); PG8_STAGE(PG8_SB(0, 0), b2, voffB);
            PG8_BAR; PG8_WAIT_L(0); PG8_MMA(0, 1, At, B1); PG8_BAR;
            PG8_LDA(At, 0, 1); PG8_STAGE(PG8_SA(0, 0), a2, voffA);
            PG8_BAR; PG8_WAIT_L(0); PG8_MMA(1, 0, At, B0); PG8_BAR; PG8_SCHED;
            PG8_STAGE(PG8_SB(0, 1), b2 + hstepB, voffB);
            PG8_WAIT_V(6); PG8_BAR; PG8_MMA(1, 1, At, B1); PG8_BAR;
            PG8_LDB(B0, 1, 0); PG8_SCHED; PG8_LDA(At, 1, 0); PG8_STAGE(PG8_SA(0, 1), a2 + hstepA, voffA);
            PG8_WAIT_L(8); PG8_BAR; PG8_WAIT_L(0); PG8_MMA(0, 0, At, B0); PG8_BAR; PG8_SCHED;
            PG8_LDB(B1, 1, 1); PG8_STAGE(PG8_SB(1, 0), b3, voffB);
            PG8_BAR; PG8_WAIT_L(0); PG8_MMA(0, 1, At, B1); PG8_BAR;
            PG8_LDA(At, 1, 1); PG8_STAGE(PG8_SA(1, 0), a3, voffA);
            PG8_BAR; PG8_WAIT_L(0); PG8_MMA(1, 0, At, B0); PG8_BAR; PG8_SCHED;
            PG8_STAGE(PG8_SB(1, 1), b3 + hstepB, voffB);
            PG8_WAIT_V(6); PG8_BAR; PG8_MMA(1, 1, At, B1); PG8_BAR;
            }
        }
        if constexpr (ALIGN_EPI) { if (wr == 0) PG8_BAR; }
        E(acc, cur, wr, wc, fr, fq);
        if (!has_next) break;
#pragma unroll
        for (int a = 0; a < 2; ++a)
#pragma unroll
            for (int b = 0; b < 2; ++b)
#pragma unroll
                for (int m = 0; m < 4; ++m)
#pragma unroll
                    for (int n = 0; n < 2; ++n) acc[a][b][m][n] = (f32x4){0.f, 0.f, 0.f, 0.f};
        cur = nxt; cA = nA; cB = nB; ++ui;
        if constexpr (ALIGN_EPI) { if (wr == 1) PG8_BAR; }
    }
    PG8_WAIT_V(0);
    if constexpr (!ALIGN_EPI) { if (wr == 0) PG8_BAR; }
    PG8_BAR;
#undef PG8_SA
#undef PG8_SB
#undef PG8_STAGE
#undef PG8_LDA
#undef PG8_LDB
#undef PG8_MMA
#undef PG8_WAIT_V
#undef PG8_WAIT_L
#undef PG8_BAR
#undef PG8_SCHED
#undef PG8_BBASE
}
}
#ifndef MK_NT
#define MK_NT 1
#endif
#if MK_NT
#define PG8_NTSTORE(p, v) __builtin_nontemporal_store((v), (p))
#else
#define PG8_NTSTORE(p, v) (*(p) = (v))
#endif
namespace pg8 {
__device__ __forceinline__ float sigmoidf_(float x) { return __builtin_amdgcn_rcpf(1.0f + __builtin_amdgcn_exp2f(x * -1.4426950408889634f)); }

struct EpiCols {
    static constexpr bool PERM = true; static constexpr int HOOK_T = 0;
    bf16_t* qkvz; bf16_t* rw; bf16_t* gab; float qscale;
    __device__ __forceinline__ void operator()(const f32x4 (&acc)[2][2][4][2], const Unit& u, int wr, int wc, int fr, int fq) const {
        const int pn = u.pn; bf16_t* base; int pitch, coff, nbj = 2; float sc = 1.f;
        if (pn < 8) { base = qkvz; pitch = 2112; coff = pn * 256; if (pn < 2) sc = qscale; }
        else if (pn < 16) { base = rw; pitch = 2176; coff = (pn - 8) * 256; }
        else if (pn < 24) { base = gab; pitch = 2112; coff = (pn - 16) * 256; }
        else { base = rw; pitch = 2176; coff = 2048; nbj = 1; }
        const int row0 = u.pm * BM + wr * 64 + fr; const int col0 = coff + wc * 32 + 8 * fq;
#pragma unroll
        for (int ai = 0; ai < 2; ++ai)
#pragma unroll
            for (int m = 0; m < 4; ++m) { bf16_t* rowp = base + (size_t)(row0 + ai * HALF + m * 16) * pitch + col0;
#pragma unroll
                for (int bj = 0; bj < 2; ++bj) { if (bj < nbj) { f32x4 v0 = acc[ai][bj][m][0] * sc, v1 = acc[ai][bj][m][1] * sc;
                    u32x4 w; w.x = cvt_pk_bf16(v0[0], v0[1]); w.y = cvt_pk_bf16(v0[2], v0[3]); w.z = cvt_pk_bf16(v1[0], v1[1]); w.w = cvt_pk_bf16(v1[2], v1[3]);
                    PG8_NTSTORE((u32x4*)(rowp + bj * HALF), w); } } }
    }
};
struct EpiBf16 {
    static constexpr bool PERM = true; static constexpr int HOOK_T = 0;
    bf16_t* O; int ldc;
    __device__ __forceinline__ void operator()(const f32x4 (&acc)[2][2][4][2], const Unit& u, int wr, int wc, int fr, int fq) const {
        const int row0 = u.pm * BM + wr * 64 + fr; const int col0 = u.pn * BM + wc * 32 + 8 * fq;
#pragma unroll
        for (int ai = 0; ai < 2; ++ai)
#pragma unroll
            for (int m = 0; m < 4; ++m) { bf16_t* rowp = O + (size_t)(row0 + ai * HALF + m * 16) * ldc + col0;
#pragma unroll
                for (int bj = 0; bj < 2; ++bj) { const f32x4 v0 = acc[ai][bj][m][0], v1 = acc[ai][bj][m][1];
                    u32x4 w; w.x = cvt_pk_bf16(v0[0], v0[1]); w.y = cvt_pk_bf16(v0[2], v0[3]); w.z = cvt_pk_bf16(v1[0], v1[1]); w.w = cvt_pk_bf16(v1[2], v1[3]);
                    *(u32x4*)(rowp + bj * HALF) = w; } }
    }
};
struct EpiF32 {
    static constexpr bool PERM = false; static constexpr int HOOK_T = 0;
    float* O; int ldc;
    __device__ __forceinline__ void operator()(const f32x4 (&acc)[2][2][4][2], const Unit& u, int wr, int wc, int fr, int fq) const {
        const int row0 = u.pm * BM + wr * 64 + fr; const int col0 = u.pn * BM + wc * 32 + 4 * fq;
#pragma unroll
        for (int ai = 0; ai < 2; ++ai)
#pragma unroll
            for (int m = 0; m < 4; ++m) { float* rowp = O + (size_t)(row0 + ai * HALF + m * 16) * ldc + col0;
#pragma unroll
                for (int bj = 0; bj < 2; ++bj)
#pragma unroll
                    for (int n = 0; n < 2; ++n) *(f32x4*)(rowp + bj * HALF + n * 16) = acc[ai][bj][m][n]; }
    }
};
struct EpiGate {
    static constexpr bool PERM = false; static constexpr int HOOK_T = 0;
    float* O;
    __device__ __forceinline__ void operator()(const f32x4 (&acc)[2][2][4][2], const Unit& u, int wr, int wc, int fr, int fq) const {
        const int row0 = u.pm * BM + wr * 64 + fr; const int col0 = wc * 32 + 4 * fq;
#pragma unroll
        for (int ai = 0; ai < 2; ++ai)
#pragma unroll
            for (int m = 0; m < 4; ++m) { float* rowp = O + (size_t)(row0 + ai * HALF + m * 16) * 128 + col0;
#pragma unroll
                for (int n = 0; n < 2; ++n) *(f32x4*)(rowp + n * 16) = acc[ai][0][m][n] + acc[ai][1][m][n]; }
    }
};
template <bool ADD> struct EpiMerge {
    static constexpr bool PERM = true; static constexpr int HOOK_T = 0;
    bf16_t* O; int ldc; const bf16_t* G; int ldg;
    __device__ __forceinline__ void operator()(const f32x4 (&acc)[2][2][4][2], const Unit& u, int wr, int wc, int fr, int fq) const {
        const int row0 = u.pm * BM + wr * 64 + fr; const int col0 = u.pn * BM + wc * 32 + 8 * fq;
#pragma unroll
        for (int ai = 0; ai < 2; ++ai)
#pragma unroll
            for (int m = 0; m < 4; ++m) { const size_t r = (size_t)(row0 + ai * HALF + m * 16);
#pragma unroll
                for (int bj = 0; bj < 2; ++bj) { const f32x4 v0 = acc[ai][bj][m][0], v1 = acc[ai][bj][m][1];
                    const u32x4 gw = *(const u32x4*)(G + r * ldg + col0 + bj * HALF);
                    float o[8];
                    o[0] = sigmoidf_(bf_lo(gw.x)) * v0[0]; o[1] = sigmoidf_(bf_hi(gw.x)) * v0[1]; o[2] = sigmoidf_(bf_lo(gw.y)) * v0[2]; o[3] = sigmoidf_(bf_hi(gw.y)) * v0[3];
                    o[4] = sigmoidf_(bf_lo(gw.z)) * v1[0]; o[5] = sigmoidf_(bf_hi(gw.z)) * v1[1]; o[6] = sigmoidf_(bf_lo(gw.w)) * v1[2]; o[7] = sigmoidf_(bf_hi(gw.w)) * v1[3];
                    bf16_t* op = O + r * ldc + col0 + bj * HALF;
                    if (ADD) { const u32x4 pw = *(const u32x4*)op;
                        o[0] += bf_lo(pw.x); o[1] += bf_hi(pw.x); o[2] += bf_lo(pw.y); o[3] += bf_hi(pw.y); o[4] += bf_lo(pw.z); o[5] += bf_hi(pw.z); o[6] += bf_lo(pw.w); o[7] += bf_hi(pw.w); }
                    u32x4 w; w.x = cvt_pk_bf16(o[0], o[1]); w.y = cvt_pk_bf16(o[2], o[3]); w.z = cvt_pk_bf16(o[4], o[5]); w.w = cvt_pk_bf16(o[6], o[7]);
                    *(u32x4*)op = w; } }
    }
};
struct EpiYStat {
    static constexpr bool PERM = true; static constexpr int HOOK_T = 0;
    bf16_t* O; int ldc; PG8_LAS float* part;
    __device__ __forceinline__ void operator()(const f32x4 (&acc)[2][2][4][2], const Unit& u, int wr, int wc, int fr, int fq) const {
        const int row0 = u.pm * BM + wr * 64 + fr; const int col0 = u.pn * BM + wc * 32 + 8 * fq;
#pragma unroll
        for (int ai = 0; ai < 2; ++ai)
#pragma unroll
            for (int m = 0; m < 4; ++m) { bf16_t* rowp = O + (size_t)(row0 + ai * HALF + m * 16) * ldc + col0; float s = 0.f;
#pragma unroll
                for (int bj = 0; bj < 2; ++bj) { const f32x4 v0 = acc[ai][bj][m][0], v1 = acc[ai][bj][m][1];
                    u32x4 w; w.x = cvt_pk_bf16(v0[0], v0[1]); w.y = cvt_pk_bf16(v0[2], v0[3]); w.z = cvt_pk_bf16(v1[0], v1[1]); w.w = cvt_pk_bf16(v1[2], v1[3]);
                    *(u32x4*)(rowp + bj * HALF) = w;
                    s += (bf_lo(w.x) * bf_lo(w.x) + bf_hi(w.x) * bf_hi(w.x)) + (bf_lo(w.y) * bf_lo(w.y) + bf_hi(w.y) * bf_hi(w.y)) + (bf_lo(w.z) * bf_lo(w.z) + bf_hi(w.z) * bf_hi(w.z)) + (bf_lo(w.w) * bf_lo(w.w) + bf_hi(w.w) * bf_hi(w.w)); }
                s += __shfl_xor(s, 16); s += __shfl_xor(s, 32);
                if (fq == 0) part[(ai * HALF + wr * 64 + m * 16 + fr) * 16 + wc * 4 + u.pn] = s; }
    }
};
struct EpiYStatG {
    static constexpr bool PERM = true; static constexpr int HOOK_T = 0;
    bf16_t* O; int ldc; float* part;
    __device__ __forceinline__ void operator()(const f32x4 (&acc)[2][2][4][2], const Unit& u, int wr, int wc, int fr, int fq) const {
        const int row0 = u.pm * BM + wr * 64 + fr; const int col0 = u.pn * BM + wc * 32 + 8 * fq;
#pragma unroll
        for (int ai = 0; ai < 2; ++ai)
#pragma unroll
            for (int m = 0; m < 4; ++m) { bf16_t* rowp = O + (size_t)(row0 + ai * HALF + m * 16) * ldc + col0; float s = 0.f;
#pragma unroll
                for (int bj = 0; bj < 2; ++bj) { const f32x4 v0 = acc[ai][bj][m][0], v1 = acc[ai][bj][m][1];
                    u32x4 w; w.x = cvt_pk_bf16(v0[0], v0[1]); w.y = cvt_pk_bf16(v0[2], v0[3]); w.z = cvt_pk_bf16(v1[0], v1[1]); w.w = cvt_pk_bf16(v1[2], v1[3]);
                    *(u32x4*)(rowp + bj * HALF) = w;
                    s += (bf_lo(w.x) * bf_lo(w.x) + bf_hi(w.x) * bf_hi(w.x)) + (bf_lo(w.y) * bf_lo(w.y) + bf_hi(w.y) * bf_hi(w.y)) + (bf_lo(w.z) * bf_lo(w.z) + bf_hi(w.z) * bf_hi(w.z)) + (bf_lo(w.w) * bf_lo(w.w) + bf_hi(w.w) * bf_hi(w.w)); }
                s += __shfl_xor(s, 16); s += __shfl_xor(s, 32);
                if (fq == 0) part[(size_t)(row0 + ai * HALF + m * 16) * 16 + wc * 4 + u.pn] = s; }
    }
};
struct EpiMergeFused {
    static constexpr bool PERM = true; static constexpr int HOOK_T = 8;
    bf16_t* O; int ldc; const bf16_t* G; int ldg;
    struct GOps { u32x4 ga[2], gb[2]; };
    __device__ __forceinline__ void loadg(GOps& o, size_t r, int col0, bool both) const {
#pragma unroll
        for (int bj = 0; bj < 2; ++bj) { if (both) o.ga[bj] = *(const u32x4*)(G + r * ldg + col0 + bj * HALF); o.gb[bj] = *(const u32x4*)(G + r * ldg + 1024 + col0 + bj * HALF); }
    }
    __device__ __forceinline__ void mid(f32x4 (&acc)[2][2][4][2], const Unit& u, int wr, int wc, int fr, int fq) const {
        asm volatile("" : "+v"(fr), "+v"(fq));
        const int row0 = u.pm * BM + wr * 64 + fr; const int col0 = u.pn * BM + wc * 32 + 8 * fq;
        GOps A, B; loadg(A, (size_t)row0, col0, true);
#pragma unroll
        for (int g = 0; g < 8; ++g) { const int ai = g >> 2, m = g & 3; GOps& cur = (g & 1) ? B : A; GOps& nxt = (g & 1) ? A : B;
            if (g < 7) loadg(nxt, (size_t)(row0 + ((g + 1) >> 2) * HALF + ((g + 1) & 3) * 16), col0, true);
            __builtin_amdgcn_sched_barrier(0);
#pragma unroll
            for (int bj = 0; bj < 2; ++bj) { const u32x4 ga = cur.ga[bj], gb = cur.gb[bj];
#define MQ_(wa, wb, HI) ((1.0f + __builtin_amdgcn_exp2f(fmaxf(HI ? bf_hi(wb) : bf_lo(wb), -80.f) * -1.4426950408889634f)) * __builtin_amdgcn_rcpf(1.0f + __builtin_amdgcn_exp2f((HI ? bf_hi(wa) : bf_lo(wa)) * -1.4426950408889634f)))
                acc[ai][bj][m][0][0] *= MQ_(ga.x, gb.x, 0); acc[ai][bj][m][0][1] *= MQ_(ga.x, gb.x, 1); acc[ai][bj][m][0][2] *= MQ_(ga.y, gb.y, 0); acc[ai][bj][m][0][3] *= MQ_(ga.y, gb.y, 1);
                acc[ai][bj][m][1][0] *= MQ_(ga.z, gb.z, 0); acc[ai][bj][m][1][1] *= MQ_(ga.z, gb.z, 1); acc[ai][bj][m][1][2] *= MQ_(ga.w, gb.w, 0); acc[ai][bj][m][1][3] *= MQ_(ga.w, gb.w, 1);
#undef MQ_
            }
            __builtin_amdgcn_sched_barrier(0); }
    }
    __device__ __forceinline__ void operator()(const f32x4 (&acc)[2][2][4][2], const Unit& u, int wr, int wc, int fr, int fq) const {
        asm volatile("" : "+v"(fr), "+v"(fq));
        const int row0 = u.pm * BM + wr * 64 + fr; const int col0 = u.pn * BM + wc * 32 + 8 * fq;
        GOps A, B; loadg(A, (size_t)row0, col0, false);
#pragma unroll
        for (int g = 0; g < 8; ++g) { const int ai = g >> 2, m = g & 3; const size_t r = (size_t)(row0 + ai * HALF + m * 16); GOps& cur = (g & 1) ? B : A; GOps& nxt = (g & 1) ? A : B;
            if (g < 7) loadg(nxt, (size_t)(row0 + ((g + 1) >> 2) * HALF + ((g + 1) & 3) * 16), col0, false);
            __builtin_amdgcn_sched_barrier(0);
#pragma unroll
            for (int bj = 0; bj < 2; ++bj) { const f32x4 v0 = acc[ai][bj][m][0], v1 = acc[ai][bj][m][1]; const u32x4 gw = cur.gb[bj];
                u32x4 w; w.x = cvt_pk_bf16(sigmoidf_(fmaxf(bf_lo(gw.x), -80.f)) * v0[0], sigmoidf_(fmaxf(bf_hi(gw.x), -80.f)) * v0[1]); w.y = cvt_pk_bf16(sigmoidf_(fmaxf(bf_lo(gw.y), -80.f)) * v0[2], sigmoidf_(fmaxf(bf_hi(gw.y), -80.f)) * v0[3]);
                w.z = cvt_pk_bf16(sigmoidf_(fmaxf(bf_lo(gw.z), -80.f)) * v1[0], sigmoidf_(fmaxf(bf_hi(gw.z), -80.f)) * v1[1]); w.w = cvt_pk_bf16(sigmoidf_(fmaxf(bf_lo(gw.w), -80.f)) * v1[2], sigmoidf_(fmaxf(bf_hi(gw.w), -80.f)) * v1[3]);
                *(u32x4*)(O + r * ldc + col0 + bj * HALF) = w; }
            __builtin_amdgcn_sched_barrier(0); }
    }
};
struct EpiFinal {
    static constexpr bool PERM = false; static constexpr int HOOK_T = 4;
    float* out; const bf16_t* h; u32x4* park; int ldc, ldh, tid;
    struct Ops { u32x2 hw[4]; u32x4 ew[2]; };
    __device__ __forceinline__ void load(Ops& o, size_t r, int col0, int g) const {
#pragma unroll
        for (int q = 0; q < 4; ++q) { const int c = col0 + (q >> 1) * HALF + (q & 1) * 16; o.hw[q] = *(const u32x2*)(h + r * ldh + c); }
        o.ew[0] = park[(g * 2 + 0) * 512 + tid]; o.ew[1] = park[(g * 2 + 1) * 512 + tid];
    }
    __device__ __forceinline__ void mid(f32x4 (&acc)[2][2][4][2], const Unit& u, int wr, int wc, int fr, int fq) const {
#pragma unroll
        for (int g = 0; g < 8; ++g) { const int ai = g >> 2, m = g & 3;
#pragma unroll
            for (int bj = 0; bj < 2; ++bj) { const f32x4 a0 = acc[ai][bj][m][0], a1 = acc[ai][bj][m][1];
                park[(g * 2 + bj) * 512 + tid] = (u32x4){cvt_pk_bf16(a0[0], a0[1]), cvt_pk_bf16(a0[2], a0[3]), cvt_pk_bf16(a1[0], a1[1]), cvt_pk_bf16(a1[2], a1[3])};
                acc[ai][bj][m][0] = (f32x4){0.f, 0.f, 0.f, 0.f}; acc[ai][bj][m][1] = (f32x4){0.f, 0.f, 0.f, 0.f}; } }
    }
    __device__ __forceinline__ void operator()(const f32x4 (&acc)[2][2][4][2], const Unit& u, int wr, int wc, int fr, int fq) const {
        asm volatile("" : "+v"(fr), "+v"(fq));
        const int row0 = u.pm * BM + wr * 64 + fr; const int col0 = u.pn * BM + wc * 32 + 4 * fq;
        Ops O[3];
        load(O[0], (size_t)row0, col0, 0); load(O[1], (size_t)(row0 + 16), col0, 1);
#pragma unroll
        for (int g = 0; g < 8; ++g) { const int ai = g >> 2, m = g & 3; const size_t r = (size_t)(row0 + ai * HALF + m * 16);
            Ops& cur = O[g % 3];
            if (g < 6) load(O[(g + 2) % 3], (size_t)(row0 + ((g + 2) >> 2) * HALF + ((g + 2) & 3) * 16), col0, g + 2);
            __builtin_amdgcn_sched_barrier(0);
#pragma unroll
            for (int q = 0; q < 4; ++q) { const int bj = q >> 1, n = q & 1; const f32x4 a = acc[ai][bj][m][n]; const u32x2 hw = cur.hw[q]; const unsigned e0 = n ? cur.ew[bj].z : cur.ew[bj].x, e1 = n ? cur.ew[bj].w : cur.ew[bj].y; f32x4 o;
                o[0] = bf_lo(hw.x) + sigmoidf_(a[0]) * bf_lo(e0);
                o[1] = bf_hi(hw.x) + sigmoidf_(a[1]) * bf_hi(e0);
                o[2] = bf_lo(hw.y) + sigmoidf_(a[2]) * bf_lo(e1);
                o[3] = bf_hi(hw.y) + sigmoidf_(a[3]) * bf_hi(e1);
                PG8_NTSTORE((f32x4*)(out + r * ldc + col0 + bj * HALF + n * 16), o); }
            __builtin_amdgcn_sched_barrier(0); }
    }
};
}
#define GAS __attribute__((address_space(1)))
#define LAS __attribute__((address_space(3)))
typedef unsigned short bf16;
typedef unsigned v4u __attribute__((ext_vector_type(4)));
typedef unsigned v2u __attribute__((ext_vector_type(2)));
typedef float f32x4 __attribute__((ext_vector_type(4)));

constexpr int NWAVES = 8, NTHR = 512;
constexpr int BATCH = 16, SEQ = 4096, DM = 1024, M = BATCH * SEQ;
constexpr int NH = 8, HD = 64, AW = 512, PLE = 256;
constexpr int RWC = 2176, INC = 6272, INCP = 6400;
constexpr int NBLK = 16, BLK = 256;
constexpr float RMS_EPS = 1e-6f, GN_EPS = 64e-5f;
constexpr float LOG2E = 1.4426950408889634f;
constexpr float QSCALE = 0.125f * LOG2E;

constexpr size_t MiB = 1u << 20;
constexpr size_t WS_WIN = 2 * MiB;
constexpr size_t WS_WG = 16 * MiB;
constexpr size_t WS_PAB = 32 * MiB;
constexpr size_t WS_WOUT = 34 * MiB;
constexpr size_t WS_WPG = 36 * MiB;
constexpr int ACP = 1280;
constexpr size_t WS_RSY = 39 * MiB;
constexpr size_t WS_UBAR = 40 * MiB, WS_KMEAN = 41 * MiB;
constexpr size_t WS_PARTS = 42 * MiB;
constexpr size_t WS_GATE = 74 * MiB;
constexpr int WINP = 1088;
constexpr int QP = 2112, GP = 2112;
constexpr size_t WS_QKVZ = 138 * MiB;
constexpr size_t WS_RW = 402 * MiB;
constexpr size_t WS_GAB = 674 * MiB;
constexpr size_t WS_END = 1004 * MiB;
constexpr size_t WS_CNT = 0;
constexpr size_t WS_QCTR = 16384;
constexpr size_t WS_WUPT = 39 * MiB + 512 * 1024, WS_AUPT = WS_WUPT + 65536;
constexpr size_t WS_BON = 938 * MiB;
constexpr size_t WS_SC = 940 * MiB;
constexpr size_t DO_PARTO = 0, DO_PARTML = 192 * MiB;
constexpr size_t WS_LISTS = 46 * MiB;

__device__ const unsigned char T5B[128] = {0, 1, 2, 3, 4, 5, 6, 7, 8, 9, 10, 11, 12, 13, 14, 15, 16, 16, 16, 17, 17, 18, 18, 18, 19, 19, 19, 20, 20, 20, 20, 21, 21, 21, 21, 22, 22, 22, 22, 22, 23, 23, 23, 23, 23, 23, 24, 24, 24, 24, 24, 24, 25, 25, 25, 25, 25, 25, 25, 26, 26, 26, 26, 26, 26, 26, 26, 27, 27, 27, 27, 27, 27, 27, 27, 27, 27, 28, 28, 28, 28, 28, 28, 28, 28, 28, 28, 29, 29, 29, 29, 29, 29, 29, 29, 29, 29, 29, 29, 30, 30, 30, 30, 30, 30, 30, 30, 30, 30, 30, 30, 30, 30, 31, 31, 31, 31, 31, 31, 31, 31, 31, 31, 31, 31, 31, 31, 31};

typedef float f32x2_cv __attribute__((ext_vector_type(2))); typedef __bf16 bf16x2_cv __attribute__((ext_vector_type(2)));
__device__ __forceinline__ unsigned pk2(float lo, float hi) { f32x2_cv v = {lo, hi}; bf16x2_cv b = __builtin_convertvector(v, bf16x2_cv); return __builtin_bit_cast(unsigned, b); }
__device__ __forceinline__ unsigned f2bf(float f) { return pk2(f, 0.f) & 0xffffu; }
__device__ __forceinline__ float bf2f(unsigned short h) { return __uint_as_float((unsigned)h << 16); }
__device__ __forceinline__ float wave_sum(float v) {
#pragma unroll
    for (int o = 1; o < 64; o <<= 1) v += __shfl_xor(v, o);
    return v;
}
__device__ __forceinline__ float fexp2(float x) { return __builtin_amdgcn_exp2f(x); }
__device__ __forceinline__ float fexp(float x) { return __builtin_amdgcn_exp2f(x * LOG2E); }
__device__ __forceinline__ float frcp(float x) { return __builtin_amdgcn_rcpf(x); }
__device__ __forceinline__ float frsq(float x) { return __builtin_amdgcn_rsqf(x); }
__device__ __forceinline__ float sigm(float x) { return frcp(1.0f + fexp2(-x * LOG2E)); }
__device__ __forceinline__ float ftanh(float x) { return 1.0f - 2.0f * frcp(1.0f + fexp2(x * (2.0f * LOG2E))); }
__device__ __forceinline__ float dpp_sum32(float v) {
#define DPP_ADD_(ctrl, rmask) v += __builtin_bit_cast(float, __builtin_amdgcn_update_dpp(0, __builtin_bit_cast(int, v), ctrl, rmask, 0xf, true))
    DPP_ADD_(0x118, 0xf); DPP_ADD_(0x114, 0xf); DPP_ADD_(0x112, 0xf); DPP_ADD_(0x111, 0xf);
    v += __builtin_bit_cast(float, __builtin_amdgcn_update_dpp(0, __builtin_bit_cast(int, v), 0x142, 0xa, 0xf, false));
#undef DPP_ADD_
    return v;
}

struct Args {
    const float* in[21]; float* out; unsigned char* ws; int ph_lo, ph_hi;
};
struct Frame {
    LAS unsigned char* lds; int tid, lane, wave, vcu, G;
    const float *x, *p, *g_pre, *w_in, *rel_bias, *mu, *w0, *w_up, *a0, *a_up, *k_k, *k_a, *r_k, *ln_w, *ln_b, *p_a, *p_b, *w_out, *g_post, *w_pu, *w_pg;
    float* out; unsigned char* ws;
};

__device__ __forceinline__ float wave_sum_fast(float v) { v = dpp_sum32(v); return __builtin_bit_cast(float, __builtin_amdgcn_readlane(__builtin_bit_cast(int, v), 31)) + __builtin_bit_cast(float, __builtin_amdgcn_readlane(__builtin_bit_cast(int, v), 63)); }
constexpr size_t WS_BAR = 32768;
#define XB_TMO      128
#define XB_XCNT(j)  (256  + 64 * (j))
#define XB_XSUB(j)  (1280 + 64 * (j))
#define XB_XGEN(j)  (2304 + 64 * (j))
#define XB_TOP      3328
#define XB_TOPGEN   3392
#define XB_SPIN_CAP (1u << 20)
__device__ __forceinline__ unsigned xb_ld(unsigned* p)              { return __hip_atomic_load(p, __ATOMIC_RELAXED, __HIP_MEMORY_SCOPE_AGENT); }
__device__ __forceinline__ unsigned xb_add(unsigned* p, unsigned v) { return __hip_atomic_fetch_add(p, v, __ATOMIC_RELAXED, __HIP_MEMORY_SCOPE_AGENT); }
__device__ __forceinline__ unsigned xb_xcc_id() { return (unsigned)__builtin_amdgcn_s_getreg((3 << 11) | 20) & 0xFu; }
#define XB_SPIN(cond, bar) do { unsigned _sp = 0; while (cond) { __builtin_amdgcn_s_sleep(1); \
    if ((++_sp & 255u) == 0u) { if (xb_ld(&(bar)[XB_TMO])) break; if (_sp > XB_SPIN_CAP) { atomicAdd(&(bar)[XB_TMO], 1u); break; } } } } while (0)
__device__ __forceinline__ void xcd_barrier_post(unsigned* bar) { if (threadIdx.x == 0) (void)xb_add(&bar[XB_XCNT(xb_xcc_id())], 1u); }
__device__ __forceinline__ void xcd_barrier_complete(unsigned* bar, unsigned x, unsigned& nloc, unsigned& nx) {
    const unsigned G = gridDim.x * gridDim.y * gridDim.z;
    unsigned sum, cnt, mine, sp = 0u;
    for (;;) {
        sum = 0u; cnt = 0u; mine = 0u;
#pragma unroll
        for (unsigned j = 0; j < 16; ++j) { const unsigned c = xb_ld(&bar[XB_XCNT(j)]); sum += c; cnt += (c > 0u) ? 1u : 0u; mine = (j == x) ? c : mine; }
        if (sum == G) break;
        __builtin_amdgcn_s_sleep(1);
        if ((++sp & 255u) == 0u) { if (xb_ld(&bar[XB_TMO])) break; if (sp > XB_SPIN_CAP) { atomicAdd(&bar[XB_TMO], 1u); break; } }
    }
    nloc = mine > 0u ? mine : 1u; nx = cnt > 0u ? cnt : 1u;
}
__device__ __forceinline__ void xcd_barrier(unsigned* bar, volatile LAS unsigned* st) {
    asm volatile("s_waitcnt vmcnt(0)" ::: "memory");
    __syncthreads();
    if (threadIdx.x == 0) {
        const unsigned x = xb_xcc_id();
        __builtin_amdgcn_s_waitcnt(0);
        unsigned nloc = st[0], nx = st[1];
        if (nloc == 0u) { xcd_barrier_complete(bar, x, nloc, nx); st[0] = nloc; st[1] = nx; }
        const unsigned old = xb_add(&bar[XB_XSUB(x)], 1u);
        const unsigned gen = old / nloc;
        if (old + 1u == (gen + 1u) * nloc) {
            __builtin_amdgcn_fence(__ATOMIC_RELEASE, "agent");
            asm volatile("s_waitcnt vmcnt(0)" ::: "memory");
            const unsigned og = xb_add(&bar[XB_TOP], 1u);
            const unsigned tg = og / nx;
            if (og + 1u == (tg + 1u) * nx) xb_add(&bar[XB_TOPGEN], 1u);
            else XB_SPIN(xb_ld(&bar[XB_TOPGEN]) == tg, bar);
            __builtin_amdgcn_fence(__ATOMIC_ACQUIRE, "agent");
            xb_add(&bar[XB_XGEN(x)], 1u);
            asm volatile("s_waitcnt vmcnt(0)" ::: "memory");
        } else {
            XB_SPIN(xb_ld(&bar[XB_XGEN(x)]) == gen, bar);
            __builtin_amdgcn_fence(__ATOMIC_ACQUIRE, "agent");
            asm volatile("s_waitcnt vmcnt(0)" ::: "memory");
        }
    }
    __syncthreads();
}

__device__ __forceinline__ void transpose_item(const float* W, int N, int k0, int n0, bf16* WT, int ldw, int drow0, int koff, LAS float* scr, int lane) {
    float t[32];
#pragma unroll
    for (int i = 0; i < 32; ++i) t[i] = W[(size_t)(k0 + 2 * i + (lane >> 5)) * N + n0 + (lane & 31)];
#pragma unroll
    for (int i = 0; i < 32; ++i) scr[(2 * i + (lane >> 5)) * 33 + (lane & 31)] = t[i];
    asm volatile("s_waitcnt lgkmcnt(0)" ::: "memory");
    const int c = lane & 7;
#pragma unroll
    for (int j = 0; j < 4; ++j) { const int n = (lane >> 3) + 8 * j; const LAS float* s = scr + (8 * c) * 33 + n;
        v4u o; o.x = pk2(s[0 * 33], s[1 * 33]); o.y = pk2(s[2 * 33], s[3 * 33]); o.z = pk2(s[4 * 33], s[5 * 33]); o.w = pk2(s[6 * 33], s[7 * 33]);
        *(v4u*)(WT + (size_t)(drow0 + n) * ldw + koff + k0 + 8 * c) = o; }
    asm volatile("s_waitcnt lgkmcnt(0)" ::: "memory");
}

__device__ __forceinline__ void pro_side(Frame& F, int part, int gw, int ngw, int lt, int nlt) {
    LAS float* scr = (LAS float*)(F.lds + F.wave * 16384);
    bf16* WinT = (bf16*)(F.ws + WS_WIN); bf16* PabT = (bf16*)(F.ws + WS_PAB); bf16* WoutT = (bf16*)(F.ws + WS_WOUT); bf16* WpgT = (bf16*)(F.ws + WS_WPG);
    if (part == 0) {
        constexpr int I_IN = 16 * (INC / 32), I_PA = 8 * 32, I_PB = 8 * 32, I_WO = 16 * 32, I_PG = 16 * 32, I_PU = 4 * 32, I_UP = 16;
        constexpr int NIT = I_IN + I_PA + I_PB + I_WO + I_PG + I_PU + 2 * I_UP;
        for (int it = gw; it < NIT; it += ngw) {
            int r = it;
            if (r < I_IN) { const int nb = r % (INC / 32), kb = r / (INC / 32), n0 = nb * 32;
                const int d0 = n0 < 4096 ? n0 : (n0 < 4224 ? n0 + 2048 : n0 - 128);
                transpose_item(F.w_in, INC, kb * 64, n0, WinT, WINP, d0, 0, scr, F.lane); continue; } r -= I_IN;
            if (r < I_PA) { transpose_item(F.p_a, DM, (r / 32) * 64, (r % 32) * 32, PabT, 1024, (r % 32) * 32, 0, scr, F.lane); continue; } r -= I_PA;
            if (r < I_PB) { transpose_item(F.p_b, DM, (r / 32) * 64, (r % 32) * 32, PabT, 1024, (r % 32) * 32, 512, scr, F.lane); continue; } r -= I_PB;
            if (r < I_WO) { transpose_item(F.w_out, DM, (r / 32) * 64, (r % 32) * 32, WoutT, 1024, (r % 32) * 32, 0, scr, F.lane); continue; } r -= I_WO;
            if (r < I_PG) { transpose_item(F.w_pg, DM, (r / 32) * 64, (r % 32) * 32, WpgT, ACP, (r % 32) * 32, PLE, scr, F.lane); continue; } r -= I_PG;
            if (r < I_PU) { transpose_item(F.w_pu, DM, (r / 32) * 64, (r % 32) * 32, WpgT, ACP, (r % 32) * 32, 0, scr, F.lane); continue; } r -= I_PU;
            if (r < I_UP) { transpose_item(F.w_up, AW, 0, r * 32, (bf16*)(F.ws + WS_WUPT), 64, r * 32, 0, scr, F.lane); continue; } r -= I_UP;
            transpose_item(F.a_up, AW, 0, r * 32, (bf16*)(F.ws + WS_AUPT), 64, r * 32, 0, scr, F.lane);
        }
        for (int i = gw * 64 + F.lane; i < 128 * WINP / 8; i += ngw * 64) *(v4u*)(WinT + (size_t)INC * WINP + (size_t)i * 8) = (v4u){0u, 0u, 0u, 0u};
    }
}
__device__ __forceinline__ void p0_xpass(Frame& F) {
    LAS float* red = (LAS float*)F.lds;
    bf16* U2 = (bf16*)F.out; float* UBAR = (float*)(F.ws + WS_UBAR);
    for (int blk = F.vcu; blk < M / BLK; blk += F.G) {
        float cs[16];
#pragma unroll
        for (int i = 0; i < 16; ++i) cs[i] = 0.f;
        f32x4 gv[4];
#pragma unroll
        for (int j = 0; j < 4; ++j) gv[j] = *((const f32x4*)F.g_pre + F.lane + 64 * j);
        for (int i = 0; i < 8; ++i) {
            f32x4 v[4][4];
#pragma unroll
            for (int r = 0; r < 4; ++r) { const f32x4* xr = (const f32x4*)(F.x + ((size_t)blk * BLK + F.wave + 8 * (4 * i + r)) * DM) + F.lane;
#pragma unroll
                for (int j = 0; j < 4; ++j) v[r][j] = __builtin_nontemporal_load(xr + 64 * j); }
#pragma unroll
            for (int r = 0; r < 4; ++r) { const size_t row = (size_t)blk * BLK + F.wave + 8 * (4 * i + r); float s = 0.f;
#pragma unroll
                for (int j = 0; j < 4; ++j) s += (v[r][j][0] * v[r][j][0] + v[r][j][1] * v[r][j][1]) + (v[r][j][2] * v[r][j][2] + v[r][j][3] * v[r][j][3]);
                const float rs = frsq(wave_sum_fast(s) * (1.f / DM) + RMS_EPS);
#pragma unroll
                for (int j = 0; j < 4; ++j) {
                    float u[4]; unsigned h[4], l[4];
#pragma unroll
                    for (int e = 0; e < 4; ++e) { u[e] = v[r][j][e] * rs * gv[j][e]; cs[j * 4 + e] += u[e]; h[e] = f2bf(u[e]); l[e] = f2bf(u[e] - __uint_as_float(h[e] << 16)); }
                    const int col = 4 * F.lane + 256 * j;
                    *(v2u*)(U2 + row * 2048 + col) = (v2u){h[0] | (h[1] << 16), h[2] | (h[3] << 16)};
                    *(v2u*)(U2 + row * 2048 + 1024 + col) = (v2u){l[0] | (l[1] << 16), l[2] | (l[3] << 16)};
                } }
        }
        __syncthreads();
#pragma unroll
        for (int j = 0; j < 4; ++j)
#pragma unroll
            for (int e = 0; e < 4; ++e) red[F.wave * 1024 + 4 * F.lane + 256 * j + e] = cs[j * 4 + e];
        __syncthreads();
        for (int k = F.tid; k < 1024; k += NTHR) { float s = 0.f;
#pragma unroll
            for (int w = 0; w < 8; ++w) s += red[w * 1024 + k];
            UBAR[(size_t)blk * 1024 + k] = s * (1.f / BLK); }
    }
    __syncthreads();
}
__device__ __forceinline__ void p0_kmean(Frame& F) {
    LAS float* ub = (LAS float*)F.lds;
    LAS float* red = (LAS float*)(F.lds + 65536);
    const float* UBAR = (const float*)(F.ws + WS_UBAR); float* KMEAN = (float*)(F.ws + WS_KMEAN);
    for (int item = F.vcu; item < BATCH * 16; item += F.G) { const int bi = item >> 4, j = item & 15;
        __syncthreads();
        const int col = F.lane & 31, kp = F.lane >> 5, kb = F.wave * 128 + kp * 64;
        const float* wp = F.w_in + (size_t)kb * INC + 512 + 32 * j + col;
        float w[64];
#pragma unroll
        for (int i = 0; i < 64; ++i) w[i] = wp[(size_t)i * INC];
        for (int i = F.tid; i < 16 * 1024 / 4; i += NTHR) *(LAS f32x4*)(ub + 4 * i) = *(const f32x4*)(UBAR + (size_t)bi * 16 * 1024 + 4 * i);
        __syncthreads();
        float acc[16];
#pragma unroll
        for (int n = 0; n < 16; ++n) acc[n] = 0.f;
#pragma unroll
        for (int i = 0; i < 64; i += 4)
#pragma unroll
            for (int n = 0; n < 16; ++n) { const f32x4 u4 = *(const LAS f32x4*)(ub + n * 1024 + kb + i); acc[n] += (u4[0] * w[i] + u4[1] * w[i + 1]) + (u4[2] * w[i + 2] + u4[3] * w[i + 3]); }
#pragma unroll
        for (int n = 0; n < 16; ++n) red[((F.wave * 2 + kp) * 16 + n) * 32 + col] = acc[n];
        __syncthreads();
        { const int n = F.tid >> 5, c = F.tid & 31; float s = 0.f;
#pragma unroll
          for (int p = 0; p < 16; ++p) s += red[(p * 16 + n) * 32 + c];
          KMEAN[(size_t)(bi * 16 + n) * 512 + 32 * j + c] = s; }
    }
    __syncthreads();
}
__device__ __forceinline__ void p0_gvec(Frame& F) {
    LAS float* km = (LAS float*)F.lds;
    LAS float* wt = (LAS float*)(F.lds + 32768 + F.wave * 8704);
    const float* KMEAN = (const float*)(F.ws + WS_KMEAN); bf16* WgT = (bf16*)(F.ws + WS_WG);
    for (int item = F.vcu; item < BATCH * 16; item += F.G) { const int bi = item >> 4, j = item & 15, h = F.wave;
        __syncthreads();
        for (int i = F.tid; i < 16 * 512 / 4; i += NTHR) *(LAS f32x4*)(km + 4 * i) = *(const f32x4*)(KMEAN + (size_t)bi * 16 * 512 + 4 * i);
        __syncthreads();
#pragma unroll 1
        for (int p = 0; p < 2; ++p) {
            f32x4 t[8];
#pragma unroll
            for (int i = 0; i < 8; ++i) t[i] = *(const f32x4*)(F.w_in + (size_t)(64 * j + 32 * p + 4 * i + (F.lane >> 4)) * INC + h * 64 + 4 * (F.lane & 15));
#pragma unroll
            for (int i = 0; i < 8; ++i) *(LAS f32x4*)(wt + (4 * i + (F.lane >> 4)) * 68 + 4 * (F.lane & 15)) = t[i];
            asm volatile("s_waitcnt lgkmcnt(0)" ::: "memory");
            const int r = F.lane & 31, hf = F.lane >> 5;
            float acc[8];
#pragma unroll
            for (int n = 0; n < 8; ++n) acc[n] = 0.f;
#pragma unroll
            for (int c = 0; c < 16; ++c) { const f32x4 wv = *(const LAS f32x4*)(wt + r * 68 + 4 * c);
#pragma unroll
                for (int n = 0; n < 8; ++n) { const f32x4 kv = *(const LAS f32x4*)(km + (8 * hf + n) * 512 + h * 64 + 4 * c); acc[n] += (wv[0] * kv[0] + wv[1] * kv[1]) + (wv[2] * kv[2] + wv[3] * kv[3]); } }
            asm volatile("s_waitcnt lgkmcnt(0)" ::: "memory");
            const int k = 64 * j + 32 * p + r;
#pragma unroll
            for (int n = 0; n < 8; ++n) { const float s = acc[n]; const unsigned hi = f2bf(s), lo = f2bf(s - __uint_as_float(hi << 16));
                bf16* r0 = WgT + ((size_t)bi * 256 + h * 16 + 8 * hf + n) * 2048; bf16* r1 = r0 + (size_t)128 * 2048;
                r0[k] = (bf16)hi; r0[1024 + k] = (bf16)hi; r1[k] = (bf16)lo; r1[1024 + k] = (bf16)lo; }
        }
    }
    __syncthreads();
}

template <typename PartPtr> __device__ __forceinline__ void panel_norm(Frame& F, int pm, const bf16* Y, bf16* H1, float* RSY, PartPtr part, int part_row0) {
    f32x4 gv[4];
#pragma unroll
    for (int j = 0; j < 4; ++j) gv[j] = *((const f32x4*)F.g_post + F.lane + 64 * j);
    for (int i = 0; i < 8; ++i) {
        v2u yw[4][4]; f32x4 xv[4][4], pv[4]; float rs[4];
#pragma unroll
        for (int r = 0; r < 4; ++r) { const int rl = F.wave * 32 + 4 * i + r; const size_t row = (size_t)pm * 256 + rl;
            const v2u* yr = (const v2u*)(Y + row * DM) + F.lane; const f32x4* xr = (const f32x4*)(F.x + row * DM) + F.lane;
#pragma unroll
            for (int j = 0; j < 4; ++j) { yw[r][j] = __builtin_nontemporal_load(yr + 64 * j); xv[r][j] = __builtin_nontemporal_load(xr + 64 * j); }
            pv[r] = __builtin_nontemporal_load((const f32x4*)(F.p + row * PLE) + F.lane);
            const auto* pp = part + (size_t)(part_row0 + rl) * 4; const f32x4 a = pp[0], b = pp[1], c = pp[2], d = pp[3];
            rs[r] = frsq((((a[0] + a[1]) + (a[2] + a[3])) + ((b[0] + b[1]) + (b[2] + b[3])) + ((c[0] + c[1]) + (c[2] + c[3])) + ((d[0] + d[1]) + (d[2] + d[3]))) * (1.f / DM) + RMS_EPS);
            if (F.lane == 0) RSY[row] = rs[r]; }
#pragma unroll
        for (int r = 0; r < 4; ++r) { const size_t row = (size_t)pm * 256 + F.wave * 32 + 4 * i + r;
            *(v2u*)(H1 + row * ACP + 4 * F.lane) = (v2u){pk2(pv[r][0], pv[r][1]), pk2(pv[r][2], pv[r][3])};
#pragma unroll
            for (int j = 0; j < 4; ++j) { const v2u w = yw[r][j]; const float yv[4] = {__uint_as_float(w.x << 16), __uint_as_float(w.x & 0xffff0000u), __uint_as_float(w.y << 16), __uint_as_float(w.y & 0xffff0000u)}; float h[4];
#pragma unroll
                for (int e = 0; e < 4; ++e) h[e] = xv[r][j][e] + yv[e] * rs[r] * gv[j][e];
                *(v2u*)(H1 + row * ACP + PLE + 4 * F.lane + 256 * j) = (v2u){pk2(h[0], h[1]), pk2(h[2], h[3])}; } }
    }
}

__device__ __forceinline__ void post_norm(Frame& F) {
    const bf16* Y = (const bf16*)(F.ws + WS_RW); float* RSY = (float*)(F.ws + WS_RSY); bf16* H1 = (bf16*)(F.ws + WS_QKVZ);
    const int gw = F.vcu * NWAVES + F.wave, NGW = F.G * NWAVES;
    f32x4 gv[4];
#pragma unroll
    for (int j = 0; j < 4; ++j) gv[j] = *((const f32x4*)F.g_post + F.lane + 64 * j);
    for (int row0 = gw * 4; row0 < M; row0 += NGW * 4) {
        v2u yw[4][4]; f32x4 xv[4][4];
#pragma unroll
        for (int r = 0; r < 4; ++r) { const v2u* yr = (const v2u*)(Y + (size_t)(row0 + r) * DM) + F.lane; const f32x4* xr = (const f32x4*)(F.x + (size_t)(row0 + r) * DM) + F.lane;
#pragma unroll
            for (int j = 0; j < 4; ++j) { yw[r][j] = yr[64 * j]; xv[r][j] = xr[64 * j]; } }
#pragma unroll
        for (int r = 0; r < 4; ++r) { f32x4 v[4]; float s = 0.f;
#pragma unroll
            for (int j = 0; j < 4; ++j) { const v2u w = yw[r][j]; v[j] = (f32x4){__uint_as_float(w.x << 16), __uint_as_float(w.x & 0xffff0000u), __uint_as_float(w.y << 16), __uint_as_float(w.y & 0xffff0000u)}; s += (v[j][0] * v[j][0] + v[j][1] * v[j][1]) + (v[j][2] * v[j][2] + v[j][3] * v[j][3]); }
            const float rs = frsq(wave_sum_fast(s) * (1.f / DM) + RMS_EPS);
            if (F.lane == 0) RSY[row0 + r] = rs;
#pragma unroll
            for (int j = 0; j < 4; ++j) { float h[4];
#pragma unroll
                for (int e = 0; e < 4; ++e) h[e] = xv[r][j][e] + v[j][e] * rs * gv[j][e];
                *(v2u*)(H1 + (size_t)(row0 + r) * DM + 4 * F.lane + 256 * j) = (v2u){pk2(h[0], h[1]), pk2(h[2], h[3])}; } }
    }
}
namespace moba {
using bf16x8 = __attribute__((ext_vector_type(8))) short;
using s16x4 = __attribute__((ext_vector_type(4))) short;
using f32x16 = __attribute__((ext_vector_type(16))) float;
using u32x4 = __attribute__((ext_vector_type(4))) unsigned;
typedef short v4i16_t __attribute__((ext_vector_type(4)));
typedef float f32x2_t __attribute__((ext_vector_type(2))); typedef __bf16 bf16x2_t __attribute__((ext_vector_type(2)));
__device__ __forceinline__ int crow(int r, int hi) { return (r & 3) + 8 * (r >> 2) + 4 * hi; }
__device__ __forceinline__ unsigned cvtpk(float lo, float hi) { f32x2_t v = {lo, hi}; bf16x2_t b = __builtin_convertvector(v, bf16x2_t); return __builtin_bit_cast(unsigned, b); }
__device__ __forceinline__ float max3f(float a, float b, float c) { return fmaxf(fmaxf(a, b), c); }

constexpr int SLOTB = 8192;
__device__ __forceinline__ void qkt(f32x16& p0, f32x16& p1, const LAS unsigned char* Kslot, const bf16x8* qr, int r32, int hi) {
    const LAS unsigned char* kb = Kslot + hi * 1024 + r32 * 16;
    const f32x16 z = {};
#pragma unroll
    for (int d0 = 0; d0 < 4; ++d0) {
        const bf16x8 b0 = *(const LAS bf16x8*)(kb + d0 * 2048);
        const bf16x8 b1 = *(const LAS bf16x8*)(kb + d0 * 2048 + 512);
        if (d0 == 0) { p0 = __builtin_amdgcn_mfma_f32_32x32x16_bf16(b0, qr[0], z, 0, 0, 0); p1 = __builtin_amdgcn_mfma_f32_32x32x16_bf16(b1, qr[0], z, 0, 0, 0); }
        else { p0 = __builtin_amdgcn_mfma_f32_32x32x16_bf16(b0, qr[d0], p0, 0, 0, 0); p1 = __builtin_amdgcn_mfma_f32_32x32x16_bf16(b1, qr[d0], p1, 0, 0, 0); } }
}
__device__ __forceinline__ void qkt_acc(f32x16& p0, f32x16& p1, const LAS unsigned char* Kslot, const bf16x8* qr, int r32, int hi) {
    const LAS unsigned char* kb = Kslot + hi * 1024 + r32 * 16;
#pragma unroll
    for (int d0 = 0; d0 < 4; ++d0) {
        const bf16x8 b0 = *(const LAS bf16x8*)(kb + d0 * 2048);
        const bf16x8 b1 = *(const LAS bf16x8*)(kb + d0 * 2048 + 512);
        p0 = __builtin_amdgcn_mfma_f32_32x32x16_bf16(b0, qr[d0], p0, 0, 0, 0); p1 = __builtin_amdgcn_mfma_f32_32x32x16_bf16(b1, qr[d0], p1, 0, 0, 0); }
}
__device__ __forceinline__ void pv(f32x16* o, int vb, bf16x8 pa0, bf16x8 pa1, bf16x8 pa2, bf16x8 pa3) {
#pragma unroll
    for (int d0 = 0; d0 < 2; ++d0) { s16x4 lo[4], hi[4];
#pragma unroll
        for (int ks = 0; ks < 4; ++ks) {
            asm volatile("ds_read_b64_tr_b16 %0,%1 offset:%c2" : "=&v"(lo[ks]) : "v"(vb), "i"(d0 * 4096 + ks * 1024) : "memory");
            asm volatile("ds_read_b64_tr_b16 %0,%1 offset:%c2" : "=&v"(hi[ks]) : "v"(vb), "i"(d0 * 4096 + ks * 1024 + 512) : "memory"); }
        asm volatile("s_waitcnt lgkmcnt(0)" ::: "memory"); __builtin_amdgcn_sched_barrier(0);
#define PK(k) (bf16x8){lo[k][0], lo[k][1], lo[k][2], lo[k][3], hi[k][0], hi[k][1], hi[k][2], hi[k][3]}
        o[d0] = __builtin_amdgcn_mfma_f32_32x32x16_bf16(pa0, PK(0), o[d0], 0, 0, 0);
        o[d0] = __builtin_amdgcn_mfma_f32_32x32x16_bf16(pa1, PK(1), o[d0], 0, 0, 0);
        o[d0] = __builtin_amdgcn_mfma_f32_32x32x16_bf16(pa2, PK(2), o[d0], 0, 0, 0);
        o[d0] = __builtin_amdgcn_mfma_f32_32x32x16_bf16(pa3, PK(3), o[d0], 0, 0, 0);
#undef PK
    }
}
__device__ __forceinline__ float rowmax2(const f32x16& p0, const f32x16& p1, float a) {
#pragma unroll
    for (int r = 0; r < 16; r += 2) { a = max3f(a, p0[r], p0[r + 1]); a = max3f(a, p1[r], p1[r + 1]); }
    return a;
}
__device__ __forceinline__ float swapmax(float m) { auto rr = __builtin_amdgcn_permlane32_swap(__float_as_uint(m), __float_as_uint(m), false, false); return fmaxf(__uint_as_float(rr[0]), __uint_as_float(rr[1])); }
__device__ __forceinline__ float swapsum(float m) { auto rr = __builtin_amdgcn_permlane32_swap(__float_as_uint(m), __float_as_uint(m), false, false); return __uint_as_float(rr[0]) + __uint_as_float(rr[1]); }

__device__ __forceinline__ void load_kv_block(LAS unsigned char* lds, int KOFF, int VOFF, const bf16* QKVZ, size_t krow0, int h, int wid, int lane) {
    const bf16* ksrc = QKVZ + (krow0 + lane) * QP + 512 + h * HD + wid * 8;
    const bf16* vsrc = QKVZ + (krow0 + 16 * (wid & 3) + (lane >> 2)) * QP + 1024 + h * HD + (wid >> 2) * 32 + (lane & 3) * 8;
#pragma unroll
    for (int t = 0; t < 4; ++t) {
        __builtin_amdgcn_global_load_lds((const unsigned*)(ksrc + (size_t)t * 64 * QP), (LAS unsigned*)(lds + KOFF + t * SLOTB + wid * 1024), 16, 0, 0);
        __builtin_amdgcn_global_load_lds((const unsigned*)(vsrc + (size_t)t * 64 * QP), (LAS unsigned*)(lds + VOFF + t * SLOTB + wid * 1024), 16, 0, 0); }
}
}

constexpr int LIST_CAP = 3840;

__device__ __forceinline__ void attn_select(Frame& F, const float* GATE, unsigned* CNT, unsigned short* LISTS, int panel = -1) {
    constexpr int NIT = BATCH * NH * (SEQ / 64);
    const int gw = F.vcu * NWAVES + F.wave, NGW = F.G * NWAVES;
#pragma unroll 1
    for (int it0 = gw; it0 < NIT; it0 += 4 * NGW) {
        f32x4 ga[4][4]; int sb[4], sh[4], ss[4]; bool act[4];
#pragma unroll
        for (int k = 0; k < 4; ++k) { const int it = it0 + k * NGW; bool v = it < NIT; const int itc = v ? it : gw;
            int sg = itc % (SEQ / 64), h = (itc / (SEQ / 64)) % NH, b = itc / (SEQ / 64 * NH);
            if (panel >= 0) { const int j = F.wave * 4 + k; h = j & 7; sg = (panel & 15) * 4 + (j >> 3); b = panel >> 4; v = true; }
            const int s = sg * 64 + F.lane;
            sb[k] = b; sh[k] = h; ss[k] = s; act[k] = v && (s >> 8) > 0;
            const size_t row = (size_t)b * SEQ + s; const f32x4* gp = (const f32x4*)(GATE + row * 128 + h * 16);
#pragma unroll
            for (int c = 0; c < 4; ++c) ga[k][c] = gp[c]; }
        int i0[4], i1[4], i2[4], r0[4], r1[4], r2[4]; unsigned mycnt[4], base[4];
#pragma unroll
        for (int k = 0; k < 4; ++k) { const int qb = ss[k] >> 8;
            float g0 = -INFINITY, g1 = -INFINITY, g2 = -INFINITY; int j0 = -1, j1 = -1, j2 = -1;
#pragma unroll
            for (int c = 0; c < 4; ++c)
#pragma unroll
                for (int e = 0; e < 4; ++e) { const int n = c * 4 + e; const float g = (n < qb) ? ga[k][c][e] : -INFINITY;
                    if (g > g0) { g2 = g1; j2 = j1; g1 = g0; j1 = j0; g0 = g; j0 = n; } else if (g > g1) { g2 = g1; j2 = j1; g1 = g; j1 = n; } else if (g > g2) { g2 = g; j2 = n; } }
            if (!act[k]) { j0 = -1; j1 = -1; j2 = -1; }
            i0[k] = j0; i1[k] = j1; i2[k] = j2;
            int q0 = 0, q1 = 0, q2 = 0; unsigned mc = 0u;
            const int qbu = act[k] ? __builtin_amdgcn_readfirstlane(qb) : 0;
            for (int n = 0; n < qbu; ++n) {
                const bool pick = (j0 == n) | (j1 == n) | (j2 == n);
                const unsigned long long mask = __ballot(pick);
                const int before = __builtin_amdgcn_mbcnt_hi((unsigned)(mask >> 32), __builtin_amdgcn_mbcnt_lo((unsigned)mask, 0u));
                if (j0 == n) q0 = before; if (j1 == n) q1 = before; if (j2 == n) q2 = before;
                if (F.lane == n) mc = (unsigned)__popcll(mask);
            }
            r0[k] = q0; r1[k] = q1; r2[k] = q2; mycnt[k] = mc; }
#pragma unroll
        for (int k = 0; k < 4; ++k) { base[k] = 0u; if (mycnt[k]) base[k] = atomicAdd(CNT + (sb[k] * NH + sh[k]) * 16 + F.lane, mycnt[k]); }
#pragma unroll
        for (int k = 0; k < 4; ++k) { unsigned short* lst = LISTS + (size_t)(sb[k] * NH + sh[k]) * 16 * LIST_CAP; const int s = ss[k];
            const unsigned b0 = __shfl(base[k], i0[k] < 0 ? 0 : i0[k]), b1 = __shfl(base[k], i1[k] < 0 ? 0 : i1[k]), b2 = __shfl(base[k], i2[k] < 0 ? 0 : i2[k]);
            if (i0[k] >= 0) lst[(size_t)i0[k] * LIST_CAP + b0 + r0[k]] = (unsigned short)(s | (0 << 12));
            if (i1[k] >= 0) lst[(size_t)i1[k] * LIST_CAP + b1 + r1[k]] = (unsigned short)(s | (1 << 12));
            if (i2[k] >= 0) lst[(size_t)i2[k] * LIST_CAP + b2 + r2[k]] = (unsigned short)(s | (2 << 12)); }
        if (panel >= 0) break;
    }
}

__device__ __forceinline__ void attn_partial(Frame& F, const bf16* QKVZ, const unsigned* CNT, const unsigned short* LISTS, bf16* PART_O, float* PART_ML, unsigned* QCTR) {
    using namespace moba;
    LAS unsigned char* lds = F.lds; const int wid = F.wave, lane = F.lane, r32 = lane & 31, hi = lane >> 5;
    LAS float* btab = (LAS float*)(lds + 114688); LAS unsigned* uword = (LAS unsigned*)(lds + 106496); LAS unsigned short* llist = (LAS unsigned short*)(lds + 106624);
    LAS float* wsf = (LAS float*)(lds + 98304) + wid * 128; LAS bf16* stg = (LAS bf16*)(lds + 65536) + wid * 2048;
    for (int i = F.tid; i < NH * 512; i += NTHR) { const int h = i >> 9, d = i & 511; btab[i] = d < 113 ? (F.rel_bias[T5B[d] * NH + h] - F.rel_bias[31 * NH + h]) * LOG2E : 0.f; }
    const int vb0 = (int)(uintptr_t)(lds + 32768) + ((lane >> 4) & 1) * 32 + (lane & 3) * 8 + (4 * hi + ((lane & 15) >> 2)) * 64;
    const int NUNIT = BATCH * NH * 15;
    if (F.tid == 0) { const unsigned u0 = atomicAdd(QCTR, 1u); uword[0] = u0; uword[1] = (u0 < (unsigned)NUNIT) ? CNT[(u0 % (BATCH * NH)) * 16 + u0 / (BATCH * NH)] : 0u; }
    for (;;) {
        __syncthreads();
        const int u = (int)uword[0]; const int cnt = (int)uword[1];
        if (u >= NUNIT) break;
        const int n = u / (BATCH * NH), bh = u % (BATCH * NH), b = bh / NH, h = bh % NH;
        load_kv_block(lds, 0, 32768, QKVZ, (size_t)b * SEQ + n * BLK, h, wid, lane);
        const unsigned short* lst = LISTS + ((size_t)bh * 16 + n) * LIST_CAP;
        for (int i = F.tid; i < (cnt + 1) / 2; i += NTHR) ((LAS unsigned*)llist)[i] = ((const unsigned*)lst)[i];
        unsigned nu = 0u, nc = 0u;
        if (F.tid == 0) { nu = atomicAdd(QCTR, 1u); nc = (nu < (unsigned)NUNIT) ? CNT[(nu % (BATCH * NH)) * 16 + nu / (BATCH * NH)] : 0u; }
        const float b31 = F.rel_bias[31 * NH + h] * LOG2E;
        __syncthreads();
        const int ntile = (cnt + 31) >> 5;
        bf16x8 qn[4]; int tile = wid;
        if (tile < ntile) { const int idx = tile * 32 + r32; const unsigned e = llist[idx < cnt ? idx : 0]; const size_t row = (size_t)b * SEQ + (e & 4095);
#pragma unroll
            for (int d0 = 0; d0 < 4; ++d0) qn[d0] = *(const bf16x8*)(QKVZ + row * QP + h * HD + d0 * 16 + hi * 8); }
        for (; tile < ntile; tile += NWAVES) {
            int lane_ = F.tid; asm volatile("" : "+v"(lane_)); lane_ &= 63;
            const int lane = lane_, r32 = lane & 31, hi = lane >> 5;
            const int vb0 = (int)(uintptr_t)(lds + 32768) + ((lane >> 4) & 1) * 32 + (lane & 3) * 8 + (4 * hi + ((lane & 15) >> 2)) * 64;
            const int idx = tile * 32 + r32; const bool valid = idx < cnt;
            const unsigned e = llist[valid ? idx : 0]; const int s = e & 4095, slot = e >> 12; const size_t row = (size_t)b * SEQ + s;
            bf16x8 qr[4];
#pragma unroll
            for (int d0 = 0; d0 < 4; ++d0) qr[d0] = qn[d0];
            if (tile + NWAVES < ntile) { const int idx2 = (tile + NWAVES) * 32 + r32; const unsigned e2 = llist[idx2 < cnt ? idx2 : 0]; const size_t row2 = (size_t)b * SEQ + (e2 & 4095);
#pragma unroll
                for (int d0 = 0; d0 < 4; ++d0) qn[d0] = *(const bf16x8*)(QKVZ + row2 * QP + h * HD + d0 * 16 + hi * 8); }
            f32x16 o[2]; o[0] = f32x16{}; o[1] = f32x16{};
            float mx = -INFINITY, l = 0.f;
            const bool near = ((s >> 8) == n + 1);
            const int dbase = near ? (s - (n * BLK + 128)) : 400;
            const LAS float* bq = btab + h * 512 + dbase - 127;
#pragma unroll
            for (int half = 0; half < 2; ++half) {
                if (half) __builtin_amdgcn_sched_barrier(0);
                f32x16 p[2][2];
                if (half == 1) {
#pragma unroll
                    for (int t = 0; t < 2; ++t)
#pragma unroll
                        for (int r = 0; r < 16; ++r) { const int kvc = t * 64 + (r & 3) + 8 * (r >> 2);
                            p[t][0][r] = (bq - 4 * hi)[127 - kvc]; p[t][1][r] = (bq - 4 * hi)[127 - kvc - 32]; }
                } else { p[0][0] = f32x16{}; p[0][1] = f32x16{}; p[1][0] = f32x16{}; p[1][1] = f32x16{}; }
#pragma unroll
                for (int t = 0; t < 2; ++t) qkt_acc(p[t][0], p[t][1], lds + (2 * half + t) * SLOTB, qr, r32, hi);
                float m2 = rowmax2(p[0][0], p[0][1], mx); m2 = rowmax2(p[1][0], p[1][1], m2); m2 = swapmax(m2);
                const float f = fexp2(mx - m2); l *= f; mx = m2;
                if (half == 1) {
                    if (hi == 0) wsf[64 + r32] = f;
                    asm volatile("s_waitcnt lgkmcnt(0)" ::: "memory");
#pragma unroll
                    for (int r = 0; r < 16; ++r) { const float fr_ = wsf[64 + crow(r, hi)]; o[0][r] *= fr_; o[1][r] *= fr_; } }
#pragma unroll
                for (int t = 0; t < 2; ++t) {
#pragma unroll
                    for (int r = 0; r < 16; ++r) { p[t][0][r] = fexp2(p[t][0][r] - mx); p[t][1][r] = fexp2(p[t][1][r] - mx); l += p[t][0][r] + p[t][1][r]; }
                    u32x4 w0, w1, w2, w3;
                    w0 = (u32x4){cvtpk(p[t][0][0], p[t][0][1]), cvtpk(p[t][0][2], p[t][0][3]), cvtpk(p[t][0][4], p[t][0][5]), cvtpk(p[t][0][6], p[t][0][7])};
                    w1 = (u32x4){cvtpk(p[t][0][8], p[t][0][9]), cvtpk(p[t][0][10], p[t][0][11]), cvtpk(p[t][0][12], p[t][0][13]), cvtpk(p[t][0][14], p[t][0][15])};
                    w2 = (u32x4){cvtpk(p[t][1][0], p[t][1][1]), cvtpk(p[t][1][2], p[t][1][3]), cvtpk(p[t][1][4], p[t][1][5]), cvtpk(p[t][1][6], p[t][1][7])};
                    w3 = (u32x4){cvtpk(p[t][1][8], p[t][1][9]), cvtpk(p[t][1][10], p[t][1][11]), cvtpk(p[t][1][12], p[t][1][13]), cvtpk(p[t][1][14], p[t][1][15])};
                    pv(o, vb0 + (2 * half + t) * SLOTB, __builtin_bit_cast(bf16x8, w0), __builtin_bit_cast(bf16x8, w1), __builtin_bit_cast(bf16x8, w2), __builtin_bit_cast(bf16x8, w3)); }
            }
            __builtin_amdgcn_sched_barrier(0);
            l = swapsum(l);
            if (hi == 0) { wsf[r32] = frcp(l); ((LAS int*)wsf)[32 + r32] = valid ? (int)(((row * NH + h) * 3 + slot)) : -1;
                           if (valid) { float2 ml; ml.x = mx + b31; ml.y = l; *(float2*)(PART_ML + ((row * NH + h) * 3 + slot) * 2) = ml; } }
            asm volatile("s_waitcnt lgkmcnt(0)" ::: "memory");
#pragma unroll
            for (int r = 0; r < 16; ++r) { const int orow = crow(r, hi); const float il = wsf[orow];
#pragma unroll
                for (int d0 = 0; d0 < 2; ++d0) stg[orow * 64 + d0 * 32 + r32] = (bf16)f2bf(o[d0][r] * il); }
            asm volatile("s_waitcnt lgkmcnt(0)" ::: "memory");
#pragma unroll
            for (int i = 0; i < 4; ++i) { const int rr = i * 8 + (lane >> 3), ch = lane & 7; const int dst = ((LAS int*)wsf)[32 + rr];
                const u32x4 v = *(const LAS u32x4*)(stg + rr * 64 + ch * 8);
                if (dst >= 0) *(u32x4*)(PART_O + (size_t)dst * 64 + ch * 8) = v; }
            asm volatile("s_waitcnt lgkmcnt(0)" ::: "memory");
        }
        if (F.tid == 0) { uword[0] = nu; uword[1] = nc; }
    }
}

__device__ __forceinline__ void attn_own_combine(Frame& F, bf16* QKVZ, const bf16* PART_O, const float* PART_ML, bf16* OUTB, int out_pitch) {
    using namespace moba;
    LAS unsigned char* lds = F.lds; const int wid = F.wave, lane = F.lane, r32 = lane & 31, hi = lane >> 5;
    const int qt = wid < 4 ? wid : 11 - wid;
    LAS float* btab = (LAS float*)(lds + 139264);
    LAS float* wsf = (LAS float*)(lds + 135168) + wid * 128; LAS float* ost = (LAS float*)(lds + 65536 + wid * 8704);
    __syncthreads();
    for (int i = F.tid; i < NH * 256; i += NTHR) { const int h = i >> 8, d = i & 255; btab[i] = F.rel_bias[T5B[d < 127 ? d : 127] * NH + h] * LOG2E; }
    const int vb0 = (int)(uintptr_t)(lds + 32768) + ((lane >> 4) & 1) * 32 + (lane & 3) * 8 + (4 * hi + ((lane & 15) >> 2)) * 64;
    for (int u = F.vcu; u < BATCH * NH * NBLK; u += F.G) {
        const int qb = u % NBLK, bh = u / NBLK, b = bh / NH, h = bh % NH;
        __syncthreads();
        load_kv_block(lds, 0, 32768, QKVZ, (size_t)b * SEQ + qb * BLK, h, wid, lane);
        const int sq = qb * BLK + qt * 32 + r32; const size_t row = (size_t)b * SEQ + sq;
        bf16x8 qr[4];
#pragma unroll
        for (int d0 = 0; d0 < 4; ++d0) qr[d0] = *(const bf16x8*)(QKVZ + row * QP + h * HD + d0 * 16 + hi * 8);
        const int cq = lane >> 1, cc0 = (lane & 1) * 32; const size_t crow2 = (size_t)b * SEQ + qb * BLK + qt * 32 + cq;
        float2 pml[3]; v4u po[3][4], zw[4];
#pragma unroll
        for (int j = 0; j < 3; ++j) { pml[j] = *(const float2*)(PART_ML + ((crow2 * NH + h) * 3 + j) * 2);
#pragma unroll
            for (int c = 0; c < 4; ++c) po[j][c] = *((const v4u*)(PART_O + ((crow2 * NH + h) * 3 + j) * 64 + cc0) + c); }
#pragma unroll
        for (int c = 0; c < 4; ++c) zw[c] = *((const v4u*)(QKVZ + crow2 * QP + 1536 + h * HD + cc0) + c);
        __syncthreads();
        const int nt = (qt >> 1) + 1;
        int ql = qt * 32 + r32;
        asm volatile("" : "+v"(ql));
        const LAS float* bt = btab + h * 256;
        float mx = -INFINITY, l = 0.f;
        f32x16 o[2]; o[0] = f32x16{}; o[1] = f32x16{};
#pragma unroll 1
        for (int t = 0; t < nt; ++t) { f32x16 p0, p1;
            qkt(p0, p1, lds + t * SLOTB, qr, r32, hi);
            if (t < nt - 1) {
#pragma unroll
                for (int r = 0; r < 16; ++r) { const int kv = t * 64 + crow(r, hi); const int d0 = ql - kv, d1 = d0 - 32; p0[r] += bt[d0]; p1[r] += bt[d1]; }
            } else {
#pragma unroll
                for (int r = 0; r < 16; ++r) { const int kv = t * 64 + crow(r, hi); const int d0 = ql - kv, d1 = d0 - 32; const float b0 = bt[d0 < 0 ? 0 : d0], b1 = bt[d1 < 0 ? 0 : d1];
                    p0[r] = d0 >= 0 ? p0[r] + b0 : -INFINITY; p1[r] = d1 >= 0 ? p1[r] + b1 : -INFINITY; } }
            const float m2 = swapmax(rowmax2(p0, p1, mx));
            const float f = fexp2(mx - m2); l *= f; mx = m2;
            if (t > 0) { if (hi == 0) wsf[64 + r32] = f;
                asm volatile("s_waitcnt lgkmcnt(0)" ::: "memory");
#pragma unroll
                for (int r = 0; r < 16; ++r) { const float fr_ = wsf[64 + crow(r, hi)]; o[0][r] *= fr_; o[1][r] *= fr_; } }
#pragma unroll
            for (int r = 0; r < 16; ++r) { p0[r] = fexp2(p0[r] - mx); p1[r] = fexp2(p1[r] - mx); l += p0[r] + p1[r]; }
            u32x4 w0, w1, w2, w3;
            w0 = (u32x4){cvtpk(p0[0], p0[1]), cvtpk(p0[2], p0[3]), cvtpk(p0[4], p0[5]), cvtpk(p0[6], p0[7])};
            w1 = (u32x4){cvtpk(p0[8], p0[9]), cvtpk(p0[10], p0[11]), cvtpk(p0[12], p0[13]), cvtpk(p0[14], p0[15])};
            w2 = (u32x4){cvtpk(p1[0], p1[1]), cvtpk(p1[2], p1[3]), cvtpk(p1[4], p1[5]), cvtpk(p1[6], p1[7])};
            w3 = (u32x4){cvtpk(p1[8], p1[9]), cvtpk(p1[10], p1[11]), cvtpk(p1[12], p1[13]), cvtpk(p1[14], p1[15])};
            pv(o, vb0 + t * SLOTB, __builtin_bit_cast(bf16x8, w0), __builtin_bit_cast(bf16x8, w1), __builtin_bit_cast(bf16x8, w2), __builtin_bit_cast(bf16x8, w3));
        }
        l = swapsum(l);
        if (hi == 0) { wsf[r32] = mx; wsf[32 + r32] = l; }
#pragma unroll
        for (int r = 0; r < 16; ++r) { const int orow = crow(r, hi);
#pragma unroll
            for (int d0 = 0; d0 < 2; ++d0) ost[orow * 68 + d0 * 32 + r32] = o[d0][r]; }
        asm volatile("s_waitcnt lgkmcnt(0)" ::: "memory");
        { const int q = lane >> 1, c0 = (lane & 1) * 32; const int s2 = qb * BLK + qt * 32 + q; const size_t row2 = (size_t)b * SEQ + s2;
          const float m0 = wsf[q], l0 = wsf[32 + q]; const int np = qb < 3 ? qb : 3;
          float mj[3], lj[3]; float mt = m0;
#pragma unroll
          for (int j = 0; j < 3; ++j) { if (j < np) { const float2 ml = pml[j]; mj[j] = ml.x; lj[j] = ml.y; mt = fmaxf(mt, ml.x); } else { mj[j] = -INFINITY; lj[j] = 0.f; } }
          const float w0 = fexp2(m0 - mt); float wj[3]; float den = w0 * l0;
#pragma unroll
          for (int j = 0; j < 3; ++j) { wj[j] = (j < np) ? fexp2(mj[j] - mt) * lj[j] : 0.f; den += wj[j]; }
          const float iden = frcp(den);
          float acc[32];
#pragma unroll
          for (int c = 0; c < 32; c += 4) { const f32x4 v = *(const LAS f32x4*)(ost + q * 68 + c0 + c); acc[c] = v[0] * w0; acc[c + 1] = v[1] * w0; acc[c + 2] = v[2] * w0; acc[c + 3] = v[3] * w0; }
#pragma unroll
          for (int j = 0; j < 3; ++j) if (j < np) {
#pragma unroll
              for (int c = 0; c < 4; ++c) { const v4u w = po[j][c]; const float f = wj[j];
                  acc[c * 8 + 0] += f * __uint_as_float(w.x << 16); acc[c * 8 + 1] += f * __uint_as_float(w.x & 0xffff0000u); acc[c * 8 + 2] += f * __uint_as_float(w.y << 16); acc[c * 8 + 3] += f * __uint_as_float(w.y & 0xffff0000u);
                  acc[c * 8 + 4] += f * __uint_as_float(w.z << 16); acc[c * 8 + 5] += f * __uint_as_float(w.z & 0xffff0000u); acc[c * 8 + 6] += f * __uint_as_float(w.w << 16); acc[c * 8 + 7] += f * __uint_as_float(w.w & 0xffff0000u); } }
          asm volatile("s_waitcnt lgkmcnt(0)" ::: "memory");
#pragma unroll
          for (int c = 0; c < 4; ++c) { const v4u w = zw[c]; const float z[8] = {__uint_as_float(w.x << 16), __uint_as_float(w.x & 0xffff0000u), __uint_as_float(w.y << 16), __uint_as_float(w.y & 0xffff0000u),
                                                                               __uint_as_float(w.z << 16), __uint_as_float(w.z & 0xffff0000u), __uint_as_float(w.w << 16), __uint_as_float(w.w & 0xffff0000u)};
              float rr[8];
#pragma unroll
              for (int e2 = 0; e2 < 8; ++e2) rr[e2] = acc[c * 8 + e2] * iden * z[e2] * sigm(z[e2]);
              v4u ow; ow.x = pk2(rr[0], rr[1]); ow.y = pk2(rr[2], rr[3]); ow.z = pk2(rr[4], rr[5]); ow.w = pk2(rr[6], rr[7]); *(LAS v4u*)((LAS bf16*)ost + q * 72 + c0 + c * 8) = ow; }
          asm volatile("s_waitcnt lgkmcnt(0)" ::: "memory");
#pragma unroll
          for (int i = 0; i < 4; ++i) { const int rr = i * 8 + (lane >> 3), chk = lane & 7; const v4u w = *(const LAS v4u*)((LAS bf16*)ost + rr * 72 + chk * 8);
              *(v4u*)(OUTB + ((size_t)b * SEQ + qb * BLK + qt * 32 + rr) * out_pitch + h * HD + chk * 8) = w; } }
        asm volatile("s_waitcnt lgkmcnt(0)" ::: "memory");
    }
}
namespace rk {
using bf16x8 = __attribute__((ext_vector_type(8))) short;
using s16x4 = __attribute__((ext_vector_type(4))) short;
using f32x16 = __attribute__((ext_vector_type(16))) float;
using u32x4 = __attribute__((ext_vector_type(4))) unsigned;
using u32x2 = __attribute__((ext_vector_type(2))) unsigned;
typedef short v4i16_t __attribute__((ext_vector_type(4)));
typedef float f32x2_t __attribute__((ext_vector_type(2))); typedef __bf16 bf16x2_t __attribute__((ext_vector_type(2)));
constexpr int P = 144, IMG = 64 * P, GRP = 81920, MISC = 8 * IMG;
#define RK_MFMA(a, b, c) __builtin_amdgcn_mfma_f32_32x32x16_bf16((a), (b), (c), 0, 0, 0)
__device__ __forceinline__ int crow(int r, int hi) { return (r & 3) + 8 * (r >> 2) + 4 * hi; }
__device__ __forceinline__ unsigned cvtpk(float lo, float hi) { f32x2_t v = {lo, hi}; bf16x2_t b = __builtin_convertvector(v, bf16x2_t); return __builtin_bit_cast(unsigned, b); }
__device__ __forceinline__ float bflo(unsigned w) { return __uint_as_float(w << 16); }
__device__ __forceinline__ float bfhi(unsigned w) { return __uint_as_float(w & 0xffff0000u); }
__device__ __forceinline__ s16x4 trrd(const LAS unsigned char* p) { return __builtin_bit_cast(s16x4, __builtin_amdgcn_ds_read_tr16_b64_v4i16((LAS v4i16_t*)p)); }
struct Ln { int r, h, blk, q, p; };
__device__ __forceinline__ bf16x8 frag_row(const LAS unsigned char* img, const Ln& l, int tile, int s, int coloff = 0) { return *(const LAS bf16x8*)(img + (32 * tile + l.r) * P + (coloff + 16 * s + 8 * l.h) * 2); }
__device__ __forceinline__ bf16x8 frag_tr(const LAS unsigned char* img, const Ln& l, int tile, int s, int rowoff = 0) {
    const LAS unsigned char* b = img + (rowoff + 16 * s + 8 * l.h + l.q) * P + 64 * tile + 32 * l.blk + 8 * l.p;
    const s16x4 lo = trrd(b), hi = trrd(b + 4 * P);
    return (bf16x8){lo[0], lo[1], lo[2], lo[3], hi[0], hi[1], hi[2], hi[3]};
}
__device__ __forceinline__ bf16x8 frag_row_perm(const LAS unsigned char* img, const Ln& l, int tile, int s, int coloff = 0) {
    const LAS unsigned char* b = img + (32 * tile + l.r) * P + (coloff + 16 * s + 4 * l.h) * 2;
    const s16x4 lo = *(const LAS s16x4*)b, hi = *(const LAS s16x4*)(b + 16);
    return (bf16x8){lo[0], lo[1], lo[2], lo[3], hi[0], hi[1], hi[2], hi[3]};
}
__device__ __forceinline__ bf16x8 frag_tr_perm(const LAS unsigned char* img, const Ln& l, int tile, int s, int rowoff = 0) {
    const LAS unsigned char* b = img + (rowoff + 16 * s + 4 * l.h + l.q) * P + 64 * tile + 32 * l.blk + 8 * l.p;
    const s16x4 lo = trrd(b), hi = trrd(b + 8 * P);
    return (bf16x8){lo[0], lo[1], lo[2], lo[3], hi[0], hi[1], hi[2], hi[3]};
}
__device__ __forceinline__ bf16x8 pack(const f32x16& x, int s) {
    u32x4 w; w.x = cvtpk(x[8 * s], x[8 * s + 1]); w.y = cvtpk(x[8 * s + 2], x[8 * s + 3]); w.z = cvtpk(x[8 * s + 4], x[8 * s + 5]); w.w = cvtpk(x[8 * s + 6], x[8 * s + 7]);
    return __builtin_bit_cast(bf16x8, w);
}
__device__ __forceinline__ void store_T(LAS unsigned char* img, const Ln& l, const f32x16& x, int ti, int tj) {
#pragma unroll
    for (int g = 0; g < 4; ++g) { u32x2 w; w.x = cvtpk(x[4 * g], x[4 * g + 1]); w.y = cvtpk(x[4 * g + 2], x[4 * g + 3]);
        *(LAS u32x2*)(img + (32 * tj + l.r) * P + (32 * ti + 8 * g + 4 * l.h) * 2) = w; }
}
__device__ __forceinline__ float xhalf(float v) { return __shfl_xor(v, 32); }
__device__ __forceinline__ void tri_inv32(f32x16& D, f32x16& DT, f32x16 S, f32x16 ST) {
    const f32x16 z = {};
#pragma unroll
    for (int it = 0; it < 4; ++it) {
        f32x16 S2 = z, S2T = z;
#pragma unroll
        for (int s = 0; s < 2; ++s) { const bf16x8 ps = pack(S, s), pst = pack(ST, s); S2 = RK_MFMA(pst, ps, S2); S2T = RK_MFMA(ps, pst, S2T); }
        f32x16 DS = S2, DST = S2T;
#pragma unroll
        for (int s = 0; s < 2; ++s) { DS = RK_MFMA(pack(DT, s), pack(S2, s), DS); DST = RK_MFMA(pack(S2, s), pack(DT, s), DST); }
        D = D + DS; DT = DT + DST; S = S2; ST = S2T;
    }
}
}

constexpr size_t DO_NT = 0, DO_MT = 128 * MiB, DO_RH = 192 * MiB;

struct R1Ctx { int item, c, h, b; int nc, nh, nb; rk::f32x16 Wt0, Wt1; unsigned bcnt; };
#ifndef MK_R1_GBAR
#define MK_R1_GBAR 0
#endif
__device__ __forceinline__ void r1_gbar(Frame& F, unsigned& cnt) {
#if MK_R1_GBAR
    int t_ = F.tid; asm volatile("" : "+v"(t_));
    LAS unsigned* ctr = (LAS unsigned*)(F.lds + (t_ >> 8) * rk::GRP + rk::MISC + 8000);
    asm volatile("s_waitcnt lgkmcnt(0)" ::: "memory");
    cnt += 4u;
    if ((t_ & 63) == 0) __hip_atomic_fetch_add(ctr, 1u, __ATOMIC_RELAXED, __HIP_MEMORY_SCOPE_WORKGROUP);
    while (__hip_atomic_load(ctr, __ATOMIC_RELAXED, __HIP_MEMORY_SCOPE_WORKGROUP) < cnt) __builtin_amdgcn_s_sleep(1);
    asm volatile("" ::: "memory");
#else
    (void)cnt; __syncthreads();
#endif
}
#define RK_RELANE() do { int t_ = F.tid; asm volatile("" : "+v"(t_)); lane = t_ & 63; tg = t_ & 255; grp = t_ >> 8; w4 = (t_ >> 6) & 3; ti = w4 >> 1; tj = w4 & 1; l.r = lane & 31; l.h = lane >> 5; l.blk = (lane >> 4) & 1; l.q = (lane & 15) >> 2; l.p = lane & 3; G = F.lds + grp * GRP; } while (0)
#define RK_KA() const __attribute__((address_space(4))) Args* ka = (const __attribute__((address_space(4))) Args*)__builtin_amdgcn_kernarg_segment_ptr(); asm volatile("" : "+s"(ka))
#define s0 (G)
#define s1 (G + IMG)
#define s2 (G + 2 * IMG)
#define s3 (G + 3 * IMG)
#define s4 (G + 4 * IMG)
#define s5 (G + 5 * IMG)
#define s6 (G + 6 * IMG)
#define s7 (G + 7 * IMG)
#define nrminv ((LAS float*)(G + MISC))
#define ltot (nrminv + 64)
#define gam (nrminv + 128)
#define bonp (nrminv + 192)
#define hcst (nrminv + 384)
template <int VAR> __device__ __forceinline__ void r1_S1a_t(Frame& F, R1Ctx& X) {
    using namespace rk;
    if (VAR == 3) { int t_ = F.tid; asm volatile("" : "+v"(t_)); if ((t_ & 255) < 64) ((LAS float*)(F.lds + (t_ >> 8) * GRP + MISC))[t_ & 63] = 1.0f; return; }
    int grp, w4, ti, tj, lane, tg; Ln l; LAS unsigned char* G; const f32x16 z16 = {};
    RK_RELANE(); (void)w4; (void)tg; (void)ti; (void)tj;
    const int item = X.item, c = X.c, h = X.h, b = X.b; (void)item; (void)c; (void)h; (void)b;
    { RK_KA(); const bf16* RW = (const bf16*)(ka->ws + WS_RW); const float* mu_ = ka->in[5]; const float* kk_ = ka->in[10];
      const int t = tg >> 2, q4 = tg & 3; const int sq = c * 64 + t; const size_t row = (size_t)b * SEQ + sq;
      const bf16* cur = RW + row * RWC; const bool hasp = sq > 0; const bf16* prv = hasp ? cur - RWC : cur; const float pm = hasp ? 1.f : 0.f;
      float nr = 0.f;
      v4u cr_[2], pr_[2], ck_[2], pk_[2], cv_[2], pv_[2], cw_[2], pw_[2], ca_[2], pa_[2];
#pragma unroll
      for (int half = 0; half < 2; ++half) { const int k0 = 16 * q4 + 8 * half, col = h * HD + k0;
          if (VAR == 2) { const v4u c_ = {0x3f803f80u + (unsigned)col, 0x3f003f00u, 0x3e803e80u, 0x3f803f00u}; cr_[half] = c_; pr_[half] = c_; ck_[half] = c_; pk_[half] = c_; cv_[half] = c_; pv_[half] = c_; cw_[half] = c_; pw_[half] = c_; ca_[half] = c_; pa_[half] = c_; } else {
          cr_[half] = *(const v4u*)(cur + col); pr_[half] = *(const v4u*)(prv + col); ck_[half] = *(const v4u*)(cur + 512 + col); pk_[half] = *(const v4u*)(prv + 512 + col); cv_[half] = *(const v4u*)(cur + 1024 + col); pv_[half] = *(const v4u*)(prv + 1024 + col);
          cw_[half] = *(const v4u*)(cur + 2048 + k0); pw_[half] = *(const v4u*)(prv + 2048 + k0); ca_[half] = *(const v4u*)(cur + 2112 + k0); pa_[half] = *(const v4u*)(prv + 2112 + k0); } }
      __builtin_amdgcn_sched_barrier(0);
#pragma unroll
      for (int half = 0; half < 2; ++half) { const int k0 = 16 * q4 + 8 * half, col = h * HD + k0;
          const v4u cr = cr_[half], pr = pr_[half], ck = ck_[half], pk = pk_[half], cv = cv_[half], pv = pv_[half], cw = cw_[half], pw = pw_[half], ca = ca_[half], pa = pa_[half];
          float ro[8], ko[8], vo[8], wo[8], ao[8];
          float mr[8], mk[8], mv[8], mw[8], ma[8], kkc[8];
          { const LAS f32x4* p; f32x4 x0, x1;
#define LD8_(dst, ptr) p = (const LAS f32x4*)(ptr); x0 = p[0]; x1 = p[1]; dst[0] = x0[0]; dst[1] = x0[1]; dst[2] = x0[2]; dst[3] = x0[3]; dst[4] = x1[0]; dst[5] = x1[1]; dst[6] = x1[2]; dst[7] = x1[3]
            LD8_(mr, hcst + k0); LD8_(mk, hcst + 64 + k0); LD8_(mv, hcst + 128 + k0); LD8_(mw, hcst + 256 + k0); LD8_(ma, hcst + 320 + k0); LD8_(kkc, hcst + 384 + k0);
#undef LD8_
          }
#pragma unroll
          for (int e = 0; e < 8; ++e) { const unsigned wcr = cr[e >> 1], wpr = pr[e >> 1], wck = ck[e >> 1], wpk = pk[e >> 1], wcv = cv[e >> 1], wpv = pv[e >> 1];
              const unsigned wcw = cw[e >> 1], wpw = pw[e >> 1], wca = ca[e >> 1], wpa = pa[e >> 1];
              const float xr = (e & 1) ? bfhi(wcr) : bflo(wcr), yr = pm * ((e & 1) ? bfhi(wpr) : bflo(wpr)); ro[e] = xr + (yr - xr) * mr[e];
              const float xk = (e & 1) ? bfhi(wck) : bflo(wck), yk = pm * ((e & 1) ? bfhi(wpk) : bflo(wpk)); ko[e] = xk + (yk - xk) * mk[e];
              const float xv = (e & 1) ? bfhi(wcv) : bflo(wcv), yv = pm * ((e & 1) ? bfhi(wpv) : bflo(wpv)); vo[e] = xv + (yv - xv) * mv[e];
              const float xw = (e & 1) ? bfhi(wcw) : bflo(wcw), yw = pm * ((e & 1) ? bfhi(wpw) : bflo(wpw)); wo[e] = ftanh(xw + (yw - xw) * mw[e]);
              const float xa = (e & 1) ? bfhi(wca) : bflo(wca), ya = pm * ((e & 1) ? bfhi(wpa) : bflo(wpa)); ao[e] = xa + (ya - xa) * ma[e];
              const float kkx = ko[e] * kkc[e]; nr += kkx * kkx; }
          const int off = t * P + k0 * 2;
          *(LAS u32x4*)(s0 + off) = (u32x4){cvtpk(wo[0], wo[1]), cvtpk(wo[2], wo[3]), cvtpk(wo[4], wo[5]), cvtpk(wo[6], wo[7])};
          *(LAS u32x4*)(s1 + off) = (u32x4){cvtpk(ao[0], ao[1]), cvtpk(ao[2], ao[3]), cvtpk(ao[4], ao[5]), cvtpk(ao[6], ao[7])};
          *(LAS u32x4*)(s2 + off) = (u32x4){cvtpk(ro[0], ro[1]), cvtpk(ro[2], ro[3]), cvtpk(ro[4], ro[5]), cvtpk(ro[6], ro[7])};
          *(LAS u32x4*)(s3 + off) = (u32x4){cvtpk(ko[0], ko[1]), cvtpk(ko[2], ko[3]), cvtpk(ko[4], ko[5]), cvtpk(ko[6], ko[7])};
          const u32x4 vw = (u32x4){cvtpk(vo[0], vo[1]), cvtpk(vo[2], vo[3]), cvtpk(vo[4], vo[5]), cvtpk(vo[6], vo[7])};
          *(LAS u32x4*)(s4 + off) = vw;
          }
      nr += __shfl_xor(nr, 1); nr += __shfl_xor(nr, 2);
      if (q4 == 0) nrminv[t] = frsq(fmaxf(nr, 1e-24f)); }
}
__device__ __forceinline__ void r1_S1a(Frame& F, R1Ctx& X) { r1_S1a_t<0>(F, X); }
__device__ __forceinline__ void r1_S1b(Frame& F, R1Ctx& X) {
    using namespace rk;
    int grp, w4, ti, tj, lane, tg; Ln l; LAS unsigned char* G; const f32x16 z16 = {};
    RK_RELANE(); (void)w4; (void)tg; (void)ti; (void)tj;
    const int item = X.item, c = X.c, h = X.h, b = X.b; (void)item; (void)c; (void)h; (void)b;
    {
        RK_KA(); const bf16* WupT = (const bf16*)(ka->ws + WS_WUPT); const bf16* AupT = (const bf16*)(ka->ws + WS_AUPT);
        const int kcol = 32 * tj + l.r, kc = h * HD + kcol;
        f32x16 W = z16, Aq = z16;
#pragma unroll
        for (int s = 0; s < 4; ++s) { const bf16x8 bw = *(const bf16x8*)(WupT + (size_t)kc * 64 + 16 * s + 8 * l.h), ba = *(const bf16x8*)(AupT + (size_t)kc * 64 + 16 * s + 8 * l.h);
            W = RK_MFMA(frag_row(s0, l, ti, s), bw, W); Aq = RK_MFMA(frag_row(s1, l, ti, s), ba, Aq); }
        const float w0 = hcst[448 + kcol], a0 = hcst[512 + kcol], kkc = hcst[384 + kcol], kac = hcst[576 + kcol], rkc = hcst[640 + kcol];
        float lw[16], L[16];
#pragma unroll
        for (int r = 0; r < 16; ++r) { const float x = W[r] + w0; const float sp = (-x > 20.f) ? -x : 0.6931471805599453f * __builtin_amdgcn_logf(1.0f + fexp(-x)); lw[r] = -fexp(-sp - 0.5f); Aq[r] = sigm(Aq[r] + a0); }
        float gs[4], go[4];
#pragma unroll
        for (int g = 0; g < 4; ++g) { L[4 * g] = lw[4 * g]; L[4 * g + 1] = L[4 * g] + lw[4 * g + 1]; L[4 * g + 2] = L[4 * g + 1] + lw[4 * g + 2]; L[4 * g + 3] = L[4 * g + 2] + lw[4 * g + 3]; gs[g] = L[4 * g + 3]; }
        float run = 0.f;
#pragma unroll
        for (int g = 0; g < 4; ++g) { const float og = xhalf(gs[g]); const float lo = l.h ? og : gs[g], hi = l.h ? gs[g] : og;
            go[g] = run + (l.h ? lo : 0.f); run += lo + hi; }
#pragma unroll
        for (int r = 0; r < 16; ++r) L[r] += go[r >> 2];
        if (ti == 0 && l.h == 0) ltot[kcol] = run;
        r1_gbar(F, X.bcnt);
        if (ti == 1) { const float add = ltot[kcol];
#pragma unroll
            for (int r = 0; r < 16; ++r) L[r] += add;
            if (l.h == 1) gam[kcol] = fexp(L[15]); }
        f32x16 At, Bt, Kt, Rt; float xb[16];
#pragma unroll
        for (int r = 0; r < 16; ++r) { const int t = 32 * ti + crow(r, l.h);
            const float rr = bf2f(*(const LAS unsigned short*)(s2 + t * P + kcol * 2)), kx = bf2f(*(const LAS unsigned short*)(s3 + t * P + kcol * 2));
            const float kn = kx * kkc * nrminv[t], a = Aq[r], km = kx * (1.0f + (a - 1.0f) * kac);
            const float eL = fexp(L[r]), eLn = fexp(-L[r]), eLp = fexp(L[r] - lw[r]);
            At[r] = -kn * eLp; Bt[r] = kn * a * eLn; Kt[r] = km * eLn; Rt[r] = rr * eL; xb[r] = rr * km * rkc; }
#pragma unroll
        for (int r = 0; r < 16; ++r) xb[r] = dpp_sum32(xb[r]);
        if (l.r == 31) {
#pragma unroll
            for (int r = 0; r < 16; ++r) bonp[tj * 64 + 32 * ti + crow(r, l.h)] = xb[r]; }
        store_T(s0, l, At, ti, tj); store_T(s1, l, Bt, ti, tj); store_T(s5, l, Kt, ti, tj); store_T(s6, l, Rt, ti, tj);
    }
}
__device__ __forceinline__ void r1_S2(Frame& F, R1Ctx& X) {
    using namespace rk;
    int grp, w4, ti, tj, lane, tg; Ln l; LAS unsigned char* G; const f32x16 z16 = {};
    RK_RELANE(); (void)w4; (void)tg; (void)ti; (void)tj;
    const int item = X.item, c = X.c, h = X.h, b = X.b; (void)item; (void)c; (void)h; (void)b;
    unsigned pf0 = 0u, pf1 = 0u;
    if (X.nb >= 0) { RK_KA(); const bf16* RW = (const bf16*)(ka->ws + WS_RW);
        { const int j = tg; const int rr = j / 6, pc = j % 6; const long sq = (long)X.nb * SEQ + X.nc * 64 + rr - 1;
          if (sq >= (long)X.nb * SEQ) pf0 = *(const volatile unsigned char*)(RW + (size_t)sq * RWC + (pc < 4 ? pc * 512 + X.nh * HD : 2048 + (pc - 4) * 64)); }
        { const int j = tg + 256; const int rr = j / 6, pc = j % 6; const long sq = (long)X.nb * SEQ + X.nc * 64 + rr - 1;
          if (j < 65 * 6) pf1 = *(const volatile unsigned char*)(RW + (size_t)sq * RWC + (pc < 4 ? pc * 512 + X.nh * HD : 2048 + (pc - 4) * 64)); } }
    {
        f32x16 X = z16;
        if (ti >= tj) {
#pragma unroll
            for (int s = 0; s < 4; ++s) X = RK_MFMA(frag_tr(s0, l, ti, s), frag_tr(s5, l, tj, s), X);
#pragma unroll
            for (int r = 0; r < 16; ++r) { const int t = 32 * ti + crow(r, l.h), i = 32 * tj + l.r; if (!(t > i)) X[r] = 0.f; } }
        store_T(s2, l, X, ti, tj);
        if (w4 == 0 || w4 == 3) { const int d = w4 == 3;
            f32x16 S = z16, ST = z16;
#pragma unroll
            for (int s = 0; s < 4; ++s) { const bf16x8 fa = frag_tr(s0, l, d, s), fb = frag_tr(s1, l, d, s); S = RK_MFMA(fa, fb, S); ST = RK_MFMA(fb, fa, ST); }
#pragma unroll
            for (int r = 0; r < 16; ++r) { const int rw = crow(r, l.h); if (!(rw > l.r)) S[r] = 0.f; if (!(l.r > rw)) ST[r] = 0.f; }
            f32x16 D = S, DT = ST;
            tri_inv32(D, DT, S, ST);
            store_T(s7, l, D, d, d);
            asm volatile("s_waitcnt lgkmcnt(0)" ::: "memory");
            if (l.h == 0) *(LAS unsigned short*)(s7 + (32 * d + l.r) * P + (32 * d + l.r) * 2) = 0x3f80;
        } else if (w4 == 2) {
            f32x16 X21 = z16;
#pragma unroll
            for (int s = 0; s < 4; ++s) X21 = RK_MFMA(frag_tr(s0, l, 1, s), frag_tr(s1, l, 0, s), X21);
            store_T(s3, l, X21, 0, 0);
        } else {
            store_T(s7, l, z16, 0, 1);
            { RK_KA(); float* BON = (float*)(ka->ws + WS_BON); const int t = lane; BON[((size_t)b * SEQ + c * 64 + t) * NH + h] = bonp[t] + bonp[64 + t]; }
        }
    }
    asm volatile("" :: "v"(pf0), "v"(pf1));
}
__device__ __forceinline__ void r1_S3(Frame& F, R1Ctx& X) {
    using namespace rk;
    int grp, w4, ti, tj, lane, tg; Ln l; LAS unsigned char* G; const f32x16 z16 = {};
    RK_RELANE(); (void)w4; (void)tg; (void)ti; (void)tj;
    const int item = X.item, c = X.c, h = X.h, b = X.b; (void)item; (void)c; (void)h; (void)b;
    f32x16& Wt0 = X.Wt0; f32x16& Wt1 = X.Wt1;
    Wt0 = z16; Wt1 = z16;
    {
        if (w4 == 2) {
            f32x16 E = z16;
#pragma unroll
            for (int s = 0; s < 2; ++s) E = RK_MFMA(frag_tr(s3, l, 0, s), frag_row(s7, l, 0, s), E);
            store_T(s3, l, E, 0, 1);
            f32x16 T21 = z16;
#pragma unroll
            for (int s = 0; s < 2; ++s) T21 = RK_MFMA(frag_tr(s7, l, 1, s, 32), frag_row(s3, l, 1, s), T21);
            store_T(s7, l, T21, 1, 0);
        }
#pragma unroll
        for (int s = 0; s < 4; ++s) Wt0 = RK_MFMA(frag_tr(s2, l, 0, s), frag_tr(s4, l, tj, s), Wt0);
        if (ti == 1) {
#pragma unroll
            for (int s = 0; s < 4; ++s) Wt1 = RK_MFMA(frag_tr(s2, l, 1, s), frag_tr(s4, l, tj, s), Wt1); }
    }
}
__device__ __forceinline__ void r1_S4(Frame& F, R1Ctx& X) {
    using namespace rk;
    int grp, w4, ti, tj, lane, tg; Ln l; LAS unsigned char* G; const f32x16 z16 = {};
    RK_RELANE(); (void)w4; (void)tg; (void)ti; (void)tj;
    const int item = X.item, c = X.c, h = X.h, b = X.b; (void)item; (void)c; (void)h; (void)b;
    f32x16& Wt0 = X.Wt0; f32x16& Wt1 = X.Wt1;
    {
        f32x16 Ap = z16;
#pragma unroll
        for (int s = 0; s < 4; ++s) if (s < 2 || ti == 1) Ap = RK_MFMA(frag_tr(s7, l, ti, s), frag_row(s0, l, tj, s), Ap);
        f32x16 Uv = z16;
#pragma unroll
        for (int s = 0; s < 2; ++s) Uv = RK_MFMA(frag_tr_perm(s7, l, ti, s, 0), pack(Wt0, s), Uv);
        if (ti == 1) {
#pragma unroll
            for (int s = 0; s < 2; ++s) Uv = RK_MFMA(frag_tr_perm(s7, l, ti, s, 32), pack(Wt1, s), Uv); }
        store_T(s2, l, Ap, ti, tj); store_T(s3, l, Uv, ti, tj);
    }
}
__device__ __forceinline__ void r1_S5(Frame& F, R1Ctx& X) {
    using namespace rk;
    int grp, w4, ti, tj, lane, tg; Ln l; LAS unsigned char* G; const f32x16 z16 = {};
    RK_RELANE(); (void)w4; (void)tg; (void)ti; (void)tj;
    const int item = X.item, c = X.c, h = X.h, b = X.b; (void)item; (void)c; (void)h; (void)b;
    {
        RK_KA(); float* NT = (float*)((unsigned char*)ka->out + DO_NT); bf16* MT = (bf16*)((unsigned char*)ka->out + DO_MT); bf16* RH = (bf16*)((unsigned char*)ka->out + DO_RH); bf16* Y0 = (bf16*)(ka->ws + WS_GATE);
        const size_t ib = (size_t)((b * 64 + c) * NH + h) * 4096;
        f32x16 Xrb0 = z16, Xrk0 = z16, Xrb1 = z16, Xrk1 = z16;
#pragma unroll
        for (int s = 0; s < 4; ++s) { const bf16x8 fr = frag_tr(s6, l, ti, s); Xrb0 = RK_MFMA(frag_tr(s1, l, 0, s), fr, Xrb0); Xrk0 = RK_MFMA(frag_tr(s5, l, 0, s), fr, Xrk0); }
        if (ti == 1) {
#pragma unroll
            for (int s = 0; s < 4; ++s) { const bf16x8 fr = frag_tr(s6, l, ti, s); Xrb1 = RK_MFMA(frag_tr(s1, l, 1, s), fr, Xrb1); Xrk1 = RK_MFMA(frag_tr(s5, l, 1, s), fr, Xrk1); } }
#pragma unroll
        for (int r = 0; r < 16; ++r) { const bool keep = crow(r, l.h) <= l.r; if (ti == 0) { if (!keep) { Xrb0[r] = 0.f; Xrk0[r] = 0.f; } } else { if (!keep) { Xrb1[r] = 0.f; Xrk1[r] = 0.f; } } }
        f32x16 acc;
#pragma unroll
        for (int g = 0; g < 4; ++g) { const u32x2 w = *(const LAS u32x2*)(s6 + (32 * tj + l.r) * P + (32 * ti + 8 * g + 4 * l.h) * 2); acc[4 * g] = bflo(w.x); acc[4 * g + 1] = bfhi(w.x); acc[4 * g + 2] = bflo(w.y); acc[4 * g + 3] = bfhi(w.y); }
#pragma unroll
        for (int s = 0; s < 2; ++s) acc = RK_MFMA(pack(Xrb0, s), frag_row_perm(s2, l, tj, s, 0), acc);
        if (ti == 1) {
#pragma unroll
            for (int s = 0; s < 2; ++s) acc = RK_MFMA(pack(Xrb1, s), frag_row_perm(s2, l, tj, s, 32), acc); }
#pragma unroll
        for (int r = 0; r < 16; ++r) RH[ib + (32 * ti + crow(r, l.h)) * 64 + 32 * tj + l.r] = (bf16)f2bf(acc[r]);
        acc = z16;
#pragma unroll
        for (int s = 0; s < 2; ++s) { acc = RK_MFMA(pack(Xrb0, s), frag_row_perm(s3, l, tj, s, 0), acc); acc = RK_MFMA(pack(Xrk0, s), frag_tr_perm(s4, l, tj, s, 0), acc); }
        if (ti == 1) {
#pragma unroll
            for (int s = 0; s < 2; ++s) { acc = RK_MFMA(pack(Xrb1, s), frag_row_perm(s3, l, tj, s, 32), acc); acc = RK_MFMA(pack(Xrk1, s), frag_tr_perm(s4, l, tj, s, 32), acc); } }
#pragma unroll
        for (int r = 0; r < 16; ++r) Y0[ib + (32 * ti + crow(r, l.h)) * 64 + 32 * tj + l.r] = (bf16)f2bf(acc[r]);
        acc = z16;
#pragma unroll
        for (int s = 0; s < 4; ++s) acc = RK_MFMA(frag_row(s1, l, ti, s), frag_row(s2, l, tj, s), acc);
#pragma unroll
        for (int r = 0; r < 16; ++r) { const int kp = 32 * ti + crow(r, l.h), k = 32 * tj + l.r; const float v = (acc[r] + (kp == k ? 1.f : 0.f)) * gam[kp]; MT[ib + kp * 64 + k] = (bf16)f2bf(v); }
        acc = z16;
#pragma unroll
        for (int s = 0; s < 4; ++s) { acc = RK_MFMA(frag_row(s1, l, ti, s), frag_row(s3, l, tj, s), acc); acc = RK_MFMA(frag_row(s5, l, ti, s), frag_tr(s4, l, tj, s), acc); }
#pragma unroll
        for (int r = 0; r < 16; ++r) NT[ib + ((ti * 2 + tj) * 16 + r) * 64 + lane] = acc[r] * gam[32 * ti + crow(r, l.h)];
    }
}
__device__ __forceinline__ void r1_consts(Frame& F, int h) {
    using namespace rk;
    int t_ = F.tid; asm volatile("" : "+v"(t_)); const int grp = t_ >> 8, tg = t_ & 255; LAS unsigned char* G = F.lds + grp * GRP;
    for (int i = tg; i < 11 * 64; i += 256) { const int a = i >> 6, k = i & 63, col = h * HD + k; float v;
        switch (a) { case 0: v = F.mu[col]; break; case 1: v = F.mu[512 + col]; break; case 2: v = F.mu[1024 + col]; break; case 3: v = F.mu[1536 + col]; break; case 4: v = F.mu[2048 + k]; break; case 5: v = F.mu[2112 + k]; break;
                     case 6: v = F.k_k[col]; break; case 7: v = F.w0[col]; break; case 8: v = F.a0[col]; break; case 9: v = F.k_a[col]; break; default: v = F.r_k[col]; break; }
        hcst[i] = v; }
}
#ifndef MK_R1_REP
#define MK_R1_REP -1
#endif
__device__ __forceinline__ void rwkv_chunk_ops(Frame& F) {
    R1Ctx X; int cur_h = -1; X.bcnt = 0u; bool first = true;
    { int t_ = F.tid; asm volatile("" : "+v"(t_)); if ((t_ & 255) == 0) *(LAS unsigned*)(F.lds + (t_ >> 8) * rk::GRP + rk::MISC + 8000) = 0u; }
    __syncthreads();
    for (int ip = F.vcu; ip < BATCH * NH * 64 / 2; ip += F.G) {
        { const int hh = ((ip * 2) >> 6) % NH; if (hh != cur_h) { r1_consts(F, hh); cur_h = hh; __syncthreads(); } }
#if MK_R1_GBAR
        if (first) { first = false; if (F.wave >= 4) { for (int i_ = 0; i_ < MK_R1_GBAR * 3; ++i_) __builtin_amdgcn_s_sleep(127); } }
#endif
        { int t_ = F.tid; asm volatile("" : "+v"(t_)); const int grp = t_ >> 8; X.item = ip * 2 + grp; X.c = X.item & 63; const int bh = X.item >> 6; X.h = bh % NH; X.b = bh / NH;
          const int nit = (ip + F.G) * 2 + grp; const int nbh = nit >> 6; X.nc = nit & 63; X.nh = nbh % NH; X.nb = (ip + F.G < BATCH * NH * 64 / 2) ? nbh / NH : -1; }
        r1_S1a(F, X); r1_gbar(F, X.bcnt);
        if constexpr (MK_R1_REP == 0) { r1_S1a(F, X); r1_gbar(F, X.bcnt); }
        r1_S1b(F, X); r1_gbar(F, X.bcnt);
        if constexpr (MK_R1_REP == 1) { r1_S1a(F, X); r1_gbar(F, X.bcnt); r1_S1b(F, X); r1_gbar(F, X.bcnt); }
        r1_S2(F, X); r1_gbar(F, X.bcnt);
        if constexpr (MK_R1_REP == 2) { r1_S2(F, X); r1_gbar(F, X.bcnt); }
        r1_S3(F, X); r1_gbar(F, X.bcnt);
        r1_S4(F, X); r1_gbar(F, X.bcnt);
        r1_S5(F, X); r1_gbar(F, X.bcnt);
        if constexpr (MK_R1_REP == 5) { r1_S5(F, X); r1_gbar(F, X.bcnt); }
    }
}
#undef s0
#undef s1
#undef s2
#undef s3
#undef s4
#undef s5
#undef s6
#undef s7
#undef nrminv
#undef ltot
#undef gam
#undef bonp
#undef hcst
__device__ __forceinline__ void rwkv_relay(Frame& F) {
    using namespace rk;
    const int lane = F.lane, wid = F.wave; const int lr = lane & 31, lh = lane >> 5;
    LAS float* sbuf = (LAS float*)F.lds; volatile LAS int* flag = (volatile LAS int*)(F.lds + 16384);
    const float* NT = (const float*)((unsigned char*)F.out + DO_NT); bf16* MT = (bf16*)((unsigned char*)F.out + DO_MT);
    for (int ch = F.vcu; ch < BATCH * NH * 2; ch += F.G) {
        const int bh = ch >> 1, ct = ch & 1;
        __syncthreads();
        for (int i = F.tid; i < 2048; i += NTHR) sbuf[i] = 0.f;
        if (F.tid == 0) flag[0] = 0;
        __syncthreads();
        for (int c = wid; c < 64; c += NWAVES) {
            const size_t ib = (size_t)(((bh >> 3) * 64 + c) * NH + (bh & 7)) * 4096;
            bf16x8 am[2][4]; f32x16 sn[2];
#pragma unroll
            for (int rt = 0; rt < 2; ++rt)
#pragma unroll
                for (int s = 0; s < 4; ++s) { const bf16* pm = MT + ib + (32 * rt + lr) * 64 + 16 * s + 4 * lh;
                    const v2u m0 = *(const v2u*)pm, m1 = *(const v2u*)(pm + 8);
                    am[rt][s] = __builtin_bit_cast(bf16x8, (u32x4){m0.x, m0.y, m1.x, m1.y}); }
#pragma unroll
            for (int rt = 0; rt < 2; ++rt)
#pragma unroll
                for (int r = 0; r < 16; ++r) sn[rt][r] = NT[ib + ((rt * 2 + ct) * 16 + r) * 64 + lane];
            while (flag[0] < c) __builtin_amdgcn_s_sleep(1);
            asm volatile("s_waitcnt lgkmcnt(0)" ::: "memory");
            const LAS float* sin = sbuf + (c & 1) * 2048; LAS float* sout = sbuf + ((c + 1) & 1) * 2048;
            bf16x8 sp[2][2];
#pragma unroll
            for (int kt = 0; kt < 2; ++kt) { f32x16 sv;
#pragma unroll
                for (int r = 0; r < 16; ++r) sv[r] = sin[(kt * 16 + r) * 64 + lane];
                sp[kt][0] = pack(sv, 0); sp[kt][1] = pack(sv, 1); }
#pragma unroll
            for (int s = 0; s < 4; ++s)
#pragma unroll
                for (int rt = 0; rt < 2; ++rt) sn[rt] = RK_MFMA(am[rt][s], sp[s >> 1][s & 1], sn[rt]);
#pragma unroll
            for (int rt = 0; rt < 2; ++rt)
#pragma unroll
                for (int r = 0; r < 16; ++r) sout[(rt * 16 + r) * 64 + lane] = sn[rt][r];
            asm volatile("s_waitcnt lgkmcnt(0)" ::: "memory");
            if (lane == 0) flag[0] = c + 1;
            bf16* sc = (bf16*)(F.ws + WS_SC) + ib;
#pragma unroll
            for (int kt = 0; kt < 2; ++kt)
#pragma unroll
                for (int sl = 0; sl < 2; ++sl) *(bf16x8*)(sc + (((kt * 2 + ct) * 2 + sl) * 64 + lane) * 8) = sp[kt][sl];
        }
    }
}

struct R2Tile { v4u y0[4], cv[4], pv[4], cz[4], pz[4]; float bon, pm; };
__device__ __forceinline__ void r2_load_tile(R2Tile& T, const bf16* Y0, const bf16* RW, const float* BON, size_t ib, int b, int h, int c, int tt, int lane) {
    const int q = lane >> 1, c0 = (lane & 1) * 32; const int sq = c * 64 + tt * 32 + q; const size_t row = (size_t)b * SEQ + sq;
    const v4u* y0p = (const v4u*)(Y0 + ib + (tt * 32 + q) * 64 + c0);
    const bf16* cur = RW + row * RWC + h * HD + c0; const bool hasp = sq > 0; const bf16* prv = hasp ? cur - RWC : cur; T.pm = hasp ? 1.f : 0.f;
#pragma unroll
    for (int i = 0; i < 4; ++i) { T.y0[i] = y0p[i]; T.cv[i] = *((const v4u*)(cur + 1024) + i); T.pv[i] = *((const v4u*)(prv + 1024) + i); T.cz[i] = *((const v4u*)(cur + 1536) + i); T.pz[i] = *((const v4u*)(prv + 1536) + i); }
    T.bon = BON[row * NH + h];
}
__device__ __forceinline__ void rwkv_output(Frame& F) {
    using namespace rk;
    const int wid = F.wave;
    LAS float* yst = (LAS float*)(F.lds + wid * 8704); LAS float* cst = (LAS float*)(F.lds + 69632);
    bf16* QKVZ = (bf16*)(F.ws + WS_QKVZ); const bf16* RW = (const bf16*)(F.ws + WS_RW);
    const bf16* SC = (const bf16*)(F.ws + WS_SC); const bf16* RH = (const bf16*)((unsigned char*)F.out + DO_RH);
    const bf16* Y0 = (const bf16*)(F.ws + WS_GATE); const float* BON = (const float*)(F.ws + WS_BON);
    __syncthreads();
    for (int i = F.tid; i < 4 * 512; i += NTHR) { const int a = i >> 9, col = i & 511; cst[i] = a == 0 ? F.ln_w[col] : a == 1 ? F.ln_b[col] : a == 2 ? F.mu[1024 + col] : F.mu[1536 + col]; }
    __syncthreads();
    const int gw = F.vcu * NWAVES + wid, NGW = F.G * NWAVES;
    for (int idx = gw; idx < BATCH * NH * 64; idx += NGW) {
        const int h = idx & 7, c = (idx >> 3) & 63, b = idx >> 9; const size_t ib = (size_t)idx * 4096;
        bf16x8 sp[2][2][2];
        { const int lane = F.lane;
#pragma unroll
          for (int kt = 0; kt < 2; ++kt)
#pragma unroll
              for (int ct = 0; ct < 2; ++ct)
#pragma unroll
                  for (int sl = 0; sl < 2; ++sl) sp[kt][ct][sl] = *(const bf16x8*)(SC + ib + (((kt * 2 + ct) * 2 + sl) * 64 + lane) * 8); }
#pragma unroll 1
        for (int tt = 0; tt < 2; ++tt) {
            int lane_ = F.tid; asm volatile("" : "+v"(lane_)); const int lane = lane_ & 63, lr = lane & 31, lh = lane >> 5;
            bf16x8 ar[4];
#pragma unroll
            for (int s = 0; s < 4; ++s) { const bf16* pr = RH + ib + (32 * tt + lr) * 64 + 16 * s + 4 * lh; const v2u r0 = *(const v2u*)pr, r1 = *(const v2u*)(pr + 8);
                ar[s] = __builtin_bit_cast(bf16x8, (u32x4){r0.x, r0.y, r1.x, r1.y}); }
            R2Tile T; r2_load_tile(T, Y0, RW, BON, ib, b, h, c, tt, lane);
            f32x16 y0 = {}, y1 = {};
#ifndef MK_R2B_X
#define MK_R2B_X 0
#endif
#pragma unroll 1
            for (int rep2 = 0; rep2 < (MK_R2B_X == 2 ? 4 : 1); ++rep2) {
            y0 = f32x16{}; y1 = f32x16{};
#pragma unroll
            for (int s = 0; s < 4; ++s) { y0 = RK_MFMA(ar[s], sp[s >> 1][0][s & 1], y0); y1 = RK_MFMA(ar[s], sp[s >> 1][1][s & 1], y1); }
#pragma unroll
            for (int r = 0; r < 16; ++r) { yst[crow(r, lh) * 68 + lr] = y0[r]; yst[crow(r, lh) * 68 + 32 + lr] = y1[r]; }
            asm volatile("s_waitcnt lgkmcnt(0)" ::: "memory"); }
            const int q = lane >> 1, c0 = (lane & 1) * 32; const int sq = c * 64 + tt * 32 + q; const size_t row = (size_t)b * SEQ + sq;
            const LAS float* cs = cst + h * HD + c0;
            float y[32];
#pragma unroll 1
            for (int rep1 = 0; rep1 < (MK_R2B_X == 1 ? 4 : 1); ++rep1) {
#pragma unroll
            for (int e = 0; e < 32; e += 8) { const f32x4 a = *(const LAS f32x4*)(yst + q * 68 + c0 + e), bq = *(const LAS f32x4*)(yst + q * 68 + c0 + e + 4); const v4u w = T.y0[e >> 3];
                y[e] = a[0] + bflo(w.x); y[e + 1] = a[1] + bfhi(w.x); y[e + 2] = a[2] + bflo(w.y); y[e + 3] = a[3] + bfhi(w.y); y[e + 4] = bq[0] + bflo(w.z); y[e + 5] = bq[1] + bfhi(w.z); y[e + 6] = bq[2] + bflo(w.w); y[e + 7] = bq[3] + bfhi(w.w); }
            float sm = 0.f;
#pragma unroll
            for (int e = 0; e < 32; ++e) sm += y[e];
            sm += __shfl_xor(sm, 1); const float mean = sm * (1.f / 64.f);
            float sv = 0.f;
#pragma unroll
            for (int e = 0; e < 32; ++e) { const float d = y[e] - mean; sv += d * d; }
            sv += __shfl_xor(sv, 1); const float rstd = frsq(sv * (1.f / 64.f) + GN_EPS);
            const float bon = T.bon;
#pragma unroll
            for (int e = 0; e < 32; e += 8) { const v4u cvw = T.cv[e >> 3], pvw = T.pv[e >> 3], czw = T.cz[e >> 3], pzw = T.pz[e >> 3];
                float o[8];
#pragma unroll
                for (int j4 = 0; j4 < 8; j4 += 4) {
                    const f32x4 lw = *(const LAS f32x4*)(cs + e + j4), lb = *(const LAS f32x4*)(cs + 512 + e + j4), mv = *(const LAS f32x4*)(cs + 1024 + e + j4), mz = *(const LAS f32x4*)(cs + 1536 + e + j4);
#pragma unroll
                    for (int jj = 0; jj < 4; ++jj) { const int j = j4 + jj; const unsigned wcv = cvw[j >> 1], wpv = pvw[j >> 1], wcz = czw[j >> 1], wpz = pzw[j >> 1];
                        const float xv = (j & 1) ? bfhi(wcv) : bflo(wcv), yv = T.pm * ((j & 1) ? bfhi(wpv) : bflo(wpv)), xz = (j & 1) ? bfhi(wcz) : bflo(wcz), yz = T.pm * ((j & 1) ? bfhi(wpz) : bflo(wpz));
                        const float vv = xv + (yv - xv) * mv[jj], zz = xz + (yz - xz) * mz[jj];
                        o[j] = ((y[e + j] - mean) * rstd * lw[jj] + lb[jj] + bon * vv) * (zz * sigm(zz)); }
                    __builtin_amdgcn_sched_barrier(0); }
                *(LAS v4u*)((LAS bf16*)yst + q * 72 + c0 + e) = (v4u){pk2(o[0], o[1]), pk2(o[2], o[3]), pk2(o[4], o[5]), pk2(o[6], o[7])}; }
            asm volatile("s_waitcnt lgkmcnt(0)" ::: "memory");
#pragma unroll
            for (int i = 0; i < 4; ++i) { const int rr = i * 8 + (lane >> 3), chk = lane & 7; const v4u w = *(const LAS v4u*)((LAS bf16*)yst + rr * 72 + chk * 8);
                *(v4u*)(QKVZ + ((size_t)b * SEQ + c * 64 + tt * 32 + rr) * QP + 512 + h * HD + chk * 8) = w; }
            asm volatile("s_waitcnt lgkmcnt(0)" ::: "memory"); }
        }
    }
}
#define BAR_ST ((volatile LAS unsigned*)(F.lds + 163832))
constexpr int LDS_BYTES = 163840;
constexpr int NPHASE = 13;

template <int PLO, int PHI> __global__ void __launch_bounds__(NTHR, 2) fwd(Args args) {
    extern __shared__ __attribute__((aligned(16))) unsigned char lds[];
    Frame F;
    F.lds = (LAS unsigned char*)lds;
#define RETID() do { int t_ = threadIdx.x; asm volatile("" : "+v"(t_)); F.tid = t_; F.lane = t_ & 63; F.wave = __builtin_amdgcn_readfirstlane(t_ >> 6); \
    int bx_ = blockIdx.x, g_ = gridDim.x; asm volatile("" : "+s"(bx_), "+s"(g_)); F.G = g_; F.vcu = (g_ % 8 == 0) ? (bx_ % 8) * (g_ / 8) + bx_ / 8 : bx_; } while (0)
    RETID();
    if (threadIdx.x == 0) { BAR_ST[0] = 0u; BAR_ST[1] = 0u; }
    if constexpr (PHI - PLO > 1) xcd_barrier_post((unsigned*)(args.ws + WS_BAR));
    if (args.ph_hi == 0x7fffffff) cg::this_grid().sync();
#define LOADF() do { const __attribute__((address_space(4))) Args* ap_ = (const __attribute__((address_space(4))) Args*)__builtin_amdgcn_kernarg_segment_ptr(); asm volatile("" : "+s"(ap_)); \
    F.x = ap_->in[0]; F.p = ap_->in[1]; F.g_pre = ap_->in[2]; F.w_in = ap_->in[3]; F.rel_bias = ap_->in[4]; F.mu = ap_->in[5]; F.w0 = ap_->in[6]; F.w_up = ap_->in[7]; \
    F.a0 = ap_->in[8]; F.a_up = ap_->in[9]; F.k_k = ap_->in[10]; F.k_a = ap_->in[11]; F.r_k = ap_->in[12]; F.ln_w = ap_->in[13]; F.ln_b = ap_->in[14]; \
    F.p_a = ap_->in[15]; F.p_b = ap_->in[16]; F.w_out = ap_->in[17]; F.g_post = ap_->in[18]; F.w_pu = ap_->in[19]; F.w_pg = ap_->in[20]; F.out = ap_->out; F.ws = ap_->ws; ws = F.ws; \
    U2 = (pg8::bf16_t*)F.out; MERGED = (pg8::bf16_t*)(ws + WS_RW); QKVZ = (pg8::bf16_t*)(ws + WS_QKVZ); RWb = (pg8::bf16_t*)(ws + WS_RW); GAB = (pg8::bf16_t*)(ws + WS_GAB); } while (0)
    unsigned char* ws; pg8::bf16_t *U2, *MERGED, *QKVZ, *RWb, *GAB;
    constexpr int lo = PLO, hi = PHI;
    cg::grid_group grid = cg::this_grid();
#define IN(k) (lo <= (k) && (k) < hi)
#define GRIDBAR() do { const __attribute__((address_space(4))) Args* apb_ = (const __attribute__((address_space(4))) Args*)__builtin_amdgcn_kernarg_segment_ptr(); asm volatile("" : "+s"(apb_)); \
    xcd_barrier((unsigned*)(apb_->ws + WS_BAR), BAR_ST); } while (0)
#define SEAM(k) do { if constexpr (IN(k) && IN((k) + 1)) GRIDBAR(); } while (0)
#ifndef MK_REPEAT_PHASE
#define MK_REPEAT_PHASE -1
#endif
#define NREP(k) (((k) == MK_REPEAT_PHASE) ? 2 : 1)
#ifndef MK_STAGM
#define MK_STAGM 3
#endif
#define STAGGER(steps) do { const int d_ = (F.vcu & MK_STAGM) * (steps); for (int i_ = 0; i_ < d_; ++i_) __builtin_amdgcn_s_sleep(107); } while (0)
#ifndef MK_SELFUSE
#define MK_SELFUSE 0
#endif
#ifndef MK_STAG4
#define MK_STAG4 0
#endif
#ifndef MK_STAG5
#define MK_STAG5 0
#endif
#ifndef MK_STAG7
#define MK_STAG7 0
#endif

#define P0SEQ() do { RETID(); LOADF(); p0_xpass(F); pro_side(F, 0, F.vcu * NWAVES + F.wave, F.G * NWAVES, F.vcu * NTHR + F.tid, F.G * NTHR); GRIDBAR(); \
    RETID(); LOADF(); p0_kmean(F); GRIDBAR(); RETID(); LOADF(); p0_gvec(F); } while (0)
    if constexpr (IN(0)) { P0SEQ(); if constexpr (0 == MK_REPEAT_PHASE) { GRIDBAR(); P0SEQ(); } } SEAM(0);
#ifdef MK_BWTEST
    if constexpr (IN(1)) { RETID(); LOADF();
        const f32x4* xp = (const f32x4*)F.x; f32x4 acc = {0.f, 0.f, 0.f, 0.f};
        const int gw = F.vcu * NWAVES + F.wave, NGW = F.G * NWAVES;
        if (MK_BWTEST == 1) { const size_t n4 = (size_t)M * DM / 4;
            for (size_t i = (size_t)F.vcu * NTHR + F.tid; i + (size_t)31 * F.G * NTHR < n4; i += (size_t)32 * F.G * NTHR) { f32x4 t[32];
#pragma unroll
                for (int j = 0; j < 32; ++j) t[j] = xp[i + (size_t)j * F.G * NTHR];
#pragma unroll
                for (int j = 0; j < 32; ++j) acc += t[j]; }
        } else {
            for (int it = gw; it < (M / 32) * 8; it += NGW) { const int rg = it >> 3, cb = it & 7; const int q = F.lane >> 1, hf = F.lane & 1;
                const f32x4* p = xp + ((size_t)(rg * 32 + q) * DM + cb * 128 + hf * 64) / 4; f32x4 t[16];
#pragma unroll
                for (int j = 0; j < 16; ++j) t[j] = p[j];
#pragma unroll
                for (int j = 0; j < 16; ++j) acc += t[j]; } }
        if (acc[0] + acc[1] + acc[2] + acc[3] == 1.2345e30f) ((float*)(ws + WS_RSY))[F.tid] = acc[0];
        grid.sync(); }
#endif
    if constexpr (IN(1)) { RETID(); LOADF();
#ifndef MK_STAG1
#define MK_STAG1 2
#endif
        STAGGER(MK_STAG1);
        { pg8::Gemm g{U2, (const pg8::bf16_t*)(ws + WS_WIN), M, INCP, DM, 2048, WINP, 0, 0}; pg8::StaticOrder S; S.init(M, INCP, F.G, (int)blockIdx.x);
          pg8::EpiCols E{QKVZ, RWb, GAB, QSCALE};
          pg8::gemm_phase<pg8::EpiCols, pg8::StaticOrder, true, true>(F.lds, g, S, E);
          if constexpr (MK_REPEAT_PHASE == 101) { __syncthreads(); pg8::gemm_phase<pg8::EpiCols, pg8::StaticOrder, true, true>(F.lds, g, S, E); } }
        { pg8::Gemm g{U2, (const pg8::bf16_t*)(ws + WS_WG), M, 256, 2048, 2048, 2048, 16, (size_t)256 * 2048}; pg8::StaticOrder S; S.init(M, 256, F.G, (int)blockIdx.x);
          pg8::EpiGate E{(float*)(ws + WS_GATE)};
          pg8::gemm_phase<pg8::EpiGate, pg8::StaticOrder, true, true>(F.lds, g, S, E);
          if constexpr (MK_REPEAT_PHASE == 102) { __syncthreads(); pg8::gemm_phase<pg8::EpiGate, pg8::StaticOrder, true, true>(F.lds, g, S, E); }
#if MK_SELFUSE
          __syncthreads();
          { pg8::Unit u; for (int i = 0; S.next(i, u); ++i) { RETID(); attn_select(F, (const float*)(ws + WS_GATE), (unsigned*)(ws + WS_CNT), (unsigned short*)(ws + WS_LISTS), u.pm); } }
#endif
        }
    } SEAM(1);
#ifdef MK_SYNCTEST
    for (int i_ = 0; i_ < 20; ++i_) GRIDBAR();
#endif
#if !MK_SELFUSE
    if constexpr (IN(2)) { RETID(); LOADF(); attn_select(F, (const float*)(ws + WS_GATE), (unsigned*)(ws + WS_CNT), (unsigned short*)(ws + WS_LISTS));
        if constexpr (2 == MK_REPEAT_PHASE) { GRIDBAR(); if (blockIdx.x == 0) for (int i = threadIdx.x; i < 2048; i += NTHR) ((unsigned*)(args.ws + WS_CNT))[i] = 0u; GRIDBAR(); RETID(); LOADF();
            attn_select(F, (const float*)(ws + WS_GATE), (unsigned*)(ws + WS_CNT), (unsigned short*)(ws + WS_LISTS)); } } SEAM(2);
#endif
    if constexpr (IN(3)) { RETID(); LOADF(); attn_partial(F, (const bf16*)(ws + WS_QKVZ), (const unsigned*)(ws + WS_CNT), (const unsigned short*)(ws + WS_LISTS),
                                         (bf16*)((unsigned char*)F.out + DO_PARTO), (float*)((unsigned char*)F.out + DO_PARTML), (unsigned*)(ws + WS_QCTR)); if constexpr (3 == MK_REPEAT_PHASE) { { GRIDBAR(); if (blockIdx.x == 0 && threadIdx.x == 0) *(unsigned*)(args.ws + WS_QCTR) = 0u; GRIDBAR(); } RETID(); LOADF(); attn_partial(F, (const bf16*)(ws + WS_QKVZ), (const unsigned*)(ws + WS_CNT), (const unsigned short*)(ws + WS_LISTS),
                                         (bf16*)((unsigned char*)F.out + DO_PARTO), (float*)((unsigned char*)F.out + DO_PARTML), (unsigned*)(ws + WS_QCTR)); } } SEAM(3);
    if constexpr (IN(4)) { RETID(); LOADF();
        if constexpr (4 == MK_REPEAT_PHASE) { attn_own_combine(F, (bf16*)(ws + WS_QKVZ), (const bf16*)((unsigned char*)F.out + DO_PARTO), (const float*)((unsigned char*)F.out + DO_PARTML), (bf16*)(ws + WS_GATE), 512); grid.sync(); RETID(); LOADF(); }
        STAGGER(MK_STAG4);
        attn_own_combine(F, (bf16*)(ws + WS_QKVZ), (const bf16*)((unsigned char*)F.out + DO_PARTO), (const float*)((unsigned char*)F.out + DO_PARTML), (bf16*)(ws + WS_QKVZ), QP); } SEAM(4);
    if constexpr (IN(5)) { RETID(); LOADF(); STAGGER(MK_STAG5); rwkv_chunk_ops(F); if constexpr (5 == MK_REPEAT_PHASE) { GRIDBAR(); RETID(); LOADF(); rwkv_chunk_ops(F); } } SEAM(5);
    if constexpr (IN(6)) { RETID(); LOADF(); rwkv_relay(F); if constexpr (6 == MK_REPEAT_PHASE) { GRIDBAR(); RETID(); LOADF(); rwkv_relay(F); } } SEAM(6);
    if constexpr (IN(7)) { RETID(); LOADF(); STAGGER(MK_STAG7); rwkv_output(F); if constexpr (7 == MK_REPEAT_PHASE) { GRIDBAR(); RETID(); LOADF(); rwkv_output(F); } } SEAM(7);
#ifndef MK_STAG8
#define MK_STAG8 0
#endif
#ifndef MK_STAG10
#define MK_STAG10 0
#endif
#ifndef MK_STAG12
#define MK_STAG12 0
#endif
    if constexpr (IN(8)) { RETID(); LOADF(); STAGGER(MK_STAG8);
        pg8::Gemm g{QKVZ, (const pg8::bf16_t*)(ws + WS_PAB), M, DM, 1024, QP, 1024, 0, 0}; pg8::StaticOrder S; S.init(M, DM, F.G, (int)blockIdx.x);
        pg8::EpiMergeFused E{MERGED, DM, GAB, GP};
        pg8::gemm_phase<pg8::EpiMergeFused, pg8::StaticOrder, true, true>(F.lds, g, S, E);
    } SEAM(9);
    if constexpr (IN(10)) { RETID(); LOADF(); STAGGER(MK_STAG10);
        pg8::bf16_t* YB = RWb + (size_t)M * DM;
        pg8::Gemm g{MERGED, (const pg8::bf16_t*)(ws + WS_WOUT), M, DM, DM, DM, DM, 0, 0}; pg8::StaticOrder S; S.init(M, DM, F.G, (int)blockIdx.x); pg8::EpiYStatG E{YB, DM, (float*)(ws + WS_PARTS)};
        pg8::gemm_phase<pg8::EpiYStatG, pg8::StaticOrder, true, true>(F.lds, g, S, E);
    } SEAM(10);
    if constexpr (IN(11)) { RETID(); LOADF();
        const pg8::bf16_t* YB = RWb + (size_t)M * DM;
        for (int pm = F.vcu; pm < M / 256; pm += F.G) panel_norm(F, pm, (const bf16*)YB, (bf16*)QKVZ, (float*)(ws + WS_RSY), (const f32x4*)(ws + WS_PARTS), pm * 256);
    } SEAM(11);
    if constexpr (IN(12)) { RETID(); LOADF(); STAGGER(MK_STAG12);
        pg8::bf16_t* H1B = QKVZ;
        pg8::Gemm g{H1B, (const pg8::bf16_t*)(ws + WS_WPG), M, DM, ACP, ACP, ACP, 0, 0}; pg8::StaticOrder S; S.init(M, DM, F.G, (int)blockIdx.x);
        pg8::EpiFinal E{F.out, H1B + PLE, (pg8::u32x4*)((unsigned char*)GAB + (size_t)F.vcu * 131072), DM, ACP, F.tid};
        pg8::gemm_phase<pg8::EpiFinal, pg8::StaticOrder, true, true>(F.lds, g, S, E);
    }
#undef IN
#undef SEAM
}

#ifndef MK_ONE_LAUNCH
#define MK_ONE_LAUNCH 1
#endif
extern "C" void kernel_launch(void* const* d_in, const int* in_sizes, int n_in, void* d_out, int out_size, void* d_ws, size_t ws_size, hipStream_t stream) {
    static int grid = 0;
    if (grid == 0) {
        if (n_in != 21 || out_size != M * DM || ws_size < WS_END) { fprintf(stderr, "kernel_launch: unexpected shapes n_in %d out %d ws %zu\n", n_in, out_size, ws_size); grid = -1; return; }
        int dev = 0, cus = 0, per_cu = 0;
        (void)hipGetDevice(&dev); (void)hipDeviceGetAttribute(&cus, hipDeviceAttributeMultiprocessorCount, dev);
        (void)per_cu;
        grid = cus;
    }
    if (grid < 0) return;
    if (hipMemsetAsync(d_ws, 0, 65536, stream) != hipSuccess) { fprintf(stderr, "kernel_launch: hipMemsetAsync of the control words failed\n"); return; }
    Args a{};
    for (int i = 0; i < 21; ++i) a.in[i] = (const float*)d_in[i];
    a.out = (float*)d_out; a.ws = (unsigned char*)d_ws;
#if MK_ONE_LAUNCH
    a.ph_lo = 0; a.ph_hi = NPHASE;
    void* kargs[] = {&a};
    (void)hipFuncSetAttribute((const void*)fwd<0, NPHASE>, hipFuncAttributeMaxDynamicSharedMemorySize, LDS_BYTES);
    hipError_t e = hipLaunchCooperativeKernel((const void*)fwd<0, NPHASE>, dim3(grid), dim3(NTHR), kargs, LDS_BYTES, stream);
    if (e != hipSuccess) fprintf(stderr, "cooperative launch failed: %s\n", hipGetErrorString(e));
#else
#define LAUNCH_PH(k) do { (void)hipFuncSetAttribute((const void*)fwd<k, k + 1>, hipFuncAttributeMaxDynamicSharedMemorySize, LDS_BYTES); a.ph_lo = k; a.ph_hi = k + 1; hipLaunchKernelGGL((fwd<k, k + 1>), dim3(grid), dim3(NTHR), LDS_BYTES, stream, a); } while (0)
    LAUNCH_PH(0); LAUNCH_PH(1); LAUNCH_PH(2); LAUNCH_PH(3); LAUNCH_PH(4); LAUNCH_PH(5); LAUNCH_PH(6); LAUNCH_PH(7); LAUNCH_PH(8); LAUNCH_PH(9); LAUNCH_PH(10); LAUNCH_PH(11); LAUNCH_PH(12);
#endif
}
```

```cpp
#include <hip/hip_runtime.h>
#include <hip/hip_cooperative_groups.h>
#include <cstdio>
#include <cstdint>
#include <cmath>
namespace cg = cooperative_groups;
#ifndef MK_DMA_NT
#define MK_DMA_NT 0
#endif
namespace pg8 {
#define PG8_LAS __attribute__((address_space(3)))
typedef unsigned short bf16_t;
typedef short bf16x8 __attribute__((ext_vector_type(8)));
typedef float f32x4 __attribute__((ext_vector_type(4)));
typedef float f32x2 __attribute__((ext_vector_type(2)));
typedef unsigned u32x4 __attribute__((ext_vector_type(4)));
typedef unsigned u32x2 __attribute__((ext_vector_type(2)));
constexpr int BM = 256, BK = 64, HALF = 128, HTB = HALF * BK * 2  , STAGE_BYTES = 8 * HTB, NXCD = 8, WGM = 8;

__host__ __device__ __forceinline__ int lds_byte(int r, int c) { const int st = (r >> 4) * 2 + (c >> 5), rr = r & 15, cc = c & 31, ob = rr * 64 + cc * 2; return st * 1024 + (ob ^ (((ob >> 9) & 1) << 5)); }
__host__ __device__ __forceinline__ void stage_rc(int b, int& R, int& C) { const int st = b / 1024, sb = b % 1024, swz = sb ^ (((sb >> 9) & 1) << 5); R = (st >> 1) * 16 + swz / 64; C = (st & 1) * 32 + (swz % 64) / 2; }
__host__ __device__ __forceinline__ int perm32(int rho) { const int n = rho >> 4, i = rho & 15; return 8 * (i >> 2) + 4 * n + (i & 3); }

struct Unit { int pm, pn; };
template <typename E, typename = void> struct pg8_a_nt { static constexpr bool value = false; };
template <typename E> struct pg8_a_nt<E, decltype((void)E::A_NT)> { static constexpr bool value = E::A_NT; };
struct Gemm { const bf16_t* A; const bf16_t* Bt; int M, N, K, lda, ldb, bdiv; size_t bstride; };

struct StaticOrder {
    int nM, nN, nwg, G, c;
    __host__ __device__ void init(int M, int N, int G_, int c_) { nM = M / BM; nN = N / BM; nwg = nM * nN; G = G_; c = c_; }
    __host__ __device__ __forceinline__ bool next(int i, Unit& u) const {
        const long L = (long)i * G + c; if (L >= nwg) return false;
        int wgid = (int)L; { const int q = nwg / NXCD, r = nwg % NXCD, xcd = wgid % NXCD, off = wgid / NXCD; wgid = (xcd < r ? xcd * (q + 1) : r * (q + 1) + (xcd - r) * q) + off; }
        const int nig = WGM * nN, gid = wgid / nig, fm = gid * WGM, gsz = (nM - fm) < WGM ? (nM - fm) : WGM;
        u.pm = fm + ((wgid % nig) % gsz); u.pn = (wgid % nig) / gsz; return true;
    }
};

struct WeightMajorOrder {
    int nM, nN, nwg, G, c;
    __host__ __device__ void init(int M, int N, int G_, int c_) { nM = M / BM; nN = N / BM; nwg = nM * nN; G = G_; c = c_; }
    __host__ __device__ __forceinline__ bool next(int i, Unit& u) const {
        const long L = (long)i * G + c; if (L >= nwg) return false;
        const int xcd = (int)(L % NXCD), off = (int)(L / NXCD), pmx = nM / NXCD;
        const int cg = off / (pmx * 4), ncol = (nN - cg * 4) < 4 ? (nN - cg * 4) : 4, w = off - cg * pmx * 4, per = 8 * ncol, st = w / per, in = w % per;
        u.pm = xcd * pmx + st * 8 + in % 8; u.pn = cg * 4 + in / 8; return true;
    }
};

struct PanelOrder { int pm; __host__ __device__ bool next(int i, Unit& u) const { if (i >= 4) return false; u.pm = pm; u.pn = i; return true; } };
__device__ __forceinline__ unsigned cvt_pk_bf16(float lo, float hi) { unsigned r; asm volatile("v_cvt_pk_bf16_f32 %0, %1, %2" : "=v"(r) : "v"(lo), "v"(hi)); return r; }
__device__ __forceinline__ float bf_lo(unsigned w) { return __uint_as_float(w << 16); }
__device__ __forceinline__ float bf_hi(unsigned w) { return __uint_as_float(w & 0xffff0000u); }

template <class Epi, class Sched, bool ALIGN_EPI = false, bool SP2 = false>
__device__ __forceinline__ void gemm_phase(PG8_LAS unsigned char* lds, const Gemm g, const Sched& S, const Epi& E) {
    int tid_ = threadIdx.x; asm volatile("" : "+v"(tid_));
    const int tid = tid_, wid = __builtin_amdgcn_readfirstlane(tid >> 6), lane = tid & 63, wr = wid >> 2, wc = wid & 3, fr = lane & 15, fq = lane >> 4;
    const int K = g.K, nt = K / BK;
    unsigned voffA[2], voffB[2];
#pragma unroll
    for (int i = 0; i < 2; ++i) { int R, C; stage_rc(tid * 16 + i * 8192, R, C); const int Rb = Epi::PERM ? ((R & ~31) + perm32(R & 31)) : R;
        voffA[i] = (unsigned)(R * g.lda + C) * 2u; voffB[i] = (unsigned)(Rb * g.ldb + C) * 2u; }
    const size_t kstep = (size_t)(BK * 2);
    const size_t hstepA = (size_t)HALF * g.lda * 2, hstepB = (size_t)HALF * g.ldb * 2;
    const size_t tstepA = 2 * hstepA, tstepB = 2 * hstepB;
    const unsigned ldsw = (unsigned)wid * 1024u;
    const int aoff = lds_byte(wr * 64 + fr, fq * 8), boff = lds_byte(wc * 32 + fr, fq * 8);
#define PG8_SA(b, h) (((b) * 2 + (h)) * HTB)
#define PG8_SB(b, h) ((4 + (b) * 2 + (h)) * HTB)
#define PG8_STAGE_X(bufoff, gbase, voff, AUX) do { _Pragma("unroll") for (int _i = 0; _i < 2; ++_i) \
        __builtin_amdgcn_global_load_lds((const unsigned*)((const char*)(gbase) + (voff)[_i]), (PG8_LAS unsigned*)(lds + (bufoff) + ldsw + _i * 8192), 16, 0, AUX); } while (0)
#define PG8_STAGE(bufoff, gbase, voff) PG8_STAGE_X(bufoff, gbase, voff, 0)
#define PG8_STAGE_A(bufoff, gbase, voff) PG8_STAGE_X(bufoff, gbase, voff, (pg8_a_nt<Epi>::value ? 2 : 0))
#define PG8_LDA(dst, b, h) do { _Pragma("unroll") for (int m = 0; m < 4; ++m) _Pragma("unroll") for (int k = 0; k < 2; ++k) dst[m][k] = *(const PG8_LAS bf16x8*)(lds + PG8_SA(b, h) + aoff + m * 2048 + k * 1024); } while (0)
#define PG8_LDB(dst, b, h) do { _Pragma("unroll") for (int n = 0; n < 2; ++n) _Pragma("unroll") for (int k = 0; k < 2; ++k) dst[n][k] = *(const PG8_LAS bf16x8*)(lds + PG8_SB(b, h) + boff + n * 2048 + k * 1024); } while (0)
#define PG8_MMA(ai, bj, At, Bt) do { __builtin_amdgcn_s_setprio(1); _Pragma("unroll") for (int m = 0; m < 4; ++m) _Pragma("unroll") for (int n = 0; n < 2; ++n) _Pragma("unroll") for (int k = 0; k < 2; ++k) \
        acc[ai][bj][m][n] = __builtin_amdgcn_mfma_f32_16x16x32_bf16(Bt[n][k], At[m][k], acc[ai][bj][m][n], 0, 0, 0); __builtin_amdgcn_s_setprio(0); } while (0)
#define PG8_WAIT_V(n) asm volatile("s_waitcnt vmcnt(" #n ")" ::: "memory")
#define PG8_WAIT_L(n) asm volatile("s_waitcnt lgkmcnt(" #n ")" ::: "memory")
#define PG8_BAR __builtin_amdgcn_s_barrier()
#define PG8_SCHED __builtin_amdgcn_sched_barrier(0)
#define PG8_BBASE(u) ((const char*)g.Bt + (size_t)(u).pn * tstepB + (g.bdiv ? (size_t)((u).pm / g.bdiv) * g.bstride * 2 : (size_t)0))
    Unit cur, nxt; int ui = 0;
    if (!S.next(0, cur)) return;
    f32x4 acc[2][2][4][2];
#pragma unroll
    for (int a = 0; a < 2; ++a)
#pragma unroll
        for (int b = 0; b < 2; ++b)
#pragma unroll
            for (int m = 0; m < 4; ++m)
#pragma unroll
                for (int n = 0; n < 2; ++n) acc[a][b][m][n] = (f32x4){0.f, 0.f, 0.f, 0.f};
    bf16x8 At[4][2], B0[2][2], B1[2][2];
    const char* cA = (const char*)g.A + (size_t)cur.pm * tstepA; const char* cB = PG8_BBASE(cur);
    if constexpr (SP2) {
        PG8_STAGE(PG8_SB(0, 0), cB, voffB); PG8_STAGE(PG8_SB(0, 1), cB + hstepB, voffB); PG8_STAGE_A(PG8_SA(0, 0), cA, voffA); PG8_STAGE_A(PG8_SA(0, 1), cA + hstepA, voffA);
        if (wr == 1) PG8_BAR;
        PG8_WAIT_V(2); PG8_BAR;
        PG8_STAGE(PG8_SB(1, 0), cB + kstep, voffB); PG8_STAGE_A(PG8_SA(1, 0), cA + kstep, voffA); PG8_STAGE(PG8_SB(1, 1), cB + hstepB + kstep, voffB);
        PG8_WAIT_V(6); PG8_BAR;
    } else {
        PG8_STAGE(PG8_SB(0, 0), cB, voffB); PG8_STAGE_A(PG8_SA(0, 0), cA, voffA); PG8_STAGE(PG8_SB(0, 1), cB + hstepB, voffB); PG8_STAGE_A(PG8_SA(0, 1), cA + hstepA, voffA);
        if (wr == 1) PG8_BAR;
        PG8_WAIT_V(4); PG8_BAR;
        PG8_STAGE(PG8_SB(1, 0), cB + kstep, voffB); PG8_STAGE_A(PG8_SA(1, 0), cA + kstep, voffA); PG8_STAGE(PG8_SB(1, 1), cB + hstepB + kstep, voffB);
        PG8_WAIT_V(6); PG8_BAR;
    }
    for (;;) {
        const bool has_next = S.next(ui + 1, nxt);
        const char* nA = has_next ? (const char*)g.A + (size_t)nxt.pm * tstepA : cA; const char* nB = has_next ? PG8_BBASE(nxt) : cB;
        for (int t = 0; t < nt; t += 2) {
            if constexpr (Epi::HOOK_T > 0) { if (t == Epi::HOOK_T) { PG8_SCHED; E.mid(acc, cur, wr, wc, fr, fq); PG8_SCHED; } }
            const bool last = (t == nt - 2);
            const char* a1 = cA + (size_t)(t + 1) * kstep;
            const char* a2 = last ? nA : cA + (size_t)(t + 2) * kstep; const char* b2 = last ? nB : cB + (size_t)(t + 2) * kstep;
            const char* a3 = a2 + kstep; const char* b3 = b2 + kstep;
            if constexpr (SP2) {
            PG8_LDB(B0, 0, 0); PG8_LDB(B1, 0, 1); PG8_SCHED; PG8_LDA(At, 0, 0); PG8_STAGE_A(PG8_SA(1, 1), a1 + hstepA, voffA);
            PG8_WAIT_V(8); PG8_WAIT_L(0); PG8_BAR; PG8_MMA(0, 0, At, B0); PG8_MMA(0, 1, At, B1); PG8_BAR; PG8_SCHED;
            PG8_LDA(At, 0, 1); PG8_STAGE(PG8_SB(0, 0), b2, voffB); PG8_STAGE(PG8_SB(0, 1), b2 + hstepB, voffB); PG8_STAGE_A(PG8_SA(0, 0), a2, voffA);
            PG8_WAIT_V(8); PG8_WAIT_L(0); PG8_BAR; PG8_MMA(1, 0, At, B0); PG8_MMA(1, 1, At, B1); PG8_BAR; PG8_SCHED;
            PG8_LDB(B0, 1, 0); PG8_LDB(B1, 1, 1); PG8_SCHED; PG8_LDA(At, 1, 0); PG8_STAGE_A(PG8_SA(0, 1), a2 + hstepA, voffA);
            PG8_WAIT_V(8); PG8_WAIT_L(0); PG8_BAR; PG8_MMA(0, 0, At, B0); PG8_MMA(0, 1, At, B1); PG8_BAR; PG8_SCHED;
            PG8_LDA(At, 1, 1); PG8_STAGE(PG8_SB(1, 0), b3, voffB); PG8_STAGE(PG8_SB(1, 1), b3 + hstepB, voffB); PG8_STAGE_A(PG8_SA(1, 0), a3, voffA);
            PG8_WAIT_V(8); PG8_WAIT_L(0); PG8_BAR; PG8_MMA(1, 0, At, B0); PG8_MMA(1, 1, At, B1); PG8_BAR; PG8_SCHED;
            } else {
            PG8_LDB(B0, 0, 0); PG8_SCHED; PG8_LDA(At, 0, 0); PG8_STAGE_A(PG8_SA(1, 1), a1 + hstepA, voffA);
            PG8_WAIT_L(8); PG8_BAR; PG8_WAIT_L(0); PG8_MMA(0, 0, At, B0); PG8_BAR; PG8_SCHED;
            PG8_LDB(B1, 0, 1); PG8_STAGE(PG8_SB(0, 0), b2, voffB);
            PG8_BAR; PG8_WAIT_L(0); PG8_MMA(0, 1, At, B1); PG8_BAR;
            PG8_LDA(At, 0, 1); PG8_STAGE_A(PG8_SA(0, 0), a2, voffA);
            PG8_BAR; PG8_WAIT_L(0); PG8_MMA(1, 0, At, B0); PG8_BAR; PG8_SCHED;
            PG8_STAGE(PG8_SB(0, 1), b2 + hstepB, voffB);
            PG8_WAIT_V(6); PG8_BAR; PG8_MMA(1, 1, At, B1); PG8_BAR;
            PG8_LDB(B0, 1, 0); PG8_SCHED; PG8_LDA(At, 1, 0); PG8_STAGE_A(PG8_SA(0, 1), a2 + hstepA, voffA);
            PG8_WAIT_L(8); PG8_BAR; PG8_WAIT_L(0); PG8_MMA(0, 0, At, B0); PG8_BAR; PG8_SCHED;
            PG8_LDB(B1, 1, 1); PG8_STAGE(PG8_SB(1, 0), b3, voffB);
            PG8_BAR; PG8_WAIT_L(0); PG8_MMA(0, 1, At, B1); PG8_BAR;
            PG8_LDA(At, 1, 1); PG8_STAGE_A(PG8_SA(1, 0), a3, voffA);
            PG8_BAR; PG8_WAIT_L(0); PG8_MMA(1, 0, At, B0); PG8_BAR; PG8_SCHED;
            PG8_STAGE(PG8_SB(1, 1), b3 + hstepB, voffB);
            PG8_WAIT_V(6); PG8_BAR; PG8_MMA(1, 1, At, B1); PG8_BAR;
            }
        }
        if constexpr (ALIGN_EPI) { if (wr == 0) PG8_BAR; }
        E(acc, cur, wr, wc, fr, fq);
        if (!has_next) break;
#pragma unroll
        for (int a = 0; a < 2; ++a)
#pragma unroll
            for (int b = 0; b < 2; ++b)
#pragma unroll
                for (int m = 0; m < 4; ++m)
#pragma unroll
                    for (int n = 0; n < 2; ++n) acc[a][b][m][n] = (f32x4){0.f, 0.f, 0.f, 0.f};
        cur = nxt; cA = nA; cB = nB; ++ui;
        if constexpr (ALIGN_EPI) { if (wr == 1) PG8_BAR; }
    }
    PG8_WAIT_V(0);
    if constexpr (!ALIGN_EPI) { if (wr == 0) PG8_BAR; }
    PG8_BAR;
#undef PG8_SA
#undef PG8_SB
#undef PG8_STAGE
#undef PG8_LDA
#undef PG8_LDB
#undef PG8_MMA
#undef PG8_WAIT_V
#undef PG8_WAIT_L
#undef PG8_BAR
#undef PG8_SCHED
#undef PG8_BBASE
}
}
#ifndef MK_NT
#define MK_NT 1
#endif
#if MK_NT
#define PG8_NTSTORE(p, v) __builtin_nontemporal_store((v), (p))
#else
#define PG8_NTSTORE(p, v) (*(p) = (v))
#endif
namespace pg8 {
__device__ __forceinline__ float sigmoidf_(float x) { return __builtin_amdgcn_rcpf(1.0f + __builtin_amdgcn_exp2f(x * -1.4426950408889634f)); }

struct EpiCols {
    static constexpr bool PERM = true; static constexpr int HOOK_T = 0;
    bf16_t* qkvz; bf16_t* rw; bf16_t* gab; float qscale;
    __device__ __forceinline__ void operator()(const f32x4 (&acc)[2][2][4][2], const Unit& u, int wr, int wc, int fr, int fq) const {
        const int pn = u.pn; bf16_t* base; int pitch, coff, nbj = 2; float sc = 1.f;
        if (pn < 8) { base = qkvz; pitch = 2112; coff = pn * 256; if (pn < 2) sc = qscale; }
        else if (pn < 16) { base = rw; pitch = 2176; coff = (pn - 8) * 256; }
        else if (pn < 24) { base = gab; pitch = 2112; coff = (pn - 16) * 256; }
        else { base = rw; pitch = 2176; coff = 2048; nbj = 1; }
        const int row0 = u.pm * BM + wr * 64 + fr; const int col0 = coff + wc * 32 + 8 * fq;
#pragma unroll
        for (int ai = 0; ai < 2; ++ai)
#pragma unroll
            for (int m = 0; m < 4; ++m) { bf16_t* rowp = base + (size_t)(row0 + ai * HALF + m * 16) * pitch + col0;
#pragma unroll
                for (int bj = 0; bj < 2; ++bj) { if (bj < nbj) { f32x4 v0 = acc[ai][bj][m][0] * sc, v1 = acc[ai][bj][m][1] * sc;
                    u32x4 w; w.x = cvt_pk_bf16(v0[0], v0[1]); w.y = cvt_pk_bf16(v0[2], v0[3]); w.z = cvt_pk_bf16(v1[0], v1[1]); w.w = cvt_pk_bf16(v1[2], v1[3]);
                    PG8_NTSTORE((u32x4*)(rowp + bj * HALF), w); } } }
    }
};
struct EpiBf16 {
    static constexpr bool PERM = true; static constexpr int HOOK_T = 0;
    bf16_t* O; int ldc;
    __device__ __forceinline__ void operator()(const f32x4 (&acc)[2][2][4][2], const Unit& u, int wr, int wc, int fr, int fq) const {
        const int row0 = u.pm * BM + wr * 64 + fr; const int col0 = u.pn * BM + wc * 32 + 8 * fq;
#pragma unroll
        for (int ai = 0; ai < 2; ++ai)
#pragma unroll
            for (int m = 0; m < 4; ++m) { bf16_t* rowp = O + (size_t)(row0 + ai * HALF + m * 16) * ldc + col0;
#pragma unroll
                for (int bj = 0; bj < 2; ++bj) { const f32x4 v0 = acc[ai][bj][m][0], v1 = acc[ai][bj][m][1];
                    u32x4 w; w.x = cvt_pk_bf16(v0[0], v0[1]); w.y = cvt_pk_bf16(v0[2], v0[3]); w.z = cvt_pk_bf16(v1[0], v1[1]); w.w = cvt_pk_bf16(v1[2], v1[3]);
                    *(u32x4*)(rowp + bj * HALF) = w; } }
    }
};
struct EpiF32 {
    static constexpr bool PERM = false; static constexpr int HOOK_T = 0;
    float* O; int ldc;
    __device__ __forceinline__ void operator()(const f32x4 (&acc)[2][2][4][2], const Unit& u, int wr, int wc, int fr, int fq) const {
        const int row0 = u.pm * BM + wr * 64 + fr; const int col0 = u.pn * BM + wc * 32 + 4 * fq;
#pragma unroll
        for (int ai = 0; ai < 2; ++ai)
#pragma unroll
            for (int m = 0; m < 4; ++m) { float* rowp = O + (size_t)(row0 + ai * HALF + m * 16) * ldc + col0;
#pragma unroll
                for (int bj = 0; bj < 2; ++bj)
#pragma unroll
                    for (int n = 0; n < 2; ++n) *(f32x4*)(rowp + bj * HALF + n * 16) = acc[ai][bj][m][n]; }
    }
};
struct EpiGate {
    static constexpr bool PERM = false; static constexpr int HOOK_T = 0;
    static constexpr bool A_NT = MK_DMA_NT != 0;
    float* O;
    __device__ __forceinline__ void operator()(const f32x4 (&acc)[2][2][4][2], const Unit& u, int wr, int wc, int fr, int fq) const {
        const int row0 = u.pm * BM + wr * 64 + fr; const int col0 = wc * 32 + 4 * fq;
#pragma unroll
        for (int ai = 0; ai < 2; ++ai)
#pragma unroll
            for (int m = 0; m < 4; ++m) { float* rowp = O + (size_t)(row0 + ai * HALF + m * 16) * 128 + col0;
#pragma unroll
                for (int n = 0; n < 2; ++n) PG8_NTSTORE((f32x4*)(rowp + n * 16), acc[ai][0][m][n] + acc[ai][1][m][n]); }
    }
};
template <bool ADD> struct EpiMerge {
    static constexpr bool PERM = true; static constexpr int HOOK_T = 0;
    bf16_t* O; int ldc; const bf16_t* G; int ldg;
    __device__ __forceinline__ void operator()(const f32x4 (&acc)[2][2][4][2], const Unit& u, int wr, int wc, int fr, int fq) const {
        const int row0 = u.pm * BM + wr * 64 + fr; const int col0 = u.pn * BM + wc * 32 + 8 * fq;
#pragma unroll
        for (int ai = 0; ai < 2; ++ai)
#pragma unroll
            for (int m = 0; m < 4; ++m) { const size_t r = (size_t)(row0 + ai * HALF + m * 16);
#pragma unroll
                for (int bj = 0; bj < 2; ++bj) { const f32x4 v0 = acc[ai][bj][m][0], v1 = acc[ai][bj][m][1];
                    const u32x4 gw = *(const u32x4*)(G + r * ldg + col0 + bj * HALF);
                    float o[8];
                    o[0] = sigmoidf_(bf_lo(gw.x)) * v0[0]; o[1] = sigmoidf_(bf_hi(gw.x)) * v0[1]; o[2] = sigmoidf_(bf_lo(gw.y)) * v0[2]; o[3] = sigmoidf_(bf_hi(gw.y)) * v0[3];
                    o[4] = sigmoidf_(bf_lo(gw.z)) * v1[0]; o[5] = sigmoidf_(bf_hi(gw.z)) * v1[1]; o[6] = sigmoidf_(bf_lo(gw.w)) * v1[2]; o[7] = sigmoidf_(bf_hi(gw.w)) * v1[3];
                    bf16_t* op = O + r * ldc + col0 + bj * HALF;
                    if (ADD) { const u32x4 pw = *(const u32x4*)op;
                        o[0] += bf_lo(pw.x); o[1] += bf_hi(pw.x); o[2] += bf_lo(pw.y); o[3] += bf_hi(pw.y); o[4] += bf_lo(pw.z); o[5] += bf_hi(pw.z); o[6] += bf_lo(pw.w); o[7] += bf_hi(pw.w); }
                    u32x4 w; w.x = cvt_pk_bf16(o[0], o[1]); w.y = cvt_pk_bf16(o[2], o[3]); w.z = cvt_pk_bf16(o[4], o[5]); w.w = cvt_pk_bf16(o[6], o[7]);
                    *(u32x4*)op = w; } }
    }
};
struct EpiYStat {
    static constexpr bool PERM = true; static constexpr int HOOK_T = 0;
    bf16_t* O; int ldc; PG8_LAS float* part;
    __device__ __forceinline__ void operator()(const f32x4 (&acc)[2][2][4][2], const Unit& u, int wr, int wc, int fr, int fq) const {
        const int row0 = u.pm * BM + wr * 64 + fr; const int col0 = u.pn * BM + wc * 32 + 8 * fq;
#pragma unroll
        for (int ai = 0; ai < 2; ++ai)
#pragma unroll
            for (int m = 0; m < 4; ++m) { bf16_t* rowp = O + (size_t)(row0 + ai * HALF + m * 16) * ldc + col0; float s = 0.f;
#pragma unroll
                for (int bj = 0; bj < 2; ++bj) { const f32x4 v0 = acc[ai][bj][m][0], v1 = acc[ai][bj][m][1];
                    u32x4 w; w.x = cvt_pk_bf16(v0[0], v0[1]); w.y = cvt_pk_bf16(v0[2], v0[3]); w.z = cvt_pk_bf16(v1[0], v1[1]); w.w = cvt_pk_bf16(v1[2], v1[3]);
                    *(u32x4*)(rowp + bj * HALF) = w;
                    s += (bf_lo(w.x) * bf_lo(w.x) + bf_hi(w.x) * bf_hi(w.x)) + (bf_lo(w.y) * bf_lo(w.y) + bf_hi(w.y) * bf_hi(w.y)) + (bf_lo(w.z) * bf_lo(w.z) + bf_hi(w.z) * bf_hi(w.z)) + (bf_lo(w.w) * bf_lo(w.w) + bf_hi(w.w) * bf_hi(w.w)); }
                s += __shfl_xor(s, 16); s += __shfl_xor(s, 32);
                if (fq == 0) part[(ai * HALF + wr * 64 + m * 16 + fr) * 16 + wc * 4 + u.pn] = s; }
    }
};
#ifndef MK_Y_NT
#define MK_Y_NT 0
#endif
#if MK_Y_NT
#define YS_ST(p, v) __builtin_nontemporal_store((v), (p))
#else
#define YS_ST(p, v) (*(p) = (v))
#endif
struct EpiYStatG {
    static constexpr bool PERM = true; static constexpr int HOOK_T = 0;
    bf16_t* O; int ldc; float* part;
    __device__ __forceinline__ void operator()(const f32x4 (&acc)[2][2][4][2], const Unit& u, int wr, int wc, int fr, int fq) const {
        const int row0 = u.pm * BM + wr * 64 + fr; const int col0 = u.pn * BM + wc * 32 + 8 * fq;
#pragma unroll
        for (int ai = 0; ai < 2; ++ai)
#pragma unroll
            for (int m = 0; m < 4; ++m) { bf16_t* rowp = O + (size_t)(row0 + ai * HALF + m * 16) * ldc + col0; float s = 0.f;
#pragma unroll
                for (int bj = 0; bj < 2; ++bj) { const f32x4 v0 = acc[ai][bj][m][0], v1 = acc[ai][bj][m][1];
                    u32x4 w; w.x = cvt_pk_bf16(v0[0], v0[1]); w.y = cvt_pk_bf16(v0[2], v0[3]); w.z = cvt_pk_bf16(v1[0], v1[1]); w.w = cvt_pk_bf16(v1[2], v1[3]);
                    YS_ST((u32x4*)(rowp + bj * HALF), w);
                    s += (bf_lo(w.x) * bf_lo(w.x) + bf_hi(w.x) * bf_hi(w.x)) + (bf_lo(w.y) * bf_lo(w.y) + bf_hi(w.y) * bf_hi(w.y)) + (bf_lo(w.z) * bf_lo(w.z) + bf_hi(w.z) * bf_hi(w.z)) + (bf_lo(w.w) * bf_lo(w.w) + bf_hi(w.w) * bf_hi(w.w)); }
                s += __shfl_xor(s, 16); s += __shfl_xor(s, 32);
                if (fq == 0) part[(size_t)(row0 + ai * HALF + m * 16) * 16 + wc * 4 + u.pn] = s; }
    }
};
#ifndef MK_MG_NT
#define MK_MG_NT 0
#endif
#if MK_MG_NT
#define MG_LD(p) __builtin_nontemporal_load(p)
#else
#define MG_LD(p) (*(p))
#endif
struct EpiMergeFused {
    static constexpr bool PERM = true; static constexpr int HOOK_T = 8;
    bf16_t* O; int ldc; const bf16_t* G; int ldg;
    struct GOps { u32x4 ga[2], gb[2]; };
    __device__ __forceinline__ void loadg(GOps& o, size_t r, int col0, bool both) const {
#pragma unroll
        for (int bj = 0; bj < 2; ++bj) { if (both) o.ga[bj] = MG_LD((const u32x4*)(G + r * ldg + col0 + bj * HALF)); o.gb[bj] = *(const u32x4*)(G + r * ldg + 1024 + col0 + bj * HALF); }
    }
    __device__ __forceinline__ void mid(f32x4 (&acc)[2][2][4][2], const Unit& u, int wr, int wc, int fr, int fq) const {
        asm volatile("" : "+v"(fr), "+v"(fq));
        const int row0 = u.pm * BM + wr * 64 + fr; const int col0 = u.pn * BM + wc * 32 + 8 * fq;
        GOps A, B; loadg(A, (size_t)row0, col0, true);
#pragma unroll
        for (int g = 0; g < 8; ++g) { const int ai = g >> 2, m = g & 3; GOps& cur = (g & 1) ? B : A; GOps& nxt = (g & 1) ? A : B;
            if (g < 7) loadg(nxt, (size_t)(row0 + ((g + 1) >> 2) * HALF + ((g + 1) & 3) * 16), col0, true);
            __builtin_amdgcn_sched_barrier(0);
#pragma unroll
            for (int bj = 0; bj < 2; ++bj) { const u32x4 ga = cur.ga[bj], gb = cur.gb[bj];
#define MQ_(wa, wb, HI) ((1.0f + __builtin_amdgcn_exp2f(fmaxf(HI ? bf_hi(wb) : bf_lo(wb), -80.f) * -1.4426950408889634f)) * __builtin_amdgcn_rcpf(1.0f + __builtin_amdgcn_exp2f((HI ? bf_hi(wa) : bf_lo(wa)) * -1.4426950408889634f)))
                acc[ai][bj][m][0][0] *= MQ_(ga.x, gb.x, 0); acc[ai][bj][m][0][1] *= MQ_(ga.x, gb.x, 1); acc[ai][bj][m][0][2] *= MQ_(ga.y, gb.y, 0); acc[ai][bj][m][0][3] *= MQ_(ga.y, gb.y, 1);
                acc[ai][bj][m][1][0] *= MQ_(ga.z, gb.z, 0); acc[ai][bj][m][1][1] *= MQ_(ga.z, gb.z, 1); acc[ai][bj][m][1][2] *= MQ_(ga.w, gb.w, 0); acc[ai][bj][m][1][3] *= MQ_(ga.w, gb.w, 1);
#undef MQ_
            }
            __builtin_amdgcn_sched_barrier(0); }
    }
    __device__ __forceinline__ void operator()(const f32x4 (&acc)[2][2][4][2], const Unit& u, int wr, int wc, int fr, int fq) const {
        asm volatile("" : "+v"(fr), "+v"(fq));
        const int row0 = u.pm * BM + wr * 64 + fr; const int col0 = u.pn * BM + wc * 32 + 8 * fq;
        GOps A, B; loadg(A, (size_t)row0, col0, false);
#pragma unroll
        for (int g = 0; g < 8; ++g) { const int ai = g >> 2, m = g & 3; const size_t r = (size_t)(row0 + ai * HALF + m * 16); GOps& cur = (g & 1) ? B : A; GOps& nxt = (g & 1) ? A : B;
            if (g < 7) loadg(nxt, (size_t)(row0 + ((g + 1) >> 2) * HALF + ((g + 1) & 3) * 16), col0, false);
            __builtin_amdgcn_sched_barrier(0);
#pragma unroll
            for (int bj = 0; bj < 2; ++bj) { const f32x4 v0 = acc[ai][bj][m][0], v1 = acc[ai][bj][m][1]; const u32x4 gw = cur.gb[bj];
                u32x4 w; w.x = cvt_pk_bf16(sigmoidf_(fmaxf(bf_lo(gw.x), -80.f)) * v0[0], sigmoidf_(fmaxf(bf_hi(gw.x), -80.f)) * v0[1]); w.y = cvt_pk_bf16(sigmoidf_(fmaxf(bf_lo(gw.y), -80.f)) * v0[2], sigmoidf_(fmaxf(bf_hi(gw.y), -80.f)) * v0[3]);
                w.z = cvt_pk_bf16(sigmoidf_(fmaxf(bf_lo(gw.z), -80.f)) * v1[0], sigmoidf_(fmaxf(bf_hi(gw.z), -80.f)) * v1[1]); w.w = cvt_pk_bf16(sigmoidf_(fmaxf(bf_lo(gw.w), -80.f)) * v1[2], sigmoidf_(fmaxf(bf_hi(gw.w), -80.f)) * v1[3]);
                *(u32x4*)(O + r * ldc + col0 + bj * HALF) = w; }
            __builtin_amdgcn_sched_barrier(0); }
    }
};
struct EpiFinal {
    static constexpr bool PERM = false; static constexpr int HOOK_T = 4;
    float* out; const bf16_t* h; u32x4* park; int ldc, ldh, tid;
    struct Ops { u32x2 hw[4]; u32x4 ew[2]; };
    __device__ __forceinline__ void load(Ops& o, size_t r, int col0, int g) const {
#pragma unroll
        for (int q = 0; q < 4; ++q) { const int c = col0 + (q >> 1) * HALF + (q & 1) * 16; o.hw[q] = *(const u32x2*)(h + r * ldh + c); }
        o.ew[0] = park[(g * 2 + 0) * 512 + tid]; o.ew[1] = park[(g * 2 + 1) * 512 + tid];
    }
    __device__ __forceinline__ void mid(f32x4 (&acc)[2][2][4][2], const Unit& u, int wr, int wc, int fr, int fq) const {
#pragma unroll
        for (int g = 0; g < 8; ++g) { const int ai = g >> 2, m = g & 3;
#pragma unroll
            for (int bj = 0; bj < 2; ++bj) { const f32x4 a0 = acc[ai][bj][m][0], a1 = acc[ai][bj][m][1];
                park[(g * 2 + bj) * 512 + tid] = (u32x4){cvt_pk_bf16(a0[0], a0[1]), cvt_pk_bf16(a0[2], a0[3]), cvt_pk_bf16(a1[0], a1[1]), cvt_pk_bf16(a1[2], a1[3])};
                acc[ai][bj][m][0] = (f32x4){0.f, 0.f, 0.f, 0.f}; acc[ai][bj][m][1] = (f32x4){0.f, 0.f, 0.f, 0.f}; } }
    }
    __device__ __forceinline__ void operator()(const f32x4 (&acc)[2][2][4][2], const Unit& u, int wr, int wc, int fr, int fq) const {
        asm volatile("" : "+v"(fr), "+v"(fq));
        const int row0 = u.pm * BM + wr * 64 + fr; const int col0 = u.pn * BM + wc * 32 + 4 * fq;
        Ops O[3];
        load(O[0], (size_t)row0, col0, 0); load(O[1], (size_t)(row0 + 16), col0, 1);
#pragma unroll
        for (int g = 0; g < 8; ++g) { const int ai = g >> 2, m = g & 3; const size_t r = (size_t)(row0 + ai * HALF + m * 16);
            Ops& cur = O[g % 3];
            if (g < 6) load(O[(g + 2) % 3], (size_t)(row0 + ((g + 2) >> 2) * HALF + ((g + 2) & 3) * 16), col0, g + 2);
            __builtin_amdgcn_sched_barrier(0);
#pragma unroll
            for (int q = 0; q < 4; ++q) { const int bj = q >> 1, n = q & 1; const f32x4 a = acc[ai][bj][m][n]; const u32x2 hw = cur.hw[q]; const unsigned e0 = n ? cur.ew[bj].z : cur.ew[bj].x, e1 = n ? cur.ew[bj].w : cur.ew[bj].y; f32x4 o;
                o[0] = bf_lo(hw.x) + sigmoidf_(a[0]) * bf_lo(e0);
                o[1] = bf_hi(hw.x) + sigmoidf_(a[1]) * bf_hi(e0);
                o[2] = bf_lo(hw.y) + sigmoidf_(a[2]) * bf_lo(e1);
                o[3] = bf_hi(hw.y) + sigmoidf_(a[3]) * bf_hi(e1);
                PG8_NTSTORE((f32x4*)(out + r * ldc + col0 + bj * HALF + n * 16), o); }
            __builtin_amdgcn_sched_barrier(0); }
    }
};
}
#define GAS __attribute__((address_space(1)))
#define LAS __attribute__((address_space(3)))
typedef unsigned short bf16;
typedef unsigned v4u __attribute__((ext_vector_type(4)));
typedef unsigned v2u __attribute__((ext_vector_type(2)));
typedef float f32x4 __attribute__((ext_vector_type(4)));

constexpr int NWAVES = 8, NTHR = 512;
constexpr int BATCH = 16, SEQ = 4096, DM = 1024, M = BATCH * SEQ;
constexpr int NH = 8, HD = 64, AW = 512, PLE = 256;
constexpr int RWC = 2176, INC = 6272, INCP = 6400;
constexpr int NBLK = 16, BLK = 256;
constexpr float RMS_EPS = 1e-6f, GN_EPS = 64e-5f;
constexpr float LOG2E = 1.4426950408889634f;
constexpr float QSCALE = 0.125f * LOG2E;

constexpr size_t MiB = 1u << 20;
constexpr size_t WS_WIN = 2 * MiB;
constexpr size_t WS_WG = 16 * MiB;
constexpr size_t WS_PAB = 32 * MiB;
constexpr size_t WS_WOUT = 34 * MiB;
constexpr size_t WS_WPG = 36 * MiB;
constexpr int ACP = 1280;
constexpr size_t WS_RSY = 39 * MiB;
constexpr size_t WS_UBAR = 40 * MiB, WS_KMEAN = 41 * MiB;
constexpr size_t WS_PARTS = 42 * MiB;
constexpr size_t WS_GATE = 74 * MiB;
constexpr int WINP = 1024;
constexpr int QP = 2112, GP = 2112;
constexpr size_t WS_QKVZ = 138 * MiB;
constexpr size_t WS_RW = 402 * MiB;
constexpr size_t WS_GAB = 674 * MiB;
constexpr size_t WS_END = 1004 * MiB;
constexpr size_t WS_CNT = 0;
constexpr size_t WS_QCTR = 16384;
constexpr size_t WS_WUPT = 39 * MiB + 512 * 1024, WS_AUPT = WS_WUPT + 65536;
constexpr size_t WS_BON = 938 * MiB;
constexpr size_t WS_SC = 940 * MiB;
constexpr size_t DO_PARTO = 0, DO_PARTML = 192 * MiB;
constexpr size_t WS_LISTS = 46 * MiB;

__device__ const unsigned char T5B[128] = {0, 1, 2, 3, 4, 5, 6, 7, 8, 9, 10, 11, 12, 13, 14, 15, 16, 16, 16, 17, 17, 18, 18, 18, 19, 19, 19, 20, 20, 20, 20, 21, 21, 21, 21, 22, 22, 22, 22, 22, 23, 23, 23, 23, 23, 23, 24, 24, 24, 24, 24, 24, 25, 25, 25, 25, 25, 25, 25, 26, 26, 26, 26, 26, 26, 26, 26, 27, 27, 27, 27, 27, 27, 27, 27, 27, 27, 28, 28, 28, 28, 28, 28, 28, 28, 28, 28, 29, 29, 29, 29, 29, 29, 29, 29, 29, 29, 29, 29, 30, 30, 30, 30, 30, 30, 30, 30, 30, 30, 30, 30, 30, 30, 31, 31, 31, 31, 31, 31, 31, 31, 31, 31, 31, 31, 31, 31, 31};

typedef float f32x2_cv __attribute__((ext_vector_type(2))); typedef __bf16 bf16x2_cv __attribute__((ext_vector_type(2)));
__device__ __forceinline__ unsigned pk2(float lo, float hi) { f32x2_cv v = {lo, hi}; bf16x2_cv b = __builtin_convertvector(v, bf16x2_cv); return __builtin_bit_cast(unsigned, b); }
__device__ __forceinline__ unsigned f2bf(float f) { return pk2(f, 0.f) & 0xffffu; }
__device__ __forceinline__ float bf2f(unsigned short h) { return __uint_as_float((unsigned)h << 16); }
__device__ __forceinline__ float wave_sum(float v) {
#pragma unroll
    for (int o = 1; o < 64; o <<= 1) v += __shfl_xor(v, o);
    return v;
}
__device__ __forceinline__ float fexp2(float x) { return __builtin_amdgcn_exp2f(x); }
__device__ __forceinline__ float fexp(float x) { return __builtin_amdgcn_exp2f(x * LOG2E); }
__device__ __forceinline__ float frcp(float x) { return __builtin_amdgcn_rcpf(x); }
__device__ __forceinline__ float frsq(float x) { return __builtin_amdgcn_rsqf(x); }
__device__ __forceinline__ float sigm(float x) { return frcp(1.0f + fexp2(-x * LOG2E)); }
__device__ __forceinline__ float ftanh(float x) { return 1.0f - 2.0f * frcp(1.0f + fexp2(x * (2.0f * LOG2E))); }
__device__ __forceinline__ float dpp_sum32(float v) {
#define DPP_ADD_(ctrl, rmask) v += __builtin_bit_cast(float, __builtin_amdgcn_update_dpp(0, __builtin_bit_cast(int, v), ctrl, rmask, 0xf, true))
    DPP_ADD_(0x118, 0xf); DPP_ADD_(0x114, 0xf); DPP_ADD_(0x112, 0xf); DPP_ADD_(0x111, 0xf);
    v += __builtin_bit_cast(float, __builtin_amdgcn_update_dpp(0, __builtin_bit_cast(int, v), 0x142, 0xa, 0xf, false));
#undef DPP_ADD_
    return v;
}

struct Args {
    const float* in[21]; float* out; unsigned char* ws; int ph_lo, ph_hi;
};
struct Frame {
    LAS unsigned char* lds; int tid, lane, wave, vcu, G;
    const float *x, *p, *g_pre, *w_in, *rel_bias, *mu, *w0, *w_up, *a0, *a_up, *k_k, *k_a, *r_k, *ln_w, *ln_b, *p_a, *p_b, *w_out, *g_post, *w_pu, *w_pg;
    float* out; unsigned char* ws;
};

__device__ __forceinline__ void lds_barrier() { asm volatile("s_waitcnt lgkmcnt(0)" ::: "memory"); __builtin_amdgcn_s_barrier(); asm volatile("" ::: "memory"); }
__device__ __forceinline__ float wave_sum_fast(float v) { v = dpp_sum32(v); return __builtin_bit_cast(float, __builtin_amdgcn_readlane(__builtin_bit_cast(int, v), 31)) + __builtin_bit_cast(float, __builtin_amdgcn_readlane(__builtin_bit_cast(int, v), 63)); }
constexpr size_t WS_BAR = 32768;
#define XB_TMO      128
#define XB_XCNT(j)  (256  + 64 * (j))
#define XB_XSUB(j)  (1280 + 64 * (j))
#define XB_XGEN(j)  (2304 + 64 * (j))
#define XB_TOP      3328
#define XB_TOPGEN   3392
#define XB_SPIN_CAP (1u << 20)
__device__ __forceinline__ unsigned xb_ld(unsigned* p)              { return __hip_atomic_load(p, __ATOMIC_RELAXED, __HIP_MEMORY_SCOPE_AGENT); }
__device__ __forceinline__ unsigned xb_add(unsigned* p, unsigned v) { return __hip_atomic_fetch_add(p, v, __ATOMIC_RELAXED, __HIP_MEMORY_SCOPE_AGENT); }
__device__ __forceinline__ unsigned xb_xcc_id() { return (unsigned)__builtin_amdgcn_s_getreg((3 << 11) | 20) & 0xFu; }
#define XB_SPIN(cond, bar) do { unsigned _sp = 0; while (cond) { __builtin_amdgcn_s_sleep(1); \
    if ((++_sp & 255u) == 0u) { if (xb_ld(&(bar)[XB_TMO])) break; if (_sp > XB_SPIN_CAP) { atomicAdd(&(bar)[XB_TMO], 1u); break; } } } } while (0)
__device__ __forceinline__ void xcd_barrier_post(unsigned* bar) { if (threadIdx.x == 0) (void)xb_add(&bar[XB_XCNT(xb_xcc_id())], 1u); }
__device__ __forceinline__ void xcd_barrier_complete(unsigned* bar, unsigned x, unsigned& nloc, unsigned& nx) {
    const unsigned G = gridDim.x * gridDim.y * gridDim.z;
    unsigned sum, cnt, mine, sp = 0u;
    for (;;) {
        sum = 0u; cnt = 0u; mine = 0u;
#pragma unroll
        for (unsigned j = 0; j < 16; ++j) { const unsigned c = xb_ld(&bar[XB_XCNT(j)]); sum += c; cnt += (c > 0u) ? 1u : 0u; mine = (j == x) ? c : mine; }
        if (sum == G) break;
        __builtin_amdgcn_s_sleep(1);
        if ((++sp & 255u) == 0u) { if (xb_ld(&bar[XB_TMO])) break; if (sp > XB_SPIN_CAP) { atomicAdd(&bar[XB_TMO], 1u); break; } }
    }
    nloc = mine > 0u ? mine : 1u; nx = cnt > 0u ? cnt : 1u;
}
__device__ __forceinline__ void xcd_barrier(unsigned* bar, volatile LAS unsigned* st) {
    asm volatile("s_waitcnt vmcnt(0)" ::: "memory");
    __syncthreads();
    if (threadIdx.x == 0) {
        const unsigned x = xb_xcc_id();
        __builtin_amdgcn_s_waitcnt(0);
        unsigned nloc = st[0], nx = st[1];
        if (nloc == 0u) { xcd_barrier_complete(bar, x, nloc, nx); st[0] = nloc; st[1] = nx; }
        const unsigned old = xb_add(&bar[XB_XSUB(x)], 1u);
        const unsigned gen = old / nloc;
        if (old + 1u == (gen + 1u) * nloc) {
            __builtin_amdgcn_fence(__ATOMIC_RELEASE, "agent");
            asm volatile("s_waitcnt vmcnt(0)" ::: "memory");
            const unsigned og = xb_add(&bar[XB_TOP], 1u);
            const unsigned tg = og / nx, target = (tg + 1u) * nx;
            if (og + 1u != target) XB_SPIN(xb_ld(&bar[XB_TOP]) < target, bar);
            __builtin_amdgcn_fence(__ATOMIC_ACQUIRE, "agent");
            xb_add(&bar[XB_XGEN(x)], 1u);
            asm volatile("s_waitcnt vmcnt(0)" ::: "memory");
        } else {
            XB_SPIN(xb_ld(&bar[XB_XGEN(x)]) == gen, bar);
            __builtin_amdgcn_fence(__ATOMIC_ACQUIRE, "agent");
            asm volatile("s_waitcnt vmcnt(0)" ::: "memory");
        }
    }
    __syncthreads();
}

__device__ __forceinline__ void transpose_item(const float* W, int N, int k0, int n0, bf16* WT, int ldw, int drow0, int koff, LAS float* scr, int lane) {
    float t[32];
#pragma unroll
    for (int i = 0; i < 32; ++i) t[i] = W[(size_t)(k0 + 2 * i + (lane >> 5)) * N + n0 + (lane & 31)];
#pragma unroll
    for (int i = 0; i < 32; ++i) scr[(2 * i + (lane >> 5)) * 33 + (lane & 31)] = t[i];
    asm volatile("s_waitcnt lgkmcnt(0)" ::: "memory");
    const int c = lane & 7;
#pragma unroll
    for (int j = 0; j < 4; ++j) { const int n = (lane >> 3) + 8 * j; const LAS float* s = scr + (8 * c) * 33 + n;
        v4u o; o.x = pk2(s[0 * 33], s[1 * 33]); o.y = pk2(s[2 * 33], s[3 * 33]); o.z = pk2(s[4 * 33], s[5 * 33]); o.w = pk2(s[6 * 33], s[7 * 33]);
        *(v4u*)(WT + (size_t)(drow0 + n) * ldw + koff + k0 + 8 * c) = o; }
    asm volatile("s_waitcnt lgkmcnt(0)" ::: "memory");
}

__device__ __forceinline__ void pro_side(Frame& F, int part, int gw, int ngw, int lt, int nlt) {
    LAS float* scr = (LAS float*)(F.lds + F.wave * 16384);
    bf16* WinT = (bf16*)(F.ws + WS_WIN); bf16* PabT = (bf16*)(F.ws + WS_PAB); bf16* WoutT = (bf16*)(F.ws + WS_WOUT); bf16* WpgT = (bf16*)(F.ws + WS_WPG);
    if (part == 0) {
        constexpr int I_IN = 16 * (INC / 32), I_PA = 8 * 32, I_PB = 8 * 32, I_WO = 16 * 32, I_PG = 16 * 32, I_PU = 4 * 32, I_UP = 16;
        constexpr int NIT = I_IN + I_PA + I_PB + I_WO + I_PG + I_PU + 2 * I_UP;
        for (int it = gw; it < NIT; it += ngw) {
            int r = it;
            if (r < I_IN) { const int nb = r % (INC / 32), kb = r / (INC / 32), n0 = nb * 32;
                const int d0 = n0 < 4096 ? n0 : (n0 < 4224 ? n0 + 2048 : n0 - 128);
                transpose_item(F.w_in, INC, kb * 64, n0, WinT, WINP, d0, 0, scr, F.lane); continue; } r -= I_IN;
            if (r < I_PA) { transpose_item(F.p_a, DM, (r / 32) * 64, (r % 32) * 32, PabT, 1024, (r % 32) * 32, 0, scr, F.lane); continue; } r -= I_PA;
            if (r < I_PB) { transpose_item(F.p_b, DM, (r / 32) * 64, (r % 32) * 32, PabT, 1024, (r % 32) * 32, 512, scr, F.lane); continue; } r -= I_PB;
            if (r < I_WO) { transpose_item(F.w_out, DM, (r / 32) * 64, (r % 32) * 32, WoutT, 1024, (r % 32) * 32, 0, scr, F.lane); continue; } r -= I_WO;
            if (r < I_PG) { transpose_item(F.w_pg, DM, (r / 32) * 64, (r % 32) * 32, WpgT, ACP, (r % 32) * 32, PLE, scr, F.lane); continue; } r -= I_PG;
            if (r < I_PU) { transpose_item(F.w_pu, DM, (r / 32) * 64, (r % 32) * 32, WpgT, ACP, (r % 32) * 32, 0, scr, F.lane); continue; } r -= I_PU;
            if (r < I_UP) { transpose_item(F.w_up, AW, 0, r * 32, (bf16*)(F.ws + WS_WUPT), 64, r * 32, 0, scr, F.lane); continue; } r -= I_UP;
            transpose_item(F.a_up, AW, 0, r * 32, (bf16*)(F.ws + WS_AUPT), 64, r * 32, 0, scr, F.lane);
        }
        for (int i = gw * 64 + F.lane; i < 128 * WINP / 8; i += ngw * 64) *(v4u*)(WinT + (size_t)INC * WINP + (size_t)i * 8) = (v4u){0u, 0u, 0u, 0u};
    }
}
#ifndef MK_XP_NT_HI
#define MK_XP_NT_HI 0
#endif
#if MK_XP_NT_HI
#define XP_ST_HI(p, v) __builtin_nontemporal_store((v), (p))
#else
#define XP_ST_HI(p, v) (*(p) = (v))
#endif
#ifndef MK_XP_NT
#define MK_XP_NT 1
#endif
#if MK_XP_NT
#define XP_ST(p, v) __builtin_nontemporal_store((v), (p))
#else
#define XP_ST(p, v) (*(p) = (v))
#endif
__device__ __forceinline__ void p0_xpass(Frame& F) {
    LAS float* red = (LAS float*)F.lds;
    bf16* U2 = (bf16*)F.out; float* UBAR = (float*)(F.ws + WS_UBAR);
    for (int blk = F.vcu; blk < M / BLK; blk += F.G) {
        float cs[16];
#pragma unroll
        for (int i = 0; i < 16; ++i) cs[i] = 0.f;
        f32x4 gv[4];
#pragma unroll
        for (int j = 0; j < 4; ++j) gv[j] = *((const f32x4*)F.g_pre + F.lane + 64 * j);
        for (int i = 0; i < 8; ++i) {
            f32x4 v[4][4];
#pragma unroll
            for (int r = 0; r < 4; ++r) { const f32x4* xr = (const f32x4*)(F.x + ((size_t)blk * BLK + F.wave + 8 * (4 * i + r)) * DM) + F.lane;
#pragma unroll
                for (int j = 0; j < 4; ++j) v[r][j] = __builtin_nontemporal_load(xr + 64 * j); }
#pragma unroll
            for (int r = 0; r < 4; ++r) { const size_t row = (size_t)blk * BLK + F.wave + 8 * (4 * i + r); float s = 0.f;
#pragma unroll
                for (int j = 0; j < 4; ++j) s += (v[r][j][0] * v[r][j][0] + v[r][j][1] * v[r][j][1]) + (v[r][j][2] * v[r][j][2] + v[r][j][3] * v[r][j][3]);
                const float rs = frsq(wave_sum_fast(s) * (1.f / DM) + RMS_EPS);
#pragma unroll
                for (int j = 0; j < 4; ++j) {
                    float u[4]; unsigned h[4], l[4];
#pragma unroll
                    for (int e = 0; e < 4; ++e) { u[e] = v[r][j][e] * rs * gv[j][e]; cs[j * 4 + e] += u[e]; h[e] = f2bf(u[e]); l[e] = f2bf(u[e] - __uint_as_float(h[e] << 16)); }
                    const int col = 4 * F.lane + 256 * j;
                    XP_ST_HI((v2u*)(U2 + row * 2048 + col), ((v2u){h[0] | (h[1] << 16), h[2] | (h[3] << 16)}));
                    XP_ST((v2u*)(U2 + row * 2048 + 1024 + col), ((v2u){l[0] | (l[1] << 16), l[2] | (l[3] << 16)}));
                } }
        }
        __syncthreads();
#pragma unroll
        for (int j = 0; j < 4; ++j)
#pragma unroll
            for (int e = 0; e < 4; ++e) red[F.wave * 1024 + 4 * F.lane + 256 * j + e] = cs[j * 4 + e];
        __syncthreads();
        for (int k = F.tid; k < 1024; k += NTHR) { float s = 0.f;
#pragma unroll
            for (int w = 0; w < 8; ++w) s += red[w * 1024 + k];
            UBAR[(size_t)blk * 1024 + k] = s * (1.f / BLK); }
    }
    __syncthreads();
}
__device__ __forceinline__ void p0_kmean(Frame& F) {
    LAS float* ub = (LAS float*)F.lds;
    LAS float* red = (LAS float*)(F.lds + 65536);
    const float* UBAR = (const float*)(F.ws + WS_UBAR); float* KMEAN = (float*)(F.ws + WS_KMEAN);
    for (int item = F.vcu; item < BATCH * 16; item += F.G) { const int bi = item >> 4, j = item & 15;
        __syncthreads();
        const int col = F.lane & 31, kp = F.lane >> 5, kb = F.wave * 128 + kp * 64;
        const float* wp = F.w_in + (size_t)kb * INC + 512 + 32 * j + col;
        float w[64];
#pragma unroll
        for (int i = 0; i < 64; ++i) w[i] = wp[(size_t)i * INC];
        for (int i = F.tid; i < 16 * 1024 / 4; i += NTHR) *(LAS f32x4*)(ub + 4 * i) = *(const f32x4*)(UBAR + (size_t)bi * 16 * 1024 + 4 * i);
        __syncthreads();
        float acc[16];
#pragma unroll
        for (int n = 0; n < 16; ++n) acc[n] = 0.f;
#pragma unroll
        for (int i = 0; i < 64; i += 4)
#pragma unroll
            for (int n = 0; n < 16; ++n) { const f32x4 u4 = *(const LAS f32x4*)(ub + n * 1024 + kb + i); acc[n] += (u4[0] * w[i] + u4[1] * w[i + 1]) + (u4[2] * w[i + 2] + u4[3] * w[i + 3]); }
#pragma unroll
        for (int n = 0; n < 16; ++n) red[((F.wave * 2 + kp) * 16 + n) * 32 + col] = acc[n];
        __syncthreads();
        { const int n = F.tid >> 5, c = F.tid & 31; float s = 0.f;
#pragma unroll
          for (int p = 0; p < 16; ++p) s += red[(p * 16 + n) * 32 + c];
          KMEAN[(size_t)(bi * 16 + n) * 512 + 32 * j + c] = s; }
    }
    __syncthreads();
}
__device__ __forceinline__ void p0_gvec(Frame& F) {
    LAS float* km = (LAS float*)F.lds;
    LAS float* wt = (LAS float*)(F.lds + 32768 + F.wave * 8704);
    const float* KMEAN = (const float*)(F.ws + WS_KMEAN); bf16* WgT = (bf16*)(F.ws + WS_WG);
    for (int item = F.vcu; item < BATCH * 16; item += F.G) { const int bi = item >> 4, j = item & 15, h = F.wave;
        __syncthreads();
        for (int i = F.tid; i < 16 * 512 / 4; i += NTHR) *(LAS f32x4*)(km + 4 * i) = *(const f32x4*)(KMEAN + (size_t)bi * 16 * 512 + 4 * i);
        __syncthreads();
#pragma unroll 1
        for (int p = 0; p < 2; ++p) {
            f32x4 t[8];
#pragma unroll
            for (int i = 0; i < 8; ++i) t[i] = *(const f32x4*)(F.w_in + (size_t)(64 * j + 32 * p + 4 * i + (F.lane >> 4)) * INC + h * 64 + 4 * (F.lane & 15));
#pragma unroll
            for (int i = 0; i < 8; ++i) *(LAS f32x4*)(wt + (4 * i + (F.lane >> 4)) * 68 + 4 * (F.lane & 15)) = t[i];
            asm volatile("s_waitcnt lgkmcnt(0)" ::: "memory");
            const int r = F.lane & 31, hf = F.lane >> 5;
            float acc[8];
#pragma unroll
            for (int n = 0; n < 8; ++n) acc[n] = 0.f;
#pragma unroll
            for (int c = 0; c < 16; ++c) { const f32x4 wv = *(const LAS f32x4*)(wt + r * 68 + 4 * c);
#pragma unroll
                for (int n = 0; n < 8; ++n) { const f32x4 kv = *(const LAS f32x4*)(km + (8 * hf + n) * 512 + h * 64 + 4 * c); acc[n] += (wv[0] * kv[0] + wv[1] * kv[1]) + (wv[2] * kv[2] + wv[3] * kv[3]); } }
            asm volatile("s_waitcnt lgkmcnt(0)" ::: "memory");
            const int k = 64 * j + 32 * p + r;
#pragma unroll
            for (int n = 0; n < 8; ++n) { const float s = acc[n]; const unsigned hi = f2bf(s), lo = f2bf(s - __uint_as_float(hi << 16));
                bf16* r0 = WgT + ((size_t)bi * 256 + h * 16 + 8 * hf + n) * 2048; bf16* r1 = r0 + (size_t)128 * 2048;
                r0[k] = (bf16)hi; r0[1024 + k] = (bf16)hi; r1[k] = (bf16)lo; r1[1024 + k] = (bf16)lo; }
        }
    }
    __syncthreads();
}

template <typename PartPtr> __device__ __forceinline__ void panel_norm(Frame& F, int pm, const bf16* Y, bf16* H1, float* RSY, PartPtr part, int part_row0) {
    f32x4 gv[4];
#pragma unroll
    for (int j = 0; j < 4; ++j) gv[j] = *((const f32x4*)F.g_post + F.lane + 64 * j);
    for (int i = 0; i < 8; ++i) {
        v2u yw[4][4]; f32x4 xv[4][4], pv[4]; float rs[4];
#pragma unroll
        for (int r = 0; r < 4; ++r) { const int rl = F.wave * 32 + 4 * i + r; const size_t row = (size_t)pm * 256 + rl;
            const v2u* yr = (const v2u*)(Y + row * DM) + F.lane; const f32x4* xr = (const f32x4*)(F.x + row * DM) + F.lane;
#pragma unroll
            for (int j = 0; j < 4; ++j) { yw[r][j] = __builtin_nontemporal_load(yr + 64 * j); xv[r][j] = __builtin_nontemporal_load(xr + 64 * j); }
            pv[r] = __builtin_nontemporal_load((const f32x4*)(F.p + row * PLE) + F.lane);
            const auto* pp = part + (size_t)(part_row0 + rl) * 4; const f32x4 a = pp[0], b = pp[1], c = pp[2], d = pp[3];
            rs[r] = frsq((((a[0] + a[1]) + (a[2] + a[3])) + ((b[0] + b[1]) + (b[2] + b[3])) + ((c[0] + c[1]) + (c[2] + c[3])) + ((d[0] + d[1]) + (d[2] + d[3]))) * (1.f / DM) + RMS_EPS);
            if (F.lane == 0) RSY[row] = rs[r]; }
#pragma unroll
        for (int r = 0; r < 4; ++r) { const size_t row = (size_t)pm * 256 + F.wave * 32 + 4 * i + r;
            *(v2u*)(H1 + row * 1344 + 4 * F.lane) = (v2u){pk2(pv[r][0], pv[r][1]), pk2(pv[r][2], pv[r][3])};
#pragma unroll
            for (int j = 0; j < 4; ++j) { const v2u w = yw[r][j]; const float yv[4] = {__uint_as_float(w.x << 16), __uint_as_float(w.x & 0xffff0000u), __uint_as_float(w.y << 16), __uint_as_float(w.y & 0xffff0000u)}; float h[4];
#pragma unroll
                for (int e = 0; e < 4; ++e) h[e] = xv[r][j][e] + yv[e] * rs[r] * gv[j][e];
                *(v2u*)(H1 + row * 1344 + PLE + 4 * F.lane + 256 * j) = (v2u){pk2(h[0], h[1]), pk2(h[2], h[3])}; } }
    }
}

__device__ __forceinline__ void post_norm(Frame& F) {
    const bf16* Y = (const bf16*)(F.ws + WS_RW); float* RSY = (float*)(F.ws + WS_RSY); bf16* H1 = (bf16*)(F.ws + WS_QKVZ);
    const int gw = F.vcu * NWAVES + F.wave, NGW = F.G * NWAVES;
    f32x4 gv[4];
#pragma unroll
    for (int j = 0; j < 4; ++j) gv[j] = *((const f32x4*)F.g_post + F.lane + 64 * j);
    for (int row0 = gw * 4; row0 < M; row0 += NGW * 4) {
        v2u yw[4][4]; f32x4 xv[4][4];
#pragma unroll
        for (int r = 0; r < 4; ++r) { const v2u* yr = (const v2u*)(Y + (size_t)(row0 + r) * DM) + F.lane; const f32x4* xr = (const f32x4*)(F.x + (size_t)(row0 + r) * DM) + F.lane;
#pragma unroll
            for (int j = 0; j < 4; ++j) { yw[r][j] = yr[64 * j]; xv[r][j] = xr[64 * j]; } }
#pragma unroll
        for (int r = 0; r < 4; ++r) { f32x4 v[4]; float s = 0.f;
#pragma unroll
            for (int j = 0; j < 4; ++j) { const v2u w = yw[r][j]; v[j] = (f32x4){__uint_as_float(w.x << 16), __uint_as_float(w.x & 0xffff0000u), __uint_as_float(w.y << 16), __uint_as_float(w.y & 0xffff0000u)}; s += (v[j][0] * v[j][0] + v[j][1] * v[j][1]) + (v[j][2] * v[j][2] + v[j][3] * v[j][3]); }
            const float rs = frsq(wave_sum_fast(s) * (1.f / DM) + RMS_EPS);
            if (F.lane == 0) RSY[row0 + r] = rs;
#pragma unroll
            for (int j = 0; j < 4; ++j) { float h[4];
#pragma unroll
                for (int e = 0; e < 4; ++e) h[e] = xv[r][j][e] + v[j][e] * rs * gv[j][e];
                *(v2u*)(H1 + (size_t)(row0 + r) * DM + 4 * F.lane + 256 * j) = (v2u){pk2(h[0], h[1]), pk2(h[2], h[3])}; } }
    }
}
namespace moba {
using bf16x8 = __attribute__((ext_vector_type(8))) short;
using s16x4 = __attribute__((ext_vector_type(4))) short;
using f32x16 = __attribute__((ext_vector_type(16))) float;
using u32x4 = __attribute__((ext_vector_type(4))) unsigned;
typedef short v4i16_t __attribute__((ext_vector_type(4)));
typedef float f32x2_t __attribute__((ext_vector_type(2))); typedef __bf16 bf16x2_t __attribute__((ext_vector_type(2)));
__device__ __forceinline__ int crow(int r, int hi) { return (r & 3) + 8 * (r >> 2) + 4 * hi; }
__device__ __forceinline__ unsigned cvtpk(float lo, float hi) { f32x2_t v = {lo, hi}; bf16x2_t b = __builtin_convertvector(v, bf16x2_t); return __builtin_bit_cast(unsigned, b); }
__device__ __forceinline__ float max3f(float a, float b, float c) { return fmaxf(fmaxf(a, b), c); }

constexpr int SLOTB = 8192;
#ifndef MK_ATT_PRIO
#define MK_ATT_PRIO 0
#endif
#if MK_ATT_PRIO
#define ATT_PRIO(x) __builtin_amdgcn_s_setprio(x)
#else
#define ATT_PRIO(x) ((void)0)
#endif
__device__ __forceinline__ void qkt(f32x16& p0, f32x16& p1, const LAS unsigned char* Kslot, const bf16x8* qr, int r32, int hi) {
    const LAS unsigned char* kb = Kslot + hi * 1024 + r32 * 16;
    const f32x16 z = {};
    ATT_PRIO(1);
#pragma unroll
    for (int d0 = 0; d0 < 4; ++d0) {
        const bf16x8 b0 = *(const LAS bf16x8*)(kb + d0 * 2048);
        const bf16x8 b1 = *(const LAS bf16x8*)(kb + d0 * 2048 + 512);
        if (d0 == 0) { p0 = __builtin_amdgcn_mfma_f32_32x32x16_bf16(b0, qr[0], z, 0, 0, 0); p1 = __builtin_amdgcn_mfma_f32_32x32x16_bf16(b1, qr[0], z, 0, 0, 0); }
        else { p0 = __builtin_amdgcn_mfma_f32_32x32x16_bf16(b0, qr[d0], p0, 0, 0, 0); p1 = __builtin_amdgcn_mfma_f32_32x32x16_bf16(b1, qr[d0], p1, 0, 0, 0); } }
    ATT_PRIO(0);
}
__device__ __forceinline__ void qkt_acc(f32x16& p0, f32x16& p1, const LAS unsigned char* Kslot, const bf16x8* qr, int r32, int hi) {
    const LAS unsigned char* kb = Kslot + hi * 1024 + r32 * 16;
    ATT_PRIO(1);
#pragma unroll
    for (int d0 = 0; d0 < 4; ++d0) {
        const bf16x8 b0 = *(const LAS bf16x8*)(kb + d0 * 2048);
        const bf16x8 b1 = *(const LAS bf16x8*)(kb + d0 * 2048 + 512);
        p0 = __builtin_amdgcn_mfma_f32_32x32x16_bf16(b0, qr[d0], p0, 0, 0, 0); p1 = __builtin_amdgcn_mfma_f32_32x32x16_bf16(b1, qr[d0], p1, 0, 0, 0); }
    ATT_PRIO(0);
}
__device__ __forceinline__ void pv(f32x16* o, int vb, bf16x8 pa0, bf16x8 pa1, bf16x8 pa2, bf16x8 pa3) {
#pragma unroll
    for (int d0 = 0; d0 < 2; ++d0) { s16x4 lo[4], hi[4];
#pragma unroll
        for (int ks = 0; ks < 4; ++ks) {
            asm volatile("ds_read_b64_tr_b16 %0,%1 offset:%c2" : "=&v"(lo[ks]) : "v"(vb), "i"(d0 * 4096 + ks * 1024) : "memory");
            asm volatile("ds_read_b64_tr_b16 %0,%1 offset:%c2" : "=&v"(hi[ks]) : "v"(vb), "i"(d0 * 4096 + ks * 1024 + 512) : "memory"); }
        asm volatile("s_waitcnt lgkmcnt(0)" ::: "memory"); __builtin_amdgcn_sched_barrier(0);
        ATT_PRIO(1);
#define PK(k) (bf16x8){lo[k][0], lo[k][1], lo[k][2], lo[k][3], hi[k][0], hi[k][1], hi[k][2], hi[k][3]}
        o[d0] = __builtin_amdgcn_mfma_f32_32x32x16_bf16(pa0, PK(0), o[d0], 0, 0, 0);
        o[d0] = __builtin_amdgcn_mfma_f32_32x32x16_bf16(pa1, PK(1), o[d0], 0, 0, 0);
        o[d0] = __builtin_amdgcn_mfma_f32_32x32x16_bf16(pa2, PK(2), o[d0], 0, 0, 0);
        o[d0] = __builtin_amdgcn_mfma_f32_32x32x16_bf16(pa3, PK(3), o[d0], 0, 0, 0);
        ATT_PRIO(0);
#undef PK
    }
}
__device__ __forceinline__ float rowmax2(const f32x16& p0, const f32x16& p1, float a) {
#pragma unroll
    for (int r = 0; r < 16; r += 2) { a = max3f(a, p0[r], p0[r + 1]); a = max3f(a, p1[r], p1[r + 1]); }
    return a;
}
__device__ __forceinline__ float swapmax(float m) { auto rr = __builtin_amdgcn_permlane32_swap(__float_as_uint(m), __float_as_uint(m), false, false); return fmaxf(__uint_as_float(rr[0]), __uint_as_float(rr[1])); }
__device__ __forceinline__ float swapsum(float m) { auto rr = __builtin_amdgcn_permlane32_swap(__float_as_uint(m), __float_as_uint(m), false, false); return __uint_as_float(rr[0]) + __uint_as_float(rr[1]); }

__device__ __forceinline__ void load_kv_block(LAS unsigned char* lds, int KOFF, int VOFF, const bf16* QKVZ, size_t krow0, int h, int wid, int lane) {
    const bf16* ksrc = QKVZ + (krow0 + lane) * QP + 512 + h * HD + wid * 8;
    const bf16* vsrc = QKVZ + (krow0 + 16 * (wid & 3) + (lane >> 2)) * QP + 1024 + h * HD + (wid >> 2) * 32 + (lane & 3) * 8;
#pragma unroll
    for (int t = 0; t < 4; ++t) {
        __builtin_amdgcn_global_load_lds((const unsigned*)(ksrc + (size_t)t * 64 * QP), (LAS unsigned*)(lds + KOFF + t * SLOTB + wid * 1024), 16, 0, MK_DMA_NT ? 2 : 0);
        __builtin_amdgcn_global_load_lds((const unsigned*)(vsrc + (size_t)t * 64 * QP), (LAS unsigned*)(lds + VOFF + t * SLOTB + wid * 1024), 16, 0, MK_DMA_NT ? 2 : 0); }
}

__device__ __forceinline__ void glds16_asm(const void* gsrc, unsigned lds_dst) {
    unsigned keep;
#if MK_DMA_NT
    asm volatile("s_mov_b32 %0, m0\n\ts_mov_b32 m0, %2\n\ts_nop 0\n\tglobal_load_lds_dwordx4 %1, off nt\n\ts_mov_b32 m0, %0" : "=&s"(keep) : "v"(gsrc), "s"(lds_dst) : "memory");
#else
    asm volatile("s_mov_b32 %0, m0\n\ts_mov_b32 m0, %2\n\ts_nop 0\n\tglobal_load_lds_dwordx4 %1, off\n\ts_mov_b32 m0, %0" : "=&s"(keep) : "v"(gsrc), "s"(lds_dst) : "memory");
#endif
}
__device__ __forceinline__ void load_kv_block_asm(LAS unsigned char* lds, int KOFF, int VOFF, const bf16* QKVZ, size_t krow0, int h, int wid, int lane) {
    const bf16* ksrc = QKVZ + (krow0 + lane) * QP + 512 + h * HD + wid * 8;
    const bf16* vsrc = QKVZ + (krow0 + 16 * (wid & 3) + (lane >> 2)) * QP + 1024 + h * HD + (wid >> 2) * 32 + (lane & 3) * 8;
    const unsigned base = (unsigned)(uintptr_t)lds + (unsigned)__builtin_amdgcn_readfirstlane(wid) * 1024u;
#pragma unroll
    for (int t = 0; t < 4; ++t) {
        glds16_asm(ksrc + (size_t)t * 64 * QP, base + KOFF + t * SLOTB);
        glds16_asm(vsrc + (size_t)t * 64 * QP, base + VOFF + t * SLOTB); }
}
}

constexpr int LIST_CAP = 3840;

__device__ __forceinline__ void attn_select(Frame& F, const float* GATE, unsigned* CNT, unsigned short* LISTS, int panel = -1) {
    constexpr int NIT = BATCH * NH * (SEQ / 64);
    const int gw = F.vcu * NWAVES + F.wave, NGW = F.G * NWAVES;
#pragma unroll 1
    for (int it0 = gw; it0 < NIT; it0 += 4 * NGW) {
        f32x4 ga[4][4]; int sb[4], sh[4], ss[4]; bool act[4];
#pragma unroll
        for (int k = 0; k < 4; ++k) { const int it = it0 + k * NGW; bool v = it < NIT; const int itc = v ? it : gw;
            int sg = itc % (SEQ / 64), h = (itc / (SEQ / 64)) % NH, b = itc / (SEQ / 64 * NH);
            if (panel >= 0) { const int j = F.wave * 4 + k; h = j & 7; sg = (panel & 15) * 4 + (j >> 3); b = panel >> 4; v = true; }
            const int s = sg * 64 + F.lane;
            sb[k] = b; sh[k] = h; ss[k] = s; act[k] = v && (s >> 8) > 0;
            const size_t row = (size_t)b * SEQ + s; const f32x4* gp = (const f32x4*)(GATE + row * 128 + h * 16);
#pragma unroll
            for (int c = 0; c < 4; ++c) ga[k][c] = gp[c]; }
        int i0[4], i1[4], i2[4], r0[4], r1[4], r2[4]; unsigned mycnt[4], base[4];
#pragma unroll
        for (int k = 0; k < 4; ++k) { const int qb = ss[k] >> 8;
            float g0 = -INFINITY, g1 = -INFINITY, g2 = -INFINITY; int j0 = -1, j1 = -1, j2 = -1;
#pragma unroll
            for (int c = 0; c < 4; ++c)
#pragma unroll
                for (int e = 0; e < 4; ++e) { const int n = c * 4 + e; const float g = (n < qb) ? ga[k][c][e] : -INFINITY;
                    if (g > g0) { g2 = g1; j2 = j1; g1 = g0; j1 = j0; g0 = g; j0 = n; } else if (g > g1) { g2 = g1; j2 = j1; g1 = g; j1 = n; } else if (g > g2) { g2 = g; j2 = n; } }
            if (!act[k]) { j0 = -1; j1 = -1; j2 = -1; }
            i0[k] = j0; i1[k] = j1; i2[k] = j2;
            int q0 = 0, q1 = 0, q2 = 0; unsigned mc = 0u;
            const int qbu = act[k] ? __builtin_amdgcn_readfirstlane(qb) : 0;
            for (int n = 0; n < qbu; ++n) {
                const bool pick = (j0 == n) | (j1 == n) | (j2 == n);
                const unsigned long long mask = __ballot(pick);
                const int before = __builtin_amdgcn_mbcnt_hi((unsigned)(mask >> 32), __builtin_amdgcn_mbcnt_lo((unsigned)mask, 0u));
                if (j0 == n) q0 = before; if (j1 == n) q1 = before; if (j2 == n) q2 = before;
                if (F.lane == n) mc = (unsigned)__popcll(mask);
            }
            r0[k] = q0; r1[k] = q1; r2[k] = q2; mycnt[k] = mc; }
#pragma unroll
        for (int k = 0; k < 4; ++k) { base[k] = 0u; if (mycnt[k]) base[k] = atomicAdd(CNT + (sb[k] * NH + sh[k]) * 16 + F.lane, mycnt[k]); }
#pragma unroll
        for (int k = 0; k < 4; ++k) { unsigned short* lst = LISTS + (size_t)(sb[k] * NH + sh[k]) * 16 * LIST_CAP; const int s = ss[k];
            const unsigned b0 = __shfl(base[k], i0[k] < 0 ? 0 : i0[k]), b1 = __shfl(base[k], i1[k] < 0 ? 0 : i1[k]), b2 = __shfl(base[k], i2[k] < 0 ? 0 : i2[k]);
            if (i0[k] >= 0) lst[(size_t)i0[k] * LIST_CAP + b0 + r0[k]] = (unsigned short)(s | (0 << 12));
            if (i1[k] >= 0) lst[(size_t)i1[k] * LIST_CAP + b1 + r1[k]] = (unsigned short)(s | (1 << 12));
            if (i2[k] >= 0) lst[(size_t)i2[k] * LIST_CAP + b2 + r2[k]] = (unsigned short)(s | (2 << 12)); }
        if (panel >= 0) break;
    }
}

#ifndef MK_A1_NT
#define MK_A1_NT 0
#endif
#if MK_A1_NT
#define A1_ST(p, v) __builtin_nontemporal_store((v), (p))
#else
#define A1_ST(p, v) (*(p) = (v))
#endif
__device__ __forceinline__ void attn_partial(Frame& F, const bf16* QKVZ, const unsigned* CNT, const unsigned short* LISTS, bf16* PART_O, float* PART_ML, unsigned* QCTR) {
    using namespace moba;
    LAS unsigned char* lds = F.lds; const int wid = F.wave, lane = F.lane, r32 = lane & 31, hi = lane >> 5;
    LAS float* btab = (LAS float*)(lds + 114688); LAS unsigned* uword = (LAS unsigned*)(lds + 106496); LAS unsigned short* llist = (LAS unsigned short*)(lds + 106624);
    LAS float* wsf = (LAS float*)(lds + 98304) + wid * 128; LAS bf16* stg = (LAS bf16*)(lds + 65536) + wid * 2048;
    for (int i = F.tid; i < NH * 512; i += NTHR) { const int h = i >> 9, d = i & 511; btab[i] = d < 113 ? (F.rel_bias[T5B[d] * NH + h] - F.rel_bias[31 * NH + h]) * LOG2E : 0.f; }
    const int vb0 = (int)(uintptr_t)(lds + 32768) + ((lane >> 4) & 1) * 32 + (lane & 3) * 8 + (4 * hi + ((lane & 15) >> 2)) * 64;
    const int NUNIT = BATCH * NH * 15;
    if (F.tid == 0) { const unsigned u0 = atomicAdd(QCTR, 1u); uword[0] = u0; uword[1] = (u0 < (unsigned)NUNIT) ? CNT[(u0 % (BATCH * NH)) * 16 + u0 / (BATCH * NH)] : 0u; }
    for (;;) {
        lds_barrier();
        const int u = (int)uword[0]; const int cnt = (int)uword[1];
        if (u >= NUNIT) break;
        const int n = u / (BATCH * NH), bh = u % (BATCH * NH), b = bh / NH, h = bh % NH;
        load_kv_block(lds, 0, 32768, QKVZ, (size_t)b * SEQ + n * BLK, h, wid, lane);
        const unsigned short* lst = LISTS + ((size_t)bh * 16 + n) * LIST_CAP;
        for (int i = F.tid; i < (cnt + 1) / 2; i += NTHR) ((LAS unsigned*)llist)[i] = ((const unsigned*)lst)[i];
        const float b31 = F.rel_bias[31 * NH + h] * LOG2E;
        __syncthreads();
        unsigned nu = 0u, nc = 0u;
        if (F.tid == NTHR - 64) { nu = atomicAdd(QCTR, 1u); nc = (nu < (unsigned)NUNIT) ? CNT[(nu % (BATCH * NH)) * 16 + nu / (BATCH * NH)] : 0u; }
        const int ntile = (cnt + 31) >> 5;
        bf16x8 qr[4], qn[4]; int tile = wid;
        if (tile < ntile) { const int idx = tile * 32 + r32; const unsigned e = llist[idx < cnt ? idx : 0]; const size_t row = (size_t)b * SEQ + (e & 4095);
#pragma unroll
            for (int d0 = 0; d0 < 4; ++d0) { qr[d0] = *(const bf16x8*)(QKVZ + row * QP + h * HD + d0 * 16 + hi * 8); qn[d0] = qr[d0]; } }
        for (; tile < ntile; tile += NWAVES) {
            int lane_ = F.tid; asm volatile("" : "+v"(lane_)); lane_ &= 63;
            const int lane = lane_, r32 = lane & 31, hi = lane >> 5;
            const int vb0 = (int)(uintptr_t)(lds + 32768) + ((lane >> 4) & 1) * 32 + (lane & 3) * 8 + (4 * hi + ((lane & 15) >> 2)) * 64;
            const int idx = tile * 32 + r32; const bool valid = idx < cnt;
            const unsigned e = llist[valid ? idx : 0]; const int s = e & 4095, slot = e >> 12; const size_t row = (size_t)b * SEQ + s;
            if (tile + NWAVES < ntile) { const int idx2 = (tile + NWAVES) * 32 + r32; const unsigned e2 = llist[idx2 < cnt ? idx2 : 0]; const size_t row2 = (size_t)b * SEQ + (e2 & 4095);
#pragma unroll
                for (int d0 = 0; d0 < 4; ++d0) qn[d0] = *(const bf16x8*)(QKVZ + row2 * QP + h * HD + d0 * 16 + hi * 8); }
            f32x16 o[2]; o[0] = f32x16{}; o[1] = f32x16{};
            float mx = -INFINITY, l = 0.f;
            const bool near = ((s >> 8) == n + 1);
            const int dbase = near ? (s - (n * BLK + 128)) : 400;
            const LAS float* bq = btab + h * 512 + dbase - 127;
#pragma unroll
            for (int half = 0; half < 2; ++half) {
                if (half) __builtin_amdgcn_sched_barrier(0);
                f32x16 p[2][2];
                if (half == 1) {
#pragma unroll
                    for (int t = 0; t < 2; ++t)
#pragma unroll
                        for (int r = 0; r < 16; ++r) { const int kvc = t * 64 + (r & 3) + 8 * (r >> 2);
                            p[t][0][r] = (bq - 4 * hi)[127 - kvc]; p[t][1][r] = (bq - 4 * hi)[127 - kvc - 32]; }
                } else { p[0][0] = f32x16{}; p[0][1] = f32x16{}; p[1][0] = f32x16{}; p[1][1] = f32x16{}; }
#pragma unroll
                for (int t = 0; t < 2; ++t) qkt_acc(p[t][0], p[t][1], lds + (2 * half + t) * SLOTB, qr, r32, hi);
                float m2 = rowmax2(p[0][0], p[0][1], mx); m2 = rowmax2(p[1][0], p[1][1], m2); m2 = swapmax(m2);
                const float f = fexp2(mx - m2); l *= f; mx = m2;
                if (half == 1) {
                    if (hi == 0) wsf[64 + r32] = f;
                    asm volatile("s_waitcnt lgkmcnt(0)" ::: "memory");
#pragma unroll
                    for (int r = 0; r < 16; ++r) { const float fr_ = wsf[64 + crow(r, hi)]; o[0][r] *= fr_; o[1][r] *= fr_; } }
#pragma unroll
                for (int t = 0; t < 2; ++t) {
#pragma unroll
                    for (int r = 0; r < 16; ++r) { p[t][0][r] = fexp2(p[t][0][r] - mx); p[t][1][r] = fexp2(p[t][1][r] - mx); l += p[t][0][r] + p[t][1][r]; }
                    u32x4 w0, w1, w2, w3;
                    w0 = (u32x4){cvtpk(p[t][0][0], p[t][0][1]), cvtpk(p[t][0][2], p[t][0][3]), cvtpk(p[t][0][4], p[t][0][5]), cvtpk(p[t][0][6], p[t][0][7])};
                    w1 = (u32x4){cvtpk(p[t][0][8], p[t][0][9]), cvtpk(p[t][0][10], p[t][0][11]), cvtpk(p[t][0][12], p[t][0][13]), cvtpk(p[t][0][14], p[t][0][15])};
                    w2 = (u32x4){cvtpk(p[t][1][0], p[t][1][1]), cvtpk(p[t][1][2], p[t][1][3]), cvtpk(p[t][1][4], p[t][1][5]), cvtpk(p[t][1][6], p[t][1][7])};
                    w3 = (u32x4){cvtpk(p[t][1][8], p[t][1][9]), cvtpk(p[t][1][10], p[t][1][11]), cvtpk(p[t][1][12], p[t][1][13]), cvtpk(p[t][1][14], p[t][1][15])};
                    pv(o, vb0 + (2 * half + t) * SLOTB, __builtin_bit_cast(bf16x8, w0), __builtin_bit_cast(bf16x8, w1), __builtin_bit_cast(bf16x8, w2), __builtin_bit_cast(bf16x8, w3)); }
            }
            __builtin_amdgcn_sched_barrier(0);
#pragma unroll
            for (int d0 = 0; d0 < 4; ++d0) { u32x4 t_ = __builtin_bit_cast(u32x4, qn[d0]); asm volatile("" : "+v"(t_)); qr[d0] = __builtin_bit_cast(bf16x8, t_); }
            __builtin_amdgcn_sched_barrier(0);
            l = swapsum(l);
            if (hi == 0) { wsf[r32] = frcp(l); ((LAS int*)wsf)[32 + r32] = valid ? (int)(((row * NH + h) * 3 + slot)) : -1;
                           if (valid) { float2 ml; ml.x = mx + b31; ml.y = l; *(float2*)(PART_ML + ((row * NH + h) * 3 + slot) * 2) = ml; } }
            asm volatile("s_waitcnt lgkmcnt(0)" ::: "memory");
#pragma unroll
            for (int r = 0; r < 16; ++r) { const int orow = crow(r, hi); const float il = wsf[orow];
#pragma unroll
                for (int d0 = 0; d0 < 2; ++d0) stg[orow * 64 + d0 * 32 + r32] = (bf16)f2bf(o[d0][r] * il); }
            asm volatile("s_waitcnt lgkmcnt(0)" ::: "memory");
#pragma unroll
            for (int i = 0; i < 4; ++i) { const int rr = i * 8 + (lane >> 3), ch = lane & 7; const int dst = ((LAS int*)wsf)[32 + rr];
                const u32x4 v = *(const LAS u32x4*)(stg + rr * 64 + ch * 8);
                if (dst >= 0) A1_ST((u32x4*)(PART_O + (size_t)dst * 64 + ch * 8), v); }
            asm volatile("s_waitcnt lgkmcnt(0)" ::: "memory");
        }
        if (F.tid == NTHR - 64) { uword[0] = nu; uword[1] = nc; }
    }
}

#ifndef MK_A2_NT
#define MK_A2_NT 0
#endif
#if MK_A2_NT
#define A2_ST(p, v) __builtin_nontemporal_store((v), (p))
#else
#define A2_ST(p, v) (*(p) = (v))
#endif
#ifndef MK_A2_KVAHEAD
#define MK_A2_KVAHEAD 2
#endif
#if MK_A2_KVAHEAD == 2
#define A2_KVLOAD load_kv_block_asm
#else
#define A2_KVLOAD load_kv_block
#endif
#ifndef MK_A2_KVAHEAD
#define MK_A2_KVAHEAD 0
#endif
__device__ __forceinline__ void attn_own_combine(Frame& F, bf16* QKVZ, const bf16* PART_O, const float* PART_ML, bf16* OUTB, int out_pitch) {
    using namespace moba;
    LAS unsigned char* lds = F.lds; const int wid = F.wave, lane = F.lane, r32 = lane & 31, hi = lane >> 5;
    const int qt = wid < 4 ? wid : 11 - wid;
    LAS float* btab = (LAS float*)(lds + 139264);
    LAS float* wsf = (LAS float*)(lds + 135168) + wid * 128; LAS float* ost = (LAS float*)(lds + 65536 + wid * 8704);
    __syncthreads();
    for (int i = F.tid; i < NH * 256; i += NTHR) { const int h = i >> 8, d = i & 255; btab[i] = F.rel_bias[T5B[d < 127 ? d : 127] * NH + h] * LOG2E; }
    const int vb0 = (int)(uintptr_t)(lds + 32768) + ((lane >> 4) & 1) * 32 + (lane & 3) * 8 + (4 * hi + ((lane & 15) >> 2)) * 64;
#if MK_A2_KVAHEAD
    bf16x8 qr[4];
    if (F.vcu < BATCH * NH * NBLK) { const int u0 = F.vcu, qb0 = u0 % NBLK, bh0 = u0 / NBLK; lds_barrier(); A2_KVLOAD(lds, 0, 32768, QKVZ, (size_t)(bh0 / NH) * SEQ + qb0 * BLK, bh0 % NH, wid, lane);
        const size_t row0 = (size_t)(bh0 / NH) * SEQ + qb0 * BLK + qt * 32 + r32;
#pragma unroll
        for (int d0 = 0; d0 < 4; ++d0) qr[d0] = *(const bf16x8*)(QKVZ + row0 * QP + (bh0 % NH) * HD + d0 * 16 + hi * 8); }
#endif
    for (int u = F.vcu; u < BATCH * NH * NBLK; u += F.G) {
        const int qb = u % NBLK, bh = u / NBLK, b = bh / NH, h = bh % NH;
#if !MK_A2_KVAHEAD
        lds_barrier();
        load_kv_block(lds, 0, 32768, QKVZ, (size_t)b * SEQ + qb * BLK, h, wid, lane);
#endif
        const int sq = qb * BLK + qt * 32 + r32; const size_t row = (size_t)b * SEQ + sq;
#if !MK_A2_KVAHEAD
        bf16x8 qr[4];
#pragma unroll
        for (int d0 = 0; d0 < 4; ++d0) qr[d0] = *(const bf16x8*)(QKVZ + row * QP + h * HD + d0 * 16 + hi * 8);
#endif
#if MK_A2_KVAHEAD == 2
        asm volatile("s_waitcnt vmcnt(0)" ::: "memory");
#endif
        __syncthreads();
        const int cq = lane >> 1, cc0 = (lane & 1) * 32; const size_t crow2 = (size_t)b * SEQ + qb * BLK + qt * 32 + cq;
        float2 pml[3]; v4u po[3][4], zw[4];
#pragma unroll
        for (int j = 0; j < 3; ++j) { pml[j] = *(const float2*)(PART_ML + ((crow2 * NH + h) * 3 + j) * 2);
#pragma unroll
            for (int c = 0; c < 4; ++c) po[j][c] = *((const v4u*)(PART_O + ((crow2 * NH + h) * 3 + j) * 64 + cc0) + c); }
#pragma unroll
        for (int c = 0; c < 4; ++c) zw[c] = *((const v4u*)(QKVZ + crow2 * QP + 1536 + h * HD + cc0) + c);
        const int nt = (qt >> 1) + 1;
        int ql = qt * 32 + r32;
        asm volatile("" : "+v"(ql));
        const LAS float* bt = btab + h * 256;
        float mx = -INFINITY, l = 0.f;
        f32x16 o[2]; o[0] = f32x16{}; o[1] = f32x16{};
#pragma unroll 1
        for (int t = 0; t < nt; ++t) { f32x16 p0, p1;
            qkt(p0, p1, lds + t * SLOTB, qr, r32, hi);
            if (t < nt - 1) {
#pragma unroll
                for (int r = 0; r < 16; ++r) { const int kv = t * 64 + crow(r, hi); const int d0 = ql - kv, d1 = d0 - 32; p0[r] += bt[d0]; p1[r] += bt[d1]; }
            } else {
#pragma unroll
                for (int r = 0; r < 16; ++r) { const int kv = t * 64 + crow(r, hi); const int d0 = ql - kv, d1 = d0 - 32; const float b0 = bt[d0 < 0 ? 0 : d0], b1 = bt[d1 < 0 ? 0 : d1];
                    p0[r] = d0 >= 0 ? p0[r] + b0 : -INFINITY; p1[r] = d1 >= 0 ? p1[r] + b1 : -INFINITY; } }
            const float m2 = swapmax(rowmax2(p0, p1, mx));
            const float f = fexp2(mx - m2); l *= f; mx = m2;
            if (t > 0) { if (hi == 0) wsf[64 + r32] = f;
                asm volatile("s_waitcnt lgkmcnt(0)" ::: "memory");
#pragma unroll
                for (int r = 0; r < 16; ++r) { const float fr_ = wsf[64 + crow(r, hi)]; o[0][r] *= fr_; o[1][r] *= fr_; } }
#pragma unroll
            for (int r = 0; r < 16; ++r) { p0[r] = fexp2(p0[r] - mx); p1[r] = fexp2(p1[r] - mx); l += p0[r] + p1[r]; }
            u32x4 w0, w1, w2, w3;
            w0 = (u32x4){cvtpk(p0[0], p0[1]), cvtpk(p0[2], p0[3]), cvtpk(p0[4], p0[5]), cvtpk(p0[6], p0[7])};
            w1 = (u32x4){cvtpk(p0[8], p0[9]), cvtpk(p0[10], p0[11]), cvtpk(p0[12], p0[13]), cvtpk(p0[14], p0[15])};
            w2 = (u32x4){cvtpk(p1[0], p1[1]), cvtpk(p1[2], p1[3]), cvtpk(p1[4], p1[5]), cvtpk(p1[6], p1[7])};
            w3 = (u32x4){cvtpk(p1[8], p1[9]), cvtpk(p1[10], p1[11]), cvtpk(p1[12], p1[13]), cvtpk(p1[14], p1[15])};
            pv(o, vb0 + t * SLOTB, __builtin_bit_cast(bf16x8, w0), __builtin_bit_cast(bf16x8, w1), __builtin_bit_cast(bf16x8, w2), __builtin_bit_cast(bf16x8, w3));
        }
        l = swapsum(l);
#if MK_A2_KVAHEAD
        lds_barrier();
        if (u + F.G < BATCH * NH * NBLK) { const int u1 = u + F.G, qb1 = u1 % NBLK, bh1 = u1 / NBLK; A2_KVLOAD(lds, 0, 32768, QKVZ, (size_t)(bh1 / NH) * SEQ + qb1 * BLK, bh1 % NH, wid, lane);
            const size_t row1 = (size_t)(bh1 / NH) * SEQ + qb1 * BLK + qt * 32 + r32;
#pragma unroll
            for (int d0 = 0; d0 < 4; ++d0) qr[d0] = *(const bf16x8*)(QKVZ + row1 * QP + (bh1 % NH) * HD + d0 * 16 + hi * 8); }
#endif
        if (hi == 0) { wsf[r32] = mx; wsf[32 + r32] = l; }
#pragma unroll
        for (int r = 0; r < 16; ++r) { const int orow = crow(r, hi);
#pragma unroll
            for (int d0 = 0; d0 < 2; ++d0) ost[orow * 68 + d0 * 32 + r32] = o[d0][r]; }
        asm volatile("s_waitcnt lgkmcnt(0)" ::: "memory");
        { const int q = lane >> 1, c0 = (lane & 1) * 32; const int s2 = qb * BLK + qt * 32 + q; const size_t row2 = (size_t)b * SEQ + s2;
          const float m0 = wsf[q], l0 = wsf[32 + q]; const int np = qb < 3 ? qb : 3;
          float mj[3], lj[3]; float mt = m0;
#pragma unroll
          for (int j = 0; j < 3; ++j) { if (j < np) { const float2 ml = pml[j]; mj[j] = ml.x; lj[j] = ml.y; mt = fmaxf(mt, ml.x); } else { mj[j] = -INFINITY; lj[j] = 0.f; } }
          const float w0 = fexp2(m0 - mt); float wj[3]; float den = w0 * l0;
#pragma unroll
          for (int j = 0; j < 3; ++j) { wj[j] = (j < np) ? fexp2(mj[j] - mt) * lj[j] : 0.f; den += wj[j]; }
          const float iden = frcp(den);
          float acc[32];
#pragma unroll
          for (int c = 0; c < 32; c += 4) { const f32x4 v = *(const LAS f32x4*)(ost + q * 68 + c0 + c); acc[c] = v[0] * w0; acc[c + 1] = v[1] * w0; acc[c + 2] = v[2] * w0; acc[c + 3] = v[3] * w0; }
#pragma unroll
          for (int j = 0; j < 3; ++j) if (j < np) {
#pragma unroll
              for (int c = 0; c < 4; ++c) { const v4u w = po[j][c]; const float f = wj[j];
                  acc[c * 8 + 0] += f * __uint_as_float(w.x << 16); acc[c * 8 + 1] += f * __uint_as_float(w.x & 0xffff0000u); acc[c * 8 + 2] += f * __uint_as_float(w.y << 16); acc[c * 8 + 3] += f * __uint_as_float(w.y & 0xffff0000u);
                  acc[c * 8 + 4] += f * __uint_as_float(w.z << 16); acc[c * 8 + 5] += f * __uint_as_float(w.z & 0xffff0000u); acc[c * 8 + 6] += f * __uint_as_float(w.w << 16); acc[c * 8 + 7] += f * __uint_as_float(w.w & 0xffff0000u); } }
          asm volatile("s_waitcnt lgkmcnt(0)" ::: "memory");
#pragma unroll
          for (int c = 0; c < 4; ++c) { const v4u w = zw[c]; const float z[8] = {__uint_as_float(w.x << 16), __uint_as_float(w.x & 0xffff0000u), __uint_as_float(w.y << 16), __uint_as_float(w.y & 0xffff0000u),
                                                                               __uint_as_float(w.z << 16), __uint_as_float(w.z & 0xffff0000u), __uint_as_float(w.w << 16), __uint_as_float(w.w & 0xffff0000u)};
              float rr[8];
#pragma unroll
              for (int e2 = 0; e2 < 8; ++e2) rr[e2] = acc[c * 8 + e2] * iden * z[e2] * sigm(z[e2]);
              v4u ow; ow.x = pk2(rr[0], rr[1]); ow.y = pk2(rr[2], rr[3]); ow.z = pk2(rr[4], rr[5]); ow.w = pk2(rr[6], rr[7]); *(LAS v4u*)((LAS bf16*)ost + q * 72 + c0 + c * 8) = ow; }
          asm volatile("s_waitcnt lgkmcnt(0)" ::: "memory");
#pragma unroll
          for (int i = 0; i < 4; ++i) { const int rr = i * 8 + (lane >> 3), chk = lane & 7; const v4u w = *(const LAS v4u*)((LAS bf16*)ost + rr * 72 + chk * 8);
              A2_ST((v4u*)(OUTB + ((size_t)b * SEQ + qb * BLK + qt * 32 + rr) * out_pitch + h * HD + chk * 8), w); } }
        asm volatile("s_waitcnt lgkmcnt(0)" ::: "memory");
    }
}
namespace rk {
using bf16x8 = __attribute__((ext_vector_type(8))) short;
using s16x4 = __attribute__((ext_vector_type(4))) short;
using f32x16 = __attribute__((ext_vector_type(16))) float;
using u32x4 = __attribute__((ext_vector_type(4))) unsigned;
using u32x2 = __attribute__((ext_vector_type(2))) unsigned;
typedef short v4i16_t __attribute__((ext_vector_type(4)));
typedef float f32x2_t __attribute__((ext_vector_type(2))); typedef __bf16 bf16x2_t __attribute__((ext_vector_type(2)));
constexpr int P = 144, IMG = 64 * P, GRP = 81920, MISC = 8 * IMG;
#define RK_MFMA(a, b, c) __builtin_amdgcn_mfma_f32_32x32x16_bf16((a), (b), (c), 0, 0, 0)
__device__ __forceinline__ int crow(int r, int hi) { return (r & 3) + 8 * (r >> 2) + 4 * hi; }
__device__ __forceinline__ unsigned cvtpk(float lo, float hi) { f32x2_t v = {lo, hi}; bf16x2_t b = __builtin_convertvector(v, bf16x2_t); return __builtin_bit_cast(unsigned, b); }
__device__ __forceinline__ float bflo(unsigned w) { return __uint_as_float(w << 16); }
__device__ __forceinline__ float bfhi(unsigned w) { return __uint_as_float(w & 0xffff0000u); }
__device__ __forceinline__ s16x4 trrd(const LAS unsigned char* p) { return __builtin_bit_cast(s16x4, __builtin_amdgcn_ds_read_tr16_b64_v4i16((LAS v4i16_t*)p)); }
struct Ln { int r, h, blk, q, p; };
__device__ __forceinline__ bf16x8 frag_row(const LAS unsigned char* img, const Ln& l, int tile, int s, int coloff = 0) { return *(const LAS bf16x8*)(img + (32 * tile + l.r) * P + (coloff + 16 * s + 8 * l.h) * 2); }
__device__ __forceinline__ bf16x8 frag_tr(const LAS unsigned char* img, const Ln& l, int tile, int s, int rowoff = 0) {
    const LAS unsigned char* b = img + (rowoff + 16 * s + 8 * l.h + l.q) * P + 64 * tile + 32 * l.blk + 8 * l.p;
    const s16x4 lo = trrd(b), hi = trrd(b + 4 * P);
    return (bf16x8){lo[0], lo[1], lo[2], lo[3], hi[0], hi[1], hi[2], hi[3]};
}
__device__ __forceinline__ bf16x8 frag_row_perm(const LAS unsigned char* img, const Ln& l, int tile, int s, int coloff = 0) {
    const LAS unsigned char* b = img + (32 * tile + l.r) * P + (coloff + 16 * s + 4 * l.h) * 2;
    const s16x4 lo = *(const LAS s16x4*)b, hi = *(const LAS s16x4*)(b + 16);
    return (bf16x8){lo[0], lo[1], lo[2], lo[3], hi[0], hi[1], hi[2], hi[3]};
}
__device__ __forceinline__ bf16x8 frag_tr_perm(const LAS unsigned char* img, const Ln& l, int tile, int s, int rowoff = 0) {
    const LAS unsigned char* b = img + (rowoff + 16 * s + 4 * l.h + l.q) * P + 64 * tile + 32 * l.blk + 8 * l.p;
    const s16x4 lo = trrd(b), hi = trrd(b + 8 * P);
    return (bf16x8){lo[0], lo[1], lo[2], lo[3], hi[0], hi[1], hi[2], hi[3]};
}
__device__ __forceinline__ bf16x8 pack(const f32x16& x, int s) {
    u32x4 w; w.x = cvtpk(x[8 * s], x[8 * s + 1]); w.y = cvtpk(x[8 * s + 2], x[8 * s + 3]); w.z = cvtpk(x[8 * s + 4], x[8 * s + 5]); w.w = cvtpk(x[8 * s + 6], x[8 * s + 7]);
    return __builtin_bit_cast(bf16x8, w);
}
__device__ __forceinline__ void store_T(LAS unsigned char* img, const Ln& l, const f32x16& x, int ti, int tj) {
#pragma unroll
    for (int g = 0; g < 4; ++g) { u32x2 w; w.x = cvtpk(x[4 * g], x[4 * g + 1]); w.y = cvtpk(x[4 * g + 2], x[4 * g + 3]);
        *(LAS u32x2*)(img + (32 * tj + l.r) * P + (32 * ti + 8 * g + 4 * l.h) * 2) = w; }
}
__device__ __forceinline__ float xhalf(float v) { return __shfl_xor(v, 32); }
__device__ __forceinline__ void tri_inv32(f32x16& D, f32x16& DT, f32x16 S, f32x16 ST) {
    const f32x16 z = {};
#pragma unroll
    for (int it = 0; it < 4; ++it) {
        f32x16 S2 = z, S2T = z;
#pragma unroll
        for (int s = 0; s < 2; ++s) { const bf16x8 ps = pack(S, s), pst = pack(ST, s); S2 = RK_MFMA(pst, ps, S2); S2T = RK_MFMA(ps, pst, S2T); }
        f32x16 DS = S2, DST = S2T;
#pragma unroll
        for (int s = 0; s < 2; ++s) { DS = RK_MFMA(pack(DT, s), pack(S2, s), DS); DST = RK_MFMA(pack(S2, s), pack(DT, s), DST); }
        D = D + DS; DT = DT + DST; S = S2; ST = S2T;
    }
}
}

constexpr size_t DO_NT = 0, DO_MT = 128 * MiB, DO_RH = 192 * MiB;

struct R1Ctx { int item, c, h, b; int nc, nh, nb; rk::f32x16 Wt0, Wt1; unsigned bcnt; };
#ifndef MK_R1_GBAR
#define MK_R1_GBAR 0
#endif
__device__ __forceinline__ void r1_gbar(Frame& F, unsigned& cnt) {
#if MK_R1_GBAR
    int t_ = F.tid; asm volatile("" : "+v"(t_));
    LAS unsigned* ctr = (LAS unsigned*)(F.lds + (t_ >> 8) * rk::GRP + rk::MISC + 8000);
    asm volatile("s_waitcnt lgkmcnt(0)" ::: "memory");
    cnt += 4u;
    if ((t_ & 63) == 0) __hip_atomic_fetch_add(ctr, 1u, __ATOMIC_RELAXED, __HIP_MEMORY_SCOPE_WORKGROUP);
    while (__hip_atomic_load(ctr, __ATOMIC_RELAXED, __HIP_MEMORY_SCOPE_WORKGROUP) < cnt) __builtin_amdgcn_s_sleep(1);
    asm volatile("" ::: "memory");
#else
    (void)cnt; lds_barrier();
#endif
}
#define RK_RELANE() do { int t_ = F.tid; asm volatile("" : "+v"(t_)); lane = t_ & 63; tg = t_ & 255; grp = t_ >> 8; w4 = ((t_ >> 6) & 3) ^ ((t_ >> 8) << 1);   ti = w4 >> 1; tj = w4 & 1; l.r = lane & 31; l.h = lane >> 5; l.blk = (lane >> 4) & 1; l.q = (lane & 15) >> 2; l.p = lane & 3; G = F.lds + grp * GRP; } while (0)
#define RK_KA() const __attribute__((address_space(4))) Args* ka = (const __attribute__((address_space(4))) Args*)__builtin_amdgcn_kernarg_segment_ptr(); asm volatile("" : "+s"(ka))
#define s0 (G)
#define s1 (G + IMG)
#define s2 (G + 2 * IMG)
#define s3 (G + 3 * IMG)
#define s4 (G + 4 * IMG)
#define s5 (G + 5 * IMG)
#define s6 (G + 6 * IMG)
#define s7 (G + 7 * IMG)
#define nrminv ((LAS float*)(G + MISC))
#define ltot (nrminv + 64)
#define gam (nrminv + 128)
#define bonp (nrminv + 192)
#define hcst (nrminv + 384)
template <int VAR> __device__ __forceinline__ void r1_S1a_t(Frame& F, R1Ctx& X) {
    using namespace rk;
    if (VAR == 3) { int t_ = F.tid; asm volatile("" : "+v"(t_)); if ((t_ & 255) < 64) ((LAS float*)(F.lds + (t_ >> 8) * GRP + MISC))[t_ & 63] = 1.0f; return; }
    int grp, w4, ti, tj, lane, tg; Ln l; LAS unsigned char* G; const f32x16 z16 = {};
    RK_RELANE(); (void)w4; (void)tg; (void)ti; (void)tj;
    const int item = X.item, c = X.c, h = X.h, b = X.b; (void)item; (void)c; (void)h; (void)b;
    { RK_KA(); const bf16* RW = (const bf16*)(ka->ws + WS_RW); const float* mu_ = ka->in[5]; const float* kk_ = ka->in[10];
      const int t = tg >> 2, q4 = tg & 3; const int sq = c * 64 + t; const size_t row = (size_t)b * SEQ + sq;
      const bf16* cur = RW + row * RWC; const bool hasp = sq > 0; const bf16* prv = hasp ? cur - RWC : cur; const float pm = hasp ? 1.f : 0.f;
      float nr = 0.f;
      v4u cr_[2], pr_[2], ck_[2], pk_[2], cv_[2], pv_[2], cw_[2], pw_[2], ca_[2], pa_[2];
#pragma unroll
      for (int half = 0; half < 2; ++half) { const int k0 = 16 * q4 + 8 * half, col = h * HD + k0;
          if (VAR == 2) { const v4u c_ = {0x3f803f80u + (unsigned)col, 0x3f003f00u, 0x3e803e80u, 0x3f803f00u}; cr_[half] = c_; pr_[half] = c_; ck_[half] = c_; pk_[half] = c_; cv_[half] = c_; pv_[half] = c_; cw_[half] = c_; pw_[half] = c_; ca_[half] = c_; pa_[half] = c_; } else {
          cr_[half] = *(const v4u*)(cur + col); pr_[half] = *(const v4u*)(prv + col); ck_[half] = *(const v4u*)(cur + 512 + col); pk_[half] = *(const v4u*)(prv + 512 + col); cv_[half] = *(const v4u*)(cur + 1024 + col); pv_[half] = *(const v4u*)(prv + 1024 + col);
          cw_[half] = *(const v4u*)(cur + 2048 + k0); pw_[half] = *(const v4u*)(prv + 2048 + k0); ca_[half] = *(const v4u*)(cur + 2112 + k0); pa_[half] = *(const v4u*)(prv + 2112 + k0); } }
      __builtin_amdgcn_sched_barrier(0);
#pragma unroll
      for (int half = 0; half < 2; ++half) { const int k0 = 16 * q4 + 8 * half, col = h * HD + k0;
          const v4u cr = cr_[half], pr = pr_[half], ck = ck_[half], pk = pk_[half], cv = cv_[half], pv = pv_[half], cw = cw_[half], pw = pw_[half], ca = ca_[half], pa = pa_[half];
          float ro[8], ko[8], vo[8], wo[8], ao[8];
          float mr[8], mk[8], mv[8], mw[8], ma[8], kkc[8];
          { const LAS f32x4* p; f32x4 x0, x1;
#define LD8_(dst, ptr) p = (const LAS f32x4*)(ptr); x0 = p[0]; x1 = p[1]; dst[0] = x0[0]; dst[1] = x0[1]; dst[2] = x0[2]; dst[3] = x0[3]; dst[4] = x1[0]; dst[5] = x1[1]; dst[6] = x1[2]; dst[7] = x1[3]
            LD8_(mr, hcst + k0); LD8_(mk, hcst + 64 + k0); LD8_(mv, hcst + 128 + k0); LD8_(mw, hcst + 256 + k0); LD8_(ma, hcst + 320 + k0); LD8_(kkc, hcst + 384 + k0);
#undef LD8_
          }
#pragma unroll
          for (int e = 0; e < 8; ++e) { const unsigned wcr = cr[e >> 1], wpr = pr[e >> 1], wck = ck[e >> 1], wpk = pk[e >> 1], wcv = cv[e >> 1], wpv = pv[e >> 1];
              const unsigned wcw = cw[e >> 1], wpw = pw[e >> 1], wca = ca[e >> 1], wpa = pa[e >> 1];
              const float xr = (e & 1) ? bfhi(wcr) : bflo(wcr), yr = pm * ((e & 1) ? bfhi(wpr) : bflo(wpr)); ro[e] = xr + (yr - xr) * mr[e];
              const float xk = (e & 1) ? bfhi(wck) : bflo(wck), yk = pm * ((e & 1) ? bfhi(wpk) : bflo(wpk)); ko[e] = xk + (yk - xk) * mk[e];
              const float xv = (e & 1) ? bfhi(wcv) : bflo(wcv), yv = pm * ((e & 1) ? bfhi(wpv) : bflo(wpv)); vo[e] = xv + (yv - xv) * mv[e];
              const float xw = (e & 1) ? bfhi(wcw) : bflo(wcw), yw = pm * ((e & 1) ? bfhi(wpw) : bflo(wpw)); wo[e] = ftanh(xw + (yw - xw) * mw[e]);
              const float xa = (e & 1) ? bfhi(wca) : bflo(wca), ya = pm * ((e & 1) ? bfhi(wpa) : bflo(wpa)); ao[e] = xa + (ya - xa) * ma[e];
              const float kkx = ko[e] * kkc[e]; nr += kkx * kkx; }
          const int off = t * P + k0 * 2;
          *(LAS u32x4*)(s0 + off) = (u32x4){cvtpk(wo[0], wo[1]), cvtpk(wo[2], wo[3]), cvtpk(wo[4], wo[5]), cvtpk(wo[6], wo[7])};
          *(LAS u32x4*)(s1 + off) = (u32x4){cvtpk(ao[0], ao[1]), cvtpk(ao[2], ao[3]), cvtpk(ao[4], ao[5]), cvtpk(ao[6], ao[7])};
          *(LAS u32x4*)(s2 + off) = (u32x4){cvtpk(ro[0], ro[1]), cvtpk(ro[2], ro[3]), cvtpk(ro[4], ro[5]), cvtpk(ro[6], ro[7])};
          *(LAS u32x4*)(s3 + off) = (u32x4){cvtpk(ko[0], ko[1]), cvtpk(ko[2], ko[3]), cvtpk(ko[4], ko[5]), cvtpk(ko[6], ko[7])};
          const u32x4 vw = (u32x4){cvtpk(vo[0], vo[1]), cvtpk(vo[2], vo[3]), cvtpk(vo[4], vo[5]), cvtpk(vo[6], vo[7])};
          *(LAS u32x4*)(s4 + off) = vw;
          }
      nr += __shfl_xor(nr, 1); nr += __shfl_xor(nr, 2);
      if (q4 == 0) nrminv[t] = frsq(fmaxf(nr, 1e-24f)); }
}
__device__ __forceinline__ void r1_S1a(Frame& F, R1Ctx& X) { r1_S1a_t<0>(F, X); }
__device__ __forceinline__ void r1_S1b(Frame& F, R1Ctx& X) {
    using namespace rk;
    int grp, w4, ti, tj, lane, tg; Ln l; LAS unsigned char* G; const f32x16 z16 = {};
    RK_RELANE(); (void)w4; (void)tg; (void)ti; (void)tj;
    const int item = X.item, c = X.c, h = X.h, b = X.b; (void)item; (void)c; (void)h; (void)b;
    {
        RK_KA(); const bf16* WupT = (const bf16*)(ka->ws + WS_WUPT); const bf16* AupT = (const bf16*)(ka->ws + WS_AUPT);
        const int kcol = 32 * tj + l.r, kc = h * HD + kcol;
        f32x16 W = z16, Aq = z16;
#pragma unroll
        for (int s = 0; s < 4; ++s) { const bf16x8 bw = *(const bf16x8*)(WupT + (size_t)kc * 64 + 16 * s + 8 * l.h), ba = *(const bf16x8*)(AupT + (size_t)kc * 64 + 16 * s + 8 * l.h);
            W = RK_MFMA(frag_row(s0, l, ti, s), bw, W); Aq = RK_MFMA(frag_row(s1, l, ti, s), ba, Aq); }
        const float w0 = hcst[448 + kcol], a0 = hcst[512 + kcol], kkc = hcst[384 + kcol], kac = hcst[576 + kcol], rkc = hcst[640 + kcol];
        float lw[16], L[16];
#pragma unroll
        for (int r = 0; r < 16; ++r) { const float x = W[r] + w0; const float sp = (-x > 20.f) ? -x : 0.6931471805599453f * __builtin_amdgcn_logf(1.0f + fexp(-x)); lw[r] = -fexp(-sp - 0.5f); Aq[r] = sigm(Aq[r] + a0); }
        float gs[4], go[4];
#pragma unroll
        for (int g = 0; g < 4; ++g) { L[4 * g] = lw[4 * g]; L[4 * g + 1] = L[4 * g] + lw[4 * g + 1]; L[4 * g + 2] = L[4 * g + 1] + lw[4 * g + 2]; L[4 * g + 3] = L[4 * g + 2] + lw[4 * g + 3]; gs[g] = L[4 * g + 3]; }
        float run = 0.f;
#pragma unroll
        for (int g = 0; g < 4; ++g) { const float og = xhalf(gs[g]); const float lo = l.h ? og : gs[g], hi = l.h ? gs[g] : og;
            go[g] = run + (l.h ? lo : 0.f); run += lo + hi; }
#pragma unroll
        for (int r = 0; r < 16; ++r) L[r] += go[r >> 2];
        if (ti == 0 && l.h == 0) ltot[kcol] = run;
        r1_gbar(F, X.bcnt);
        if (ti == 1) { const float add = ltot[kcol];
#pragma unroll
            for (int r = 0; r < 16; ++r) L[r] += add;
            if (l.h == 1) gam[kcol] = fexp(L[15]); }
        f32x16 At, Bt, Kt, Rt; float xb[16];
#pragma unroll
        for (int r = 0; r < 16; ++r) { const int t = 32 * ti + crow(r, l.h);
            const float rr = bf2f(*(const LAS unsigned short*)(s2 + t * P + kcol * 2)), kx = bf2f(*(const LAS unsigned short*)(s3 + t * P + kcol * 2));
            const float kn = kx * kkc * nrminv[t], a = Aq[r], km = kx * (1.0f + (a - 1.0f) * kac);
            const float eL = fexp(L[r]), eLn = fexp(-L[r]), eLp = fexp(L[r] - lw[r]);
            At[r] = -kn * eLp; Bt[r] = kn * a * eLn; Kt[r] = km * eLn; Rt[r] = rr * eL; xb[r] = rr * km * rkc; }
#pragma unroll
        for (int r = 0; r < 16; ++r) xb[r] = dpp_sum32(xb[r]);
        if (l.r == 31) {
#pragma unroll
            for (int r = 0; r < 16; ++r) bonp[tj * 64 + 32 * ti + crow(r, l.h)] = xb[r]; }
        store_T(s0, l, At, ti, tj); store_T(s1, l, Bt, ti, tj); store_T(s5, l, Kt, ti, tj); store_T(s6, l, Rt, ti, tj);
    }
}
__device__ __forceinline__ void r1_S2(Frame& F, R1Ctx& X) {
    using namespace rk;
    int grp, w4, ti, tj, lane, tg; Ln l; LAS unsigned char* G; const f32x16 z16 = {};
    RK_RELANE(); (void)w4; (void)tg; (void)ti; (void)tj;
    const int item = X.item, c = X.c, h = X.h, b = X.b; (void)item; (void)c; (void)h; (void)b;
    unsigned pf0 = 0u, pf1 = 0u;
    if (X.nb >= 0) { RK_KA(); const bf16* RW = (const bf16*)(ka->ws + WS_RW);
        { const int j = tg; const int rr = j / 6, pc = j % 6; const long sq = (long)X.nb * SEQ + X.nc * 64 + rr - 1;
          if (sq >= (long)X.nb * SEQ) pf0 = *(const volatile unsigned char*)(RW + (size_t)sq * RWC + (pc < 4 ? pc * 512 + X.nh * HD : 2048 + (pc - 4) * 64)); }
        { const int j = tg + 256; const int rr = j / 6, pc = j % 6; const long sq = (long)X.nb * SEQ + X.nc * 64 + rr - 1;
          if (j < 65 * 6) pf1 = *(const volatile unsigned char*)(RW + (size_t)sq * RWC + (pc < 4 ? pc * 512 + X.nh * HD : 2048 + (pc - 4) * 64)); } }
    {
        f32x16 X = z16;
        if (ti >= tj) {
#pragma unroll
            for (int s = 0; s < 4; ++s) X = RK_MFMA(frag_tr(s0, l, ti, s), frag_tr(s5, l, tj, s), X);
#pragma unroll
            for (int r = 0; r < 16; ++r) { const int t = 32 * ti + crow(r, l.h), i = 32 * tj + l.r; if (!(t > i)) X[r] = 0.f; } }
        store_T(s2, l, X, ti, tj);
        if (w4 == 0 || w4 == 3) { const int d = w4 == 3;
            f32x16 S = z16, ST = z16;
#pragma unroll
            for (int s = 0; s < 4; ++s) { const bf16x8 fa = frag_tr(s0, l, d, s), fb = frag_tr(s1, l, d, s); S = RK_MFMA(fa, fb, S); ST = RK_MFMA(fb, fa, ST); }
#pragma unroll
            for (int r = 0; r < 16; ++r) { const int rw = crow(r, l.h); if (!(rw > l.r)) S[r] = 0.f; if (!(l.r > rw)) ST[r] = 0.f; }
            f32x16 D = S, DT = ST;
            tri_inv32(D, DT, S, ST);
            store_T(s7, l, D, d, d);
            asm volatile("s_waitcnt lgkmcnt(0)" ::: "memory");
            if (l.h == 0) *(LAS unsigned short*)(s7 + (32 * d + l.r) * P + (32 * d + l.r) * 2) = 0x3f80;
        } else if (w4 == 2) {
            f32x16 X21 = z16;
#pragma unroll
            for (int s = 0; s < 4; ++s) X21 = RK_MFMA(frag_tr(s0, l, 1, s), frag_tr(s1, l, 0, s), X21);
            store_T(s3, l, X21, 0, 0);
        } else {
            store_T(s7, l, z16, 0, 1);
            { RK_KA(); float* BON = (float*)(ka->ws + WS_BON); const int t = lane; BON[((size_t)b * SEQ + c * 64 + t) * NH + h] = bonp[t] + bonp[64 + t]; }
        }
    }
    asm volatile("" :: "v"(pf0), "v"(pf1));
}
__device__ __forceinline__ void r1_S3(Frame& F, R1Ctx& X) {
    using namespace rk;
    int grp, w4, ti, tj, lane, tg; Ln l; LAS unsigned char* G; const f32x16 z16 = {};
    RK_RELANE(); (void)w4; (void)tg; (void)ti; (void)tj;
    const int item = X.item, c = X.c, h = X.h, b = X.b; (void)item; (void)c; (void)h; (void)b;
    f32x16& Wt0 = X.Wt0; f32x16& Wt1 = X.Wt1;
    Wt0 = z16; Wt1 = z16;
    {
        if (w4 == 2) {
            f32x16 E = z16;
#pragma unroll
            for (int s = 0; s < 2; ++s) E = RK_MFMA(frag_tr(s3, l, 0, s), frag_row(s7, l, 0, s), E);
            store_T(s3, l, E, 0, 1);
            f32x16 T21 = z16;
#pragma unroll
            for (int s = 0; s < 2; ++s) T21 = RK_MFMA(frag_tr(s7, l, 1, s, 32), frag_row(s3, l, 1, s), T21);
            store_T(s7, l, T21, 1, 0);
        }
#pragma unroll
        for (int s = 0; s < 4; ++s) Wt0 = RK_MFMA(frag_tr(s2, l, 0, s), frag_tr(s4, l, tj, s), Wt0);
        if (ti == 1) {
#pragma unroll
            for (int s = 0; s < 4; ++s) Wt1 = RK_MFMA(frag_tr(s2, l, 1, s), frag_tr(s4, l, tj, s), Wt1); }
    }
}
__device__ __forceinline__ void r1_S4(Frame& F, R1Ctx& X) {
    using namespace rk;
    int grp, w4, ti, tj, lane, tg; Ln l; LAS unsigned char* G; const f32x16 z16 = {};
    RK_RELANE(); (void)w4; (void)tg; (void)ti; (void)tj;
    const int item = X.item, c = X.c, h = X.h, b = X.b; (void)item; (void)c; (void)h; (void)b;
    f32x16& Wt0 = X.Wt0; f32x16& Wt1 = X.Wt1;
    {
        f32x16 Ap = z16;
#pragma unroll
        for (int s = 0; s < 4; ++s) if (s < 2 || ti == 1) Ap = RK_MFMA(frag_tr(s7, l, ti, s), frag_row(s0, l, tj, s), Ap);
        f32x16 Uv = z16;
#pragma unroll
        for (int s = 0; s < 2; ++s) Uv = RK_MFMA(frag_tr_perm(s7, l, ti, s, 0), pack(Wt0, s), Uv);
        if (ti == 1) {
#pragma unroll
            for (int s = 0; s < 2; ++s) Uv = RK_MFMA(frag_tr_perm(s7, l, ti, s, 32), pack(Wt1, s), Uv); }
        store_T(s2, l, Ap, ti, tj); store_T(s3, l, Uv, ti, tj);
    }
}
#ifndef MK_R1_STNT
#define MK_R1_STNT 1
#endif
#if MK_R1_STNT
#define R1_ST(p, v) __builtin_nontemporal_store((v), (p))
#else
#define R1_ST(p, v) (*(p) = (v))
#endif
#ifndef MK_R1_STNT2
#define MK_R1_STNT2 0
#endif
#if MK_R1_STNT2
#define R1_ST2(p, v) __builtin_nontemporal_store((v), (p))
#else
#define R1_ST2(p, v) (*(p) = (v))
#endif
#ifndef MK_S5_WIDE
#define MK_S5_WIDE 0
#endif
#define S5_WIDE_STORE(DST, IMG) do { asm volatile("s_waitcnt lgkmcnt(0)" ::: "memory"); store_T(IMG, l, acc, ti, tj); asm volatile("s_waitcnt lgkmcnt(0)" ::: "memory"); \
    _Pragma("unroll") for (int s_ = 0; s_ < 2; ++s_) { const bf16x8 fr_ = frag_tr(IMG, l, ti, s_, 32 * tj); *(bf16x8*)(DST + ib + (32 * ti + l.r) * 64 + 32 * tj + 16 * s_ + 8 * l.h) = fr_; } } while (0)
__device__ __forceinline__ void r1_S5(Frame& F, R1Ctx& X) {
    using namespace rk;
    int grp, w4, ti, tj, lane, tg; Ln l; LAS unsigned char* G; const f32x16 z16 = {};
    RK_RELANE(); (void)w4; (void)tg; (void)ti; (void)tj;
    const int item = X.item, c = X.c, h = X.h, b = X.b; (void)item; (void)c; (void)h; (void)b;
    {
        RK_KA(); float* NT = (float*)((unsigned char*)ka->out + DO_NT); bf16* MT = (bf16*)((unsigned char*)ka->out + DO_MT); bf16* RH = (bf16*)((unsigned char*)ka->out + DO_RH); bf16* Y0 = (bf16*)(ka->ws + WS_GATE);
        const size_t ib = (size_t)((b * 64 + c) * NH + h) * 4096;
        f32x16 Xrb0 = z16, Xrk0 = z16, Xrb1 = z16, Xrk1 = z16;
#pragma unroll
        for (int s = 0; s < 4; ++s) { const bf16x8 fr = frag_tr(s6, l, ti, s); Xrb0 = RK_MFMA(frag_tr(s1, l, 0, s), fr, Xrb0); Xrk0 = RK_MFMA(frag_tr(s5, l, 0, s), fr, Xrk0); }
        if (ti == 1) {
#pragma unroll
            for (int s = 0; s < 4; ++s) { const bf16x8 fr = frag_tr(s6, l, ti, s); Xrb1 = RK_MFMA(frag_tr(s1, l, 1, s), fr, Xrb1); Xrk1 = RK_MFMA(frag_tr(s5, l, 1, s), fr, Xrk1); } }
#pragma unroll
        for (int r = 0; r < 16; ++r) { const bool keep = crow(r, l.h) <= l.r; if (ti == 0) { if (!keep) { Xrb0[r] = 0.f; Xrk0[r] = 0.f; } } else { if (!keep) { Xrb1[r] = 0.f; Xrk1[r] = 0.f; } } }
        f32x16 acc;
#pragma unroll
        for (int g = 0; g < 4; ++g) { const u32x2 w = *(const LAS u32x2*)(s6 + (32 * tj + l.r) * P + (32 * ti + 8 * g + 4 * l.h) * 2); acc[4 * g] = bflo(w.x); acc[4 * g + 1] = bfhi(w.x); acc[4 * g + 2] = bflo(w.y); acc[4 * g + 3] = bfhi(w.y); }
#pragma unroll
        for (int s = 0; s < 2; ++s) acc = RK_MFMA(pack(Xrb0, s), frag_row_perm(s2, l, tj, s, 0), acc);
        if (ti == 1) {
#pragma unroll
            for (int s = 0; s < 2; ++s) acc = RK_MFMA(pack(Xrb1, s), frag_row_perm(s2, l, tj, s, 32), acc); }
#if MK_S5_WIDE
        S5_WIDE_STORE(RH, s0);
#else
#pragma unroll
        for (int r = 0; r < 16; ++r) R1_ST2(RH + ib + (32 * ti + crow(r, l.h)) * 64 + 32 * tj + l.r, (bf16)f2bf(acc[r]));
#endif
        acc = z16;
#pragma unroll
        for (int s = 0; s < 2; ++s) { acc = RK_MFMA(pack(Xrb0, s), frag_row_perm(s3, l, tj, s, 0), acc); acc = RK_MFMA(pack(Xrk0, s), frag_tr_perm(s4, l, tj, s, 0), acc); }
        if (ti == 1) {
#pragma unroll
            for (int s = 0; s < 2; ++s) { acc = RK_MFMA(pack(Xrb1, s), frag_row_perm(s3, l, tj, s, 32), acc); acc = RK_MFMA(pack(Xrk1, s), frag_tr_perm(s4, l, tj, s, 32), acc); } }
#if MK_S5_WIDE
        S5_WIDE_STORE(Y0, s7);
#else
#pragma unroll
        for (int r = 0; r < 16; ++r) R1_ST2(Y0 + ib + (32 * ti + crow(r, l.h)) * 64 + 32 * tj + l.r, (bf16)f2bf(acc[r]));
#endif
        acc = z16;
#pragma unroll
        for (int s = 0; s < 4; ++s) acc = RK_MFMA(frag_row(s1, l, ti, s), frag_row(s2, l, tj, s), acc);
#pragma unroll
        for (int r = 0; r < 16; ++r) { const int kp = 32 * ti + crow(r, l.h), k = 32 * tj + l.r; const float v = (acc[r] + (kp == k ? 1.f : 0.f)) * gam[kp]; R1_ST2(MT + ib + kp * 64 + k, (bf16)f2bf(v)); }
        acc = z16;
#pragma unroll
        for (int s = 0; s < 4; ++s) { acc = RK_MFMA(frag_row(s1, l, ti, s), frag_row(s3, l, tj, s), acc); acc = RK_MFMA(frag_row(s5, l, ti, s), frag_tr(s4, l, tj, s), acc); }
#pragma unroll
        for (int r = 0; r < 16; ++r) R1_ST(NT + ib + ((ti * 2 + tj) * 16 + r) * 64 + lane, acc[r] * gam[32 * ti + crow(r, l.h)]);
    }
}
__device__ __forceinline__ void r1_consts(Frame& F, int h) {
    using namespace rk;
    int t_ = F.tid; asm volatile("" : "+v"(t_)); const int grp = t_ >> 8, tg = t_ & 255; LAS unsigned char* G = F.lds + grp * GRP;
    for (int i = tg; i < 11 * 64; i += 256) { const int a = i >> 6, k = i & 63, col = h * HD + k; float v;
        switch (a) { case 0: v = F.mu[col]; break; case 1: v = F.mu[512 + col]; break; case 2: v = F.mu[1024 + col]; break; case 3: v = F.mu[1536 + col]; break; case 4: v = F.mu[2048 + k]; break; case 5: v = F.mu[2112 + k]; break;
                     case 6: v = F.k_k[col]; break; case 7: v = F.w0[col]; break; case 8: v = F.a0[col]; break; case 9: v = F.k_a[col]; break; default: v = F.r_k[col]; break; }
        hcst[i] = v; }
}
#ifndef MK_R1_REP
#define MK_R1_REP -1
#endif
__device__ __forceinline__ void rwkv_chunk_ops(Frame& F) {
    R1Ctx X; int cur_h = -1; X.bcnt = 0u; bool first = true;
    { int t_ = F.tid; asm volatile("" : "+v"(t_)); if ((t_ & 255) == 0) *(LAS unsigned*)(F.lds + (t_ >> 8) * rk::GRP + rk::MISC + 8000) = 0u; }
    __syncthreads();
    for (int ip = F.vcu; ip < BATCH * NH * 64 / 2; ip += F.G) {
        { const int hh = ((ip * 2) >> 6) % NH; if (hh != cur_h) { r1_consts(F, hh); cur_h = hh; __syncthreads(); } }
#if MK_R1_GBAR
        if (first) { first = false; if (F.wave >= 4) { for (int i_ = 0; i_ < MK_R1_GBAR * 3; ++i_) __builtin_amdgcn_s_sleep(127); } }
#endif
        { int t_ = F.tid; asm volatile("" : "+v"(t_)); const int grp = t_ >> 8; X.item = ip * 2 + grp; X.c = X.item & 63; const int bh = X.item >> 6; X.h = bh % NH; X.b = bh / NH;
          const int nit = (ip + F.G) * 2 + grp; const int nbh = nit >> 6; X.nc = nit & 63; X.nh = nbh % NH; X.nb = (ip + F.G < BATCH * NH * 64 / 2) ? nbh / NH : -1; }
        r1_S1a(F, X); r1_gbar(F, X.bcnt);
        if constexpr (MK_R1_REP == 0) { r1_S1a(F, X); r1_gbar(F, X.bcnt); }
        r1_S1b(F, X); r1_gbar(F, X.bcnt);
        if constexpr (MK_R1_REP == 1) { r1_S1a(F, X); r1_gbar(F, X.bcnt); r1_S1b(F, X); r1_gbar(F, X.bcnt); }
        r1_S2(F, X); r1_gbar(F, X.bcnt);
        if constexpr (MK_R1_REP == 2) { r1_S2(F, X); r1_gbar(F, X.bcnt); }
        r1_S3(F, X); r1_gbar(F, X.bcnt);
        r1_S4(F, X); r1_gbar(F, X.bcnt);
        r1_S5(F, X); r1_gbar(F, X.bcnt);
        if constexpr (MK_R1_REP == 5) { r1_S5(F, X); r1_gbar(F, X.bcnt); }
    }
}
#undef s0
#undef s1
#undef s2
#undef s3
#undef s4
#undef s5
#undef s6
#undef s7
#undef nrminv
#undef ltot
#undef gam
#undef bonp
#undef hcst
__device__ __forceinline__ void rwkv_relay(Frame& F) {
    using namespace rk;
    const int lane = F.lane, wid = F.wave; const int lr = lane & 31, lh = lane >> 5;
    LAS float* sbuf = (LAS float*)F.lds; volatile LAS int* flag = (volatile LAS int*)(F.lds + 16384);
    const float* NT = (const float*)((unsigned char*)F.out + DO_NT); bf16* MT = (bf16*)((unsigned char*)F.out + DO_MT);
    for (int ch = F.vcu; ch < BATCH * NH * 2; ch += F.G) {
        const int bh = ch >> 1, ct = ch & 1;
        __syncthreads();
        for (int i = F.tid; i < 2048; i += NTHR) sbuf[i] = 0.f;
        if (F.tid == 0) flag[0] = 0;
        __syncthreads();
        for (int c = wid; c < 64; c += NWAVES) {
            const size_t ib = (size_t)(((bh >> 3) * 64 + c) * NH + (bh & 7)) * 4096;
            bf16x8 am[2][4]; f32x16 sn[2];
#pragma unroll
            for (int rt = 0; rt < 2; ++rt)
#pragma unroll
                for (int s = 0; s < 4; ++s) { const bf16* pm = MT + ib + (32 * rt + lr) * 64 + 16 * s + 4 * lh;
                    const v2u m0 = *(const v2u*)pm, m1 = *(const v2u*)(pm + 8);
                    am[rt][s] = __builtin_bit_cast(bf16x8, (u32x4){m0.x, m0.y, m1.x, m1.y}); }
#pragma unroll
            for (int rt = 0; rt < 2; ++rt)
#pragma unroll
                for (int r = 0; r < 16; ++r) sn[rt][r] = NT[ib + ((rt * 2 + ct) * 16 + r) * 64 + lane];
            while (flag[0] < c) __builtin_amdgcn_s_sleep(1);
            asm volatile("s_waitcnt lgkmcnt(0)" ::: "memory");
            const LAS float* sin = sbuf + (c & 1) * 2048; LAS float* sout = sbuf + ((c + 1) & 1) * 2048;
            bf16x8 sp[2][2];
#pragma unroll
            for (int kt = 0; kt < 2; ++kt) { f32x16 sv;
#pragma unroll
                for (int r = 0; r < 16; ++r) sv[r] = sin[(kt * 16 + r) * 64 + lane];
                sp[kt][0] = pack(sv, 0); sp[kt][1] = pack(sv, 1); }
#pragma unroll
            for (int s = 0; s < 4; ++s)
#pragma unroll
                for (int rt = 0; rt < 2; ++rt) sn[rt] = RK_MFMA(am[rt][s], sp[s >> 1][s & 1], sn[rt]);
#pragma unroll
            for (int rt = 0; rt < 2; ++rt)
#pragma unroll
                for (int r = 0; r < 16; ++r) sout[(rt * 16 + r) * 64 + lane] = sn[rt][r];
            asm volatile("s_waitcnt lgkmcnt(0)" ::: "memory");
            if (lane == 0) flag[0] = c + 1;
            bf16* sc = (bf16*)(F.ws + WS_SC) + ib;
#pragma unroll
            for (int kt = 0; kt < 2; ++kt)
#pragma unroll
                for (int sl = 0; sl < 2; ++sl) R1_ST((bf16x8*)(sc + (((kt * 2 + ct) * 2 + sl) * 64 + lane) * 8), sp[kt][sl]);
        }
    }
}

#ifndef MK_R2B_NT
#define MK_R2B_NT 0
#endif
#if MK_R2B_NT
#define R2B_LD(p) __builtin_nontemporal_load(p)
#else
#define R2B_LD(p) (*(p))
#endif
#ifndef MK_R2B_STNT
#define MK_R2B_STNT 1
#endif
#if MK_R2B_STNT
#define R2B_ST(p, v) __builtin_nontemporal_store((v), (p))
#else
#define R2B_ST(p, v) (*(p) = (v))
#endif
struct R2Tile { v4u y0[4], cv[4], pv[4], cz[4], pz[4]; float bon, pm; };
__device__ __forceinline__ void r2_load_tile(R2Tile& T, const bf16* Y0, const bf16* RW, const float* BON, size_t ib, int b, int h, int c, int tt, int lane) {
    const int q = lane >> 1, c0 = (lane & 1) * 32; const int sq = c * 64 + tt * 32 + q; const size_t row = (size_t)b * SEQ + sq;
    const v4u* y0p = (const v4u*)(Y0 + ib + (tt * 32 + q) * 64 + c0);
    const bf16* cur = RW + row * RWC + h * HD + c0; const bool hasp = sq > 0; const bf16* prv = hasp ? cur - RWC : cur; T.pm = hasp ? 1.f : 0.f;
#pragma unroll
    for (int i = 0; i < 4; ++i) { T.y0[i] = R2B_LD(y0p + i); T.cv[i] = *((const v4u*)(cur + 1024) + i); T.pv[i] = *((const v4u*)(prv + 1024) + i); T.cz[i] = *((const v4u*)(cur + 1536) + i); T.pz[i] = *((const v4u*)(prv + 1536) + i); }
    T.bon = BON[row * NH + h];
}
__device__ __forceinline__ void rwkv_output(Frame& F) {
    using namespace rk;
    const int wid = F.wave;
    LAS float* yst = (LAS float*)(F.lds + wid * 8704); LAS float* cst = (LAS float*)(F.lds + 69632);
    bf16* QKVZ = (bf16*)(F.ws + WS_QKVZ); const bf16* RW = (const bf16*)(F.ws + WS_RW);
    const bf16* SC = (const bf16*)(F.ws + WS_SC); const bf16* RH = (const bf16*)((unsigned char*)F.out + DO_RH);
    const bf16* Y0 = (const bf16*)(F.ws + WS_GATE); const float* BON = (const float*)(F.ws + WS_BON);
    __syncthreads();
    for (int i = F.tid; i < 4 * 512; i += NTHR) { const int a = i >> 9, col = i & 511; cst[i] = a == 0 ? F.ln_w[col] : a == 1 ? F.ln_b[col] : a == 2 ? F.mu[1024 + col] : F.mu[1536 + col]; }
    __syncthreads();
    const int gw = F.vcu * NWAVES + wid, NGW = F.G * NWAVES;
    for (int idx = gw; idx < BATCH * NH * 64; idx += NGW) {
        const int h = idx & 7, c = (idx >> 3) & 63, b = idx >> 9; const size_t ib = (size_t)idx * 4096;
        bf16x8 sp[2][2][2];
        { const int lane = F.lane;
#pragma unroll
          for (int kt = 0; kt < 2; ++kt)
#pragma unroll
              for (int ct = 0; ct < 2; ++ct)
#pragma unroll
                  for (int sl = 0; sl < 2; ++sl) sp[kt][ct][sl] = R2B_LD((const bf16x8*)(SC + ib + (((kt * 2 + ct) * 2 + sl) * 64 + lane) * 8)); }
#pragma unroll 1
        for (int tt = 0; tt < 2; ++tt) {
            int lane_ = F.tid; asm volatile("" : "+v"(lane_)); const int lane = lane_ & 63, lr = lane & 31, lh = lane >> 5;
            bf16x8 ar[4];
#pragma unroll
            for (int s = 0; s < 4; ++s) { const bf16* pr = RH + ib + (32 * tt + lr) * 64 + 16 * s + 4 * lh; const v2u r0 = R2B_LD((const v2u*)pr), r1 = R2B_LD((const v2u*)(pr + 8));
                ar[s] = __builtin_bit_cast(bf16x8, (u32x4){r0.x, r0.y, r1.x, r1.y}); }
            R2Tile T; r2_load_tile(T, Y0, RW, BON, ib, b, h, c, tt, lane);
            f32x16 y0 = {}, y1 = {};
#ifndef MK_R2B_X
#define MK_R2B_X 0
#endif
#pragma unroll 1
            for (int rep2 = 0; rep2 < (MK_R2B_X == 2 ? 4 : 1); ++rep2) {
            y0 = f32x16{}; y1 = f32x16{};
#pragma unroll
            for (int s = 0; s < 4; ++s) { y0 = RK_MFMA(ar[s], sp[s >> 1][0][s & 1], y0); y1 = RK_MFMA(ar[s], sp[s >> 1][1][s & 1], y1); }
#pragma unroll
            for (int r = 0; r < 16; ++r) { yst[crow(r, lh) * 68 + lr] = y0[r]; yst[crow(r, lh) * 68 + 32 + lr] = y1[r]; }
            asm volatile("s_waitcnt lgkmcnt(0)" ::: "memory"); }
            const int q = lane >> 1, c0 = (lane & 1) * 32; const int sq = c * 64 + tt * 32 + q; const size_t row = (size_t)b * SEQ + sq;
            const LAS float* cs = cst + h * HD + c0;
            float y[32];
#pragma unroll 1
            for (int rep1 = 0; rep1 < (MK_R2B_X == 1 ? 4 : 1); ++rep1) {
#pragma unroll
            for (int e = 0; e < 32; e += 8) { const f32x4 a = *(const LAS f32x4*)(yst + q * 68 + c0 + e), bq = *(const LAS f32x4*)(yst + q * 68 + c0 + e + 4); const v4u w = T.y0[e >> 3];
                y[e] = a[0] + bflo(w.x); y[e + 1] = a[1] + bfhi(w.x); y[e + 2] = a[2] + bflo(w.y); y[e + 3] = a[3] + bfhi(w.y); y[e + 4] = bq[0] + bflo(w.z); y[e + 5] = bq[1] + bfhi(w.z); y[e + 6] = bq[2] + bflo(w.w); y[e + 7] = bq[3] + bfhi(w.w); }
            float sm = 0.f;
#pragma unroll
            for (int e = 0; e < 32; ++e) sm += y[e];
            sm += __shfl_xor(sm, 1); const float mean = sm * (1.f / 64.f);
            float sv = 0.f;
#pragma unroll
            for (int e = 0; e < 32; ++e) { const float d = y[e] - mean; sv += d * d; }
            sv += __shfl_xor(sv, 1); const float rstd = frsq(sv * (1.f / 64.f) + GN_EPS);
            const float bon = T.bon;
#pragma unroll
            for (int e = 0; e < 32; e += 8) { const v4u cvw = T.cv[e >> 3], pvw = T.pv[e >> 3], czw = T.cz[e >> 3], pzw = T.pz[e >> 3];
                float o[8];
#pragma unroll
                for (int j4 = 0; j4 < 8; j4 += 4) {
                    const f32x4 lw = *(const LAS f32x4*)(cs + e + j4), lb = *(const LAS f32x4*)(cs + 512 + e + j4), mv = *(const LAS f32x4*)(cs + 1024 + e + j4), mz = *(const LAS f32x4*)(cs + 1536 + e + j4);
#pragma unroll
                    for (int jj = 0; jj < 4; ++jj) { const int j = j4 + jj; const unsigned wcv = cvw[j >> 1], wpv = pvw[j >> 1], wcz = czw[j >> 1], wpz = pzw[j >> 1];
                        const float xv = (j & 1) ? bfhi(wcv) : bflo(wcv), yv = T.pm * ((j & 1) ? bfhi(wpv) : bflo(wpv)), xz = (j & 1) ? bfhi(wcz) : bflo(wcz), yz = T.pm * ((j & 1) ? bfhi(wpz) : bflo(wpz));
                        const float vv = xv + (yv - xv) * mv[jj], zz = xz + (yz - xz) * mz[jj];
                        o[j] = ((y[e + j] - mean) * rstd * lw[jj] + lb[jj] + bon * vv) * (zz * sigm(zz)); }
                    __builtin_amdgcn_sched_barrier(0); }
                *(LAS v4u*)((LAS bf16*)yst + q * 72 + c0 + e) = (v4u){pk2(o[0], o[1]), pk2(o[2], o[3]), pk2(o[4], o[5]), pk2(o[6], o[7])}; }
            asm volatile("s_waitcnt lgkmcnt(0)" ::: "memory");
#pragma unroll
            for (int i = 0; i < 4; ++i) { const int rr = i * 8 + (lane >> 3), chk = lane & 7; const v4u w = *(const LAS v4u*)((LAS bf16*)yst + rr * 72 + chk * 8);
                R2B_ST((v4u*)(QKVZ + ((size_t)b * SEQ + c * 64 + tt * 32 + rr) * QP + 512 + h * HD + chk * 8), w); }
            asm volatile("s_waitcnt lgkmcnt(0)" ::: "memory"); }
        }
    }
}
#define BAR_ST ((volatile LAS unsigned*)(F.lds + 163832))
constexpr int LDS_BYTES = 163840;
constexpr int NPHASE = 13;

template <int PLO, int PHI> __global__ void __launch_bounds__(NTHR, 2) fwd(Args args) {
    extern __shared__ __attribute__((aligned(16))) unsigned char lds[];
    Frame F;
    F.lds = (LAS unsigned char*)lds;
#define RETID() do { int t_ = threadIdx.x; asm volatile("" : "+v"(t_)); F.tid = t_; F.lane = t_ & 63; F.wave = __builtin_amdgcn_readfirstlane(t_ >> 6); \
    int bx_ = blockIdx.x, g_ = gridDim.x; asm volatile("" : "+s"(bx_), "+s"(g_)); F.G = g_; F.vcu = (g_ % 8 == 0) ? (bx_ % 8) * (g_ / 8) + bx_ / 8 : bx_; } while (0)
    RETID();
    if (threadIdx.x == 0) { BAR_ST[0] = 0u; BAR_ST[1] = 0u; }
    if constexpr (PHI - PLO > 1) xcd_barrier_post((unsigned*)(args.ws + WS_BAR));
    if (args.ph_hi == 0x7fffffff) cg::this_grid().sync();
#define LOADF() do { const __attribute__((address_space(4))) Args* ap_ = (const __attribute__((address_space(4))) Args*)__builtin_amdgcn_kernarg_segment_ptr(); asm volatile("" : "+s"(ap_)); \
    F.x = ap_->in[0]; F.p = ap_->in[1]; F.g_pre = ap_->in[2]; F.w_in = ap_->in[3]; F.rel_bias = ap_->in[4]; F.mu = ap_->in[5]; F.w0 = ap_->in[6]; F.w_up = ap_->in[7]; \
    F.a0 = ap_->in[8]; F.a_up = ap_->in[9]; F.k_k = ap_->in[10]; F.k_a = ap_->in[11]; F.r_k = ap_->in[12]; F.ln_w = ap_->in[13]; F.ln_b = ap_->in[14]; \
    F.p_a = ap_->in[15]; F.p_b = ap_->in[16]; F.w_out = ap_->in[17]; F.g_post = ap_->in[18]; F.w_pu = ap_->in[19]; F.w_pg = ap_->in[20]; F.out = ap_->out; F.ws = ap_->ws; ws = F.ws; \
    U2 = (pg8::bf16_t*)F.out; MERGED = (pg8::bf16_t*)(ws + WS_RW); QKVZ = (pg8::bf16_t*)(ws + WS_QKVZ); RWb = (pg8::bf16_t*)(ws + WS_RW); GAB = (pg8::bf16_t*)(ws + WS_GAB); } while (0)
    unsigned char* ws; pg8::bf16_t *U2, *MERGED, *QKVZ, *RWb, *GAB;
    constexpr int lo = PLO, hi = PHI;
    cg::grid_group grid = cg::this_grid();
#define IN(k) (lo <= (k) && (k) < hi)
#define GRIDBAR() do { const __attribute__((address_space(4))) Args* apb_ = (const __attribute__((address_space(4))) Args*)__builtin_amdgcn_kernarg_segment_ptr(); asm volatile("" : "+s"(apb_)); \
    xcd_barrier((unsigned*)(apb_->ws + WS_BAR), BAR_ST); } while (0)
#define SEAM(k) do { if constexpr (IN(k) && IN((k) + 1)) GRIDBAR(); } while (0)
#ifndef MK_REPEAT_PHASE
#define MK_REPEAT_PHASE -1
#endif
#define NREP(k) (((k) == MK_REPEAT_PHASE) ? 2 : 1)
#ifndef MK_STAGM
#define MK_STAGM 3
#endif
#define STAGGER(steps) do { const int d_ = (F.vcu & MK_STAGM) * (steps); for (int i_ = 0; i_ < d_; ++i_) __builtin_amdgcn_s_sleep(107); } while (0)
#ifndef MK_SELFUSE
#define MK_SELFUSE 0
#endif
#ifndef MK_STAG4
#define MK_STAG4 0
#endif
#ifndef MK_STAG5
#define MK_STAG5 0
#endif
#ifndef MK_STAG7
#define MK_STAG7 0
#endif

#define P0SEQ() do { RETID(); LOADF(); p0_xpass(F); pro_side(F, 0, F.vcu * NWAVES + F.wave, F.G * NWAVES, F.vcu * NTHR + F.tid, F.G * NTHR); GRIDBAR(); \
    RETID(); LOADF(); p0_kmean(F); GRIDBAR(); RETID(); LOADF(); p0_gvec(F); } while (0)
    if constexpr (IN(0)) { P0SEQ(); if constexpr (0 == MK_REPEAT_PHASE) { GRIDBAR(); P0SEQ(); } } SEAM(0);
#ifdef MK_BWTEST
    if constexpr (IN(1)) { RETID(); LOADF();
        const f32x4* xp = (const f32x4*)F.x; f32x4 acc = {0.f, 0.f, 0.f, 0.f};
        const int gw = F.vcu * NWAVES + F.wave, NGW = F.G * NWAVES;
        if (MK_BWTEST == 1) { const size_t n4 = (size_t)M * DM / 4;
            for (size_t i = (size_t)F.vcu * NTHR + F.tid; i + (size_t)31 * F.G * NTHR < n4; i += (size_t)32 * F.G * NTHR) { f32x4 t[32];
#pragma unroll
                for (int j = 0; j < 32; ++j) t[j] = xp[i + (size_t)j * F.G * NTHR];
#pragma unroll
                for (int j = 0; j < 32; ++j) acc += t[j]; }
        } else {
            for (int it = gw; it < (M / 32) * 8; it += NGW) { const int rg = it >> 3, cb = it & 7; const int q = F.lane >> 1, hf = F.lane & 1;
                const f32x4* p = xp + ((size_t)(rg * 32 + q) * DM + cb * 128 + hf * 64) / 4; f32x4 t[16];
#pragma unroll
                for (int j = 0; j < 16; ++j) t[j] = p[j];
#pragma unroll
                for (int j = 0; j < 16; ++j) acc += t[j]; } }
        if (acc[0] + acc[1] + acc[2] + acc[3] == 1.2345e30f) ((float*)(ws + WS_RSY))[F.tid] = acc[0];
        grid.sync(); }
#endif
    if constexpr (IN(1)) { RETID(); LOADF();
#ifndef MK_STAG1
#define MK_STAG1 2
#endif
        STAGGER(MK_STAG1);
#ifndef MK_WMAJOR
#define MK_WMAJOR 0
#endif
#if MK_WMAJOR
#define INPROJ_ORDER pg8::WeightMajorOrder
#else
#define INPROJ_ORDER pg8::StaticOrder
#endif
        { pg8::Gemm g{U2, (const pg8::bf16_t*)(ws + WS_WIN), M, INCP, DM, 2048, WINP, 0, 0}; INPROJ_ORDER S; S.init(M, INCP, F.G, (int)blockIdx.x);
          pg8::EpiCols E{QKVZ, RWb, GAB, QSCALE};
#ifdef MK_LDA_TEST
          { pg8::Gemm g2 = g; g2.lda = MK_LDA_TEST; pg8::gemm_phase<pg8::EpiCols, INPROJ_ORDER, true, true>(F.lds, g2, S, E); __syncthreads(); }
#endif
          pg8::gemm_phase<pg8::EpiCols, INPROJ_ORDER, true, true>(F.lds, g, S, E);
          if constexpr (MK_REPEAT_PHASE == 101) { __syncthreads(); pg8::gemm_phase<pg8::EpiCols, INPROJ_ORDER, true, true>(F.lds, g, S, E); } }
        { pg8::Gemm g{U2, (const pg8::bf16_t*)(ws + WS_WG), M, 256, 2048, 2048, 2048, 16, (size_t)256 * 2048}; pg8::StaticOrder S; S.init(M, 256, F.G, (int)blockIdx.x);
          pg8::EpiGate E{(float*)(ws + WS_GATE)};
          pg8::gemm_phase<pg8::EpiGate, pg8::StaticOrder, true, true>(F.lds, g, S, E);
          if constexpr (MK_REPEAT_PHASE == 102) { __syncthreads(); pg8::gemm_phase<pg8::EpiGate, pg8::StaticOrder, true, true>(F.lds, g, S, E); }
#if MK_SELFUSE
          __syncthreads();
          { pg8::Unit u; for (int i = 0; S.next(i, u); ++i) { RETID(); attn_select(F, (const float*)(ws + WS_GATE), (unsigned*)(ws + WS_CNT), (unsigned short*)(ws + WS_LISTS), u.pm); } }
#endif
        }
    } SEAM(1);
#ifdef MK_SYNCTEST
    for (int i_ = 0; i_ < 20; ++i_) GRIDBAR();
#endif
#if !MK_SELFUSE
    if constexpr (IN(2)) { RETID(); LOADF(); attn_select(F, (const float*)(ws + WS_GATE), (unsigned*)(ws + WS_CNT), (unsigned short*)(ws + WS_LISTS));
        if constexpr (2 == MK_REPEAT_PHASE) { GRIDBAR(); if (blockIdx.x == 0) for (int i = threadIdx.x; i < 2048; i += NTHR) ((unsigned*)(args.ws + WS_CNT))[i] = 0u; GRIDBAR(); RETID(); LOADF();
            attn_select(F, (const float*)(ws + WS_GATE), (unsigned*)(ws + WS_CNT), (unsigned short*)(ws + WS_LISTS)); } } SEAM(2);
#endif
    if constexpr (IN(3)) { RETID(); LOADF(); attn_partial(F, (const bf16*)(ws + WS_QKVZ), (const unsigned*)(ws + WS_CNT), (const unsigned short*)(ws + WS_LISTS),
                                         (bf16*)((unsigned char*)F.out + DO_PARTO), (float*)((unsigned char*)F.out + DO_PARTML), (unsigned*)(ws + WS_QCTR)); if constexpr (3 == MK_REPEAT_PHASE) { { GRIDBAR(); if (blockIdx.x == 0 && threadIdx.x == 0) *(unsigned*)(args.ws + WS_QCTR) = 0u; GRIDBAR(); } RETID(); LOADF(); attn_partial(F, (const bf16*)(ws + WS_QKVZ), (const unsigned*)(ws + WS_CNT), (const unsigned short*)(ws + WS_LISTS),
                                         (bf16*)((unsigned char*)F.out + DO_PARTO), (float*)((unsigned char*)F.out + DO_PARTML), (unsigned*)(ws + WS_QCTR)); } } SEAM(3);
    if constexpr (IN(4)) { RETID(); LOADF();
        if constexpr (4 == MK_REPEAT_PHASE) { attn_own_combine(F, (bf16*)(ws + WS_QKVZ), (const bf16*)((unsigned char*)F.out + DO_PARTO), (const float*)((unsigned char*)F.out + DO_PARTML), (bf16*)(ws + WS_GATE), 512); grid.sync(); RETID(); LOADF(); }
        STAGGER(MK_STAG4);
        attn_own_combine(F, (bf16*)(ws + WS_QKVZ), (const bf16*)((unsigned char*)F.out + DO_PARTO), (const float*)((unsigned char*)F.out + DO_PARTML), (bf16*)(ws + WS_QKVZ), QP); } SEAM(4);
    if constexpr (IN(5)) { RETID(); LOADF(); STAGGER(MK_STAG5); rwkv_chunk_ops(F); if constexpr (5 == MK_REPEAT_PHASE) { GRIDBAR(); RETID(); LOADF(); rwkv_chunk_ops(F); } } SEAM(5);
    if constexpr (IN(6)) { RETID(); LOADF(); rwkv_relay(F); if constexpr (6 == MK_REPEAT_PHASE) { GRIDBAR(); RETID(); LOADF(); rwkv_relay(F); } } SEAM(6);
    if constexpr (IN(7)) { RETID(); LOADF(); STAGGER(MK_STAG7); rwkv_output(F); if constexpr (7 == MK_REPEAT_PHASE) { GRIDBAR(); RETID(); LOADF(); rwkv_output(F); } } SEAM(7);
#ifndef MK_STAG8
#define MK_STAG8 0
#endif
#ifndef MK_STAG10
#define MK_STAG10 0
#endif
#ifndef MK_STAG12
#define MK_STAG12 0
#endif
    if constexpr (IN(8)) { RETID(); LOADF(); STAGGER(MK_STAG8);
        pg8::Gemm g{QKVZ, (const pg8::bf16_t*)(ws + WS_PAB), M, DM, 1024, QP, 1024, 0, 0}; pg8::StaticOrder S; S.init(M, DM, F.G, (int)blockIdx.x);
        pg8::EpiMergeFused E{MERGED, DM, GAB, GP};
        pg8::gemm_phase<pg8::EpiMergeFused, pg8::StaticOrder, true, true>(F.lds, g, S, E);
        if constexpr (8 == MK_REPEAT_PHASE) { GRIDBAR(); pg8::gemm_phase<pg8::EpiMergeFused, pg8::StaticOrder, true, true>(F.lds, g, S, E); }
    } SEAM(9);
    if constexpr (IN(10)) { RETID(); LOADF(); STAGGER(MK_STAG10);
        pg8::bf16_t* YB = RWb + (size_t)M * DM;
        pg8::Gemm g{MERGED, (const pg8::bf16_t*)(ws + WS_WOUT), M, DM, DM, DM, DM, 0, 0}; pg8::StaticOrder S; S.init(M, DM, F.G, (int)blockIdx.x); pg8::EpiYStatG E{YB, DM, (float*)(ws + WS_PARTS)};
        pg8::gemm_phase<pg8::EpiYStatG, pg8::StaticOrder, true, true>(F.lds, g, S, E);
    } SEAM(10);
    if constexpr (IN(11)) { RETID(); LOADF();
        const pg8::bf16_t* YB = RWb + (size_t)M * DM;
        for (int pm = F.vcu; pm < M / 256; pm += F.G) panel_norm(F, pm, (const bf16*)YB, (bf16*)QKVZ, (float*)(ws + WS_RSY), (const f32x4*)(ws + WS_PARTS), pm * 256);
    } SEAM(11);
    if constexpr (IN(12)) { RETID(); LOADF(); STAGGER(MK_STAG12);
        pg8::bf16_t* H1B = QKVZ;
        pg8::Gemm g{H1B, (const pg8::bf16_t*)(ws + WS_WPG), M, DM, ACP, 1344, ACP, 0, 0};        pg8::StaticOrder S; S.init(M, DM, F.G, (int)blockIdx.x);
        pg8::EpiFinal E{F.out, H1B + PLE, (pg8::u32x4*)((unsigned char*)GAB + (size_t)F.vcu * 131072), DM, 1344, F.tid};
        pg8::gemm_phase<pg8::EpiFinal, pg8::StaticOrder, true, true>(F.lds, g, S, E);
        if constexpr (12 == MK_REPEAT_PHASE) { GRIDBAR(); pg8::gemm_phase<pg8::EpiFinal, pg8::StaticOrder, true, true>(F.lds, g, S, E); }
    }
#undef IN
#undef SEAM
}

#ifndef MK_ONE_LAUNCH
#define MK_ONE_LAUNCH 1
#endif
extern "C" void kernel_launch(void* const* d_in, const int* in_sizes, int n_in, void* d_out, int out_size, void* d_ws, size_t ws_size, hipStream_t stream) {
    static int grid = 0;
    if (grid == 0) {
        if (n_in != 21 || out_size != M * DM || ws_size < WS_END) { fprintf(stderr, "kernel_launch: unexpected shapes n_in %d out %d ws %zu\n", n_in, out_size, ws_size); grid = -1; return; }
        int dev = 0, cus = 0, per_cu = 0;
        (void)hipGetDevice(&dev); (void)hipDeviceGetAttribute(&cus, hipDeviceAttributeMultiprocessorCount, dev);
        (void)per_cu;
        grid = cus;
    }
    if (grid < 0) return;
    if (hipMemsetAsync(d_ws, 0, 65536, stream) != hipSuccess) { fprintf(stderr, "kernel_launch: hipMemsetAsync of the control words failed\n"); return; }
    Args a{};
    for (int i = 0; i < 21; ++i) a.in[i] = (const float*)d_in[i];
    a.out = (float*)d_out; a.ws = (unsigned char*)d_ws;
#if MK_ONE_LAUNCH
    a.ph_lo = 0; a.ph_hi = NPHASE;
    void* kargs[] = {&a};
    (void)hipFuncSetAttribute((const void*)fwd<0, NPHASE>, hipFuncAttributeMaxDynamicSharedMemorySize, LDS_BYTES);
    hipError_t e = hipLaunchCooperativeKernel((const void*)fwd<0, NPHASE>, dim3(grid), dim3(NTHR), kargs, LDS_BYTES, stream);
    if (e != hipSuccess) fprintf(stderr, "cooperative launch failed: %s\n", hipGetErrorString(e));
#else
#define LAUNCH_PH(k) do { (void)hipFuncSetAttribute((const void*)fwd<k, k + 1>, hipFuncAttributeMaxDynamicSharedMemorySize, LDS_BYTES); a.ph_lo = k; a.ph_hi = k + 1; hipLaunchKernelGGL((fwd<k, k + 1>), dim3(grid), dim3(NTHR), LDS_BYTES, stream, a); } while (0)
    LAUNCH_PH(0); LAUNCH_PH(1); LAUNCH_PH(2); LAUNCH_PH(3); LAUNCH_PH(4); LAUNCH_PH(5); LAUNCH_PH(6); LAUNCH_PH(7); LAUNCH_PH(8); LAUNCH_PH(9); LAUNCH_PH(10); LAUNCH_PH(11); LAUNCH_PH(12);
#endif
}
```
